# Optimizing an MI355X kernel written in HIP

```python
import math
import jax, jax.numpy as jnp
from jax import lax
import numpy as np

D_MODEL = 1024
BATCH = 8
SEQ = 4096
DEPTH = 1

GRID_W = 64
CTX_LEN = 256
EPS = 1e-6

N_HEADS = 8
N_KV_HEADS = 2
HEAD_DIM = 64
AXIS_ROPE_DIM = HEAD_DIM // 2
ROPE_THETA = 10000.0
Q_BLOCK = 128

HY_DIM = D_MODEL // 2
HY_ORDER = 2
HY_SHORT = 3
HY_EMB_BANDS = 16
HY_EMB_DIM = 1 + 2 * HY_EMB_BANDS
HY_FFN = 64
HY_FAST_DECAY = 0.3
HY_SLOW_DECAY = 1.5
HY_TARGET = 1e-2

Q_DIM = N_HEADS * HEAD_DIM
KV_DIM = N_KV_HEADS * HEAD_DIM
HY_COLS = (HY_ORDER + 1) * HY_DIM
GATE_COLS = 2 * D_MODEL
IN_COLS = Q_DIM + 2 * KV_DIM + HY_COLS + GATE_COLS

PEER_HEADS = 8
PEER_N_KEYS = 128
PEER_N_EXPERTS = PEER_N_KEYS * PEER_N_KEYS
PEER_DK = 256
PEER_TOPK = 16
PEER_CHUNK = 128

kernel_name = "hybrid_hyena_gqa_peer_dit_block"


def rmsnorm(x, g):
    xf = x.astype(jnp.float32)
    y = xf * lax.rsqrt(jnp.mean(xf * xf, axis=-1, keepdims=True) + EPS)
    return (y * g.astype(jnp.float32)).astype(x.dtype)


def modulate(h, shift, scale):
    return h * (1.0 + scale) + shift


def axial_rope(rows):
    t = jnp.arange(rows * GRID_W)
    row = (t // GRID_W).astype(jnp.float32)
    col = (t % GRID_W).astype(jnp.float32)
    inv = ROPE_THETA ** (-jnp.arange(0, AXIS_ROPE_DIM, 2, dtype=jnp.float32) / AXIS_ROPE_DIM)
    ar = row[:, None] * inv
    ac = col[:, None] * inv
    ang = jnp.concatenate([ar, ar, ac, ac], axis=-1)
    return jnp.cos(ang), jnp.sin(ang)


def apply_rope(x, cos, sin):
    xf = x.astype(jnp.float32)
    half = AXIS_ROPE_DIM // 2

    def rot(a):
        return jnp.concatenate([-a[..., half:], a[..., :half]], axis=-1)

    xr = jnp.concatenate([rot(xf[..., :AXIS_ROPE_DIM]), rot(xf[..., AXIS_ROPE_DIM:])], axis=-1)
    return (xf * cos[:, None] + xr * sin[:, None]).astype(x.dtype)


def gqa_blocks(q, k, v):
    B, L, _, _ = q.shape
    G = N_HEADS // N_KV_HEADS
    nb = L // Q_BLOCK
    qb = jnp.moveaxis(q.reshape(B, nb, Q_BLOCK, N_KV_HEADS, G, HEAD_DIM), 1, 0)
    scale = HEAD_DIM ** -0.5

    def one_block(qblk):
        s = jnp.einsum('bqkgd,btkd->bkgqt', qblk, k) * scale
        p = jax.nn.softmax(s.astype(jnp.float32), axis=-1).astype(v.dtype)
        return jnp.einsum('bkgqt,btkd->bqkgd', p, v)

    o = lax.map(one_block, qb)
    return jnp.moveaxis(o, 0, 1).reshape(B, L, Q_DIM)


def short_conv(z, w, b):
    zp = jnp.pad(z, ((0, 0), (1, 1), (0, 0)))
    return zp[:, :-2] * w[0] + zp[:, 1:-1] * w[1] + zp[:, 2:] * w[2] + b


def implicit_filters(L, w1, b1, w2, b2, w3, b3, w4, freq):
    t01 = jnp.linspace(0.0, 1.0, L, dtype=jnp.float32)[:, None]
    w = 2.0 * math.pi * jnp.arange(L, dtype=jnp.float32)[:, None] / L
    f = jnp.linspace(1e-4, HY_EMB_BANDS - 1, HY_EMB_BANDS, dtype=jnp.float32)[None]
    z = jnp.concatenate([t01, jnp.cos(f * w), -jnp.sin(f * w)], axis=-1)
    act = lambda a: jnp.sin(freq * a)
    hmid = act(z @ w1 + b1)
    hmid = act(hmid @ w2 + b2)
    hmid = act(hmid @ w3 + b3)
    h = (hmid @ w4).astype(jnp.float32).reshape(L, HY_ORDER, 2, HY_DIM)
    max_decay = math.log(HY_TARGET) / HY_FAST_DECAY
    min_decay = math.log(HY_TARGET) / HY_SLOW_DECAY
    deltas = jnp.abs(jnp.linspace(min_decay, max_decay, HY_DIM, dtype=jnp.float32))
    h = h * jnp.exp(-t01[:, :, None, None] * deltas)
    fwd = h[:, :, 0]
    bwd = h[:, :, 1]
    k = jnp.concatenate([fwd, jnp.zeros_like(fwd[:1]), bwd[:0:-1]], axis=0)
    k = k / (jnp.sum(jnp.abs(k), axis=0, keepdims=True) + EPS)
    return jnp.fft.rfft(k, axis=0)


def fftconv(u, kf, d):
    L = u.shape[1]
    uf = u.astype(jnp.float32)
    U = jnp.fft.rfft(uf, n=2 * L, axis=1)
    y = jnp.fft.irfft(U * kf[None], n=2 * L, axis=1)[:, :L]
    return y + uf * d.astype(jnp.float32)


def hyena(z_hy, conv_w, conv_b, kf, skip):
    zs = short_conv(z_hy, conv_w, conv_b)
    v, x1, x2 = jnp.split(zs, 3, axis=-1)
    y = x1.astype(jnp.float32) * fftconv(v, kf[:, 0], skip[0])
    y = x2.astype(jnp.float32) * fftconv(y, kf[:, 1], skip[1])
    return y.astype(z_hy.dtype)


def mix(h, p, rope, kv_ext):
    B, L, _ = h.shape
    z = h @ p["w_in"]
    q, k, v, z_hy, gates = jnp.split(
        z, [Q_DIM, Q_DIM + KV_DIM, Q_DIM + 2 * KV_DIM, Q_DIM + 2 * KV_DIM + HY_COLS], axis=-1)
    q = rmsnorm(q.reshape(B, L, N_HEADS, HEAD_DIM), p["q_norm_g"])
    k = rmsnorm(k.reshape(B, L, N_KV_HEADS, HEAD_DIM), p["k_norm_g"])
    v = v.reshape(B, L, N_KV_HEADS, HEAD_DIM)
    if rope is not None:
        q = apply_rope(q, rope[0], rope[1])
        k = apply_rope(k, rope[0], rope[1])
    k_self, v_self = k, v
    if kv_ext is not None:
        k = jnp.concatenate([k, kv_ext[0]], axis=1)
        v = jnp.concatenate([v, kv_ext[1]], axis=1)
    attn = gqa_blocks(q, k, v)
    kf = implicit_filters(L, p["hf_w1"], p["hf_b1"], p["hf_w2"], p["hf_b2"],
                          p["hf_w3"], p["hf_b3"], p["hf_w4"], p["hf_freq"])
    hy = hyena(z_hy, p["hy_conv_w"], p["hy_conv_b"], kf, p["hy_skip"])
    g_attn, g_hy = jnp.split(gates, 2, axis=-1)
    merged = (jax.nn.sigmoid(g_attn) * (attn @ p["w_attn_out"])
              + jax.nn.sigmoid(g_hy) * (hy @ p["w_hy_out"]))
    return merged @ p["w_out"], k_self, v_self


def context_kv(hc, p):
    B, L, _ = hc.shape
    z = hc @ p["w_in"][:, Q_DIM:Q_DIM + 2 * KV_DIM]
    k, v = jnp.split(z, 2, axis=-1)
    k = rmsnorm(k.reshape(B, L, N_KV_HEADS, HEAD_DIM), p["k_norm_g"])
    return k, v.reshape(B, L, N_KV_HEADS, HEAD_DIM)


def peer(h, wq, keys1, keys2, u_tab, v_tab):
    B, L, D = h.shape
    xt = h.reshape(B * L // PEER_CHUNK, PEER_CHUNK, D)
    half = PEER_DK // 2

    def chunk(xc):
        q = (xc @ wq).reshape(PEER_CHUNK, PEER_HEADS, 2, half)
        s1 = jnp.einsum('chd,hnd->chn', q[:, :, 0], keys1).astype(jnp.float32)
        s2 = jnp.einsum('chd,hnd->chn', q[:, :, 1], keys2).astype(jnp.float32)
        v1, i1 = lax.top_k(s1, PEER_TOPK)
        v2, i2 = lax.top_k(s2, PEER_TOPK)
        cand = (v1[..., :, None] + v2[..., None, :]).reshape(PEER_CHUNK, PEER_HEADS, PEER_TOPK * PEER_TOPK)
        cidx = (i1[..., :, None] * PEER_N_KEYS + i2[..., None, :]).reshape(PEER_CHUNK, PEER_HEADS, PEER_TOPK * PEER_TOPK)
        best, pos = lax.top_k(cand, PEER_TOPK)
        eidx = jnp.take_along_axis(cidx, pos, axis=-1)
        g = jax.nn.softmax(best, axis=-1)
        a = jnp.einsum('chkd,cd->chk', u_tab[eidx], xc)
        wgt = (jax.nn.gelu(a.astype(jnp.float32)) * g).astype(xc.dtype)
        return jnp.einsum('chk,chkd->cd', wgt, v_tab[eidx])

    return lax.map(chunk, xt).reshape(B, L, D)


def setup_inputs(seed: int = 0) -> dict:
    key = jax.random.key(seed)
    ks = iter(jax.random.split(key, 40))

    def nrm(shape, scale):
        return jax.random.normal(next(ks), shape, jnp.float32) * scale

    L = DEPTH
    return {
        "x": nrm((BATCH, SEQ, D_MODEL), 1.0),
        "c": nrm((BATCH, D_MODEL), 1.0),
        "ctx": nrm((BATCH, CTX_LEN, D_MODEL), 1.0),
        "c_ctx": nrm((D_MODEL,), 1.0),
        "ada_w": nrm((L, D_MODEL, 6 * D_MODEL), D_MODEL ** -0.5),
        "ada_b": nrm((L, 6 * D_MODEL), 0.02),
        "norm_mix_g": 1.0 + nrm((L, D_MODEL), 0.02),
        "norm_ffn_g": 1.0 + nrm((L, D_MODEL), 0.02),
        "w_in": nrm((L, D_MODEL, IN_COLS), D_MODEL ** -0.5),
        "q_norm_g": 1.0 + nrm((L, HEAD_DIM), 0.02),
        "k_norm_g": 1.0 + nrm((L, HEAD_DIM), 0.02),
        "hy_conv_w": nrm((L, HY_SHORT, HY_COLS), HY_SHORT ** -0.5),
        "hy_conv_b": nrm((L, HY_COLS), 0.02),
        "hf_w1": nrm((L, HY_EMB_DIM, HY_FFN), HY_EMB_DIM ** -0.5),
        "hf_b1": nrm((L, HY_FFN), 0.02),
        "hf_w2": nrm((L, HY_FFN, HY_FFN), HY_FFN ** -0.5),
        "hf_b2": nrm((L, HY_FFN), 0.02),
        "hf_w3": nrm((L, HY_FFN, HY_FFN), HY_FFN ** -0.5),
        "hf_b3": nrm((L, HY_FFN), 0.02),
        "hf_w4": nrm((L, HY_FFN, HY_ORDER * 2 * HY_DIM), HY_FFN ** -0.5),
        "hf_freq": 1.0 + nrm((L, HY_FFN), 0.02),
        "hy_skip": nrm((L, HY_ORDER, HY_DIM), 0.5),
        "w_attn_out": nrm((L, Q_DIM, D_MODEL), Q_DIM ** -0.5),
        "w_hy_out": nrm((L, HY_DIM, D_MODEL), HY_DIM ** -0.5),
        "w_out": nrm((L, D_MODEL, D_MODEL), D_MODEL ** -0.5),
        "peer_wq": nrm((L, D_MODEL, PEER_HEADS * PEER_DK), D_MODEL ** -0.5),
        "peer_keys1": nrm((L, PEER_HEADS, PEER_N_KEYS, PEER_DK // 2), (PEER_DK // 2) ** -0.5),
        "peer_keys2": nrm((L, PEER_HEADS, PEER_N_KEYS, PEER_DK // 2), (PEER_DK // 2) ** -0.5),
        "peer_u": nrm((L, PEER_N_EXPERTS, D_MODEL), D_MODEL ** -0.5),
        "peer_v": nrm((L, PEER_N_EXPERTS, D_MODEL), PEER_HEADS ** -0.5),
        "final_norm_g": 1.0 + nrm((D_MODEL,), 0.02),
    }


def reference(x, c, ctx, c_ctx, ada_w, ada_b, norm_mix_g, norm_ffn_g, w_in, q_norm_g, k_norm_g,
              hy_conv_w, hy_conv_b, hf_w1, hf_b1, hf_w2, hf_b2, hf_w3, hf_b3, hf_w4, hf_freq, hy_skip,
              w_attn_out, w_hy_out, w_out, peer_wq, peer_keys1, peer_keys2, peer_u, peer_v, final_norm_g):
    ROWS = x.shape[1] // GRID_W
    rope = axial_rope(ROWS)
    sc = jax.nn.silu(c)
    scc = jax.nn.silu(c_ctx)
    for i in range(DEPTH):
        p = dict(w_in=w_in[i], q_norm_g=q_norm_g[i], k_norm_g=k_norm_g[i],
                 hy_conv_w=hy_conv_w[i], hy_conv_b=hy_conv_b[i],
                 hf_w1=hf_w1[i], hf_b1=hf_b1[i], hf_w2=hf_w2[i], hf_b2=hf_b2[i],
                 hf_w3=hf_w3[i], hf_b3=hf_b3[i], hf_w4=hf_w4[i], hf_freq=hf_freq[i],
                 hy_skip=hy_skip[i], w_attn_out=w_attn_out[i], w_hy_out=w_hy_out[i], w_out=w_out[i])
        mod = (sc @ ada_w[i] + ada_b[i])[:, None, :]
        mod_c = scc @ ada_w[i] + ada_b[i]
        sh1, sc1, g1, sh2, sc2, g2 = jnp.split(mod, 6, axis=-1)
        csh1, csc1, cg1, csh2, csc2, cg2 = jnp.split(mod_c, 6, axis=-1)

        h = modulate(rmsnorm(x, norm_mix_g[i]), sh1, sc1)
        hc = modulate(rmsnorm(ctx, norm_mix_g[i]), csh1, csc1)
        if i < DEPTH - 1:
            out_c, kc, vc = mix(hc, p, None, None)
        else:
            kc, vc = context_kv(hc, p)
        out, _, _ = mix(h, p, rope, (kc, vc))
        x = x + g1 * out
        x = x + g2 * peer(modulate(rmsnorm(x, norm_ffn_g[i]), sh2, sc2),
                          peer_wq[i], peer_keys1[i], peer_keys2[i], peer_u[i], peer_v[i])
        if i < DEPTH - 1:
            ctx = ctx + cg1 * out_c
            ctx = ctx + cg2 * peer(modulate(rmsnorm(ctx, norm_ffn_g[i]), csh2, csc2),
                                   peer_wq[i], peer_keys1[i], peer_keys2[i], peer_u[i], peer_v[i])
    return rmsnorm(x, final_norm_g)
```

```cpp
#include <hip/hip_runtime.h>
#include <stdint.h>
#include <cstdio>

#define DI __device__ __forceinline__
#define LAS __attribute__((address_space(3)))
typedef unsigned short bf16_t;
typedef short bf16x8 __attribute__((ext_vector_type(8)));
typedef short s16x4 __attribute__((ext_vector_type(4)));
typedef float f32x4 __attribute__((ext_vector_type(4)));
typedef float f32x16 __attribute__((ext_vector_type(16)));
typedef unsigned u32x4 __attribute__((ext_vector_type(4)));
typedef unsigned u32x2 __attribute__((ext_vector_type(2)));

constexpr int BATCH = 8, SEQ = 4096, DM = 1024, BT = BATCH * SEQ;
constexpr int CTX = 256, TK = SEQ + CTX;
constexpr int NH = 8, NKV = 2, HD = 64;
constexpr int QD = 512, KVD = 128, HYD = 512, HYC = 1536, GC = 2048, INC = 4352;
constexpr int PH = 8, PNK = 128, PDK = 256, PTOP = 16;
constexpr float EPS = 1e-6f;
constexpr int NT = 1024;

enum { I_X = 0, I_C, I_CTX, I_CCTX, I_ADAW, I_ADAB, I_NMIX, I_NFFN, I_WIN, I_QNG, I_KNG, I_HCW, I_HCB,
       I_HW1, I_HB1, I_HW2, I_HB2, I_HW3, I_HB3, I_HW4, I_HFREQ, I_HSKIP, I_WAO, I_WHO, I_WO, I_PWQ, I_PK1, I_PK2, I_PU, I_PV, I_FNG, N_IN };

constexpr size_t MB = 1024 * 1024;
constexpr size_t WS_CTL   = 0;
constexpr size_t WS_MOD   = 64 * 1024;
constexpr size_t WS_ROPE  = WS_MOD + 9 * 6144 * 4;
constexpr size_t WS_PART  = 512 * 1024;
constexpr size_t WS_WTIN  = 3 * MB;
constexpr size_t WS_WTAO  = WS_WTIN + (size_t)INC * DM * 2;
constexpr size_t WS_WTHO  = WS_WTAO + (size_t)DM * QD * 2;
constexpr size_t WS_WTO   = WS_WTHO + (size_t)DM * HYD * 2;
constexpr size_t WS_WTQ   = WS_WTO + (size_t)DM * DM * 2;
constexpr size_t WS_KEYS  = WS_WTQ + (size_t)2048 * DM * 2;
constexpr size_t WS_R     = WS_KEYS + (size_t)2 * 8 * 128 * 128 * 2;
constexpr size_t WS_KB    = WS_R + (size_t)2 * 512 * 8192 * 2;
constexpr size_t WS_VT    = WS_KB + (size_t)BATCH * NKV * TK * HD * 2;
constexpr size_t WS_HC    = WS_VT + (size_t)BATCH * NKV * TK * HD * 2;
constexpr size_t WS_H     = 60 * MB;
constexpr size_t WS_G     = WS_H + 64 * MB;
constexpr size_t WS_ZT    = WS_G + 128 * MB;
constexpr size_t WS_Q     = WS_ZT + 96 * MB;
constexpr size_t WS_ATT   = WS_Q + 32 * MB;
constexpr size_t WS_HYT   = WS_ATT + 32 * MB;
constexpr size_t WS_END   = WS_HYT + 32 * MB;
static_assert(WS_HC + (size_t)2048 * DM * 2 <= WS_H, "ws overlap");
constexpr size_t WS_FRAW  = WS_ATT;
constexpr size_t WS_HY    = WS_Q;
constexpr size_t WS_UT    = WS_ZT;
constexpr size_t WS_VTAB  = WS_ZT + 32 * MB;

constexpr int CTL_BADTID = 8000;
DI unsigned f2bf(float f) { unsigned u = __builtin_bit_cast(unsigned, f); return (u + 0x7fffu + ((u >> 16) & 1u)) >> 16; }
DI unsigned pk2(float lo, float hi) { return f2bf(lo) | (f2bf(hi) << 16); }
DI float bf2f(unsigned short b) { return __builtin_bit_cast(float, (unsigned)b << 16); }
DI float bflo(unsigned u) { return __builtin_bit_cast(float, u << 16); }
DI float bfhi(unsigned u) { return __builtin_bit_cast(float, u & 0xffff0000u); }
DI float red2pi(float x) { const float k = rintf(x * 0.15915494309189535f); float r = fmaf(-k, 6.2831854820251465f, x); return fmaf(-k, -1.7484555e-7f, r); }
DI float fsin(float x) { return __sinf(red2pi(x)); }
DI float fcos(float x) { return __cosf(red2pi(x)); }
constexpr int LDS_BYTES = 160 * 1024;
constexpr int LDS_ST_OFF = LDS_BYTES - 16;
constexpr int LDS_WTAB_OFF = LDS_BYTES - 16 - 64;
constexpr int LDS_USER = LDS_WTAB_OFF;
__shared__ __attribute__((aligned(16))) unsigned char g_lds[LDS_BYTES];
DI int get_tid() {
    const unsigned hw = __builtin_amdgcn_s_getreg((5 << 11) | 4);
    unsigned w = g_lds[LDS_WTAB_OFF + hw];
    w = __builtin_amdgcn_readfirstlane(w);
    int t;
    asm volatile("v_mbcnt_lo_u32_b32 %0, -1, 0\n\tv_mbcnt_hi_u32_b32 %0, -1, %0\n\tv_lshl_or_b32 %0, %1, 6, %0" : "=&v"(t) : "s"(w));
    return t;
}
template<int CTRL> DI float dppf(float v) { return __uint_as_float(__builtin_amdgcn_update_dpp(0u, __float_as_uint(v), CTRL, 0xF, 0xF, true)); }
DI float sum16(float v) { v += dppf<0xB1>(v); v += dppf<0x4E>(v); v += dppf<0x141>(v); v += dppf<0x140>(v); return v; }
DI float sum_x16(float v) { auto r = __builtin_amdgcn_permlane16_swap(__float_as_uint(v), __float_as_uint(v), false, false); return __uint_as_float(r[0]) + __uint_as_float(r[1]); }
DI float sum_x32(float v) { auto r = __builtin_amdgcn_permlane32_swap(__float_as_uint(v), __float_as_uint(v), false, false); return __uint_as_float(r[0]) + __uint_as_float(r[1]); }
DI float max_x32(float v) { auto r = __builtin_amdgcn_permlane32_swap(__float_as_uint(v), __float_as_uint(v), false, false); return fmaxf(__uint_as_float(r[0]), __uint_as_float(r[1])); }
DI float wave_sum(float v) { return sum_x32(sum_x16(sum16(v))); }

#define XB_TMO      128
#define XB_XCNT(j)  (256  + 64 * (j))
#define XB_XSUB(j)  (1280 + 64 * (j))
#define XB_XGEN(j)  (2304 + 64 * (j))
#define XB_TOP      3328
#define XB_TOPGEN   3392
#define XCD_BAR_WORDS 3456
#define XB_SPIN_CAP (1u << 27)
DI unsigned xb_ld(unsigned* p)              { return __hip_atomic_load(p, __ATOMIC_RELAXED, __HIP_MEMORY_SCOPE_AGENT); }
DI unsigned xb_add(unsigned* p, unsigned v) { return __hip_atomic_fetch_add(p, v, __ATOMIC_RELAXED, __HIP_MEMORY_SCOPE_AGENT); }
DI unsigned xb_xcc_id() { return (unsigned)__builtin_amdgcn_s_getreg((3 << 11) | 20) & 0xFu; }
#define XB_SPIN(cond, bar) do { unsigned _sp = 0; while (cond) { __builtin_amdgcn_s_sleep(1); \
    if ((++_sp & 255u) == 0u) { if (xb_ld(&(bar)[XB_TMO])) break; if (_sp > XB_SPIN_CAP) { atomicAdd(&(bar)[XB_TMO], 1u); break; } } } } while (0)
struct XcdBarrier { unsigned* bar; unsigned x; volatile LAS unsigned* st; };
DI XcdBarrier xcd_barrier_post(unsigned* bar, volatile LAS unsigned* st) {
    XcdBarrier b; b.bar = bar; b.x = xb_xcc_id(); b.st = st;
    if (get_tid() == 0) (void)xb_add(&bar[XB_XCNT(b.x)], 1u);
    return b;
}
DI void xcd_barrier_complete(unsigned* bar, unsigned x, unsigned& nloc, unsigned& nx) {
    const unsigned G = gridDim.x * gridDim.y * gridDim.z;
    unsigned sum, cnt, mine, sp = 0u;
    for (;;) {
        sum = 0u; cnt = 0u; mine = 0u;
#pragma unroll
        for (unsigned j = 0; j < 16; ++j) { const unsigned c = xb_ld(&bar[XB_XCNT(j)]); sum += c; cnt += (c > 0u) ? 1u : 0u; mine = (j == x) ? c : mine; }
        if (sum == G) break;
        __builtin_amdgcn_s_sleep(1);
        if ((++sp & 255u) == 0u) { if (xb_ld(&bar[XB_TMO])) break; if (sp > XB_SPIN_CAP) { atomicAdd(&bar[XB_TMO], 1u); break; } }
    }
    nloc = mine > 0u ? mine : 1u; nx = cnt > 0u ? cnt : 1u;
}
DI void xcd_barrier(const XcdBarrier& b) {
    asm volatile("s_waitcnt vmcnt(0)" ::: "memory");
    __syncthreads();
    if (get_tid() == 0) {
        unsigned* bar = b.bar;
        __builtin_amdgcn_s_waitcnt(0);
        unsigned nloc = b.st[0], nx = b.st[1];
        if (nloc == 0u) { xcd_barrier_complete(bar, b.x, nloc, nx); b.st[0] = nloc; b.st[1] = nx; }
        const unsigned old = xb_add(&bar[XB_XSUB(b.x)], 1u);
        const unsigned gen = old / nloc;
        if (old + 1u == (gen + 1u) * nloc) {
            __builtin_amdgcn_fence(__ATOMIC_RELEASE, "agent");
            asm volatile("s_waitcnt vmcnt(0)" ::: "memory");
            const unsigned og = xb_add(&bar[XB_TOP], 1u);
            const unsigned tg = og / nx;
            if (og + 1u == (tg + 1u) * nx) xb_add(&bar[XB_TOPGEN], 1u);
            else XB_SPIN(xb_ld(&bar[XB_TOPGEN]) == tg, bar);
            __builtin_amdgcn_fence(__ATOMIC_ACQUIRE, "agent");
            xb_add(&bar[XB_XGEN(b.x)], 1u);
            asm volatile("s_waitcnt vmcnt(0)" ::: "memory");
        } else {
            XB_SPIN(xb_ld(&bar[XB_XGEN(b.x)]) == gen, bar);
            __builtin_amdgcn_fence(__ATOMIC_ACQUIRE, "agent");
            asm volatile("s_waitcnt vmcnt(0)" ::: "memory");
        }
    }
    __syncthreads();
}

struct Params { const float* in[N_IN]; float* out; unsigned char* ws; };


DI void transpose_tile(const float* __restrict__ W, int K, int N, bf16_t* __restrict__ Wt, int tile, float* sm) {
    const int tid = get_tid();
    const int ntn = N / 64, tk = tile / ntn, tn = tile % ntn;
#pragma unroll
    for (int i = 0; i < 4; ++i) {
        const int idx = tid + i * NT, kk = idx >> 6, nn = idx & 63;
        sm[kk * 65 + nn] = W[(size_t)(tk * 64 + kk) * N + tn * 64 + nn];
    }
    __syncthreads();
#pragma unroll
    for (int i = 0; i < 2; ++i) {
        const int idx = tid + i * NT, nn = idx >> 5, kp = (idx & 31) * 2;
        const unsigned v = pk2(sm[kp * 65 + nn], sm[(kp + 1) * 65 + nn]);
        *(unsigned*)(Wt + (size_t)(tn * 64 + nn) * K + tk * 64 + kp) = v;
    }
    __syncthreads();
}

DI void mod_item(const Params& p, int item, float* sm) {
    const int tid = get_tid();
    float* sc = sm;
    float* red = sm + 9 * 1024;
    for (int i = tid; i < 9 * 1024; i += NT) {
        const float v = (i < 8 * 1024) ? p.in[I_C][i] : p.in[I_CCTX][i - 8 * 1024];
        sc[i] = v / (1.f + __expf(-v));
    }
    __syncthreads();
    const int col = tid & 63, kg = tid >> 6, n0 = item * 64;
    float acc[9];
#pragma unroll
    for (int r = 0; r < 9; ++r) acc[r] = 0.f;
    const float* w = p.in[I_ADAW] + n0 + col;
#pragma unroll 8
    for (int k = kg * 64; k < kg * 64 + 64; ++k) {
        const float wv = w[(size_t)k * 6144];
#pragma unroll
        for (int r = 0; r < 9; ++r) acc[r] += sc[r * 1024 + k] * wv;
    }
#pragma unroll
    for (int r = 0; r < 9; ++r) red[(kg * 9 + r) * 64 + col] = acc[r];
    __syncthreads();
    if (tid < 9 * 64) {
        const int r = tid >> 6, c2 = tid & 63;
        float s = p.in[I_ADAB][n0 + c2];
#pragma unroll
        for (int g = 0; g < 16; ++g) s += red[(g * 9 + r) * 64 + c2];
        ((float*)(p.ws + WS_MOD))[r * 6144 + n0 + c2] = s;
    }
    __syncthreads();
}

DI void filter_item(const Params& p, int item, float* sm) {
    const int tid = get_tid();
    float* z  = sm;
    float* ha = sm + 16 * 36;
    float* hb = ha + 16 * 64;
    const int t0 = item * 16;
    if (tid < 16 * 33) {
        const int pp = tid / 33, i = tid % 33;
        const int t = t0 + pp;
        float v;
        if (i == 0) v = (float)t / (float)(SEQ - 1);
        else {
            const int fi = (i - 1) & 15;
            const float f = 1e-4f + (float)fi * ((15.f - 1e-4f) / 15.f);
            const float w = 6.283185307179586f * (float)t / (float)SEQ;
            const float a = f * w;
            v = (i <= 16) ? fcos(a) : -fsin(a);
        }
        z[pp * 36 + i] = v;
    }
    __syncthreads();
    const int pp = tid >> 6, j = tid & 63;
    const float fr = p.in[I_HFREQ][j];
    {
        float a = p.in[I_HB1][j];
        const float* w1 = p.in[I_HW1];
#pragma unroll 11
        for (int i = 0; i < 33; ++i) a += z[pp * 36 + i] * w1[i * 64 + j];
        ha[pp * 64 + j] = fsin(fr * a);
    }
    __syncthreads();
    {
        float a = p.in[I_HB2][j];
        const float* w2 = p.in[I_HW2];
#pragma unroll 8
        for (int i = 0; i < 64; ++i) a += ha[pp * 64 + i] * w2[i * 64 + j];
        hb[pp * 64 + j] = fsin(fr * a);
    }
    __syncthreads();
    {
        float a = p.in[I_HB3][j];
        const float* w3 = p.in[I_HW3];
#pragma unroll 8
        for (int i = 0; i < 64; ++i) a += hb[pp * 64 + i] * w3[i * 64 + j];
        __syncthreads();
        ha[pp * 64 + j] = fsin(fr * a);
    }
    __syncthreads();
    float* fraw = (float*)(p.ws + WS_FRAW);
    float* part = (float*)(p.ws + WS_PART);
    const float* w4 = p.in[I_HW4];
#pragma unroll 1
    for (int cc = 0; cc < 2; ++cc) {
        const int col = tid + cc * NT;
        float acc[16];
#pragma unroll
        for (int q = 0; q < 16; ++q) acc[q] = 0.f;
#pragma unroll 4
        for (int i = 0; i < 64; ++i) {
            const float wv = w4[i * 2048 + col];
#pragma unroll
            for (int q = 0; q < 16; ++q) acc[q] += ha[q * 64 + i] * wv;
        }
        const int c = col & 511, dir = (col >> 9) & 1;
        const float mind = -3.0701134573253945f, maxd = -15.350567286626973f;
        const float delta = fabsf(mind + (float)c * ((maxd - mind) / 511.f));
        float s = 0.f;
#pragma unroll
        for (int q = 0; q < 16; ++q) {
            const int t = t0 + q;
            const float t01 = (float)t / (float)(SEQ - 1);
            const float v = acc[q] * expf(-t01 * delta);
            acc[q] = v;
            if (!(dir == 1 && t == 0)) s += fabsf(v);
        }
        float* dst = fraw + (size_t)col * SEQ + t0;
#pragma unroll
        for (int q = 0; q < 16; q += 4) *(f32x4*)(dst + q) = f32x4{acc[q], acc[q + 1], acc[q + 2], acc[q + 3]};
        part[item * 2048 + col] = s;
    }
    __syncthreads();
}

DI void phase_a(const Params& p, float* sm) {
    constexpr int T_WIN = 16 * 68, T_AO = 8 * 16, T_HO = 8 * 16, T_WO = 16 * 16, T_WQ = 16 * 32;
    constexpr int E0 = T_WIN, E1 = E0 + T_AO, E2 = E1 + T_HO, E3 = E2 + T_WO, E4 = E3 + T_WQ;
    constexpr int E5 = E4 + 64;
    constexpr int E6 = E5 + 96;
    constexpr int E7 = E6 + 1;
    constexpr int E8 = E7 + 256;
    for (int it = blockIdx.x; it < E8; it += gridDim.x) {
        int item = it;
        if (item < 256) { filter_item(p, item, sm); continue; }
        item -= 256;
        if (item < 96) { mod_item(p, item, sm); continue; }
        item -= 96;
        if (item < 1) {
            const int tid = get_tid();
            float* rope = (float*)(p.ws + WS_ROPE);
            const int pos = tid >> 4, f = tid & 15;
            const float inv = powf(10000.f, -(float)(2 * f) / 32.f);
            const float ang = (float)pos * inv;
            rope[tid] = fcos(ang); rope[1024 + tid] = fsin(ang);
            continue;
        }
        item -= 1;
        if (item < 64) {
            const int tid = get_tid();
            const float* src = (item < 32) ? p.in[I_PK1] : p.in[I_PK2];
            bf16_t* dst = (bf16_t*)(p.ws + WS_KEYS) + (size_t)item * 4096;
            const f32x4 v = *(const f32x4*)(src + (size_t)(item & 31) * 4096 + tid * 4);
            *(u32x2*)(dst + tid * 4) = u32x2{pk2(v[0], v[1]), pk2(v[2], v[3])};
            continue;
        }
        item -= 64;
        if (item < T_WIN) { transpose_tile(p.in[I_WIN], DM, INC, (bf16_t*)(p.ws + WS_WTIN), item, sm); continue; }
        item -= T_WIN;
        if (item < T_AO) { transpose_tile(p.in[I_WAO], QD, DM, (bf16_t*)(p.ws + WS_WTAO), item, sm); continue; }
        item -= T_AO;
        if (item < T_HO) { transpose_tile(p.in[I_WHO], HYD, DM, (bf16_t*)(p.ws + WS_WTHO), item, sm); continue; }
        item -= T_HO;
        if (item < T_WO) { transpose_tile(p.in[I_WO], DM, DM, (bf16_t*)(p.ws + WS_WTO), item, sm); continue; }
        item -= T_WO;
        transpose_tile(p.in[I_PWQ], DM, 2048, (bf16_t*)(p.ws + WS_WTQ), item, sm);
    }
    (void)E1; (void)E2; (void)E3; (void)E4; (void)E5; (void)E6; (void)E7;
}

DI void norm_mod_row(const float* __restrict__ src, const float* __restrict__ g, const float* __restrict__ shift, const float* __restrict__ scale, bf16_t* __restrict__ dst) {
    const int lane = get_tid() & 63;
    f32x4 v[4];
    float ss = 0.f;
#pragma unroll
    for (int j = 0; j < 4; ++j) { v[j] = *(const f32x4*)(src + j * 256 + lane * 4); ss += v[j][0] * v[j][0] + v[j][1] * v[j][1] + v[j][2] * v[j][2] + v[j][3] * v[j][3]; }
    ss = wave_sum(ss);
    const float rs = rsqrtf(ss * (1.f / DM) + EPS);
#pragma unroll
    for (int j = 0; j < 4; ++j) {
        const int c = j * 256 + lane * 4;
        const f32x4 gg = *(const f32x4*)(g + c), sh = *(const f32x4*)(shift + c), sc = *(const f32x4*)(scale + c);
        float o[4];
#pragma unroll
        for (int e = 0; e < 4; ++e) o[e] = v[j][e] * rs * gg[e] * (1.f + sc[e]) + sh[e];
        *(u32x2*)(dst + c) = u32x2{pk2(o[0], o[1]), pk2(o[2], o[3])};
    }
}

DI void filter_norm_item(const Params& p, int item, float* sm) {
    const int tid = get_tid();
    const int o = item >> 9, c = item & 511;
    const int colf = o * 1024 + c, colb = colf + 512;
    const float* part = (const float*)(p.ws + WS_PART);
    float s = 0.f;
    if (tid < 512) s = part[(tid & 255) * 2048 + ((tid < 256) ? colf : colb)];
    s = wave_sum(s);
    if ((tid & 63) == 0) sm[tid >> 6] = s;
    __syncthreads();
    float tot = EPS;
#pragma unroll
    for (int i = 0; i < 8; ++i) tot += sm[i];
    const float inv = 1.f / tot;
    const float* fraw = (const float*)(p.ws + WS_FRAW);
    bf16_t* R = (bf16_t*)(p.ws + WS_R) + (size_t)item * 8192;
#pragma unroll
    for (int i = 0; i < 4; ++i) {
        const int n = (tid + i * NT) * 2;
        float v0, v1;
        if (n < 4096) { v0 = (n == 0) ? 0.f : fraw[(size_t)colf * SEQ + 4096 - n]; v1 = fraw[(size_t)colf * SEQ + 4095 - n]; }
        else if (n == 4096) { v0 = fraw[(size_t)colf * SEQ]; v1 = fraw[(size_t)colb * SEQ + 1]; }
        else { v0 = fraw[(size_t)colb * SEQ + n - 4096]; v1 = fraw[(size_t)colb * SEQ + n - 4095]; }
        *(unsigned*)(R + n) = pk2(v0 * inv, v1 * inv);
    }
    __syncthreads();
}

DI void phase_b(const Params& p, float* sm) {
    const int wave = get_tid() >> 6;
    const float* mod = (const float*)(p.ws + WS_MOD);
    constexpr int ROW_ITEMS = (BT + BATCH * CTX) / 16;
    for (int it = blockIdx.x; it < ROW_ITEMS + 1024; it += gridDim.x) {
        if (it < 1024) { filter_norm_item(p, it, sm); continue; }
        const int row = (it - 1024) * 16 + wave;
        if (row < BT) {
            const int b = row >> 12;
            norm_mod_row(p.in[I_X] + (size_t)row * DM, p.in[I_NMIX], mod + b * 6144, mod + b * 6144 + 1024, (bf16_t*)(p.ws + WS_H) + (size_t)row * DM);
        } else {
            const int r = row - BT;
            norm_mod_row(p.in[I_CTX] + (size_t)r * DM, p.in[I_NMIX], mod + 8 * 6144, mod + 8 * 6144 + 1024, (bf16_t*)(p.ws + WS_HC) + (size_t)r * DM);
        }
    }
}

#define MFMA16(a, b, c) __builtin_amdgcn_mfma_f32_16x16x32_bf16((a), (b), (c), 0, 0, 0)
constexpr int GT_P = 256 * 128;
struct RowLoader {
    const bf16_t* base; int ld;
    template<int ROWS> DI void issue(unsigned char* tile, int kt, int lane, int wave) const {
#pragma unroll
        for (int i = 0; i < ROWS / 128; ++i) {
            const int grp = i * 16 + wave, row = grp * 8 + (lane >> 3), c = (lane & 7) ^ (lane >> 3);
            __builtin_amdgcn_global_load_lds((const unsigned*)(base + (size_t)row * ld + kt * 64 + c * 8), (unsigned*)(tile + grp * 1024), 16, 0, 0);
        }
    }
};
template<int NQ>
DI void gemm_mainloop(f32x4 (&acc)[4][NQ], const RowLoader& lp, const RowLoader& lq, int nk, unsigned char* lds) {
    const int tid = get_tid(), lane = tid & 63, wave = __builtin_amdgcn_readfirstlane(tid >> 6), wp = wave >> 2, wq = wave & 3;
    constexpr int QROWS = NQ * 64;
    constexpr int STAGE = GT_P + QROWS * 128;
    __syncthreads();
    lp.template issue<256>(lds, 0, lane, wave); lq.template issue<QROWS>(lds + GT_P, 0, lane, wave);
    asm volatile("s_waitcnt vmcnt(0)" ::: "memory");
    __syncthreads();
    const int l15 = lane & 15, lk = lane >> 4;
    for (int kt = 0; kt < nk; ++kt) {
        unsigned char* cur = lds + (kt & 1) * STAGE;
        unsigned char* nxt = lds + ((kt + 1) & 1) * STAGE;
        if (kt + 1 < nk) { lp.template issue<256>(nxt, kt + 1, lane, wave); lq.template issue<QROWS>(nxt + GT_P, kt + 1, lane, wave); }
#pragma unroll
        for (int ks = 0; ks < 2; ++ks) {
            bf16x8 fp[4], fq[NQ];
#pragma unroll
            for (int i = 0; i < 4; ++i) { const int row = wp * 64 + i * 16 + l15; fp[i] = *(const bf16x8*)(cur + row * 128 + (((ks * 4 + lk) ^ (row & 7)) << 4)); }
#pragma unroll
            for (int j = 0; j < NQ; ++j) { const int row = wq * (16 * NQ) + j * 16 + l15; fq[j] = *(const bf16x8*)(cur + GT_P + row * 128 + (((ks * 4 + lk) ^ (row & 7)) << 4)); }
#pragma unroll
            for (int i = 0; i < 4; ++i)
#pragma unroll
                for (int j = 0; j < NQ; ++j) acc[i][j] = MFMA16(fp[i], fq[j], acc[i][j]);
        }
        asm volatile("s_waitcnt vmcnt(0)" ::: "memory");
        __syncthreads();
    }
}

DI void head_epilogue(f32x4 (&acc)[4][4], const float* __restrict__ g, const float* __restrict__ rope, bool do_rope, int t_base  , bf16_t* __restrict__ dst  , int lane) {
    const int l15 = lane & 15, lk = lane >> 4;
    float gg[4];
#pragma unroll
    for (int j = 0; j < 4; ++j) gg[j] = g[j * 16 + l15];
#pragma unroll
    for (int i = 0; i < 4; ++i) {
#pragma unroll
        for (int r = 0; r < 4; ++r) {
            float ss = 0.f;
#pragma unroll
            for (int j = 0; j < 4; ++j) ss += acc[i][j][r] * acc[i][j][r];
            ss = sum16(ss);
            const float rs = rsqrtf(ss * (1.f / 64.f) + EPS);
            float v[4];
#pragma unroll
            for (int j = 0; j < 4; ++j) v[j] = acc[i][j][r] * rs * gg[j];
            const int t = t_base + i * 16 + lk * 4 + r;
            if (do_rope) {
                const int prow = (t >> 6) & 63, pcol = t & 63;
                const float c0 = rope[prow * 16 + l15], s0 = rope[1024 + prow * 16 + l15];
                const float c1 = rope[pcol * 16 + l15], s1 = rope[1024 + pcol * 16 + l15];
                const float a0 = v[0] * c0 - v[1] * s0, a1 = v[1] * c0 + v[0] * s0;
                const float a2 = v[2] * c1 - v[3] * s1, a3 = v[3] * c1 + v[2] * s1;
                v[0] = a0; v[1] = a1; v[2] = a2; v[3] = a3;
            }
            bf16_t* d = dst + (size_t)(i * 16 + lk * 4 + r) * 64 + l15;
#pragma unroll
            for (int j = 0; j < 4; ++j) d[j * 16] = (bf16_t)f2bf(v[j]);
        }
    }
}
DI void tstore_epilogue(f32x4 (&acc)[4][4], bf16_t* __restrict__ dst  , size_t ld, int lane) {
    const int l15 = lane & 15, lk = lane >> 4;
#pragma unroll
    for (int i = 0; i < 4; ++i)
#pragma unroll
        for (int j = 0; j < 4; ++j)
            *(u32x2*)(dst + (size_t)(j * 16 + l15) * ld + i * 16 + lk * 4) = u32x2{pk2(acc[i][j][0], acc[i][j][1]), pk2(acc[i][j][2], acc[i][j][3])};
}

DI void phase_c(const Params& p, unsigned char* lds) {
    constexpr int NTM = BT / 256, NTN = INC / 256;
    constexpr int MAIN = NTM * NTN, TOTAL = MAIN + 8;
    const bf16_t* H = (const bf16_t*)(p.ws + WS_H);
    const bf16_t* HCp = (const bf16_t*)(p.ws + WS_HC);
    const bf16_t* WT = (const bf16_t*)(p.ws + WS_WTIN);
    const float* rope = (const float*)(p.ws + WS_ROPE);
    for (int it = blockIdx.x; it < TOTAL; it += gridDim.x) {
        const int tid = get_tid(), lane = tid & 63, wave = tid >> 6, wa = wave >> 2, wb = wave & 3;
        int tm, tn; bool ctx = false;
        if (it < MAIN) { const int g = it / (16 * NTN), rem = it % (16 * NTN); tn = rem >> 4; tm = g * 16 + (rem & 15); }
        else { ctx = true; tm = it - MAIN; tn = 2; }
        const bf16_t* A = ctx ? HCp + (size_t)tm * 256 * DM : H + (size_t)tm * 256 * DM;
        const bf16_t* W = WT + (size_t)tn * 256 * DM;
        f32x4 acc[4][4];
#pragma unroll
        for (int i = 0; i < 4; ++i)
#pragma unroll
            for (int j = 0; j < 4; ++j) acc[i][j] = f32x4{0.f, 0.f, 0.f, 0.f};
        if (tn >= 9) {
            gemm_mainloop<4>(acc, RowLoader{W, DM}, RowLoader{A, DM}, DM / 64, lds);
            bf16_t* G = (bf16_t*)(p.ws + WS_G);
            const int l15 = lane & 15, lk = lane >> 4;
#pragma unroll
            for (int i = 0; i < 4; ++i)
#pragma unroll
                for (int j = 0; j < 4; ++j) {
                    const int n = tn * 256 - 2304 + wa * 64 + i * 16 + lk * 4;
                    const int tok = tm * 256 + wb * 64 + j * 16 + l15;
                    float sg[4];
#pragma unroll
                    for (int r = 0; r < 4; ++r) sg[r] = 1.f / (1.f + __expf(-acc[i][j][r]));
                    *(u32x2*)(G + (size_t)tok * GC + n) = u32x2{pk2(sg[0], sg[1]), pk2(sg[2], sg[3])};
                }
            continue;
        }
        gemm_mainloop<4>(acc, RowLoader{A, DM}, RowLoader{W, DM}, DM / 64, lds);
        const int b = ctx ? tm : (tm >> 4);
        const int tpos = ctx ? SEQ + wa * 64 : ((tm & 15) * 256 + wa * 64);
        if (tn < 2) {
            const int h = tn * 4 + wb;
            bf16_t* Q = (bf16_t*)(p.ws + WS_Q) + ((size_t)(b * NH + h) * SEQ + tpos) * HD;
            head_epilogue(acc, p.in[I_QNG], rope, true, tpos, Q, lane);
        } else if (tn == 2) {
            if (wb < 2) {
                bf16_t* K = (bf16_t*)(p.ws + WS_KB) + ((size_t)(b * NKV + wb) * TK + tpos) * HD;
                head_epilogue(acc, p.in[I_KNG], rope, !ctx, tpos, K, lane);
            } else {
                bf16_t* V = (bf16_t*)(p.ws + WS_VT) + (size_t)(b * NKV + (wb - 2)) * HD * TK + tpos;
                tstore_epilogue(acc, V, TK, lane);
            }
        } else {
            const int col = tn * 256 - 768 + wb * 64;
            bf16_t* Z = (bf16_t*)(p.ws + WS_ZT) + (size_t)col * BT + (size_t)b * SEQ + tpos;
            tstore_epilogue(acc, Z, BT, lane);
        }
    }
}

#define MFMA32(a, b, c) __builtin_amdgcn_mfma_f32_32x32x16_bf16((a), (b), (c), 0, 0, 0)
DI bf16x8 pack_step(const f32x16& x, int s) {
    u32x4 pk;
    asm volatile("v_cvt_pk_bf16_f32 %0, %4, %5\n\tv_cvt_pk_bf16_f32 %1, %6, %7\n\tv_cvt_pk_bf16_f32 %2, %8, %9\n\tv_cvt_pk_bf16_f32 %3, %10, %11\n\ts_nop 1"
                 : "=&v"(pk[0]), "=&v"(pk[1]), "=&v"(pk[2]), "=&v"(pk[3])
                 : "v"(x[8 * s]), "v"(x[8 * s + 1]), "v"(x[8 * s + 2]), "v"(x[8 * s + 3]), "v"(x[8 * s + 4]), "v"(x[8 * s + 5]), "v"(x[8 * s + 6]), "v"(x[8 * s + 7]));
    return __builtin_bit_cast(bf16x8, pk);
}

DI void attn_item(const Params& p, int item, unsigned char* lds) {
    const int tid = get_tid(), lane = tid & 63, wave = tid >> 6;
    const int b = item >> 6, kvh = (item >> 5) & 1, qb = item & 31;
    const int h = kvh * 4 + (wave >> 2), q0 = qb * 128 + (wave & 3) * 32;
    const int qi = lane & 31, hf = lane >> 5;
    const bf16_t* Qp = (const bf16_t*)(p.ws + WS_Q) + ((size_t)(b * NH + h) * SEQ + q0 + qi) * HD;
    bf16x8 qf[4];
#pragma unroll
    for (int s = 0; s < 4; ++s) qf[s] = *(const bf16x8*)(Qp + 16 * s + 8 * hf);
    const bf16_t* Kg = (const bf16_t*)(p.ws + WS_KB) + (size_t)(b * NKV + kvh) * TK * HD;
    const bf16_t* Vg = (const bf16_t*)(p.ws + WS_VT) + (size_t)(b * NKV + kvh) * HD * TK;
    const bool isK = tid < 512;
    const int li = tid & 511, lrow = li >> 3, lc = li & 7;
    const bf16_t* src = isK ? Kg + (size_t)lrow * HD + lc * 8 : Vg + (size_t)lrow * TK + lc * 8;
    const size_t sstep = isK ? (size_t)64 * HD : 64;
    const int ldst = (isK ? 0 : 8192) + lrow * 128 + ((lc ^ (lrow & 7)) << 4);
    constexpr int NTILE = TK / 64;
    const float c = 0.125f * 1.4426950408889634f;
    f32x16 o0, o1;
#pragma unroll
    for (int i = 0; i < 16; ++i) { o0[i] = 0.f; o1[i] = 0.f; }
    float m = -1e30f, l = 0.f;
    __syncthreads();
    u32x4 stg = *(const u32x4*)src;
    *(u32x4*)(lds + ldst) = stg;
    __syncthreads();
    for (int tile = 0; tile < NTILE; ++tile) {
        const unsigned char* cur = lds + (tile & 1) * 16384;
        const bool more = tile + 1 < NTILE;
        if (more) stg = *(const u32x4*)(src + (size_t)(tile + 1) * sstep);
        f32x16 sA, sB;
#pragma unroll
        for (int i = 0; i < 16; ++i) { sA[i] = 0.f; sB[i] = 0.f; }
#pragma unroll
        for (int s = 0; s < 4; ++s) {
            const int off = qi * 128 + (((2 * s + hf) ^ (qi & 7)) << 4);
            const bf16x8 kA = *(const bf16x8*)(cur + off);
            const bf16x8 kB = *(const bf16x8*)(cur + 4096 + off);
            sA = MFMA32(kA, qf[s], sA);
            sB = MFMA32(kB, qf[s], sB);
        }
        float tmax = sA[0];
#pragma unroll
        for (int i = 1; i < 16; ++i) tmax = fmaxf(tmax, sA[i]);
#pragma unroll
        for (int i = 0; i < 16; ++i) tmax = fmaxf(tmax, sB[i]);
        tmax = max_x32(tmax);
        const float mn = fmaxf(m, tmax);
        const float alpha = exp2f((m - mn) * c);
        m = mn;
        float ps = 0.f;
#pragma unroll
        for (int i = 0; i < 16; ++i) { sA[i] = exp2f((sA[i] - mn) * c); ps += sA[i]; sB[i] = exp2f((sB[i] - mn) * c); ps += sB[i]; }
        l = l * alpha + ps;
#pragma unroll
        for (int i = 0; i < 16; ++i) { o0[i] *= alpha; o1[i] *= alpha; }
#pragma unroll
        for (int kb = 0; kb < 2; ++kb) {
#pragma unroll
            for (int s2 = 0; s2 < 2; ++s2) {
                const bf16x8 pf = pack_step(kb ? sB : sA, s2);
                const int ch = 4 * kb + 2 * s2;
#pragma unroll
                for (int db = 0; db < 2; ++db) {
                    const int dr = db * 32 + qi;
                    const unsigned char* vb = cur + 8192 + dr * 128 + 8 * hf;
                    const s16x4 lo = *(const s16x4*)(vb + ((ch ^ (dr & 7)) << 4));
                    const s16x4 hi = *(const s16x4*)(vb + (((ch + 1) ^ (dr & 7)) << 4));
                    const bf16x8 vf = __builtin_shufflevector(lo, hi, 0, 1, 2, 3, 4, 5, 6, 7);
                    if (db == 0) o0 = MFMA32(vf, pf, o0); else o1 = MFMA32(vf, pf, o1);
                }
            }
        }
        if (more) *(u32x4*)(lds + ((tile + 1) & 1) * 16384 + ldst) = stg;
        __syncthreads();
    }
    l = sum_x32(l);
    const float inv = 1.f / l;
    bf16_t* O;
    {
        const int t2 = get_tid(), lane2 = t2 & 63, wave2 = t2 >> 6;
        const int h2 = kvh * 4 + (wave2 >> 2), q2 = qb * 128 + (wave2 & 3) * 32 + (lane2 & 31);
        O = (bf16_t*)(p.ws + WS_ATT) + ((size_t)b * SEQ + q2) * QD + h2 * HD + 4 * (lane2 >> 5);
    }
#pragma unroll
    for (int g4 = 0; g4 < 4; ++g4) {
        *(u32x2*)(O + 8 * g4)      = u32x2{pk2(o0[4 * g4] * inv, o0[4 * g4 + 1] * inv), pk2(o0[4 * g4 + 2] * inv, o0[4 * g4 + 3] * inv)};
        *(u32x2*)(O + 32 + 8 * g4) = u32x2{pk2(o1[4 * g4] * inv, o1[4 * g4 + 1] * inv), pk2(o1[4 * g4 + 2] * inv, o1[4 * g4 + 3] * inv)};
    }
}

constexpr int HY_USTR = 8208, HY_R = 8 * HY_USTR, HY_RSTR = 16384 + 64;
DI void hy_load_filter(const bf16_t* __restrict__ R, unsigned char* lds, int tid) {
    const int i0 = tid * 8;
    const u32x4 w = *(const u32x4*)(R + i0);
    u32x2 nx = u32x2{0u, 0u};
    if (i0 + 8 < 8192) nx = *(const u32x2*)(R + i0 + 8);
    unsigned char* d = lds + HY_R + i0 * 2;
    *(u32x4*)(d) = w;
    *(u32x4*)(d + HY_RSTR) = u32x4{__builtin_amdgcn_alignbit(w[1], w[0], 16), __builtin_amdgcn_alignbit(w[2], w[1], 16), __builtin_amdgcn_alignbit(w[3], w[2], 16), __builtin_amdgcn_alignbit(nx[0], w[3], 16)};
    *(u32x4*)(d + 2 * HY_RSTR) = u32x4{w[1], w[2], w[3], nx[0]};
    *(u32x4*)(d + 3 * HY_RSTR) = u32x4{__builtin_amdgcn_alignbit(w[2], w[1], 16), __builtin_amdgcn_alignbit(w[3], w[2], 16), __builtin_amdgcn_alignbit(nx[0], w[3], 16), __builtin_amdgcn_alignbit(nx[1], nx[0], 16)};
}
DI void short_conv4(const bf16_t* __restrict__ zrow  , int t4, float w0, float w1, float w2, float bias, float (&out)[4]) {
    const u32x2 v = *(const u32x2*)(zrow + t4);
    const float z0 = bflo(v[0]), z1 = bfhi(v[0]), z2 = bflo(v[1]), z3 = bfhi(v[1]);
    const float zm = (t4 > 0) ? bf2f(zrow[t4 - 1]) : 0.f;
    const float zp = (t4 + 4 < SEQ) ? bf2f(zrow[t4 + 4]) : 0.f;
    out[0] = zm * w0 + z0 * w1 + z1 * w2 + bias;
    out[1] = z0 * w0 + z1 * w1 + z2 * w2 + bias;
    out[2] = z1 * w0 + z2 * w1 + z3 * w2 + bias;
    out[3] = z2 * w0 + z3 * w1 + zp * w2 + bias;
}
DI void hyena_item(const Params& p, int c, unsigned char* lds) {
    const int tid = get_tid(), lane = tid & 63, ig = tid >> 6;
    const bf16_t* ZT = (const bf16_t*)(p.ws + WS_ZT);
    const float* cw = p.in[I_HCW];
    const float* cb = p.in[I_HCB];
    __syncthreads();
    {
        const int b = tid >> 7, tb = (tid & 127) * 32;
        const bf16_t* zrow = ZT + (size_t)c * BT + (size_t)b * SEQ;
        const float w0 = cw[c], w1 = cw[HYC + c], w2 = cw[2 * HYC + c], bias = cb[c];
#pragma unroll
        for (int q = 0; q < 8; ++q) {
            float o[4];
            short_conv4(zrow, tb + 4 * q, w0, w1, w2, bias, o);
            *(u32x2*)(lds + b * HY_USTR + (tb + 4 * q) * 2) = u32x2{pk2(o[0], o[1]), pk2(o[2], o[3])};
        }
    }
    const int r = lane & 31, hf = lane >> 5, Il = r >> 3, bb = r & 7;
#pragma unroll 1
    for (int o = 0; o < 2; ++o) {
        hy_load_filter((const bf16_t*)(p.ws + WS_R) + (size_t)(o * 512 + c) * 8192, lds, tid);
        __syncthreads();
        f32x16 acc0, acc1;
#pragma unroll
        for (int i = 0; i < 16; ++i) { acc0[i] = 0.f; acc1[i] = 0.f; }
#pragma unroll 1
        for (int d = 4 * ig - 63; d <= 4 * ig + 3; ++d) {
            const int J = 4 * ig + Il - d;
            const bool valid = (unsigned)J < 64u;
            const unsigned char* ub = lds + bb * HY_USTR + ((J & 63) * 64 + 8 * hf) * 2;
            const int eb = 4096 - 64 * d + 8 * hf - r;
#pragma unroll
            for (int ks = 0; ks < 4; ++ks) {
                u32x4 braw = *(const u32x4*)(ub + ks * 32);
                if (!valid) braw = u32x4{0u, 0u, 0u, 0u};
                const bf16x8 bf = __builtin_bit_cast(bf16x8, braw);
#pragma unroll
                for (int mm = 0; mm < 2; ++mm) {
                    const int e0 = eb + 16 * ks - 32 * mm;
                    const int sh = e0 & 3;
                    const unsigned char* ap = lds + HY_R + sh * HY_RSTR + (e0 - sh) * 2;
                    const s16x4 lo = *(const s16x4*)(ap);
                    const s16x4 hi = *(const s16x4*)(ap + 8);
                    const bf16x8 af = __builtin_shufflevector(lo, hi, 0, 1, 2, 3, 4, 5, 6, 7);
                    if (mm == 0) acc0 = MFMA32(af, bf, acc0); else acc1 = MFMA32(af, bf, acc1);
                }
            }
        }
        __syncthreads();
        const float skip = p.in[I_HSKIP][o * HYD + c];
        const int gcol = (o == 0 ? 512 : 1024) + c;
        const float w0 = cw[gcol], w1 = cw[HYC + gcol], w2 = cw[2 * HYC + gcol], bias = cb[gcol];
        const bf16_t* zrow = ZT + (size_t)gcol * BT + (size_t)bb * SEQ;
        bf16_t* hyt = (bf16_t*)(p.ws + WS_HYT) + (size_t)c * BT + (size_t)bb * SEQ;
#pragma unroll
        for (int mm = 0; mm < 2; ++mm) {
#pragma unroll
            for (int g4 = 0; g4 < 4; ++g4) {
                const int t4 = (4 * ig + Il) * 64 + 32 * mm + 8 * g4 + 4 * hf;
                float gt[4];
                short_conv4(zrow, t4, w0, w1, w2, bias, gt);
                unsigned char* up = lds + bb * HY_USTR + t4 * 2;
                const u32x2 uv = *(const u32x2*)up;
                const float u0 = bflo(uv[0]), u1 = bfhi(uv[0]), u2 = bflo(uv[1]), u3 = bfhi(uv[1]);
                const f32x16& a = mm ? acc1 : acc0;
                const float y0 = gt[0] * (a[4 * g4] + skip * u0), y1 = gt[1] * (a[4 * g4 + 1] + skip * u1);
                const float y2 = gt[2] * (a[4 * g4 + 2] + skip * u2), y3 = gt[3] * (a[4 * g4 + 3] + skip * u3);
                const u32x2 pk = u32x2{pk2(y0, y1), pk2(y2, y3)};
                if (o == 0) *(u32x2*)up = pk; else *(u32x2*)(hyt + t4) = pk;
            }
        }
        __syncthreads();
    }
}

constexpr int CTL_QUEUE_D = 8192;
DI void phase_d(const Params& p, unsigned char* lds) {
    unsigned* ctr = (unsigned*)(p.ws + WS_CTL) + CTL_QUEUE_D;
    volatile LAS unsigned* slot = (volatile LAS unsigned*)(LAS unsigned char*)(lds + LDS_ST_OFF + 8);
    for (;;) {
        __syncthreads();
        if (get_tid() == 0) slot[0] = atomicAdd(ctr, 1u);
        __syncthreads();
        const int it = (int)slot[0];
        if (it >= 1024) break;
        if (it < 512) hyena_item(p, it, lds); else attn_item(p, it - 512, lds);
    }
}

DI void phase_d2(const Params& p, unsigned char* lds) {
    constexpr int TILES = 8 * (BT / 256);
    constexpr int CONV = 2 * 16384 * 1024 / 8192;
    const bf16_t* HYT = (const bf16_t*)(p.ws + WS_HYT);
    bf16_t* HY = (bf16_t*)(p.ws + WS_HY);
    for (int it = blockIdx.x; it < TILES + CONV; it += gridDim.x) {
        const int tid = get_tid();
        if (it >= TILES) {
            const int ci = it - TILES;
            const float* src = (ci < 2048 ? p.in[I_PU] : p.in[I_PV]) + (size_t)(ci & 2047) * 8192 + tid * 8;
            bf16_t* dst = (bf16_t*)(p.ws + (ci < 2048 ? WS_UT : WS_VTAB)) + (size_t)(ci & 2047) * 8192 + tid * 8;
            const f32x4 a = *(const f32x4*)src, b = *(const f32x4*)(src + 4);
            *(u32x4*)dst = u32x4{pk2(a[0], a[1]), pk2(a[2], a[3]), pk2(b[0], b[1]), pk2(b[2], b[3])};
            continue;
        }
        const int c0 = (it & 7) * 64, tok0 = (it >> 3) * 256;
        __syncthreads();
#pragma unroll
        for (int i = 0; i < 2; ++i) {
            const int idx = tid + i * NT, c = idx >> 5, tg = idx & 31;
            *(u32x4*)(lds + c * 528 + tg * 16) = *(const u32x4*)(HYT + (size_t)(c0 + c) * BT + tok0 + tg * 8);
        }
        __syncthreads();
#pragma unroll
        for (int i = 0; i < 2; ++i) {
            const int idx = tid + i * NT, tok = idx >> 3, cg = idx & 7;
            unsigned w[4];
#pragma unroll
            for (int e = 0; e < 4; ++e) {
                const unsigned lo = *(const unsigned short*)(lds + (cg * 8 + 2 * e) * 528 + tok * 2);
                const unsigned hi = *(const unsigned short*)(lds + (cg * 8 + 2 * e + 1) * 528 + tok * 2);
                w[e] = lo | (hi << 16);
            }
            *(u32x4*)(HY + (size_t)(tok0 + tok) * HYD + c0 + cg * 8) = u32x4{w[0], w[1], w[2], w[3]};
        }
    }
}

DI void phase_e(const Params& p, unsigned char* lds) {
    constexpr int TILES = 4 * (BT / 128);
    for (int it = blockIdx.x; it < TILES; it += gridDim.x) {
        const int tid = get_tid(), lane = tid & 63, wave = tid >> 6, wp = wave >> 2, wq = wave & 3;
        const int tn = it & 3, tm = it >> 2;
        const int n0 = tn * 256, tok0 = tm * 128;
        f32x4 acc1[4][2], acc2[4][2];
#pragma unroll
        for (int i = 0; i < 4; ++i)
#pragma unroll
            for (int j = 0; j < 2; ++j) { acc1[i][j] = f32x4{0.f, 0.f, 0.f, 0.f}; acc2[i][j] = f32x4{0.f, 0.f, 0.f, 0.f}; }
        gemm_mainloop<2>(acc1, RowLoader{(const bf16_t*)(p.ws + WS_WTAO) + (size_t)n0 * QD, QD}, RowLoader{(const bf16_t*)(p.ws + WS_ATT) + (size_t)tok0 * QD, QD}, QD / 64, lds);
        gemm_mainloop<2>(acc2, RowLoader{(const bf16_t*)(p.ws + WS_WTHO) + (size_t)n0 * HYD, HYD}, RowLoader{(const bf16_t*)(p.ws + WS_HY) + (size_t)tok0 * HYD, HYD}, HYD / 64, lds);
        const bf16_t* G = (const bf16_t*)(p.ws + WS_G);
        bf16_t* M = (bf16_t*)(p.ws + WS_H);
        const int l15 = lane & 15, lk = lane >> 4;
#pragma unroll
        for (int i = 0; i < 4; ++i)
#pragma unroll
            for (int j = 0; j < 2; ++j) {
                const int n = n0 + wp * 64 + i * 16 + lk * 4;
                const int tok = tok0 + wq * 32 + j * 16 + l15;
                const u32x2 ga = *(const u32x2*)(G + (size_t)tok * GC + n);
                const u32x2 gh = *(const u32x2*)(G + (size_t)tok * GC + 1024 + n);
                const float m0 = bflo(ga[0]) * acc1[i][j][0] + bflo(gh[0]) * acc2[i][j][0];
                const float m1 = bfhi(ga[0]) * acc1[i][j][1] + bfhi(gh[0]) * acc2[i][j][1];
                const float m2 = bflo(ga[1]) * acc1[i][j][2] + bflo(gh[1]) * acc2[i][j][2];
                const float m3 = bfhi(ga[1]) * acc1[i][j][3] + bfhi(gh[1]) * acc2[i][j][3];
                *(u32x2*)(M + (size_t)tok * DM + n) = u32x2{pk2(m0, m1), pk2(m2, m3)};
            }
    }
}

DI void phase_f(const Params& p, unsigned char* lds) {
    constexpr int TILES = 4 * (BT / 256);
    const float* mod = (const float*)(p.ws + WS_MOD);
    for (int it = blockIdx.x; it < TILES; it += gridDim.x) {
        const int tid = get_tid(), lane = tid & 63, wave = tid >> 6, wp = wave >> 2, wq = wave & 3;
        const int tn = it & 3, tm = it >> 2;
        const int n0 = tn * 256, tok0 = tm * 256, b = tok0 >> 12;
        f32x4 acc[4][4];
#pragma unroll
        for (int i = 0; i < 4; ++i)
#pragma unroll
            for (int j = 0; j < 4; ++j) acc[i][j] = f32x4{0.f, 0.f, 0.f, 0.f};
        gemm_mainloop<4>(acc, RowLoader{(const bf16_t*)(p.ws + WS_WTO) + (size_t)n0 * DM, DM}, RowLoader{(const bf16_t*)(p.ws + WS_H) + (size_t)tok0 * DM, DM}, DM / 64, lds);
        const int l15 = lane & 15, lk = lane >> 4;
#pragma unroll
        for (int i = 0; i < 4; ++i) {
            const int n = n0 + wp * 64 + i * 16 + lk * 4;
            const f32x4 g1 = *(const f32x4*)(mod + b * 6144 + 2048 + n);
#pragma unroll
            for (int j = 0; j < 4; ++j) {
                const int tok = tok0 + wq * 64 + j * 16 + l15;
                const f32x4 xv = *(const f32x4*)(p.in[I_X] + (size_t)tok * DM + n);
                *(f32x4*)(p.out + (size_t)tok * DM + n) = f32x4{xv[0] + g1[0] * acc[i][j][0], xv[1] + g1[1] * acc[i][j][1], xv[2] + g1[2] * acc[i][j][2], xv[3] + g1[3] * acc[i][j][3]};
            }
        }
    }
}

DI void phase_g(const Params& p) {
    const float* mod = (const float*)(p.ws + WS_MOD);
    for (int it = blockIdx.x; it < BT / 16; it += gridDim.x) {
        const int row = it * 16 + (get_tid() >> 6), b = row >> 12;
        norm_mod_row(p.out + (size_t)row * DM, p.in[I_NFFN], mod + b * 6144 + 3072, mod + b * 6144 + 4096, (bf16_t*)(p.ws + WS_H) + (size_t)row * DM);
    }
}

DI void phase_h(const Params& p, unsigned char* lds) {
    constexpr int TILES = 8 * (BT / 256);
    for (int it = blockIdx.x; it < TILES; it += gridDim.x) {
        const int tid = get_tid(), lane = tid & 63, wave = tid >> 6, wp = wave >> 2, wq = wave & 3;
        const int tn = it & 7, tm = it >> 3;
        const int n0 = tn * 256, tok0 = tm * 256;
        f32x4 acc[4][4];
#pragma unroll
        for (int i = 0; i < 4; ++i)
#pragma unroll
            for (int j = 0; j < 4; ++j) acc[i][j] = f32x4{0.f, 0.f, 0.f, 0.f};
        gemm_mainloop<4>(acc, RowLoader{(const bf16_t*)(p.ws + WS_WTQ) + (size_t)n0 * DM, DM}, RowLoader{(const bf16_t*)(p.ws + WS_H) + (size_t)tok0 * DM, DM}, DM / 64, lds);
        bf16_t* QP = (bf16_t*)(p.ws + WS_G);
        const int l15 = lane & 15, lk = lane >> 4;
#pragma unroll
        for (int i = 0; i < 4; ++i)
#pragma unroll
            for (int j = 0; j < 4; ++j) {
                const int n = n0 + wp * 64 + i * 16 + lk * 4;
                const int tok = tok0 + wq * 64 + j * 16 + l15;
                *(u32x2*)(QP + (size_t)tok * 2048 + n) = u32x2{pk2(acc[i][j][0], acc[i][j][1]), pk2(acc[i][j][2], acc[i][j][3])};
            }
    }
}

DI void ins16(float (&L)[16], float v) {
#pragma unroll
    for (int i = 0; i < 16; ++i) { const float hi = fmaxf(L[i], v); v = fminf(L[i], v); L[i] = hi; }
}
DI float pack_idx(float v, unsigned idx, unsigned mask) { return __uint_as_float((__float_as_uint(v) & ~mask) | idx); }
constexpr int PI_LIST = 0;
constexpr int PI_EXP  = 32 * 1024;
constexpr int PI_GATE = 48 * 1024;
DI void peer_item(const Params& p, int item, unsigned char* lds) {
    const int tok0 = item * 32;
    __syncthreads();
    {
        const int tid = get_tid(), lane = tid & 63, hp = tid >> 6;
        const int r = lane & 31, hf = lane >> 5;
        const bf16_t* keys = (const bf16_t*)(p.ws + WS_KEYS) + (size_t)((hp & 1) * 8 + (hp >> 1)) * 128 * 128 + 8 * hf;
        const bf16_t* qp = (const bf16_t*)(p.ws + WS_G) + (size_t)(tok0 + r) * 2048 + hp * 128 + 8 * hf;
        f32x16 acc[4];
#pragma unroll
        for (int m = 0; m < 4; ++m)
#pragma unroll
            for (int i = 0; i < 16; ++i) acc[m][i] = 0.f;
#pragma unroll
        for (int ks = 0; ks < 8; ++ks) {
            const bf16x8 bq = *(const bf16x8*)(qp + 16 * ks);
#pragma unroll
            for (int m = 0; m < 4; ++m) {
                const bf16x8 ak = *(const bf16x8*)(keys + (size_t)(m * 32 + r) * 128 + 16 * ks);
                acc[m] = MFMA32(ak, bq, acc[m]);
            }
        }
        float L[16];
#pragma unroll
        for (int i = 0; i < 16; ++i) L[i] = -3.0e38f;
#pragma unroll
        for (int m = 0; m < 4; ++m)
#pragma unroll
            for (int i = 0; i < 16; ++i) {
                const unsigned n = m * 32 + (i & 3) + 8 * (i >> 2) + 4 * hf;
                ins16(L, pack_idx(acc[m][i], n, 127u));
            }
        float P[16];
#pragma unroll
        for (int i = 0; i < 16; ++i) {
            auto sw = __builtin_amdgcn_permlane32_swap(__float_as_uint(L[i]), __float_as_uint(L[i]), false, false);
            P[i] = hf ? __uint_as_float(sw[0]) : __uint_as_float(sw[1]);
        }
#pragma unroll
        for (int i = 0; i < 16; ++i) ins16(L, P[i]);
        if (hf == 0) {
            float* dst = (float*)(lds + PI_LIST) + (r * 16 + hp) * 16;
#pragma unroll
            for (int i = 0; i < 16; i += 4) *(f32x4*)(dst + i) = f32x4{L[i], L[i + 1], L[i + 2], L[i + 3]};
        }
    }
    __syncthreads();
    {
        const int tid = get_tid();
        if (tid < 256) {
            const int tok = tid >> 3, h = tid & 7;
            const float* l1 = (const float*)(lds + PI_LIST) + (tok * 16 + 2 * h) * 16;
            const float* l2 = l1 + 16;
            float v1[16], v2[16];
#pragma unroll
            for (int i = 0; i < 16; i += 4) {
                const f32x4 a = *(const f32x4*)(l1 + i), b = *(const f32x4*)(l2 + i);
                v1[i] = a[0]; v1[i + 1] = a[1]; v1[i + 2] = a[2]; v1[i + 3] = a[3];
                v2[i] = b[0]; v2[i + 1] = b[1]; v2[i + 2] = b[2]; v2[i + 3] = b[3];
            }
            float B[16];
#pragma unroll
            for (int i = 0; i < 16; ++i) B[i] = -3.0e38f;
#pragma unroll
            for (int i = 0; i < 16; ++i)
#pragma unroll
                for (int j = 0; j < 16; ++j)
                    if ((i + 1) * (j + 1) <= 16) ins16(B, pack_idx(v1[i] + v2[j], (unsigned)(i * 16 + j), 255u));
            float e[16], sum = 0.f;
#pragma unroll
            for (int k = 0; k < 16; ++k) { e[k] = __expf(B[k] - B[0]); sum += e[k]; }
            const float inv = 1.f / sum;
            int* ex = (int*)(lds + PI_EXP) + tok * 128 + h * 16;
            float* gt = (float*)(lds + PI_GATE) + tok * 128 + h * 16;
#pragma unroll
            for (int k = 0; k < 16; ++k) {
                const unsigned ij = __float_as_uint(B[k]) & 255u;
                const unsigned i1 = __float_as_uint(l1[ij >> 4]) & 127u, i2 = __float_as_uint(l2[ij & 15u]) & 127u;
                ex[k] = (int)(i1 * 128u + i2);
                gt[k] = e[k] * inv;
            }
        }
    }
    __syncthreads();
    {
        const int tid = get_tid(), lane = tid & 63, wave = tid >> 6;
        const bf16_t* UT = (const bf16_t*)(p.ws + WS_UT) + lane * 16;
        const bf16_t* VT = (const bf16_t*)(p.ws + WS_VTAB) + lane * 16;
        const float* mod = (const float*)(p.ws + WS_MOD);
#pragma unroll 1
        for (int tt = 0; tt < 2; ++tt) {
            const int tl = wave * 2 + tt, tok = tok0 + tl, b = tok >> 12;
            const int* ex = (const int*)(lds + PI_EXP) + tl * 128;
            const float* gt = (const float*)(lds + PI_GATE) + tl * 128;
            float x[16];
            {
                const bf16_t* hr = (const bf16_t*)(p.ws + WS_H) + (size_t)tok * DM + lane * 16;
                const u32x4 a = *(const u32x4*)hr, c = *(const u32x4*)(hr + 8);
#pragma unroll
                for (int i = 0; i < 4; ++i) { x[2 * i] = bflo(a[i]); x[2 * i + 1] = bfhi(a[i]); x[8 + 2 * i] = bflo(c[i]); x[9 + 2 * i] = bfhi(c[i]); }
            }
            float out[16];
#pragma unroll
            for (int i = 0; i < 16; ++i) out[i] = 0.f;
#pragma unroll 1
            for (int k0 = 0; k0 < 128; k0 += 4) {
                u32x4 ua[4], ub[4];
                int e[4];
#pragma unroll
                for (int q = 0; q < 4; ++q) {
                    e[q] = __builtin_amdgcn_readfirstlane(ex[k0 + q]);
                    const bf16_t* ur = UT + (size_t)e[q] * DM;
                    ua[q] = *(const u32x4*)ur; ub[q] = *(const u32x4*)(ur + 8);
                }
                float w[4];
#pragma unroll
                for (int q = 0; q < 4; ++q) {
                    float d = 0.f;
#pragma unroll
                    for (int i = 0; i < 4; ++i) {
                        d += bflo(ua[q][i]) * x[2 * i] + bfhi(ua[q][i]) * x[2 * i + 1];
                        d += bflo(ub[q][i]) * x[8 + 2 * i] + bfhi(ub[q][i]) * x[9 + 2 * i];
                    }
                    const float a = wave_sum(d);
                    const float y = 0.7978845608028654f * (a + 0.044715f * a * a * a);
                    const float th = 1.f - 2.f / (__expf(2.f * y) + 1.f);
                    w[q] = 0.5f * a * (1.f + th) * gt[k0 + q];
                }
#pragma unroll
                for (int q = 0; q < 4; ++q) {
                    const bf16_t* vr = VT + (size_t)e[q] * DM;
                    ua[q] = *(const u32x4*)vr; ub[q] = *(const u32x4*)(vr + 8);
                }
#pragma unroll
                for (int q = 0; q < 4; ++q) {
#pragma unroll
                    for (int i = 0; i < 4; ++i) {
                        out[2 * i] += w[q] * bflo(ua[q][i]); out[2 * i + 1] += w[q] * bfhi(ua[q][i]);
                        out[8 + 2 * i] += w[q] * bflo(ub[q][i]); out[9 + 2 * i] += w[q] * bfhi(ub[q][i]);
                    }
                }
            }
            const float* x1 = p.out + (size_t)tok * DM + lane * 16;
            const float* g2 = mod + b * 6144 + 5120 + lane * 16;
            float x2[16], ss = 0.f;
#pragma unroll
            for (int i = 0; i < 16; i += 4) {
                const f32x4 xv = *(const f32x4*)(x1 + i), gv = *(const f32x4*)(g2 + i);
#pragma unroll
                for (int j = 0; j < 4; ++j) { x2[i + j] = xv[j] + gv[j] * out[i + j]; ss += x2[i + j] * x2[i + j]; }
            }
            ss = wave_sum(ss);
            const float rs = rsqrtf(ss * (1.f / DM) + EPS);
            const float* fg = p.in[I_FNG] + lane * 16;
            float* dst = p.out + (size_t)tok * DM + lane * 16;
#pragma unroll
            for (int i = 0; i < 16; i += 4) {
                const f32x4 gv = *(const f32x4*)(fg + i);
                *(f32x4*)(dst + i) = f32x4{x2[i] * rs * gv[0], x2[i + 1] * rs * gv[1], x2[i + 2] * rs * gv[2], x2[i + 3] * rs * gv[3]};
            }
        }
    }
}
DI void phase_i(const Params& p, unsigned char* lds) {
    const bool bad = xb_ld((unsigned*)(p.ws + WS_CTL) + CTL_BADTID) != 0u || xb_ld((unsigned*)(p.ws + WS_CTL) + XB_TMO) != 0u;
    for (int it = blockIdx.x; it < BT / 32; it += gridDim.x) {
        peer_item(p, it, lds);
        if (bad) { const int tid = get_tid(); for (int i = tid; i < 32 * DM; i += NT) p.out[(size_t)it * 32 * DM + i] = __builtin_nanf(""); }
    }
}

DI void phase_final_tmp(const Params& p) {
    const int tid_ = get_tid(); const int wave = tid_ >> 6, lane = tid_ & 63;
    const bool bad = xb_ld((unsigned*)(p.ws + WS_CTL) + CTL_BADTID) != 0u || xb_ld((unsigned*)(p.ws + WS_CTL) + XB_TMO) != 0u;
    for (int it = blockIdx.x; it < BT / 16; it += gridDim.x) {
        const int row = it * 16 + wave;
        const float* src = p.in[I_X] + (size_t)row * DM;
        f32x4 v[4]; float ss = 0.f;
#pragma unroll
        for (int j = 0; j < 4; ++j) { v[j] = *(const f32x4*)(src + j * 256 + lane * 4); ss += v[j][0] * v[j][0] + v[j][1] * v[j][1] + v[j][2] * v[j][2] + v[j][3] * v[j][3]; }
        ss = wave_sum(ss);
        const float rs = rsqrtf(ss * (1.f / DM) + EPS);
#pragma unroll
        for (int j = 0; j < 4; ++j) {
            const int c = j * 256 + lane * 4;
            const f32x4 gg = *(const f32x4*)(p.in[I_FNG] + c);
            f32x4 ov = f32x4{v[j][0] * rs * gg[0], v[j][1] * rs * gg[1], v[j][2] * rs * gg[2], v[j][3] * rs * gg[3]};
            if (bad) ov = f32x4{__builtin_nanf(""), __builtin_nanf(""), __builtin_nanf(""), __builtin_nanf("")};
            *(f32x4*)(p.out + (size_t)row * DM + c) = ov;
        }
    }
}

__global__ void __launch_bounds__(NT) mega(Params p) {
    unsigned char* lds = g_lds;
    volatile LAS unsigned* st = (volatile LAS unsigned*)(LAS unsigned char*)(lds + LDS_ST_OFF);
    {
        const unsigned hw = __builtin_amdgcn_s_getreg((5 << 11) | 4);
        if ((threadIdx.x & 63) == 0) g_lds[LDS_WTAB_OFF + hw] = (unsigned char)(threadIdx.x >> 6);
        if (threadIdx.x < 2) st[threadIdx.x] = 0u;
        __syncthreads();
        if (get_tid() != (int)threadIdx.x) ((unsigned*)(p.ws + WS_CTL))[CTL_BADTID] = 1u;
    }
    XcdBarrier bar = xcd_barrier_post((unsigned*)(p.ws + WS_CTL), st);
    float* sm = (float*)lds;

    phase_a(p, sm);
    xcd_barrier(bar);
    phase_b(p, sm);
    xcd_barrier(bar);
    phase_c(p, lds);
    xcd_barrier(bar);
    phase_d(p, lds);
    xcd_barrier(bar);
    phase_d2(p, lds);
    xcd_barrier(bar);
    phase_e(p, lds);
    xcd_barrier(bar);
    phase_f(p, lds);
    xcd_barrier(bar);
    phase_g(p);
    xcd_barrier(bar);
    phase_h(p, lds);
    xcd_barrier(bar);
    phase_i(p, lds);
}

extern "C" void kernel_launch(void* const* d_in, const int* in_sizes, int n_in, void* d_out, int out_size, void* d_ws, size_t ws_size, hipStream_t stream) {
    static int grid = 0;
    if (grid == 0) {
        int dev = 0, cus = 0;
        if (hipGetDevice(&dev) != hipSuccess || hipDeviceGetAttribute(&cus, hipDeviceAttributeMultiprocessorCount, dev) != hipSuccess) { fprintf(stderr, "kernel_launch: device query failed\n"); grid = -1; return; }
        if (n_in != N_IN || ws_size < WS_END) { fprintf(stderr, "kernel_launch: unexpected n_in %d or ws_size %zu (< %zu)\n", n_in, ws_size, (size_t)WS_END); grid = -1; return; }
        grid = cus;
    }
    if (grid < 0) return;
    (void)hipMemsetAsync((char*)d_ws + WS_CTL, 0, 64 * 1024, stream);
    Params p{};
    for (int i = 0; i < N_IN; ++i) p.in[i] = (const float*)d_in[i];
    p.out = (float*)d_out; p.ws = (unsigned char*)d_ws;
    hipLaunchKernelGGL(mega, dim3(grid), dim3(NT), 0, stream, p);
}
```

```cpp
#include <hip/hip_runtime.h>
#include <stdint.h>
#include <cstdio>

#define DI __device__ __forceinline__
#define LAS __attribute__((address_space(3)))
typedef unsigned short bf16_t;
typedef short bf16x8 __attribute__((ext_vector_type(8)));
typedef short s16x4 __attribute__((ext_vector_type(4)));
typedef float f32x4 __attribute__((ext_vector_type(4)));
typedef float f32x16 __attribute__((ext_vector_type(16)));
typedef unsigned u32x4 __attribute__((ext_vector_type(4)));
typedef unsigned u32x2 __attribute__((ext_vector_type(2)));

#ifndef PROBE_PHASE
#define PROBE_PHASE (-1)
#endif
#ifndef PROBE_SCALE
#define PROBE_SCALE 100.f
#endif
constexpr int BATCH = 8, SEQ = 4096, DM = 1024, BT = BATCH * SEQ;
constexpr int CTX = 256, TK = SEQ + CTX;
constexpr int NH = 8, NKV = 2, HD = 64;
constexpr int QD = 512, KVD = 128, HYD = 512, HYC = 1536, GC = 2048, INC = 4352;
constexpr int PH = 8, PNK = 128, PDK = 256, PTOP = 16;
constexpr float EPS = 1e-6f;
constexpr int NT = 1024;

enum { I_X = 0, I_C, I_CTX, I_CCTX, I_ADAW, I_ADAB, I_NMIX, I_NFFN, I_WIN, I_QNG, I_KNG, I_HCW, I_HCB,
       I_HW1, I_HB1, I_HW2, I_HB2, I_HW3, I_HB3, I_HW4, I_HFREQ, I_HSKIP, I_WAO, I_WHO, I_WO, I_PWQ, I_PK1, I_PK2, I_PU, I_PV, I_FNG, N_IN };

constexpr size_t MB = 1024 * 1024;
constexpr size_t WS_CTL   = 0;
constexpr size_t WS_MOD   = 64 * 1024;
constexpr size_t WS_ROPE  = WS_MOD + 9 * 6144 * 4;
constexpr size_t WS_PART  = 512 * 1024;
constexpr size_t WS_WTIN  = 3 * MB;
constexpr size_t WS_WTAO  = WS_WTIN + (size_t)INC * DM * 2;
constexpr size_t WS_WTHO  = WS_WTAO + (size_t)DM * QD * 2;
constexpr size_t WS_WTO   = WS_WTHO + (size_t)DM * HYD * 2;
constexpr size_t WS_WTQ   = WS_WTO + (size_t)DM * DM * 2;
constexpr size_t WS_KEYS  = WS_WTQ + (size_t)2048 * DM * 2;
constexpr size_t WS_R     = WS_KEYS + (size_t)2 * 8 * 128 * 128 * 2;
constexpr size_t WS_KB    = WS_R + (size_t)2 * 512 * 8192 * 2;
constexpr size_t WS_VT    = WS_KB + (size_t)BATCH * NKV * TK * HD * 2;
constexpr size_t WS_HC    = WS_VT + (size_t)BATCH * NKV * TK * HD * 2;
constexpr size_t WS_H     = 60 * MB;
constexpr size_t WS_G     = WS_H + 64 * MB;
constexpr size_t WS_ZT    = WS_G + 128 * MB;
constexpr size_t WS_Q     = WS_ZT + 96 * MB;
constexpr size_t WS_ATT   = WS_Q + 32 * MB;
constexpr size_t WS_HYT   = WS_ATT + 32 * MB;
constexpr size_t WS_END   = WS_HYT + 32 * MB;
static_assert(WS_HC + (size_t)2048 * DM * 2 <= WS_H, "ws overlap");
constexpr size_t WS_FRAW  = WS_ATT;
constexpr size_t WS_HY    = WS_Q;
constexpr size_t WS_UT    = WS_ZT;
constexpr size_t WS_VTAB  = WS_ZT + 32 * MB;
constexpr size_t WS_EXPI  = WS_ATT;
constexpr size_t WS_GATE  = WS_ATT + 16 * MB;
constexpr size_t WS_PAIRS = WS_HYT;
constexpr size_t WS_SSQ   = WS_Q;
constexpr float USCALE = 256.f, VSCALE = 64.f;

constexpr int CTL_BADTID = 8000;
DI unsigned f2bf(float f) { unsigned u = __builtin_bit_cast(unsigned, f); return (u + 0x7fffu + ((u >> 16) & 1u)) >> 16; }
DI unsigned pk2(float lo, float hi) { return f2bf(lo) | (f2bf(hi) << 16); }
DI float bf2f(unsigned short b) { return __builtin_bit_cast(float, (unsigned)b << 16); }
DI float bflo(unsigned u) { return __builtin_bit_cast(float, u << 16); }
DI float bfhi(unsigned u) { return __builtin_bit_cast(float, u & 0xffff0000u); }
DI float red2pi(float x) { const float k = rintf(x * 0.15915494309189535f); float r = fmaf(-k, 6.2831854820251465f, x); return fmaf(-k, -1.7484555e-7f, r); }
DI float fsin(float x) { return __sinf(red2pi(x)); }
DI float fcos(float x) { return __cosf(red2pi(x)); }
constexpr int LDS_BYTES = 160 * 1024;
constexpr int LDS_ST_OFF = LDS_BYTES - 16;
constexpr int LDS_PROBE_OFF = LDS_BYTES - 16 - 32;
constexpr int LDS_WTAB_OFF = LDS_BYTES - 16 - 32 - 64;
constexpr int LDS_USER = LDS_WTAB_OFF;
__shared__ __attribute__((aligned(16))) unsigned char g_lds[LDS_BYTES];
DI int get_tid() {
    const unsigned hw = __builtin_amdgcn_s_getreg((5 << 11) | 4);
    unsigned w = g_lds[LDS_WTAB_OFF + hw];
    w = __builtin_amdgcn_readfirstlane(w);
    int t;
    asm volatile("v_mbcnt_lo_u32_b32 %0, -1, 0\n\tv_mbcnt_hi_u32_b32 %0, -1, %0\n\tv_lshl_or_b32 %0, %1, 6, %0" : "=&v"(t) : "s"(w));
    return t;
}
template<int CTRL> DI float dppf(float v) { return __uint_as_float(__builtin_amdgcn_update_dpp(0u, __float_as_uint(v), CTRL, 0xF, 0xF, true)); }
DI float sum16(float v) { v += dppf<0xB1>(v); v += dppf<0x4E>(v); v += dppf<0x141>(v); v += dppf<0x140>(v); return v; }
DI float sum_x16(float v) { auto r = __builtin_amdgcn_permlane16_swap(__float_as_uint(v), __float_as_uint(v), false, false); return __uint_as_float(r[0]) + __uint_as_float(r[1]); }
DI float sum_x32(float v) { auto r = __builtin_amdgcn_permlane32_swap(__float_as_uint(v), __float_as_uint(v), false, false); return __uint_as_float(r[0]) + __uint_as_float(r[1]); }
DI float max_x32(float v) { auto r = __builtin_amdgcn_permlane32_swap(__float_as_uint(v), __float_as_uint(v), false, false); return fmaxf(__uint_as_float(r[0]), __uint_as_float(r[1])); }
DI float wave_sum(float v) { return sum_x32(sum_x16(sum16(v))); }

#define XB_TMO      128
#define XB_XCNT(j)  (256  + 64 * (j))
#define XB_XSUB(j)  (1280 + 64 * (j))
#define XB_XGEN(j)  (2304 + 64 * (j))
#define XB_TOP      3328
#define XB_TOPGEN   3392
#define XCD_BAR_WORDS 3456
#define XB_SPIN_CAP (1u << 27)
DI unsigned xb_ld(unsigned* p)              { return __hip_atomic_load(p, __ATOMIC_RELAXED, __HIP_MEMORY_SCOPE_AGENT); }
DI unsigned xb_add(unsigned* p, unsigned v) { return __hip_atomic_fetch_add(p, v, __ATOMIC_RELAXED, __HIP_MEMORY_SCOPE_AGENT); }
DI unsigned xb_xcc_id() { return (unsigned)__builtin_amdgcn_s_getreg((3 << 11) | 20) & 0xFu; }
#define XB_SPIN(cond, bar) do { unsigned _sp = 0; while (cond) { __builtin_amdgcn_s_sleep(1); \
    if ((++_sp & 255u) == 0u) { if (xb_ld(&(bar)[XB_TMO])) break; if (_sp > XB_SPIN_CAP) { atomicAdd(&(bar)[XB_TMO], 1u); break; } } } } while (0)
struct XcdBarrier { unsigned* bar; unsigned x; volatile LAS unsigned* st; };
DI XcdBarrier xcd_barrier_post(unsigned* bar, volatile LAS unsigned* st) {
    XcdBarrier b; b.bar = bar; b.x = xb_xcc_id(); b.st = st;
    if (get_tid() == 0) (void)xb_add(&bar[XB_XCNT(b.x)], 1u);
    return b;
}
DI void xcd_barrier_complete(unsigned* bar, unsigned x, unsigned& nloc, unsigned& nx) {
    const unsigned G = gridDim.x * gridDim.y * gridDim.z;
    unsigned sum, cnt, mine, sp = 0u;
    for (;;) {
        sum = 0u; cnt = 0u; mine = 0u;
#pragma unroll
        for (unsigned j = 0; j < 16; ++j) { const unsigned c = xb_ld(&bar[XB_XCNT(j)]); sum += c; cnt += (c > 0u) ? 1u : 0u; mine = (j == x) ? c : mine; }
        if (sum == G) break;
        __builtin_amdgcn_s_sleep(1);
        if ((++sp & 255u) == 0u) { if (xb_ld(&bar[XB_TMO])) break; if (sp > XB_SPIN_CAP) { atomicAdd(&bar[XB_TMO], 1u); break; } }
    }
    nloc = mine > 0u ? mine : 1u; nx = cnt > 0u ? cnt : 1u;
}
DI void xcd_barrier(const XcdBarrier& b) {
    asm volatile("s_waitcnt vmcnt(0)" ::: "memory");
    __syncthreads();
    if (get_tid() == 0) {
        unsigned* bar = b.bar;
        __builtin_amdgcn_s_waitcnt(0);
        unsigned nloc = b.st[0], nx = b.st[1];
        if (nloc == 0u) { xcd_barrier_complete(bar, b.x, nloc, nx); b.st[0] = nloc; b.st[1] = nx; }
        const unsigned old = xb_add(&bar[XB_XSUB(b.x)], 1u);
        const unsigned gen = old / nloc;
        if (old + 1u == (gen + 1u) * nloc) {
            __builtin_amdgcn_fence(__ATOMIC_RELEASE, "agent");
            asm volatile("s_waitcnt vmcnt(0)" ::: "memory");
            const unsigned og = xb_add(&bar[XB_TOP], 1u);
            const unsigned tg = og / nx;
            if (og + 1u == (tg + 1u) * nx) xb_add(&bar[XB_TOPGEN], 1u);
            else XB_SPIN(xb_ld(&bar[XB_TOPGEN]) == tg, bar);
            __builtin_amdgcn_fence(__ATOMIC_ACQUIRE, "agent");
            xb_add(&bar[XB_XGEN(b.x)], 1u);
            asm volatile("s_waitcnt vmcnt(0)" ::: "memory");
        } else {
            XB_SPIN(xb_ld(&bar[XB_XGEN(b.x)]) == gen, bar);
            __builtin_amdgcn_fence(__ATOMIC_ACQUIRE, "agent");
            asm volatile("s_waitcnt vmcnt(0)" ::: "memory");
        }
    }
    __syncthreads();
}

struct Params { const float* in[N_IN]; float* out; unsigned char* ws; };


DI void transpose_tile(const float* __restrict__ W, int K, int N, bf16_t* __restrict__ Wt, int tile, float* sm) {
    const int tid = get_tid();
    const int ntn = N / 64, tk = tile / ntn, tn = tile % ntn;
#pragma unroll
    for (int i = 0; i < 4; ++i) {
        const int idx = tid + i * NT, kk = idx >> 6, nn = idx & 63;
        sm[kk * 65 + nn] = W[(size_t)(tk * 64 + kk) * N + tn * 64 + nn];
    }
    __syncthreads();
#pragma unroll
    for (int i = 0; i < 2; ++i) {
        const int idx = tid + i * NT, nn = idx >> 5, kp = (idx & 31) * 2;
        const unsigned v = pk2(sm[kp * 65 + nn], sm[(kp + 1) * 65 + nn]);
        *(unsigned*)(Wt + (size_t)(tn * 64 + nn) * K + tk * 64 + kp) = v;
    }
    __syncthreads();
}

DI void mod_item(const Params& p, int item, float* sm) {
    const int tid = get_tid();
    float* sc = sm;
    float* red = sm + 9 * 1024;
    for (int i = tid; i < 9 * 1024; i += NT) {
        const float v = (i < 8 * 1024) ? p.in[I_C][i] : p.in[I_CCTX][i - 8 * 1024];
        sc[i] = v / (1.f + __expf(-v));
    }
    __syncthreads();
    const int col = tid & 63, kg = tid >> 6, n0 = item * 64;
    float acc[9];
#pragma unroll
    for (int r = 0; r < 9; ++r) acc[r] = 0.f;
    const float* w = p.in[I_ADAW] + n0 + col;
#pragma unroll 8
    for (int k = kg * 64; k < kg * 64 + 64; ++k) {
        const float wv = w[(size_t)k * 6144];
#pragma unroll
        for (int r = 0; r < 9; ++r) acc[r] += sc[r * 1024 + k] * wv;
    }
#pragma unroll
    for (int r = 0; r < 9; ++r) red[(kg * 9 + r) * 64 + col] = acc[r];
    __syncthreads();
    if (tid < 9 * 64) {
        const int r = tid >> 6, c2 = tid & 63;
        float s = p.in[I_ADAB][n0 + c2];
#pragma unroll
        for (int g = 0; g < 16; ++g) s += red[(g * 9 + r) * 64 + c2];
        ((float*)(p.ws + WS_MOD))[r * 6144 + n0 + c2] = s;
    }
    __syncthreads();
}

DI void filter_item(const Params& p, int item, float* sm) {
    const int tid = get_tid();
    float* z  = sm;
    float* ha = sm + 16 * 36;
    float* hb = ha + 16 * 64;
    const int t0 = item * 16;
    if (tid < 16 * 33) {
        const int pp = tid / 33, i = tid % 33;
        const int t = t0 + pp;
        float v;
        if (i == 0) v = (float)t / (float)(SEQ - 1);
        else {
            const int fi = (i - 1) & 15;
            const float f = 1e-4f + (float)fi * ((15.f - 1e-4f) / 15.f);
            const float w = 6.283185307179586f * (float)t / (float)SEQ;
            const float a = f * w;
            v = (i <= 16) ? fcos(a) : -fsin(a);
        }
        z[pp * 36 + i] = v;
    }
    __syncthreads();
    const int pp = tid >> 6, j = tid & 63;
    const float fr = p.in[I_HFREQ][j];
    {
        float a = p.in[I_HB1][j];
        const float* w1 = p.in[I_HW1];
#pragma unroll 11
        for (int i = 0; i < 33; ++i) a += z[pp * 36 + i] * w1[i * 64 + j];
        ha[pp * 64 + j] = fsin(fr * a);
    }
    __syncthreads();
    {
        float a = p.in[I_HB2][j];
        const float* w2 = p.in[I_HW2];
#pragma unroll 8
        for (int i = 0; i < 64; ++i) a += ha[pp * 64 + i] * w2[i * 64 + j];
        hb[pp * 64 + j] = fsin(fr * a);
    }
    __syncthreads();
    {
        float a = p.in[I_HB3][j];
        const float* w3 = p.in[I_HW3];
#pragma unroll 8
        for (int i = 0; i < 64; ++i) a += hb[pp * 64 + i] * w3[i * 64 + j];
        __syncthreads();
        ha[pp * 64 + j] = fsin(fr * a);
    }
    __syncthreads();
    float* fraw = (float*)(p.ws + WS_FRAW);
    float* part = (float*)(p.ws + WS_PART);
    const float* w4 = p.in[I_HW4];
#pragma unroll 1
    for (int cc = 0; cc < 2; ++cc) {
        const int col = tid + cc * NT;
        float acc[16];
#pragma unroll
        for (int q = 0; q < 16; ++q) acc[q] = 0.f;
#pragma unroll 4
        for (int i = 0; i < 64; ++i) {
            const float wv = w4[i * 2048 + col];
#pragma unroll
            for (int q = 0; q < 16; ++q) acc[q] += ha[q * 64 + i] * wv;
        }
        const int c = col & 511, dir = (col >> 9) & 1;
        const float mind = -3.0701134573253945f, maxd = -15.350567286626973f;
        const float delta = fabsf(mind + (float)c * ((maxd - mind) / 511.f));
        float s = 0.f;
#pragma unroll
        for (int q = 0; q < 16; ++q) {
            const int t = t0 + q;
            const float t01 = (float)t / (float)(SEQ - 1);
            const float v = acc[q] * expf(-t01 * delta);
            acc[q] = v;
            if (!(dir == 1 && t == 0)) s += fabsf(v);
        }
        float* dst = fraw + (size_t)col * SEQ + t0;
#pragma unroll
        for (int q = 0; q < 16; q += 4) *(f32x4*)(dst + q) = f32x4{acc[q], acc[q + 1], acc[q + 2], acc[q + 3]};
        part[item * 2048 + col] = s;
    }
    __syncthreads();
}

DI void phase_a(const Params& p, float* sm) {
    constexpr int T_WIN = 16 * 68, T_AO = 8 * 16, T_HO = 8 * 16, T_WO = 16 * 16, T_WQ = 16 * 32;
    constexpr int E0 = T_WIN, E1 = E0 + T_AO, E2 = E1 + T_HO, E3 = E2 + T_WO, E4 = E3 + T_WQ;
    constexpr int E5 = E4 + 64;
    constexpr int E6 = E5 + 96;
    constexpr int E7 = E6 + 1;
    constexpr int E8 = E7 + 256;
    for (int it = blockIdx.x; it < E8; it += gridDim.x) {
        int item = it;
        if (item < 256) { filter_item(p, item, sm); continue; }
        item -= 256;
        if (item < 96) { mod_item(p, item, sm); continue; }
        item -= 96;
        if (item < 1) {
            const int tid = get_tid();
            float* rope = (float*)(p.ws + WS_ROPE);
            const int pos = tid >> 4, f = tid & 15;
            const float inv = powf(10000.f, -(float)(2 * f) / 32.f);
            const float ang = (float)pos * inv;
            rope[tid] = fcos(ang); rope[1024 + tid] = fsin(ang);
            continue;
        }
        item -= 1;
        if (item < 64) {
            const int tid = get_tid();
            const float* src = (item < 32) ? p.in[I_PK1] : p.in[I_PK2];
            bf16_t* dst = (bf16_t*)(p.ws + WS_KEYS) + (size_t)item * 4096;
            const f32x4 v = *(const f32x4*)(src + (size_t)(item & 31) * 4096 + tid * 4);
            *(u32x2*)(dst + tid * 4) = u32x2{pk2(v[0], v[1]), pk2(v[2], v[3])};
            continue;
        }
        item -= 64;
        if (item < T_WIN) { transpose_tile(p.in[I_WIN], DM, INC, (bf16_t*)(p.ws + WS_WTIN), item, sm); continue; }
        item -= T_WIN;
        if (item < T_AO) { transpose_tile(p.in[I_WAO], QD, DM, (bf16_t*)(p.ws + WS_WTAO), item, sm); continue; }
        item -= T_AO;
        if (item < T_HO) { transpose_tile(p.in[I_WHO], HYD, DM, (bf16_t*)(p.ws + WS_WTHO), item, sm); continue; }
        item -= T_HO;
        if (item < T_WO) { transpose_tile(p.in[I_WO], DM, DM, (bf16_t*)(p.ws + WS_WTO), item, sm); continue; }
        item -= T_WO;
        transpose_tile(p.in[I_PWQ], DM, 2048, (bf16_t*)(p.ws + WS_WTQ), item, sm);
    }
    (void)E1; (void)E2; (void)E3; (void)E4; (void)E5; (void)E6; (void)E7;
}

DI void norm_mod_row(const float* __restrict__ src, const float* __restrict__ g, const float* __restrict__ shift, const float* __restrict__ scale, bf16_t* __restrict__ dst) {
    const int lane = get_tid() & 63;
    f32x4 v[4];
    float ss = 0.f;
#pragma unroll
    for (int j = 0; j < 4; ++j) { v[j] = *(const f32x4*)(src + j * 256 + lane * 4); ss += v[j][0] * v[j][0] + v[j][1] * v[j][1] + v[j][2] * v[j][2] + v[j][3] * v[j][3]; }
    ss = wave_sum(ss);
    const float rs = rsqrtf(ss * (1.f / DM) + EPS);
#pragma unroll
    for (int j = 0; j < 4; ++j) {
        const int c = j * 256 + lane * 4;
        const f32x4 gg = *(const f32x4*)(g + c), sh = *(const f32x4*)(shift + c), sc = *(const f32x4*)(scale + c);
        float o[4];
#pragma unroll
        for (int e = 0; e < 4; ++e) o[e] = v[j][e] * rs * gg[e] * (1.f + sc[e]) + sh[e];
        *(u32x2*)(dst + c) = u32x2{pk2(o[0], o[1]), pk2(o[2], o[3])};
    }
}

DI void filter_norm_item(const Params& p, int item, float* sm) {
    const int tid = get_tid();
    const int o = item >> 9, c = item & 511;
    const int colf = o * 1024 + c, colb = colf + 512;
    const float* part = (const float*)(p.ws + WS_PART);
    float s = 0.f;
    if (tid < 512) s = part[(tid & 255) * 2048 + ((tid < 256) ? colf : colb)];
    s = wave_sum(s);
    if ((tid & 63) == 0) sm[tid >> 6] = s;
    __syncthreads();
    float tot = EPS;
#pragma unroll
    for (int i = 0; i < 8; ++i) tot += sm[i];
    const float inv = 1.f / tot;
    const float* fraw = (const float*)(p.ws + WS_FRAW);
    bf16_t* R = (bf16_t*)(p.ws + WS_R) + (size_t)item * 8192;
#pragma unroll
    for (int i = 0; i < 4; ++i) {
        const int n = (tid + i * NT) * 2;
        float v0, v1;
        if (n < 4096) { v0 = (n == 0) ? 0.f : fraw[(size_t)colf * SEQ + 4096 - n]; v1 = fraw[(size_t)colf * SEQ + 4095 - n]; }
        else if (n == 4096) { v0 = fraw[(size_t)colf * SEQ]; v1 = fraw[(size_t)colb * SEQ + 1]; }
        else { v0 = fraw[(size_t)colb * SEQ + n - 4096]; v1 = fraw[(size_t)colb * SEQ + n - 4095]; }
        *(unsigned*)(R + n) = pk2(v0 * inv, v1 * inv);
    }
    __syncthreads();
}

DI void phase_b(const Params& p, float* sm) {
    const int wave = get_tid() >> 6;
    const float* mod = (const float*)(p.ws + WS_MOD);
    constexpr int ROW_ITEMS = (BT + BATCH * CTX) / 16;
    for (int it = blockIdx.x; it < ROW_ITEMS + 1024; it += gridDim.x) {
        if (it < 1024) { filter_norm_item(p, it, sm); continue; }
        const int row = (it - 1024) * 16 + wave;
        if (row < BT) {
            const int b = row >> 12;
            norm_mod_row(p.in[I_X] + (size_t)row * DM, p.in[I_NMIX], mod + b * 6144, mod + b * 6144 + 1024, (bf16_t*)(p.ws + WS_H) + (size_t)row * DM);
        } else {
            const int r = row - BT;
            norm_mod_row(p.in[I_CTX] + (size_t)r * DM, p.in[I_NMIX], mod + 8 * 6144, mod + 8 * 6144 + 1024, (bf16_t*)(p.ws + WS_HC) + (size_t)r * DM);
        }
    }
}

#define MFMA16(a, b, c) __builtin_amdgcn_mfma_f32_16x16x32_bf16((a), (b), (c), 0, 0, 0)
constexpr int GT_P = 256 * 128;
struct RowLoader {
    const bf16_t* base; int ld;
    template<int ROWS> DI void issue(unsigned char* tile, int kt, int lane, int wave) const {
#pragma unroll
        for (int i = 0; i < ROWS / 128; ++i) {
            const int grp = i * 16 + wave, row = grp * 8 + (lane >> 3), c = (lane & 7) ^ (lane >> 3);
            __builtin_amdgcn_global_load_lds((const unsigned*)(base + (size_t)row * ld + kt * 64 + c * 8), (unsigned*)(tile + grp * 1024), 16, 0, 0);
        }
    }
};
template<int NQ>
DI void gemm_mainloop(f32x4 (&acc)[4][NQ], const RowLoader& lp, const RowLoader& lq, int nk, unsigned char* lds) {
    const int tid = get_tid(), lane = tid & 63, wave = __builtin_amdgcn_readfirstlane(tid >> 6), wp = wave >> 2, wq = wave & 3;
    constexpr int QROWS = NQ * 64;
    constexpr int STAGE = GT_P + QROWS * 128;
    __syncthreads();
    lp.template issue<256>(lds, 0, lane, wave); lq.template issue<QROWS>(lds + GT_P, 0, lane, wave);
    asm volatile("s_waitcnt vmcnt(0)" ::: "memory");
    __syncthreads();
    const int l15 = lane & 15, lk = lane >> 4;
    for (int kt = 0; kt < nk; ++kt) {
        unsigned char* cur = lds + (kt & 1) * STAGE;
        unsigned char* nxt = lds + ((kt + 1) & 1) * STAGE;
        if (kt + 1 < nk) { lp.template issue<256>(nxt, kt + 1, lane, wave); lq.template issue<QROWS>(nxt + GT_P, kt + 1, lane, wave); }
#pragma unroll
        for (int ks = 0; ks < 2; ++ks) {
            bf16x8 fp[4], fq[NQ];
#pragma unroll
            for (int i = 0; i < 4; ++i) { const int row = wp * 64 + i * 16 + l15; fp[i] = *(const bf16x8*)(cur + row * 128 + (((ks * 4 + lk) ^ (row & 7)) << 4)); }
#pragma unroll
            for (int j = 0; j < NQ; ++j) { const int row = wq * (16 * NQ) + j * 16 + l15; fq[j] = *(const bf16x8*)(cur + GT_P + row * 128 + (((ks * 4 + lk) ^ (row & 7)) << 4)); }
#pragma unroll
            for (int i = 0; i < 4; ++i)
#pragma unroll
                for (int j = 0; j < NQ; ++j) acc[i][j] = MFMA16(fp[i], fq[j], acc[i][j]);
        }
        asm volatile("s_waitcnt vmcnt(0)" ::: "memory");
        __syncthreads();
    }
}

DI void head_epilogue(f32x4 (&acc)[4][4], const float* __restrict__ g, const float* __restrict__ rope, bool do_rope, int t_base  , bf16_t* __restrict__ dst  , int lane) {
    const int l15 = lane & 15, lk = lane >> 4;
    float gg[4];
#pragma unroll
    for (int j = 0; j < 4; ++j) gg[j] = g[j * 16 + l15];
#pragma unroll
    for (int i = 0; i < 4; ++i) {
#pragma unroll
        for (int r = 0; r < 4; ++r) {
            float ss = 0.f;
#pragma unroll
            for (int j = 0; j < 4; ++j) ss += acc[i][j][r] * acc[i][j][r];
            ss = sum16(ss);
            const float rs = rsqrtf(ss * (1.f / 64.f) + EPS);
            float v[4];
#pragma unroll
            for (int j = 0; j < 4; ++j) v[j] = acc[i][j][r] * rs * gg[j];
            const int t = t_base + i * 16 + lk * 4 + r;
            if (do_rope) {
                const int prow = (t >> 6) & 63, pcol = t & 63;
                const float c0 = rope[prow * 16 + l15], s0 = rope[1024 + prow * 16 + l15];
                const float c1 = rope[pcol * 16 + l15], s1 = rope[1024 + pcol * 16 + l15];
                const float a0 = v[0] * c0 - v[1] * s0, a1 = v[1] * c0 + v[0] * s0;
                const float a2 = v[2] * c1 - v[3] * s1, a3 = v[3] * c1 + v[2] * s1;
                v[0] = a0; v[1] = a1; v[2] = a2; v[3] = a3;
            }
            bf16_t* d = dst + (size_t)(i * 16 + lk * 4 + r) * 64 + l15;
#pragma unroll
            for (int j = 0; j < 4; ++j) d[j * 16] = (bf16_t)f2bf(v[j]);
        }
    }
}
DI void tstore_epilogue(f32x4 (&acc)[4][4], bf16_t* __restrict__ dst  , size_t ld, int lane) {
    const int l15 = lane & 15, lk = lane >> 4;
#pragma unroll
    for (int i = 0; i < 4; ++i)
#pragma unroll
        for (int j = 0; j < 4; ++j)
            *(u32x2*)(dst + (size_t)(j * 16 + l15) * ld + i * 16 + lk * 4) = u32x2{pk2(acc[i][j][0], acc[i][j][1]), pk2(acc[i][j][2], acc[i][j][3])};
}

DI void phase_c(const Params& p, unsigned char* lds) {
    constexpr int NTM = BT / 256, NTN = INC / 256;
    constexpr int MAIN = NTM * NTN, TOTAL = MAIN + 8;
    const bf16_t* H = (const bf16_t*)(p.ws + WS_H);
    const bf16_t* HCp = (const bf16_t*)(p.ws + WS_HC);
    const bf16_t* WT = (const bf16_t*)(p.ws + WS_WTIN);
    const float* rope = (const float*)(p.ws + WS_ROPE);
    for (int it = blockIdx.x; it < TOTAL; it += gridDim.x) {
        const int tid = get_tid(), lane = tid & 63, wave = tid >> 6, wa = wave >> 2, wb = wave & 3;
        int tm, tn; bool ctx = false;
        if (it < MAIN) { const int g = it / (16 * NTN), rem = it % (16 * NTN); tn = rem >> 4; tm = g * 16 + (rem & 15); }
        else { ctx = true; tm = it - MAIN; tn = 2; }
        const bf16_t* A = ctx ? HCp + (size_t)tm * 256 * DM : H + (size_t)tm * 256 * DM;
        const bf16_t* W = WT + (size_t)tn * 256 * DM;
        f32x4 acc[4][4];
#pragma unroll
        for (int i = 0; i < 4; ++i)
#pragma unroll
            for (int j = 0; j < 4; ++j) acc[i][j] = f32x4{0.f, 0.f, 0.f, 0.f};
        if (tn >= 9) {
            gemm_mainloop<4>(acc, RowLoader{W, DM}, RowLoader{A, DM}, DM / 64, lds);
            bf16_t* G = (bf16_t*)(p.ws + WS_G);
            const int l15 = lane & 15, lk = lane >> 4;
#pragma unroll
            for (int i = 0; i < 4; ++i)
#pragma unroll
                for (int j = 0; j < 4; ++j) {
                    const int n = tn * 256 - 2304 + wa * 64 + i * 16 + lk * 4;
                    const int tok = tm * 256 + wb * 64 + j * 16 + l15;
                    float sg[4];
#pragma unroll
                    for (int r = 0; r < 4; ++r) sg[r] = 1.f / (1.f + __expf(-acc[i][j][r]));
                    *(u32x2*)(G + (size_t)tok * GC + n) = u32x2{pk2(sg[0], sg[1]), pk2(sg[2], sg[3])};
                }
            continue;
        }
        gemm_mainloop<4>(acc, RowLoader{A, DM}, RowLoader{W, DM}, DM / 64, lds);
        const int b = ctx ? tm : (tm >> 4);
        const int tpos = ctx ? SEQ + wa * 64 : ((tm & 15) * 256 + wa * 64);
        if (tn < 2) {
            const int h = tn * 4 + wb;
            bf16_t* Q = (bf16_t*)(p.ws + WS_Q) + ((size_t)(b * NH + h) * SEQ + tpos) * HD;
            head_epilogue(acc, p.in[I_QNG], rope, true, tpos, Q, lane);
        } else if (tn == 2) {
            if (wb < 2) {
                bf16_t* K = (bf16_t*)(p.ws + WS_KB) + ((size_t)(b * NKV + wb) * TK + tpos) * HD;
                head_epilogue(acc, p.in[I_KNG], rope, !ctx, tpos, K, lane);
            } else {
                bf16_t* V = (bf16_t*)(p.ws + WS_VT) + (size_t)(b * NKV + (wb - 2)) * HD * TK + tpos;
                tstore_epilogue(acc, V, TK, lane);
            }
        } else {
            const int col = tn * 256 - 768 + wb * 64;
            bf16_t* Z = (bf16_t*)(p.ws + WS_ZT) + (size_t)col * BT + (size_t)b * SEQ + tpos;
            tstore_epilogue(acc, Z, BT, lane);
        }
    }
}

#define MFMA32(a, b, c) __builtin_amdgcn_mfma_f32_32x32x16_bf16((a), (b), (c), 0, 0, 0)
DI bf16x8 pack_step(const f32x16& x, int s) {
    u32x4 pk;
    asm volatile("v_cvt_pk_bf16_f32 %0, %4, %5\n\tv_cvt_pk_bf16_f32 %1, %6, %7\n\tv_cvt_pk_bf16_f32 %2, %8, %9\n\tv_cvt_pk_bf16_f32 %3, %10, %11\n\ts_nop 1"
                 : "=&v"(pk[0]), "=&v"(pk[1]), "=&v"(pk[2]), "=&v"(pk[3])
                 : "v"(x[8 * s]), "v"(x[8 * s + 1]), "v"(x[8 * s + 2]), "v"(x[8 * s + 3]), "v"(x[8 * s + 4]), "v"(x[8 * s + 5]), "v"(x[8 * s + 6]), "v"(x[8 * s + 7]));
    return __builtin_bit_cast(bf16x8, pk);
}

DI void attn_item(const Params& p, int item, unsigned char* lds) {
    const int tid = get_tid(), lane = tid & 63, wave = tid >> 6;
    const int b = item >> 6, kvh = (item >> 5) & 1, qb = item & 31;
    const int h = kvh * 4 + (wave >> 2), q0 = qb * 128 + (wave & 3) * 32;
    const int qi = lane & 31, hf = lane >> 5;
    const bf16_t* Qp = (const bf16_t*)(p.ws + WS_Q) + ((size_t)(b * NH + h) * SEQ + q0 + qi) * HD;
    bf16x8 qf[4];
#pragma unroll
    for (int s = 0; s < 4; ++s) qf[s] = *(const bf16x8*)(Qp + 16 * s + 8 * hf);
    const bf16_t* Kg = (const bf16_t*)(p.ws + WS_KB) + (size_t)(b * NKV + kvh) * TK * HD;
    const bf16_t* Vg = (const bf16_t*)(p.ws + WS_VT) + (size_t)(b * NKV + kvh) * HD * TK;
    const bool isK = tid < 512;
    const int li = tid & 511, lrow = li >> 3, lc = li & 7;
    const bf16_t* src = isK ? Kg + (size_t)lrow * HD + lc * 8 : Vg + (size_t)lrow * TK + lc * 8;
    const size_t sstep = isK ? (size_t)64 * HD : 64;
    const int ldst = (isK ? 0 : 8192) + lrow * 128 + ((lc ^ (lrow & 7)) << 4);
    constexpr int NTILE = TK / 64;
    const float c = 0.125f * 1.4426950408889634f;
    f32x16 o0, o1;
#pragma unroll
    for (int i = 0; i < 16; ++i) { o0[i] = 0.f; o1[i] = 0.f; }
    float m = -1e30f, l = 0.f;
    __syncthreads();
    u32x4 stg = *(const u32x4*)src;
    *(u32x4*)(lds + ldst) = stg;
    __syncthreads();
    for (int tile = 0; tile < NTILE; ++tile) {
        const unsigned char* cur = lds + (tile & 1) * 16384;
        const bool more = tile + 1 < NTILE;
        if (more) stg = *(const u32x4*)(src + (size_t)(tile + 1) * sstep);
        f32x16 sA, sB;
#pragma unroll
        for (int i = 0; i < 16; ++i) { sA[i] = 0.f; sB[i] = 0.f; }
#pragma unroll
        for (int s = 0; s < 4; ++s) {
            const int off = qi * 128 + (((2 * s + hf) ^ (qi & 7)) << 4);
            const bf16x8 kA = *(const bf16x8*)(cur + off);
            const bf16x8 kB = *(const bf16x8*)(cur + 4096 + off);
            sA = MFMA32(kA, qf[s], sA);
            sB = MFMA32(kB, qf[s], sB);
        }
        float tmax = sA[0];
#pragma unroll
        for (int i = 1; i < 16; ++i) tmax = fmaxf(tmax, sA[i]);
#pragma unroll
        for (int i = 0; i < 16; ++i) tmax = fmaxf(tmax, sB[i]);
        tmax = max_x32(tmax);
        const float mn = fmaxf(m, tmax);
        const float alpha = exp2f((m - mn) * c);
        m = mn;
        float ps = 0.f;
#pragma unroll
        for (int i = 0; i < 16; ++i) { sA[i] = exp2f((sA[i] - mn) * c); ps += sA[i]; sB[i] = exp2f((sB[i] - mn) * c); ps += sB[i]; }
        l = l * alpha + ps;
#pragma unroll
        for (int i = 0; i < 16; ++i) { o0[i] *= alpha; o1[i] *= alpha; }
#pragma unroll
        for (int kb = 0; kb < 2; ++kb) {
#pragma unroll
            for (int s2 = 0; s2 < 2; ++s2) {
                const bf16x8 pf = pack_step(kb ? sB : sA, s2);
                const int ch = 4 * kb + 2 * s2;
#pragma unroll
                for (int db = 0; db < 2; ++db) {
                    const int dr = db * 32 + qi;
                    const unsigned char* vb = cur + 8192 + dr * 128 + 8 * hf;
                    const s16x4 lo = *(const s16x4*)(vb + ((ch ^ (dr & 7)) << 4));
                    const s16x4 hi = *(const s16x4*)(vb + (((ch + 1) ^ (dr & 7)) << 4));
                    const bf16x8 vf = __builtin_shufflevector(lo, hi, 0, 1, 2, 3, 4, 5, 6, 7);
                    if (db == 0) o0 = MFMA32(vf, pf, o0); else o1 = MFMA32(vf, pf, o1);
                }
            }
        }
        if (more) *(u32x4*)(lds + ((tile + 1) & 1) * 16384 + ldst) = stg;
        __syncthreads();
    }
    l = sum_x32(l);
    const float inv = 1.f / l;
    bf16_t* O;
    {
        const int t2 = get_tid(), lane2 = t2 & 63, wave2 = t2 >> 6;
        const int h2 = kvh * 4 + (wave2 >> 2), q2 = qb * 128 + (wave2 & 3) * 32 + (lane2 & 31);
        O = (bf16_t*)(p.ws + WS_ATT) + ((size_t)b * SEQ + q2) * QD + h2 * HD + 4 * (lane2 >> 5);
    }
#pragma unroll
    for (int g4 = 0; g4 < 4; ++g4) {
        *(u32x2*)(O + 8 * g4)      = u32x2{pk2(o0[4 * g4] * inv, o0[4 * g4 + 1] * inv), pk2(o0[4 * g4 + 2] * inv, o0[4 * g4 + 3] * inv)};
        *(u32x2*)(O + 32 + 8 * g4) = u32x2{pk2(o1[4 * g4] * inv, o1[4 * g4 + 1] * inv), pk2(o1[4 * g4 + 2] * inv, o1[4 * g4 + 3] * inv)};
    }
}

constexpr int HY_USTR = 8208, HY_R = 8 * HY_USTR, HY_RSTR = 16384 + 64;
DI void hy_load_filter(const bf16_t* __restrict__ R, unsigned char* lds, int tid) {
    const int i0 = tid * 8;
    const u32x4 w = *(const u32x4*)(R + i0);
    u32x2 nx = u32x2{0u, 0u};
    if (i0 + 8 < 8192) nx = *(const u32x2*)(R + i0 + 8);
    unsigned char* d = lds + HY_R + i0 * 2;
    *(u32x4*)(d) = w;
    *(u32x4*)(d + HY_RSTR) = u32x4{__builtin_amdgcn_alignbit(w[1], w[0], 16), __builtin_amdgcn_alignbit(w[2], w[1], 16), __builtin_amdgcn_alignbit(w[3], w[2], 16), __builtin_amdgcn_alignbit(nx[0], w[3], 16)};
    *(u32x4*)(d + 2 * HY_RSTR) = u32x4{w[1], w[2], w[3], nx[0]};
    *(u32x4*)(d + 3 * HY_RSTR) = u32x4{__builtin_amdgcn_alignbit(w[2], w[1], 16), __builtin_amdgcn_alignbit(w[3], w[2], 16), __builtin_amdgcn_alignbit(nx[0], w[3], 16), __builtin_amdgcn_alignbit(nx[1], nx[0], 16)};
}
DI void short_conv4(const bf16_t* __restrict__ zrow  , int t4, float w0, float w1, float w2, float bias, float (&out)[4]) {
    const u32x2 v = *(const u32x2*)(zrow + t4);
    const float z0 = bflo(v[0]), z1 = bfhi(v[0]), z2 = bflo(v[1]), z3 = bfhi(v[1]);
    const float zm = (t4 > 0) ? bf2f(zrow[t4 - 1]) : 0.f;
    const float zp = (t4 + 4 < SEQ) ? bf2f(zrow[t4 + 4]) : 0.f;
    out[0] = zm * w0 + z0 * w1 + z1 * w2 + bias;
    out[1] = z0 * w0 + z1 * w1 + z2 * w2 + bias;
    out[2] = z1 * w0 + z2 * w1 + z3 * w2 + bias;
    out[3] = z2 * w0 + z3 * w1 + zp * w2 + bias;
}
DI void hyena_item(const Params& p, int c, unsigned char* lds) {
    const int tid = get_tid(), lane = tid & 63, ig = tid >> 6;
    const bf16_t* ZT = (const bf16_t*)(p.ws + WS_ZT);
    const float* cw = p.in[I_HCW];
    const float* cb = p.in[I_HCB];
    __syncthreads();
    {
        const int b = tid >> 7, tb = (tid & 127) * 32;
        const bf16_t* zrow = ZT + (size_t)c * BT + (size_t)b * SEQ;
        const float w0 = cw[c], w1 = cw[HYC + c], w2 = cw[2 * HYC + c], bias = cb[c];
#pragma unroll
        for (int q = 0; q < 8; ++q) {
            float o[4];
            short_conv4(zrow, tb + 4 * q, w0, w1, w2, bias, o);
            *(u32x2*)(lds + b * HY_USTR + (tb + 4 * q) * 2) = u32x2{pk2(o[0], o[1]), pk2(o[2], o[3])};
        }
    }
    const int r = lane & 31, hf = lane >> 5, Il = r >> 3, bb = r & 7;
#pragma unroll 1
    for (int o = 0; o < 2; ++o) {
        hy_load_filter((const bf16_t*)(p.ws + WS_R) + (size_t)(o * 512 + c) * 8192, lds, tid);
        __syncthreads();
        f32x16 acc0, acc1;
#pragma unroll
        for (int i = 0; i < 16; ++i) { acc0[i] = 0.f; acc1[i] = 0.f; }
#pragma unroll 1
        for (int d = 4 * ig - 63; d <= 4 * ig + 3; ++d) {
            const int J = 4 * ig + Il - d;
            const bool valid = (unsigned)J < 64u;
            const unsigned char* ub = lds + bb * HY_USTR + ((J & 63) * 64 + 8 * hf) * 2;
            const int eb = 4096 - 64 * d + 8 * hf - r;
#pragma unroll
            for (int ks = 0; ks < 4; ++ks) {
                u32x4 braw = *(const u32x4*)(ub + ks * 32);
                if (!valid) braw = u32x4{0u, 0u, 0u, 0u};
                const bf16x8 bf = __builtin_bit_cast(bf16x8, braw);
#pragma unroll
                for (int mm = 0; mm < 2; ++mm) {
                    const int e0 = eb + 16 * ks - 32 * mm;
                    const int sh = e0 & 3;
                    const unsigned char* ap = lds + HY_R + sh * HY_RSTR + (e0 - sh) * 2;
                    const s16x4 lo = *(const s16x4*)(ap);
                    const s16x4 hi = *(const s16x4*)(ap + 8);
                    const bf16x8 af = __builtin_shufflevector(lo, hi, 0, 1, 2, 3, 4, 5, 6, 7);
                    if (mm == 0) acc0 = MFMA32(af, bf, acc0); else acc1 = MFMA32(af, bf, acc1);
                }
            }
        }
        __syncthreads();
        const float skip = p.in[I_HSKIP][o * HYD + c];
        const int gcol = (o == 0 ? 512 : 1024) + c;
        const float w0 = cw[gcol], w1 = cw[HYC + gcol], w2 = cw[2 * HYC + gcol], bias = cb[gcol];
        const bf16_t* zrow = ZT + (size_t)gcol * BT + (size_t)bb * SEQ;
        bf16_t* hyt = (bf16_t*)(p.ws + WS_HYT) + (size_t)c * BT + (size_t)bb * SEQ;
#pragma unroll
        for (int mm = 0; mm < 2; ++mm) {
#pragma unroll
            for (int g4 = 0; g4 < 4; ++g4) {
                const int t4 = (4 * ig + Il) * 64 + 32 * mm + 8 * g4 + 4 * hf;
                float gt[4];
                short_conv4(zrow, t4, w0, w1, w2, bias, gt);
                unsigned char* up = lds + bb * HY_USTR + t4 * 2;
                const u32x2 uv = *(const u32x2*)up;
                const float u0 = bflo(uv[0]), u1 = bfhi(uv[0]), u2 = bflo(uv[1]), u3 = bfhi(uv[1]);
                const f32x16& a = mm ? acc1 : acc0;
                const float y0 = gt[0] * (a[4 * g4] + skip * u0), y1 = gt[1] * (a[4 * g4 + 1] + skip * u1);
                const float y2 = gt[2] * (a[4 * g4 + 2] + skip * u2), y3 = gt[3] * (a[4 * g4 + 3] + skip * u3);
                const u32x2 pk = u32x2{pk2(y0, y1), pk2(y2, y3)};
                if (o == 0) *(u32x2*)up = pk; else *(u32x2*)(hyt + t4) = pk;
            }
        }
        __syncthreads();
    }
}

constexpr int CTL_QUEUE_D = 8192;
template<bool HY> DI void phase_d(const Params& p, unsigned char* lds) {
    unsigned* ctr = (unsigned*)(p.ws + WS_CTL) + CTL_QUEUE_D + (HY ? 0 : 64);
    volatile LAS unsigned* slot = (volatile LAS unsigned*)(LAS unsigned char*)(lds + LDS_ST_OFF + 8);
    for (;;) {
        __syncthreads();
        if (get_tid() == 0) slot[0] = atomicAdd(ctr, 1u);
        __syncthreads();
        const int it = __builtin_amdgcn_readfirstlane((int)slot[0]);
        if (it >= 512) break;
        if (HY) hyena_item(p, it, lds); else attn_item(p, it, lds);
    }
}

DI void phase_d2(const Params& p, unsigned char* lds) {
    constexpr int TILES = 8 * (BT / 256);
    constexpr int CONV = 2 * 16384 * 1024 / 8192;
    const bf16_t* HYT = (const bf16_t*)(p.ws + WS_HYT);
    bf16_t* HY = (bf16_t*)(p.ws + WS_HY);
    for (int it = blockIdx.x; it < TILES + CONV; it += gridDim.x) {
        const int tid = get_tid();
        if (it >= TILES) {
            const int ci = it - TILES;
            const size_t el = (size_t)(ci & 2047) * 8192 + tid * 8;
            const float* src = (ci < 2048 ? p.in[I_PU] : p.in[I_PV]) + el;
            const float sc = ci < 2048 ? USCALE : VSCALE;
            const f32x4 a = *(const f32x4*)src, b = *(const f32x4*)(src + 4);
            int w0 = 0, w1 = 0;
            w0 = __builtin_amdgcn_cvt_pk_fp8_f32(a[0] * sc, a[1] * sc, w0, false); w0 = __builtin_amdgcn_cvt_pk_fp8_f32(a[2] * sc, a[3] * sc, w0, true);
            w1 = __builtin_amdgcn_cvt_pk_fp8_f32(b[0] * sc, b[1] * sc, w1, false); w1 = __builtin_amdgcn_cvt_pk_fp8_f32(b[2] * sc, b[3] * sc, w1, true);
            const size_t e = el >> 10, col = el & 1023;
            unsigned char* dst = ci < 2048 ? p.ws + WS_UT + el : p.ws + WS_VTAB + ((col >> 7) * 16384 + e) * 128 + (col & 127);
            *(u32x2*)dst = u32x2{(unsigned)w0, (unsigned)w1};
            continue;
        }
        const int c0 = (it & 7) * 64, tok0 = (it >> 3) * 256;
        __syncthreads();
#pragma unroll
        for (int i = 0; i < 2; ++i) {
            const int idx = tid + i * NT, c = idx >> 5, tg = idx & 31;
            *(u32x4*)(lds + c * 528 + tg * 16) = *(const u32x4*)(HYT + (size_t)(c0 + c) * BT + tok0 + tg * 8);
        }
        __syncthreads();
#pragma unroll
        for (int i = 0; i < 2; ++i) {
            const int idx = tid + i * NT, tok = idx >> 3, cg = idx & 7;
            unsigned w[4];
#pragma unroll
            for (int e = 0; e < 4; ++e) {
                const unsigned lo = *(const unsigned short*)(lds + (cg * 8 + 2 * e) * 528 + tok * 2);
                const unsigned hi = *(const unsigned short*)(lds + (cg * 8 + 2 * e + 1) * 528 + tok * 2);
                w[e] = lo | (hi << 16);
            }
            *(u32x4*)(HY + (size_t)(tok0 + tok) * HYD + c0 + cg * 8) = u32x4{w[0], w[1], w[2], w[3]};
        }
    }
}

DI void phase_e(const Params& p, unsigned char* lds) {
    constexpr int TILES = 4 * (BT / 128);
    for (int it = blockIdx.x; it < TILES; it += gridDim.x) {
        const int tid = get_tid(), lane = tid & 63, wave = tid >> 6, wp = wave >> 2, wq = wave & 3;
        const int tn = it & 3, tm = it >> 2;
        const int n0 = tn * 256, tok0 = tm * 128;
        f32x4 acc1[4][2], acc2[4][2];
#pragma unroll
        for (int i = 0; i < 4; ++i)
#pragma unroll
            for (int j = 0; j < 2; ++j) { acc1[i][j] = f32x4{0.f, 0.f, 0.f, 0.f}; acc2[i][j] = f32x4{0.f, 0.f, 0.f, 0.f}; }
        gemm_mainloop<2>(acc1, RowLoader{(const bf16_t*)(p.ws + WS_WTAO) + (size_t)n0 * QD, QD}, RowLoader{(const bf16_t*)(p.ws + WS_ATT) + (size_t)tok0 * QD, QD}, QD / 64, lds);
        gemm_mainloop<2>(acc2, RowLoader{(const bf16_t*)(p.ws + WS_WTHO) + (size_t)n0 * HYD, HYD}, RowLoader{(const bf16_t*)(p.ws + WS_HY) + (size_t)tok0 * HYD, HYD}, HYD / 64, lds);
        const bf16_t* G = (const bf16_t*)(p.ws + WS_G);
        bf16_t* M = (bf16_t*)(p.ws + WS_H);
        const int l15 = lane & 15, lk = lane >> 4;
#pragma unroll
        for (int i = 0; i < 4; ++i)
#pragma unroll
            for (int j = 0; j < 2; ++j) {
                const int n = n0 + wp * 64 + i * 16 + lk * 4;
                const int tok = tok0 + wq * 32 + j * 16 + l15;
                const u32x2 ga = *(const u32x2*)(G + (size_t)tok * GC + n);
                const u32x2 gh = *(const u32x2*)(G + (size_t)tok * GC + 1024 + n);
                const float m0 = bflo(ga[0]) * acc1[i][j][0] + bflo(gh[0]) * acc2[i][j][0];
                const float m1 = bfhi(ga[0]) * acc1[i][j][1] + bfhi(gh[0]) * acc2[i][j][1];
                const float m2 = bflo(ga[1]) * acc1[i][j][2] + bflo(gh[1]) * acc2[i][j][2];
                const float m3 = bfhi(ga[1]) * acc1[i][j][3] + bfhi(gh[1]) * acc2[i][j][3];
                *(u32x2*)(M + (size_t)tok * DM + n) = u32x2{pk2(m0, m1), pk2(m2, m3)};
            }
    }
}

DI void phase_f(const Params& p, unsigned char* lds) {
    constexpr int TILES = 4 * (BT / 256);
    const float* mod = (const float*)(p.ws + WS_MOD);
    for (int it = blockIdx.x; it < TILES; it += gridDim.x) {
        const int tid = get_tid(), lane = tid & 63, wave = tid >> 6, wp = wave >> 2, wq = wave & 3;
        const int tn = it & 3, tm = it >> 2;
        const int n0 = tn * 256, tok0 = tm * 256, b = tok0 >> 12;
        f32x4 acc[4][4];
#pragma unroll
        for (int i = 0; i < 4; ++i)
#pragma unroll
            for (int j = 0; j < 4; ++j) acc[i][j] = f32x4{0.f, 0.f, 0.f, 0.f};
        gemm_mainloop<4>(acc, RowLoader{(const bf16_t*)(p.ws + WS_WTO) + (size_t)n0 * DM, DM}, RowLoader{(const bf16_t*)(p.ws + WS_H) + (size_t)tok0 * DM, DM}, DM / 64, lds);
        const int l15 = lane & 15, lk = lane >> 4;
#pragma unroll
        for (int i = 0; i < 4; ++i) {
            const int n = n0 + wp * 64 + i * 16 + lk * 4;
            const f32x4 g1 = *(const f32x4*)(mod + b * 6144 + 2048 + n);
#pragma unroll
            for (int j = 0; j < 4; ++j) {
                const int tok = tok0 + wq * 64 + j * 16 + l15;
                const f32x4 xv = *(const f32x4*)(p.in[I_X] + (size_t)tok * DM + n);
                *(f32x4*)(p.out + (size_t)tok * DM + n) = f32x4{xv[0] + g1[0] * acc[i][j][0], xv[1] + g1[1] * acc[i][j][1], xv[2] + g1[2] * acc[i][j][2], xv[3] + g1[3] * acc[i][j][3]};
            }
        }
    }
}

DI void phase_g(const Params& p) {
    const float* mod = (const float*)(p.ws + WS_MOD);
    for (int it = blockIdx.x; it < BT / 16; it += gridDim.x) {
        const int row = it * 16 + (get_tid() >> 6), b = row >> 12;
        norm_mod_row(p.out + (size_t)row * DM, p.in[I_NFFN], mod + b * 6144 + 3072, mod + b * 6144 + 4096, (bf16_t*)(p.ws + WS_H) + (size_t)row * DM);
    }
}

DI void phase_h(const Params& p, unsigned char* lds) {
    constexpr int TILES = 8 * (BT / 256);
    for (int it = blockIdx.x; it < TILES; it += gridDim.x) {
        const int tid = get_tid(), lane = tid & 63, wave = tid >> 6, wp = wave >> 2, wq = wave & 3;
        const int tn = it & 7, tm = it >> 3;
        const int n0 = tn * 256, tok0 = tm * 256;
        f32x4 acc[4][4];
#pragma unroll
        for (int i = 0; i < 4; ++i)
#pragma unroll
            for (int j = 0; j < 4; ++j) acc[i][j] = f32x4{0.f, 0.f, 0.f, 0.f};
        gemm_mainloop<4>(acc, RowLoader{(const bf16_t*)(p.ws + WS_WTQ) + (size_t)n0 * DM, DM}, RowLoader{(const bf16_t*)(p.ws + WS_H) + (size_t)tok0 * DM, DM}, DM / 64, lds);
        bf16_t* QP = (bf16_t*)(p.ws + WS_G);
        const int l15 = lane & 15, lk = lane >> 4;
#pragma unroll
        for (int i = 0; i < 4; ++i)
#pragma unroll
            for (int j = 0; j < 4; ++j) {
                const int n = n0 + wp * 64 + i * 16 + lk * 4;
                const int tok = tok0 + wq * 64 + j * 16 + l15;
                *(u32x2*)(QP + (size_t)tok * 2048 + n) = u32x2{pk2(acc[i][j][0], acc[i][j][1]), pk2(acc[i][j][2], acc[i][j][3])};
            }
    }
}

DI void ins16(float (&L)[16], float v) {
#pragma unroll
    for (int i = 0; i < 16; ++i) { const float hi = fmaxf(L[i], v); v = fminf(L[i], v); L[i] = hi; }
}
DI float pack_idx(float v, unsigned idx, unsigned mask) { return __uint_as_float((__float_as_uint(v) & ~mask) | idx); }
constexpr int PI_LIST = 0;
DI void peer_select_item(const Params& p, int item, unsigned char* lds) {
    const int tok0 = item * 32;
    __syncthreads();
    {
        const int tid = get_tid(), lane = tid & 63, hp = tid >> 6;
        const int r = lane & 31, hf = lane >> 5;
        const bf16_t* keys = (const bf16_t*)(p.ws + WS_KEYS) + (size_t)((hp & 1) * 8 + (hp >> 1)) * 128 * 128 + 8 * hf;
        const bf16_t* qp = (const bf16_t*)(p.ws + WS_G) + (size_t)(tok0 + r) * 2048 + hp * 128 + 8 * hf;
        f32x16 acc[4];
#pragma unroll
        for (int m = 0; m < 4; ++m)
#pragma unroll
            for (int i = 0; i < 16; ++i) acc[m][i] = 0.f;
#pragma unroll
        for (int ks = 0; ks < 8; ++ks) {
            const bf16x8 bq = *(const bf16x8*)(qp + 16 * ks);
#pragma unroll
            for (int m = 0; m < 4; ++m) {
                const bf16x8 ak = *(const bf16x8*)(keys + (size_t)(m * 32 + r) * 128 + 16 * ks);
                acc[m] = MFMA32(ak, bq, acc[m]);
            }
        }
        float L[16];
#pragma unroll
        for (int i = 0; i < 16; ++i) L[i] = -3.0e38f;
#pragma unroll
        for (int m = 0; m < 4; ++m)
#pragma unroll
            for (int i = 0; i < 16; ++i) {
                const unsigned n = m * 32 + (i & 3) + 8 * (i >> 2) + 4 * hf;
                ins16(L, pack_idx(acc[m][i], n, 127u));
            }
        float P[16];
#pragma unroll
        for (int i = 0; i < 16; ++i) {
            auto sw = __builtin_amdgcn_permlane32_swap(__float_as_uint(L[i]), __float_as_uint(L[i]), false, false);
            P[i] = hf ? __uint_as_float(sw[0]) : __uint_as_float(sw[1]);
        }
#pragma unroll
        for (int i = 0; i < 16; ++i) ins16(L, P[i]);
        if (hf == 0) {
            float* dst = (float*)(lds + PI_LIST) + (r * 16 + hp) * 16;
#pragma unroll
            for (int i = 0; i < 16; i += 4) *(f32x4*)(dst + i) = f32x4{L[i], L[i + 1], L[i + 2], L[i + 3]};
        }
    }
    __syncthreads();
    {
        const int tid = get_tid();
        if (tid < 256) {
            const int tok = tid >> 3, h = tid & 7;
            const float* l1 = (const float*)(lds + PI_LIST) + (tok * 16 + 2 * h) * 16;
            const float* l2 = l1 + 16;
            float v1[16], v2[16];
#pragma unroll
            for (int i = 0; i < 16; i += 4) {
                const f32x4 a = *(const f32x4*)(l1 + i), b = *(const f32x4*)(l2 + i);
                v1[i] = a[0]; v1[i + 1] = a[1]; v1[i + 2] = a[2]; v1[i + 3] = a[3];
                v2[i] = b[0]; v2[i + 1] = b[1]; v2[i + 2] = b[2]; v2[i + 3] = b[3];
            }
            float B[16];
#pragma unroll
            for (int i = 0; i < 16; ++i) B[i] = -3.0e38f;
#pragma unroll
            for (int i = 0; i < 16; ++i)
#pragma unroll
                for (int j = 0; j < 16; ++j)
                    if ((i + 1) * (j + 1) <= 16) ins16(B, pack_idx(v1[i] + v2[j], (unsigned)(i * 16 + j), 255u));
            float e[16], sum = 0.f;
#pragma unroll
            for (int k = 0; k < 16; ++k) { e[k] = __expf(B[k] - B[0]); sum += e[k]; }
            const float inv = 1.f / sum;
            int* ex = (int*)(p.ws + WS_EXPI) + (size_t)(tok0 + tok) * 128 + h * 16;
            float* gt = (float*)(p.ws + WS_GATE) + (size_t)(tok0 + tok) * 128 + h * 16;
            int ev[16]; float gv[16];
#pragma unroll
            for (int k = 0; k < 16; ++k) {
                const unsigned ij = __float_as_uint(B[k]) & 255u;
                const unsigned i1 = __float_as_uint(l1[ij >> 4]) & 127u, i2 = __float_as_uint(l2[ij & 15u]) & 127u;
                ev[k] = (int)(i1 * 128u + i2);
                gv[k] = e[k] * inv;
            }
#pragma unroll
            for (int k = 0; k < 16; k += 4) {
                *(u32x4*)(ex + k) = u32x4{(unsigned)ev[k], (unsigned)ev[k + 1], (unsigned)ev[k + 2], (unsigned)ev[k + 3]};
                *(f32x4*)(gt + k) = f32x4{gv[k], gv[k + 1], gv[k + 2], gv[k + 3]};
            }
        }
    }
}
DI void phase_i1(const Params& p, unsigned char* lds) {
    for (int it = blockIdx.x; it < BT / 32; it += gridDim.x) peer_select_item(p, it, lds);
}

DI float dot16_fp8(const u32x4& w, const float (&x)[16]) {
    float d = 0.f;
#pragma unroll
    for (int i = 0; i < 4; ++i) {
        const auto lo = __builtin_amdgcn_cvt_pk_f32_fp8((int)w[i], false);
        const auto hi = __builtin_amdgcn_cvt_pk_f32_fp8((int)w[i], true);
        d += lo[0] * x[4 * i] + lo[1] * x[4 * i + 1] + hi[0] * x[4 * i + 2] + hi[1] * x[4 * i + 3];
    }
    return d;
}
template<class F> DI void run_partitioned(const Params& p, unsigned char* lds, int qbase, int nitems, F&& body) {
    unsigned* ctl = (unsigned*)(p.ws + WS_CTL);
    volatile LAS unsigned* slot = (volatile LAS unsigned*)(LAS unsigned char*)(lds + LDS_ST_OFF + 8);
    const int x0 = (int)(xb_xcc_id() & 7u);
#pragma unroll 1
    for (int pp = 0; pp < 8; ++pp) {
        const int part = (x0 + pp) & 7;
        for (;;) {
            __syncthreads();
            if (get_tid() == 0) slot[0] = atomicAdd(ctl + qbase + 64 * part, 1u);
            __syncthreads();
            const int it = __builtin_amdgcn_readfirstlane((int)slot[0]);
            if (it >= nitems) break;
            body(part, it);
        }
    }
}
constexpr int CTL_QUEUE_I2 = 8320, CTL_QUEUE_I3 = 8896;
constexpr int UW_BYTES = 6144, UW_GT = 4096, UW_LIST = 5120;
DI void peer_u_chunk(const Params& p, int part, int chunk, unsigned char* lds) {
    const int tid = get_tid(), lane = tid & 63, wave = __builtin_amdgcn_readfirstlane(tid >> 6);
    unsigned char* wl = lds + wave * UW_BYTES;
    unsigned* lst = (unsigned*)(wl + UW_LIST);
    const float* gts = (const float*)(wl + UW_GT);
    const unsigned char* UT8 = p.ws + WS_UT + lane * 16;
    const int tokw = chunk * 512 + wave * 2;
    int pe[4]; u32x4 ph[4]; float pg[4];
#define U_PREFETCH(tok) do { \
        const int* ex_ = (const int*)(p.ws + WS_EXPI) + (size_t)(tok) * 128 + lane; \
        const float* gt_ = (const float*)(p.ws + WS_GATE) + (size_t)(tok) * 128 + lane; \
        const bf16_t* hr_ = (const bf16_t*)(p.ws + WS_H) + (size_t)(tok) * DM + lane * 16; \
        pe[0] = ex_[0]; pe[1] = ex_[64]; pe[2] = ex_[128]; pe[3] = ex_[192]; \
        pg[0] = gt_[0]; pg[1] = gt_[64]; pg[2] = gt_[128]; pg[3] = gt_[192]; \
        ph[0] = *(const u32x4*)hr_; ph[1] = *(const u32x4*)(hr_ + 8); ph[2] = *(const u32x4*)(hr_ + DM); ph[3] = *(const u32x4*)(hr_ + DM + 8); } while (0)
    U_PREFETCH(tokw);
#pragma unroll 1
    for (int sub = 0; sub < 16; ++sub) {
        const int tok0 = tokw + sub * 32;
        *(u32x4*)(wl + lane * 32) = ph[0]; *(u32x4*)(wl + lane * 32 + 16) = ph[1];
        *(u32x4*)(wl + 2048 + lane * 32) = ph[2]; *(u32x4*)(wl + 2048 + lane * 32 + 16) = ph[3];
        int cnt = 0;
#pragma unroll
        for (int g = 0; g < 4; ++g) {
            ((float*)(wl + UW_GT))[g * 64 + lane] = pg[g];
            const bool m = (pe[g] >> 11) == part;
            const unsigned long long bm = __ballot(m);
            const int pos = cnt + __builtin_amdgcn_mbcnt_hi((unsigned)(bm >> 32), __builtin_amdgcn_mbcnt_lo((unsigned)bm, 0u));
            if (m) lst[pos] = ((unsigned)(g * 64 + lane) << 16) | (unsigned)pe[g];
            cnt += __popcll(bm);
        }
        if (sub + 1 < 16) U_PREFETCH(tok0 + 32);
#pragma unroll 1
        for (int base = 0; base < cnt; base += 8) {
            u32x4 row[8]; unsigned en[8];
#pragma unroll
            for (int q = 0; q < 8; ++q) {
                en[q] = __builtin_amdgcn_readfirstlane(lst[min(base + q, cnt - 1)]);
                row[q] = *(const u32x4*)(UT8 + (size_t)(en[q] & 0x3fffu) * 1024);
            }
            float d[8];
#pragma unroll
            for (int q = 0; q < 8; ++q) {
                const unsigned char* xr = wl + (en[q] >> 23) * 2048 + lane * 32;
                const u32x4 xa = *(const u32x4*)xr, xb = *(const u32x4*)(xr + 16);
                float acc = 0.f;
#pragma unroll
                for (int i = 0; i < 4; ++i) {
                    const auto lo = __builtin_amdgcn_cvt_scalef32_pk_bf16_fp8(row[q][i], 1.0f, false);
                    const auto hi = __builtin_amdgcn_cvt_scalef32_pk_bf16_fp8(row[q][i], 1.0f, true);
                    const unsigned x0 = (i < 2) ? xa[2 * i] : xb[2 * i - 4], x1 = (i < 2) ? xa[2 * i + 1] : xb[2 * i - 3];
                    acc = __builtin_amdgcn_fdot2_f32_bf16(lo, __builtin_bit_cast(decltype(lo), x0), acc, false);
                    acc = __builtin_amdgcn_fdot2_f32_bf16(hi, __builtin_bit_cast(decltype(hi), x1), acc, false);
                }
                d[q] = acc;
            }
            float r4[4], r2[2];
#pragma unroll
            for (int i = 0; i < 4; ++i) { auto sw = __builtin_amdgcn_permlane32_swap(__float_as_uint(d[i]), __float_as_uint(d[i + 4]), false, false); r4[i] = __uint_as_float(sw[0]) + __uint_as_float(sw[1]); }
#pragma unroll
            for (int i = 0; i < 2; ++i) { auto sw = __builtin_amdgcn_permlane16_swap(__float_as_uint(r4[i]), __float_as_uint(r4[i + 2]), false, false); r2[i] = __uint_as_float(sw[0]) + __uint_as_float(sw[1]); }
            const bool b3 = (lane & 8) != 0;
            float a = (b3 ? r2[1] : r2[0]) + dppf<0x128>(b3 ? r2[0] : r2[1]);
            a += dppf<0xB1>(a); a += dppf<0x4E>(a); a += dppf<0x141>(a);
            a *= (1.f / USCALE);
            const int g = lane >> 3;
            const unsigned ent = lst[min(base + g, cnt - 1)];
            const int idx = (int)(ent >> 16);
            const float y = 0.7978845608028654f * (a + 0.044715f * a * a * a);
            const float th = 1.f - 2.f / (__expf(2.f * y) + 1.f);
            const float w = 0.5f * a * (1.f + th) * gts[idx];
            if ((lane & 7) == 0 && base + g < cnt) ((u32x2*)(p.ws + WS_PAIRS))[(size_t)tok0 * 128 + idx] = u32x2{ent & 0x3fffu, __float_as_uint(w)};
        }
    }
#undef U_PREFETCH
}
DI void phase_i2(const Params& p, unsigned char* lds) {
    run_partitioned(p, lds, CTL_QUEUE_I2, BT / 512, [&](int part, int it) { peer_u_chunk(p, part, it, lds); });
}
typedef float f32x2 __attribute__((ext_vector_type(2)));
DI void peer_v_chunk(const Params& p, int part, int chunk, unsigned char* lds) {
    const int tid = get_tid(), lane = tid & 63, wave = __builtin_amdgcn_readfirstlane(tid >> 6);
    unsigned char* wl = lds + wave * 1024;
    const int es = lane >> 3, ch = lane & 7;
    const unsigned char* VT8 = p.ws + WS_VTAB + (size_t)part * 16384 * 128 + ch * 16;
    const float* mod = (const float*)(p.ws + WS_MOD);
    const int col = part * 128 + 16 * ch + 2 * es;
    const int tokw = chunk * 512 + wave;
    u32x4 pp = *((const u32x4*)(p.ws + WS_PAIRS + (size_t)tokw * 1024) + lane);
#pragma unroll 1
    for (int step = 0; step < 32; ++step) {
        const int tok = tokw + step * 16, b = tok >> 12;
        *(u32x4*)(wl + lane * 16) = pp;
        if (step + 1 < 32) pp = *((const u32x4*)(p.ws + WS_PAIRS + (size_t)(tok + 16) * 1024) + lane);
        float* xo = p.out + (size_t)tok * DM + col;
        const f32x2 x1 = *(const f32x2*)xo;
        const f32x2 g2 = *(const f32x2*)(mod + b * 6144 + 5120 + col);
        f32x2 acc[8];
#pragma unroll
        for (int i = 0; i < 8; ++i) acc[i] = f32x2{0.f, 0.f};
        const u32x2* pr = (const u32x2*)wl + es;
#pragma unroll 1
        for (int ih = 0; ih < 2; ++ih) {
            u32x2 pe[8]; u32x4 row[8];
#pragma unroll
            for (int q = 0; q < 8; ++q) { pe[q] = pr[(ih * 8 + q) * 8]; row[q] = *(const u32x4*)(VT8 + (size_t)pe[q][0] * 128); }
#pragma unroll
            for (int q = 0; q < 8; ++q) {
                const float w = __uint_as_float(pe[q][1]);
                const f32x2 w2 = f32x2{w, w};
#pragma unroll
                for (int i = 0; i < 4; ++i) {
                    const f32x2 lo = __builtin_amdgcn_cvt_pk_f32_fp8((int)row[q][i], false);
                    const f32x2 hi = __builtin_amdgcn_cvt_pk_f32_fp8((int)row[q][i], true);
                    acc[2 * i] += w2 * lo; acc[2 * i + 1] += w2 * hi;
                }
            }
        }
        float a16[16];
#pragma unroll
        for (int i = 0; i < 8; ++i) { a16[2 * i] = acc[i][0]; a16[2 * i + 1] = acc[i][1]; }
        float r8[8], r4[4], r2[2];
#pragma unroll
        for (int i = 0; i < 8; ++i) { auto sw = __builtin_amdgcn_permlane32_swap(__float_as_uint(a16[i]), __float_as_uint(a16[i + 8]), false, false); r8[i] = __uint_as_float(sw[0]) + __uint_as_float(sw[1]); }
#pragma unroll
        for (int i = 0; i < 4; ++i) { auto sw = __builtin_amdgcn_permlane16_swap(__float_as_uint(r8[i]), __float_as_uint(r8[i + 4]), false, false); r4[i] = __uint_as_float(sw[0]) + __uint_as_float(sw[1]); }
        const bool b3 = (lane & 8) != 0;
#pragma unroll
        for (int i = 0; i < 2; ++i) { const float keep = b3 ? r4[i + 2] : r4[i], send = b3 ? r4[i] : r4[i + 2]; r2[i] = keep + dppf<0x128>(send); }
        const float xa = x1[0] + g2[0] * r2[0] * (1.f / VSCALE), xb = x1[1] + g2[1] * r2[1] * (1.f / VSCALE);
        *(f32x2*)xo = f32x2{xa, xb};
        const float ss = wave_sum(xa * xa + xb * xb);
        if (lane == 0) ((float*)(p.ws + WS_SSQ))[(size_t)tok * 8 + part] = ss;
    }
}
DI void phase_i3(const Params& p, unsigned char* lds) {
    run_partitioned(p, lds, CTL_QUEUE_I3, BT / 512, [&](int part, int it) { peer_v_chunk(p, part, it, lds); });
}
DI void phase_i4(const Params& p) {
    const bool bad = xb_ld((unsigned*)(p.ws + WS_CTL) + CTL_BADTID) != 0u || xb_ld((unsigned*)(p.ws + WS_CTL) + XB_TMO) != 0u;
    for (int it = blockIdx.x; it < BT / 16; it += gridDim.x) {
        const int tid = get_tid(), lane = tid & 63, row = it * 16 + (tid >> 6);
        const float* sq = (const float*)(p.ws + WS_SSQ) + (size_t)row * 8;
        const f32x4 s0 = *(const f32x4*)sq, s1 = *(const f32x4*)(sq + 4);
        const float ss = s0[0] + s0[1] + s0[2] + s0[3] + s1[0] + s1[1] + s1[2] + s1[3];
        float rs = rsqrtf(ss * (1.f / DM) + EPS);
        if (bad) rs = __builtin_nanf("");
        float* o = p.out + (size_t)row * DM;
#pragma unroll
        for (int j = 0; j < 4; ++j) {
            const int c = j * 256 + lane * 4;
            const f32x4 v = *(const f32x4*)(o + c), g = *(const f32x4*)(p.in[I_FNG] + c);
            *(f32x4*)(o + c) = f32x4{v[0] * rs * g[0], v[1] * rs * g[1], v[2] * rs * g[2], v[3] * rs * g[3]};
        }
    }
}

__global__ void __launch_bounds__(NT) mega(Params p) {
    unsigned char* lds = g_lds;
    volatile LAS unsigned* st = (volatile LAS unsigned*)(LAS unsigned char*)(lds + LDS_ST_OFF);
    {
        const unsigned hw = __builtin_amdgcn_s_getreg((5 << 11) | 4);
        if ((threadIdx.x & 63) == 0) g_lds[LDS_WTAB_OFF + hw] = (unsigned char)(threadIdx.x >> 6);
        if (threadIdx.x < 2) st[threadIdx.x] = 0u;
        __syncthreads();
        if (get_tid() != (int)threadIdx.x) ((unsigned*)(p.ws + WS_CTL))[CTL_BADTID] = 1u;
    }
    XcdBarrier bar = xcd_barrier_post((unsigned*)(p.ws + WS_CTL), st);
    float* sm = (float*)lds;

#define STAMP(k, which) do { if (PROBE_PHASE == (k) && blockIdx.x == 0 && get_tid() == 0) ((volatile unsigned long long*)(lds + LDS_PROBE_OFF))[which] = __builtin_amdgcn_s_memrealtime(); } while (0)
    STAMP(0, 0); phase_a(p, sm);   xcd_barrier(bar); STAMP(0, 1);
    STAMP(1, 0); phase_b(p, sm);   xcd_barrier(bar); STAMP(1, 1);
    STAMP(2, 0); phase_c(p, lds);  xcd_barrier(bar); STAMP(2, 1);
    STAMP(3, 0); phase_d<true>(p, lds);  xcd_barrier(bar); STAMP(3, 1);
    STAMP(13, 0); phase_d<false>(p, lds); xcd_barrier(bar); STAMP(13, 1);
    STAMP(4, 0); phase_d2(p, lds); xcd_barrier(bar); STAMP(4, 1);
    STAMP(5, 0); phase_e(p, lds);  xcd_barrier(bar); STAMP(5, 1);
    STAMP(6, 0); phase_f(p, lds);  xcd_barrier(bar); STAMP(6, 1);
    STAMP(7, 0); phase_g(p);       xcd_barrier(bar); STAMP(7, 1);
    STAMP(8, 0); phase_h(p, lds);  xcd_barrier(bar); STAMP(8, 1);
    STAMP(9, 0); phase_i1(p, lds); xcd_barrier(bar); STAMP(9, 1);
    STAMP(10, 0); phase_i2(p, lds); xcd_barrier(bar); STAMP(10, 1);
    STAMP(11, 0); phase_i3(p, lds); xcd_barrier(bar); STAMP(11, 1);
    STAMP(12, 0); phase_i4(p);
    if (PROBE_PHASE >= 0) {
        xcd_barrier(bar); STAMP(12, 1);
        if (blockIdx.x == 0 && get_tid() == 0) {
            volatile unsigned long long* ts = (volatile unsigned long long*)(lds + LDS_PROBE_OFF);
            p.out[0] += (float)(ts[1] - ts[0]) * (0.01f / PROBE_SCALE);
        }
    }
}

extern "C" void kernel_launch(void* const* d_in, const int* in_sizes, int n_in, void* d_out, int out_size, void* d_ws, size_t ws_size, hipStream_t stream) {
    static int grid = 0;
    if (grid == 0) {
        int dev = 0, cus = 0;
        if (hipGetDevice(&dev) != hipSuccess || hipDeviceGetAttribute(&cus, hipDeviceAttributeMultiprocessorCount, dev) != hipSuccess) { fprintf(stderr, "kernel_launch: device query failed\n"); grid = -1; return; }
        if (n_in != N_IN || ws_size < WS_END) { fprintf(stderr, "kernel_launch: unexpected n_in %d or ws_size %zu (< %zu)\n", n_in, ws_size, (size_t)WS_END); grid = -1; return; }
        grid = cus;
    }
    if (grid < 0) return;
    (void)hipMemsetAsync((char*)d_ws + WS_CTL, 0, 64 * 1024, stream);
    Params p{};
    for (int i = 0; i < N_IN; ++i) p.in[i] = (const float*)d_in[i];
    p.out = (float*)d_out; p.ws = (unsigned char*)d_ws;
    hipLaunchKernelGGL(mega, dim3(grid), dim3(NT), 0, stream, p);
}
```

```cpp
#include <hip/hip_runtime.h>
#include <stdint.h>
#include <cstdio>

#define DI __device__ __forceinline__
#define LAS __attribute__((address_space(3)))
typedef unsigned short bf16_t;
typedef short bf16x8 __attribute__((ext_vector_type(8)));
typedef short s16x4 __attribute__((ext_vector_type(4)));
typedef float f32x4 __attribute__((ext_vector_type(4)));
typedef float f32x16 __attribute__((ext_vector_type(16)));
typedef unsigned u32x4 __attribute__((ext_vector_type(4)));
typedef unsigned u32x2 __attribute__((ext_vector_type(2)));

#ifndef PROBE_PHASE
#define PROBE_PHASE (-1)
#endif
#ifndef PROBE_SCALE
#define PROBE_SCALE 100.f
#endif
constexpr int BATCH = 8, SEQ = 4096, DM = 1024, BT = BATCH * SEQ;
constexpr int CTX = 256, TK = SEQ + CTX;
constexpr int NH = 8, NKV = 2, HD = 64;
constexpr int QD = 512, KVD = 128, HYD = 512, HYC = 1536, GC = 2048, INC = 4352;
constexpr int PH = 8, PNK = 128, PDK = 256, PTOP = 16;
constexpr float EPS = 1e-6f;
constexpr int NT = 1024;

enum { I_X = 0, I_C, I_CTX, I_CCTX, I_ADAW, I_ADAB, I_NMIX, I_NFFN, I_WIN, I_QNG, I_KNG, I_HCW, I_HCB,
       I_HW1, I_HB1, I_HW2, I_HB2, I_HW3, I_HB3, I_HW4, I_HFREQ, I_HSKIP, I_WAO, I_WHO, I_WO, I_PWQ, I_PK1, I_PK2, I_PU, I_PV, I_FNG, N_IN };

constexpr size_t MB = 1024 * 1024;
constexpr size_t WS_CTL   = 0;
constexpr size_t WS_MOD   = 64 * 1024;
constexpr size_t WS_ROPE  = WS_MOD + 9 * 6144 * 4;
constexpr size_t WS_PART  = 512 * 1024;
constexpr size_t WS_WTIN  = 3 * MB;
constexpr size_t WS_WTAO  = WS_WTIN + (size_t)INC * DM * 2;
constexpr size_t WS_WTHO  = WS_WTAO + (size_t)DM * QD * 2;
constexpr size_t WS_WTO   = WS_WTHO + (size_t)DM * HYD * 2;
constexpr size_t WS_WTQ   = WS_WTO + (size_t)DM * DM * 2;
constexpr size_t WS_KEYS  = WS_WTQ + (size_t)2048 * DM * 2;
constexpr size_t WS_R     = WS_KEYS + (size_t)2 * 8 * 128 * 128 * 2;
constexpr size_t WS_KB    = WS_R + (size_t)2 * 512 * 8192 * 2;
constexpr size_t WS_VT    = WS_KB + (size_t)BATCH * NKV * TK * HD * 2;
constexpr size_t WS_HC    = WS_VT + (size_t)BATCH * NKV * TK * HD * 2;
constexpr size_t WS_H     = 60 * MB;
constexpr size_t WS_G     = WS_H + 64 * MB;
constexpr size_t WS_ZT    = WS_G + 128 * MB;
constexpr size_t WS_Q     = WS_ZT + 96 * MB;
constexpr size_t WS_ATT   = WS_Q + 32 * MB;
constexpr size_t WS_HYT   = WS_ATT + 32 * MB;
constexpr size_t WS_END   = WS_HYT + 32 * MB;
static_assert(WS_HC + (size_t)2048 * DM * 2 <= WS_H, "ws overlap");
constexpr size_t WS_FRAW  = WS_ATT;
constexpr size_t WS_HY    = WS_Q;
constexpr size_t WS_UT    = WS_ZT;
constexpr size_t WS_VTAB  = WS_ZT + 32 * MB;
constexpr size_t WS_EXPI  = WS_ATT;
constexpr size_t WS_GATE  = WS_ATT + 16 * MB;
constexpr size_t WS_PAIRS = WS_HYT;
constexpr size_t WS_SSQ   = WS_Q;
constexpr float USCALE = 256.f, VSCALE = 64.f;

constexpr int CTL_BADTID = 8000;
DI unsigned f2bf(float f) { unsigned u = __builtin_bit_cast(unsigned, f); return (u + 0x7fffu + ((u >> 16) & 1u)) >> 16; }
DI unsigned pk2(float lo, float hi) { return f2bf(lo) | (f2bf(hi) << 16); }
DI float bf2f(unsigned short b) { return __builtin_bit_cast(float, (unsigned)b << 16); }
DI float bflo(unsigned u) { return __builtin_bit_cast(float, u << 16); }
DI float bfhi(unsigned u) { return __builtin_bit_cast(float, u & 0xffff0000u); }
DI float red2pi(float x) { const float k = rintf(x * 0.15915494309189535f); float r = fmaf(-k, 6.2831854820251465f, x); return fmaf(-k, -1.7484555e-7f, r); }
DI float fsin(float x) { return __sinf(red2pi(x)); }
DI float fcos(float x) { return __cosf(red2pi(x)); }
constexpr int LDS_BYTES = 160 * 1024;
constexpr int LDS_ST_OFF = LDS_BYTES - 16;
constexpr int LDS_PROBE_OFF = LDS_BYTES - 16 - 32;
constexpr int LDS_WTAB_OFF = LDS_BYTES - 16 - 32 - 64;
constexpr int LDS_USER = LDS_WTAB_OFF;
__shared__ __attribute__((aligned(16))) unsigned char g_lds[LDS_BYTES];
DI s16x4 lds_rd64(const unsigned char* ptr) { return *(const volatile LAS s16x4*)(const LAS unsigned char*)ptr; }
DI int get_tid() {
    const unsigned hw = __builtin_amdgcn_s_getreg((5 << 11) | 4);
    unsigned w = g_lds[LDS_WTAB_OFF + hw];
    w = __builtin_amdgcn_readfirstlane(w);
    int t;
    asm volatile("v_mbcnt_lo_u32_b32 %0, -1, 0\n\tv_mbcnt_hi_u32_b32 %0, -1, %0\n\tv_lshl_or_b32 %0, %1, 6, %0" : "=&v"(t) : "s"(w));
    return t;
}
template<int CTRL> DI float dppf(float v) { return __uint_as_float(__builtin_amdgcn_update_dpp(0u, __float_as_uint(v), CTRL, 0xF, 0xF, true)); }
DI float sum16(float v) { v += dppf<0xB1>(v); v += dppf<0x4E>(v); v += dppf<0x141>(v); v += dppf<0x140>(v); return v; }
DI float sum_x16(float v) { auto r = __builtin_amdgcn_permlane16_swap(__float_as_uint(v), __float_as_uint(v), false, false); return __uint_as_float(r[0]) + __uint_as_float(r[1]); }
DI float sum_x32(float v) { auto r = __builtin_amdgcn_permlane32_swap(__float_as_uint(v), __float_as_uint(v), false, false); return __uint_as_float(r[0]) + __uint_as_float(r[1]); }
DI float max_x32(float v) { auto r = __builtin_amdgcn_permlane32_swap(__float_as_uint(v), __float_as_uint(v), false, false); return fmaxf(__uint_as_float(r[0]), __uint_as_float(r[1])); }
DI float wave_sum(float v) { return sum_x32(sum_x16(sum16(v))); }

#define XB_TMO      128
#define XB_XCNT(j)  (256  + 64 * (j))
#define XB_XSUB(j)  (1280 + 64 * (j))
#define XB_XGEN(j)  (2304 + 64 * (j))
#define XB_TOP      3328
#define XB_TOPGEN   3392
#define XCD_BAR_WORDS 3456
#define XB_SPIN_CAP (1u << 27)
DI unsigned xb_ld(unsigned* p)              { return __hip_atomic_load(p, __ATOMIC_RELAXED, __HIP_MEMORY_SCOPE_AGENT); }
DI unsigned xb_add(unsigned* p, unsigned v) { return __hip_atomic_fetch_add(p, v, __ATOMIC_RELAXED, __HIP_MEMORY_SCOPE_AGENT); }
DI unsigned xb_xcc_id() { return (unsigned)__builtin_amdgcn_s_getreg((3 << 11) | 20) & 0xFu; }
#define XB_SPIN(cond, bar) do { unsigned _sp = 0; while (cond) { __builtin_amdgcn_s_sleep(1); \
    if ((++_sp & 255u) == 0u) { if (xb_ld(&(bar)[XB_TMO])) break; if (_sp > XB_SPIN_CAP) { atomicAdd(&(bar)[XB_TMO], 1u); break; } } } } while (0)
struct XcdBarrier { unsigned* bar; unsigned x; volatile LAS unsigned* st; };
DI XcdBarrier xcd_barrier_post(unsigned* bar, volatile LAS unsigned* st) {
    XcdBarrier b; b.bar = bar; b.x = xb_xcc_id(); b.st = st;
    if (get_tid() == 0) (void)xb_add(&bar[XB_XCNT(b.x)], 1u);
    return b;
}
DI void xcd_barrier_complete(unsigned* bar, unsigned x, unsigned& nloc, unsigned& nx) {
    const unsigned G = gridDim.x * gridDim.y * gridDim.z;
    unsigned sum, cnt, mine, sp = 0u;
    for (;;) {
        sum = 0u; cnt = 0u; mine = 0u;
#pragma unroll
        for (unsigned j = 0; j < 16; ++j) { const unsigned c = xb_ld(&bar[XB_XCNT(j)]); sum += c; cnt += (c > 0u) ? 1u : 0u; mine = (j == x) ? c : mine; }
        if (sum == G) break;
        __builtin_amdgcn_s_sleep(1);
        if ((++sp & 255u) == 0u) { if (xb_ld(&bar[XB_TMO])) break; if (sp > XB_SPIN_CAP) { atomicAdd(&bar[XB_TMO], 1u); break; } }
    }
    nloc = mine > 0u ? mine : 1u; nx = cnt > 0u ? cnt : 1u;
}
DI void xcd_barrier(const XcdBarrier& b) {
    asm volatile("s_waitcnt vmcnt(0)" ::: "memory");
    __syncthreads();
    if (get_tid() == 0) {
        unsigned* bar = b.bar;
        __builtin_amdgcn_s_waitcnt(0);
        unsigned nloc = b.st[0], nx = b.st[1];
        if (nloc == 0u) { xcd_barrier_complete(bar, b.x, nloc, nx); b.st[0] = nloc; b.st[1] = nx; }
        const unsigned old = xb_add(&bar[XB_XSUB(b.x)], 1u);
        const unsigned gen = old / nloc;
        if (old + 1u == (gen + 1u) * nloc) {
            __builtin_amdgcn_fence(__ATOMIC_RELEASE, "agent");
            asm volatile("s_waitcnt vmcnt(0)" ::: "memory");
            const unsigned og = xb_add(&bar[XB_TOP], 1u);
            const unsigned tg = og / nx;
            if (og + 1u == (tg + 1u) * nx) xb_add(&bar[XB_TOPGEN], 1u);
            else XB_SPIN(xb_ld(&bar[XB_TOPGEN]) == tg, bar);
            __builtin_amdgcn_fence(__ATOMIC_ACQUIRE, "agent");
            xb_add(&bar[XB_XGEN(b.x)], 1u);
            asm volatile("s_waitcnt vmcnt(0)" ::: "memory");
        } else {
            XB_SPIN(xb_ld(&bar[XB_XGEN(b.x)]) == gen, bar);
            __builtin_amdgcn_fence(__ATOMIC_ACQUIRE, "agent");
            asm volatile("s_waitcnt vmcnt(0)" ::: "memory");
        }
    }
    __syncthreads();
}

struct Params { const float* in[N_IN]; float* out; unsigned char* ws; };


DI void transpose_tile(const float* __restrict__ W, int K, int N, bf16_t* __restrict__ Wt, int tile, float* sm) {
    const int tid = get_tid();
    const int ntn = N / 64, tk = tile / ntn, tn = tile % ntn;
#pragma unroll
    for (int i = 0; i < 4; ++i) {
        const int idx = tid + i * NT, kk = idx >> 6, nn = idx & 63;
        sm[kk * 65 + nn] = W[(size_t)(tk * 64 + kk) * N + tn * 64 + nn];
    }
    __syncthreads();
#pragma unroll
    for (int i = 0; i < 2; ++i) {
        const int idx = tid + i * NT, nn = idx >> 5, kp = (idx & 31) * 2;
        const unsigned v = pk2(sm[kp * 65 + nn], sm[(kp + 1) * 65 + nn]);
        *(unsigned*)(Wt + (size_t)(tn * 64 + nn) * K + tk * 64 + kp) = v;
    }
    __syncthreads();
}

DI void mod_item(const Params& p, int item, float* sm) {
    const int tid = get_tid();
    float* sc = sm;
    float* red = sm + 9 * 1024;
    for (int i = tid; i < 9 * 1024; i += NT) {
        const float v = (i < 8 * 1024) ? p.in[I_C][i] : p.in[I_CCTX][i - 8 * 1024];
        sc[i] = v / (1.f + __expf(-v));
    }
    __syncthreads();
    const int col = tid & 63, kg = tid >> 6, n0 = item * 64;
    float acc[9];
#pragma unroll
    for (int r = 0; r < 9; ++r) acc[r] = 0.f;
    const float* w = p.in[I_ADAW] + n0 + col;
#pragma unroll 8
    for (int k = kg * 64; k < kg * 64 + 64; ++k) {
        const float wv = w[(size_t)k * 6144];
#pragma unroll
        for (int r = 0; r < 9; ++r) acc[r] += sc[r * 1024 + k] * wv;
    }
#pragma unroll
    for (int r = 0; r < 9; ++r) red[(kg * 9 + r) * 64 + col] = acc[r];
    __syncthreads();
    if (tid < 9 * 64) {
        const int r = tid >> 6, c2 = tid & 63;
        float s = p.in[I_ADAB][n0 + c2];
#pragma unroll
        for (int g = 0; g < 16; ++g) s += red[(g * 9 + r) * 64 + c2];
        ((float*)(p.ws + WS_MOD))[r * 6144 + n0 + c2] = s;
    }
    __syncthreads();
}

DI void filter_item(const Params& p, int item, float* sm) {
    const int tid = get_tid();
    float* z  = sm;
    float* ha = sm + 16 * 36;
    float* hb = ha + 16 * 64;
    const int t0 = item * 16;
    if (tid < 16 * 33) {
        const int pp = tid / 33, i = tid % 33;
        const int t = t0 + pp;
        float v;
        if (i == 0) v = (float)t / (float)(SEQ - 1);
        else {
            const int fi = (i - 1) & 15;
            const float f = 1e-4f + (float)fi * ((15.f - 1e-4f) / 15.f);
            const float w = 6.283185307179586f * (float)t / (float)SEQ;
            const float a = f * w;
            v = (i <= 16) ? fcos(a) : -fsin(a);
        }
        z[pp * 36 + i] = v;
    }
    __syncthreads();
    const int pp = tid >> 6, j = tid & 63;
    const float fr = p.in[I_HFREQ][j];
    {
        float a = p.in[I_HB1][j];
        const float* w1 = p.in[I_HW1];
#pragma unroll 11
        for (int i = 0; i < 33; ++i) a += z[pp * 36 + i] * w1[i * 64 + j];
        ha[pp * 64 + j] = fsin(fr * a);
    }
    __syncthreads();
    {
        float a = p.in[I_HB2][j];
        const float* w2 = p.in[I_HW2];
#pragma unroll 8
        for (int i = 0; i < 64; ++i) a += ha[pp * 64 + i] * w2[i * 64 + j];
        hb[pp * 64 + j] = fsin(fr * a);
    }
    __syncthreads();
    {
        float a = p.in[I_HB3][j];
        const float* w3 = p.in[I_HW3];
#pragma unroll 8
        for (int i = 0; i < 64; ++i) a += hb[pp * 64 + i] * w3[i * 64 + j];
        __syncthreads();
        ha[pp * 64 + j] = fsin(fr * a);
    }
    __syncthreads();
    float* fraw = (float*)(p.ws + WS_FRAW);
    float* part = (float*)(p.ws + WS_PART);
    const float* w4 = p.in[I_HW4];
#pragma unroll 1
    for (int cc = 0; cc < 2; ++cc) {
        const int col = tid + cc * NT;
        float acc[16];
#pragma unroll
        for (int q = 0; q < 16; ++q) acc[q] = 0.f;
#pragma unroll 4
        for (int i = 0; i < 64; ++i) {
            const float wv = w4[i * 2048 + col];
#pragma unroll
            for (int q = 0; q < 16; ++q) acc[q] += ha[q * 64 + i] * wv;
        }
        const int c = col & 511, dir = (col >> 9) & 1;
        const float mind = -3.0701134573253945f, maxd = -15.350567286626973f;
        const float delta = fabsf(mind + (float)c * ((maxd - mind) / 511.f));
        float s = 0.f;
#pragma unroll
        for (int q = 0; q < 16; ++q) {
            const int t = t0 + q;
            const float t01 = (float)t / (float)(SEQ - 1);
            const float v = acc[q] * expf(-t01 * delta);
            acc[q] = v;
            if (!(dir == 1 && t == 0)) s += fabsf(v);
        }
        float* dst = fraw + (size_t)col * SEQ + t0;
#pragma unroll
        for (int q = 0; q < 16; q += 4) *(f32x4*)(dst + q) = f32x4{acc[q], acc[q + 1], acc[q + 2], acc[q + 3]};
        part[item * 2048 + col] = s;
    }
    __syncthreads();
}

DI void phase_a(const Params& p, float* sm) {
    constexpr int T_WIN = 16 * 68, T_AO = 8 * 16, T_HO = 8 * 16, T_WO = 16 * 16, T_WQ = 16 * 32;
    constexpr int E0 = T_WIN, E1 = E0 + T_AO, E2 = E1 + T_HO, E3 = E2 + T_WO, E4 = E3 + T_WQ;
    constexpr int E5 = E4 + 64;
    constexpr int E6 = E5 + 96;
    constexpr int E7 = E6 + 1;
    constexpr int E8 = E7 + 256;
    for (int it = blockIdx.x; it < E8; it += gridDim.x) {
        int item = it;
        if (item < 256) { filter_item(p, item, sm); continue; }
        item -= 256;
        if (item < 96) { mod_item(p, item, sm); continue; }
        item -= 96;
        if (item < 1) {
            const int tid = get_tid();
            float* rope = (float*)(p.ws + WS_ROPE);
            const int pos = tid >> 4, f = tid & 15;
            const float inv = powf(10000.f, -(float)(2 * f) / 32.f);
            const float ang = (float)pos * inv;
            rope[tid] = fcos(ang); rope[1024 + tid] = fsin(ang);
            continue;
        }
        item -= 1;
        if (item < 64) {
            const int tid = get_tid();
            const float* src = (item < 32) ? p.in[I_PK1] : p.in[I_PK2];
            bf16_t* dst = (bf16_t*)(p.ws + WS_KEYS) + (size_t)item * 4096;
            const f32x4 v = *(const f32x4*)(src + (size_t)(item & 31) * 4096 + tid * 4);
            *(u32x2*)(dst + tid * 4) = u32x2{pk2(v[0], v[1]), pk2(v[2], v[3])};
            continue;
        }
        item -= 64;
        if (item < T_WIN) { transpose_tile(p.in[I_WIN], DM, INC, (bf16_t*)(p.ws + WS_WTIN), item, sm); continue; }
        item -= T_WIN;
        if (item < T_AO) { transpose_tile(p.in[I_WAO], QD, DM, (bf16_t*)(p.ws + WS_WTAO), item, sm); continue; }
        item -= T_AO;
        if (item < T_HO) { transpose_tile(p.in[I_WHO], HYD, DM, (bf16_t*)(p.ws + WS_WTHO), item, sm); continue; }
        item -= T_HO;
        if (item < T_WO) { transpose_tile(p.in[I_WO], DM, DM, (bf16_t*)(p.ws + WS_WTO), item, sm); continue; }
        item -= T_WO;
        transpose_tile(p.in[I_PWQ], DM, 2048, (bf16_t*)(p.ws + WS_WTQ), item, sm);
    }
    (void)E1; (void)E2; (void)E3; (void)E4; (void)E5; (void)E6; (void)E7;
}

DI void norm_mod_row(const float* __restrict__ src, const float* __restrict__ g, const float* __restrict__ shift, const float* __restrict__ scale, bf16_t* __restrict__ dst) {
    const int lane = get_tid() & 63;
    f32x4 v[4];
    float ss = 0.f;
#pragma unroll
    for (int j = 0; j < 4; ++j) { v[j] = *(const f32x4*)(src + j * 256 + lane * 4); ss += v[j][0] * v[j][0] + v[j][1] * v[j][1] + v[j][2] * v[j][2] + v[j][3] * v[j][3]; }
    ss = wave_sum(ss);
    const float rs = rsqrtf(ss * (1.f / DM) + EPS);
#pragma unroll
    for (int j = 0; j < 4; ++j) {
        const int c = j * 256 + lane * 4;
        const f32x4 gg = *(const f32x4*)(g + c), sh = *(const f32x4*)(shift + c), sc = *(const f32x4*)(scale + c);
        float o[4];
#pragma unroll
        for (int e = 0; e < 4; ++e) o[e] = v[j][e] * rs * gg[e] * (1.f + sc[e]) + sh[e];
        *(u32x2*)(dst + c) = u32x2{pk2(o[0], o[1]), pk2(o[2], o[3])};
    }
}

DI void filter_norm_item(const Params& p, int item, float* sm) {
    const int tid = get_tid();
    const int o = item >> 9, c = item & 511;
    const int colf = o * 1024 + c, colb = colf + 512;
    const float* part = (const float*)(p.ws + WS_PART);
    float s = 0.f;
    if (tid < 512) s = part[(tid & 255) * 2048 + ((tid < 256) ? colf : colb)];
    s = wave_sum(s);
    if ((tid & 63) == 0) sm[tid >> 6] = s;
    __syncthreads();
    float tot = EPS;
#pragma unroll
    for (int i = 0; i < 8; ++i) tot += sm[i];
    const float inv = 1.f / tot;
    const float* fraw = (const float*)(p.ws + WS_FRAW);
    bf16_t* R = (bf16_t*)(p.ws + WS_R) + (size_t)item * 8192;
#pragma unroll
    for (int i = 0; i < 4; ++i) {
        const int n = (tid + i * NT) * 2;
        float v0, v1;
        if (n < 4096) { v0 = (n == 0) ? 0.f : fraw[(size_t)colf * SEQ + 4096 - n]; v1 = fraw[(size_t)colf * SEQ + 4095 - n]; }
        else if (n == 4096) { v0 = fraw[(size_t)colf * SEQ]; v1 = fraw[(size_t)colb * SEQ + 1]; }
        else { v0 = fraw[(size_t)colb * SEQ + n - 4096]; v1 = fraw[(size_t)colb * SEQ + n - 4095]; }
        *(unsigned*)(R + n) = pk2(v0 * inv, v1 * inv);
    }
    __syncthreads();
}

DI void phase_b(const Params& p, float* sm) {
    const int wave = get_tid() >> 6;
    const float* mod = (const float*)(p.ws + WS_MOD);
    constexpr int ROW_ITEMS = (BT + BATCH * CTX) / 16;
    for (int it = blockIdx.x; it < ROW_ITEMS + 1024; it += gridDim.x) {
        if (it < 1024) { filter_norm_item(p, it, sm); continue; }
        const int row = (it - 1024) * 16 + wave;
        if (row < BT) {
            const int b = row >> 12;
            norm_mod_row(p.in[I_X] + (size_t)row * DM, p.in[I_NMIX], mod + b * 6144, mod + b * 6144 + 1024, (bf16_t*)(p.ws + WS_H) + (size_t)row * DM);
        } else {
            const int r = row - BT;
            norm_mod_row(p.in[I_CTX] + (size_t)r * DM, p.in[I_NMIX], mod + 8 * 6144, mod + 8 * 6144 + 1024, (bf16_t*)(p.ws + WS_HC) + (size_t)r * DM);
        }
    }
}

#define MFMA16(a, b, c) __builtin_amdgcn_mfma_f32_16x16x32_bf16((a), (b), (c), 0, 0, 0)
constexpr int GT_P = 256 * 128;
struct RowLoader {
    const bf16_t* base; int ld;
    template<int ROWS> DI void issue(unsigned char* tile, int kt, int lane, int wave) const {
#pragma unroll
        for (int i = 0; i < ROWS / 128; ++i) {
            const int grp = i * 16 + wave, row = grp * 8 + (lane >> 3), c = (lane & 7) ^ (lane >> 3);
            __builtin_amdgcn_global_load_lds((const unsigned*)(base + (size_t)row * ld + kt * 64 + c * 8), (unsigned*)(tile + grp * 1024), 16, 0, 0);
        }
    }
};

template<int NQ>
DI void gemm_mainloop(f32x4 (&acc)[4][NQ], const RowLoader& lp, const RowLoader& lq, int nk, unsigned char* lds) {
    const int tid = get_tid(), lane = tid & 63, wave = __builtin_amdgcn_readfirstlane(tid >> 6), wp = wave >> 2, wq = wave & 3;
    constexpr int QROWS = NQ * 64;
    constexpr int STAGE = GT_P + QROWS * 128;
    __syncthreads();
    lp.template issue<256>(lds, 0, lane, wave); lq.template issue<QROWS>(lds + GT_P, 0, lane, wave);
    asm volatile("s_waitcnt vmcnt(0)" ::: "memory");
    __syncthreads();
    const int l15 = lane & 15, lk = lane >> 4;
    for (int kt = 0; kt < nk; ++kt) {
        unsigned char* cur = lds + (kt & 1) * STAGE;
        unsigned char* nxt = lds + ((kt + 1) & 1) * STAGE;
        if (kt + 1 < nk) { lp.template issue<256>(nxt, kt + 1, lane, wave); lq.template issue<QROWS>(nxt + GT_P, kt + 1, lane, wave); }
#pragma unroll
        for (int ks = 0; ks < 2; ++ks) {
            bf16x8 fp[4], fq[NQ];
#pragma unroll
            for (int i = 0; i < 4; ++i) { const int row = wp * 64 + i * 16 + l15; fp[i] = *(const bf16x8*)(cur + row * 128 + (((ks * 4 + lk) ^ (row & 7)) << 4)); }
#pragma unroll
            for (int j = 0; j < NQ; ++j) { const int row = wq * (16 * NQ) + j * 16 + l15; fq[j] = *(const bf16x8*)(cur + GT_P + row * 128 + (((ks * 4 + lk) ^ (row & 7)) << 4)); }
#pragma unroll
            for (int i = 0; i < 4; ++i)
#pragma unroll
                for (int j = 0; j < NQ; ++j) acc[i][j] = MFMA16(fp[i], fq[j], acc[i][j]);
        }
        asm volatile("s_waitcnt vmcnt(0)" ::: "memory");
        __syncthreads();
    }
}

DI void head_epilogue(f32x4 (&acc)[4][4], const float* __restrict__ g, float gscale, const float* __restrict__ rope, bool do_rope, int t_base  , bf16_t* __restrict__ dst  , int lane) {
    const int l15 = lane & 15, lk = lane >> 4;
    float gg[4];
#pragma unroll
    for (int j = 0; j < 4; ++j) gg[j] = g[j * 16 + l15] * gscale;
#pragma unroll
    for (int i = 0; i < 4; ++i) {
#pragma unroll
        for (int r = 0; r < 4; ++r) {
            float ss = 0.f;
#pragma unroll
            for (int j = 0; j < 4; ++j) ss += acc[i][j][r] * acc[i][j][r];
            ss = sum16(ss);
            const float rs = rsqrtf(ss * (1.f / 64.f) + EPS);
            float v[4];
#pragma unroll
            for (int j = 0; j < 4; ++j) v[j] = acc[i][j][r] * rs * gg[j];
            const int t = t_base + i * 16 + lk * 4 + r;
            if (do_rope) {
                const int prow = (t >> 6) & 63, pcol = t & 63;
                const float c0 = rope[prow * 16 + l15], s0 = rope[1024 + prow * 16 + l15];
                const float c1 = rope[pcol * 16 + l15], s1 = rope[1024 + pcol * 16 + l15];
                const float a0 = v[0] * c0 - v[1] * s0, a1 = v[1] * c0 + v[0] * s0;
                const float a2 = v[2] * c1 - v[3] * s1, a3 = v[3] * c1 + v[2] * s1;
                v[0] = a0; v[1] = a1; v[2] = a2; v[3] = a3;
            }
            bf16_t* d = dst + (size_t)(i * 16 + lk * 4 + r) * 64 + l15;
#pragma unroll
            for (int j = 0; j < 4; ++j) d[j * 16] = (bf16_t)f2bf(v[j]);
        }
    }
}
DI void tstore_epilogue(f32x4 (&acc)[4][4], bf16_t* __restrict__ dst  , size_t ld, int lane) {
    const int l15 = lane & 15, lk = lane >> 4;
#pragma unroll
    for (int i = 0; i < 4; ++i)
#pragma unroll
        for (int j = 0; j < 4; ++j)
            *(u32x2*)(dst + (size_t)(j * 16 + l15) * ld + i * 16 + lk * 4) = u32x2{pk2(acc[i][j][0], acc[i][j][1]), pk2(acc[i][j][2], acc[i][j][3])};
}

DI void phase_c(const Params& p, unsigned char* lds) {
    constexpr int NTM = BT / 256, NTN = INC / 256;
    constexpr int MAIN = NTM * NTN, TOTAL = MAIN + 8;
    const bf16_t* H = (const bf16_t*)(p.ws + WS_H);
    const bf16_t* HCp = (const bf16_t*)(p.ws + WS_HC);
    const bf16_t* WT = (const bf16_t*)(p.ws + WS_WTIN);
    const float* rope = (const float*)(p.ws + WS_ROPE);
    for (int it = blockIdx.x; it < TOTAL; it += gridDim.x) {
        const int tid = get_tid(), lane = tid & 63, wave = tid >> 6, wa = wave >> 2, wb = wave & 3;
        int tm, tn; bool ctx = false;
        if (it < MAIN) { const int g = it / (16 * NTN), rem = it % (16 * NTN); tn = rem >> 4; tm = g * 16 + (rem & 15); }
        else { ctx = true; tm = it - MAIN; tn = 2; }
        const bf16_t* A = ctx ? HCp + (size_t)tm * 256 * DM : H + (size_t)tm * 256 * DM;
        const bf16_t* W = WT + (size_t)tn * 256 * DM;
        f32x4 acc[4][4];
#pragma unroll
        for (int i = 0; i < 4; ++i)
#pragma unroll
            for (int j = 0; j < 4; ++j) acc[i][j] = f32x4{0.f, 0.f, 0.f, 0.f};
        if (tn >= 9) {
            gemm_mainloop<4>(acc, RowLoader{W, DM}, RowLoader{A, DM}, DM / 64, lds);
            bf16_t* G = (bf16_t*)(p.ws + WS_G);
            const int l15 = lane & 15, lk = lane >> 4;
#pragma unroll
            for (int i = 0; i < 4; ++i)
#pragma unroll
                for (int j = 0; j < 4; ++j) {
                    const int n = tn * 256 - 2304 + wa * 64 + i * 16 + lk * 4;
                    const int tok = tm * 256 + wb * 64 + j * 16 + l15;
                    float sg[4];
#pragma unroll
                    for (int r = 0; r < 4; ++r) sg[r] = 1.f / (1.f + __expf(-acc[i][j][r]));
                    *(u32x2*)(G + (size_t)tok * GC + n) = u32x2{pk2(sg[0], sg[1]), pk2(sg[2], sg[3])};
                }
            continue;
        }
        gemm_mainloop<4>(acc, RowLoader{A, DM}, RowLoader{W, DM}, DM / 64, lds);
        const int b = ctx ? tm : (tm >> 4);
        const int tpos = ctx ? SEQ + wa * 64 : ((tm & 15) * 256 + wa * 64);
        if (tn < 2) {
            const int h = tn * 4 + wb;
            bf16_t* Q = (bf16_t*)(p.ws + WS_Q) + ((size_t)(b * NH + h) * SEQ + tpos) * HD;
            head_epilogue(acc, p.in[I_QNG], 0.125f * 1.4426950408889634f, rope, true, tpos, Q, lane);
        } else if (tn == 2) {
            if (wb < 2) {
                bf16_t* K = (bf16_t*)(p.ws + WS_KB) + ((size_t)(b * NKV + wb) * TK + tpos) * HD;
                head_epilogue(acc, p.in[I_KNG], 1.f, rope, !ctx, tpos, K, lane);
            } else {
                bf16_t* V = (bf16_t*)(p.ws + WS_VT) + (size_t)(b * NKV + (wb - 2)) * HD * TK + tpos;
                tstore_epilogue(acc, V, TK, lane);
            }
        } else {
            const int col = tn * 256 - 768 + wb * 64;
            bf16_t* Z = (bf16_t*)(p.ws + WS_ZT) + (size_t)col * BT + (size_t)b * SEQ + tpos;
            tstore_epilogue(acc, Z, BT, lane);
        }
    }
}

#define MFMA32(a, b, c) __builtin_amdgcn_mfma_f32_32x32x16_bf16((a), (b), (c), 0, 0, 0)
DI bf16x8 pack_step(const f32x16& x, int s) {
    u32x4 pk;
    asm volatile("v_cvt_pk_bf16_f32 %0, %4, %5\n\tv_cvt_pk_bf16_f32 %1, %6, %7\n\tv_cvt_pk_bf16_f32 %2, %8, %9\n\tv_cvt_pk_bf16_f32 %3, %10, %11\n\ts_nop 1"
                 : "=&v"(pk[0]), "=&v"(pk[1]), "=&v"(pk[2]), "=&v"(pk[3])
                 : "v"(x[8 * s]), "v"(x[8 * s + 1]), "v"(x[8 * s + 2]), "v"(x[8 * s + 3]), "v"(x[8 * s + 4]), "v"(x[8 * s + 5]), "v"(x[8 * s + 6]), "v"(x[8 * s + 7]));
    return __builtin_bit_cast(bf16x8, pk);
}

constexpr int AT_KSTR = 144, AT_VSTR = 136, AT_VOFF = 64 * AT_KSTR, AT_STAGE = AT_VOFF + 64 * AT_VSTR;
DI void attn_item(const Params& p, int item, unsigned char* lds) {
    const int tid = get_tid(), lane = tid & 63, wave = tid >> 6;
    const int b = item >> 6, kvh = (item >> 5) & 1, qb = item & 31;
    const int h = kvh * 4 + (wave >> 2), q0 = qb * 128 + (wave & 3) * 32;
    const int qi = lane & 31, hf = lane >> 5;
    const bf16_t* Qp = (const bf16_t*)(p.ws + WS_Q) + ((size_t)(b * NH + h) * SEQ + q0 + qi) * HD;
    bf16x8 qf[4];
#pragma unroll
    for (int s = 0; s < 4; ++s) qf[s] = *(const bf16x8*)(Qp + 16 * s + 8 * hf);
    const bf16_t* Kg = (const bf16_t*)(p.ws + WS_KB) + (size_t)(b * NKV + kvh) * TK * HD;
    const bf16_t* Vg = (const bf16_t*)(p.ws + WS_VT) + (size_t)(b * NKV + kvh) * HD * TK;
    const bool isK = tid < 512;
    const int li = tid & 511, lrow = li >> 3, lc = li & 7;
    const bf16_t* src = isK ? Kg + (size_t)lrow * HD + lc * 8 : Vg + (size_t)lrow * TK + lc * 8;
    const size_t sstep = isK ? (size_t)64 * HD : 64;
    const int ldst = isK ? lrow * AT_KSTR + lc * 16 : AT_VOFF + lrow * AT_VSTR + lc * 16;
    constexpr int NTILE = TK / 64;
    f32x16 o0, o1;
#pragma unroll
    for (int i = 0; i < 16; ++i) { o0[i] = 0.f; o1[i] = 0.f; }
    float l = 0.f;
    __syncthreads();
    constexpr int NSUB = 4, NSTG = NTILE / NSUB;
    static_assert(NTILE % NSUB == 0 && 2 * NSUB * AT_STAGE <= LDS_USER, "attention LDS stages");
    u32x4 stg[NSUB];
#pragma unroll
    for (int j = 0; j < NSUB; ++j) stg[j] = *(const u32x4*)(src + (size_t)j * sstep);
#pragma unroll
    for (int j = 0; j < NSUB; ++j) { unsigned char* d = lds + j * AT_STAGE + ldst; *(u32x2*)d = u32x2{stg[j][0], stg[j][1]}; *(u32x2*)(d + 8) = u32x2{stg[j][2], stg[j][3]}; }
    __syncthreads();
    const int koff = qi * AT_KSTR + hf * 16;
    const int voff = AT_VOFF + qi * AT_VSTR + hf * 8;
    for (int st = 0; st < NSTG; ++st) {
      const bool more = st + 1 < NSTG;
      if (more) {
#pragma unroll
          for (int j = 0; j < NSUB; ++j) stg[j] = *(const u32x4*)(src + (size_t)((st + 1) * NSUB + j) * sstep);
      }
#pragma unroll 1
      for (int j = 0; j < NSUB; ++j) {
        const unsigned char* cur = lds + ((st & 1) * NSUB + j) * AT_STAGE;
        f32x16 sA, sB;
#pragma unroll
        for (int i = 0; i < 16; ++i) { sA[i] = 0.f; sB[i] = 0.f; }
#pragma unroll
        for (int s = 0; s < 4; ++s) sA = MFMA32(*(const bf16x8*)(cur + koff + s * 32), qf[s], sA);
#pragma unroll
        for (int s = 0; s < 4; ++s) sB = MFMA32(*(const bf16x8*)(cur + koff + 32 * AT_KSTR + s * 32), qf[s], sB);
        float ps = 0.f;
#pragma unroll
        for (int kb = 0; kb < 2; ++kb) {
            f32x16& sx = kb ? sB : sA;
#pragma unroll
            for (int i = 0; i < 16; ++i) { sx[i] = __builtin_amdgcn_exp2f(sx[i]); ps += sx[i]; }
#pragma unroll
            for (int s2 = 0; s2 < 2; ++s2) {
                const bf16x8 pf = pack_step(sx, s2);
#pragma unroll
                for (int db = 0; db < 2; ++db) {
                    const unsigned char* vb = cur + voff + db * 32 * AT_VSTR + (4 * kb + 2 * s2) * 16;
                    const s16x4 lo = lds_rd64(vb);
                    const s16x4 hi = lds_rd64(vb + 16);
                    const bf16x8 vf = __builtin_shufflevector(lo, hi, 0, 1, 2, 3, 4, 5, 6, 7);
                    if (db == 0) o0 = MFMA32(vf, pf, o0); else o1 = MFMA32(vf, pf, o1);
                }
            }
        }
        l += ps;
      }
      if (more) {
#pragma unroll
          for (int j = 0; j < NSUB; ++j) { unsigned char* d = lds + (((st + 1) & 1) * NSUB + j) * AT_STAGE + ldst; *(u32x2*)d = u32x2{stg[j][0], stg[j][1]}; *(u32x2*)(d + 8) = u32x2{stg[j][2], stg[j][3]}; }
      }
      __syncthreads();
    }
    l = sum_x32(l);
    const float inv = 1.f / l;
    bf16_t* O;
    {
        const int t2 = get_tid(), lane2 = t2 & 63, wave2 = t2 >> 6;
        const int h2 = kvh * 4 + (wave2 >> 2), q2 = qb * 128 + (wave2 & 3) * 32 + (lane2 & 31);
        O = (bf16_t*)(p.ws + WS_ATT) + ((size_t)b * SEQ + q2) * QD + h2 * HD + 4 * (lane2 >> 5);
    }
#pragma unroll
    for (int g4 = 0; g4 < 4; ++g4) {
        *(u32x2*)(O + 8 * g4)      = u32x2{pk2(o0[4 * g4] * inv, o0[4 * g4 + 1] * inv), pk2(o0[4 * g4 + 2] * inv, o0[4 * g4 + 3] * inv)};
        *(u32x2*)(O + 32 + 8 * g4) = u32x2{pk2(o1[4 * g4] * inv, o1[4 * g4 + 1] * inv), pk2(o1[4 * g4 + 2] * inv, o1[4 * g4 + 3] * inv)};
    }
}

constexpr int HY_USTR = 8208, HY_R = 8 * HY_USTR, HY_RSTR = 16384 + 64;
DI void hy_load_filter(const bf16_t* __restrict__ R, unsigned char* lds, int tid) {
    const int i0 = tid * 8;
    const u32x4 w = *(const u32x4*)(R + i0);
    u32x2 nx = u32x2{0u, 0u};
    if (i0 + 8 < 8192) nx = *(const u32x2*)(R + i0 + 8);
    unsigned char* d = lds + HY_R + i0 * 2;
    *(u32x4*)(d) = w;
    *(u32x4*)(d + HY_RSTR) = u32x4{__builtin_amdgcn_alignbit(w[1], w[0], 16), __builtin_amdgcn_alignbit(w[2], w[1], 16), __builtin_amdgcn_alignbit(w[3], w[2], 16), __builtin_amdgcn_alignbit(nx[0], w[3], 16)};
    *(u32x4*)(d + 2 * HY_RSTR) = u32x4{w[1], w[2], w[3], nx[0]};
    *(u32x4*)(d + 3 * HY_RSTR) = u32x4{__builtin_amdgcn_alignbit(w[2], w[1], 16), __builtin_amdgcn_alignbit(w[3], w[2], 16), __builtin_amdgcn_alignbit(nx[0], w[3], 16), __builtin_amdgcn_alignbit(nx[1], nx[0], 16)};
}
DI void short_conv4(const bf16_t* __restrict__ zrow  , int t4, float w0, float w1, float w2, float bias, float (&out)[4]) {
    const u32x2 v = *(const u32x2*)(zrow + t4);
    const float z0 = bflo(v[0]), z1 = bfhi(v[0]), z2 = bflo(v[1]), z3 = bfhi(v[1]);
    const float zm = (t4 > 0) ? bf2f(zrow[t4 - 1]) : 0.f;
    const float zp = (t4 + 4 < SEQ) ? bf2f(zrow[t4 + 4]) : 0.f;
    out[0] = zm * w0 + z0 * w1 + z1 * w2 + bias;
    out[1] = z0 * w0 + z1 * w1 + z2 * w2 + bias;
    out[2] = z1 * w0 + z2 * w1 + z3 * w2 + bias;
    out[3] = z2 * w0 + z3 * w1 + zp * w2 + bias;
}
DI void hyena_item(const Params& p, int c, unsigned char* lds) {
    const int tid = get_tid(), lane = tid & 63, ig = tid >> 6;
    const bf16_t* ZT = (const bf16_t*)(p.ws + WS_ZT);
    const float* cw = p.in[I_HCW];
    const float* cb = p.in[I_HCB];
    __syncthreads();
    {
        const int b = tid >> 7, tb = (tid & 127) * 32;
        const bf16_t* zrow = ZT + (size_t)c * BT + (size_t)b * SEQ;
        const float w0 = cw[c], w1 = cw[HYC + c], w2 = cw[2 * HYC + c], bias = cb[c];
#pragma unroll
        for (int q = 0; q < 8; ++q) {
            float o[4];
            short_conv4(zrow, tb + 4 * q, w0, w1, w2, bias, o);
            *(u32x2*)(lds + b * HY_USTR + (tb + 4 * q) * 2) = u32x2{pk2(o[0], o[1]), pk2(o[2], o[3])};
        }
    }
    const int r = lane & 31, hf = lane >> 5, Il = r >> 3, bb = r & 7;
#pragma unroll 1
    for (int o = 0; o < 2; ++o) {
        hy_load_filter((const bf16_t*)(p.ws + WS_R) + (size_t)(o * 512 + c) * 8192, lds, tid);
        __syncthreads();
        f32x16 acc0, acc1;
#pragma unroll
        for (int i = 0; i < 16; ++i) { acc0[i] = 0.f; acc1[i] = 0.f; }
        const int sh = (-r) & 3;
        const unsigned char* abase = lds + HY_R + sh * HY_RSTR + (4096 + 8 * hf - r - sh) * 2 - 64;
        const unsigned char* ubase = lds + bb * HY_USTR + ((4 * ig + Il) * 64 + 8 * hf) * 2;
#define HY_STEP(MASKED) do { \
            const unsigned char* ap = abase - 128 * d; \
            const unsigned char* ub = ubase - 128 * d; \
            bool valid = true; \
            if (MASKED) { const int J = 4 * ig + Il - d; valid = (unsigned)J < 64u; if (!valid) ub = lds; } \
            _Pragma("unroll") for (int ks = 0; ks < 4; ++ks) { \
                u32x4 braw = *(const u32x4*)(ub + ks * 32); \
                if (MASKED) { if (!valid) braw = u32x4{0u, 0u, 0u, 0u}; } \
                const bf16x8 bf = __builtin_bit_cast(bf16x8, braw); \
                { const s16x4 lo = lds_rd64(ap + 32 * ks + 64), hi = lds_rd64(ap + 32 * ks + 72);     \
                  acc0 = MFMA32(__builtin_shufflevector(lo, hi, 0, 1, 2, 3, 4, 5, 6, 7), bf, acc0); } \
                { const s16x4 lo = lds_rd64(ap + 32 * ks), hi = lds_rd64(ap + 32 * ks + 8); \
                  acc1 = MFMA32(__builtin_shufflevector(lo, hi, 0, 1, 2, 3, 4, 5, 6, 7), bf, acc1); } \
            } } while (0)
        const int dlo = 4 * ig - 63, dhi = 4 * ig + 3;
#pragma unroll 1
        for (int d = dlo; d < dlo + 3; ++d) HY_STEP(true);
#pragma unroll 1
        for (int d = dlo + 3; d <= dhi - 3; ++d) HY_STEP(false);
#pragma unroll 1
        for (int d = dhi - 2; d <= dhi; ++d) HY_STEP(true);
#undef HY_STEP
        __syncthreads();
        const float skip = p.in[I_HSKIP][o * HYD + c];
        const int gcol = (o == 0 ? 512 : 1024) + c;
        const float w0 = cw[gcol], w1 = cw[HYC + gcol], w2 = cw[2 * HYC + gcol], bias = cb[gcol];
        const bf16_t* zrow = ZT + (size_t)gcol * BT + (size_t)bb * SEQ;
        bf16_t* hyt = (bf16_t*)(p.ws + WS_HYT) + (size_t)c * BT + (size_t)bb * SEQ;
#pragma unroll
        for (int mm = 0; mm < 2; ++mm) {
#pragma unroll
            for (int g4 = 0; g4 < 4; ++g4) {
                const int t4 = (4 * ig + Il) * 64 + 32 * mm + 8 * g4 + 4 * hf;
                float gt[4];
                short_conv4(zrow, t4, w0, w1, w2, bias, gt);
                unsigned char* up = lds + bb * HY_USTR + t4 * 2;
                const u32x2 uv = *(const u32x2*)up;
                const float u0 = bflo(uv[0]), u1 = bfhi(uv[0]), u2 = bflo(uv[1]), u3 = bfhi(uv[1]);
                const f32x16& a = mm ? acc1 : acc0;
                const float y0 = gt[0] * (a[4 * g4] + skip * u0), y1 = gt[1] * (a[4 * g4 + 1] + skip * u1);
                const float y2 = gt[2] * (a[4 * g4 + 2] + skip * u2), y3 = gt[3] * (a[4 * g4 + 3] + skip * u3);
                const u32x2 pk = u32x2{pk2(y0, y1), pk2(y2, y3)};
                if (o == 0) *(u32x2*)up = pk; else *(u32x2*)(hyt + t4) = pk;
            }
        }
        __syncthreads();
    }
}

constexpr int CTL_QUEUE_D = 8192;
template<bool HY> DI void phase_d(const Params& p, unsigned char* lds) {
    unsigned* ctr = (unsigned*)(p.ws + WS_CTL) + CTL_QUEUE_D + (HY ? 0 : 64);
    volatile LAS unsigned* slot = (volatile LAS unsigned*)(LAS unsigned char*)(lds + LDS_ST_OFF + 8);
    for (;;) {
        __syncthreads();
        if (get_tid() == 0) slot[0] = atomicAdd(ctr, 1u);
        __syncthreads();
        const int it = __builtin_amdgcn_readfirstlane((int)slot[0]);
        if (it >= 512) break;
        if (HY) hyena_item(p, it, lds); else attn_item(p, it, lds);
    }
}

DI void phase_d2(const Params& p, unsigned char* lds) {
    constexpr int TILES = 8 * (BT / 256);
    constexpr int CONV = 2 * 16384 * 1024 / 8192;
    const bf16_t* HYT = (const bf16_t*)(p.ws + WS_HYT);
    bf16_t* HY = (bf16_t*)(p.ws + WS_HY);
    for (int it = blockIdx.x; it < TILES + CONV; it += gridDim.x) {
        const int tid = get_tid();
        if (it >= TILES) {
            const int ci = it - TILES;
            const size_t el = (size_t)(ci & 2047) * 8192 + tid * 8;
            const float* src = (ci < 2048 ? p.in[I_PU] : p.in[I_PV]) + el;
            const float sc = ci < 2048 ? USCALE : VSCALE;
            const f32x4 a = *(const f32x4*)src, b = *(const f32x4*)(src + 4);
            int w0 = 0, w1 = 0;
            w0 = __builtin_amdgcn_cvt_pk_fp8_f32(a[0] * sc, a[1] * sc, w0, false); w0 = __builtin_amdgcn_cvt_pk_fp8_f32(a[2] * sc, a[3] * sc, w0, true);
            w1 = __builtin_amdgcn_cvt_pk_fp8_f32(b[0] * sc, b[1] * sc, w1, false); w1 = __builtin_amdgcn_cvt_pk_fp8_f32(b[2] * sc, b[3] * sc, w1, true);
            const size_t e = el >> 10, col = el & 1023;
            unsigned char* dst = ci < 2048 ? p.ws + WS_UT + el : p.ws + WS_VTAB + ((col >> 7) * 16384 + e) * 128 + (col & 127);
            *(u32x2*)dst = u32x2{(unsigned)w0, (unsigned)w1};
            continue;
        }
        const int c0 = (it & 7) * 64, tok0 = (it >> 3) * 256;
        __syncthreads();
#pragma unroll
        for (int i = 0; i < 2; ++i) {
            const int idx = tid + i * NT, c = idx >> 5, tg = idx & 31;
            *(u32x4*)(lds + c * 528 + tg * 16) = *(const u32x4*)(HYT + (size_t)(c0 + c) * BT + tok0 + tg * 8);
        }
        __syncthreads();
#pragma unroll
        for (int i = 0; i < 2; ++i) {
            const int idx = tid + i * NT, tok = idx >> 3, cg = idx & 7;
            unsigned w[4];
#pragma unroll
            for (int e = 0; e < 4; ++e) {
                const unsigned lo = *(const unsigned short*)(lds + (cg * 8 + 2 * e) * 528 + tok * 2);
                const unsigned hi = *(const unsigned short*)(lds + (cg * 8 + 2 * e + 1) * 528 + tok * 2);
                w[e] = lo | (hi << 16);
            }
            *(u32x4*)(HY + (size_t)(tok0 + tok) * HYD + c0 + cg * 8) = u32x4{w[0], w[1], w[2], w[3]};
        }
    }
}

DI void phase_e(const Params& p, unsigned char* lds) {
    constexpr int TILES = 4 * (BT / 128);
    for (int it = blockIdx.x; it < TILES; it += gridDim.x) {
        const int tid = get_tid(), lane = tid & 63, wave = tid >> 6, wp = wave >> 2, wq = wave & 3;
        const int tn = it & 3, tm = it >> 2;
        const int n0 = tn * 256, tok0 = tm * 128;
        f32x4 acc1[4][2], acc2[4][2];
#pragma unroll
        for (int i = 0; i < 4; ++i)
#pragma unroll
            for (int j = 0; j < 2; ++j) { acc1[i][j] = f32x4{0.f, 0.f, 0.f, 0.f}; acc2[i][j] = f32x4{0.f, 0.f, 0.f, 0.f}; }
        gemm_mainloop<2>(acc1, RowLoader{(const bf16_t*)(p.ws + WS_WTAO) + (size_t)n0 * QD, QD}, RowLoader{(const bf16_t*)(p.ws + WS_ATT) + (size_t)tok0 * QD, QD}, QD / 64, lds);
        gemm_mainloop<2>(acc2, RowLoader{(const bf16_t*)(p.ws + WS_WTHO) + (size_t)n0 * HYD, HYD}, RowLoader{(const bf16_t*)(p.ws + WS_HY) + (size_t)tok0 * HYD, HYD}, HYD / 64, lds);
        const bf16_t* G = (const bf16_t*)(p.ws + WS_G);
        bf16_t* M = (bf16_t*)(p.ws + WS_H);
        const int l15 = lane & 15, lk = lane >> 4;
#pragma unroll
        for (int i = 0; i < 4; ++i)
#pragma unroll
            for (int j = 0; j < 2; ++j) {
                const int n = n0 + wp * 64 + i * 16 + lk * 4;
                const int tok = tok0 + wq * 32 + j * 16 + l15;
                const u32x2 ga = *(const u32x2*)(G + (size_t)tok * GC + n);
                const u32x2 gh = *(const u32x2*)(G + (size_t)tok * GC + 1024 + n);
                const float m0 = bflo(ga[0]) * acc1[i][j][0] + bflo(gh[0]) * acc2[i][j][0];
                const float m1 = bfhi(ga[0]) * acc1[i][j][1] + bfhi(gh[0]) * acc2[i][j][1];
                const float m2 = bflo(ga[1]) * acc1[i][j][2] + bflo(gh[1]) * acc2[i][j][2];
                const float m3 = bfhi(ga[1]) * acc1[i][j][3] + bfhi(gh[1]) * acc2[i][j][3];
                *(u32x2*)(M + (size_t)tok * DM + n) = u32x2{pk2(m0, m1), pk2(m2, m3)};
            }
    }
}

DI void phase_f(const Params& p, unsigned char* lds) {
    constexpr int TILES = 4 * (BT / 256);
    const float* mod = (const float*)(p.ws + WS_MOD);
    for (int it = blockIdx.x; it < TILES; it += gridDim.x) {
        const int tid = get_tid(), lane = tid & 63, wave = tid >> 6, wp = wave >> 2, wq = wave & 3;
        const int tn = it & 3, tm = it >> 2;
        const int n0 = tn * 256, tok0 = tm * 256, b = tok0 >> 12;
        f32x4 acc[4][4];
#pragma unroll
        for (int i = 0; i < 4; ++i)
#pragma unroll
            for (int j = 0; j < 4; ++j) acc[i][j] = f32x4{0.f, 0.f, 0.f, 0.f};
        gemm_mainloop<4>(acc, RowLoader{(const bf16_t*)(p.ws + WS_WTO) + (size_t)n0 * DM, DM}, RowLoader{(const bf16_t*)(p.ws + WS_H) + (size_t)tok0 * DM, DM}, DM / 64, lds);
        const int l15 = lane & 15, lk = lane >> 4;
#pragma unroll
        for (int i = 0; i < 4; ++i) {
            const int n = n0 + wp * 64 + i * 16 + lk * 4;
            const f32x4 g1 = *(const f32x4*)(mod + b * 6144 + 2048 + n);
#pragma unroll
            for (int j = 0; j < 4; ++j) {
                const int tok = tok0 + wq * 64 + j * 16 + l15;
                const f32x4 xv = *(const f32x4*)(p.in[I_X] + (size_t)tok * DM + n);
                *(f32x4*)(p.out + (size_t)tok * DM + n) = f32x4{xv[0] + g1[0] * acc[i][j][0], xv[1] + g1[1] * acc[i][j][1], xv[2] + g1[2] * acc[i][j][2], xv[3] + g1[3] * acc[i][j][3]};
            }
        }
    }
}

DI void phase_g(const Params& p) {
    const float* mod = (const float*)(p.ws + WS_MOD);
    for (int it = blockIdx.x; it < BT / 16; it += gridDim.x) {
        const int row = it * 16 + (get_tid() >> 6), b = row >> 12;
        norm_mod_row(p.out + (size_t)row * DM, p.in[I_NFFN], mod + b * 6144 + 3072, mod + b * 6144 + 4096, (bf16_t*)(p.ws + WS_H) + (size_t)row * DM);
    }
}

DI void phase_h(const Params& p, unsigned char* lds) {
    constexpr int TILES = 8 * (BT / 256);
    for (int it = blockIdx.x; it < TILES; it += gridDim.x) {
        const int tid = get_tid(), lane = tid & 63, wave = tid >> 6, wp = wave >> 2, wq = wave & 3;
        const int tn = it & 7, tm = it >> 3;
        const int n0 = tn * 256, tok0 = tm * 256;
        f32x4 acc[4][4];
#pragma unroll
        for (int i = 0; i < 4; ++i)
#pragma unroll
            for (int j = 0; j < 4; ++j) acc[i][j] = f32x4{0.f, 0.f, 0.f, 0.f};
        gemm_mainloop<4>(acc, RowLoader{(const bf16_t*)(p.ws + WS_WTQ) + (size_t)n0 * DM, DM}, RowLoader{(const bf16_t*)(p.ws + WS_H) + (size_t)tok0 * DM, DM}, DM / 64, lds);
        bf16_t* QP = (bf16_t*)(p.ws + WS_G);
        const int l15 = lane & 15, lk = lane >> 4;
#pragma unroll
        for (int i = 0; i < 4; ++i)
#pragma unroll
            for (int j = 0; j < 4; ++j) {
                const int n = n0 + wp * 64 + i * 16 + lk * 4;
                const int tok = tok0 + wq * 64 + j * 16 + l15;
                *(u32x2*)(QP + (size_t)tok * 2048 + n) = u32x2{pk2(acc[i][j][0], acc[i][j][1]), pk2(acc[i][j][2], acc[i][j][3])};
            }
    }
}

DI void ins16(float (&L)[16], float v) {
#pragma unroll
    for (int i = 0; i < 16; ++i) { const float hi = fmaxf(L[i], v); v = fminf(L[i], v); L[i] = hi; }
}
DI float pack_idx(float v, unsigned idx, unsigned mask) { return __uint_as_float((__float_as_uint(v) & ~mask) | idx); }
constexpr int PI_LIST = 0;
DI void peer_select_item(const Params& p, int item, unsigned char* lds) {
    const int tok0 = item * 32;
    __syncthreads();
    {
        const int tid = get_tid(), lane = tid & 63, hp = tid >> 6;
        const int r = lane & 31, hf = lane >> 5;
        const bf16_t* keys = (const bf16_t*)(p.ws + WS_KEYS) + (size_t)((hp & 1) * 8 + (hp >> 1)) * 128 * 128 + 8 * hf;
        const bf16_t* qp = (const bf16_t*)(p.ws + WS_G) + (size_t)(tok0 + r) * 2048 + hp * 128 + 8 * hf;
        f32x16 acc[4];
#pragma unroll
        for (int m = 0; m < 4; ++m)
#pragma unroll
            for (int i = 0; i < 16; ++i) acc[m][i] = 0.f;
#pragma unroll
        for (int ks = 0; ks < 8; ++ks) {
            const bf16x8 bq = *(const bf16x8*)(qp + 16 * ks);
#pragma unroll
            for (int m = 0; m < 4; ++m) {
                const bf16x8 ak = *(const bf16x8*)(keys + (size_t)(m * 32 + r) * 128 + 16 * ks);
                acc[m] = MFMA32(ak, bq, acc[m]);
            }
        }
        float L[16];
#pragma unroll
        for (int i = 0; i < 16; ++i) L[i] = -3.0e38f;
#pragma unroll
        for (int m = 0; m < 4; ++m)
#pragma unroll
            for (int i = 0; i < 16; ++i) {
                const unsigned n = m * 32 + (i & 3) + 8 * (i >> 2) + 4 * hf;
                ins16(L, pack_idx(acc[m][i], n, 127u));
            }
        float P[16];
#pragma unroll
        for (int i = 0; i < 16; ++i) {
            auto sw = __builtin_amdgcn_permlane32_swap(__float_as_uint(L[i]), __float_as_uint(L[i]), false, false);
            P[i] = hf ? __uint_as_float(sw[0]) : __uint_as_float(sw[1]);
        }
#pragma unroll
        for (int i = 0; i < 16; ++i) ins16(L, P[i]);
        if (hf == 0) {
            float* dst = (float*)(lds + PI_LIST) + (r * 16 + hp) * 16;
#pragma unroll
            for (int i = 0; i < 16; i += 4) *(f32x4*)(dst + i) = f32x4{L[i], L[i + 1], L[i + 2], L[i + 3]};
        }
    }
    __syncthreads();
    {
        const int tid = get_tid();
        if (tid < 256) {
            const int tok = tid >> 3, h = tid & 7;
            const float* l1 = (const float*)(lds + PI_LIST) + (tok * 16 + 2 * h) * 16;
            const float* l2 = l1 + 16;
            float v1[16], v2[16];
#pragma unroll
            for (int i = 0; i < 16; i += 4) {
                const f32x4 a = *(const f32x4*)(l1 + i), b = *(const f32x4*)(l2 + i);
                v1[i] = a[0]; v1[i + 1] = a[1]; v1[i + 2] = a[2]; v1[i + 3] = a[3];
                v2[i] = b[0]; v2[i + 1] = b[1]; v2[i + 2] = b[2]; v2[i + 3] = b[3];
            }
            float B[16];
#pragma unroll
            for (int i = 0; i < 16; ++i) B[i] = -3.0e38f;
#pragma unroll
            for (int i = 0; i < 16; ++i)
#pragma unroll
                for (int j = 0; j < 16; ++j)
                    if ((i + 1) * (j + 1) <= 16) ins16(B, pack_idx(v1[i] + v2[j], (unsigned)(i * 16 + j), 255u));
            float e[16], sum = 0.f;
#pragma unroll
            for (int k = 0; k < 16; ++k) { e[k] = __expf(B[k] - B[0]); sum += e[k]; }
            const float inv = 1.f / sum;
            int* ex = (int*)(p.ws + WS_EXPI) + (size_t)(tok0 + tok) * 128 + h * 16;
            float* gt = (float*)(p.ws + WS_GATE) + (size_t)(tok0 + tok) * 128 + h * 16;
            int ev[16]; float gv[16];
#pragma unroll
            for (int k = 0; k < 16; ++k) {
                const unsigned ij = __float_as_uint(B[k]) & 255u;
                const unsigned i1 = __float_as_uint(l1[ij >> 4]) & 127u, i2 = __float_as_uint(l2[ij & 15u]) & 127u;
                ev[k] = (int)(i1 * 128u + i2);
                gv[k] = e[k] * inv;
            }
#pragma unroll
            for (int k = 0; k < 16; k += 4) {
                *(u32x4*)(ex + k) = u32x4{(unsigned)ev[k], (unsigned)ev[k + 1], (unsigned)ev[k + 2], (unsigned)ev[k + 3]};
                *(f32x4*)(gt + k) = f32x4{gv[k], gv[k + 1], gv[k + 2], gv[k + 3]};
            }
        }
    }
}
DI void phase_i1(const Params& p, unsigned char* lds) {
    for (int it = blockIdx.x; it < BT / 32; it += gridDim.x) peer_select_item(p, it, lds);
}

DI float dot16_fp8(const u32x4& w, const float (&x)[16]) {
    float d = 0.f;
#pragma unroll
    for (int i = 0; i < 4; ++i) {
        const auto lo = __builtin_amdgcn_cvt_pk_f32_fp8((int)w[i], false);
        const auto hi = __builtin_amdgcn_cvt_pk_f32_fp8((int)w[i], true);
        d += lo[0] * x[4 * i] + lo[1] * x[4 * i + 1] + hi[0] * x[4 * i + 2] + hi[1] * x[4 * i + 3];
    }
    return d;
}
template<class F> DI void run_partitioned(const Params& p, unsigned char* lds, int qbase, int nitems, F&& body) {
    unsigned* ctl = (unsigned*)(p.ws + WS_CTL);
    volatile LAS unsigned* slot = (volatile LAS unsigned*)(LAS unsigned char*)(lds + LDS_ST_OFF + 8);
    const int x0 = (int)(xb_xcc_id() & 7u);
#pragma unroll 1
    for (int pp = 0; pp < 8; ++pp) {
        const int part = (x0 + pp) & 7;
        for (;;) {
            __syncthreads();
            if (get_tid() == 0) slot[0] = atomicAdd(ctl + qbase + 64 * part, 1u);
            __syncthreads();
            const int it = __builtin_amdgcn_readfirstlane((int)slot[0]);
            if (it >= nitems) break;
            body(part, it);
        }
    }
}
constexpr int CTL_QUEUE_I2 = 8320, CTL_QUEUE_I3 = 8896;
constexpr int UW_BYTES = 6144, UW_GT = 4096, UW_LIST = 5120;
DI void peer_u_chunk(const Params& p, int part, int chunk, unsigned char* lds) {
    const int tid = get_tid(), lane = tid & 63, wave = __builtin_amdgcn_readfirstlane(tid >> 6);
    unsigned char* wl = lds + wave * UW_BYTES;
    unsigned* lst = (unsigned*)(wl + UW_LIST);
    const float* gts = (const float*)(wl + UW_GT);
    const unsigned char* UT8 = p.ws + WS_UT + lane * 16;
    const int tokw = chunk * 512 + wave * 2;
    int pe[4]; u32x4 ph[4]; float pg[4];
#define U_PREFETCH(tok) do { \
        const int* ex_ = (const int*)(p.ws + WS_EXPI) + (size_t)(tok) * 128 + lane; \
        const float* gt_ = (const float*)(p.ws + WS_GATE) + (size_t)(tok) * 128 + lane; \
        const bf16_t* hr_ = (const bf16_t*)(p.ws + WS_H) + (size_t)(tok) * DM + lane * 16; \
        pe[0] = ex_[0]; pe[1] = ex_[64]; pe[2] = ex_[128]; pe[3] = ex_[192]; \
        pg[0] = gt_[0]; pg[1] = gt_[64]; pg[2] = gt_[128]; pg[3] = gt_[192]; \
        ph[0] = *(const u32x4*)hr_; ph[1] = *(const u32x4*)(hr_ + 8); ph[2] = *(const u32x4*)(hr_ + DM); ph[3] = *(const u32x4*)(hr_ + DM + 8); } while (0)
    U_PREFETCH(tokw);
#pragma unroll 1
    for (int sub = 0; sub < 16; ++sub) {
        const int tok0 = tokw + sub * 32;
        *(u32x4*)(wl + lane * 32) = ph[0]; *(u32x4*)(wl + lane * 32 + 16) = ph[1];
        *(u32x4*)(wl + 2048 + lane * 32) = ph[2]; *(u32x4*)(wl + 2048 + lane * 32 + 16) = ph[3];
        int cnt = 0;
#pragma unroll
        for (int g = 0; g < 4; ++g) {
            ((float*)(wl + UW_GT))[g * 64 + lane] = pg[g];
            const bool m = (pe[g] >> 11) == part;
            const unsigned long long bm = __ballot(m);
            const int pos = cnt + __builtin_amdgcn_mbcnt_hi((unsigned)(bm >> 32), __builtin_amdgcn_mbcnt_lo((unsigned)bm, 0u));
            if (m) lst[pos] = ((unsigned)(g * 64 + lane) << 16) | (unsigned)pe[g];
            cnt += __popcll(bm);
        }
        if (sub + 1 < 16) U_PREFETCH(tok0 + 32);
#pragma unroll 1
        for (int base = 0; base < cnt; base += 8) {
            u32x4 row[8]; unsigned en[8];
#pragma unroll
            for (int q = 0; q < 8; ++q) {
                en[q] = __builtin_amdgcn_readfirstlane(lst[min(base + q, cnt - 1)]);
                row[q] = *(const u32x4*)(UT8 + (size_t)(en[q] & 0x3fffu) * 1024);
            }
            float d[8];
#pragma unroll
            for (int q = 0; q < 8; ++q) {
                const unsigned char* xr = wl + (en[q] >> 23) * 2048 + lane * 32;
                const u32x4 xa = *(const u32x4*)xr, xb = *(const u32x4*)(xr + 16);
                float acc = 0.f;
#pragma unroll
                for (int i = 0; i < 4; ++i) {
                    const auto lo = __builtin_amdgcn_cvt_scalef32_pk_bf16_fp8(row[q][i], 1.0f, false);
                    const auto hi = __builtin_amdgcn_cvt_scalef32_pk_bf16_fp8(row[q][i], 1.0f, true);
                    const unsigned x0 = (i < 2) ? xa[2 * i] : xb[2 * i - 4], x1 = (i < 2) ? xa[2 * i + 1] : xb[2 * i - 3];
                    acc = __builtin_amdgcn_fdot2_f32_bf16(lo, __builtin_bit_cast(decltype(lo), x0), acc, false);
                    acc = __builtin_amdgcn_fdot2_f32_bf16(hi, __builtin_bit_cast(decltype(hi), x1), acc, false);
                }
                d[q] = acc;
            }
            float r4[4], r2[2];
#pragma unroll
            for (int i = 0; i < 4; ++i) { auto sw = __builtin_amdgcn_permlane32_swap(__float_as_uint(d[i]), __float_as_uint(d[i + 4]), false, false); r4[i] = __uint_as_float(sw[0]) + __uint_as_float(sw[1]); }
#pragma unroll
            for (int i = 0; i < 2; ++i) { auto sw = __builtin_amdgcn_permlane16_swap(__float_as_uint(r4[i]), __float_as_uint(r4[i + 2]), false, false); r2[i] = __uint_as_float(sw[0]) + __uint_as_float(sw[1]); }
            const bool b3 = (lane & 8) != 0;
            float a = (b3 ? r2[1] : r2[0]) + dppf<0x128>(b3 ? r2[0] : r2[1]);
            a += dppf<0xB1>(a); a += dppf<0x4E>(a); a += dppf<0x141>(a);
            a *= (1.f / USCALE);
            const int g = lane >> 3;
            const unsigned ent = lst[min(base + g, cnt - 1)];
            const int idx = (int)(ent >> 16);
            const float y = 0.7978845608028654f * (a + 0.044715f * a * a * a);
            const float th = 1.f - 2.f / (__expf(2.f * y) + 1.f);
            const float w = 0.5f * a * (1.f + th) * gts[idx];
            if ((lane & 7) == 0 && base + g < cnt) ((u32x2*)(p.ws + WS_PAIRS))[(size_t)tok0 * 128 + idx] = u32x2{ent & 0x3fffu, __float_as_uint(w)};
        }
    }
#undef U_PREFETCH
}
DI void phase_i2(const Params& p, unsigned char* lds) {
    run_partitioned(p, lds, CTL_QUEUE_I2, BT / 512, [&](int part, int it) { peer_u_chunk(p, part, it, lds); });
}
typedef float f32x2 __attribute__((ext_vector_type(2)));
DI void peer_v_chunk(const Params& p, int part, int chunk, unsigned char* lds) {
    const int tid = get_tid(), lane = tid & 63, wave = __builtin_amdgcn_readfirstlane(tid >> 6);
    unsigned char* wl = lds + wave * 1024;
    const int es = lane >> 3, ch = lane & 7;
    const unsigned char* VT8 = p.ws + WS_VTAB + (size_t)part * 16384 * 128 + ch * 16;
    const float* mod = (const float*)(p.ws + WS_MOD);
    const int col = part * 128 + 16 * ch + 2 * es;
    const int tokw = chunk * 512 + wave;
    u32x4 pp = *((const u32x4*)(p.ws + WS_PAIRS + (size_t)tokw * 1024) + lane);
#pragma unroll 1
    for (int step = 0; step < 32; ++step) {
        const int tok = tokw + step * 16, b = tok >> 12;
        *(u32x4*)(wl + lane * 16) = pp;
        if (step + 1 < 32) pp = *((const u32x4*)(p.ws + WS_PAIRS + (size_t)(tok + 16) * 1024) + lane);
        float* xo = p.out + (size_t)tok * DM + col;
        const f32x2 x1 = *(const f32x2*)xo;
        const f32x2 g2 = *(const f32x2*)(mod + b * 6144 + 5120 + col);
        f32x2 acc[8];
#pragma unroll
        for (int i = 0; i < 8; ++i) acc[i] = f32x2{0.f, 0.f};
        const u32x2* pr = (const u32x2*)wl + es;
#pragma unroll 1
        for (int ih = 0; ih < 2; ++ih) {
            u32x2 pe[8]; u32x4 row[8];
#pragma unroll
            for (int q = 0; q < 8; ++q) { pe[q] = pr[(ih * 8 + q) * 8]; row[q] = *(const u32x4*)(VT8 + (size_t)pe[q][0] * 128); }
#pragma unroll
            for (int q = 0; q < 8; ++q) {
                const float w = __uint_as_float(pe[q][1]);
                const f32x2 w2 = f32x2{w, w};
#pragma unroll
                for (int i = 0; i < 4; ++i) {
                    const f32x2 lo = __builtin_amdgcn_cvt_pk_f32_fp8((int)row[q][i], false);
                    const f32x2 hi = __builtin_amdgcn_cvt_pk_f32_fp8((int)row[q][i], true);
                    acc[2 * i] += w2 * lo; acc[2 * i + 1] += w2 * hi;
                }
            }
        }
        float a16[16];
#pragma unroll
        for (int i = 0; i < 8; ++i) { a16[2 * i] = acc[i][0]; a16[2 * i + 1] = acc[i][1]; }
        float r8[8], r4[4], r2[2];
#pragma unroll
        for (int i = 0; i < 8; ++i) { auto sw = __builtin_amdgcn_permlane32_swap(__float_as_uint(a16[i]), __float_as_uint(a16[i + 8]), false, false); r8[i] = __uint_as_float(sw[0]) + __uint_as_float(sw[1]); }
#pragma unroll
        for (int i = 0; i < 4; ++i) { auto sw = __builtin_amdgcn_permlane16_swap(__float_as_uint(r8[i]), __float_as_uint(r8[i + 4]), false, false); r4[i] = __uint_as_float(sw[0]) + __uint_as_float(sw[1]); }
        const bool b3 = (lane & 8) != 0;
#pragma unroll
        for (int i = 0; i < 2; ++i) { const float keep = b3 ? r4[i + 2] : r4[i], send = b3 ? r4[i] : r4[i + 2]; r2[i] = keep + dppf<0x128>(send); }
        const float xa = x1[0] + g2[0] * r2[0] * (1.f / VSCALE), xb = x1[1] + g2[1] * r2[1] * (1.f / VSCALE);
        *(f32x2*)xo = f32x2{xa, xb};
        const float ss = wave_sum(xa * xa + xb * xb);
        if (lane == 0) ((float*)(p.ws + WS_SSQ))[(size_t)tok * 8 + part] = ss;
    }
}
DI void phase_i3(const Params& p, unsigned char* lds) {
    run_partitioned(p, lds, CTL_QUEUE_I3, BT / 512, [&](int part, int it) { peer_v_chunk(p, part, it, lds); });
}
DI void phase_i4(const Params& p) {
    const bool bad = xb_ld((unsigned*)(p.ws + WS_CTL) + CTL_BADTID) != 0u || xb_ld((unsigned*)(p.ws + WS_CTL) + XB_TMO) != 0u;
    for (int it = blockIdx.x; it < BT / 16; it += gridDim.x) {
        const int tid = get_tid(), lane = tid & 63, row = it * 16 + (tid >> 6);
        const float* sq = (const float*)(p.ws + WS_SSQ) + (size_t)row * 8;
        const f32x4 s0 = *(const f32x4*)sq, s1 = *(const f32x4*)(sq + 4);
        const float ss = s0[0] + s0[1] + s0[2] + s0[3] + s1[0] + s1[1] + s1[2] + s1[3];
        float rs = rsqrtf(ss * (1.f / DM) + EPS);
        if (bad) rs = __builtin_nanf("");
        float* o = p.out + (size_t)row * DM;
#pragma unroll
        for (int j = 0; j < 4; ++j) {
            const int c = j * 256 + lane * 4;
            const f32x4 v = *(const f32x4*)(o + c), g = *(const f32x4*)(p.in[I_FNG] + c);
            *(f32x4*)(o + c) = f32x4{v[0] * rs * g[0], v[1] * rs * g[1], v[2] * rs * g[2], v[3] * rs * g[3]};
        }
    }
}

__global__ void __launch_bounds__(NT) mega(Params p) {
    unsigned char* lds = g_lds;
    volatile LAS unsigned* st = (volatile LAS unsigned*)(LAS unsigned char*)(lds + LDS_ST_OFF);
    {
        const unsigned hw = __builtin_amdgcn_s_getreg((5 << 11) | 4);
        if ((threadIdx.x & 63) == 0) g_lds[LDS_WTAB_OFF + hw] = (unsigned char)(threadIdx.x >> 6);
        if (threadIdx.x < 2) st[threadIdx.x] = 0u;
        __syncthreads();
        if (get_tid() != (int)threadIdx.x) ((unsigned*)(p.ws + WS_CTL))[CTL_BADTID] = 1u;
    }
    XcdBarrier bar = xcd_barrier_post((unsigned*)(p.ws + WS_CTL), st);
    float* sm = (float*)lds;

#define STAMP(k, which) do { if (PROBE_PHASE == (k) && blockIdx.x == 0 && get_tid() == 0) ((volatile unsigned long long*)(lds + LDS_PROBE_OFF))[which] = __builtin_amdgcn_s_memrealtime(); } while (0)
    STAMP(0, 0); phase_a(p, sm);   xcd_barrier(bar); STAMP(0, 1);
    STAMP(1, 0); phase_b(p, sm);   xcd_barrier(bar); STAMP(1, 1);
    STAMP(2, 0); phase_c(p, lds);  xcd_barrier(bar); STAMP(2, 1);
    STAMP(3, 0); phase_d<true>(p, lds);  xcd_barrier(bar); STAMP(3, 1);
    STAMP(13, 0); phase_d<false>(p, lds); xcd_barrier(bar); STAMP(13, 1);
    STAMP(4, 0); phase_d2(p, lds); xcd_barrier(bar); STAMP(4, 1);
    STAMP(5, 0); phase_e(p, lds);  xcd_barrier(bar); STAMP(5, 1);
    STAMP(6, 0); phase_f(p, lds);  xcd_barrier(bar); STAMP(6, 1);
    STAMP(7, 0); phase_g(p);       xcd_barrier(bar); STAMP(7, 1);
    STAMP(8, 0); phase_h(p, lds);  xcd_barrier(bar); STAMP(8, 1);
    STAMP(9, 0); phase_i1(p, lds); xcd_barrier(bar); STAMP(9, 1);
    STAMP(10, 0); phase_i2(p, lds); xcd_barrier(bar); STAMP(10, 1);
    STAMP(11, 0); phase_i3(p, lds); xcd_barrier(bar); STAMP(11, 1);
    STAMP(12, 0); phase_i4(p);
    if (PROBE_PHASE >= 0) {
        xcd_barrier(bar); STAMP(12, 1);
        if (blockIdx.x == 0 && get_tid() == 0) {
            volatile unsigned long long* ts = (volatile unsigned long long*)(lds + LDS_PROBE_OFF);
            p.out[0] += (float)(ts[1] - ts[0]) * (0.01f / PROBE_SCALE);
        }
    }
}

extern "C" void kernel_launch(void* const* d_in, const int* in_sizes, int n_in, void* d_out, int out_size, void* d_ws, size_t ws_size, hipStream_t stream) {
    static int grid = 0;
    if (grid == 0) {
        int dev = 0, cus = 0;
        if (hipGetDevice(&dev) != hipSuccess || hipDeviceGetAttribute(&cus, hipDeviceAttributeMultiprocessorCount, dev) != hipSuccess) { fprintf(stderr, "kernel_launch: device query failed\n"); grid = -1; return; }
        if (n_in != N_IN || ws_size < WS_END) { fprintf(stderr, "kernel_launch: unexpected n_in %d or ws_size %zu (< %zu)\n", n_in, ws_size, (size_t)WS_END); grid = -1; return; }
        grid = cus;
    }
    if (grid < 0) return;
    (void)hipMemsetAsync((char*)d_ws + WS_CTL, 0, 64 * 1024, stream);
    Params p{};
    for (int i = 0; i < N_IN; ++i) p.in[i] = (const float*)d_in[i];
    p.out = (float*)d_out; p.ws = (unsigned char*)d_ws;
    hipLaunchKernelGGL(mega, dim3(grid), dim3(NT), 0, stream, p);
}
```

```cpp
#include <hip/hip_runtime.h>
#include <stdint.h>
#include <cstdio>

#define DI __device__ __forceinline__
#define LAS __attribute__((address_space(3)))
typedef unsigned short bf16_t;
typedef short bf16x8 __attribute__((ext_vector_type(8)));
typedef short s16x4 __attribute__((ext_vector_type(4)));
typedef float f32x4 __attribute__((ext_vector_type(4)));
typedef float f32x16 __attribute__((ext_vector_type(16)));
typedef unsigned u32x4 __attribute__((ext_vector_type(4)));
typedef unsigned u32x2 __attribute__((ext_vector_type(2)));

#ifndef PROBE_PHASE
#define PROBE_PHASE (-1)
#endif
#ifndef PROBE_SCALE
#define PROBE_SCALE 100.f
#endif
constexpr int BATCH = 8, SEQ = 4096, DM = 1024, BT = BATCH * SEQ;
constexpr int CTX = 256, TK = SEQ + CTX;
constexpr int NH = 8, NKV = 2, HD = 64;
constexpr int QD = 512, KVD = 128, HYD = 512, HYC = 1536, GC = 2048, INC = 4352;
constexpr int PH = 8, PNK = 128, PDK = 256, PTOP = 16;
constexpr float EPS = 1e-6f;
constexpr int NT = 1024;

enum { I_X = 0, I_C, I_CTX, I_CCTX, I_ADAW, I_ADAB, I_NMIX, I_NFFN, I_WIN, I_QNG, I_KNG, I_HCW, I_HCB,
       I_HW1, I_HB1, I_HW2, I_HB2, I_HW3, I_HB3, I_HW4, I_HFREQ, I_HSKIP, I_WAO, I_WHO, I_WO, I_PWQ, I_PK1, I_PK2, I_PU, I_PV, I_FNG, N_IN };

constexpr size_t MB = 1024 * 1024;
constexpr size_t WS_CTL   = 0;
constexpr size_t WS_MOD   = 64 * 1024;
constexpr size_t WS_ROPE  = WS_MOD + 9 * 6144 * 4;
constexpr size_t WS_PART  = 512 * 1024;
constexpr size_t WS_WTIN  = 3 * MB;
constexpr size_t WS_WTAO  = WS_WTIN + (size_t)INC * DM * 2;
constexpr size_t WS_WTHO  = WS_WTAO + (size_t)DM * QD * 2;
constexpr size_t WS_WTO   = WS_WTHO + (size_t)DM * HYD * 2;
constexpr size_t WS_WTQ   = WS_WTO + (size_t)DM * DM * 2;
constexpr size_t WS_KEYS  = WS_WTQ + (size_t)2048 * DM * 2;
constexpr size_t WS_R     = WS_KEYS + (size_t)2 * 8 * 128 * 128 * 2;
constexpr size_t WS_KB    = WS_R + (size_t)2 * 512 * 8192 * 2;
constexpr size_t WS_VT    = WS_KB + (size_t)BATCH * NKV * TK * HD * 2;
constexpr size_t WS_HC    = WS_VT + (size_t)BATCH * NKV * TK * HD * 2;
constexpr size_t WS_H     = 60 * MB;
constexpr size_t WS_G     = WS_H + 64 * MB;
constexpr size_t WS_ZT    = WS_G + 128 * MB;
constexpr size_t WS_Q     = WS_ZT + 96 * MB;
constexpr size_t WS_ATT   = WS_Q + 32 * MB;
constexpr size_t WS_HYT   = WS_ATT + 32 * MB;
constexpr size_t WS_END   = WS_HYT + 32 * MB;
static_assert(WS_HC + (size_t)2048 * DM * 2 <= WS_H, "ws overlap");
constexpr size_t WS_FRAW  = WS_ATT;
constexpr size_t WS_HY    = WS_Q;
constexpr size_t WS_UT    = WS_ZT;
constexpr size_t WS_VTAB  = WS_ZT + 32 * MB;
constexpr size_t WS_EXPI  = WS_ATT;
constexpr size_t WS_GATE  = WS_ATT + 16 * MB;
constexpr size_t WS_PAIRS = WS_HYT;
constexpr size_t WS_SSQ   = WS_Q;
constexpr float USCALE = 256.f, VSCALE = 64.f;

constexpr int CTL_BADTID = 8000;
DI unsigned f2bf(float f) { unsigned u = __builtin_bit_cast(unsigned, f); return (u + 0x7fffu + ((u >> 16) & 1u)) >> 16; }
DI unsigned pk2(float lo, float hi) { return f2bf(lo) | (f2bf(hi) << 16); }
DI float bf2f(unsigned short b) { return __builtin_bit_cast(float, (unsigned)b << 16); }
DI float bflo(unsigned u) { return __builtin_bit_cast(float, u << 16); }
DI float bfhi(unsigned u) { return __builtin_bit_cast(float, u & 0xffff0000u); }
DI float red2pi(float x) { const float k = rintf(x * 0.15915494309189535f); float r = fmaf(-k, 6.2831854820251465f, x); return fmaf(-k, -1.7484555e-7f, r); }
DI float fsin(float x) { return __sinf(red2pi(x)); }
DI float fcos(float x) { return __cosf(red2pi(x)); }
constexpr int LDS_BYTES = 160 * 1024;
constexpr int LDS_ST_OFF = LDS_BYTES - 16;
constexpr int LDS_PROBE_OFF = LDS_BYTES - 16 - 32;
constexpr int LDS_WTAB_OFF = LDS_BYTES - 16 - 32 - 64;
constexpr int LDS_USER = LDS_WTAB_OFF;
__shared__ __attribute__((aligned(16))) unsigned char g_lds[LDS_BYTES];
DI s16x4 lds_rd64(const unsigned char* ptr) { return *(const volatile LAS s16x4*)(const LAS unsigned char*)ptr; }
DI int get_tid() {
    const unsigned hw = __builtin_amdgcn_s_getreg((5 << 11) | 4);
    unsigned w = g_lds[LDS_WTAB_OFF + hw];
    w = __builtin_amdgcn_readfirstlane(w);
    int t;
    asm volatile("v_mbcnt_lo_u32_b32 %0, -1, 0\n\tv_mbcnt_hi_u32_b32 %0, -1, %0\n\tv_lshl_or_b32 %0, %1, 6, %0" : "=&v"(t) : "s"(w));
    return t;
}
template<int CTRL> DI float dppf(float v) { return __uint_as_float(__builtin_amdgcn_update_dpp(0u, __float_as_uint(v), CTRL, 0xF, 0xF, true)); }
DI float sum16(float v) { v += dppf<0xB1>(v); v += dppf<0x4E>(v); v += dppf<0x141>(v); v += dppf<0x140>(v); return v; }
DI float sum_x16(float v) { auto r = __builtin_amdgcn_permlane16_swap(__float_as_uint(v), __float_as_uint(v), false, false); return __uint_as_float(r[0]) + __uint_as_float(r[1]); }
DI float sum_x32(float v) { auto r = __builtin_amdgcn_permlane32_swap(__float_as_uint(v), __float_as_uint(v), false, false); return __uint_as_float(r[0]) + __uint_as_float(r[1]); }
DI float max_x32(float v) { auto r = __builtin_amdgcn_permlane32_swap(__float_as_uint(v), __float_as_uint(v), false, false); return fmaxf(__uint_as_float(r[0]), __uint_as_float(r[1])); }
DI float wave_sum(float v) { return sum_x32(sum_x16(sum16(v))); }

#define XB_TMO      128
#define XB_XCNT(j)  (256  + 64 * (j))
#define XB_XSUB(j)  (1280 + 64 * (j))
#define XB_XGEN(j)  (2304 + 64 * (j))
#define XB_TOP      3328
#define XB_TOPGEN   3392
#define XCD_BAR_WORDS 3456
#define XB_SPIN_CAP (1u << 27)
DI unsigned xb_ld(unsigned* p)              { return __hip_atomic_load(p, __ATOMIC_RELAXED, __HIP_MEMORY_SCOPE_AGENT); }
DI unsigned xb_add(unsigned* p, unsigned v) { return __hip_atomic_fetch_add(p, v, __ATOMIC_RELAXED, __HIP_MEMORY_SCOPE_AGENT); }
DI unsigned xb_xcc_id() { return (unsigned)__builtin_amdgcn_s_getreg((3 << 11) | 20) & 0xFu; }
#define XB_SPIN(cond, bar) do { unsigned _sp = 0; while (cond) { __builtin_amdgcn_s_sleep(1); \
    if ((++_sp & 255u) == 0u) { if (xb_ld(&(bar)[XB_TMO])) break; if (_sp > XB_SPIN_CAP) { atomicAdd(&(bar)[XB_TMO], 1u); break; } } } } while (0)
struct XcdBarrier { unsigned* bar; unsigned x; volatile LAS unsigned* st; };
DI XcdBarrier xcd_barrier_post(unsigned* bar, volatile LAS unsigned* st) {
    XcdBarrier b; b.bar = bar; b.x = xb_xcc_id(); b.st = st;
    if (get_tid() == 0) (void)xb_add(&bar[XB_XCNT(b.x)], 1u);
    return b;
}
DI void xcd_barrier_complete(unsigned* bar, unsigned x, unsigned& nloc, unsigned& nx) {
    const unsigned G = gridDim.x * gridDim.y * gridDim.z;
    unsigned sum, cnt, mine, sp = 0u;
    for (;;) {
        sum = 0u; cnt = 0u; mine = 0u;
#pragma unroll
        for (unsigned j = 0; j < 16; ++j) { const unsigned c = xb_ld(&bar[XB_XCNT(j)]); sum += c; cnt += (c > 0u) ? 1u : 0u; mine = (j == x) ? c : mine; }
        if (sum == G) break;
        __builtin_amdgcn_s_sleep(1);
        if ((++sp & 255u) == 0u) { if (xb_ld(&bar[XB_TMO])) break; if (sp > XB_SPIN_CAP) { atomicAdd(&bar[XB_TMO], 1u); break; } }
    }
    nloc = mine > 0u ? mine : 1u; nx = cnt > 0u ? cnt : 1u;
}
DI void xcd_barrier(const XcdBarrier& b) {
    asm volatile("s_waitcnt vmcnt(0)" ::: "memory");
    __syncthreads();
    if (get_tid() == 0) {
        unsigned* bar = b.bar;
        __builtin_amdgcn_s_waitcnt(0);
        unsigned nloc = b.st[0], nx = b.st[1];
        if (nloc == 0u) { xcd_barrier_complete(bar, b.x, nloc, nx); b.st[0] = nloc; b.st[1] = nx; }
        const unsigned old = xb_add(&bar[XB_XSUB(b.x)], 1u);
        const unsigned gen = old / nloc;
        if (old + 1u == (gen + 1u) * nloc) {
            __builtin_amdgcn_fence(__ATOMIC_RELEASE, "agent");
            asm volatile("s_waitcnt vmcnt(0)" ::: "memory");
            const unsigned og = xb_add(&bar[XB_TOP], 1u);
            const unsigned tg = og / nx;
            if (og + 1u == (tg + 1u) * nx) xb_add(&bar[XB_TOPGEN], 1u);
            else XB_SPIN(xb_ld(&bar[XB_TOPGEN]) == tg, bar);
            __builtin_amdgcn_fence(__ATOMIC_ACQUIRE, "agent");
            xb_add(&bar[XB_XGEN(b.x)], 1u);
            asm volatile("s_waitcnt vmcnt(0)" ::: "memory");
        } else {
            XB_SPIN(xb_ld(&bar[XB_XGEN(b.x)]) == gen, bar);
            __builtin_amdgcn_fence(__ATOMIC_ACQUIRE, "agent");
            asm volatile("s_waitcnt vmcnt(0)" ::: "memory");
        }
    }
    __syncthreads();
}

struct Params { const float* in[N_IN]; float* out; unsigned char* ws; };


DI void transpose_tile(const float* __restrict__ W, int K, int N, bf16_t* __restrict__ Wt, int tile, float* sm) {
    const int tid = get_tid();
    const int ntn = N / 64, tk = tile / ntn, tn = tile % ntn;
#pragma unroll
    for (int i = 0; i < 4; ++i) {
        const int idx = tid + i * NT, kk = idx >> 6, nn = idx & 63;
        sm[kk * 65 + nn] = W[(size_t)(tk * 64 + kk) * N + tn * 64 + nn];
    }
    __syncthreads();
#pragma unroll
    for (int i = 0; i < 2; ++i) {
        const int idx = tid + i * NT, nn = idx >> 5, kp = (idx & 31) * 2;
        const unsigned v = pk2(sm[kp * 65 + nn], sm[(kp + 1) * 65 + nn]);
        *(unsigned*)(Wt + (size_t)(tn * 64 + nn) * K + tk * 64 + kp) = v;
    }
    __syncthreads();
}

DI void mod_item(const Params& p, int item, float* sm) {
    const int tid = get_tid();
    float* sc = sm;
    float* red = sm + 9 * 1024;
    for (int i = tid; i < 9 * 1024; i += NT) {
        const float v = (i < 8 * 1024) ? p.in[I_C][i] : p.in[I_CCTX][i - 8 * 1024];
        sc[i] = v / (1.f + __expf(-v));
    }
    __syncthreads();
    const int col = tid & 63, kg = tid >> 6, n0 = item * 64;
    float acc[9];
#pragma unroll
    for (int r = 0; r < 9; ++r) acc[r] = 0.f;
    const float* w = p.in[I_ADAW] + n0 + col;
#pragma unroll 8
    for (int k = kg * 64; k < kg * 64 + 64; ++k) {
        const float wv = w[(size_t)k * 6144];
#pragma unroll
        for (int r = 0; r < 9; ++r) acc[r] += sc[r * 1024 + k] * wv;
    }
#pragma unroll
    for (int r = 0; r < 9; ++r) red[(kg * 9 + r) * 64 + col] = acc[r];
    __syncthreads();
    if (tid < 9 * 64) {
        const int r = tid >> 6, c2 = tid & 63;
        float s = p.in[I_ADAB][n0 + c2];
#pragma unroll
        for (int g = 0; g < 16; ++g) s += red[(g * 9 + r) * 64 + c2];
        ((float*)(p.ws + WS_MOD))[r * 6144 + n0 + c2] = s;
    }
    __syncthreads();
}

DI void filter_item(const Params& p, int item, float* sm) {
    const int tid = get_tid();
    float* z  = sm;
    float* ha = sm + 16 * 36;
    float* hb = ha + 16 * 64;
    const int t0 = item * 16;
    if (tid < 16 * 33) {
        const int pp = tid / 33, i = tid % 33;
        const int t = t0 + pp;
        float v;
        if (i == 0) v = (float)t / (float)(SEQ - 1);
        else {
            const int fi = (i - 1) & 15;
            const float f = 1e-4f + (float)fi * ((15.f - 1e-4f) / 15.f);
            const float w = 6.283185307179586f * (float)t / (float)SEQ;
            const float a = f * w;
            v = (i <= 16) ? fcos(a) : -fsin(a);
        }
        z[pp * 36 + i] = v;
    }
    __syncthreads();
    const int pp = tid >> 6, j = tid & 63;
    const float fr = p.in[I_HFREQ][j];
    {
        float a = p.in[I_HB1][j];
        const float* w1 = p.in[I_HW1];
#pragma unroll 11
        for (int i = 0; i < 33; ++i) a += z[pp * 36 + i] * w1[i * 64 + j];
        ha[pp * 64 + j] = fsin(fr * a);
    }
    __syncthreads();
    {
        float a = p.in[I_HB2][j];
        const float* w2 = p.in[I_HW2];
#pragma unroll 8
        for (int i = 0; i < 64; ++i) a += ha[pp * 64 + i] * w2[i * 64 + j];
        hb[pp * 64 + j] = fsin(fr * a);
    }
    __syncthreads();
    {
        float a = p.in[I_HB3][j];
        const float* w3 = p.in[I_HW3];
#pragma unroll 8
        for (int i = 0; i < 64; ++i) a += hb[pp * 64 + i] * w3[i * 64 + j];
        __syncthreads();
        ha[pp * 64 + j] = fsin(fr * a);
    }
    __syncthreads();
    float* fraw = (float*)(p.ws + WS_FRAW);
    float* part = (float*)(p.ws + WS_PART);
    const float* w4 = p.in[I_HW4];
#pragma unroll 1
    for (int cc = 0; cc < 2; ++cc) {
        const int col = tid + cc * NT;
        float acc[16];
#pragma unroll
        for (int q = 0; q < 16; ++q) acc[q] = 0.f;
#pragma unroll 4
        for (int i = 0; i < 64; ++i) {
            const float wv = w4[i * 2048 + col];
#pragma unroll
            for (int q = 0; q < 16; ++q) acc[q] += ha[q * 64 + i] * wv;
        }
        const int c = col & 511, dir = (col >> 9) & 1;
        const float mind = -3.0701134573253945f, maxd = -15.350567286626973f;
        const float delta = fabsf(mind + (float)c * ((maxd - mind) / 511.f));
        float s = 0.f;
#pragma unroll
        for (int q = 0; q < 16; ++q) {
            const int t = t0 + q;
            const float t01 = (float)t / (float)(SEQ - 1);
            const float v = acc[q] * expf(-t01 * delta);
            acc[q] = v;
            if (!(dir == 1 && t == 0)) s += fabsf(v);
        }
        float* dst = fraw + (size_t)col * SEQ + t0;
#pragma unroll
        for (int q = 0; q < 16; q += 4) *(f32x4*)(dst + q) = f32x4{acc[q], acc[q + 1], acc[q + 2], acc[q + 3]};
        part[item * 2048 + col] = s;
    }
    __syncthreads();
}

DI void phase_a(const Params& p, float* sm) {
    constexpr int T_WIN = 16 * 68, T_AO = 8 * 16, T_HO = 8 * 16, T_WO = 16 * 16, T_WQ = 16 * 32;
    constexpr int E0 = T_WIN, E1 = E0 + T_AO, E2 = E1 + T_HO, E3 = E2 + T_WO, E4 = E3 + T_WQ;
    constexpr int E5 = E4 + 64;
    constexpr int E6 = E5 + 96;
    constexpr int E7 = E6 + 1;
    constexpr int E8 = E7 + 256;
    for (int it = blockIdx.x; it < E8; it += gridDim.x) {
        int item = it;
        if (item < 256) { filter_item(p, item, sm); continue; }
        item -= 256;
        if (item < 96) { mod_item(p, item, sm); continue; }
        item -= 96;
        if (item < 1) {
            const int tid = get_tid();
            float* rope = (float*)(p.ws + WS_ROPE);
            const int pos = tid >> 4, f = tid & 15;
            const float inv = powf(10000.f, -(float)(2 * f) / 32.f);
            const float ang = (float)pos * inv;
            rope[tid] = fcos(ang); rope[1024 + tid] = fsin(ang);
            continue;
        }
        item -= 1;
        if (item < 64) {
            const int tid = get_tid();
            const float* src = (item < 32) ? p.in[I_PK1] : p.in[I_PK2];
            bf16_t* dst = (bf16_t*)(p.ws + WS_KEYS) + (size_t)item * 4096;
            const f32x4 v = *(const f32x4*)(src + (size_t)(item & 31) * 4096 + tid * 4);
            *(u32x2*)(dst + tid * 4) = u32x2{pk2(v[0], v[1]), pk2(v[2], v[3])};
            continue;
        }
        item -= 64;
        if (item < T_WIN) { transpose_tile(p.in[I_WIN], DM, INC, (bf16_t*)(p.ws + WS_WTIN), item, sm); continue; }
        item -= T_WIN;
        if (item < T_AO) { transpose_tile(p.in[I_WAO], QD, DM, (bf16_t*)(p.ws + WS_WTAO), item, sm); continue; }
        item -= T_AO;
        if (item < T_HO) { transpose_tile(p.in[I_WHO], HYD, DM, (bf16_t*)(p.ws + WS_WTHO), item, sm); continue; }
        item -= T_HO;
        if (item < T_WO) { transpose_tile(p.in[I_WO], DM, DM, (bf16_t*)(p.ws + WS_WTO), item, sm); continue; }
        item -= T_WO;
        transpose_tile(p.in[I_PWQ], DM, 2048, (bf16_t*)(p.ws + WS_WTQ), item, sm);
    }
    (void)E1; (void)E2; (void)E3; (void)E4; (void)E5; (void)E6; (void)E7;
}

DI void norm_mod_row(const float* __restrict__ src, const float* __restrict__ g, const float* __restrict__ shift, const float* __restrict__ scale, bf16_t* __restrict__ dst) {
    const int lane = get_tid() & 63;
    f32x4 v[4];
    float ss = 0.f;
#pragma unroll
    for (int j = 0; j < 4; ++j) { v[j] = *(const f32x4*)(src + j * 256 + lane * 4); ss += v[j][0] * v[j][0] + v[j][1] * v[j][1] + v[j][2] * v[j][2] + v[j][3] * v[j][3]; }
    ss = wave_sum(ss);
    const float rs = rsqrtf(ss * (1.f / DM) + EPS);
#pragma unroll
    for (int j = 0; j < 4; ++j) {
        const int c = j * 256 + lane * 4;
        const f32x4 gg = *(const f32x4*)(g + c), sh = *(const f32x4*)(shift + c), sc = *(const f32x4*)(scale + c);
        float o[4];
#pragma unroll
        for (int e = 0; e < 4; ++e) o[e] = v[j][e] * rs * gg[e] * (1.f + sc[e]) + sh[e];
        *(u32x2*)(dst + c) = u32x2{pk2(o[0], o[1]), pk2(o[2], o[3])};
    }
}

DI void filter_norm_item(const Params& p, int item, float* sm) {
    const int tid = get_tid();
    const int o = item >> 9, c = item & 511;
    const int colf = o * 1024 + c, colb = colf + 512;
    const float* part = (const float*)(p.ws + WS_PART);
    float s = 0.f;
    if (tid < 512) s = part[(tid & 255) * 2048 + ((tid < 256) ? colf : colb)];
    s = wave_sum(s);
    if ((tid & 63) == 0) sm[tid >> 6] = s;
    __syncthreads();
    float tot = EPS;
#pragma unroll
    for (int i = 0; i < 8; ++i) tot += sm[i];
    const float inv = 1.f / tot;
    const float* fraw = (const float*)(p.ws + WS_FRAW);
    bf16_t* R = (bf16_t*)(p.ws + WS_R) + (size_t)item * 8192;
#pragma unroll
    for (int i = 0; i < 4; ++i) {
        const int n = (tid + i * NT) * 2;
        float v0, v1;
        if (n < 4096) { v0 = (n == 0) ? 0.f : fraw[(size_t)colf * SEQ + 4096 - n]; v1 = fraw[(size_t)colf * SEQ + 4095 - n]; }
        else if (n == 4096) { v0 = fraw[(size_t)colf * SEQ]; v1 = fraw[(size_t)colb * SEQ + 1]; }
        else { v0 = fraw[(size_t)colb * SEQ + n - 4096]; v1 = fraw[(size_t)colb * SEQ + n - 4095]; }
        *(unsigned*)(R + n) = pk2(v0 * inv, v1 * inv);
    }
    __syncthreads();
}

DI void phase_b(const Params& p, float* sm) {
    const int wave = get_tid() >> 6;
    const float* mod = (const float*)(p.ws + WS_MOD);
    constexpr int ROW_ITEMS = (BT + BATCH * CTX) / 16;
    for (int it = blockIdx.x; it < ROW_ITEMS + 1024; it += gridDim.x) {
        if (it < 1024) { filter_norm_item(p, it, sm); continue; }
        const int row = (it - 1024) * 16 + wave;
        if (row < BT) {
            const int b = row >> 12;
            norm_mod_row(p.in[I_X] + (size_t)row * DM, p.in[I_NMIX], mod + b * 6144, mod + b * 6144 + 1024, (bf16_t*)(p.ws + WS_H) + (size_t)row * DM);
        } else {
            const int r = row - BT;
            norm_mod_row(p.in[I_CTX] + (size_t)r * DM, p.in[I_NMIX], mod + 8 * 6144, mod + 8 * 6144 + 1024, (bf16_t*)(p.ws + WS_HC) + (size_t)r * DM);
        }
    }
}

#define MFMA16(a, b, c) __builtin_amdgcn_mfma_f32_16x16x32_bf16((a), (b), (c), 0, 0, 0)
constexpr int GT_P = 256 * 128;
struct RowLoader {
    const bf16_t* base; int ld;
    template<int ROWS> DI void issue(unsigned char* tile, int kt, int lane, int wave) const {
#pragma unroll
        for (int i = 0; i < ROWS / 128; ++i) {
            const int grp = i * 16 + wave, row = grp * 8 + (lane >> 3), c = (lane & 7) ^ (lane >> 3);
            __builtin_amdgcn_global_load_lds((const unsigned*)(base + (size_t)row * ld + kt * 64 + c * 8), (unsigned*)(tile + grp * 1024), 16, 0, 0);
        }
    }
};

template<int NQ>
DI void gemm_mainloop(f32x4 (&acc)[4][NQ], const RowLoader& lp, const RowLoader& lq, int nk, unsigned char* lds) {
    const int tid = get_tid(), lane = tid & 63, wave = __builtin_amdgcn_readfirstlane(tid >> 6), wp = wave >> 2, wq = wave & 3;
    constexpr int QROWS = NQ * 64;
    constexpr int STAGE = GT_P + QROWS * 128;
    __syncthreads();
    lp.template issue<256>(lds, 0, lane, wave); lq.template issue<QROWS>(lds + GT_P, 0, lane, wave);
    asm volatile("s_waitcnt vmcnt(0)" ::: "memory");
    __syncthreads();
    const int l15 = lane & 15, lk = lane >> 4;
    for (int kt = 0; kt < nk; ++kt) {
        unsigned char* cur = lds + (kt & 1) * STAGE;
        unsigned char* nxt = lds + ((kt + 1) & 1) * STAGE;
        if (kt + 1 < nk) { lp.template issue<256>(nxt, kt + 1, lane, wave); lq.template issue<QROWS>(nxt + GT_P, kt + 1, lane, wave); }
#pragma unroll
        for (int ks = 0; ks < 2; ++ks) {
            bf16x8 fp[4], fq[NQ];
#pragma unroll
            for (int i = 0; i < 4; ++i) { const int row = wp * 64 + i * 16 + l15; fp[i] = *(const bf16x8*)(cur + row * 128 + (((ks * 4 + lk) ^ (row & 7)) << 4)); }
#pragma unroll
            for (int j = 0; j < NQ; ++j) { const int row = wq * (16 * NQ) + j * 16 + l15; fq[j] = *(const bf16x8*)(cur + GT_P + row * 128 + (((ks * 4 + lk) ^ (row & 7)) << 4)); }
#pragma unroll
            for (int i = 0; i < 4; ++i)
#pragma unroll
                for (int j = 0; j < NQ; ++j) acc[i][j] = MFMA16(fp[i], fq[j], acc[i][j]);
        }
        asm volatile("s_waitcnt vmcnt(0)" ::: "memory");
        __syncthreads();
    }
}

#ifndef SHADOW
#define SHADOW 0
#endif
template<int NQ>
DI void gemm_shadow(const RowLoader& lp, const RowLoader& lq, int nk, unsigned char* lds) {
    f32x4 acc[4][NQ];
#pragma unroll
    for (int i = 0; i < 4; ++i)
#pragma unroll
        for (int j = 0; j < NQ; ++j) acc[i][j] = f32x4{0.f, 0.f, 0.f, 0.f};
    if (SHADOW == 1) gemm_mainloop<NQ>(acc, lp, lq, nk, lds);
    else {
        const int tid = get_tid(), lane = tid & 63, wave = __builtin_amdgcn_readfirstlane(tid >> 6), wp = wave >> 2, wq = wave & 3;
        constexpr int QROWS = NQ * 64;
        constexpr int STAGE = GT_P + QROWS * 128;
        const int l15 = lane & 15, lk = lane >> 4;
        bf16x8 fp[4], fq[NQ];
        if (SHADOW == 3) {
#pragma unroll
            for (int i = 0; i < 4; ++i) fp[i] = *(const bf16x8*)(lds + (wp * 64 + i * 16 + l15) * 128 + lk * 16);
#pragma unroll
            for (int j = 0; j < NQ; ++j) fq[j] = *(const bf16x8*)(lds + GT_P + (wq * 16 * NQ + j * 16 + l15) * 128 + lk * 16);
        }
        for (int kt = 0; kt < nk; ++kt) {
            unsigned char* cur = lds + (kt & 1) * STAGE;
#pragma unroll
            for (int ks = 0; ks < 2; ++ks) {
                if (SHADOW == 2 || SHADOW == 4) {
#pragma unroll
                    for (int i = 0; i < 4; ++i) { const int row = wp * 64 + i * 16 + l15; fp[i] = *(const bf16x8*)(cur + row * 128 + (((ks * 4 + lk) ^ (row & 7)) << 4)); }
#pragma unroll
                    for (int j = 0; j < NQ; ++j) { const int row = wq * (16 * NQ) + j * 16 + l15; fq[j] = *(const bf16x8*)(cur + GT_P + row * 128 + (((ks * 4 + lk) ^ (row & 7)) << 4)); }
                }
#pragma unroll
                for (int i = 0; i < 4; ++i)
#pragma unroll
                    for (int j = 0; j < NQ; ++j) acc[i][j] = MFMA16(fp[i], fq[j], acc[i][j]);
            }
            if (SHADOW == 2) asm volatile("" ::: "memory");
            if (SHADOW == 4) __syncthreads();
        }
    }
#pragma unroll
    for (int i = 0; i < 4; ++i)
#pragma unroll
        for (int j = 0; j < NQ; ++j) asm volatile("" :: "v"(acc[i][j]));
}

DI void head_epilogue(f32x4 (&acc)[4][4], const float* __restrict__ g, float gscale, const float* __restrict__ rope, bool do_rope, int t_base  , bf16_t* __restrict__ dst  , int lane) {
    const int l15 = lane & 15, lk = lane >> 4;
    float gg[4];
#pragma unroll
    for (int j = 0; j < 4; ++j) gg[j] = g[j * 16 + l15] * gscale;
#pragma unroll
    for (int i = 0; i < 4; ++i) {
#pragma unroll
        for (int r = 0; r < 4; ++r) {
            float ss = 0.f;
#pragma unroll
            for (int j = 0; j < 4; ++j) ss += acc[i][j][r] * acc[i][j][r];
            ss = sum16(ss);
            const float rs = rsqrtf(ss * (1.f / 64.f) + EPS);
            float v[4];
#pragma unroll
            for (int j = 0; j < 4; ++j) v[j] = acc[i][j][r] * rs * gg[j];
            const int t = t_base + i * 16 + lk * 4 + r;
            if (do_rope) {
                const int prow = (t >> 6) & 63, pcol = t & 63;
                const float c0 = rope[prow * 16 + l15], s0 = rope[1024 + prow * 16 + l15];
                const float c1 = rope[pcol * 16 + l15], s1 = rope[1024 + pcol * 16 + l15];
                const float a0 = v[0] * c0 - v[1] * s0, a1 = v[1] * c0 + v[0] * s0;
                const float a2 = v[2] * c1 - v[3] * s1, a3 = v[3] * c1 + v[2] * s1;
                v[0] = a0; v[1] = a1; v[2] = a2; v[3] = a3;
            }
            bf16_t* d = dst + (size_t)(i * 16 + lk * 4 + r) * 64 + l15;
#pragma unroll
            for (int j = 0; j < 4; ++j) d[j * 16] = (bf16_t)f2bf(v[j]);
        }
    }
}
DI void tstore_epilogue(f32x4 (&acc)[4][4], bf16_t* __restrict__ dst  , size_t ld, int lane) {
    const int l15 = lane & 15, lk = lane >> 4;
#pragma unroll
    for (int i = 0; i < 4; ++i)
#pragma unroll
        for (int j = 0; j < 4; ++j)
            *(u32x2*)(dst + (size_t)(j * 16 + l15) * ld + i * 16 + lk * 4) = u32x2{pk2(acc[i][j][0], acc[i][j][1]), pk2(acc[i][j][2], acc[i][j][3])};
}

DI void phase_c(const Params& p, unsigned char* lds) {
    constexpr int NTM = BT / 256, NTN = INC / 256;
    constexpr int MAIN = NTM * NTN, TOTAL = MAIN + 8;
    const bf16_t* H = (const bf16_t*)(p.ws + WS_H);
    const bf16_t* HCp = (const bf16_t*)(p.ws + WS_HC);
    const bf16_t* WT = (const bf16_t*)(p.ws + WS_WTIN);
    const float* rope = (const float*)(p.ws + WS_ROPE);
    for (int it = blockIdx.x; it < TOTAL; it += gridDim.x) {
        const int tid = get_tid(), lane = tid & 63, wave = tid >> 6, wa = wave >> 2, wb = wave & 3;
        int tm, tn; bool ctx = false;
        if (it < MAIN) { const int g = it / (16 * NTN), rem = it % (16 * NTN); tn = rem >> 4; tm = g * 16 + (rem & 15); }
        else { ctx = true; tm = it - MAIN; tn = 2; }
        const bf16_t* A = ctx ? HCp + (size_t)tm * 256 * DM : H + (size_t)tm * 256 * DM;
        const bf16_t* W = WT + (size_t)tn * 256 * DM;
        f32x4 acc[4][4];
#pragma unroll
        for (int i = 0; i < 4; ++i)
#pragma unroll
            for (int j = 0; j < 4; ++j) acc[i][j] = f32x4{0.f, 0.f, 0.f, 0.f};
        if (tn >= 9) {
            gemm_mainloop<4>(acc, RowLoader{W, DM}, RowLoader{A, DM}, DM / 64, lds);
            bf16_t* G = (bf16_t*)(p.ws + WS_G);
            const int l15 = lane & 15, lk = lane >> 4;
#pragma unroll
            for (int i = 0; i < 4; ++i)
#pragma unroll
                for (int j = 0; j < 4; ++j) {
                    const int n = tn * 256 - 2304 + wa * 64 + i * 16 + lk * 4;
                    const int tok = tm * 256 + wb * 64 + j * 16 + l15;
                    float sg[4];
#pragma unroll
                    for (int r = 0; r < 4; ++r) sg[r] = 1.f / (1.f + __expf(-acc[i][j][r]));
                    *(u32x2*)(G + (size_t)tok * GC + n) = u32x2{pk2(sg[0], sg[1]), pk2(sg[2], sg[3])};
                }
            continue;
        }
        if (SHADOW) gemm_shadow<4>(RowLoader{A, DM}, RowLoader{W, DM}, DM / 64, lds);
        gemm_mainloop<4>(acc, RowLoader{A, DM}, RowLoader{W, DM}, DM / 64, lds);
        const int b = ctx ? tm : (tm >> 4);
        const int tpos = ctx ? SEQ + wa * 64 : ((tm & 15) * 256 + wa * 64);
        if (tn < 2) {
            const int h = tn * 4 + wb;
            bf16_t* Q = (bf16_t*)(p.ws + WS_Q) + ((size_t)(b * NH + h) * SEQ + tpos) * HD;
            head_epilogue(acc, p.in[I_QNG], 0.125f * 1.4426950408889634f, rope, true, tpos, Q, lane);
        } else if (tn == 2) {
            if (wb < 2) {
                bf16_t* K = (bf16_t*)(p.ws + WS_KB) + ((size_t)(b * NKV + wb) * TK + tpos) * HD;
                head_epilogue(acc, p.in[I_KNG], 1.f, rope, !ctx, tpos, K, lane);
            } else {
                bf16_t* V = (bf16_t*)(p.ws + WS_VT) + (size_t)(b * NKV + (wb - 2)) * HD * TK + tpos;
                tstore_epilogue(acc, V, TK, lane);
            }
        } else {
            const int col = tn * 256 - 768 + wb * 64;
            bf16_t* Z = (bf16_t*)(p.ws + WS_ZT) + (size_t)col * BT + (size_t)b * SEQ + tpos;
            tstore_epilogue(acc, Z, BT, lane);
        }
    }
}

#define MFMA32(a, b, c) __builtin_amdgcn_mfma_f32_32x32x16_bf16((a), (b), (c), 0, 0, 0)
DI bf16x8 pack_step(const f32x16& x, int s) {
    u32x4 pk;
    asm volatile("v_cvt_pk_bf16_f32 %0, %4, %5\n\tv_cvt_pk_bf16_f32 %1, %6, %7\n\tv_cvt_pk_bf16_f32 %2, %8, %9\n\tv_cvt_pk_bf16_f32 %3, %10, %11\n\ts_nop 1"
                 : "=&v"(pk[0]), "=&v"(pk[1]), "=&v"(pk[2]), "=&v"(pk[3])
                 : "v"(x[8 * s]), "v"(x[8 * s + 1]), "v"(x[8 * s + 2]), "v"(x[8 * s + 3]), "v"(x[8 * s + 4]), "v"(x[8 * s + 5]), "v"(x[8 * s + 6]), "v"(x[8 * s + 7]));
    return __builtin_bit_cast(bf16x8, pk);
}

constexpr int AT_KSTR = 144, AT_VSTR = 136, AT_VOFF = 64 * AT_KSTR, AT_STAGE = AT_VOFF + 64 * AT_VSTR;
DI void attn_item(const Params& p, int item, unsigned char* lds) {
    const int tid = get_tid(), lane = tid & 63, wave = tid >> 6;
    const int b = item >> 6, kvh = (item >> 5) & 1, qb = item & 31;
    const int h = kvh * 4 + (wave >> 2), q0 = qb * 128 + (wave & 3) * 32;
    const int qi = lane & 31, hf = lane >> 5;
    const bf16_t* Qp = (const bf16_t*)(p.ws + WS_Q) + ((size_t)(b * NH + h) * SEQ + q0 + qi) * HD;
    bf16x8 qf[4];
#pragma unroll
    for (int s = 0; s < 4; ++s) qf[s] = *(const bf16x8*)(Qp + 16 * s + 8 * hf);
    const bf16_t* Kg = (const bf16_t*)(p.ws + WS_KB) + (size_t)(b * NKV + kvh) * TK * HD;
    const bf16_t* Vg = (const bf16_t*)(p.ws + WS_VT) + (size_t)(b * NKV + kvh) * HD * TK;
    const bool isK = tid < 512;
    const int li = tid & 511, lrow = li >> 3, lc = li & 7;
    const bf16_t* src = isK ? Kg + (size_t)lrow * HD + lc * 8 : Vg + (size_t)lrow * TK + lc * 8;
    const size_t sstep = isK ? (size_t)64 * HD : 64;
    const int ldst = isK ? lrow * AT_KSTR + lc * 16 : AT_VOFF + lrow * AT_VSTR + lc * 16;
    constexpr int NTILE = TK / 64;
    f32x16 o0, o1;
#pragma unroll
    for (int i = 0; i < 16; ++i) { o0[i] = 0.f; o1[i] = 0.f; }
    float l = 0.f;
    __syncthreads();
    constexpr int NSUB = 4, NSTG = NTILE / NSUB;
    static_assert(NTILE % NSUB == 0 && 2 * NSUB * AT_STAGE <= LDS_USER, "attention LDS stages");
    u32x4 stg[NSUB];
#pragma unroll
    for (int j = 0; j < NSUB; ++j) stg[j] = *(const u32x4*)(src + (size_t)j * sstep);
#pragma unroll
    for (int j = 0; j < NSUB; ++j) { unsigned char* d = lds + j * AT_STAGE + ldst; *(u32x2*)d = u32x2{stg[j][0], stg[j][1]}; *(u32x2*)(d + 8) = u32x2{stg[j][2], stg[j][3]}; }
    __syncthreads();
    const int koff = qi * AT_KSTR + hf * 16;
    const int voff = AT_VOFF + qi * AT_VSTR + hf * 8;
    for (int st = 0; st < NSTG; ++st) {
      const bool more = st + 1 < NSTG;
      if (more) {
#pragma unroll
          for (int j = 0; j < NSUB; ++j) stg[j] = *(const u32x4*)(src + (size_t)((st + 1) * NSUB + j) * sstep);
      }
#pragma unroll 1
      for (int j = 0; j < NSUB; ++j) {
        const unsigned char* cur = lds + ((st & 1) * NSUB + j) * AT_STAGE;
        f32x16 sA, sB;
#pragma unroll
        for (int i = 0; i < 16; ++i) { sA[i] = 0.f; sB[i] = 0.f; }
#pragma unroll
        for (int s = 0; s < 4; ++s) sA = MFMA32(*(const bf16x8*)(cur + koff + s * 32), qf[s], sA);
#pragma unroll
        for (int s = 0; s < 4; ++s) sB = MFMA32(*(const bf16x8*)(cur + koff + 32 * AT_KSTR + s * 32), qf[s], sB);
        float ps = 0.f;
#pragma unroll
        for (int kb = 0; kb < 2; ++kb) {
            f32x16& sx = kb ? sB : sA;
#pragma unroll
            for (int i = 0; i < 16; ++i) { sx[i] = __builtin_amdgcn_exp2f(sx[i]); ps += sx[i]; }
#pragma unroll
            for (int s2 = 0; s2 < 2; ++s2) {
                const bf16x8 pf = pack_step(sx, s2);
#pragma unroll
                for (int db = 0; db < 2; ++db) {
                    const unsigned char* vb = cur + voff + db * 32 * AT_VSTR + (4 * kb + 2 * s2) * 16;
                    const s16x4 lo = lds_rd64(vb);
                    const s16x4 hi = lds_rd64(vb + 16);
                    const bf16x8 vf = __builtin_shufflevector(lo, hi, 0, 1, 2, 3, 4, 5, 6, 7);
                    if (db == 0) o0 = MFMA32(vf, pf, o0); else o1 = MFMA32(vf, pf, o1);
                }
            }
        }
        l += ps;
      }
      if (more) {
#pragma unroll
          for (int j = 0; j < NSUB; ++j) { unsigned char* d = lds + (((st + 1) & 1) * NSUB + j) * AT_STAGE + ldst; *(u32x2*)d = u32x2{stg[j][0], stg[j][1]}; *(u32x2*)(d + 8) = u32x2{stg[j][2], stg[j][3]}; }
      }
      __syncthreads();
    }
    l = sum_x32(l);
    const float inv = 1.f / l;
    bf16_t* O;
    {
        const int t2 = get_tid(), lane2 = t2 & 63, wave2 = t2 >> 6;
        const int h2 = kvh * 4 + (wave2 >> 2), q2 = qb * 128 + (wave2 & 3) * 32 + (lane2 & 31);
        O = (bf16_t*)(p.ws + WS_ATT) + ((size_t)b * SEQ + q2) * QD + h2 * HD + 4 * (lane2 >> 5);
    }
#pragma unroll
    for (int g4 = 0; g4 < 4; ++g4) {
        *(u32x2*)(O + 8 * g4)      = u32x2{pk2(o0[4 * g4] * inv, o0[4 * g4 + 1] * inv), pk2(o0[4 * g4 + 2] * inv, o0[4 * g4 + 3] * inv)};
        *(u32x2*)(O + 32 + 8 * g4) = u32x2{pk2(o1[4 * g4] * inv, o1[4 * g4 + 1] * inv), pk2(o1[4 * g4 + 2] * inv, o1[4 * g4 + 3] * inv)};
    }
}

constexpr int HY_USTR = 8208, HY_R = 8 * HY_USTR, HY_RSTR = 16384 + 64;
DI void hy_load_filter(const bf16_t* __restrict__ R, unsigned char* lds, int tid) {
    const int i0 = tid * 8;
    const u32x4 w = *(const u32x4*)(R + i0);
    u32x2 nx = u32x2{0u, 0u};
    if (i0 + 8 < 8192) nx = *(const u32x2*)(R + i0 + 8);
    unsigned char* d = lds + HY_R + i0 * 2;
    *(u32x4*)(d) = w;
    *(u32x4*)(d + HY_RSTR) = u32x4{__builtin_amdgcn_alignbit(w[1], w[0], 16), __builtin_amdgcn_alignbit(w[2], w[1], 16), __builtin_amdgcn_alignbit(w[3], w[2], 16), __builtin_amdgcn_alignbit(nx[0], w[3], 16)};
    *(u32x4*)(d + 2 * HY_RSTR) = u32x4{w[1], w[2], w[3], nx[0]};
    *(u32x4*)(d + 3 * HY_RSTR) = u32x4{__builtin_amdgcn_alignbit(w[2], w[1], 16), __builtin_amdgcn_alignbit(w[3], w[2], 16), __builtin_amdgcn_alignbit(nx[0], w[3], 16), __builtin_amdgcn_alignbit(nx[1], nx[0], 16)};
}
DI void short_conv4(const bf16_t* __restrict__ zrow  , int t4, float w0, float w1, float w2, float bias, float (&out)[4]) {
    const u32x2 v = *(const u32x2*)(zrow + t4);
    const float z0 = bflo(v[0]), z1 = bfhi(v[0]), z2 = bflo(v[1]), z3 = bfhi(v[1]);
    const float zm = (t4 > 0) ? bf2f(zrow[t4 - 1]) : 0.f;
    const float zp = (t4 + 4 < SEQ) ? bf2f(zrow[t4 + 4]) : 0.f;
    out[0] = zm * w0 + z0 * w1 + z1 * w2 + bias;
    out[1] = z0 * w0 + z1 * w1 + z2 * w2 + bias;
    out[2] = z1 * w0 + z2 * w1 + z3 * w2 + bias;
    out[3] = z2 * w0 + z3 * w1 + zp * w2 + bias;
}
DI void hyena_item(const Params& p, int c, unsigned char* lds) {
    const int tid = get_tid(), lane = tid & 63, ig = tid >> 6;
    const bf16_t* ZT = (const bf16_t*)(p.ws + WS_ZT);
    const float* cw = p.in[I_HCW];
    const float* cb = p.in[I_HCB];
    __syncthreads();
    {
        const int b = tid >> 7, tb = (tid & 127) * 32;
        const bf16_t* zrow = ZT + (size_t)c * BT + (size_t)b * SEQ;
        const float w0 = cw[c], w1 = cw[HYC + c], w2 = cw[2 * HYC + c], bias = cb[c];
#pragma unroll
        for (int q = 0; q < 8; ++q) {
            float o[4];
            short_conv4(zrow, tb + 4 * q, w0, w1, w2, bias, o);
            *(u32x2*)(lds + b * HY_USTR + (tb + 4 * q) * 2) = u32x2{pk2(o[0], o[1]), pk2(o[2], o[3])};
        }
    }
    const int r = lane & 31, hf = lane >> 5, Il = r >> 3, bb = r & 7;
#pragma unroll 1
    for (int o = 0; o < 2; ++o) {
        hy_load_filter((const bf16_t*)(p.ws + WS_R) + (size_t)(o * 512 + c) * 8192, lds, tid);
        __syncthreads();
        f32x16 acc0, acc1;
#pragma unroll
        for (int i = 0; i < 16; ++i) { acc0[i] = 0.f; acc1[i] = 0.f; }
        const int sh = (-r) & 3;
        const unsigned char* abase = lds + HY_R + sh * HY_RSTR + (4096 + 8 * hf - r - sh) * 2 - 64;
        const unsigned char* ubase = lds + bb * HY_USTR + ((4 * ig + Il) * 64 + 8 * hf) * 2;
#define HY_STEP(MASKED) do { \
            const unsigned char* ap = abase - 128 * d; \
            const unsigned char* ub = ubase - 128 * d; \
            bool valid = true; \
            if (MASKED) { const int J = 4 * ig + Il - d; valid = (unsigned)J < 64u; if (!valid) ub = lds; } \
            _Pragma("unroll") for (int ks = 0; ks < 4; ++ks) { \
                u32x4 braw = *(const u32x4*)(ub + ks * 32); \
                if (MASKED) { if (!valid) braw = u32x4{0u, 0u, 0u, 0u}; } \
                const bf16x8 bf = __builtin_bit_cast(bf16x8, braw); \
                { const s16x4 lo = lds_rd64(ap + 32 * ks + 64), hi = lds_rd64(ap + 32 * ks + 72);     \
                  acc0 = MFMA32(__builtin_shufflevector(lo, hi, 0, 1, 2, 3, 4, 5, 6, 7), bf, acc0); } \
                { const s16x4 lo = lds_rd64(ap + 32 * ks), hi = lds_rd64(ap + 32 * ks + 8); \
                  acc1 = MFMA32(__builtin_shufflevector(lo, hi, 0, 1, 2, 3, 4, 5, 6, 7), bf, acc1); } \
            } } while (0)
        const int dlo = 4 * ig - 63, dhi = 4 * ig + 3;
#pragma unroll 1
        for (int d = dlo; d < dlo + 3; ++d) HY_STEP(true);
#pragma unroll 1
        for (int d = dlo + 3; d <= dhi - 3; ++d) HY_STEP(false);
#pragma unroll 1
        for (int d = dhi - 2; d <= dhi; ++d) HY_STEP(true);
#undef HY_STEP
        __syncthreads();
        const float skip = p.in[I_HSKIP][o * HYD + c];
        const int gcol = (o == 0 ? 512 : 1024) + c;
        const float w0 = cw[gcol], w1 = cw[HYC + gcol], w2 = cw[2 * HYC + gcol], bias = cb[gcol];
        const bf16_t* zrow = ZT + (size_t)gcol * BT + (size_t)bb * SEQ;
        bf16_t* hyt = (bf16_t*)(p.ws + WS_HYT) + (size_t)c * BT + (size_t)bb * SEQ;
#pragma unroll
        for (int mm = 0; mm < 2; ++mm) {
#pragma unroll
            for (int g4 = 0; g4 < 4; ++g4) {
                const int t4 = (4 * ig + Il) * 64 + 32 * mm + 8 * g4 + 4 * hf;
                float gt[4];
                short_conv4(zrow, t4, w0, w1, w2, bias, gt);
                unsigned char* up = lds + bb * HY_USTR + t4 * 2;
                const u32x2 uv = *(const u32x2*)up;
                const float u0 = bflo(uv[0]), u1 = bfhi(uv[0]), u2 = bflo(uv[1]), u3 = bfhi(uv[1]);
                const f32x16& a = mm ? acc1 : acc0;
                const float y0 = gt[0] * (a[4 * g4] + skip * u0), y1 = gt[1] * (a[4 * g4 + 1] + skip * u1);
                const float y2 = gt[2] * (a[4 * g4 + 2] + skip * u2), y3 = gt[3] * (a[4 * g4 + 3] + skip * u3);
                const u32x2 pk = u32x2{pk2(y0, y1), pk2(y2, y3)};
                if (o == 0) *(u32x2*)up = pk; else *(u32x2*)(hyt + t4) = pk;
            }
        }
        __syncthreads();
    }
}

constexpr int CTL_QUEUE_D = 8192;
template<bool HY> DI void phase_d(const Params& p, unsigned char* lds) {
    unsigned* ctr = (unsigned*)(p.ws + WS_CTL) + CTL_QUEUE_D + (HY ? 0 : 64);
    volatile LAS unsigned* slot = (volatile LAS unsigned*)(LAS unsigned char*)(lds + LDS_ST_OFF + 8);
    for (;;) {
        __syncthreads();
        if (get_tid() == 0) slot[0] = atomicAdd(ctr, 1u);
        __syncthreads();
        const int it = __builtin_amdgcn_readfirstlane((int)slot[0]);
        if (it >= 512) break;
        if (HY) hyena_item(p, it, lds); else attn_item(p, it, lds);
    }
}

DI void phase_d2(const Params& p, unsigned char* lds) {
    constexpr int TILES = 8 * (BT / 256);
    constexpr int CONV = 2 * 16384 * 1024 / 8192;
    const bf16_t* HYT = (const bf16_t*)(p.ws + WS_HYT);
    bf16_t* HY = (bf16_t*)(p.ws + WS_HY);
    for (int it = blockIdx.x; it < TILES + CONV; it += gridDim.x) {
        const int tid = get_tid();
        if (it >= TILES) {
            const int ci = it - TILES;
            const size_t el = (size_t)(ci & 2047) * 8192 + tid * 8;
            const float* src = (ci < 2048 ? p.in[I_PU] : p.in[I_PV]) + el;
            const float sc = ci < 2048 ? USCALE : VSCALE;
            const f32x4 a = *(const f32x4*)src, b = *(const f32x4*)(src + 4);
            int w0 = 0, w1 = 0;
            w0 = __builtin_amdgcn_cvt_pk_fp8_f32(a[0] * sc, a[1] * sc, w0, false); w0 = __builtin_amdgcn_cvt_pk_fp8_f32(a[2] * sc, a[3] * sc, w0, true);
            w1 = __builtin_amdgcn_cvt_pk_fp8_f32(b[0] * sc, b[1] * sc, w1, false); w1 = __builtin_amdgcn_cvt_pk_fp8_f32(b[2] * sc, b[3] * sc, w1, true);
            const size_t e = el >> 10, col = el & 1023;
            unsigned char* dst = ci < 2048 ? p.ws + WS_UT + el : p.ws + WS_VTAB + ((col >> 7) * 16384 + e) * 128 + (col & 127);
            *(u32x2*)dst = u32x2{(unsigned)w0, (unsigned)w1};
            continue;
        }
        const int c0 = (it & 7) * 64, tok0 = (it >> 3) * 256;
        __syncthreads();
#pragma unroll
        for (int i = 0; i < 2; ++i) {
            const int idx = tid + i * NT, c = idx >> 5, tg = idx & 31;
            *(u32x4*)(lds + c * 528 + tg * 16) = *(const u32x4*)(HYT + (size_t)(c0 + c) * BT + tok0 + tg * 8);
        }
        __syncthreads();
#pragma unroll
        for (int i = 0; i < 2; ++i) {
            const int idx = tid + i * NT, tok = idx >> 3, cg = idx & 7;
            unsigned w[4];
#pragma unroll
            for (int e = 0; e < 4; ++e) {
                const unsigned lo = *(const unsigned short*)(lds + (cg * 8 + 2 * e) * 528 + tok * 2);
                const unsigned hi = *(const unsigned short*)(lds + (cg * 8 + 2 * e + 1) * 528 + tok * 2);
                w[e] = lo | (hi << 16);
            }
            *(u32x4*)(HY + (size_t)(tok0 + tok) * HYD + c0 + cg * 8) = u32x4{w[0], w[1], w[2], w[3]};
        }
    }
}

DI void phase_e(const Params& p, unsigned char* lds) {
    constexpr int TILES = 4 * (BT / 128);
    for (int it = blockIdx.x; it < TILES; it += gridDim.x) {
        const int tid = get_tid(), lane = tid & 63, wave = tid >> 6, wp = wave >> 2, wq = wave & 3;
        const int tn = it & 3, tm = it >> 2;
        const int n0 = tn * 256, tok0 = tm * 128;
        f32x4 acc1[4][2], acc2[4][2];
#pragma unroll
        for (int i = 0; i < 4; ++i)
#pragma unroll
            for (int j = 0; j < 2; ++j) { acc1[i][j] = f32x4{0.f, 0.f, 0.f, 0.f}; acc2[i][j] = f32x4{0.f, 0.f, 0.f, 0.f}; }
        gemm_mainloop<2>(acc1, RowLoader{(const bf16_t*)(p.ws + WS_WTAO) + (size_t)n0 * QD, QD}, RowLoader{(const bf16_t*)(p.ws + WS_ATT) + (size_t)tok0 * QD, QD}, QD / 64, lds);
        gemm_mainloop<2>(acc2, RowLoader{(const bf16_t*)(p.ws + WS_WTHO) + (size_t)n0 * HYD, HYD}, RowLoader{(const bf16_t*)(p.ws + WS_HY) + (size_t)tok0 * HYD, HYD}, HYD / 64, lds);
        const bf16_t* G = (const bf16_t*)(p.ws + WS_G);
        bf16_t* M = (bf16_t*)(p.ws + WS_H);
        const int l15 = lane & 15, lk = lane >> 4;
#pragma unroll
        for (int i = 0; i < 4; ++i)
#pragma unroll
            for (int j = 0; j < 2; ++j) {
                const int n = n0 + wp * 64 + i * 16 + lk * 4;
                const int tok = tok0 + wq * 32 + j * 16 + l15;
                const u32x2 ga = *(const u32x2*)(G + (size_t)tok * GC + n);
                const u32x2 gh = *(const u32x2*)(G + (size_t)tok * GC + 1024 + n);
                const float m0 = bflo(ga[0]) * acc1[i][j][0] + bflo(gh[0]) * acc2[i][j][0];
                const float m1 = bfhi(ga[0]) * acc1[i][j][1] + bfhi(gh[0]) * acc2[i][j][1];
                const float m2 = bflo(ga[1]) * acc1[i][j][2] + bflo(gh[1]) * acc2[i][j][2];
                const float m3 = bfhi(ga[1]) * acc1[i][j][3] + bfhi(gh[1]) * acc2[i][j][3];
                *(u32x2*)(M + (size_t)tok * DM + n) = u32x2{pk2(m0, m1), pk2(m2, m3)};
            }
    }
}

DI void phase_f(const Params& p, unsigned char* lds) {
    constexpr int TILES = 4 * (BT / 256);
    const float* mod = (const float*)(p.ws + WS_MOD);
    for (int it = blockIdx.x; it < TILES; it += gridDim.x) {
        const int tid = get_tid(), lane = tid & 63, wave = tid >> 6, wp = wave >> 2, wq = wave & 3;
        const int tn = it & 3, tm = it >> 2;
        const int n0 = tn * 256, tok0 = tm * 256, b = tok0 >> 12;
        f32x4 acc[4][4];
#pragma unroll
        for (int i = 0; i < 4; ++i)
#pragma unroll
            for (int j = 0; j < 4; ++j) acc[i][j] = f32x4{0.f, 0.f, 0.f, 0.f};
        gemm_mainloop<4>(acc, RowLoader{(const bf16_t*)(p.ws + WS_WTO) + (size_t)n0 * DM, DM}, RowLoader{(const bf16_t*)(p.ws + WS_H) + (size_t)tok0 * DM, DM}, DM / 64, lds);
        const int l15 = lane & 15, lk = lane >> 4;
#pragma unroll
        for (int i = 0; i < 4; ++i) {
            const int n = n0 + wp * 64 + i * 16 + lk * 4;
            const f32x4 g1 = *(const f32x4*)(mod + b * 6144 + 2048 + n);
#pragma unroll
            for (int j = 0; j < 4; ++j) {
                const int tok = tok0 + wq * 64 + j * 16 + l15;
                const f32x4 xv = *(const f32x4*)(p.in[I_X] + (size_t)tok * DM + n);
                *(f32x4*)(p.out + (size_t)tok * DM + n) = f32x4{xv[0] + g1[0] * acc[i][j][0], xv[1] + g1[1] * acc[i][j][1], xv[2] + g1[2] * acc[i][j][2], xv[3] + g1[3] * acc[i][j][3]};
            }
        }
    }
}

DI void phase_g(const Params& p) {
    const float* mod = (const float*)(p.ws + WS_MOD);
    for (int it = blockIdx.x; it < BT / 16; it += gridDim.x) {
        const int row = it * 16 + (get_tid() >> 6), b = row >> 12;
        norm_mod_row(p.out + (size_t)row * DM, p.in[I_NFFN], mod + b * 6144 + 3072, mod + b * 6144 + 4096, (bf16_t*)(p.ws + WS_H) + (size_t)row * DM);
    }
}

DI void phase_h(const Params& p, unsigned char* lds) {
    constexpr int TILES = 8 * (BT / 256);
    for (int it = blockIdx.x; it < TILES; it += gridDim.x) {
        const int tid = get_tid(), lane = tid & 63, wave = tid >> 6, wp = wave >> 2, wq = wave & 3;
        const int tn = it & 7, tm = it >> 3;
        const int n0 = tn * 256, tok0 = tm * 256;
        f32x4 acc[4][4];
#pragma unroll
        for (int i = 0; i < 4; ++i)
#pragma unroll
            for (int j = 0; j < 4; ++j) acc[i][j] = f32x4{0.f, 0.f, 0.f, 0.f};
        gemm_mainloop<4>(acc, RowLoader{(const bf16_t*)(p.ws + WS_WTQ) + (size_t)n0 * DM, DM}, RowLoader{(const bf16_t*)(p.ws + WS_H) + (size_t)tok0 * DM, DM}, DM / 64, lds);
        bf16_t* QP = (bf16_t*)(p.ws + WS_G);
        const int l15 = lane & 15, lk = lane >> 4;
#pragma unroll
        for (int i = 0; i < 4; ++i)
#pragma unroll
            for (int j = 0; j < 4; ++j) {
                const int n = n0 + wp * 64 + i * 16 + lk * 4;
                const int tok = tok0 + wq * 64 + j * 16 + l15;
                *(u32x2*)(QP + (size_t)tok * 2048 + n) = u32x2{pk2(acc[i][j][0], acc[i][j][1]), pk2(acc[i][j][2], acc[i][j][3])};
            }
    }
}

DI void ins16(float (&L)[16], float v) {
#pragma unroll
    for (int i = 0; i < 16; ++i) { const float hi = fmaxf(L[i], v); v = fminf(L[i], v); L[i] = hi; }
}
DI void cex_desc(float& a, float& b) { const float hi = fmaxf(a, b), lo = fminf(a, b); a = hi; b = lo; }
DI void bitonic_merge16_desc(float (&v)[16]) {
#pragma unroll
    for (int j = 8; j > 0; j >>= 1)
#pragma unroll
        for (int i = 0; i < 16; ++i) if ((i ^ j) > i) cex_desc(v[i], v[i ^ j]);
}
DI void sort16_desc(float (&v)[16]) {
#pragma unroll
    for (int k = 2; k <= 16; k <<= 1)
#pragma unroll
        for (int j = k >> 1; j > 0; j >>= 1)
#pragma unroll
            for (int i = 0; i < 16; ++i) {
                const int l = i ^ j;
                if (l > i) { if ((i & k) == 0) cex_desc(v[i], v[l]); else cex_desc(v[l], v[i]); }
            }
}
DI void top16_merge(float (&a)[16], const float (&b)[16]) {
#pragma unroll
    for (int i = 0; i < 16; ++i) a[i] = fmaxf(a[i], b[15 - i]);
    bitonic_merge16_desc(a);
}
DI float pack_idx(float v, unsigned idx, unsigned mask) { return __uint_as_float((__float_as_uint(v) & ~mask) | idx); }
constexpr int PI_LIST = 0;
DI void peer_select_item(const Params& p, int item, unsigned char* lds) {
    const int tok0 = item * 128;
    __syncthreads();
    {
#pragma unroll 1
        for (int sb = 0; sb < 4; ++sb) {
            const int tid = get_tid(), lane = tid & 63, hp = tid >> 6;
            const int r = lane & 31, hf = lane >> 5;
            const bf16_t* keys = (const bf16_t*)(p.ws + WS_KEYS) + (size_t)((hp & 1) * 8 + (hp >> 1)) * 128 * 128 + 8 * hf;
            const bf16_t* qp = (const bf16_t*)(p.ws + WS_G) + (size_t)(tok0 + r) * 2048 + hp * 128 + 8 * hf;
            bf16x8 bq[8];
#pragma unroll
            for (int ks = 0; ks < 8; ++ks) bq[ks] = *(const bf16x8*)(qp + (size_t)sb * 32 * 2048 + 16 * ks);
            f32x16 acc[4];
#pragma unroll
            for (int m = 0; m < 4; ++m)
#pragma unroll
                for (int i = 0; i < 16; ++i) acc[m][i] = 0.f;
#pragma unroll
            for (int ks = 0; ks < 8; ++ks) {
#pragma unroll
                for (int m = 0; m < 4; ++m) {
                    const bf16x8 ak = *(const bf16x8*)(keys + (size_t)(m * 32 + r) * 128 + 16 * ks);
                    acc[m] = MFMA32(ak, bq[ks], acc[m]);
                }
            }
            float V[4][16];
#define PK_SORT(m) do { _Pragma("unroll") for (int i = 0; i < 16; ++i) V[m][i] = pack_idx(acc[m][i], (unsigned)((m) * 32 + (i & 3) + 8 * (i >> 2) + 4 * hf), 127u); sort16_desc(V[m]); } while (0)
            PK_SORT(0); PK_SORT(1); top16_merge(V[0], V[1]); __builtin_amdgcn_sched_barrier(0);
            PK_SORT(2); PK_SORT(3); top16_merge(V[2], V[3]); __builtin_amdgcn_sched_barrier(0);
            top16_merge(V[0], V[2]);
#undef PK_SORT
            float (&L)[16] = V[0];
            const int t3 = get_tid(), hf3 = (t3 >> 5) & 1, r3 = t3 & 31, hp3 = t3 >> 6;
            float P[16];
#pragma unroll
            for (int i = 0; i < 16; ++i) {
                auto sw = __builtin_amdgcn_permlane32_swap(__float_as_uint(L[i]), __float_as_uint(L[i]), false, false);
                P[i] = hf3 ? __uint_as_float(sw[0]) : __uint_as_float(sw[1]);
            }
            top16_merge(L, P);
            if (hf3 == 0) {
                float* dst = (float*)(lds + PI_LIST) + ((sb * 32 + r3) * 16 + hp3) * 16;
#pragma unroll
                for (int i = 0; i < 16; i += 4) *(f32x4*)(dst + i) = f32x4{L[i], L[i + 1], L[i + 2], L[i + 3]};
            }
        }
    }
    __syncthreads();
    {
        const int tid = get_tid();
        {
            const int tok = tid >> 3, h = tid & 7;
            const float* l1 = (const float*)(lds + PI_LIST) + (tok * 16 + 2 * h) * 16;
            const float* l2 = l1 + 16;
            float v1[16], v2[16];
#pragma unroll
            for (int i = 0; i < 16; i += 4) {
                const f32x4 a = *(const f32x4*)(l1 + i), b = *(const f32x4*)(l2 + i);
                v1[i] = a[0]; v1[i + 1] = a[1]; v1[i + 2] = a[2]; v1[i + 3] = a[3];
                v2[i] = b[0]; v2[i + 1] = b[1]; v2[i + 2] = b[2]; v2[i + 3] = b[3];
            }
            float B[16];
#pragma unroll
            for (int i = 0; i < 16; ++i) B[i] = -3.0e38f;
#pragma unroll
            for (int i = 0; i < 16; ++i)
#pragma unroll
                for (int j = 0; j < 16; ++j)
                    if ((i + 1) * (j + 1) <= 16) ins16(B, pack_idx(v1[i] + v2[j], (unsigned)(i * 16 + j), 255u));
            float e[16], sum = 0.f;
#pragma unroll
            for (int k = 0; k < 16; ++k) { e[k] = __expf(B[k] - B[0]); sum += e[k]; }
            const float inv = 1.f / sum;
            int* ex = (int*)(p.ws + WS_EXPI) + (size_t)(tok0 + tok) * 128 + h * 16;
            float* gt = (float*)(p.ws + WS_GATE) + (size_t)(tok0 + tok) * 128 + h * 16;
            int ev[16]; float gv[16];
#pragma unroll
            for (int k = 0; k < 16; ++k) {
                const unsigned ij = __float_as_uint(B[k]) & 255u;
                const unsigned i1 = __float_as_uint(l1[ij >> 4]) & 127u, i2 = __float_as_uint(l2[ij & 15u]) & 127u;
                ev[k] = (int)(i1 * 128u + i2);
                gv[k] = e[k] * inv;
            }
#pragma unroll
            for (int k = 0; k < 16; k += 4) {
                *(u32x4*)(ex + k) = u32x4{(unsigned)ev[k], (unsigned)ev[k + 1], (unsigned)ev[k + 2], (unsigned)ev[k + 3]};
                *(f32x4*)(gt + k) = f32x4{gv[k], gv[k + 1], gv[k + 2], gv[k + 3]};
            }
        }
    }
}
DI void phase_i1(const Params& p, unsigned char* lds) {
    for (int it = blockIdx.x; it < BT / 128; it += gridDim.x) peer_select_item(p, it, lds);
}

DI float dot16_fp8(const u32x4& w, const float (&x)[16]) {
    float d = 0.f;
#pragma unroll
    for (int i = 0; i < 4; ++i) {
        const auto lo = __builtin_amdgcn_cvt_pk_f32_fp8((int)w[i], false);
        const auto hi = __builtin_amdgcn_cvt_pk_f32_fp8((int)w[i], true);
        d += lo[0] * x[4 * i] + lo[1] * x[4 * i + 1] + hi[0] * x[4 * i + 2] + hi[1] * x[4 * i + 3];
    }
    return d;
}
template<class F> DI void run_partitioned(const Params& p, unsigned char* lds, int qbase, int nitems, F&& body) {
    unsigned* ctl = (unsigned*)(p.ws + WS_CTL);
    volatile LAS unsigned* slot = (volatile LAS unsigned*)(LAS unsigned char*)(lds + LDS_ST_OFF + 8);
    const int x0 = (int)(xb_xcc_id() & 7u);
#pragma unroll 1
    for (int pp = 0; pp < 8; ++pp) {
        const int part = (x0 + pp) & 7;
        for (;;) {
            __syncthreads();
            if (get_tid() == 0) slot[0] = atomicAdd(ctl + qbase + 64 * part, 1u);
            __syncthreads();
            const int it = __builtin_amdgcn_readfirstlane((int)slot[0]);
            if (it >= nitems) break;
            body(part, it);
        }
    }
}
constexpr int CTL_QUEUE_I2 = 8320, CTL_QUEUE_I3 = 8896;
constexpr int UW_BYTES = 6144, UW_GT = 4096, UW_LIST = 5120;
DI void peer_u_chunk(const Params& p, int part, int chunk, unsigned char* lds) {
    const int tid = get_tid(), lane = tid & 63, wave = __builtin_amdgcn_readfirstlane(tid >> 6);
    unsigned char* wl = lds + wave * UW_BYTES;
    unsigned* lst = (unsigned*)(wl + UW_LIST);
    const float* gts = (const float*)(wl + UW_GT);
    const unsigned char* UT8 = p.ws + WS_UT + lane * 16;
    const int tokw = chunk * 512 + wave * 2;
    int pe[4]; u32x4 ph[4]; float pg[4];
#define U_PREFETCH(tok) do { \
        const int* ex_ = (const int*)(p.ws + WS_EXPI) + (size_t)(tok) * 128 + lane; \
        const float* gt_ = (const float*)(p.ws + WS_GATE) + (size_t)(tok) * 128 + lane; \
        const bf16_t* hr_ = (const bf16_t*)(p.ws + WS_H) + (size_t)(tok) * DM + lane * 16; \
        pe[0] = ex_[0]; pe[1] = ex_[64]; pe[2] = ex_[128]; pe[3] = ex_[192]; \
        pg[0] = gt_[0]; pg[1] = gt_[64]; pg[2] = gt_[128]; pg[3] = gt_[192]; \
        ph[0] = *(const u32x4*)hr_; ph[1] = *(const u32x4*)(hr_ + 8); ph[2] = *(const u32x4*)(hr_ + DM); ph[3] = *(const u32x4*)(hr_ + DM + 8); } while (0)
    U_PREFETCH(tokw);
#pragma unroll 1
    for (int sub = 0; sub < 16; ++sub) {
        const int tok0 = tokw + sub * 32;
        *(u32x4*)(wl + lane * 32) = ph[0]; *(u32x4*)(wl + lane * 32 + 16) = ph[1];
        *(u32x4*)(wl + 2048 + lane * 32) = ph[2]; *(u32x4*)(wl + 2048 + lane * 32 + 16) = ph[3];
        int cnt = 0;
#pragma unroll
        for (int g = 0; g < 4; ++g) {
            ((float*)(wl + UW_GT))[g * 64 + lane] = pg[g];
            const bool m = (pe[g] >> 11) == part;
            const unsigned long long bm = __ballot(m);
            const int pos = cnt + __builtin_amdgcn_mbcnt_hi((unsigned)(bm >> 32), __builtin_amdgcn_mbcnt_lo((unsigned)bm, 0u));
            if (m) lst[pos] = ((unsigned)(g * 64 + lane) << 16) | (unsigned)pe[g];
            cnt += __popcll(bm);
        }
        if (sub + 1 < 16) U_PREFETCH(tok0 + 32);
#pragma unroll 1
        for (int base = 0; base < cnt; base += 8) {
            u32x4 row[8]; unsigned en[8];
#pragma unroll
            for (int q = 0; q < 8; ++q) {
                en[q] = __builtin_amdgcn_readfirstlane(lst[min(base + q, cnt - 1)]);
                row[q] = *(const u32x4*)(UT8 + (size_t)(en[q] & 0x3fffu) * 1024);
            }
            float d[8];
#pragma unroll
            for (int q = 0; q < 8; ++q) {
                const unsigned char* xr = wl + (en[q] >> 23) * 2048 + lane * 32;
                const u32x4 xa = *(const u32x4*)xr, xb = *(const u32x4*)(xr + 16);
                float acc = 0.f;
#pragma unroll
                for (int i = 0; i < 4; ++i) {
                    const auto lo = __builtin_amdgcn_cvt_scalef32_pk_bf16_fp8(row[q][i], 1.0f, false);
                    const auto hi = __builtin_amdgcn_cvt_scalef32_pk_bf16_fp8(row[q][i], 1.0f, true);
                    const unsigned x0 = (i < 2) ? xa[2 * i] : xb[2 * i - 4], x1 = (i < 2) ? xa[2 * i + 1] : xb[2 * i - 3];
                    acc = __builtin_amdgcn_fdot2_f32_bf16(lo, __builtin_bit_cast(decltype(lo), x0), acc, false);
                    acc = __builtin_amdgcn_fdot2_f32_bf16(hi, __builtin_bit_cast(decltype(hi), x1), acc, false);
                }
                d[q] = acc;
            }
            float r4[4], r2[2];
#pragma unroll
            for (int i = 0; i < 4; ++i) { auto sw = __builtin_amdgcn_permlane32_swap(__float_as_uint(d[i]), __float_as_uint(d[i + 4]), false, false); r4[i] = __uint_as_float(sw[0]) + __uint_as_float(sw[1]); }
#pragma unroll
            for (int i = 0; i < 2; ++i) { auto sw = __builtin_amdgcn_permlane16_swap(__float_as_uint(r4[i]), __float_as_uint(r4[i + 2]), false, false); r2[i] = __uint_as_float(sw[0]) + __uint_as_float(sw[1]); }
            const bool b3 = (lane & 8) != 0;
            float a = (b3 ? r2[1] : r2[0]) + dppf<0x128>(b3 ? r2[0] : r2[1]);
            a += dppf<0xB1>(a); a += dppf<0x4E>(a); a += dppf<0x141>(a);
            a *= (1.f / USCALE);
            const int g = lane >> 3;
            const unsigned ent = lst[min(base + g, cnt - 1)];
            const int idx = (int)(ent >> 16);
            const float y = 0.7978845608028654f * (a + 0.044715f * a * a * a);
            const float th = 1.f - 2.f / (__expf(2.f * y) + 1.f);
            const float w = 0.5f * a * (1.f + th) * gts[idx];
            if ((lane & 7) == 0 && base + g < cnt) ((u32x2*)(p.ws + WS_PAIRS))[(size_t)tok0 * 128 + idx] = u32x2{ent & 0x3fffu, __float_as_uint(w)};
        }
    }
#undef U_PREFETCH
}
DI void phase_i2(const Params& p, unsigned char* lds) {
    run_partitioned(p, lds, CTL_QUEUE_I2, BT / 512, [&](int part, int it) { peer_u_chunk(p, part, it, lds); });
}
typedef float f32x2 __attribute__((ext_vector_type(2)));
DI void peer_v_chunk(const Params& p, int part, int chunk, unsigned char* lds) {
    const int tid = get_tid(), lane = tid & 63, wave = __builtin_amdgcn_readfirstlane(tid >> 6);
    unsigned char* wl = lds + wave * 1024;
    const int es = lane >> 3, ch = lane & 7;
    const unsigned char* VT8 = p.ws + WS_VTAB + (size_t)part * 16384 * 128 + ch * 16;
    const float* mod = (const float*)(p.ws + WS_MOD);
    const int col = part * 128 + 16 * ch + 2 * es;
    const int tokw = chunk * 512 + wave;
    u32x4 pp = *((const u32x4*)(p.ws + WS_PAIRS + (size_t)tokw * 1024) + lane);
#pragma unroll 1
    for (int step = 0; step < 32; ++step) {
        const int tok = tokw + step * 16, b = tok >> 12;
        *(u32x4*)(wl + lane * 16) = pp;
        if (step + 1 < 32) pp = *((const u32x4*)(p.ws + WS_PAIRS + (size_t)(tok + 16) * 1024) + lane);
        float* xo = p.out + (size_t)tok * DM + col;
        const f32x2 x1 = *(const f32x2*)xo;
        const f32x2 g2 = *(const f32x2*)(mod + b * 6144 + 5120 + col);
        f32x2 acc[8];
#pragma unroll
        for (int i = 0; i < 8; ++i) acc[i] = f32x2{0.f, 0.f};
        const u32x2* pr = (const u32x2*)wl + es;
#pragma unroll 1
        for (int ih = 0; ih < 2; ++ih) {
            u32x2 pe[8]; u32x4 row[8];
#pragma unroll
            for (int q = 0; q < 8; ++q) { pe[q] = pr[(ih * 8 + q) * 8]; row[q] = *(const u32x4*)(VT8 + (size_t)pe[q][0] * 128); }
#pragma unroll
            for (int q = 0; q < 8; ++q) {
                const float w = __uint_as_float(pe[q][1]);
                const f32x2 w2 = f32x2{w, w};
#pragma unroll
                for (int i = 0; i < 4; ++i) {
                    const f32x2 lo = __builtin_amdgcn_cvt_pk_f32_fp8((int)row[q][i], false);
                    const f32x2 hi = __builtin_amdgcn_cvt_pk_f32_fp8((int)row[q][i], true);
                    acc[2 * i] += w2 * lo; acc[2 * i + 1] += w2 * hi;
                }
            }
        }
        float a16[16];
#pragma unroll
        for (int i = 0; i < 8; ++i) { a16[2 * i] = acc[i][0]; a16[2 * i + 1] = acc[i][1]; }
        float r8[8], r4[4], r2[2];
#pragma unroll
        for (int i = 0; i < 8; ++i) { auto sw = __builtin_amdgcn_permlane32_swap(__float_as_uint(a16[i]), __float_as_uint(a16[i + 8]), false, false); r8[i] = __uint_as_float(sw[0]) + __uint_as_float(sw[1]); }
#pragma unroll
        for (int i = 0; i < 4; ++i) { auto sw = __builtin_amdgcn_permlane16_swap(__float_as_uint(r8[i]), __float_as_uint(r8[i + 4]), false, false); r4[i] = __uint_as_float(sw[0]) + __uint_as_float(sw[1]); }
        const bool b3 = (lane & 8) != 0;
#pragma unroll
        for (int i = 0; i < 2; ++i) { const float keep = b3 ? r4[i + 2] : r4[i], send = b3 ? r4[i] : r4[i + 2]; r2[i] = keep + dppf<0x128>(send); }
        const float xa = x1[0] + g2[0] * r2[0] * (1.f / VSCALE), xb = x1[1] + g2[1] * r2[1] * (1.f / VSCALE);
        *(f32x2*)xo = f32x2{xa, xb};
        const float ss = wave_sum(xa * xa + xb * xb);
        if (lane == 0) ((float*)(p.ws + WS_SSQ))[(size_t)tok * 8 + part] = ss;
    }
}
DI void phase_i3(const Params& p, unsigned char* lds) {
    run_partitioned(p, lds, CTL_QUEUE_I3, BT / 512, [&](int part, int it) { peer_v_chunk(p, part, it, lds); });
}
DI void phase_i4(const Params& p) {
    const bool bad = xb_ld((unsigned*)(p.ws + WS_CTL) + CTL_BADTID) != 0u || xb_ld((unsigned*)(p.ws + WS_CTL) + XB_TMO) != 0u;
    for (int it = blockIdx.x; it < BT / 16; it += gridDim.x) {
        const int tid = get_tid(), lane = tid & 63, row = it * 16 + (tid >> 6);
        const float* sq = (const float*)(p.ws + WS_SSQ) + (size_t)row * 8;
        const f32x4 s0 = *(const f32x4*)sq, s1 = *(const f32x4*)(sq + 4);
        const float ss = s0[0] + s0[1] + s0[2] + s0[3] + s1[0] + s1[1] + s1[2] + s1[3];
        float rs = rsqrtf(ss * (1.f / DM) + EPS);
        if (bad) rs = __builtin_nanf("");
        float* o = p.out + (size_t)row * DM;
#pragma unroll
        for (int j = 0; j < 4; ++j) {
            const int c = j * 256 + lane * 4;
            const f32x4 v = *(const f32x4*)(o + c), g = *(const f32x4*)(p.in[I_FNG] + c);
            *(f32x4*)(o + c) = f32x4{v[0] * rs * g[0], v[1] * rs * g[1], v[2] * rs * g[2], v[3] * rs * g[3]};
        }
    }
}

__global__ void __launch_bounds__(NT) mega(Params p) {
    unsigned char* lds = g_lds;
    volatile LAS unsigned* st = (volatile LAS unsigned*)(LAS unsigned char*)(lds + LDS_ST_OFF);
    {
        const unsigned hw = __builtin_amdgcn_s_getreg((5 << 11) | 4);
        if ((threadIdx.x & 63) == 0) g_lds[LDS_WTAB_OFF + hw] = (unsigned char)(threadIdx.x >> 6);
        if (threadIdx.x < 2) st[threadIdx.x] = 0u;
        __syncthreads();
        if (get_tid() != (int)threadIdx.x) ((unsigned*)(p.ws + WS_CTL))[CTL_BADTID] = 1u;
    }
    XcdBarrier bar = xcd_barrier_post((unsigned*)(p.ws + WS_CTL), st);
    float* sm = (float*)lds;

#define STAMP(k, which) do { if (PROBE_PHASE == (k) && blockIdx.x == 0 && get_tid() == 0) ((volatile unsigned long long*)(lds + LDS_PROBE_OFF))[which] = __builtin_amdgcn_s_memrealtime(); } while (0)
    STAMP(0, 0); phase_a(p, sm);   xcd_barrier(bar); STAMP(0, 1);
    STAMP(1, 0); phase_b(p, sm);   xcd_barrier(bar); STAMP(1, 1);
    STAMP(2, 0); phase_c(p, lds);  xcd_barrier(bar); STAMP(2, 1);
    STAMP(3, 0); phase_d<true>(p, lds);  xcd_barrier(bar); STAMP(3, 1);
    STAMP(13, 0); phase_d<false>(p, lds); xcd_barrier(bar); STAMP(13, 1);
    STAMP(4, 0); phase_d2(p, lds); xcd_barrier(bar); STAMP(4, 1);
    STAMP(5, 0); phase_e(p, lds);  xcd_barrier(bar); STAMP(5, 1);
    STAMP(6, 0); phase_f(p, lds);  xcd_barrier(bar); STAMP(6, 1);
    STAMP(7, 0); phase_g(p);       xcd_barrier(bar); STAMP(7, 1);
    STAMP(8, 0); phase_h(p, lds);  xcd_barrier(bar); STAMP(8, 1);
    STAMP(9, 0); phase_i1(p, lds); xcd_barrier(bar); STAMP(9, 1);
    STAMP(10, 0); phase_i2(p, lds); xcd_barrier(bar); STAMP(10, 1);
    STAMP(11, 0); phase_i3(p, lds); xcd_barrier(bar); STAMP(11, 1);
    STAMP(12, 0); phase_i4(p);
    if (PROBE_PHASE >= 0) {
        xcd_barrier(bar); STAMP(12, 1);
        if (blockIdx.x == 0 && get_tid() == 0) {
            volatile unsigned long long* ts = (volatile unsigned long long*)(lds + LDS_PROBE_OFF);
            p.out[0] += (float)(ts[1] - ts[0]) * (0.01f / PROBE_SCALE);
        }
    }
}

extern "C" void kernel_launch(void* const* d_in, const int* in_sizes, int n_in, void* d_out, int out_size, void* d_ws, size_t ws_size, hipStream_t stream) {
    static int grid = 0;
    if (grid == 0) {
        int dev = 0, cus = 0;
        if (hipGetDevice(&dev) != hipSuccess || hipDeviceGetAttribute(&cus, hipDeviceAttributeMultiprocessorCount, dev) != hipSuccess) { fprintf(stderr, "kernel_launch: device query failed\n"); grid = -1; return; }
        if (n_in != N_IN || ws_size < WS_END) { fprintf(stderr, "kernel_launch: unexpected n_in %d or ws_size %zu (< %zu)\n", n_in, ws_size, (size_t)WS_END); grid = -1; return; }
        grid = cus;
    }
    if (grid < 0) return;
    (void)hipMemsetAsync((char*)d_ws + WS_CTL, 0, 64 * 1024, stream);
    Params p{};
    for (int i = 0; i < N_IN; ++i) p.in[i] = (const float*)d_in[i];
    p.out = (float*)d_out; p.ws = (unsigned char*)d_ws;
    hipLaunchKernelGGL(mega, dim3(grid), dim3(NT), 0, stream, p);
}
```

```cpp
#include <hip/hip_runtime.h>
#include <stdint.h>
#include <cstdio>

#define DI __device__ __forceinline__
#define LAS __attribute__((address_space(3)))
typedef unsigned short bf16_t;
typedef short bf16x8 __attribute__((ext_vector_type(8)));
typedef short s16x4 __attribute__((ext_vector_type(4)));
typedef float f32x4 __attribute__((ext_vector_type(4)));
typedef float f32x2 __attribute__((ext_vector_type(2)));
typedef float f32x16 __attribute__((ext_vector_type(16)));
typedef unsigned u32x4 __attribute__((ext_vector_type(4)));
typedef unsigned u32x2 __attribute__((ext_vector_type(2)));

#ifndef PROBE_PHASE
#define PROBE_PHASE (-1)
#endif
#ifndef PROBE_SCALE
#define PROBE_SCALE 100.f
#endif
constexpr int BATCH = 8, SEQ = 4096, DM = 1024, BT = BATCH * SEQ;
constexpr int CTX = 256, TK = SEQ + CTX;
constexpr int NH = 8, NKV = 2, HD = 64;
constexpr int QD = 512, KVD = 128, HYD = 512, HYC = 1536, GC = 2048, INC = 4352;
constexpr int PH = 8, PNK = 128, PDK = 256, PTOP = 16;
constexpr float EPS = 1e-6f;
constexpr int NT = 1024;

enum { I_X = 0, I_C, I_CTX, I_CCTX, I_ADAW, I_ADAB, I_NMIX, I_NFFN, I_WIN, I_QNG, I_KNG, I_HCW, I_HCB,
       I_HW1, I_HB1, I_HW2, I_HB2, I_HW3, I_HB3, I_HW4, I_HFREQ, I_HSKIP, I_WAO, I_WHO, I_WO, I_PWQ, I_PK1, I_PK2, I_PU, I_PV, I_FNG, N_IN };

constexpr size_t MB = 1024 * 1024;
constexpr size_t WS_CTL   = 0;
constexpr size_t WS_MOD   = 64 * 1024;
constexpr size_t WS_ROPE  = WS_MOD + 9 * 6144 * 4;
constexpr size_t WS_PART  = 512 * 1024;
constexpr size_t WS_WTIN  = 3 * MB;
constexpr size_t WS_WTAO  = WS_WTIN + (size_t)INC * DM * 2;
constexpr size_t WS_WTHO  = WS_WTAO + (size_t)DM * QD * 2;
constexpr size_t WS_WTO   = WS_WTHO + (size_t)DM * HYD * 2;
constexpr size_t WS_WTQ   = WS_WTO + (size_t)DM * DM * 2;
constexpr size_t WS_KEYS  = WS_WTQ + (size_t)2048 * DM * 2;
constexpr size_t WS_R     = WS_KEYS + (size_t)2 * 8 * 128 * 128 * 2;
constexpr size_t WS_KB    = WS_R + (size_t)2 * 512 * 8192 * 2;
constexpr size_t WS_VT    = WS_KB + (size_t)BATCH * NKV * TK * HD * 2;
constexpr size_t WS_HC    = WS_VT + (size_t)BATCH * NKV * TK * HD * 2;
constexpr size_t WS_H     = 60 * MB;
constexpr size_t WS_G     = WS_H + 64 * MB;
constexpr size_t WS_ZT    = WS_G + 128 * MB;
constexpr size_t WS_Q     = WS_ZT + 96 * MB;
constexpr size_t WS_ATT   = WS_Q + 32 * MB;
constexpr size_t WS_HYT   = WS_ATT + 32 * MB;
constexpr size_t WS_END   = WS_HYT + 32 * MB;
static_assert(WS_HC + (size_t)2048 * DM * 2 <= WS_H, "ws overlap");
constexpr size_t WS_FRAW  = WS_ATT;
constexpr size_t WS_HY    = WS_Q;
constexpr size_t WS_UT    = WS_ZT;
constexpr size_t WS_VTAB  = WS_ZT + 32 * MB;
constexpr size_t WS_EXPI  = WS_ATT;
constexpr size_t WS_GATE  = WS_Q;
constexpr size_t WS_PAIRS = WS_HYT;
constexpr size_t WS_SSQ   = WS_PART + 1 * MB;
constexpr size_t WS_USC   = WS_PART;
constexpr float VSCALE = 64.f;

constexpr int CTL_BADTID = 8000;
DI unsigned f2bf(float f) { unsigned u = __builtin_bit_cast(unsigned, f); return (u + 0x7fffu + ((u >> 16) & 1u)) >> 16; }
DI unsigned pk2(float lo, float hi) { return f2bf(lo) | (f2bf(hi) << 16); }
DI float bf2f(unsigned short b) { return __builtin_bit_cast(float, (unsigned)b << 16); }
DI float bflo(unsigned u) { return __builtin_bit_cast(float, u << 16); }
DI float bfhi(unsigned u) { return __builtin_bit_cast(float, u & 0xffff0000u); }
DI float red2pi(float x) { const float k = rintf(x * 0.15915494309189535f); float r = fmaf(-k, 6.2831854820251465f, x); return fmaf(-k, -1.7484555e-7f, r); }
DI float fsin(float x) { return __sinf(red2pi(x)); }
DI float fcos(float x) { return __cosf(red2pi(x)); }
constexpr int LDS_BYTES = 160 * 1024;
constexpr int LDS_ST_OFF = LDS_BYTES - 16;
constexpr int LDS_PROBE_OFF = LDS_BYTES - 16 - 32;
constexpr int LDS_WTAB_OFF = LDS_BYTES - 16 - 32 - 64;
constexpr int LDS_USER = LDS_WTAB_OFF;
__shared__ __attribute__((aligned(16))) unsigned char g_lds[LDS_BYTES];
DI s16x4 lds_rd64(const unsigned char* ptr) { return *(const volatile LAS s16x4*)(const LAS unsigned char*)ptr; }
DI int get_tid() {
    const unsigned hw = __builtin_amdgcn_s_getreg((5 << 11) | 4);
    unsigned w = g_lds[LDS_WTAB_OFF + hw];
    w = __builtin_amdgcn_readfirstlane(w);
    int t;
    asm volatile("v_mbcnt_lo_u32_b32 %0, -1, 0\n\tv_mbcnt_hi_u32_b32 %0, -1, %0\n\tv_lshl_or_b32 %0, %1, 6, %0" : "=&v"(t) : "s"(w));
    return t;
}
template<int CTRL> DI float dppf(float v) { return __uint_as_float(__builtin_amdgcn_update_dpp(0u, __float_as_uint(v), CTRL, 0xF, 0xF, true)); }
template<int CTRL> DI int dppi(int v) { return (int)__builtin_amdgcn_update_dpp(0u, (unsigned)v, CTRL, 0xF, 0xF, true); }
DI float sum16(float v) { v += dppf<0xB1>(v); v += dppf<0x4E>(v); v += dppf<0x141>(v); v += dppf<0x140>(v); return v; }
DI float sum_x16(float v) { auto r = __builtin_amdgcn_permlane16_swap(__float_as_uint(v), __float_as_uint(v), false, false); return __uint_as_float(r[0]) + __uint_as_float(r[1]); }
DI float sum_x32(float v) { auto r = __builtin_amdgcn_permlane32_swap(__float_as_uint(v), __float_as_uint(v), false, false); return __uint_as_float(r[0]) + __uint_as_float(r[1]); }
DI float max_x32(float v) { auto r = __builtin_amdgcn_permlane32_swap(__float_as_uint(v), __float_as_uint(v), false, false); return fmaxf(__uint_as_float(r[0]), __uint_as_float(r[1])); }
DI float wave_sum(float v) { return sum_x32(sum_x16(sum16(v))); }

#define XB_TMO      128
#define XB_XCNT(j)  (256  + 64 * (j))
#define XB_XSUB(j)  (1280 + 64 * (j))
#define XB_XGEN(j)  (2304 + 64 * (j))
#define XB_TOP      3328
#define XB_TOPGEN   3392
#define XCD_BAR_WORDS 3456
#define XB_SPIN_CAP (1u << 27)
DI unsigned xb_ld(unsigned* p)              { return __hip_atomic_load(p, __ATOMIC_RELAXED, __HIP_MEMORY_SCOPE_AGENT); }
DI unsigned xb_add(unsigned* p, unsigned v) { return __hip_atomic_fetch_add(p, v, __ATOMIC_RELAXED, __HIP_MEMORY_SCOPE_AGENT); }
DI unsigned xb_xcc_id() { return (unsigned)__builtin_amdgcn_s_getreg((3 << 11) | 20) & 0xFu; }
#define XB_SPIN(cond, bar) do { unsigned _sp = 0; while (cond) { __builtin_amdgcn_s_sleep(1); \
    if ((++_sp & 255u) == 0u) { if (xb_ld(&(bar)[XB_TMO])) break; if (_sp > XB_SPIN_CAP) { atomicAdd(&(bar)[XB_TMO], 1u); break; } } } } while (0)
struct XcdBarrier { unsigned* bar; unsigned x; volatile LAS unsigned* st; };
DI XcdBarrier xcd_barrier_post(unsigned* bar, volatile LAS unsigned* st) {
    XcdBarrier b; b.bar = bar; b.x = xb_xcc_id(); b.st = st;
    if (get_tid() == 0) (void)xb_add(&bar[XB_XCNT(b.x)], 1u);
    return b;
}
DI void xcd_barrier_complete(unsigned* bar, unsigned x, unsigned& nloc, unsigned& nx) {
    const unsigned G = gridDim.x * gridDim.y * gridDim.z;
    unsigned sum, cnt, mine, sp = 0u;
    for (;;) {
        sum = 0u; cnt = 0u; mine = 0u;
#pragma unroll
        for (unsigned j = 0; j < 16; ++j) { const unsigned c = xb_ld(&bar[XB_XCNT(j)]); sum += c; cnt += (c > 0u) ? 1u : 0u; mine = (j == x) ? c : mine; }
        if (sum == G) break;
        __builtin_amdgcn_s_sleep(1);
        if ((++sp & 255u) == 0u) { if (xb_ld(&bar[XB_TMO])) break; if (sp > XB_SPIN_CAP) { atomicAdd(&bar[XB_TMO], 1u); break; } }
    }
    nloc = mine > 0u ? mine : 1u; nx = cnt > 0u ? cnt : 1u;
}
DI void xcd_barrier(const XcdBarrier& b) {
    asm volatile("s_waitcnt vmcnt(0)" ::: "memory");
    __syncthreads();
    if (get_tid() == 0) {
        unsigned* bar = b.bar;
        __builtin_amdgcn_s_waitcnt(0);
        unsigned nloc = b.st[0], nx = b.st[1];
        if (nloc == 0u) { xcd_barrier_complete(bar, b.x, nloc, nx); b.st[0] = nloc; b.st[1] = nx; }
        const unsigned old = xb_add(&bar[XB_XSUB(b.x)], 1u);
        const unsigned gen = old / nloc;
        if (old + 1u == (gen + 1u) * nloc) {
            __builtin_amdgcn_fence(__ATOMIC_RELEASE, "agent");
            asm volatile("s_waitcnt vmcnt(0)" ::: "memory");
            const unsigned og = xb_add(&bar[XB_TOP], 1u);
            const unsigned tg = og / nx;
            if (og + 1u == (tg + 1u) * nx) xb_add(&bar[XB_TOPGEN], 1u);
            else XB_SPIN(xb_ld(&bar[XB_TOPGEN]) == tg, bar);
            __builtin_amdgcn_fence(__ATOMIC_ACQUIRE, "agent");
            xb_add(&bar[XB_XGEN(b.x)], 1u);
            asm volatile("s_waitcnt vmcnt(0)" ::: "memory");
        } else {
            XB_SPIN(xb_ld(&bar[XB_XGEN(b.x)]) == gen, bar);
            __builtin_amdgcn_fence(__ATOMIC_ACQUIRE, "agent");
            asm volatile("s_waitcnt vmcnt(0)" ::: "memory");
        }
    }
    __syncthreads();
}

struct Params { const float* in[N_IN]; float* out; unsigned char* ws; };


DI void transpose_tile(const float* __restrict__ W, int K, int N, bf16_t* __restrict__ Wt, int tile, float* sm) {
    const int tid = get_tid();
    const int ntn = N / 64, tk = tile / ntn, tn = tile % ntn;
#pragma unroll
    for (int i = 0; i < 4; ++i) {
        const int idx = tid + i * NT, kk = idx >> 6, nn = idx & 63;
        sm[kk * 65 + nn] = W[(size_t)(tk * 64 + kk) * N + tn * 64 + nn];
    }
    __syncthreads();
#pragma unroll
    for (int i = 0; i < 2; ++i) {
        const int idx = tid + i * NT, nn = idx >> 5, kp = (idx & 31) * 2;
        const unsigned v = pk2(sm[kp * 65 + nn], sm[(kp + 1) * 65 + nn]);
        *(unsigned*)(Wt + (size_t)(tn * 64 + nn) * K + tk * 64 + kp) = v;
    }
    __syncthreads();
}

DI void mod_item(const Params& p, int item, float* sm) {
    const int tid = get_tid();
    float* sc = sm;
    float* red = sm + 9 * 1024;
    for (int i = tid; i < 9 * 1024; i += NT) {
        const float v = (i < 8 * 1024) ? p.in[I_C][i] : p.in[I_CCTX][i - 8 * 1024];
        sc[i] = v / (1.f + __expf(-v));
    }
    __syncthreads();
    const int col = tid & 63, kg = tid >> 6, n0 = item * 64;
    float acc[9];
#pragma unroll
    for (int r = 0; r < 9; ++r) acc[r] = 0.f;
    const float* w = p.in[I_ADAW] + n0 + col;
#pragma unroll 8
    for (int k = kg * 64; k < kg * 64 + 64; ++k) {
        const float wv = w[(size_t)k * 6144];
#pragma unroll
        for (int r = 0; r < 9; ++r) acc[r] += sc[r * 1024 + k] * wv;
    }
#pragma unroll
    for (int r = 0; r < 9; ++r) red[(kg * 9 + r) * 64 + col] = acc[r];
    __syncthreads();
    if (tid < 9 * 64) {
        const int r = tid >> 6, c2 = tid & 63;
        float s = p.in[I_ADAB][n0 + c2];
#pragma unroll
        for (int g = 0; g < 16; ++g) s += red[(g * 9 + r) * 64 + c2];
        ((float*)(p.ws + WS_MOD))[r * 6144 + n0 + c2] = s;
    }
    __syncthreads();
}

DI void filter_item(const Params& p, int item, float* sm) {
    const int tid = get_tid();
    float* z  = sm;
    float* ha = sm + 16 * 36;
    float* hb = ha + 16 * 64;
    const int t0 = item * 16;
    if (tid < 16 * 33) {
        const int pp = tid / 33, i = tid % 33;
        const int t = t0 + pp;
        float v;
        if (i == 0) v = (float)t / (float)(SEQ - 1);
        else {
            const int fi = (i - 1) & 15;
            const float f = 1e-4f + (float)fi * ((15.f - 1e-4f) / 15.f);
            const float w = 6.283185307179586f * (float)t / (float)SEQ;
            const float a = f * w;
            v = (i <= 16) ? fcos(a) : -fsin(a);
        }
        z[pp * 36 + i] = v;
    }
    __syncthreads();
    const int pp = tid >> 6, j = tid & 63;
    const float fr = p.in[I_HFREQ][j];
    {
        float a = p.in[I_HB1][j];
        const float* w1 = p.in[I_HW1];
#pragma unroll 11
        for (int i = 0; i < 33; ++i) a += z[pp * 36 + i] * w1[i * 64 + j];
        ha[pp * 64 + j] = fsin(fr * a);
    }
    __syncthreads();
    {
        float a = p.in[I_HB2][j];
        const float* w2 = p.in[I_HW2];
#pragma unroll 8
        for (int i = 0; i < 64; ++i) a += ha[pp * 64 + i] * w2[i * 64 + j];
        hb[pp * 64 + j] = fsin(fr * a);
    }
    __syncthreads();
    {
        float a = p.in[I_HB3][j];
        const float* w3 = p.in[I_HW3];
#pragma unroll 8
        for (int i = 0; i < 64; ++i) a += hb[pp * 64 + i] * w3[i * 64 + j];
        __syncthreads();
        ha[pp * 64 + j] = fsin(fr * a);
    }
    __syncthreads();
    float* fraw = (float*)(p.ws + WS_FRAW);
    float* part = (float*)(p.ws + WS_PART);
    const float* w4 = p.in[I_HW4];
#pragma unroll 1
    for (int cc = 0; cc < 2; ++cc) {
        const int col = tid + cc * NT;
        float acc[16];
#pragma unroll
        for (int q = 0; q < 16; ++q) acc[q] = 0.f;
#pragma unroll 4
        for (int i = 0; i < 64; ++i) {
            const float wv = w4[i * 2048 + col];
#pragma unroll
            for (int q = 0; q < 16; ++q) acc[q] += ha[q * 64 + i] * wv;
        }
        const int c = col & 511, dir = (col >> 9) & 1;
        const float mind = -3.0701134573253945f, maxd = -15.350567286626973f;
        const float delta = fabsf(mind + (float)c * ((maxd - mind) / 511.f));
        float s = 0.f;
#pragma unroll
        for (int q = 0; q < 16; ++q) {
            const int t = t0 + q;
            const float t01 = (float)t / (float)(SEQ - 1);
            const float v = acc[q] * expf(-t01 * delta);
            acc[q] = v;
            if (!(dir == 1 && t == 0)) s += fabsf(v);
        }
        float* dst = fraw + (size_t)col * SEQ + t0;
#pragma unroll
        for (int q = 0; q < 16; q += 4) *(f32x4*)(dst + q) = f32x4{acc[q], acc[q + 1], acc[q + 2], acc[q + 3]};
        part[item * 2048 + col] = s;
    }
    __syncthreads();
}

DI void phase_a(const Params& p, float* sm) {
    constexpr int T_WIN = 16 * 68, T_AO = 8 * 16, T_HO = 8 * 16, T_WO = 16 * 16, T_WQ = 16 * 32;
    constexpr int E0 = T_WIN, E1 = E0 + T_AO, E2 = E1 + T_HO, E3 = E2 + T_WO, E4 = E3 + T_WQ;
    constexpr int E5 = E4 + 64;
    constexpr int E6 = E5 + 96;
    constexpr int E7 = E6 + 1;
    constexpr int E8 = E7 + 256;
    for (int it = blockIdx.x; it < E8; it += gridDim.x) {
        int item = it;
        if (item < 256) { filter_item(p, item, sm); continue; }
        item -= 256;
        if (item < 96) { mod_item(p, item, sm); continue; }
        item -= 96;
        if (item < 1) {
            const int tid = get_tid();
            float* rope = (float*)(p.ws + WS_ROPE);
            const int pos = tid >> 4, f = tid & 15;
            const float inv = powf(10000.f, -(float)(2 * f) / 32.f);
            const float ang = (float)pos * inv;
            rope[tid] = fcos(ang); rope[1024 + tid] = fsin(ang);
            continue;
        }
        item -= 1;
        if (item < 64) {
            const int tid = get_tid();
            const float* src = (item < 32) ? p.in[I_PK1] : p.in[I_PK2];
            bf16_t* dst = (bf16_t*)(p.ws + WS_KEYS) + (size_t)item * 4096;
            const f32x4 v = *(const f32x4*)(src + (size_t)(item & 31) * 4096 + tid * 4);
            *(u32x2*)(dst + tid * 4) = u32x2{pk2(v[0], v[1]), pk2(v[2], v[3])};
            continue;
        }
        item -= 64;
        if (item < T_WIN) { transpose_tile(p.in[I_WIN], DM, INC, (bf16_t*)(p.ws + WS_WTIN), item, sm); continue; }
        item -= T_WIN;
        if (item < T_AO) { transpose_tile(p.in[I_WAO], QD, DM, (bf16_t*)(p.ws + WS_WTAO), item, sm); continue; }
        item -= T_AO;
        if (item < T_HO) { transpose_tile(p.in[I_WHO], HYD, DM, (bf16_t*)(p.ws + WS_WTHO), item, sm); continue; }
        item -= T_HO;
        if (item < T_WO) { transpose_tile(p.in[I_WO], DM, DM, (bf16_t*)(p.ws + WS_WTO), item, sm); continue; }
        item -= T_WO;
        transpose_tile(p.in[I_PWQ], DM, 2048, (bf16_t*)(p.ws + WS_WTQ), item, sm);
    }
    (void)E1; (void)E2; (void)E3; (void)E4; (void)E5; (void)E6; (void)E7;
}

DI void norm_mod_row(const float* __restrict__ src, const float* __restrict__ g, const float* __restrict__ shift, const float* __restrict__ scale, bf16_t* __restrict__ dst) {
    const int lane = get_tid() & 63;
    f32x4 v[4];
    float ss = 0.f;
#pragma unroll
    for (int j = 0; j < 4; ++j) { v[j] = *(const f32x4*)(src + j * 256 + lane * 4); ss += v[j][0] * v[j][0] + v[j][1] * v[j][1] + v[j][2] * v[j][2] + v[j][3] * v[j][3]; }
    ss = wave_sum(ss);
    const float rs = rsqrtf(ss * (1.f / DM) + EPS);
#pragma unroll
    for (int j = 0; j < 4; ++j) {
        const int c = j * 256 + lane * 4;
        const f32x4 gg = *(const f32x4*)(g + c), sh = *(const f32x4*)(shift + c), sc = *(const f32x4*)(scale + c);
        float o[4];
#pragma unroll
        for (int e = 0; e < 4; ++e) o[e] = v[j][e] * rs * gg[e] * (1.f + sc[e]) + sh[e];
        *(u32x2*)(dst + c) = u32x2{pk2(o[0], o[1]), pk2(o[2], o[3])};
    }
}

DI void filter_norm_item(const Params& p, int item, float* sm) {
    const int tid = get_tid();
    const int o = item >> 9, c = item & 511;
    const int colf = o * 1024 + c, colb = colf + 512;
    const float* part = (const float*)(p.ws + WS_PART);
    float s = 0.f;
    if (tid < 512) s = part[(tid & 255) * 2048 + ((tid < 256) ? colf : colb)];
    s = wave_sum(s);
    if ((tid & 63) == 0) sm[tid >> 6] = s;
    __syncthreads();
    float tot = EPS;
#pragma unroll
    for (int i = 0; i < 8; ++i) tot += sm[i];
    const float inv = 1.f / tot;
    const float* fraw = (const float*)(p.ws + WS_FRAW);
    bf16_t* R = (bf16_t*)(p.ws + WS_R) + (size_t)item * 8192;
#pragma unroll
    for (int i = 0; i < 4; ++i) {
        const int n = (tid + i * NT) * 2;
        float v0, v1;
        if (n < 4096) { v0 = (n == 0) ? 0.f : fraw[(size_t)colf * SEQ + 4096 - n]; v1 = fraw[(size_t)colf * SEQ + 4095 - n]; }
        else if (n == 4096) { v0 = fraw[(size_t)colf * SEQ]; v1 = fraw[(size_t)colb * SEQ + 1]; }
        else { v0 = fraw[(size_t)colb * SEQ + n - 4096]; v1 = fraw[(size_t)colb * SEQ + n - 4095]; }
        *(unsigned*)(R + n) = pk2(v0 * inv, v1 * inv);
    }
    __syncthreads();
}

DI void phase_b(const Params& p, float* sm) {
    const int wave = get_tid() >> 6;
    const float* mod = (const float*)(p.ws + WS_MOD);
    constexpr int ROW_ITEMS = (BT + BATCH * CTX) / 16;
    for (int it = blockIdx.x; it < ROW_ITEMS + 1024; it += gridDim.x) {
        if (it < 1024) { filter_norm_item(p, it, sm); continue; }
        const int row = (it - 1024) * 16 + wave;
        if (row < BT) {
            const int b = row >> 12;
            norm_mod_row(p.in[I_X] + (size_t)row * DM, p.in[I_NMIX], mod + b * 6144, mod + b * 6144 + 1024, (bf16_t*)(p.ws + WS_H) + (size_t)row * DM);
        } else {
            const int r = row - BT;
            norm_mod_row(p.in[I_CTX] + (size_t)r * DM, p.in[I_NMIX], mod + 8 * 6144, mod + 8 * 6144 + 1024, (bf16_t*)(p.ws + WS_HC) + (size_t)r * DM);
        }
    }
}

#define MFMA16(a, b, c) __builtin_amdgcn_mfma_f32_16x16x32_bf16((a), (b), (c), 0, 0, 0)
constexpr int GT_P = 256 * 128;
struct RowLoader {
    const bf16_t* base; int ld;
    template<int ROWS> DI void issue(unsigned char* tile, int kt, int lane, int wave) const {
#pragma unroll
        for (int i = 0; i < ROWS / 128; ++i) {
            const int grp = i * 16 + wave, row = grp * 8 + (lane >> 3), c = (lane & 7) ^ (lane >> 3);
            __builtin_amdgcn_global_load_lds((const unsigned*)(base + (size_t)row * ld + kt * 64 + c * 8), (unsigned*)(tile + grp * 1024), 16, 0, 0);
        }
    }
};

template<int NQ>
DI void gemm_mainloop(f32x4 (&acc)[4][NQ], const RowLoader& lp, const RowLoader& lq, int nk, unsigned char* lds) {
    const int tid = get_tid(), lane = tid & 63, wave = __builtin_amdgcn_readfirstlane(tid >> 6), wp = wave >> 2, wq = wave & 3;
    constexpr int QROWS = NQ * 64;
    constexpr int STAGE = GT_P + QROWS * 128;
    __syncthreads();
    lp.template issue<256>(lds, 0, lane, wave); lq.template issue<QROWS>(lds + GT_P, 0, lane, wave);
    asm volatile("s_waitcnt vmcnt(0)" ::: "memory");
    __syncthreads();
    const int l15 = lane & 15, lk = lane >> 4;
    for (int kt = 0; kt < nk; ++kt) {
        unsigned char* cur = lds + (kt & 1) * STAGE;
        unsigned char* nxt = lds + ((kt + 1) & 1) * STAGE;
        if (kt + 1 < nk) { lp.template issue<256>(nxt, kt + 1, lane, wave); lq.template issue<QROWS>(nxt + GT_P, kt + 1, lane, wave); }
#pragma unroll
        for (int ks = 0; ks < 2; ++ks) {
            bf16x8 fp[4], fq[NQ];
#pragma unroll
            for (int i = 0; i < 4; ++i) { const int row = wp * 64 + i * 16 + l15; fp[i] = *(const bf16x8*)(cur + row * 128 + (((ks * 4 + lk) ^ (row & 7)) << 4)); }
#pragma unroll
            for (int j = 0; j < NQ; ++j) { const int row = wq * (16 * NQ) + j * 16 + l15; fq[j] = *(const bf16x8*)(cur + GT_P + row * 128 + (((ks * 4 + lk) ^ (row & 7)) << 4)); }
#pragma unroll
            for (int i = 0; i < 4; ++i)
#pragma unroll
                for (int j = 0; j < NQ; ++j) acc[i][j] = MFMA16(fp[i], fq[j], acc[i][j]);
        }
        asm volatile("s_waitcnt vmcnt(0)" ::: "memory");
        __syncthreads();
    }
}

#ifndef SHADOW
#define SHADOW 0
#endif
template<int NQ>
DI void gemm_shadow(const RowLoader& lp, const RowLoader& lq, int nk, unsigned char* lds) {
    f32x4 acc[4][NQ];
#pragma unroll
    for (int i = 0; i < 4; ++i)
#pragma unroll
        for (int j = 0; j < NQ; ++j) acc[i][j] = f32x4{0.f, 0.f, 0.f, 0.f};
    if (SHADOW == 1) gemm_mainloop<NQ>(acc, lp, lq, nk, lds);
    else {
        const int tid = get_tid(), lane = tid & 63, wave = __builtin_amdgcn_readfirstlane(tid >> 6), wp = wave >> 2, wq = wave & 3;
        constexpr int QROWS = NQ * 64;
        constexpr int STAGE = GT_P + QROWS * 128;
        const int l15 = lane & 15, lk = lane >> 4;
        bf16x8 fp[4], fq[NQ];
        if (SHADOW == 3) {
#pragma unroll
            for (int i = 0; i < 4; ++i) fp[i] = *(const bf16x8*)(lds + (wp * 64 + i * 16 + l15) * 128 + lk * 16);
#pragma unroll
            for (int j = 0; j < NQ; ++j) fq[j] = *(const bf16x8*)(lds + GT_P + (wq * 16 * NQ + j * 16 + l15) * 128 + lk * 16);
        }
        for (int kt = 0; kt < nk; ++kt) {
            unsigned char* cur = lds + (kt & 1) * STAGE;
#pragma unroll
            for (int ks = 0; ks < 2; ++ks) {
                if (SHADOW == 2 || SHADOW == 4) {
#pragma unroll
                    for (int i = 0; i < 4; ++i) { const int row = wp * 64 + i * 16 + l15; fp[i] = *(const bf16x8*)(cur + row * 128 + (((ks * 4 + lk) ^ (row & 7)) << 4)); }
#pragma unroll
                    for (int j = 0; j < NQ; ++j) { const int row = wq * (16 * NQ) + j * 16 + l15; fq[j] = *(const bf16x8*)(cur + GT_P + row * 128 + (((ks * 4 + lk) ^ (row & 7)) << 4)); }
                }
#pragma unroll
                for (int i = 0; i < 4; ++i)
#pragma unroll
                    for (int j = 0; j < NQ; ++j) acc[i][j] = MFMA16(fp[i], fq[j], acc[i][j]);
            }
            if (SHADOW == 2) asm volatile("" ::: "memory");
            if (SHADOW == 4) __syncthreads();
        }
    }
#pragma unroll
    for (int i = 0; i < 4; ++i)
#pragma unroll
        for (int j = 0; j < NQ; ++j) asm volatile("" :: "v"(acc[i][j]));
}

DI void head_epilogue(f32x4 (&acc)[4][4], const float* __restrict__ g, float gscale, const float* __restrict__ rope, bool do_rope, int t_base  , bf16_t* __restrict__ dst  , int lane) {
    const int l15 = lane & 15, lk = lane >> 4;
    float gg[4];
#pragma unroll
    for (int j = 0; j < 4; ++j) gg[j] = g[j * 16 + l15] * gscale;
#pragma unroll
    for (int i = 0; i < 4; ++i) {
#pragma unroll
        for (int r = 0; r < 4; ++r) {
            float ss = 0.f;
#pragma unroll
            for (int j = 0; j < 4; ++j) ss += acc[i][j][r] * acc[i][j][r];
            ss = sum16(ss);
            const float rs = rsqrtf(ss * (1.f / 64.f) + EPS);
            float v[4];
#pragma unroll
            for (int j = 0; j < 4; ++j) v[j] = acc[i][j][r] * rs * gg[j];
            const int t = t_base + i * 16 + lk * 4 + r;
            if (do_rope) {
                const int prow = (t >> 6) & 63, pcol = t & 63;
                const float c0 = rope[prow * 16 + l15], s0 = rope[1024 + prow * 16 + l15];
                const float c1 = rope[pcol * 16 + l15], s1 = rope[1024 + pcol * 16 + l15];
                const float a0 = v[0] * c0 - v[1] * s0, a1 = v[1] * c0 + v[0] * s0;
                const float a2 = v[2] * c1 - v[3] * s1, a3 = v[3] * c1 + v[2] * s1;
                v[0] = a0; v[1] = a1; v[2] = a2; v[3] = a3;
            }
            bf16_t* d = dst + (size_t)(i * 16 + lk * 4 + r) * 64 + l15;
#pragma unroll
            for (int j = 0; j < 4; ++j) d[j * 16] = (bf16_t)f2bf(v[j]);
        }
    }
}
DI void tstore_epilogue(f32x4 (&acc)[4][4], bf16_t* __restrict__ dst  , size_t ld, int lane) {
    const int l15 = lane & 15, lk = lane >> 4;
#pragma unroll
    for (int i = 0; i < 4; ++i)
#pragma unroll
        for (int j = 0; j < 4; ++j)
            *(u32x2*)(dst + (size_t)(j * 16 + l15) * ld + i * 16 + lk * 4) = u32x2{pk2(acc[i][j][0], acc[i][j][1]), pk2(acc[i][j][2], acc[i][j][3])};
}

DI void phase_c(const Params& p, unsigned char* lds) {
    constexpr int NTM = BT / 256, NTN = INC / 256;
    constexpr int MAIN = NTM * NTN, TOTAL = MAIN + 8;
    const bf16_t* H = (const bf16_t*)(p.ws + WS_H);
    const bf16_t* HCp = (const bf16_t*)(p.ws + WS_HC);
    const bf16_t* WT = (const bf16_t*)(p.ws + WS_WTIN);
    const float* rope = (const float*)(p.ws + WS_ROPE);
    for (int it = blockIdx.x; it < TOTAL; it += gridDim.x) {
        const int tid = get_tid(), lane = tid & 63, wave = tid >> 6, wa = wave >> 2, wb = wave & 3;
        int tm, tn; bool ctx = false;
        if (it < MAIN) { const int g = it / (16 * NTN), rem = it % (16 * NTN); tn = rem >> 4; tm = g * 16 + (rem & 15); }
        else { ctx = true; tm = it - MAIN; tn = 2; }
        const bf16_t* A = ctx ? HCp + (size_t)tm * 256 * DM : H + (size_t)tm * 256 * DM;
        const bf16_t* W = WT + (size_t)tn * 256 * DM;
        f32x4 acc[4][4];
#pragma unroll
        for (int i = 0; i < 4; ++i)
#pragma unroll
            for (int j = 0; j < 4; ++j) acc[i][j] = f32x4{0.f, 0.f, 0.f, 0.f};
        if (tn >= 9) {
            gemm_mainloop<4>(acc, RowLoader{W, DM}, RowLoader{A, DM}, DM / 64, lds);
            bf16_t* G = (bf16_t*)(p.ws + WS_G);
            const int l15 = lane & 15, lk = lane >> 4;
#pragma unroll
            for (int i = 0; i < 4; ++i)
#pragma unroll
                for (int j = 0; j < 4; ++j) {
                    const int n = tn * 256 - 2304 + wa * 64 + i * 16 + lk * 4;
                    const int tok = tm * 256 + wb * 64 + j * 16 + l15;
                    float sg[4];
#pragma unroll
                    for (int r = 0; r < 4; ++r) sg[r] = 1.f / (1.f + __expf(-acc[i][j][r]));
                    *(u32x2*)(G + (size_t)tok * GC + n) = u32x2{pk2(sg[0], sg[1]), pk2(sg[2], sg[3])};
                }
            continue;
        }
        if (SHADOW) gemm_shadow<4>(RowLoader{A, DM}, RowLoader{W, DM}, DM / 64, lds);
        gemm_mainloop<4>(acc, RowLoader{A, DM}, RowLoader{W, DM}, DM / 64, lds);
        const int b = ctx ? tm : (tm >> 4);
        const int tpos = ctx ? SEQ + wa * 64 : ((tm & 15) * 256 + wa * 64);
        if (tn < 2) {
            const int h = tn * 4 + wb;
            bf16_t* Q = (bf16_t*)(p.ws + WS_Q) + ((size_t)(b * NH + h) * SEQ + tpos) * HD;
            head_epilogue(acc, p.in[I_QNG], 0.125f * 1.4426950408889634f, rope, true, tpos, Q, lane);
        } else if (tn == 2) {
            if (wb < 2) {
                bf16_t* K = (bf16_t*)(p.ws + WS_KB) + ((size_t)(b * NKV + wb) * TK + tpos) * HD;
                head_epilogue(acc, p.in[I_KNG], 1.f, rope, !ctx, tpos, K, lane);
            } else {
                bf16_t* V = (bf16_t*)(p.ws + WS_VT) + (size_t)(b * NKV + (wb - 2)) * HD * TK + tpos;
                tstore_epilogue(acc, V, TK, lane);
            }
        } else {
            const int col = tn * 256 - 768 + wb * 64;
            bf16_t* Z = (bf16_t*)(p.ws + WS_ZT) + (size_t)col * BT + (size_t)b * SEQ + tpos;
            tstore_epilogue(acc, Z, BT, lane);
        }
    }
}

#define MFMA32(a, b, c) __builtin_amdgcn_mfma_f32_32x32x16_bf16((a), (b), (c), 0, 0, 0)
DI bf16x8 pack_step(const f32x16& x, int s) {
    u32x4 pk;
    asm volatile("v_cvt_pk_bf16_f32 %0, %4, %5\n\tv_cvt_pk_bf16_f32 %1, %6, %7\n\tv_cvt_pk_bf16_f32 %2, %8, %9\n\tv_cvt_pk_bf16_f32 %3, %10, %11\n\ts_nop 1"
                 : "=&v"(pk[0]), "=&v"(pk[1]), "=&v"(pk[2]), "=&v"(pk[3])
                 : "v"(x[8 * s]), "v"(x[8 * s + 1]), "v"(x[8 * s + 2]), "v"(x[8 * s + 3]), "v"(x[8 * s + 4]), "v"(x[8 * s + 5]), "v"(x[8 * s + 6]), "v"(x[8 * s + 7]));
    return __builtin_bit_cast(bf16x8, pk);
}

constexpr int AT_KSTR = 144, AT_VSTR = 136, AT_VOFF = 64 * AT_KSTR, AT_STAGE = AT_VOFF + 64 * AT_VSTR;
DI void attn_item(const Params& p, int item, unsigned char* lds) {
    const int tid = get_tid(), lane = tid & 63, wave = tid >> 6;
    const int b = item >> 6, kvh = (item >> 5) & 1, qb = item & 31;
    const int h = kvh * 4 + (wave >> 2), q0 = qb * 128 + (wave & 3) * 32;
    const int qi = lane & 31, hf = lane >> 5;
    const bf16_t* Qp = (const bf16_t*)(p.ws + WS_Q) + ((size_t)(b * NH + h) * SEQ + q0 + qi) * HD;
    bf16x8 qf[4];
#pragma unroll
    for (int s = 0; s < 4; ++s) qf[s] = *(const bf16x8*)(Qp + 16 * s + 8 * hf);
    const bf16_t* Kg = (const bf16_t*)(p.ws + WS_KB) + (size_t)(b * NKV + kvh) * TK * HD;
    const bf16_t* Vg = (const bf16_t*)(p.ws + WS_VT) + (size_t)(b * NKV + kvh) * HD * TK;
    const bool isK = tid < 512;
    const int li = tid & 511, lrow = li >> 3, lc = li & 7;
    const bf16_t* src = isK ? Kg + (size_t)lrow * HD + lc * 8 : Vg + (size_t)lrow * TK + lc * 8;
    const size_t sstep = isK ? (size_t)64 * HD : 64;
    const int ldst = isK ? lrow * AT_KSTR + lc * 16 : AT_VOFF + lrow * AT_VSTR + lc * 16;
    constexpr int NTILE = TK / 64;
    f32x16 o0, o1;
#pragma unroll
    for (int i = 0; i < 16; ++i) { o0[i] = 0.f; o1[i] = 0.f; }
    float l = 0.f;
    __syncthreads();
    constexpr int NSUB = 4, NSTG = NTILE / NSUB;
    static_assert(NTILE % NSUB == 0 && 2 * NSUB * AT_STAGE <= LDS_USER, "attention LDS stages");
    u32x4 stg[NSUB];
#pragma unroll
    for (int j = 0; j < NSUB; ++j) stg[j] = *(const u32x4*)(src + (size_t)j * sstep);
#pragma unroll
    for (int j = 0; j < NSUB; ++j) { unsigned char* d = lds + j * AT_STAGE + ldst; *(u32x2*)d = u32x2{stg[j][0], stg[j][1]}; *(u32x2*)(d + 8) = u32x2{stg[j][2], stg[j][3]}; }
    __syncthreads();
    const int koff = qi * AT_KSTR + hf * 16;
    const int voff = AT_VOFF + qi * AT_VSTR + hf * 8;
    for (int st = 0; st < NSTG; ++st) {
      const bool more = st + 1 < NSTG;
      if (more) {
#pragma unroll
          for (int j = 0; j < NSUB; ++j) stg[j] = *(const u32x4*)(src + (size_t)((st + 1) * NSUB + j) * sstep);
      }
#pragma unroll 1
      for (int j = 0; j < NSUB; ++j) {
        const unsigned char* cur = lds + ((st & 1) * NSUB + j) * AT_STAGE;
        f32x16 sA, sB;
#pragma unroll
        for (int i = 0; i < 16; ++i) { sA[i] = 0.f; sB[i] = 0.f; }
#pragma unroll
        for (int s = 0; s < 4; ++s) sA = MFMA32(*(const bf16x8*)(cur + koff + s * 32), qf[s], sA);
#pragma unroll
        for (int s = 0; s < 4; ++s) sB = MFMA32(*(const bf16x8*)(cur + koff + 32 * AT_KSTR + s * 32), qf[s], sB);
        float ps = 0.f;
#pragma unroll
        for (int kb = 0; kb < 2; ++kb) {
            f32x16& sx = kb ? sB : sA;
#pragma unroll
            for (int i = 0; i < 16; ++i) { sx[i] = __builtin_amdgcn_exp2f(sx[i]); ps += sx[i]; }
#pragma unroll
            for (int s2 = 0; s2 < 2; ++s2) {
                const bf16x8 pf = pack_step(sx, s2);
#pragma unroll
                for (int db = 0; db < 2; ++db) {
                    const unsigned char* vb = cur + voff + db * 32 * AT_VSTR + (4 * kb + 2 * s2) * 16;
                    const s16x4 lo = lds_rd64(vb);
                    const s16x4 hi = lds_rd64(vb + 16);
                    const bf16x8 vf = __builtin_shufflevector(lo, hi, 0, 1, 2, 3, 4, 5, 6, 7);
                    if (db == 0) o0 = MFMA32(vf, pf, o0); else o1 = MFMA32(vf, pf, o1);
                }
            }
        }
        l += ps;
      }
      if (more) {
#pragma unroll
          for (int j = 0; j < NSUB; ++j) { unsigned char* d = lds + (((st + 1) & 1) * NSUB + j) * AT_STAGE + ldst; *(u32x2*)d = u32x2{stg[j][0], stg[j][1]}; *(u32x2*)(d + 8) = u32x2{stg[j][2], stg[j][3]}; }
      }
      __syncthreads();
    }
    l = sum_x32(l);
    const float inv = 1.f / l;
    bf16_t* O;
    {
        const int t2 = get_tid(), lane2 = t2 & 63, wave2 = t2 >> 6;
        const int h2 = kvh * 4 + (wave2 >> 2), q2 = qb * 128 + (wave2 & 3) * 32 + (lane2 & 31);
        O = (bf16_t*)(p.ws + WS_ATT) + ((size_t)b * SEQ + q2) * QD + h2 * HD + 4 * (lane2 >> 5);
    }
#pragma unroll
    for (int g4 = 0; g4 < 4; ++g4) {
        *(u32x2*)(O + 8 * g4)      = u32x2{pk2(o0[4 * g4] * inv, o0[4 * g4 + 1] * inv), pk2(o0[4 * g4 + 2] * inv, o0[4 * g4 + 3] * inv)};
        *(u32x2*)(O + 32 + 8 * g4) = u32x2{pk2(o1[4 * g4] * inv, o1[4 * g4 + 1] * inv), pk2(o1[4 * g4 + 2] * inv, o1[4 * g4 + 3] * inv)};
    }
}

constexpr int HY_USTR = 8208, HY_R = 8 * HY_USTR, HY_RSTR = 16384 + 64;
DI void hy_load_filter(const bf16_t* __restrict__ R, unsigned char* lds, int tid) {
    const int i0 = tid * 8;
    const u32x4 w = *(const u32x4*)(R + i0);
    u32x2 nx = u32x2{0u, 0u};
    if (i0 + 8 < 8192) nx = *(const u32x2*)(R + i0 + 8);
    unsigned char* d = lds + HY_R + i0 * 2;
    *(u32x4*)(d) = w;
    *(u32x4*)(d + HY_RSTR) = u32x4{__builtin_amdgcn_alignbit(w[1], w[0], 16), __builtin_amdgcn_alignbit(w[2], w[1], 16), __builtin_amdgcn_alignbit(w[3], w[2], 16), __builtin_amdgcn_alignbit(nx[0], w[3], 16)};
    *(u32x4*)(d + 2 * HY_RSTR) = u32x4{w[1], w[2], w[3], nx[0]};
    *(u32x4*)(d + 3 * HY_RSTR) = u32x4{__builtin_amdgcn_alignbit(w[2], w[1], 16), __builtin_amdgcn_alignbit(w[3], w[2], 16), __builtin_amdgcn_alignbit(nx[0], w[3], 16), __builtin_amdgcn_alignbit(nx[1], nx[0], 16)};
}
DI void short_conv4(const bf16_t* __restrict__ zrow  , int t4, float w0, float w1, float w2, float bias, float (&out)[4]) {
    const u32x2 v = *(const u32x2*)(zrow + t4);
    const float z0 = bflo(v[0]), z1 = bfhi(v[0]), z2 = bflo(v[1]), z3 = bfhi(v[1]);
    const float zm = (t4 > 0) ? bf2f(zrow[t4 - 1]) : 0.f;
    const float zp = (t4 + 4 < SEQ) ? bf2f(zrow[t4 + 4]) : 0.f;
    out[0] = zm * w0 + z0 * w1 + z1 * w2 + bias;
    out[1] = z0 * w0 + z1 * w1 + z2 * w2 + bias;
    out[2] = z1 * w0 + z2 * w1 + z3 * w2 + bias;
    out[3] = z2 * w0 + z3 * w1 + zp * w2 + bias;
}
DI void hyena_item(const Params& p, int c, unsigned char* lds) {
    const int tid = get_tid(), lane = tid & 63, ig = tid >> 6;
    const bf16_t* ZT = (const bf16_t*)(p.ws + WS_ZT);
    const float* cw = p.in[I_HCW];
    const float* cb = p.in[I_HCB];
    __syncthreads();
    {
        const int b = tid >> 7, tb = (tid & 127) * 32;
        const bf16_t* zrow = ZT + (size_t)c * BT + (size_t)b * SEQ;
        const float w0 = cw[c], w1 = cw[HYC + c], w2 = cw[2 * HYC + c], bias = cb[c];
#pragma unroll
        for (int q = 0; q < 8; ++q) {
            float o[4];
            short_conv4(zrow, tb + 4 * q, w0, w1, w2, bias, o);
            *(u32x2*)(lds + b * HY_USTR + (tb + 4 * q) * 2) = u32x2{pk2(o[0], o[1]), pk2(o[2], o[3])};
        }
    }
    const int r = lane & 31, hf = lane >> 5, Il = r >> 3, bb = r & 7;
#pragma unroll 1
    for (int o = 0; o < 2; ++o) {
        hy_load_filter((const bf16_t*)(p.ws + WS_R) + (size_t)(o * 512 + c) * 8192, lds, tid);
        __syncthreads();
        f32x16 acc0, acc1;
#pragma unroll
        for (int i = 0; i < 16; ++i) { acc0[i] = 0.f; acc1[i] = 0.f; }
        const int sh = (-r) & 3;
        const unsigned char* abase = lds + HY_R + sh * HY_RSTR + (4096 + 8 * hf - r - sh) * 2 - 64;
        const unsigned char* ubase = lds + bb * HY_USTR + ((4 * ig + Il) * 64 + 8 * hf) * 2;
#define HY_STEP(MASKED) do { \
            const unsigned char* ap = abase - 128 * d; \
            const unsigned char* ub = ubase - 128 * d; \
            bool valid = true; \
            if (MASKED) { const int J = 4 * ig + Il - d; valid = (unsigned)J < 64u; if (!valid) ub = lds; } \
            _Pragma("unroll") for (int ks = 0; ks < 4; ++ks) { \
                u32x4 braw = *(const u32x4*)(ub + ks * 32); \
                if (MASKED) { if (!valid) braw = u32x4{0u, 0u, 0u, 0u}; } \
                const bf16x8 bf = __builtin_bit_cast(bf16x8, braw); \
                { const s16x4 lo = lds_rd64(ap + 32 * ks + 64), hi = lds_rd64(ap + 32 * ks + 72);     \
                  acc0 = MFMA32(__builtin_shufflevector(lo, hi, 0, 1, 2, 3, 4, 5, 6, 7), bf, acc0); } \
                { const s16x4 lo = lds_rd64(ap + 32 * ks), hi = lds_rd64(ap + 32 * ks + 8); \
                  acc1 = MFMA32(__builtin_shufflevector(lo, hi, 0, 1, 2, 3, 4, 5, 6, 7), bf, acc1); } \
            } } while (0)
        const int dlo = 4 * ig - 63, dhi = 4 * ig + 3;
#pragma unroll 1
        for (int d = dlo; d < dlo + 3; ++d) HY_STEP(true);
#pragma unroll 1
        for (int d = dlo + 3; d <= dhi - 3; ++d) HY_STEP(false);
#pragma unroll 1
        for (int d = dhi - 2; d <= dhi; ++d) HY_STEP(true);
#undef HY_STEP
        __syncthreads();
        const float skip = p.in[I_HSKIP][o * HYD + c];
        const int gcol = (o == 0 ? 512 : 1024) + c;
        const float w0 = cw[gcol], w1 = cw[HYC + gcol], w2 = cw[2 * HYC + gcol], bias = cb[gcol];
        const bf16_t* zrow = ZT + (size_t)gcol * BT + (size_t)bb * SEQ;
        bf16_t* hyt = (bf16_t*)(p.ws + WS_HYT) + (size_t)c * BT + (size_t)bb * SEQ;
#pragma unroll
        for (int mm = 0; mm < 2; ++mm) {
#pragma unroll
            for (int g4 = 0; g4 < 4; ++g4) {
                const int t4 = (4 * ig + Il) * 64 + 32 * mm + 8 * g4 + 4 * hf;
                float gt[4];
                short_conv4(zrow, t4, w0, w1, w2, bias, gt);
                unsigned char* up = lds + bb * HY_USTR + t4 * 2;
                const u32x2 uv = *(const u32x2*)up;
                const float u0 = bflo(uv[0]), u1 = bfhi(uv[0]), u2 = bflo(uv[1]), u3 = bfhi(uv[1]);
                const f32x16& a = mm ? acc1 : acc0;
                const float y0 = gt[0] * (a[4 * g4] + skip * u0), y1 = gt[1] * (a[4 * g4 + 1] + skip * u1);
                const float y2 = gt[2] * (a[4 * g4 + 2] + skip * u2), y3 = gt[3] * (a[4 * g4 + 3] + skip * u3);
                const u32x2 pk = u32x2{pk2(y0, y1), pk2(y2, y3)};
                if (o == 0) *(u32x2*)up = pk; else *(u32x2*)(hyt + t4) = pk;
            }
        }
        __syncthreads();
    }
}

constexpr int CTL_QUEUE_D = 8192;
template<bool HY> DI void phase_d(const Params& p, unsigned char* lds) {
    unsigned* ctr = (unsigned*)(p.ws + WS_CTL) + CTL_QUEUE_D + (HY ? 0 : 64);
    volatile LAS unsigned* slot = (volatile LAS unsigned*)(LAS unsigned char*)(lds + LDS_ST_OFF + 8);
    for (;;) {
        __syncthreads();
        if (get_tid() == 0) slot[0] = atomicAdd(ctr, 1u);
        __syncthreads();
        const int it = __builtin_amdgcn_readfirstlane((int)slot[0]);
        if (it >= 512) break;
        if (HY) hyena_item(p, it, lds); else attn_item(p, it, lds);
    }
}

DI void phase_d2(const Params& p, unsigned char* lds) {
    constexpr int TILES = 8 * (BT / 256);
    constexpr int CONV = 2 * 16384 * 1024 / 8192;
    const bf16_t* HYT = (const bf16_t*)(p.ws + WS_HYT);
    bf16_t* HY = (bf16_t*)(p.ws + WS_HY);
    for (int it = blockIdx.x; it < TILES + CONV; it += gridDim.x) {
        const int tid = get_tid();
        if (it >= TILES) {
            const int ci = it - TILES;
            const size_t el = (size_t)(ci & 2047) * 8192 + tid * 8;
            const float* src = (ci < 2048 ? p.in[I_PU] : p.in[I_PV]) + el;
            const f32x4 a = *(const f32x4*)src, b = *(const f32x4*)(src + 4);
            const size_t e = el >> 10, col = el & 1023;
            if (ci < 2048) {
                float mx = fmaxf(fmaxf(fmaxf(fabsf(a[0]), fabsf(a[1])), fmaxf(fabsf(a[2]), fabsf(a[3]))), fmaxf(fmaxf(fabsf(b[0]), fabsf(b[1])), fmaxf(fabsf(b[2]), fabsf(b[3]))));
                mx = fmaxf(mx, dppf<0xB1>(mx)); mx = fmaxf(mx, dppf<0x4E>(mx)); mx = fmaxf(mx, dppf<0x141>(mx)); mx = fmaxf(mx, dppf<0x140>(mx));
                { auto r = __builtin_amdgcn_permlane16_swap(__float_as_uint(mx), __float_as_uint(mx), false, false); mx = fmaxf(__uint_as_float(r[0]), __uint_as_float(r[1])); }
                { auto r = __builtin_amdgcn_permlane32_swap(__float_as_uint(mx), __float_as_uint(mx), false, false); mx = fmaxf(__uint_as_float(r[0]), __uint_as_float(r[1])); }
                float* wm = (float*)lds;
                __syncthreads();
                if ((tid & 63) == 0) wm[tid >> 6] = mx;
                __syncthreads();
                const float rm = fmaxf(fmaxf(wm[(tid >> 7) * 2], wm[(tid >> 7) * 2 + 1]), 1e-30f);
                const float sc = 127.f / rm;
                if ((tid & 127) == 0) ((float*)(p.ws + WS_USC))[e] = rm * (1.f / 127.f);
                const int q0 = __float2int_rn(a[0] * sc), q1 = __float2int_rn(a[1] * sc), q2 = __float2int_rn(a[2] * sc), q3 = __float2int_rn(a[3] * sc);
                const int q4 = __float2int_rn(b[0] * sc), q5 = __float2int_rn(b[1] * sc), q6 = __float2int_rn(b[2] * sc), q7 = __float2int_rn(b[3] * sc);
                const unsigned w0 = (q0 & 255) | ((q1 & 255) << 8) | ((q2 & 255) << 16) | ((unsigned)q3 << 24);
                const unsigned w1 = (q4 & 255) | ((q5 & 255) << 8) | ((q6 & 255) << 16) | ((unsigned)q7 << 24);
                *(u32x2*)(p.ws + WS_UT + el) = u32x2{w0, w1};
            } else {
                const float sc = VSCALE;
                int w0 = 0, w1 = 0;
                w0 = __builtin_amdgcn_cvt_pk_fp8_f32(a[0] * sc, a[1] * sc, w0, false); w0 = __builtin_amdgcn_cvt_pk_fp8_f32(a[2] * sc, a[3] * sc, w0, true);
                w1 = __builtin_amdgcn_cvt_pk_fp8_f32(b[0] * sc, b[1] * sc, w1, false); w1 = __builtin_amdgcn_cvt_pk_fp8_f32(b[2] * sc, b[3] * sc, w1, true);
                *(u32x2*)(p.ws + WS_VTAB + ((col >> 7) * 16384 + e) * 128 + (col & 127)) = u32x2{(unsigned)w0, (unsigned)w1};
            }
            continue;
        }
        const int c0 = (it & 7) * 64, tok0 = (it >> 3) * 256;
        __syncthreads();
#pragma unroll
        for (int i = 0; i < 2; ++i) {
            const int idx = tid + i * NT, c = idx >> 5, tg = idx & 31;
            *(u32x4*)(lds + c * 528 + tg * 16) = *(const u32x4*)(HYT + (size_t)(c0 + c) * BT + tok0 + tg * 8);
        }
        __syncthreads();
#pragma unroll
        for (int i = 0; i < 2; ++i) {
            const int idx = tid + i * NT, tok = idx >> 3, cg = idx & 7;
            unsigned w[4];
#pragma unroll
            for (int e = 0; e < 4; ++e) {
                const unsigned lo = *(const unsigned short*)(lds + (cg * 8 + 2 * e) * 528 + tok * 2);
                const unsigned hi = *(const unsigned short*)(lds + (cg * 8 + 2 * e + 1) * 528 + tok * 2);
                w[e] = lo | (hi << 16);
            }
            *(u32x4*)(HY + (size_t)(tok0 + tok) * HYD + c0 + cg * 8) = u32x4{w[0], w[1], w[2], w[3]};
        }
    }
}

DI void phase_e(const Params& p, unsigned char* lds) {
    constexpr int TILES = 4 * (BT / 128);
    for (int it = blockIdx.x; it < TILES; it += gridDim.x) {
        const int tid = get_tid(), lane = tid & 63, wave = tid >> 6, wp = wave >> 2, wq = wave & 3;
        const int tn = it & 3, tm = it >> 2;
        const int n0 = tn * 256, tok0 = tm * 128;
        f32x4 acc1[4][2], acc2[4][2];
#pragma unroll
        for (int i = 0; i < 4; ++i)
#pragma unroll
            for (int j = 0; j < 2; ++j) { acc1[i][j] = f32x4{0.f, 0.f, 0.f, 0.f}; acc2[i][j] = f32x4{0.f, 0.f, 0.f, 0.f}; }
        gemm_mainloop<2>(acc1, RowLoader{(const bf16_t*)(p.ws + WS_WTAO) + (size_t)n0 * QD, QD}, RowLoader{(const bf16_t*)(p.ws + WS_ATT) + (size_t)tok0 * QD, QD}, QD / 64, lds);
        gemm_mainloop<2>(acc2, RowLoader{(const bf16_t*)(p.ws + WS_WTHO) + (size_t)n0 * HYD, HYD}, RowLoader{(const bf16_t*)(p.ws + WS_HY) + (size_t)tok0 * HYD, HYD}, HYD / 64, lds);
        const bf16_t* G = (const bf16_t*)(p.ws + WS_G);
        bf16_t* M = (bf16_t*)(p.ws + WS_H);
        const int l15 = lane & 15, lk = lane >> 4;
#pragma unroll
        for (int i = 0; i < 4; ++i)
#pragma unroll
            for (int j = 0; j < 2; ++j) {
                const int n = n0 + wp * 64 + i * 16 + lk * 4;
                const int tok = tok0 + wq * 32 + j * 16 + l15;
                const u32x2 ga = *(const u32x2*)(G + (size_t)tok * GC + n);
                const u32x2 gh = *(const u32x2*)(G + (size_t)tok * GC + 1024 + n);
                const float m0 = bflo(ga[0]) * acc1[i][j][0] + bflo(gh[0]) * acc2[i][j][0];
                const float m1 = bfhi(ga[0]) * acc1[i][j][1] + bfhi(gh[0]) * acc2[i][j][1];
                const float m2 = bflo(ga[1]) * acc1[i][j][2] + bflo(gh[1]) * acc2[i][j][2];
                const float m3 = bfhi(ga[1]) * acc1[i][j][3] + bfhi(gh[1]) * acc2[i][j][3];
                *(u32x2*)(M + (size_t)tok * DM + n) = u32x2{pk2(m0, m1), pk2(m2, m3)};
            }
    }
}

DI void phase_f(const Params& p, unsigned char* lds) {
    constexpr int TILES = 4 * (BT / 256);
    const float* mod = (const float*)(p.ws + WS_MOD);
    for (int it = blockIdx.x; it < TILES; it += gridDim.x) {
        const int tid = get_tid(), lane = tid & 63, wave = tid >> 6, wp = wave >> 2, wq = wave & 3;
        const int tn = it & 3, tm = it >> 2;
        const int n0 = tn * 256, tok0 = tm * 256, b = tok0 >> 12;
        f32x4 acc[4][4];
#pragma unroll
        for (int i = 0; i < 4; ++i)
#pragma unroll
            for (int j = 0; j < 4; ++j) acc[i][j] = f32x4{0.f, 0.f, 0.f, 0.f};
        gemm_mainloop<4>(acc, RowLoader{(const bf16_t*)(p.ws + WS_WTO) + (size_t)n0 * DM, DM}, RowLoader{(const bf16_t*)(p.ws + WS_H) + (size_t)tok0 * DM, DM}, DM / 64, lds);
        const int l15 = lane & 15, lk = lane >> 4;
#pragma unroll
        for (int i = 0; i < 4; ++i) {
            const int n = n0 + wp * 64 + i * 16 + lk * 4;
            const f32x4 g1 = *(const f32x4*)(mod + b * 6144 + 2048 + n);
#pragma unroll
            for (int j = 0; j < 4; ++j) {
                const int tok = tok0 + wq * 64 + j * 16 + l15;
                const f32x4 xv = *(const f32x4*)(p.in[I_X] + (size_t)tok * DM + n);
                *(f32x4*)(p.out + (size_t)tok * DM + n) = f32x4{xv[0] + g1[0] * acc[i][j][0], xv[1] + g1[1] * acc[i][j][1], xv[2] + g1[2] * acc[i][j][2], xv[3] + g1[3] * acc[i][j][3]};
            }
        }
    }
}

DI void phase_g(const Params& p) {
    const float* mod = (const float*)(p.ws + WS_MOD);
    for (int it = blockIdx.x; it < BT / 16; it += gridDim.x) {
        const int row = it * 16 + (get_tid() >> 6), b = row >> 12;
        norm_mod_row(p.out + (size_t)row * DM, p.in[I_NFFN], mod + b * 6144 + 3072, mod + b * 6144 + 4096, (bf16_t*)(p.ws + WS_H) + (size_t)row * DM);
    }
}

DI void phase_h(const Params& p, unsigned char* lds) {
    constexpr int TILES = 8 * (BT / 256);
    for (int it = blockIdx.x; it < TILES; it += gridDim.x) {
        const int tid = get_tid(), lane = tid & 63, wave = tid >> 6, wp = wave >> 2, wq = wave & 3;
        const int tn = it & 7, tm = it >> 3;
        const int n0 = tn * 256, tok0 = tm * 256;
        f32x4 acc[4][4];
#pragma unroll
        for (int i = 0; i < 4; ++i)
#pragma unroll
            for (int j = 0; j < 4; ++j) acc[i][j] = f32x4{0.f, 0.f, 0.f, 0.f};
        gemm_mainloop<4>(acc, RowLoader{(const bf16_t*)(p.ws + WS_WTQ) + (size_t)n0 * DM, DM}, RowLoader{(const bf16_t*)(p.ws + WS_H) + (size_t)tok0 * DM, DM}, DM / 64, lds);
        bf16_t* QP = (bf16_t*)(p.ws + WS_G);
        const int l15 = lane & 15, lk = lane >> 4;
#pragma unroll
        for (int i = 0; i < 4; ++i)
#pragma unroll
            for (int j = 0; j < 4; ++j) {
                const int n = n0 + wp * 64 + i * 16 + lk * 4;
                const int tok = tok0 + wq * 64 + j * 16 + l15;
                *(u32x2*)(QP + (size_t)tok * 2048 + n) = u32x2{pk2(acc[i][j][0], acc[i][j][1]), pk2(acc[i][j][2], acc[i][j][3])};
            }
    }
}

DI void ins16(float (&L)[16], float v) {
#pragma unroll
    for (int i = 0; i < 16; ++i) { const float hi = fmaxf(L[i], v); v = fminf(L[i], v); L[i] = hi; }
}
DI void cex_desc(float& a, float& b) { const float hi = fmaxf(a, b), lo = fminf(a, b); a = hi; b = lo; }
DI void bitonic_merge16_desc(float (&v)[16]) {
#pragma unroll
    for (int j = 8; j > 0; j >>= 1)
#pragma unroll
        for (int i = 0; i < 16; ++i) if ((i ^ j) > i) cex_desc(v[i], v[i ^ j]);
}
DI void sort16_desc(float (&v)[16]) {
#pragma unroll
    for (int k = 2; k <= 16; k <<= 1)
#pragma unroll
        for (int j = k >> 1; j > 0; j >>= 1)
#pragma unroll
            for (int i = 0; i < 16; ++i) {
                const int l = i ^ j;
                if (l > i) { if ((i & k) == 0) cex_desc(v[i], v[l]); else cex_desc(v[l], v[i]); }
            }
}
DI void top16_merge(float (&a)[16], const float (&b)[16]) {
#pragma unroll
    for (int i = 0; i < 16; ++i) a[i] = fmaxf(a[i], b[15 - i]);
    bitonic_merge16_desc(a);
}
DI float pack_idx(float v, unsigned idx, unsigned mask) { return __uint_as_float((__float_as_uint(v) & ~mask) | idx); }
constexpr int PI_LIST = 0;
DI void peer_select_item(const Params& p, int item, unsigned char* lds) {
    const int tok0 = item * 128;
    __syncthreads();
    {
#pragma unroll 1
        for (int sb = 0; sb < 4; ++sb) {
            const int tid = get_tid(), lane = tid & 63, hp = tid >> 6;
            const int r = lane & 31, hf = lane >> 5;
            const bf16_t* keys = (const bf16_t*)(p.ws + WS_KEYS) + (size_t)((hp & 1) * 8 + (hp >> 1)) * 128 * 128 + 8 * hf;
            const bf16_t* qp = (const bf16_t*)(p.ws + WS_G) + (size_t)(tok0 + r) * 2048 + hp * 128 + 8 * hf;
            bf16x8 bq[8];
#pragma unroll
            for (int ks = 0; ks < 8; ++ks) bq[ks] = *(const bf16x8*)(qp + (size_t)sb * 32 * 2048 + 16 * ks);
            f32x16 acc[4];
#pragma unroll
            for (int m = 0; m < 4; ++m)
#pragma unroll
                for (int i = 0; i < 16; ++i) acc[m][i] = 0.f;
#pragma unroll
            for (int ks = 0; ks < 8; ++ks) {
#pragma unroll
                for (int m = 0; m < 4; ++m) {
                    const bf16x8 ak = *(const bf16x8*)(keys + (size_t)(m * 32 + r) * 128 + 16 * ks);
                    acc[m] = MFMA32(ak, bq[ks], acc[m]);
                }
            }
            float V[4][16];
#define PK_SORT(m) do { _Pragma("unroll") for (int i = 0; i < 16; ++i) V[m][i] = pack_idx(acc[m][i], (unsigned)((m) * 32 + (i & 3) + 8 * (i >> 2) + 4 * hf), 127u); sort16_desc(V[m]); } while (0)
            PK_SORT(0); PK_SORT(1); top16_merge(V[0], V[1]); __builtin_amdgcn_sched_barrier(0);
            PK_SORT(2); PK_SORT(3); top16_merge(V[2], V[3]); __builtin_amdgcn_sched_barrier(0);
            top16_merge(V[0], V[2]);
#undef PK_SORT
            float (&L)[16] = V[0];
            const int t3 = get_tid(), hf3 = (t3 >> 5) & 1, r3 = t3 & 31, hp3 = t3 >> 6;
            float P[16];
#pragma unroll
            for (int i = 0; i < 16; ++i) {
                auto sw = __builtin_amdgcn_permlane32_swap(__float_as_uint(L[i]), __float_as_uint(L[i]), false, false);
                P[i] = hf3 ? __uint_as_float(sw[0]) : __uint_as_float(sw[1]);
            }
            top16_merge(L, P);
            if (hf3 == 0) {
                float* dst = (float*)(lds + PI_LIST) + ((sb * 32 + r3) * 16 + hp3) * 16;
#pragma unroll
                for (int i = 0; i < 16; i += 4) *(f32x4*)(dst + i) = f32x4{L[i], L[i + 1], L[i + 2], L[i + 3]};
            }
        }
    }
    __syncthreads();
    {
        const int tid = get_tid();
        {
            const int tok = tid >> 3, h = tid & 7;
            const float* l1 = (const float*)(lds + PI_LIST) + (tok * 16 + 2 * h) * 16;
            const float* l2 = l1 + 16;
            float v1[16], v2[16];
#pragma unroll
            for (int i = 0; i < 16; i += 4) {
                const f32x4 a = *(const f32x4*)(l1 + i), b = *(const f32x4*)(l2 + i);
                v1[i] = a[0]; v1[i + 1] = a[1]; v1[i + 2] = a[2]; v1[i + 3] = a[3];
                v2[i] = b[0]; v2[i + 1] = b[1]; v2[i + 2] = b[2]; v2[i + 3] = b[3];
            }
            float B[16];
#pragma unroll
            for (int i = 0; i < 16; ++i) B[i] = -3.0e38f;
#pragma unroll
            for (int i = 0; i < 16; ++i)
#pragma unroll
                for (int j = 0; j < 16; ++j)
                    if ((i + 1) * (j + 1) <= 16) ins16(B, pack_idx(v1[i] + v2[j], (unsigned)(i * 16 + j), 255u));
            float e[16], sum = 0.f;
#pragma unroll
            for (int k = 0; k < 16; ++k) { e[k] = __expf(B[k] - B[0]); sum += e[k]; }
            const float inv = 1.f / sum;
            int* ex = (int*)(p.ws + WS_EXPI) + (size_t)(tok0 + tok) * 128 + h * 16;
            float* gt = (float*)(p.ws + WS_GATE) + ((size_t)(tok0 + tok) * 128 + h * 16) * 2;
            const float* usc = (const float*)(p.ws + WS_USC);
            int ev[16]; float gv[16], sv[16];
#pragma unroll
            for (int k = 0; k < 16; ++k) {
                const unsigned ij = __float_as_uint(B[k]) & 255u;
                const unsigned i1 = __float_as_uint(l1[ij >> 4]) & 127u, i2 = __float_as_uint(l2[ij & 15u]) & 127u;
                ev[k] = (int)(i1 * 128u + i2);
                gv[k] = e[k] * inv;
                sv[k] = usc[ev[k]];
            }
#pragma unroll
            for (int k = 0; k < 16; k += 4) *(u32x4*)(ex + k) = u32x4{(unsigned)ev[k], (unsigned)ev[k + 1], (unsigned)ev[k + 2], (unsigned)ev[k + 3]};
#pragma unroll
            for (int k = 0; k < 16; k += 2) *(f32x4*)(gt + 2 * k) = f32x4{gv[k], sv[k], gv[k + 1], sv[k + 1]};
        }
    }
}
DI void phase_i1(const Params& p, unsigned char* lds) {
    for (int it = blockIdx.x; it < BT / 128; it += gridDim.x) peer_select_item(p, it, lds);
}

DI float dot16_fp8(const u32x4& w, const float (&x)[16]) {
    float d = 0.f;
#pragma unroll
    for (int i = 0; i < 4; ++i) {
        const auto lo = __builtin_amdgcn_cvt_pk_f32_fp8((int)w[i], false);
        const auto hi = __builtin_amdgcn_cvt_pk_f32_fp8((int)w[i], true);
        d += lo[0] * x[4 * i] + lo[1] * x[4 * i + 1] + hi[0] * x[4 * i + 2] + hi[1] * x[4 * i + 3];
    }
    return d;
}
template<int NPART, class F> DI void run_partitioned(const Params& p, unsigned char* lds, int qbase, int nitems, F&& body) {
    unsigned* ctl = (unsigned*)(p.ws + WS_CTL);
    volatile LAS unsigned* slot = (volatile LAS unsigned*)(LAS unsigned char*)(lds + LDS_ST_OFF + 8);
    const int x0 = (int)(xb_xcc_id() & 7u);
#pragma unroll 1
    for (int pp = 0; pp < NPART; ++pp) {
        const int part = (NPART == 8) ? ((x0 + pp) & 7) : ((((x0 + (pp >> 1)) & 7)) + 8 * (pp & 1));
        for (;;) {
            __syncthreads();
            if (get_tid() == 0) slot[0] = atomicAdd(ctl + qbase + 64 * part, 1u);
            __syncthreads();
            const int it = __builtin_amdgcn_readfirstlane((int)slot[0]);
            if (it >= nitems) break;
            body(part, it);
        }
    }
}
constexpr int CTL_QUEUE_I2 = 8320, CTL_QUEUE_I3 = 9408;
constexpr int UW_BYTES = 5120, UW_GT = 2048, UW_LIST = 4096;
DI float wave_max(float v) {
    v = fmaxf(v, dppf<0xB1>(v)); v = fmaxf(v, dppf<0x4E>(v)); v = fmaxf(v, dppf<0x141>(v)); v = fmaxf(v, dppf<0x140>(v));
    { auto r = __builtin_amdgcn_permlane16_swap(__float_as_uint(v), __float_as_uint(v), false, false); v = fmaxf(__uint_as_float(r[0]), __uint_as_float(r[1])); }
    { auto r = __builtin_amdgcn_permlane32_swap(__float_as_uint(v), __float_as_uint(v), false, false); v = fmaxf(__uint_as_float(r[0]), __uint_as_float(r[1])); }
    return v;
}
DI void peer_u_chunk(const Params& p, int part, int chunk, unsigned char* lds) {
    const int tid = get_tid(), lane = tid & 63, wave = __builtin_amdgcn_readfirstlane(tid >> 6);
    unsigned char* wl = lds + wave * UW_BYTES;
    unsigned* lst = (unsigned*)(wl + UW_LIST);
    const f32x2* gts = (const f32x2*)(wl + UW_GT);
    const unsigned char* UT8 = p.ws + WS_UT + lane * 16;
    const int tokw = chunk * 512 + wave * 2;
    int pe[4]; u32x4 ph[4]; f32x2 pg[4];
#define U_PREFETCH(tok) do { \
        const int* ex_ = (const int*)(p.ws + WS_EXPI) + (size_t)(tok) * 128 + lane; \
        const f32x2* gt_ = (const f32x2*)(p.ws + WS_GATE) + (size_t)(tok) * 128 + lane; \
        const bf16_t* hr_ = (const bf16_t*)(p.ws + WS_H) + (size_t)(tok) * DM + lane * 16; \
        pe[0] = ex_[0]; pe[1] = ex_[64]; pe[2] = ex_[128]; pe[3] = ex_[192]; \
        pg[0] = gt_[0]; pg[1] = gt_[64]; pg[2] = gt_[128]; pg[3] = gt_[192]; \
        ph[0] = *(const u32x4*)hr_; ph[1] = *(const u32x4*)(hr_ + 8); ph[2] = *(const u32x4*)(hr_ + DM); ph[3] = *(const u32x4*)(hr_ + DM + 8); } while (0)
    U_PREFETCH(tokw);
#pragma unroll 1
    for (int sub = 0; sub < 16; ++sub) {
        const int tok0 = tokw + sub * 32;
        float sx[2];
#pragma unroll
        for (int t = 0; t < 2; ++t) {
            float f[16];
#pragma unroll
            for (int q = 0; q < 8; ++q) { const unsigned w = ph[2 * t + (q >> 2)][q & 3]; f[2 * q] = bflo(w); f[2 * q + 1] = bfhi(w); }
            float mx = 0.f;
#pragma unroll
            for (int i = 0; i < 16; ++i) mx = fmaxf(mx, fabsf(f[i]));
            mx = fmaxf(wave_max(mx), 1e-30f);
            sx[t] = mx * (1.f / 127.f);
            const float qs = 127.f / mx;
            unsigned w8[4];
#pragma unroll
            for (int q = 0; q < 4; ++q) {
                const int q0 = __float2int_rn(f[4 * q] * qs), q1 = __float2int_rn(f[4 * q + 1] * qs), q2 = __float2int_rn(f[4 * q + 2] * qs), q3 = __float2int_rn(f[4 * q + 3] * qs);
                w8[q] = (q0 & 255) | ((q1 & 255) << 8) | ((q2 & 255) << 16) | ((unsigned)q3 << 24);
            }
            *(u32x4*)(wl + t * 1024 + lane * 16) = u32x4{w8[0], w8[1], w8[2], w8[3]};
        }
        int cnt = 0;
#pragma unroll
        for (int g = 0; g < 4; ++g) {
            ((f32x2*)(wl + UW_GT))[g * 64 + lane] = pg[g];
            const bool m = (pe[g] >> 11) == part;
            const unsigned long long bm = __ballot(m);
            const int pos = cnt + __builtin_amdgcn_mbcnt_hi((unsigned)(bm >> 32), __builtin_amdgcn_mbcnt_lo((unsigned)bm, 0u));
            if (m) lst[pos] = ((unsigned)(g * 64 + lane) << 16) | (unsigned)pe[g];
            cnt += __popcll(bm);
        }
        if (sub + 1 < 16) U_PREFETCH(tok0 + 32);
#define U_LOAD(ROW, EN, base) do { _Pragma("unroll") for (int q = 0; q < 8; ++q) { \
            EN[q] = __builtin_amdgcn_readfirstlane(lst[min((base) + q, cnt - 1)]); \
            ROW[q] = *(const u32x4*)(UT8 + (size_t)(EN[q] & 0x3fffu) * 1024); } } while (0)
#define U_COMPUTE(ROW, EN, base) do { \
            int d[8]; \
            _Pragma("unroll") for (int q = 0; q < 8; ++q) { \
                const u32x4 xv = *(const u32x4*)(wl + (EN[q] >> 23) * 1024 + lane * 16); \
                int ai = 0; \
                _Pragma("unroll") for (int i = 0; i < 4; ++i) ai = __builtin_amdgcn_sdot4((int)ROW[q][i], (int)xv[i], ai, false); \
                d[q] = ai; \
            } \
              \
            int r4[4], r2[2]; \
            _Pragma("unroll") for (int i = 0; i < 4; ++i) { auto sw = __builtin_amdgcn_permlane32_swap((unsigned)d[i], (unsigned)d[i + 4], false, false); r4[i] = (int)(sw[0] + sw[1]); } \
            _Pragma("unroll") for (int i = 0; i < 2; ++i) { auto sw = __builtin_amdgcn_permlane16_swap((unsigned)r4[i], (unsigned)r4[i + 2], false, false); r2[i] = (int)(sw[0] + sw[1]); } \
            const bool b3 = (lane & 8) != 0; \
            int ai = (b3 ? r2[1] : r2[0]) + dppi<0x128>(b3 ? r2[0] : r2[1]); \
            ai += dppi<0xB1>(ai); ai += dppi<0x4E>(ai); ai += dppi<0x141>(ai); \
            const int g = lane >> 3; \
            const unsigned ent = lst[min((base) + g, cnt - 1)]; \
            const int idx = (int)(ent >> 16); \
            const f32x2 gs = gts[idx]; \
            const float a = (float)ai * (gs[1] * ((idx >> 7) ? sx[1] : sx[0])); \
            const float y = 0.7978845608028654f * (a + 0.044715f * a * a * a); \
            const float th = 1.f - 2.f / (__expf(2.f * y) + 1.f); \
            const float w = 0.5f * a * (1.f + th) * gs[0]; \
            if ((lane & 7) == 0 && (base) + g < cnt) ((u32x2*)(p.ws + WS_PAIRS))[(size_t)tok0 * 128 + idx] = u32x2{ent & 0x3fffu, __float_as_uint(w)}; \
        } while (0)
        if (cnt > 0) {
            u32x4 rowA[8], rowB[8]; unsigned enA[8], enB[8];
            U_LOAD(rowA, enA, 0);
#pragma unroll 1
            for (int base = 0; base < cnt; base += 16) {
                if (base + 8 < cnt) U_LOAD(rowB, enB, base + 8);
                U_COMPUTE(rowA, enA, base);
                if (base + 8 < cnt) {
                    if (base + 16 < cnt) U_LOAD(rowA, enA, base + 16);
                    U_COMPUTE(rowB, enB, base + 8);
                }
            }
        }
#undef U_LOAD
#undef U_COMPUTE
    }
#undef U_PREFETCH
}
DI void phase_i2(const Params& p, unsigned char* lds) {
    run_partitioned<8>(p, lds, CTL_QUEUE_I2, BT / 512, [&](int part, int it) { peer_u_chunk(p, part, it, lds); });
}
DI void peer_v_chunk(const Params& p, int part, int chunk, unsigned char* lds) {
    const int tid = get_tid(), lane = tid & 63, wave = __builtin_amdgcn_readfirstlane(tid >> 6);
    unsigned char* wl = lds + wave * 1024;
    const int es = lane >> 3, ch = lane & 7;
    const unsigned char* VT8 = p.ws + WS_VTAB + (size_t)part * 16384 * 128 + ch * 16;
    const float* mod = (const float*)(p.ws + WS_MOD);
    const int col = part * 128 + 16 * ch + 2 * es;
    const int tokw = chunk * 512 + wave;
    u32x4 pp = *((const u32x4*)(p.ws + WS_PAIRS + (size_t)tokw * 1024) + lane);
#pragma unroll 1
    for (int step = 0; step < 32; ++step) {
        const int tok = tokw + step * 16, b = tok >> 12;
        *(u32x4*)(wl + lane * 16) = pp;
        if (step + 1 < 32) pp = *((const u32x4*)(p.ws + WS_PAIRS + (size_t)(tok + 16) * 1024) + lane);
        float* xo = p.out + (size_t)tok * DM + col;
        const f32x2 x1 = *(const f32x2*)xo;
        const f32x2 g2 = *(const f32x2*)(mod + b * 6144 + 5120 + col);
        f32x2 acc[8];
#pragma unroll
        for (int i = 0; i < 8; ++i) acc[i] = f32x2{0.f, 0.f};
        const u32x2* pr = (const u32x2*)wl + es;
#pragma unroll 1
        for (int ih = 0; ih < 2; ++ih) {
            u32x2 pe[8]; u32x4 row[8];
#pragma unroll
            for (int q = 0; q < 8; ++q) { pe[q] = pr[(ih * 8 + q) * 8]; row[q] = *(const u32x4*)(VT8 + (size_t)pe[q][0] * 128); }
#pragma unroll
            for (int q = 0; q < 8; ++q) {
                const float w = __uint_as_float(pe[q][1]);
                const f32x2 w2 = f32x2{w, w};
#pragma unroll
                for (int i = 0; i < 4; ++i) {
                    const f32x2 lo = __builtin_amdgcn_cvt_pk_f32_fp8((int)row[q][i], false);
                    const f32x2 hi = __builtin_amdgcn_cvt_pk_f32_fp8((int)row[q][i], true);
                    acc[2 * i] += w2 * lo; acc[2 * i + 1] += w2 * hi;
                }
            }
        }
        float a16[16];
#pragma unroll
        for (int i = 0; i < 8; ++i) { a16[2 * i] = acc[i][0]; a16[2 * i + 1] = acc[i][1]; }
        float r8[8], r4[4], r2[2];
#pragma unroll
        for (int i = 0; i < 8; ++i) { auto sw = __builtin_amdgcn_permlane32_swap(__float_as_uint(a16[i]), __float_as_uint(a16[i + 8]), false, false); r8[i] = __uint_as_float(sw[0]) + __uint_as_float(sw[1]); }
#pragma unroll
        for (int i = 0; i < 4; ++i) { auto sw = __builtin_amdgcn_permlane16_swap(__float_as_uint(r8[i]), __float_as_uint(r8[i + 4]), false, false); r4[i] = __uint_as_float(sw[0]) + __uint_as_float(sw[1]); }
        const bool b3 = (lane & 8) != 0;
#pragma unroll
        for (int i = 0; i < 2; ++i) { const float keep = b3 ? r4[i + 2] : r4[i], send = b3 ? r4[i] : r4[i + 2]; r2[i] = keep + dppf<0x128>(send); }
        const float xa = x1[0] + g2[0] * r2[0] * (1.f / VSCALE), xb = x1[1] + g2[1] * r2[1] * (1.f / VSCALE);
        *(f32x2*)xo = f32x2{xa, xb};
        const float ss = wave_sum(xa * xa + xb * xb);
        if (lane == 0) ((float*)(p.ws + WS_SSQ))[(size_t)tok * 8 + part] = ss;
    }
}
DI void phase_i3(const Params& p, unsigned char* lds) {
    run_partitioned<8>(p, lds, CTL_QUEUE_I3, BT / 512, [&](int part, int it) { peer_v_chunk(p, part, it, lds); });
}
DI void phase_i4(const Params& p) {
    const bool bad = xb_ld((unsigned*)(p.ws + WS_CTL) + CTL_BADTID) != 0u || xb_ld((unsigned*)(p.ws + WS_CTL) + XB_TMO) != 0u;
    for (int it = blockIdx.x; it < BT / 16; it += gridDim.x) {
        const int tid = get_tid(), lane = tid & 63, row = it * 16 + (tid >> 6);
        const float* sq = (const float*)(p.ws + WS_SSQ) + (size_t)row * 8;
        const f32x4 s0 = *(const f32x4*)sq, s1 = *(const f32x4*)(sq + 4);
        const float ss = s0[0] + s0[1] + s0[2] + s0[3] + s1[0] + s1[1] + s1[2] + s1[3];
        float rs = rsqrtf(ss * (1.f / DM) + EPS);
        if (bad) rs = __builtin_nanf("");
        float* o = p.out + (size_t)row * DM;
#pragma unroll
        for (int j = 0; j < 4; ++j) {
            const int c = j * 256 + lane * 4;
            const f32x4 v = *(const f32x4*)(o + c), g = *(const f32x4*)(p.in[I_FNG] + c);
            *(f32x4*)(o + c) = f32x4{v[0] * rs * g[0], v[1] * rs * g[1], v[2] * rs * g[2], v[3] * rs * g[3]};
        }
    }
}

__global__ void __launch_bounds__(NT) mega(Params p) {
    unsigned char* lds = g_lds;
    volatile LAS unsigned* st = (volatile LAS unsigned*)(LAS unsigned char*)(lds + LDS_ST_OFF);
    {
        const unsigned hw = __builtin_amdgcn_s_getreg((5 << 11) | 4);
        if ((threadIdx.x & 63) == 0) g_lds[LDS_WTAB_OFF + hw] = (unsigned char)(threadIdx.x >> 6);
        if (threadIdx.x < 2) st[threadIdx.x] = 0u;
        __syncthreads();
        if (get_tid() != (int)threadIdx.x) ((unsigned*)(p.ws + WS_CTL))[CTL_BADTID] = 1u;
    }
    XcdBarrier bar = xcd_barrier_post((unsigned*)(p.ws + WS_CTL), st);
    float* sm = (float*)lds;

#define STAMP(k, which) do { if (PROBE_PHASE == (k) && blockIdx.x == 0 && get_tid() == 0) ((volatile unsigned long long*)(lds + LDS_PROBE_OFF))[which] = __builtin_amdgcn_s_memrealtime(); } while (0)
    STAMP(21, 0);
    STAMP(0, 0); phase_a(p, sm);   xcd_barrier(bar); STAMP(0, 1);
    STAMP(1, 0); phase_b(p, sm);   xcd_barrier(bar); STAMP(1, 1);
    if (PROBE_PHASE == 20) { STAMP(20, 0); xcd_barrier(bar); xcd_barrier(bar); xcd_barrier(bar); xcd_barrier(bar); STAMP(20, 1); }
    STAMP(2, 0); phase_c(p, lds);  xcd_barrier(bar); STAMP(2, 1);
    STAMP(3, 0); phase_d<true>(p, lds);  xcd_barrier(bar); STAMP(3, 1);
    STAMP(13, 0); phase_d<false>(p, lds); xcd_barrier(bar); STAMP(13, 1);
    STAMP(4, 0); phase_d2(p, lds); xcd_barrier(bar); STAMP(4, 1);
    STAMP(5, 0); phase_e(p, lds);  xcd_barrier(bar); STAMP(5, 1);
    STAMP(6, 0); phase_f(p, lds);  xcd_barrier(bar); STAMP(6, 1);
    STAMP(7, 0); phase_g(p);       xcd_barrier(bar); STAMP(7, 1);
    STAMP(8, 0); phase_h(p, lds);  xcd_barrier(bar); STAMP(8, 1);
    STAMP(9, 0); phase_i1(p, lds); xcd_barrier(bar); STAMP(9, 1);
    STAMP(10, 0); phase_i2(p, lds); xcd_barrier(bar); STAMP(10, 1);
    STAMP(11, 0); phase_i3(p, lds); xcd_barrier(bar); STAMP(11, 1);
    STAMP(12, 0); phase_i4(p);
    if (PROBE_PHASE >= 0) {
        xcd_barrier(bar); STAMP(12, 1); STAMP(21, 1);
        if (blockIdx.x == 0 && get_tid() == 0) {
            volatile unsigned long long* ts = (volatile unsigned long long*)(lds + LDS_PROBE_OFF);
            p.out[0] += (float)(ts[1] - ts[0]) * (0.01f / PROBE_SCALE);
        }
    }
}

extern "C" void kernel_launch(void* const* d_in, const int* in_sizes, int n_in, void* d_out, int out_size, void* d_ws, size_t ws_size, hipStream_t stream) {
    static int grid = 0;
    if (grid == 0) {
        int dev = 0, cus = 0;
        if (hipGetDevice(&dev) != hipSuccess || hipDeviceGetAttribute(&cus, hipDeviceAttributeMultiprocessorCount, dev) != hipSuccess) { fprintf(stderr, "kernel_launch: device query failed\n"); grid = -1; return; }
        if (n_in != N_IN || ws_size < WS_END) { fprintf(stderr, "kernel_launch: unexpected n_in %d or ws_size %zu (< %zu)\n", n_in, ws_size, (size_t)WS_END); grid = -1; return; }
        grid = cus;
    }
    if (grid < 0) return;
    (void)hipMemsetAsync((char*)d_ws + WS_CTL, 0, 64 * 1024, stream);
    Params p{};
    for (int i = 0; i < N_IN; ++i) p.in[i] = (const float*)d_in[i];
    p.out = (float*)d_out; p.ws = (unsigned char*)d_ws;
    hipLaunchKernelGGL(mega, dim3(grid), dim3(NT), 0, stream, p);
}
```

```cpp
#include <hip/hip_runtime.h>
#include <stdint.h>
#include <cstdio>

#define DI __device__ __forceinline__
#define LAS __attribute__((address_space(3)))
typedef unsigned short bf16_t;
typedef short bf16x8 __attribute__((ext_vector_type(8)));
typedef short s16x4 __attribute__((ext_vector_type(4)));
typedef float f32x4 __attribute__((ext_vector_type(4)));
typedef float f32x2 __attribute__((ext_vector_type(2)));
typedef float f32x16 __attribute__((ext_vector_type(16)));
typedef unsigned u32x4 __attribute__((ext_vector_type(4)));
typedef unsigned u32x2 __attribute__((ext_vector_type(2)));

#ifndef PROBE_PHASE
#define PROBE_PHASE (-1)
#endif
#ifndef PROBE_SCALE
#define PROBE_SCALE 100.f
#endif
constexpr int BATCH = 8, SEQ = 4096, DM = 1024, BT = BATCH * SEQ;
constexpr int CTX = 256, TK = SEQ + CTX;
constexpr int NH = 8, NKV = 2, HD = 64;
constexpr int QD = 512, KVD = 128, HYD = 512, HYC = 1536, GC = 2048, INC = 4352;
constexpr int PH = 8, PNK = 128, PDK = 256, PTOP = 16;
constexpr float EPS = 1e-6f;
constexpr int NT = 1024;

enum { I_X = 0, I_C, I_CTX, I_CCTX, I_ADAW, I_ADAB, I_NMIX, I_NFFN, I_WIN, I_QNG, I_KNG, I_HCW, I_HCB,
       I_HW1, I_HB1, I_HW2, I_HB2, I_HW3, I_HB3, I_HW4, I_HFREQ, I_HSKIP, I_WAO, I_WHO, I_WO, I_PWQ, I_PK1, I_PK2, I_PU, I_PV, I_FNG, N_IN };

constexpr size_t MB = 1024 * 1024;
constexpr size_t WS_CTL   = 0;
constexpr size_t WS_MOD   = 64 * 1024;
constexpr size_t WS_ROPE  = WS_MOD + 9 * 6144 * 4;
constexpr size_t WS_PART  = 512 * 1024;
constexpr size_t WS_WTIN  = 3 * MB;
constexpr size_t WS_WTAO  = WS_WTIN + (size_t)INC * DM * 2;
constexpr size_t WS_WTHO  = WS_WTAO + (size_t)DM * QD * 2;
constexpr size_t WS_WTO   = WS_WTHO + (size_t)DM * HYD * 2;
constexpr size_t WS_WTQ   = WS_WTO + (size_t)DM * DM * 2;
constexpr size_t WS_KEYS  = WS_WTQ + (size_t)2048 * DM * 2;
constexpr size_t WS_R     = WS_KEYS + (size_t)2 * 8 * 128 * 128 * 2;
constexpr size_t WS_KB    = WS_R + (size_t)2 * 512 * 8192 * 2;
constexpr size_t WS_VT    = WS_KB + (size_t)BATCH * NKV * TK * HD * 2;
constexpr size_t WS_HC    = WS_VT + (size_t)BATCH * NKV * TK * HD * 2;
constexpr size_t WS_H     = 60 * MB;
constexpr size_t WS_G     = WS_H + 64 * MB;
constexpr size_t WS_ZT    = WS_G + 128 * MB;
constexpr size_t WS_Q     = WS_ZT + 96 * MB;
constexpr size_t WS_ATT   = WS_Q + 32 * MB;
constexpr size_t WS_HYT   = WS_ATT + 32 * MB;
constexpr size_t WS_TAB   = WS_HYT + 32 * MB;
constexpr size_t WS_END   = WS_TAB + 32 * MB;
static_assert(WS_HC + (size_t)2048 * DM * 2 <= WS_H, "ws overlap");
constexpr size_t WS_FRAW  = WS_ATT;
constexpr size_t WS_HY    = WS_Q;
constexpr size_t WS_UT    = WS_TAB;
constexpr size_t WS_VTAB  = WS_TAB + 16 * MB;
constexpr size_t WS_EXPI  = WS_ATT;
constexpr size_t WS_GATE  = WS_Q;
constexpr size_t WS_PAIRS = WS_HYT;
constexpr size_t WS_SSQ   = WS_PART + 1 * MB;
constexpr size_t WS_USC   = WS_PART + 2 * MB;
constexpr float VSCALE = 64.f;

constexpr int CTL_BADTID = 8000;
DI unsigned f2bf(float f) { unsigned u = __builtin_bit_cast(unsigned, f); return (u + 0x7fffu + ((u >> 16) & 1u)) >> 16; }
DI unsigned pk2(float lo, float hi) { return f2bf(lo) | (f2bf(hi) << 16); }
DI float bf2f(unsigned short b) { return __builtin_bit_cast(float, (unsigned)b << 16); }
DI float bflo(unsigned u) { return __builtin_bit_cast(float, u << 16); }
DI float bfhi(unsigned u) { return __builtin_bit_cast(float, u & 0xffff0000u); }
DI float red2pi(float x) { const float k = rintf(x * 0.15915494309189535f); float r = fmaf(-k, 6.2831854820251465f, x); return fmaf(-k, -1.7484555e-7f, r); }
DI float fsin(float x) { return __sinf(red2pi(x)); }
DI float fcos(float x) { return __cosf(red2pi(x)); }
constexpr int LDS_BYTES = 160 * 1024;
constexpr int LDS_ST_OFF = LDS_BYTES - 16;
constexpr int LDS_PROBE_OFF = LDS_BYTES - 16 - 32;
constexpr int LDS_WTAB_OFF = LDS_BYTES - 16 - 32 - 64;
constexpr int LDS_USER = LDS_WTAB_OFF;
__shared__ __attribute__((aligned(16))) unsigned char g_lds[LDS_BYTES];
DI s16x4 lds_rd64(const unsigned char* ptr) { return *(const volatile LAS s16x4*)(const LAS unsigned char*)ptr; }
DI int get_tid() {
    const unsigned hw = __builtin_amdgcn_s_getreg((5 << 11) | 4);
    unsigned w = g_lds[LDS_WTAB_OFF + hw];
    w = __builtin_amdgcn_readfirstlane(w);
    int t;
    asm volatile("v_mbcnt_lo_u32_b32 %0, -1, 0\n\tv_mbcnt_hi_u32_b32 %0, -1, %0\n\tv_lshl_or_b32 %0, %1, 6, %0" : "=&v"(t) : "s"(w));
    return t;
}
template<int CTRL> DI float dppf(float v) { return __uint_as_float(__builtin_amdgcn_update_dpp(0u, __float_as_uint(v), CTRL, 0xF, 0xF, true)); }
template<int CTRL> DI int dppi(int v) { return (int)__builtin_amdgcn_update_dpp(0u, (unsigned)v, CTRL, 0xF, 0xF, true); }
DI float sum16(float v) { v += dppf<0xB1>(v); v += dppf<0x4E>(v); v += dppf<0x141>(v); v += dppf<0x140>(v); return v; }
DI float sum_x16(float v) { auto r = __builtin_amdgcn_permlane16_swap(__float_as_uint(v), __float_as_uint(v), false, false); return __uint_as_float(r[0]) + __uint_as_float(r[1]); }
DI float sum_x32(float v) { auto r = __builtin_amdgcn_permlane32_swap(__float_as_uint(v), __float_as_uint(v), false, false); return __uint_as_float(r[0]) + __uint_as_float(r[1]); }
DI float max_x32(float v) { auto r = __builtin_amdgcn_permlane32_swap(__float_as_uint(v), __float_as_uint(v), false, false); return fmaxf(__uint_as_float(r[0]), __uint_as_float(r[1])); }
DI float wave_sum(float v) { return sum_x32(sum_x16(sum16(v))); }

#define XB_TMO      128
#define XB_XCNT(j)  (256  + 64 * (j))
#define XB_XSUB(j)  (1280 + 64 * (j))
#define XB_XGEN(j)  (2304 + 64 * (j))
#define XB_TOP      3328
#define XB_TOPGEN   3392
#define XCD_BAR_WORDS 3456
#define XB_SPIN_CAP (1u << 27)
DI unsigned xb_ld(unsigned* p)              { return __hip_atomic_load(p, __ATOMIC_RELAXED, __HIP_MEMORY_SCOPE_AGENT); }
DI unsigned xb_add(unsigned* p, unsigned v) { return __hip_atomic_fetch_add(p, v, __ATOMIC_RELAXED, __HIP_MEMORY_SCOPE_AGENT); }
DI unsigned xb_xcc_id() { return (unsigned)__builtin_amdgcn_s_getreg((3 << 11) | 20) & 0xFu; }
#define XB_SPIN(cond, bar) do { unsigned _sp = 0; while (cond) { __builtin_amdgcn_s_sleep(1); \
    if ((++_sp & 255u) == 0u) { if (xb_ld(&(bar)[XB_TMO])) break; if (_sp > XB_SPIN_CAP) { atomicAdd(&(bar)[XB_TMO], 1u); break; } } } } while (0)
struct XcdBarrier { unsigned* bar; unsigned x; volatile LAS unsigned* st; };
DI XcdBarrier xcd_barrier_post(unsigned* bar, volatile LAS unsigned* st) {
    XcdBarrier b; b.bar = bar; b.x = xb_xcc_id(); b.st = st;
    if (get_tid() == 0) (void)xb_add(&bar[XB_XCNT(b.x)], 1u);
    return b;
}
DI void xcd_barrier_complete(unsigned* bar, unsigned x, unsigned& nloc, unsigned& nx) {
    const unsigned G = gridDim.x * gridDim.y * gridDim.z;
    unsigned sum, cnt, mine, sp = 0u;
    for (;;) {
        sum = 0u; cnt = 0u; mine = 0u;
#pragma unroll
        for (unsigned j = 0; j < 16; ++j) { const unsigned c = xb_ld(&bar[XB_XCNT(j)]); sum += c; cnt += (c > 0u) ? 1u : 0u; mine = (j == x) ? c : mine; }
        if (sum == G) break;
        __builtin_amdgcn_s_sleep(1);
        if ((++sp & 255u) == 0u) { if (xb_ld(&bar[XB_TMO])) break; if (sp > XB_SPIN_CAP) { atomicAdd(&bar[XB_TMO], 1u); break; } }
    }
    nloc = mine > 0u ? mine : 1u; nx = cnt > 0u ? cnt : 1u;
}
DI void xcd_barrier(const XcdBarrier& b) {
    asm volatile("s_waitcnt vmcnt(0)" ::: "memory");
    __syncthreads();
    if (get_tid() == 0) {
        unsigned* bar = b.bar;
        __builtin_amdgcn_s_waitcnt(0);
        unsigned nloc = b.st[0], nx = b.st[1];
        if (nloc == 0u) { xcd_barrier_complete(bar, b.x, nloc, nx); b.st[0] = nloc; b.st[1] = nx; }
        const unsigned old = xb_add(&bar[XB_XSUB(b.x)], 1u);
        const unsigned gen = old / nloc;
        if (old + 1u == (gen + 1u) * nloc) {
            __builtin_amdgcn_fence(__ATOMIC_RELEASE, "agent");
            asm volatile("s_waitcnt vmcnt(0)" ::: "memory");
            const unsigned og = xb_add(&bar[XB_TOP], 1u);
            const unsigned tg = og / nx;
            if (og + 1u == (tg + 1u) * nx) xb_add(&bar[XB_TOPGEN], 1u);
            else XB_SPIN(xb_ld(&bar[XB_TOPGEN]) == tg, bar);
            __builtin_amdgcn_fence(__ATOMIC_ACQUIRE, "agent");
            xb_add(&bar[XB_XGEN(b.x)], 1u);
            asm volatile("s_waitcnt vmcnt(0)" ::: "memory");
        } else {
            XB_SPIN(xb_ld(&bar[XB_XGEN(b.x)]) == gen, bar);
            __builtin_amdgcn_fence(__ATOMIC_ACQUIRE, "agent");
            asm volatile("s_waitcnt vmcnt(0)" ::: "memory");
        }
    }
    __syncthreads();
}

struct Params { const float* in[N_IN]; float* out; unsigned char* ws; };


DI void transpose_tile(const float* __restrict__ W, int K, int N, bf16_t* __restrict__ Wt, int tile, float* sm) {
    const int tid = get_tid();
    const int ntn = N / 256, tk = tile / ntn, tn = tile % ntn;
    __syncthreads();
#pragma unroll
    for (int i = 0; i < 4; ++i) {
        const int idx = tid + i * NT, kk = idx >> 6, n4 = (idx & 63) * 4;
        const f32x4 v = *(const f32x4*)(W + (size_t)(tk * 64 + kk) * N + tn * 256 + n4);
        float* d = sm + kk * 257 + n4;
        d[0] = v[0]; d[1] = v[1]; d[2] = v[2]; d[3] = v[3];
    }
    __syncthreads();
#pragma unroll
    for (int i = 0; i < 2; ++i) {
        const int idx = tid + i * NT, nn = idx & 255, kg = idx >> 8;
        const float* c = sm + kg * 8 * 257 + nn;
        *(u32x4*)(Wt + (size_t)(tn * 256 + nn) * K + tk * 64 + kg * 8) = u32x4{pk2(c[0], c[257]), pk2(c[2 * 257], c[3 * 257]), pk2(c[4 * 257], c[5 * 257]), pk2(c[6 * 257], c[7 * 257])};
    }
}

DI void mod_item(const Params& p, int item, float* sm) {
    const int tid = get_tid();
    float* sc = sm;
    float* red = sm + 9 * 1024;
    __syncthreads();
    for (int i = tid; i < 9 * 1024; i += NT) {
        const float v = (i < 8 * 1024) ? p.in[I_C][i] : p.in[I_CCTX][i - 8 * 1024];
        sc[i] = v / (1.f + __expf(-v));
    }
    __syncthreads();
    const int col = tid & 15, kg = tid >> 4, n0 = item * 16;
    float acc[9];
#pragma unroll
    for (int r = 0; r < 9; ++r) acc[r] = 0.f;
    const float* w = p.in[I_ADAW] + (size_t)kg * 16 * 6144 + n0 + col;
    float wv[16];
#pragma unroll
    for (int k = 0; k < 16; ++k) wv[k] = w[(size_t)k * 6144];
#pragma unroll
    for (int k = 0; k < 16; ++k)
#pragma unroll
        for (int r = 0; r < 9; ++r) acc[r] += sc[r * 1024 + kg * 16 + k] * wv[k];
#pragma unroll
    for (int r = 0; r < 9; ++r) red[(kg * 9 + r) * 16 + col] = acc[r];
    __syncthreads();
    if (tid < 9 * 16) {
        const int r = tid >> 4, c2 = tid & 15;
        float s = p.in[I_ADAB][n0 + c2];
        for (int g = 0; g < 64; ++g) s += red[(g * 9 + r) * 16 + c2];
        ((float*)(p.ws + WS_MOD))[r * 6144 + n0 + c2] = s;
    }
    __syncthreads();
}

DI void filter_item(const Params& p, int item, float* sm) {
    const int tid = get_tid();
    float* z  = sm;
    float* ha = sm + 16 * 36;
    float* hb = ha + 16 * 64;
    const int t0 = item * 16;
    if (tid < 16 * 33) {
        const int pp = tid / 33, i = tid % 33;
        const int t = t0 + pp;
        float v;
        if (i == 0) v = (float)t / (float)(SEQ - 1);
        else {
            const int fi = (i - 1) & 15;
            const float f = 1e-4f + (float)fi * ((15.f - 1e-4f) / 15.f);
            const float w = 6.283185307179586f * (float)t / (float)SEQ;
            const float a = f * w;
            v = (i <= 16) ? fcos(a) : -fsin(a);
        }
        z[pp * 36 + i] = v;
    }
    __syncthreads();
    const int pp = tid >> 6, j = tid & 63;
    const float fr = p.in[I_HFREQ][j];
    {
        float a = p.in[I_HB1][j];
        const float* w1 = p.in[I_HW1];
#pragma unroll 11
        for (int i = 0; i < 33; ++i) a += z[pp * 36 + i] * w1[i * 64 + j];
        ha[pp * 64 + j] = fsin(fr * a);
    }
    __syncthreads();
    {
        float a = p.in[I_HB2][j];
        const float* w2 = p.in[I_HW2];
#pragma unroll 8
        for (int i = 0; i < 64; ++i) a += ha[pp * 64 + i] * w2[i * 64 + j];
        hb[pp * 64 + j] = fsin(fr * a);
    }
    __syncthreads();
    {
        float a = p.in[I_HB3][j];
        const float* w3 = p.in[I_HW3];
#pragma unroll 8
        for (int i = 0; i < 64; ++i) a += hb[pp * 64 + i] * w3[i * 64 + j];
        __syncthreads();
        ha[pp * 64 + j] = fsin(fr * a);
    }
    __syncthreads();
    float* fraw = (float*)(p.ws + WS_FRAW);
    float* part = (float*)(p.ws + WS_PART);
    const float* w4 = p.in[I_HW4];
    {
        const int lane = tid & 63, wave = tid >> 6, l15 = lane & 15, lk = lane >> 4;
        float af[16];
#pragma unroll
        for (int ks = 0; ks < 16; ++ks) af[ks] = ha[l15 * 64 + ks * 4 + lk];
#pragma unroll 1
        for (int nt = 0; nt < 8; ++nt) {
            const int col = (wave * 8 + nt) * 16 + l15;
            f32x4 acc = f32x4{0.f, 0.f, 0.f, 0.f};
#pragma unroll
            for (int ks = 0; ks < 16; ++ks) acc = __builtin_amdgcn_mfma_f32_16x16x4f32(af[ks], w4[(size_t)(ks * 4 + lk) * 2048 + col], acc, 0, 0, 0);
            const int c = col & 511, dir = (col >> 9) & 1;
            const float mind = -3.0701134573253945f, maxd = -15.350567286626973f;
            const float delta = fabsf(mind + (float)c * ((maxd - mind) / 511.f));
            float sabs = 0.f, v[4];
#pragma unroll
            for (int r = 0; r < 4; ++r) {
                const int t = t0 + 4 * lk + r;
                const float t01 = (float)t / (float)(SEQ - 1);
                v[r] = acc[r] * expf(-t01 * delta);
                if (!(dir == 1 && t == 0)) sabs += fabsf(v[r]);
            }
            *(f32x4*)(fraw + (size_t)col * SEQ + t0 + 4 * lk) = f32x4{v[0], v[1], v[2], v[3]};
            sabs = sum_x32(sum_x16(sabs));
            if (lk == 0) part[item * 2048 + col] = sabs;
        }
    }
    __syncthreads();
}

DI void phase_a(const Params& p, float* sm) {
    constexpr int T_WIN = 16 * 17, T_AO = 8 * 4, T_HO = 8 * 4, T_WO = 16 * 4, T_WQ = 16 * 8;
    constexpr int E0 = T_WIN, E1 = E0 + T_AO, E2 = E1 + T_HO, E3 = E2 + T_WO, E4 = E3 + T_WQ;
    constexpr int E5 = E4 + 64;
    constexpr int E6 = E5 + 384;
    constexpr int E7 = E6 + 1;
    constexpr int E8 = E7 + 256;
    for (int it = blockIdx.x; it < E8; it += gridDim.x) {
        int item = it;
        if (item < 256) { filter_item(p, item, sm); if (PROBE_PHASE == 30 && blockIdx.x == 0 && get_tid() == 0) ((volatile unsigned long long*)(g_lds + LDS_PROBE_OFF))[1] = __builtin_amdgcn_s_memrealtime(); continue; }
        item -= 256;
        if (item < 384) { mod_item(p, item, sm); if (PROBE_PHASE == 31 && blockIdx.x == 0 && get_tid() == 0) ((volatile unsigned long long*)(g_lds + LDS_PROBE_OFF))[1] = __builtin_amdgcn_s_memrealtime(); continue; }
        item -= 384;
        if (item < 1) {
            const int tid = get_tid();
            float* rope = (float*)(p.ws + WS_ROPE);
            const int pos = tid >> 4, f = tid & 15;
            const float inv = powf(10000.f, -(float)(2 * f) / 32.f);
            const float ang = (float)pos * inv;
            rope[tid] = fcos(ang); rope[1024 + tid] = fsin(ang);
            continue;
        }
        item -= 1;
        if (item < 64) {
            const int tid = get_tid();
            const float* src = (item < 32) ? p.in[I_PK1] : p.in[I_PK2];
            bf16_t* dst = (bf16_t*)(p.ws + WS_KEYS) + (size_t)item * 4096;
            const f32x4 v = *(const f32x4*)(src + (size_t)(item & 31) * 4096 + tid * 4);
            *(u32x2*)(dst + tid * 4) = u32x2{pk2(v[0], v[1]), pk2(v[2], v[3])};
            continue;
        }
        item -= 64;
        if (item < T_WIN) { transpose_tile(p.in[I_WIN], DM, INC, (bf16_t*)(p.ws + WS_WTIN), item, sm); continue; }
        item -= T_WIN;
        if (item < T_AO) { transpose_tile(p.in[I_WAO], QD, DM, (bf16_t*)(p.ws + WS_WTAO), item, sm); continue; }
        item -= T_AO;
        if (item < T_HO) { transpose_tile(p.in[I_WHO], HYD, DM, (bf16_t*)(p.ws + WS_WTHO), item, sm); continue; }
        item -= T_HO;
        if (item < T_WO) { transpose_tile(p.in[I_WO], DM, DM, (bf16_t*)(p.ws + WS_WTO), item, sm); continue; }
        item -= T_WO;
        transpose_tile(p.in[I_PWQ], DM, 2048, (bf16_t*)(p.ws + WS_WTQ), item, sm);
    }
    (void)E1; (void)E2; (void)E3; (void)E4; (void)E5; (void)E6; (void)E7;
}

DI void norm_mod_row(const float* __restrict__ src, const float* __restrict__ g, const float* __restrict__ shift, const float* __restrict__ scale, bf16_t* __restrict__ dst) {
    const int lane = get_tid() & 63;
    f32x4 v[4];
    float ss = 0.f;
#pragma unroll
    for (int j = 0; j < 4; ++j) { v[j] = *(const f32x4*)(src + j * 256 + lane * 4); ss += v[j][0] * v[j][0] + v[j][1] * v[j][1] + v[j][2] * v[j][2] + v[j][3] * v[j][3]; }
    ss = wave_sum(ss);
    const float rs = rsqrtf(ss * (1.f / DM) + EPS);
#pragma unroll
    for (int j = 0; j < 4; ++j) {
        const int c = j * 256 + lane * 4;
        const f32x4 gg = *(const f32x4*)(g + c), sh = *(const f32x4*)(shift + c), sc = *(const f32x4*)(scale + c);
        float o[4];
#pragma unroll
        for (int e = 0; e < 4; ++e) o[e] = v[j][e] * rs * gg[e] * (1.f + sc[e]) + sh[e];
        *(u32x2*)(dst + c) = u32x2{pk2(o[0], o[1]), pk2(o[2], o[3])};
    }
}

DI void filter_norm_item(const Params& p, int item, float* sm) {
    const int tid = get_tid();
    const int o = item >> 9, c = item & 511;
    const int colf = o * 1024 + c, colb = colf + 512;
    const float* part = (const float*)(p.ws + WS_PART);
    float s = 0.f;
    if (tid < 512) s = part[(tid & 255) * 2048 + ((tid < 256) ? colf : colb)];
    s = wave_sum(s);
    if ((tid & 63) == 0) sm[tid >> 6] = s;
    __syncthreads();
    float tot = EPS;
#pragma unroll
    for (int i = 0; i < 8; ++i) tot += sm[i];
    const float inv = 1.f / tot;
    const float* fraw = (const float*)(p.ws + WS_FRAW);
    bf16_t* R = (bf16_t*)(p.ws + WS_R) + (size_t)item * 8192;
#pragma unroll
    for (int i = 0; i < 4; ++i) {
        const int n = (tid + i * NT) * 2;
        float v0, v1;
        if (n < 4096) { v0 = (n == 0) ? 0.f : fraw[(size_t)colf * SEQ + 4096 - n]; v1 = fraw[(size_t)colf * SEQ + 4095 - n]; }
        else if (n == 4096) { v0 = fraw[(size_t)colf * SEQ]; v1 = fraw[(size_t)colb * SEQ + 1]; }
        else { v0 = fraw[(size_t)colb * SEQ + n - 4096]; v1 = fraw[(size_t)colb * SEQ + n - 4095]; }
        *(unsigned*)(R + n) = pk2(v0 * inv, v1 * inv);
    }
    __syncthreads();
}

DI void table_conv_item(const Params& p, int ci, unsigned char* lds) {
    const int tid = get_tid();
    const size_t el = (size_t)(ci & 2047) * 8192 + tid * 8;
    const float* src = (ci < 2048 ? p.in[I_PU] : p.in[I_PV]) + el;
    const f32x4 a = *(const f32x4*)src, b = *(const f32x4*)(src + 4);
    const size_t e = el >> 10, col = el & 1023;
    if (ci < 2048) {
        float mx = fmaxf(fmaxf(fmaxf(fabsf(a[0]), fabsf(a[1])), fmaxf(fabsf(a[2]), fabsf(a[3]))), fmaxf(fmaxf(fabsf(b[0]), fabsf(b[1])), fmaxf(fabsf(b[2]), fabsf(b[3]))));
        mx = fmaxf(mx, dppf<0xB1>(mx)); mx = fmaxf(mx, dppf<0x4E>(mx)); mx = fmaxf(mx, dppf<0x141>(mx)); mx = fmaxf(mx, dppf<0x140>(mx));
        { auto r = __builtin_amdgcn_permlane16_swap(__float_as_uint(mx), __float_as_uint(mx), false, false); mx = fmaxf(__uint_as_float(r[0]), __uint_as_float(r[1])); }
        { auto r = __builtin_amdgcn_permlane32_swap(__float_as_uint(mx), __float_as_uint(mx), false, false); mx = fmaxf(__uint_as_float(r[0]), __uint_as_float(r[1])); }
        float* wm = (float*)lds;
        __syncthreads();
        if ((tid & 63) == 0) wm[tid >> 6] = mx;
        __syncthreads();
        const float rm = fmaxf(fmaxf(wm[(tid >> 7) * 2], wm[(tid >> 7) * 2 + 1]), 1e-30f);
        const float sc = 127.f / rm;
        if ((tid & 127) == 0) ((float*)(p.ws + WS_USC))[e] = rm * (1.f / 127.f);
        const int q0 = __float2int_rn(a[0] * sc), q1 = __float2int_rn(a[1] * sc), q2 = __float2int_rn(a[2] * sc), q3 = __float2int_rn(a[3] * sc);
        const int q4 = __float2int_rn(b[0] * sc), q5 = __float2int_rn(b[1] * sc), q6 = __float2int_rn(b[2] * sc), q7 = __float2int_rn(b[3] * sc);
        const unsigned w0 = (q0 & 255) | ((q1 & 255) << 8) | ((q2 & 255) << 16) | ((unsigned)q3 << 24);
        const unsigned w1 = (q4 & 255) | ((q5 & 255) << 8) | ((q6 & 255) << 16) | ((unsigned)q7 << 24);
        *(u32x2*)(p.ws + WS_UT + el) = u32x2{w0, w1};
    } else {
        const float sc = VSCALE;
        int w0 = 0, w1 = 0;
        w0 = __builtin_amdgcn_cvt_pk_fp8_f32(a[0] * sc, a[1] * sc, w0, false); w0 = __builtin_amdgcn_cvt_pk_fp8_f32(a[2] * sc, a[3] * sc, w0, true);
        w1 = __builtin_amdgcn_cvt_pk_fp8_f32(b[0] * sc, b[1] * sc, w1, false); w1 = __builtin_amdgcn_cvt_pk_fp8_f32(b[2] * sc, b[3] * sc, w1, true);
        *(u32x2*)(p.ws + WS_VTAB + ((col >> 7) * 16384 + e) * 128 + (col & 127)) = u32x2{(unsigned)w0, (unsigned)w1};
    }
}

DI void phase_b(const Params& p, float* sm) {
    const int wave = get_tid() >> 6;
    const float* mod = (const float*)(p.ws + WS_MOD);
    constexpr int ROW_ITEMS = (BT + BATCH * CTX) / 16;
    constexpr int CONV = 2 * 16384 * 1024 / 8192;
    for (int it = blockIdx.x; it < ROW_ITEMS + 1024 + CONV; it += gridDim.x) {
        if (it < 1024) { filter_norm_item(p, it, sm); continue; }
        if (it >= ROW_ITEMS + 1024) { table_conv_item(p, it - ROW_ITEMS - 1024, (unsigned char*)sm); continue; }
        const int row = (it - 1024) * 16 + wave;
        if (row < BT) {
            const int b = row >> 12;
            norm_mod_row(p.in[I_X] + (size_t)row * DM, p.in[I_NMIX], mod + b * 6144, mod + b * 6144 + 1024, (bf16_t*)(p.ws + WS_H) + (size_t)row * DM);
        } else {
            const int r = row - BT;
            norm_mod_row(p.in[I_CTX] + (size_t)r * DM, p.in[I_NMIX], mod + 8 * 6144, mod + 8 * 6144 + 1024, (bf16_t*)(p.ws + WS_HC) + (size_t)r * DM);
        }
    }
}

#define MFMA16(a, b, c) __builtin_amdgcn_mfma_f32_16x16x32_bf16((a), (b), (c), 0, 0, 0)
constexpr int GT_P = 256 * 128;
struct RowLoader {
    const bf16_t* base; int ld;
    template<int ROWS> DI void issue(unsigned char* tile, int kt, int lane, int wave) const {
#pragma unroll
        for (int i = 0; i < ROWS / 128; ++i) {
            const int grp = i * 16 + wave, row = grp * 8 + (lane >> 3), c = (lane & 7) ^ (lane >> 3);
            __builtin_amdgcn_global_load_lds((const unsigned*)(base + (size_t)row * ld + kt * 64 + c * 8), (unsigned*)(tile + grp * 1024), 16, 0, 0);
        }
    }
};

template<int NQ>
DI void gemm_mainloop(f32x4 (&acc)[4][NQ], const RowLoader& lp, const RowLoader& lq, int nk, unsigned char* lds) {
    const int tid = get_tid(), lane = tid & 63, wave = __builtin_amdgcn_readfirstlane(tid >> 6), wp = wave >> 2, wq = wave & 3;
    constexpr int QROWS = NQ * 64;
    constexpr int STAGE = GT_P + QROWS * 128;
    __syncthreads();
    lp.template issue<256>(lds, 0, lane, wave); lq.template issue<QROWS>(lds + GT_P, 0, lane, wave);
    asm volatile("s_waitcnt vmcnt(0)" ::: "memory");
    __syncthreads();
    const int l15 = lane & 15, lk = lane >> 4;
    for (int kt = 0; kt < nk; ++kt) {
        unsigned char* cur = lds + (kt & 1) * STAGE;
        unsigned char* nxt = lds + ((kt + 1) & 1) * STAGE;
        if (kt + 1 < nk) { lp.template issue<256>(nxt, kt + 1, lane, wave); lq.template issue<QROWS>(nxt + GT_P, kt + 1, lane, wave); }
#pragma unroll
        for (int ks = 0; ks < 2; ++ks) {
            bf16x8 fp[4], fq[NQ];
#pragma unroll
            for (int i = 0; i < 4; ++i) { const int row = wp * 64 + i * 16 + l15; fp[i] = *(const bf16x8*)(cur + row * 128 + (((ks * 4 + lk) ^ (row & 7)) << 4)); }
#pragma unroll
            for (int j = 0; j < NQ; ++j) { const int row = wq * (16 * NQ) + j * 16 + l15; fq[j] = *(const bf16x8*)(cur + GT_P + row * 128 + (((ks * 4 + lk) ^ (row & 7)) << 4)); }
#pragma unroll
            for (int i = 0; i < 4; ++i)
#pragma unroll
                for (int j = 0; j < NQ; ++j) acc[i][j] = MFMA16(fp[i], fq[j], acc[i][j]);
        }
        asm volatile("s_waitcnt vmcnt(0)" ::: "memory");
        __syncthreads();
    }
}

#ifndef SHADOW
#define SHADOW 0
#endif
template<int NQ>
DI void gemm_shadow(const RowLoader& lp, const RowLoader& lq, int nk, unsigned char* lds) {
    f32x4 acc[4][NQ];
#pragma unroll
    for (int i = 0; i < 4; ++i)
#pragma unroll
        for (int j = 0; j < NQ; ++j) acc[i][j] = f32x4{0.f, 0.f, 0.f, 0.f};
    if (SHADOW == 1) gemm_mainloop<NQ>(acc, lp, lq, nk, lds);
    else {
        const int tid = get_tid(), lane = tid & 63, wave = __builtin_amdgcn_readfirstlane(tid >> 6), wp = wave >> 2, wq = wave & 3;
        constexpr int QROWS = NQ * 64;
        constexpr int STAGE = GT_P + QROWS * 128;
        const int l15 = lane & 15, lk = lane >> 4;
        bf16x8 fp[4], fq[NQ];
        if (SHADOW == 3) {
#pragma unroll
            for (int i = 0; i < 4; ++i) fp[i] = *(const bf16x8*)(lds + (wp * 64 + i * 16 + l15) * 128 + lk * 16);
#pragma unroll
            for (int j = 0; j < NQ; ++j) fq[j] = *(const bf16x8*)(lds + GT_P + (wq * 16 * NQ + j * 16 + l15) * 128 + lk * 16);
        }
        for (int kt = 0; kt < nk; ++kt) {
            unsigned char* cur = lds + (kt & 1) * STAGE;
#pragma unroll
            for (int ks = 0; ks < 2; ++ks) {
                if (SHADOW == 2 || SHADOW == 4) {
#pragma unroll
                    for (int i = 0; i < 4; ++i) { const int row = wp * 64 + i * 16 + l15; fp[i] = *(const bf16x8*)(cur + row * 128 + (((ks * 4 + lk) ^ (row & 7)) << 4)); }
#pragma unroll
                    for (int j = 0; j < NQ; ++j) { const int row = wq * (16 * NQ) + j * 16 + l15; fq[j] = *(const bf16x8*)(cur + GT_P + row * 128 + (((ks * 4 + lk) ^ (row & 7)) << 4)); }
                }
#pragma unroll
                for (int i = 0; i < 4; ++i)
#pragma unroll
                    for (int j = 0; j < NQ; ++j) acc[i][j] = MFMA16(fp[i], fq[j], acc[i][j]);
            }
            if (SHADOW == 2) asm volatile("" ::: "memory");
            if (SHADOW == 4) __syncthreads();
        }
    }
#pragma unroll
    for (int i = 0; i < 4; ++i)
#pragma unroll
        for (int j = 0; j < NQ; ++j) asm volatile("" :: "v"(acc[i][j]));
}

template<int NQ> DI void gemm_shadow1(const RowLoader& lp, const RowLoader& lq, int nk, unsigned char* lds) {
    f32x4 acc[4][NQ];
#pragma unroll
    for (int i = 0; i < 4; ++i)
#pragma unroll
        for (int j = 0; j < NQ; ++j) acc[i][j] = f32x4{0.f, 0.f, 0.f, 0.f};
    gemm_mainloop<NQ>(acc, lp, lq, nk, lds);
#pragma unroll
    for (int i = 0; i < 4; ++i)
#pragma unroll
        for (int j = 0; j < NQ; ++j) asm volatile("" :: "v"(acc[i][j]));
}
DI void head_epilogue(f32x4 (&acc)[4][4], const float* __restrict__ g, float gscale, const float* __restrict__ rope, bool do_rope, int t_base  , bf16_t* __restrict__ dst  , int lane) {
    const int l15 = lane & 15, lk = lane >> 4;
    float gg[4];
#pragma unroll
    for (int j = 0; j < 4; ++j) gg[j] = g[j * 16 + l15] * gscale;
#pragma unroll
    for (int i = 0; i < 4; ++i) {
#pragma unroll
        for (int r = 0; r < 4; ++r) {
            float ss = 0.f;
#pragma unroll
            for (int j = 0; j < 4; ++j) ss += acc[i][j][r] * acc[i][j][r];
            ss = sum16(ss);
            const float rs = rsqrtf(ss * (1.f / 64.f) + EPS);
            float v[4];
#pragma unroll
            for (int j = 0; j < 4; ++j) v[j] = acc[i][j][r] * rs * gg[j];
            const int t = t_base + i * 16 + lk * 4 + r;
            if (do_rope) {
                const int prow = (t >> 6) & 63, pcol = t & 63;
                const float c0 = rope[prow * 16 + l15], s0 = rope[1024 + prow * 16 + l15];
                const float c1 = rope[pcol * 16 + l15], s1 = rope[1024 + pcol * 16 + l15];
                const float a0 = v[0] * c0 - v[1] * s0, a1 = v[1] * c0 + v[0] * s0;
                const float a2 = v[2] * c1 - v[3] * s1, a3 = v[3] * c1 + v[2] * s1;
                v[0] = a0; v[1] = a1; v[2] = a2; v[3] = a3;
            }
            bf16_t* d = dst + (size_t)(i * 16 + lk * 4 + r) * 64 + l15;
#pragma unroll
            for (int j = 0; j < 4; ++j) d[j * 16] = (bf16_t)f2bf(v[j]);
        }
    }
}
DI void tstore_epilogue(f32x4 (&acc)[4][4], bf16_t* __restrict__ dst  , size_t ld, int lane) {
    const int l15 = lane & 15, lk = lane >> 4;
#pragma unroll
    for (int i = 0; i < 4; ++i)
#pragma unroll
        for (int j = 0; j < 4; ++j)
            *(u32x2*)(dst + (size_t)(j * 16 + l15) * ld + i * 16 + lk * 4) = u32x2{pk2(acc[i][j][0], acc[i][j][1]), pk2(acc[i][j][2], acc[i][j][3])};
}

DI void phase_c(const Params& p, unsigned char* lds) {
    constexpr int NTM = BT / 256, NTN = INC / 256;
    constexpr int MAIN = NTM * NTN, TOTAL = MAIN + 8;
    const bf16_t* H = (const bf16_t*)(p.ws + WS_H);
    const bf16_t* HCp = (const bf16_t*)(p.ws + WS_HC);
    const bf16_t* WT = (const bf16_t*)(p.ws + WS_WTIN);
    const float* rope = (const float*)(p.ws + WS_ROPE);
    for (int it = blockIdx.x; it < TOTAL; it += gridDim.x) {
        const int tid = get_tid(), lane = tid & 63, wave = tid >> 6, wa = wave >> 2, wb = wave & 3;
        int tm, tn; bool ctx = false;
        if (it < MAIN) { const int g = it / (16 * NTN), rem = it % (16 * NTN); tn = rem >> 4; tm = g * 16 + (rem & 15); }
        else { ctx = true; tm = it - MAIN; tn = 2; }
        const bf16_t* A = ctx ? HCp + (size_t)tm * 256 * DM : H + (size_t)tm * 256 * DM;
        const bf16_t* W = WT + (size_t)tn * 256 * DM;
        f32x4 acc[4][4];
#pragma unroll
        for (int i = 0; i < 4; ++i)
#pragma unroll
            for (int j = 0; j < 4; ++j) acc[i][j] = f32x4{0.f, 0.f, 0.f, 0.f};
        if (tn >= 9) {
            gemm_mainloop<4>(acc, RowLoader{W, DM}, RowLoader{A, DM}, DM / 64, lds);
            bf16_t* G = (bf16_t*)(p.ws + WS_G);
            const int l15 = lane & 15, lk = lane >> 4;
#pragma unroll
            for (int i = 0; i < 4; ++i)
#pragma unroll
                for (int j = 0; j < 4; ++j) {
                    const int n = tn * 256 - 2304 + wa * 64 + i * 16 + lk * 4;
                    const int tok = tm * 256 + wb * 64 + j * 16 + l15;
                    float sg[4];
#pragma unroll
                    for (int r = 0; r < 4; ++r) sg[r] = 1.f / (1.f + __expf(-acc[i][j][r]));
                    *(u32x2*)(G + (size_t)tok * GC + n) = u32x2{pk2(sg[0], sg[1]), pk2(sg[2], sg[3])};
                }
            continue;
        }
        if (SHADOW) gemm_shadow<4>(RowLoader{A, DM}, RowLoader{W, DM}, DM / 64, lds);
        gemm_mainloop<4>(acc, RowLoader{A, DM}, RowLoader{W, DM}, DM / 64, lds);
        const int b = ctx ? tm : (tm >> 4);
        const int tpos = ctx ? SEQ + wa * 64 : ((tm & 15) * 256 + wa * 64);
        if (tn < 2) {
            const int h = tn * 4 + wb;
            bf16_t* Q = (bf16_t*)(p.ws + WS_Q) + ((size_t)(b * NH + h) * SEQ + tpos) * HD;
            head_epilogue(acc, p.in[I_QNG], 0.125f * 1.4426950408889634f, rope, true, tpos, Q, lane);
        } else if (tn == 2) {
            if (wb < 2) {
                bf16_t* K = (bf16_t*)(p.ws + WS_KB) + ((size_t)(b * NKV + wb) * TK + tpos) * HD;
                head_epilogue(acc, p.in[I_KNG], 1.f, rope, !ctx, tpos, K, lane);
            } else {
                bf16_t* V = (bf16_t*)(p.ws + WS_VT) + (size_t)(b * NKV + (wb - 2)) * HD * TK + tpos;
                tstore_epilogue(acc, V, TK, lane);
            }
        } else {
            const int col = tn * 256 - 768 + wb * 64;
            bf16_t* Z = (bf16_t*)(p.ws + WS_ZT) + (size_t)col * BT + (size_t)b * SEQ + tpos;
            tstore_epilogue(acc, Z, BT, lane);
        }
    }
}

#define MFMA32(a, b, c) __builtin_amdgcn_mfma_f32_32x32x16_bf16((a), (b), (c), 0, 0, 0)
DI bf16x8 pack_step(const f32x16& x, int s) {
    u32x4 pk;
    asm volatile("v_cvt_pk_bf16_f32 %0, %4, %5\n\tv_cvt_pk_bf16_f32 %1, %6, %7\n\tv_cvt_pk_bf16_f32 %2, %8, %9\n\tv_cvt_pk_bf16_f32 %3, %10, %11\n\ts_nop 1"
                 : "=&v"(pk[0]), "=&v"(pk[1]), "=&v"(pk[2]), "=&v"(pk[3])
                 : "v"(x[8 * s]), "v"(x[8 * s + 1]), "v"(x[8 * s + 2]), "v"(x[8 * s + 3]), "v"(x[8 * s + 4]), "v"(x[8 * s + 5]), "v"(x[8 * s + 6]), "v"(x[8 * s + 7]));
    return __builtin_bit_cast(bf16x8, pk);
}

constexpr int AT_KSTR = 144, AT_VSTR = 136, AT_VOFF = 64 * AT_KSTR, AT_STAGE = AT_VOFF + 64 * AT_VSTR;
DI void attn_item(const Params& p, int item, unsigned char* lds) {
    const int tid = get_tid(), lane = tid & 63, wave = tid >> 6;
    const int b = item >> 6, kvh = (item >> 5) & 1, qb = item & 31;
    const int h = kvh * 4 + (wave >> 2), q0 = qb * 128 + (wave & 3) * 32;
    const int qi = lane & 31, hf = lane >> 5;
    const bf16_t* Qp = (const bf16_t*)(p.ws + WS_Q) + ((size_t)(b * NH + h) * SEQ + q0 + qi) * HD;
    bf16x8 qf[4];
#pragma unroll
    for (int s = 0; s < 4; ++s) qf[s] = *(const bf16x8*)(Qp + 16 * s + 8 * hf);
    const bf16_t* Kg = (const bf16_t*)(p.ws + WS_KB) + (size_t)(b * NKV + kvh) * TK * HD;
    const bf16_t* Vg = (const bf16_t*)(p.ws + WS_VT) + (size_t)(b * NKV + kvh) * HD * TK;
    const bool isK = tid < 512;
    const int li = tid & 511, lrow = li >> 3, lc = li & 7;
    const bf16_t* src = isK ? Kg + (size_t)lrow * HD + lc * 8 : Vg + (size_t)lrow * TK + lc * 8;
    const size_t sstep = isK ? (size_t)64 * HD : 64;
    const int ldst = isK ? lrow * AT_KSTR + lc * 16 : AT_VOFF + lrow * AT_VSTR + lc * 16;
    constexpr int NTILE = TK / 64;
    f32x16 o0, o1;
#pragma unroll
    for (int i = 0; i < 16; ++i) { o0[i] = 0.f; o1[i] = 0.f; }
    float l = 0.f;
    __syncthreads();
    constexpr int NSUB = 4, NSTG = NTILE / NSUB;
    static_assert(NTILE % NSUB == 0 && 2 * NSUB * AT_STAGE <= LDS_USER, "attention LDS stages");
    u32x4 stg[NSUB];
#pragma unroll
    for (int j = 0; j < NSUB; ++j) stg[j] = *(const u32x4*)(src + (size_t)j * sstep);
#pragma unroll
    for (int j = 0; j < NSUB; ++j) { unsigned char* d = lds + j * AT_STAGE + ldst; *(u32x2*)d = u32x2{stg[j][0], stg[j][1]}; *(u32x2*)(d + 8) = u32x2{stg[j][2], stg[j][3]}; }
    __syncthreads();
    const int koff = qi * AT_KSTR + hf * 16;
    const int voff = AT_VOFF + qi * AT_VSTR + hf * 8;
    for (int st = 0; st < NSTG; ++st) {
      const bool more = st + 1 < NSTG;
      if (more) {
#pragma unroll
          for (int j = 0; j < NSUB; ++j) stg[j] = *(const u32x4*)(src + (size_t)((st + 1) * NSUB + j) * sstep);
      }
#pragma unroll 1
      for (int j = 0; j < NSUB; ++j) {
        const unsigned char* cur = lds + ((st & 1) * NSUB + j) * AT_STAGE;
        f32x16 sA, sB;
#pragma unroll
        for (int i = 0; i < 16; ++i) { sA[i] = 0.f; sB[i] = 0.f; }
#pragma unroll
        for (int s = 0; s < 4; ++s) sA = MFMA32(*(const bf16x8*)(cur + koff + s * 32), qf[s], sA);
#pragma unroll
        for (int s = 0; s < 4; ++s) sB = MFMA32(*(const bf16x8*)(cur + koff + 32 * AT_KSTR + s * 32), qf[s], sB);
        float ps = 0.f;
#pragma unroll
        for (int kb = 0; kb < 2; ++kb) {
            f32x16& sx = kb ? sB : sA;
#pragma unroll
            for (int i = 0; i < 16; ++i) { sx[i] = __builtin_amdgcn_exp2f(sx[i]); ps += sx[i]; }
#pragma unroll
            for (int s2 = 0; s2 < 2; ++s2) {
                const bf16x8 pf = pack_step(sx, s2);
#pragma unroll
                for (int db = 0; db < 2; ++db) {
                    const unsigned char* vb = cur + voff + db * 32 * AT_VSTR + (4 * kb + 2 * s2) * 16;
                    const s16x4 lo = lds_rd64(vb);
                    const s16x4 hi = lds_rd64(vb + 16);
                    const bf16x8 vf = __builtin_shufflevector(lo, hi, 0, 1, 2, 3, 4, 5, 6, 7);
                    if (db == 0) o0 = MFMA32(vf, pf, o0); else o1 = MFMA32(vf, pf, o1);
                }
            }
        }
        l += ps;
      }
      if (more) {
#pragma unroll
          for (int j = 0; j < NSUB; ++j) { unsigned char* d = lds + (((st + 1) & 1) * NSUB + j) * AT_STAGE + ldst; *(u32x2*)d = u32x2{stg[j][0], stg[j][1]}; *(u32x2*)(d + 8) = u32x2{stg[j][2], stg[j][3]}; }
      }
      __syncthreads();
    }
    l = sum_x32(l);
    const float inv = 1.f / l;
    bf16_t* O;
    {
        const int t2 = get_tid(), lane2 = t2 & 63, wave2 = t2 >> 6;
        const int h2 = kvh * 4 + (wave2 >> 2), q2 = qb * 128 + (wave2 & 3) * 32 + (lane2 & 31);
        O = (bf16_t*)(p.ws + WS_ATT) + ((size_t)b * SEQ + q2) * QD + h2 * HD + 4 * (lane2 >> 5);
    }
#pragma unroll
    for (int g4 = 0; g4 < 4; ++g4) {
        *(u32x2*)(O + 8 * g4)      = u32x2{pk2(o0[4 * g4] * inv, o0[4 * g4 + 1] * inv), pk2(o0[4 * g4 + 2] * inv, o0[4 * g4 + 3] * inv)};
        *(u32x2*)(O + 32 + 8 * g4) = u32x2{pk2(o1[4 * g4] * inv, o1[4 * g4 + 1] * inv), pk2(o1[4 * g4 + 2] * inv, o1[4 * g4 + 3] * inv)};
    }
}

constexpr int HY_USTR = 8208, HY_R = 8 * HY_USTR, HY_RSTR = 16384 + 64;
DI void hy_load_filter(const bf16_t* __restrict__ R, unsigned char* lds, int tid) {
    const int i0 = tid * 8;
    const u32x4 w = *(const u32x4*)(R + i0);
    u32x2 nx = u32x2{0u, 0u};
    if (i0 + 8 < 8192) nx = *(const u32x2*)(R + i0 + 8);
    unsigned char* d = lds + HY_R + i0 * 2;
    *(u32x4*)(d) = w;
    *(u32x4*)(d + HY_RSTR) = u32x4{__builtin_amdgcn_alignbit(w[1], w[0], 16), __builtin_amdgcn_alignbit(w[2], w[1], 16), __builtin_amdgcn_alignbit(w[3], w[2], 16), __builtin_amdgcn_alignbit(nx[0], w[3], 16)};
    *(u32x4*)(d + 2 * HY_RSTR) = u32x4{w[1], w[2], w[3], nx[0]};
    *(u32x4*)(d + 3 * HY_RSTR) = u32x4{__builtin_amdgcn_alignbit(w[2], w[1], 16), __builtin_amdgcn_alignbit(w[3], w[2], 16), __builtin_amdgcn_alignbit(nx[0], w[3], 16), __builtin_amdgcn_alignbit(nx[1], nx[0], 16)};
}
DI void short_conv4(const bf16_t* __restrict__ zrow  , int t4, float w0, float w1, float w2, float bias, float (&out)[4]) {
    const u32x2 v = *(const u32x2*)(zrow + t4);
    const float z0 = bflo(v[0]), z1 = bfhi(v[0]), z2 = bflo(v[1]), z3 = bfhi(v[1]);
    const float zm = (t4 > 0) ? bf2f(zrow[t4 - 1]) : 0.f;
    const float zp = (t4 + 4 < SEQ) ? bf2f(zrow[t4 + 4]) : 0.f;
    out[0] = zm * w0 + z0 * w1 + z1 * w2 + bias;
    out[1] = z0 * w0 + z1 * w1 + z2 * w2 + bias;
    out[2] = z1 * w0 + z2 * w1 + z3 * w2 + bias;
    out[3] = z2 * w0 + z3 * w1 + zp * w2 + bias;
}
DI void hyena_item(const Params& p, int c, unsigned char* lds) {
    const int tid = get_tid(), lane = tid & 63, ig = tid >> 6;
    const bf16_t* ZT = (const bf16_t*)(p.ws + WS_ZT);
    const float* cw = p.in[I_HCW];
    const float* cb = p.in[I_HCB];
    __syncthreads();
    {
        const int b = tid >> 7, tb = (tid & 127) * 32;
        const bf16_t* zrow = ZT + (size_t)c * BT + (size_t)b * SEQ;
        const float w0 = cw[c], w1 = cw[HYC + c], w2 = cw[2 * HYC + c], bias = cb[c];
#pragma unroll
        for (int q = 0; q < 8; ++q) {
            float o[4];
            short_conv4(zrow, tb + 4 * q, w0, w1, w2, bias, o);
            *(u32x2*)(lds + b * HY_USTR + (tb + 4 * q) * 2) = u32x2{pk2(o[0], o[1]), pk2(o[2], o[3])};
        }
    }
    const int r = lane & 31, hf = lane >> 5, Il = r >> 3, bb = r & 7;
#pragma unroll 1
    for (int o = 0; o < 2; ++o) {
        hy_load_filter((const bf16_t*)(p.ws + WS_R) + (size_t)(o * 512 + c) * 8192, lds, tid);
        __syncthreads();
        f32x16 acc0, acc1;
#pragma unroll
        for (int i = 0; i < 16; ++i) { acc0[i] = 0.f; acc1[i] = 0.f; }
        const int sh = (-r) & 3;
        const unsigned char* abase = lds + HY_R + sh * HY_RSTR + (4096 + 8 * hf - r - sh) * 2 - 64;
        const unsigned char* ubase = lds + bb * HY_USTR + ((4 * ig + Il) * 64 + 8 * hf) * 2;
#define HY_STEP(MASKED) do { \
            const unsigned char* ap = abase - 128 * d; \
            const unsigned char* ub = ubase - 128 * d; \
            bool valid = true; \
            if (MASKED) { const int J = 4 * ig + Il - d; valid = (unsigned)J < 64u; if (!valid) ub = lds; } \
            _Pragma("unroll") for (int ks = 0; ks < 4; ++ks) { \
                u32x4 braw = *(const u32x4*)(ub + ks * 32); \
                if (MASKED) { if (!valid) braw = u32x4{0u, 0u, 0u, 0u}; } \
                const bf16x8 bf = __builtin_bit_cast(bf16x8, braw); \
                { const s16x4 lo = lds_rd64(ap + 32 * ks + 64), hi = lds_rd64(ap + 32 * ks + 72);     \
                  acc0 = MFMA32(__builtin_shufflevector(lo, hi, 0, 1, 2, 3, 4, 5, 6, 7), bf, acc0); } \
                { const s16x4 lo = lds_rd64(ap + 32 * ks), hi = lds_rd64(ap + 32 * ks + 8); \
                  acc1 = MFMA32(__builtin_shufflevector(lo, hi, 0, 1, 2, 3, 4, 5, 6, 7), bf, acc1); } \
            } } while (0)
        const int dlo = 4 * ig - 63, dhi = 4 * ig + 3;
#pragma unroll 1
        for (int d = dlo; d < dlo + 3; ++d) HY_STEP(true);
#pragma unroll 1
        for (int d = dlo + 3; d <= dhi - 3; ++d) HY_STEP(false);
#pragma unroll 1
        for (int d = dhi - 2; d <= dhi; ++d) HY_STEP(true);
#undef HY_STEP
        __syncthreads();
        const float skip = p.in[I_HSKIP][o * HYD + c];
        const int gcol = (o == 0 ? 512 : 1024) + c;
        const float w0 = cw[gcol], w1 = cw[HYC + gcol], w2 = cw[2 * HYC + gcol], bias = cb[gcol];
        const bf16_t* zrow = ZT + (size_t)gcol * BT + (size_t)bb * SEQ;
        bf16_t* hyt = (bf16_t*)(p.ws + WS_HYT) + (size_t)c * BT + (size_t)bb * SEQ;
#pragma unroll
        for (int mm = 0; mm < 2; ++mm) {
#pragma unroll
            for (int g4 = 0; g4 < 4; ++g4) {
                const int t4 = (4 * ig + Il) * 64 + 32 * mm + 8 * g4 + 4 * hf;
                float gt[4];
                short_conv4(zrow, t4, w0, w1, w2, bias, gt);
                unsigned char* up = lds + bb * HY_USTR + t4 * 2;
                const u32x2 uv = *(const u32x2*)up;
                const float u0 = bflo(uv[0]), u1 = bfhi(uv[0]), u2 = bflo(uv[1]), u3 = bfhi(uv[1]);
                const f32x16& a = mm ? acc1 : acc0;
                const float y0 = gt[0] * (a[4 * g4] + skip * u0), y1 = gt[1] * (a[4 * g4 + 1] + skip * u1);
                const float y2 = gt[2] * (a[4 * g4 + 2] + skip * u2), y3 = gt[3] * (a[4 * g4 + 3] + skip * u3);
                const u32x2 pk = u32x2{pk2(y0, y1), pk2(y2, y3)};
                if (o == 0) *(u32x2*)up = pk; else *(u32x2*)(hyt + t4) = pk;
            }
        }
        __syncthreads();
    }
}

constexpr int CTL_QUEUE_D = 8192;
template<bool HY> DI void phase_d(const Params& p, unsigned char* lds) {
    unsigned* ctr = (unsigned*)(p.ws + WS_CTL) + CTL_QUEUE_D + (HY ? 0 : 64);
    volatile LAS unsigned* slot = (volatile LAS unsigned*)(LAS unsigned char*)(lds + LDS_ST_OFF + 8);
    for (;;) {
        __syncthreads();
        if (get_tid() == 0) slot[0] = atomicAdd(ctr, 1u);
        __syncthreads();
        const int it = __builtin_amdgcn_readfirstlane((int)slot[0]);
        if (it >= 512) break;
        if (HY) hyena_item(p, it, lds); else attn_item(p, it, lds);
    }
}

DI void phase_d2(const Params& p, unsigned char* lds) {
    constexpr int TILES = 8 * (BT / 256);
    const bf16_t* HYT = (const bf16_t*)(p.ws + WS_HYT);
    bf16_t* HY = (bf16_t*)(p.ws + WS_HY);
    for (int it = blockIdx.x; it < TILES; it += gridDim.x) {
        const int tid = get_tid();
        const int c0 = (it & 7) * 64, tok0 = (it >> 3) * 256;
        __syncthreads();
#pragma unroll
        for (int i = 0; i < 2; ++i) {
            const int idx = tid + i * NT, c = idx >> 5, tg = idx & 31;
            *(u32x4*)(lds + c * 528 + tg * 16) = *(const u32x4*)(HYT + (size_t)(c0 + c) * BT + tok0 + tg * 8);
        }
        __syncthreads();
#pragma unroll
        for (int i = 0; i < 2; ++i) {
            const int idx = tid + i * NT, tok = idx >> 3, cg = idx & 7;
            unsigned w[4];
#pragma unroll
            for (int e = 0; e < 4; ++e) {
                const unsigned lo = *(const unsigned short*)(lds + (cg * 8 + 2 * e) * 528 + tok * 2);
                const unsigned hi = *(const unsigned short*)(lds + (cg * 8 + 2 * e + 1) * 528 + tok * 2);
                w[e] = lo | (hi << 16);
            }
            *(u32x4*)(HY + (size_t)(tok0 + tok) * HYD + c0 + cg * 8) = u32x4{w[0], w[1], w[2], w[3]};
        }
    }
}

DI void phase_e(const Params& p, unsigned char* lds) {
    constexpr int TILES = 4 * (BT / 128);
    for (int it = blockIdx.x; it < TILES; it += gridDim.x) {
        const int tid = get_tid(), lane = tid & 63, wave = tid >> 6, wp = wave >> 2, wq = wave & 3;
        const int tn = it & 3, tm = it >> 2;
        const int n0 = tn * 256, tok0 = tm * 128;
        f32x4 acc1[4][2], acc2[4][2];
#pragma unroll
        for (int i = 0; i < 4; ++i)
#pragma unroll
            for (int j = 0; j < 2; ++j) { acc1[i][j] = f32x4{0.f, 0.f, 0.f, 0.f}; acc2[i][j] = f32x4{0.f, 0.f, 0.f, 0.f}; }
        if (SHADOW == 5) { gemm_shadow1<2>(RowLoader{(const bf16_t*)(p.ws + WS_WTAO) + (size_t)n0 * QD, QD}, RowLoader{(const bf16_t*)(p.ws + WS_ATT) + (size_t)tok0 * QD, QD}, QD / 64, lds);
                           gemm_shadow1<2>(RowLoader{(const bf16_t*)(p.ws + WS_WTHO) + (size_t)n0 * HYD, HYD}, RowLoader{(const bf16_t*)(p.ws + WS_HY) + (size_t)tok0 * HYD, HYD}, HYD / 64, lds); }
        gemm_mainloop<2>(acc1, RowLoader{(const bf16_t*)(p.ws + WS_WTAO) + (size_t)n0 * QD, QD}, RowLoader{(const bf16_t*)(p.ws + WS_ATT) + (size_t)tok0 * QD, QD}, QD / 64, lds);
        gemm_mainloop<2>(acc2, RowLoader{(const bf16_t*)(p.ws + WS_WTHO) + (size_t)n0 * HYD, HYD}, RowLoader{(const bf16_t*)(p.ws + WS_HY) + (size_t)tok0 * HYD, HYD}, HYD / 64, lds);
        const bf16_t* G = (const bf16_t*)(p.ws + WS_G);
        bf16_t* M = (bf16_t*)(p.ws + WS_H);
        constexpr int ES = 528, EG2 = 128 * ES;
        __syncthreads();
        {
            u32x4 ga[4], gh[4];
#pragma unroll
            for (int q = 0; q < 4; ++q) {
                const int idx = tid + q * NT, row = idx >> 5, ch = idx & 31;
                const bf16_t* gp = G + (size_t)(tok0 + row) * GC + n0 + ch * 8;
                ga[q] = *(const u32x4*)gp; gh[q] = *(const u32x4*)(gp + 1024);
            }
#pragma unroll
            for (int q = 0; q < 4; ++q) {
                const int idx = tid + q * NT, row = idx >> 5, ch = idx & 31;
                *(u32x4*)(lds + row * ES + ch * 16) = ga[q]; *(u32x4*)(lds + EG2 + row * ES + ch * 16) = gh[q];
            }
        }
        __syncthreads();
        const int l15 = lane & 15, lk = lane >> 4;
        u32x2 mo[4][2];
#pragma unroll
        for (int i = 0; i < 4; ++i)
#pragma unroll
            for (int j = 0; j < 2; ++j) {
                const int off = (wq * 32 + j * 16 + l15) * ES + (wp * 64 + i * 16 + lk * 4) * 2;
                const u32x2 ga = *(const u32x2*)(lds + off), gh = *(const u32x2*)(lds + EG2 + off);
                const float m0 = bflo(ga[0]) * acc1[i][j][0] + bflo(gh[0]) * acc2[i][j][0];
                const float m1 = bfhi(ga[0]) * acc1[i][j][1] + bfhi(gh[0]) * acc2[i][j][1];
                const float m2 = bflo(ga[1]) * acc1[i][j][2] + bflo(gh[1]) * acc2[i][j][2];
                const float m3 = bfhi(ga[1]) * acc1[i][j][3] + bfhi(gh[1]) * acc2[i][j][3];
                mo[i][j] = u32x2{pk2(m0, m1), pk2(m2, m3)};
            }
        __syncthreads();
#pragma unroll
        for (int i = 0; i < 4; ++i)
#pragma unroll
            for (int j = 0; j < 2; ++j) *(u32x2*)(lds + (wq * 32 + j * 16 + l15) * ES + (wp * 64 + i * 16 + lk * 4) * 2) = mo[i][j];
        __syncthreads();
#pragma unroll
        for (int q = 0; q < 4; ++q) {
            const int idx = tid + q * NT, row = idx >> 5, ch = idx & 31;
            *(u32x4*)(M + (size_t)(tok0 + row) * DM + n0 + ch * 8) = *(const u32x4*)(lds + row * ES + ch * 16);
        }
    }
}

DI void phase_f(const Params& p, unsigned char* lds) {
    constexpr int TILES = 4 * (BT / 256);
    const float* mod = (const float*)(p.ws + WS_MOD);
    for (int it = blockIdx.x; it < TILES; it += gridDim.x) {
        const int tid = get_tid(), lane = tid & 63, wave = tid >> 6, wp = wave >> 2, wq = wave & 3;
        const int tn = it & 3, tm = it >> 2;
        const int n0 = tn * 256, tok0 = tm * 256, b = tok0 >> 12;
        f32x4 acc[4][4];
#pragma unroll
        for (int i = 0; i < 4; ++i)
#pragma unroll
            for (int j = 0; j < 4; ++j) acc[i][j] = f32x4{0.f, 0.f, 0.f, 0.f};
        gemm_mainloop<4>(acc, RowLoader{(const bf16_t*)(p.ws + WS_WTO) + (size_t)n0 * DM, DM}, RowLoader{(const bf16_t*)(p.ws + WS_H) + (size_t)tok0 * DM, DM}, DM / 64, lds);
        const int l15 = lane & 15, lk = lane >> 4;
#pragma unroll
        for (int i = 0; i < 4; ++i) {
            const int n = n0 + wp * 64 + i * 16 + lk * 4;
            const f32x4 g1 = *(const f32x4*)(mod + b * 6144 + 2048 + n);
#pragma unroll
            for (int j = 0; j < 4; ++j) {
                const int tok = tok0 + wq * 64 + j * 16 + l15;
                const f32x4 xv = *(const f32x4*)(p.in[I_X] + (size_t)tok * DM + n);
                *(f32x4*)(p.out + (size_t)tok * DM + n) = f32x4{xv[0] + g1[0] * acc[i][j][0], xv[1] + g1[1] * acc[i][j][1], xv[2] + g1[2] * acc[i][j][2], xv[3] + g1[3] * acc[i][j][3]};
            }
        }
    }
}

DI void phase_g(const Params& p) {
    const float* mod = (const float*)(p.ws + WS_MOD);
    for (int it = blockIdx.x; it < BT / 16; it += gridDim.x) {
        const int row = it * 16 + (get_tid() >> 6), b = row >> 12;
        norm_mod_row(p.out + (size_t)row * DM, p.in[I_NFFN], mod + b * 6144 + 3072, mod + b * 6144 + 4096, (bf16_t*)(p.ws + WS_H) + (size_t)row * DM);
    }
}

DI void phase_h(const Params& p, unsigned char* lds) {
    constexpr int TILES = 8 * (BT / 256);
    for (int it = blockIdx.x; it < TILES; it += gridDim.x) {
        const int tid = get_tid(), lane = tid & 63, wave = tid >> 6, wp = wave >> 2, wq = wave & 3;
        const int tn = it & 7, tm = it >> 3;
        const int n0 = tn * 256, tok0 = tm * 256;
        f32x4 acc[4][4];
#pragma unroll
        for (int i = 0; i < 4; ++i)
#pragma unroll
            for (int j = 0; j < 4; ++j) acc[i][j] = f32x4{0.f, 0.f, 0.f, 0.f};
        gemm_mainloop<4>(acc, RowLoader{(const bf16_t*)(p.ws + WS_WTQ) + (size_t)n0 * DM, DM}, RowLoader{(const bf16_t*)(p.ws + WS_H) + (size_t)tok0 * DM, DM}, DM / 64, lds);
        bf16_t* QP = (bf16_t*)(p.ws + WS_G);
        const int l15 = lane & 15, lk = lane >> 4;
#pragma unroll
        for (int i = 0; i < 4; ++i)
#pragma unroll
            for (int j = 0; j < 4; ++j) {
                const int n = n0 + wp * 64 + i * 16 + lk * 4;
                const int tok = tok0 + wq * 64 + j * 16 + l15;
                *(u32x2*)(QP + (size_t)tok * 2048 + n) = u32x2{pk2(acc[i][j][0], acc[i][j][1]), pk2(acc[i][j][2], acc[i][j][3])};
            }
    }
}

DI void ins16(float (&L)[16], float v) {
#pragma unroll
    for (int i = 0; i < 16; ++i) { const float hi = fmaxf(L[i], v); v = fminf(L[i], v); L[i] = hi; }
}
DI void cex_desc(float& a, float& b) { const float hi = fmaxf(a, b), lo = fminf(a, b); a = hi; b = lo; }
DI void bitonic_merge16_desc(float (&v)[16]) {
#pragma unroll
    for (int j = 8; j > 0; j >>= 1)
#pragma unroll
        for (int i = 0; i < 16; ++i) if ((i ^ j) > i) cex_desc(v[i], v[i ^ j]);
}
DI void sort16_desc(float (&v)[16]) {
#pragma unroll
    for (int k = 2; k <= 16; k <<= 1)
#pragma unroll
        for (int j = k >> 1; j > 0; j >>= 1)
#pragma unroll
            for (int i = 0; i < 16; ++i) {
                const int l = i ^ j;
                if (l > i) { if ((i & k) == 0) cex_desc(v[i], v[l]); else cex_desc(v[l], v[i]); }
            }
}
DI void top16_merge(float (&a)[16], const float (&b)[16]) {
#pragma unroll
    for (int i = 0; i < 16; ++i) a[i] = fmaxf(a[i], b[15 - i]);
    bitonic_merge16_desc(a);
}
DI float pack_idx(float v, unsigned idx, unsigned mask) { return __uint_as_float((__float_as_uint(v) & ~mask) | idx); }
constexpr int PI_LIST = 0;
DI void peer_select_item(const Params& p, int item, unsigned char* lds) {
    const int tok0 = item * 128;
    __syncthreads();
    {
#pragma unroll 1
        for (int sb = 0; sb < 4; ++sb) {
            const int tid = get_tid(), lane = tid & 63, hp = tid >> 6;
            const int r = lane & 31, hf = lane >> 5;
            const bf16_t* keys = (const bf16_t*)(p.ws + WS_KEYS) + (size_t)((hp & 1) * 8 + (hp >> 1)) * 128 * 128 + 8 * hf;
            const bf16_t* qp = (const bf16_t*)(p.ws + WS_G) + (size_t)(tok0 + r) * 2048 + hp * 128 + 8 * hf;
            bf16x8 bq[8];
#pragma unroll
            for (int ks = 0; ks < 8; ++ks) bq[ks] = *(const bf16x8*)(qp + (size_t)sb * 32 * 2048 + 16 * ks);
            f32x16 acc[4];
#pragma unroll
            for (int m = 0; m < 4; ++m)
#pragma unroll
                for (int i = 0; i < 16; ++i) acc[m][i] = 0.f;
#pragma unroll
            for (int ks = 0; ks < 8; ++ks) {
#pragma unroll
                for (int m = 0; m < 4; ++m) {
                    const bf16x8 ak = *(const bf16x8*)(keys + (size_t)(m * 32 + r) * 128 + 16 * ks);
                    acc[m] = MFMA32(ak, bq[ks], acc[m]);
                }
            }
            float V[4][16];
#define PK_SORT(m) do { _Pragma("unroll") for (int i = 0; i < 16; ++i) V[m][i] = pack_idx(acc[m][i], (unsigned)((m) * 32 + (i & 3) + 8 * (i >> 2) + 4 * hf), 127u); sort16_desc(V[m]); } while (0)
            PK_SORT(0); PK_SORT(1); top16_merge(V[0], V[1]); __builtin_amdgcn_sched_barrier(0);
            PK_SORT(2); PK_SORT(3); top16_merge(V[2], V[3]); __builtin_amdgcn_sched_barrier(0);
            top16_merge(V[0], V[2]);
#undef PK_SORT
            float (&L)[16] = V[0];
            const int t3 = get_tid(), hf3 = (t3 >> 5) & 1, r3 = t3 & 31, hp3 = t3 >> 6;
            float P[16];
#pragma unroll
            for (int i = 0; i < 16; ++i) {
                auto sw = __builtin_amdgcn_permlane32_swap(__float_as_uint(L[i]), __float_as_uint(L[i]), false, false);
                P[i] = hf3 ? __uint_as_float(sw[0]) : __uint_as_float(sw[1]);
            }
            top16_merge(L, P);
            if (hf3 == 0) {
                float* dst = (float*)(lds + PI_LIST) + ((sb * 32 + r3) * 16 + hp3) * 16;
#pragma unroll
                for (int i = 0; i < 16; i += 4) *(f32x4*)(dst + i) = f32x4{L[i], L[i + 1], L[i + 2], L[i + 3]};
            }
        }
    }
    __syncthreads();
    {
        const int tid = get_tid();
        {
            const int tok = tid >> 3, h = tid & 7;
            const float* l1 = (const float*)(lds + PI_LIST) + (tok * 16 + 2 * h) * 16;
            const float* l2 = l1 + 16;
            float v1[16], v2[16];
#pragma unroll
            for (int i = 0; i < 16; i += 4) {
                const f32x4 a = *(const f32x4*)(l1 + i), b = *(const f32x4*)(l2 + i);
                v1[i] = a[0]; v1[i + 1] = a[1]; v1[i + 2] = a[2]; v1[i + 3] = a[3];
                v2[i] = b[0]; v2[i + 1] = b[1]; v2[i + 2] = b[2]; v2[i + 3] = b[3];
            }
            float B[16];
#pragma unroll
            for (int i = 0; i < 16; ++i) B[i] = -3.0e38f;
#pragma unroll
            for (int i = 0; i < 16; ++i)
#pragma unroll
                for (int j = 0; j < 16; ++j)
                    if ((i + 1) * (j + 1) <= 16) ins16(B, pack_idx(v1[i] + v2[j], (unsigned)(i * 16 + j), 255u));
            float e[16], sum = 0.f;
#pragma unroll
            for (int k = 0; k < 16; ++k) { e[k] = __expf(B[k] - B[0]); sum += e[k]; }
            const float inv = 1.f / sum;
            int* ex = (int*)(p.ws + WS_EXPI) + (size_t)(tok0 + tok) * 128 + h * 16;
            float* gt = (float*)(p.ws + WS_GATE) + ((size_t)(tok0 + tok) * 128 + h * 16) * 2;
            const float* usc = (const float*)(p.ws + WS_USC);
            int ev[16]; float gv[16], sv[16];
#pragma unroll
            for (int k = 0; k < 16; ++k) {
                const unsigned ij = __float_as_uint(B[k]) & 255u;
                const unsigned i1 = __float_as_uint(l1[ij >> 4]) & 127u, i2 = __float_as_uint(l2[ij & 15u]) & 127u;
                ev[k] = (int)(i1 * 128u + i2);
                gv[k] = e[k] * inv;
                sv[k] = usc[ev[k]];
            }
#pragma unroll
            for (int k = 0; k < 16; k += 4) *(u32x4*)(ex + k) = u32x4{(unsigned)ev[k], (unsigned)ev[k + 1], (unsigned)ev[k + 2], (unsigned)ev[k + 3]};
#pragma unroll
            for (int k = 0; k < 16; k += 2) *(f32x4*)(gt + 2 * k) = f32x4{gv[k], sv[k], gv[k + 1], sv[k + 1]};
        }
    }
}
DI void phase_i1(const Params& p, unsigned char* lds) {
    for (int it = blockIdx.x; it < BT / 128; it += gridDim.x) peer_select_item(p, it, lds);
}

DI float dot16_fp8(const u32x4& w, const float (&x)[16]) {
    float d = 0.f;
#pragma unroll
    for (int i = 0; i < 4; ++i) {
        const auto lo = __builtin_amdgcn_cvt_pk_f32_fp8((int)w[i], false);
        const auto hi = __builtin_amdgcn_cvt_pk_f32_fp8((int)w[i], true);
        d += lo[0] * x[4 * i] + lo[1] * x[4 * i + 1] + hi[0] * x[4 * i + 2] + hi[1] * x[4 * i + 3];
    }
    return d;
}
template<int NPART, class F> DI void run_partitioned(const Params& p, unsigned char* lds, int qbase, int nitems, F&& body) {
    unsigned* ctl = (unsigned*)(p.ws + WS_CTL);
    volatile LAS unsigned* slot = (volatile LAS unsigned*)(LAS unsigned char*)(lds + LDS_ST_OFF + 8);
    const int x0 = (int)(xb_xcc_id() & 7u);
#pragma unroll 1
    for (int pp = 0; pp < NPART; ++pp) {
        const int part = (NPART == 8) ? ((x0 + pp) & 7) : ((((x0 + (pp >> 1)) & 7)) + 8 * (pp & 1));
        for (;;) {
            __syncthreads();
            if (get_tid() == 0) slot[0] = atomicAdd(ctl + qbase + 64 * part, 1u);
            __syncthreads();
            const int it = __builtin_amdgcn_readfirstlane((int)slot[0]);
            if (it >= nitems) break;
            body(part, it);
        }
    }
}
constexpr int CTL_QUEUE_I2 = 8320, CTL_QUEUE_I3 = 9408;
constexpr int UW_BYTES = 5120, UW_GT = 2048, UW_LIST = 4096;
DI float wave_max(float v) {
    v = fmaxf(v, dppf<0xB1>(v)); v = fmaxf(v, dppf<0x4E>(v)); v = fmaxf(v, dppf<0x141>(v)); v = fmaxf(v, dppf<0x140>(v));
    { auto r = __builtin_amdgcn_permlane16_swap(__float_as_uint(v), __float_as_uint(v), false, false); v = fmaxf(__uint_as_float(r[0]), __uint_as_float(r[1])); }
    { auto r = __builtin_amdgcn_permlane32_swap(__float_as_uint(v), __float_as_uint(v), false, false); v = fmaxf(__uint_as_float(r[0]), __uint_as_float(r[1])); }
    return v;
}
DI void peer_u_chunk(const Params& p, int part, int chunk, unsigned char* lds) {
    const int tid = get_tid(), lane = tid & 63, wave = __builtin_amdgcn_readfirstlane(tid >> 6);
    unsigned char* wl = lds + wave * UW_BYTES;
    unsigned* lst = (unsigned*)(wl + UW_LIST);
    const f32x2* gts = (const f32x2*)(wl + UW_GT);
    const unsigned char* UT8 = p.ws + WS_UT + lane * 16;
    const int tokw = chunk * 512 + wave * 2;
    int pe[4]; u32x4 ph[4]; f32x2 pg[4];
#define U_PREFETCH(tok) do { \
        const int* ex_ = (const int*)(p.ws + WS_EXPI) + (size_t)(tok) * 128 + lane; \
        const f32x2* gt_ = (const f32x2*)(p.ws + WS_GATE) + (size_t)(tok) * 128 + lane; \
        const bf16_t* hr_ = (const bf16_t*)(p.ws + WS_H) + (size_t)(tok) * DM + lane * 16; \
        pe[0] = ex_[0]; pe[1] = ex_[64]; pe[2] = ex_[128]; pe[3] = ex_[192]; \
        pg[0] = gt_[0]; pg[1] = gt_[64]; pg[2] = gt_[128]; pg[3] = gt_[192]; \
        ph[0] = *(const u32x4*)hr_; ph[1] = *(const u32x4*)(hr_ + 8); ph[2] = *(const u32x4*)(hr_ + DM); ph[3] = *(const u32x4*)(hr_ + DM + 8); } while (0)
    U_PREFETCH(tokw);
#pragma unroll 1
    for (int sub = 0; sub < 16; ++sub) {
        const int tok0 = tokw + sub * 32;
        float sx[2];
#pragma unroll
        for (int t = 0; t < 2; ++t) {
            float f[16];
#pragma unroll
            for (int q = 0; q < 8; ++q) { const unsigned w = ph[2 * t + (q >> 2)][q & 3]; f[2 * q] = bflo(w); f[2 * q + 1] = bfhi(w); }
            float mx = 0.f;
#pragma unroll
            for (int i = 0; i < 16; ++i) mx = fmaxf(mx, fabsf(f[i]));
            mx = fmaxf(wave_max(mx), 1e-30f);
            sx[t] = mx * (1.f / 127.f);
            const float qs = 127.f / mx;
            unsigned w8[4];
#pragma unroll
            for (int q = 0; q < 4; ++q) {
                const int q0 = __float2int_rn(f[4 * q] * qs), q1 = __float2int_rn(f[4 * q + 1] * qs), q2 = __float2int_rn(f[4 * q + 2] * qs), q3 = __float2int_rn(f[4 * q + 3] * qs);
                w8[q] = (q0 & 255) | ((q1 & 255) << 8) | ((q2 & 255) << 16) | ((unsigned)q3 << 24);
            }
            *(u32x4*)(wl + t * 1024 + lane * 16) = u32x4{w8[0], w8[1], w8[2], w8[3]};
        }
        int cnt = 0;
#pragma unroll
        for (int g = 0; g < 4; ++g) {
            ((f32x2*)(wl + UW_GT))[g * 64 + lane] = pg[g];
            const bool m = (pe[g] >> 11) == part;
            const unsigned long long bm = __ballot(m);
            const int pos = cnt + __builtin_amdgcn_mbcnt_hi((unsigned)(bm >> 32), __builtin_amdgcn_mbcnt_lo((unsigned)bm, 0u));
            if (m) lst[pos] = ((unsigned)(g * 64 + lane) << 16) | (unsigned)pe[g];
            cnt += __popcll(bm);
        }
        if (sub + 1 < 16) U_PREFETCH(tok0 + 32);
#define U_LOAD(ROW, EN, base) do { _Pragma("unroll") for (int q = 0; q < 8; ++q) { \
            EN[q] = __builtin_amdgcn_readfirstlane(lst[min((base) + q, cnt - 1)]); \
            ROW[q] = *(const u32x4*)(UT8 + (size_t)(EN[q] & 0x3fffu) * 1024); } } while (0)
#define U_COMPUTE(ROW, EN, base) do { \
            int d[8]; \
            _Pragma("unroll") for (int q = 0; q < 8; ++q) { \
                const u32x4 xv = *(const u32x4*)(wl + (EN[q] >> 23) * 1024 + lane * 16); \
                int ai = 0; \
                _Pragma("unroll") for (int i = 0; i < 4; ++i) ai = __builtin_amdgcn_sdot4((int)ROW[q][i], (int)xv[i], ai, false); \
                d[q] = ai; \
            } \
              \
            int r4[4], r2[2]; \
            _Pragma("unroll") for (int i = 0; i < 4; ++i) { auto sw = __builtin_amdgcn_permlane32_swap((unsigned)d[i], (unsigned)d[i + 4], false, false); r4[i] = (int)(sw[0] + sw[1]); } \
            _Pragma("unroll") for (int i = 0; i < 2; ++i) { auto sw = __builtin_amdgcn_permlane16_swap((unsigned)r4[i], (unsigned)r4[i + 2], false, false); r2[i] = (int)(sw[0] + sw[1]); } \
            const bool b3 = (lane & 8) != 0; \
            int ai = (b3 ? r2[1] : r2[0]) + dppi<0x128>(b3 ? r2[0] : r2[1]); \
            ai += dppi<0xB1>(ai); ai += dppi<0x4E>(ai); ai += dppi<0x141>(ai); \
            const int g = lane >> 3; \
            const unsigned ent = lst[min((base) + g, cnt - 1)]; \
            const int idx = (int)(ent >> 16); \
            const f32x2 gs = gts[idx]; \
            const float a = (float)ai * (gs[1] * ((idx >> 7) ? sx[1] : sx[0])); \
            const float y = 0.7978845608028654f * (a + 0.044715f * a * a * a); \
            const float th = 1.f - 2.f / (__expf(2.f * y) + 1.f); \
            const float w = 0.5f * a * (1.f + th) * gs[0]; \
            if ((lane & 7) == 0 && (base) + g < cnt) ((u32x2*)(p.ws + WS_PAIRS))[(size_t)tok0 * 128 + idx] = u32x2{ent & 0x3fffu, __float_as_uint(w)}; \
        } while (0)
        if (cnt > 0) {
            u32x4 rowA[8], rowB[8]; unsigned enA[8], enB[8];
            U_LOAD(rowA, enA, 0);
#pragma unroll 1
            for (int base = 0; base < cnt; base += 16) {
                if (base + 8 < cnt) U_LOAD(rowB, enB, base + 8);
                U_COMPUTE(rowA, enA, base);
                if (base + 8 < cnt) {
                    if (base + 16 < cnt) U_LOAD(rowA, enA, base + 16);
                    U_COMPUTE(rowB, enB, base + 8);
                }
            }
        }
#undef U_LOAD
#undef U_COMPUTE
    }
#undef U_PREFETCH
}
DI void phase_i2(const Params& p, unsigned char* lds) {
    run_partitioned<8>(p, lds, CTL_QUEUE_I2, BT / 512, [&](int part, int it) { peer_u_chunk(p, part, it, lds); });
}
DI void peer_v_chunk(const Params& p, int part, int chunk, unsigned char* lds) {
    const int tid = get_tid(), lane = tid & 63, wave = __builtin_amdgcn_readfirstlane(tid >> 6);
    unsigned char* wl = lds + wave * 1024;
    const int es = lane >> 3, ch = lane & 7;
    const unsigned char* VT8 = p.ws + WS_VTAB + (size_t)part * 16384 * 128 + ch * 16;
    const float* mod = (const float*)(p.ws + WS_MOD);
    const int col = part * 128 + 16 * ch + 2 * es;
    const int tokw = chunk * 512 + wave;
    u32x4 pp = *((const u32x4*)(p.ws + WS_PAIRS + (size_t)tokw * 1024) + lane);
#pragma unroll 1
    for (int step = 0; step < 32; ++step) {
        const int tok = tokw + step * 16, b = tok >> 12;
        *(u32x4*)(wl + lane * 16) = pp;
        if (step + 1 < 32) pp = *((const u32x4*)(p.ws + WS_PAIRS + (size_t)(tok + 16) * 1024) + lane);
        float* xo = p.out + (size_t)tok * DM + col;
        const f32x2 x1 = *(const f32x2*)xo;
        const f32x2 g2 = *(const f32x2*)(mod + b * 6144 + 5120 + col);
        f32x2 acc[8];
#pragma unroll
        for (int i = 0; i < 8; ++i) acc[i] = f32x2{0.f, 0.f};
        const u32x2* pr = (const u32x2*)wl + es;
#pragma unroll 1
        for (int ih = 0; ih < 2; ++ih) {
            u32x2 pe[8]; u32x4 row[8];
#pragma unroll
            for (int q = 0; q < 8; ++q) { pe[q] = pr[(ih * 8 + q) * 8]; row[q] = *(const u32x4*)(VT8 + (size_t)pe[q][0] * 128); }
#pragma unroll
            for (int q = 0; q < 8; ++q) {
                const float w = __uint_as_float(pe[q][1]);
                const f32x2 w2 = f32x2{w, w};
#pragma unroll
                for (int i = 0; i < 4; ++i) {
                    const f32x2 lo = __builtin_amdgcn_cvt_pk_f32_fp8((int)row[q][i], false);
                    const f32x2 hi = __builtin_amdgcn_cvt_pk_f32_fp8((int)row[q][i], true);
                    acc[2 * i] += w2 * lo; acc[2 * i + 1] += w2 * hi;
                }
            }
        }
        float a16[16];
#pragma unroll
        for (int i = 0; i < 8; ++i) { a16[2 * i] = acc[i][0]; a16[2 * i + 1] = acc[i][1]; }
        float r8[8], r4[4], r2[2];
#pragma unroll
        for (int i = 0; i < 8; ++i) { auto sw = __builtin_amdgcn_permlane32_swap(__float_as_uint(a16[i]), __float_as_uint(a16[i + 8]), false, false); r8[i] = __uint_as_float(sw[0]) + __uint_as_float(sw[1]); }
#pragma unroll
        for (int i = 0; i < 4; ++i) { auto sw = __builtin_amdgcn_permlane16_swap(__float_as_uint(r8[i]), __float_as_uint(r8[i + 4]), false, false); r4[i] = __uint_as_float(sw[0]) + __uint_as_float(sw[1]); }
        const bool b3 = (lane & 8) != 0;
#pragma unroll
        for (int i = 0; i < 2; ++i) { const float keep = b3 ? r4[i + 2] : r4[i], send = b3 ? r4[i] : r4[i + 2]; r2[i] = keep + dppf<0x128>(send); }
        const float xa = x1[0] + g2[0] * r2[0] * (1.f / VSCALE), xb = x1[1] + g2[1] * r2[1] * (1.f / VSCALE);
        *(f32x2*)xo = f32x2{xa, xb};
        const float ss = wave_sum(xa * xa + xb * xb);
        if (lane == 0) ((float*)(p.ws + WS_SSQ))[(size_t)tok * 8 + part] = ss;
    }
}
DI void phase_i3(const Params& p, unsigned char* lds) {
    run_partitioned<8>(p, lds, CTL_QUEUE_I3, BT / 512, [&](int part, int it) { peer_v_chunk(p, part, it, lds); });
}
DI void phase_i4(const Params& p) {
    const bool bad = xb_ld((unsigned*)(p.ws + WS_CTL) + CTL_BADTID) != 0u || xb_ld((unsigned*)(p.ws + WS_CTL) + XB_TMO) != 0u;
    for (int it = blockIdx.x; it < BT / 16; it += gridDim.x) {
        const int tid = get_tid(), lane = tid & 63, row = it * 16 + (tid >> 6);
        const float* sq = (const float*)(p.ws + WS_SSQ) + (size_t)row * 8;
        const f32x4 s0 = *(const f32x4*)sq, s1 = *(const f32x4*)(sq + 4);
        const float ss = s0[0] + s0[1] + s0[2] + s0[3] + s1[0] + s1[1] + s1[2] + s1[3];
        float rs = rsqrtf(ss * (1.f / DM) + EPS);
        if (bad) rs = __builtin_nanf("");
        float* o = p.out + (size_t)row * DM;
#pragma unroll
        for (int j = 0; j < 4; ++j) {
            const int c = j * 256 + lane * 4;
            const f32x4 v = *(const f32x4*)(o + c), g = *(const f32x4*)(p.in[I_FNG] + c);
            *(f32x4*)(o + c) = f32x4{v[0] * rs * g[0], v[1] * rs * g[1], v[2] * rs * g[2], v[3] * rs * g[3]};
        }
    }
}

__global__ void __launch_bounds__(NT) mega(Params p) {
    unsigned char* lds = g_lds;
    volatile LAS unsigned* st = (volatile LAS unsigned*)(LAS unsigned char*)(lds + LDS_ST_OFF);
    {
        const unsigned hw = __builtin_amdgcn_s_getreg((5 << 11) | 4);
        if ((threadIdx.x & 63) == 0) g_lds[LDS_WTAB_OFF + hw] = (unsigned char)(threadIdx.x >> 6);
        if (threadIdx.x < 2) st[threadIdx.x] = 0u;
        __syncthreads();
        if (get_tid() != (int)threadIdx.x) ((unsigned*)(p.ws + WS_CTL))[CTL_BADTID] = 1u;
    }
    XcdBarrier bar = xcd_barrier_post((unsigned*)(p.ws + WS_CTL), st);
    float* sm = (float*)lds;

#define STAMP(k, which) do { if (PROBE_PHASE == (k) && blockIdx.x == 0 && get_tid() == 0) ((volatile unsigned long long*)(lds + LDS_PROBE_OFF))[which] = __builtin_amdgcn_s_memrealtime(); } while (0)
    STAMP(21, 0); STAMP(30, 0); STAMP(31, 0);
    STAMP(0, 0); phase_a(p, sm);   xcd_barrier(bar); STAMP(0, 1);
    STAMP(1, 0); phase_b(p, sm);   xcd_barrier(bar); STAMP(1, 1);
    if (PROBE_PHASE == 20) { STAMP(20, 0); xcd_barrier(bar); xcd_barrier(bar); xcd_barrier(bar); xcd_barrier(bar); STAMP(20, 1); }
    STAMP(2, 0); phase_c(p, lds);  xcd_barrier(bar); STAMP(2, 1);
    STAMP(3, 0); phase_d<true>(p, lds);  xcd_barrier(bar); STAMP(3, 1);
    STAMP(13, 0); phase_d<false>(p, lds); xcd_barrier(bar); STAMP(13, 1);
    STAMP(4, 0); phase_d2(p, lds); xcd_barrier(bar); STAMP(4, 1);
    STAMP(5, 0); phase_e(p, lds);  xcd_barrier(bar); STAMP(5, 1);
    STAMP(6, 0); phase_f(p, lds);  xcd_barrier(bar); STAMP(6, 1);
    STAMP(7, 0); phase_g(p);       xcd_barrier(bar); STAMP(7, 1);
    STAMP(8, 0); phase_h(p, lds);  xcd_barrier(bar); STAMP(8, 1);
    STAMP(9, 0); phase_i1(p, lds); xcd_barrier(bar); STAMP(9, 1);
    STAMP(10, 0); phase_i2(p, lds); xcd_barrier(bar); STAMP(10, 1);
    STAMP(11, 0); phase_i3(p, lds); xcd_barrier(bar); STAMP(11, 1);
    STAMP(12, 0); phase_i4(p);
    if (PROBE_PHASE >= 0) {
        xcd_barrier(bar); STAMP(12, 1); STAMP(21, 1);
        if (blockIdx.x == 0 && get_tid() == 0) {
            volatile unsigned long long* ts = (volatile unsigned long long*)(lds + LDS_PROBE_OFF);
            p.out[0] += (float)(ts[1] - ts[0]) * (0.01f / PROBE_SCALE);
        }
    }
}

extern "C" void kernel_launch(void* const* d_in, const int* in_sizes, int n_in, void* d_out, int out_size, void* d_ws, size_t ws_size, hipStream_t stream) {
    static int grid = 0;
    if (grid == 0) {
        int dev = 0, cus = 0;
        if (hipGetDevice(&dev) != hipSuccess || hipDeviceGetAttribute(&cus, hipDeviceAttributeMultiprocessorCount, dev) != hipSuccess) { fprintf(stderr, "kernel_launch: device query failed\n"); grid = -1; return; }
        if (n_in != N_IN || ws_size < WS_END) { fprintf(stderr, "kernel_launch: unexpected n_in %d or ws_size %zu (< %zu)\n", n_in, ws_size, (size_t)WS_END); grid = -1; return; }
        grid = cus;
    }
    if (grid < 0) return;
    (void)hipMemsetAsync((char*)d_ws + WS_CTL, 0, 64 * 1024, stream);
    Params p{};
    for (int i = 0; i < N_IN; ++i) p.in[i] = (const float*)d_in[i];
    p.out = (float*)d_out; p.ws = (unsigned char*)d_ws;
    hipLaunchKernelGGL(mega, dim3(grid), dim3(NT), 0, stream, p);
}
```

```cpp
#include <hip/hip_runtime.h>
#include <stdint.h>
#include <cstdio>

#define DI __device__ __forceinline__
#define LAS __attribute__((address_space(3)))
typedef unsigned short bf16_t;
typedef short bf16x8 __attribute__((ext_vector_type(8)));
typedef short s16x4 __attribute__((ext_vector_type(4)));
typedef float f32x4 __attribute__((ext_vector_type(4)));
typedef float f32x2 __attribute__((ext_vector_type(2)));
typedef float f32x16 __attribute__((ext_vector_type(16)));
typedef unsigned u32x4 __attribute__((ext_vector_type(4)));
typedef unsigned u32x2 __attribute__((ext_vector_type(2)));

#ifndef PROBE_PHASE
#define PROBE_PHASE (-1)
#endif
#ifndef PROBE_SCALE
#define PROBE_SCALE 100.f
#endif
constexpr int BATCH = 8, SEQ = 4096, DM = 1024, BT = BATCH * SEQ;
constexpr int CTX = 256, TK = SEQ + CTX;
constexpr int NH = 8, NKV = 2, HD = 64;
constexpr int QD = 512, KVD = 128, HYD = 512, HYC = 1536, GC = 2048, INC = 4352;
constexpr int PH = 8, PNK = 128, PDK = 256, PTOP = 16;
constexpr float EPS = 1e-6f;
constexpr int NT = 1024;

enum { I_X = 0, I_C, I_CTX, I_CCTX, I_ADAW, I_ADAB, I_NMIX, I_NFFN, I_WIN, I_QNG, I_KNG, I_HCW, I_HCB,
       I_HW1, I_HB1, I_HW2, I_HB2, I_HW3, I_HB3, I_HW4, I_HFREQ, I_HSKIP, I_WAO, I_WHO, I_WO, I_PWQ, I_PK1, I_PK2, I_PU, I_PV, I_FNG, N_IN };

constexpr size_t MB = 1024 * 1024;
constexpr size_t WS_CTL   = 0;
constexpr size_t WS_MOD   = 64 * 1024;
constexpr size_t WS_ROPE  = WS_MOD + 9 * 6144 * 4;
static_assert(WS_ROPE + 16 * 1024 + 8 * 2048 * 4 <= 512 * 1024, "ws");
constexpr size_t WS_PART  = 512 * 1024;
constexpr size_t WS_WTIN  = 3 * MB;
constexpr size_t WS_WTAO  = WS_WTIN + (size_t)INC * DM * 2;
constexpr size_t WS_WTHO  = WS_WTAO + (size_t)DM * QD * 2;
constexpr size_t WS_WTO   = WS_WTHO + (size_t)DM * HYD * 2;
constexpr size_t WS_WTQ   = WS_WTO + (size_t)DM * DM * 2;
constexpr size_t WS_KEYS  = WS_WTQ + (size_t)2048 * DM * 2;
constexpr size_t WS_R     = WS_KEYS + (size_t)2 * 8 * 128 * 128 * 2;
constexpr size_t WS_KB    = WS_R + (size_t)2 * 512 * 8192 * 2;
constexpr size_t WS_VT    = WS_KB + (size_t)BATCH * NKV * TK * HD * 2;
constexpr size_t WS_HC    = WS_VT + (size_t)BATCH * NKV * TK * HD * 2;
constexpr size_t WS_H     = 60 * MB;
constexpr size_t WS_G     = WS_H + 64 * MB;
constexpr size_t WS_ZT    = WS_G + 128 * MB;
constexpr size_t WS_Q     = WS_ZT + 96 * MB;
constexpr size_t WS_ATT   = WS_Q + 32 * MB;
constexpr size_t WS_HYT   = WS_ATT + 32 * MB;
constexpr size_t WS_TAB   = WS_HYT + 32 * MB;
constexpr size_t WS_END   = WS_TAB + 32 * MB;
static_assert(WS_HC + (size_t)2048 * DM * 2 <= WS_H, "ws overlap");
constexpr size_t WS_FRAW  = WS_ATT;
constexpr size_t WS_HY    = WS_Q;
constexpr size_t WS_UT    = WS_TAB;
constexpr size_t WS_VTAB  = WS_TAB + 16 * MB;
constexpr size_t WS_EXPI  = WS_ATT;
constexpr size_t WS_GATE  = WS_Q;
constexpr size_t WS_PAIRS = WS_HYT;
constexpr size_t WS_SSQ   = WS_PART + 1 * MB;
constexpr size_t WS_USC   = WS_PART + 2 * MB;
constexpr size_t WS_Y     = WS_ZT;
constexpr size_t WS_X8    = WS_ZT + 64 * MB;
constexpr size_t WS_SSQ1  = WS_ATT + 16 * MB;
constexpr size_t WS_SX    = WS_PART + 2 * MB + 64 * 1024;
constexpr size_t WS_SHQ   = WS_ROPE + 16 * 1024;
constexpr float VSCALE = 64.f;

constexpr int CTL_BADTID = 8000;
DI unsigned f2bf(float f) { unsigned u = __builtin_bit_cast(unsigned, f); return (u + 0x7fffu + ((u >> 16) & 1u)) >> 16; }
DI unsigned pk2(float lo, float hi) { return f2bf(lo) | (f2bf(hi) << 16); }
DI float bf2f(unsigned short b) { return __builtin_bit_cast(float, (unsigned)b << 16); }
DI float bflo(unsigned u) { return __builtin_bit_cast(float, u << 16); }
DI float bfhi(unsigned u) { return __builtin_bit_cast(float, u & 0xffff0000u); }
DI float red2pi(float x) { const float k = rintf(x * 0.15915494309189535f); float r = fmaf(-k, 6.2831854820251465f, x); return fmaf(-k, -1.7484555e-7f, r); }
DI float fsin(float x) { return __sinf(red2pi(x)); }
DI float fcos(float x) { return __cosf(red2pi(x)); }
constexpr int LDS_BYTES = 160 * 1024;
constexpr int LDS_ST_OFF = LDS_BYTES - 16;
constexpr int LDS_PROBE_OFF = LDS_BYTES - 16 - 32;
constexpr int LDS_WTAB_OFF = LDS_BYTES - 16 - 32 - 64;
constexpr int LDS_USER = LDS_WTAB_OFF;
__shared__ __attribute__((aligned(16))) unsigned char g_lds[LDS_BYTES];
DI s16x4 lds_rd64(const unsigned char* ptr) { return *(const volatile LAS s16x4*)(const LAS unsigned char*)ptr; }
DI int get_tid() {
    const unsigned hw = __builtin_amdgcn_s_getreg((5 << 11) | 4);
    unsigned w = g_lds[LDS_WTAB_OFF + hw];
    w = __builtin_amdgcn_readfirstlane(w);
    int t;
    asm volatile("v_mbcnt_lo_u32_b32 %0, -1, 0\n\tv_mbcnt_hi_u32_b32 %0, -1, %0\n\tv_lshl_or_b32 %0, %1, 6, %0" : "=&v"(t) : "s"(w));
    return t;
}
template<int CTRL> DI float dppf(float v) { return __uint_as_float(__builtin_amdgcn_update_dpp(0u, __float_as_uint(v), CTRL, 0xF, 0xF, true)); }
template<int CTRL> DI int dppi(int v) { return (int)__builtin_amdgcn_update_dpp(0u, (unsigned)v, CTRL, 0xF, 0xF, true); }
DI float sum16(float v) { v += dppf<0xB1>(v); v += dppf<0x4E>(v); v += dppf<0x141>(v); v += dppf<0x140>(v); return v; }
DI float sum_x16(float v) { auto r = __builtin_amdgcn_permlane16_swap(__float_as_uint(v), __float_as_uint(v), false, false); return __uint_as_float(r[0]) + __uint_as_float(r[1]); }
DI float sum_x32(float v) { auto r = __builtin_amdgcn_permlane32_swap(__float_as_uint(v), __float_as_uint(v), false, false); return __uint_as_float(r[0]) + __uint_as_float(r[1]); }
DI float max_x32(float v) { auto r = __builtin_amdgcn_permlane32_swap(__float_as_uint(v), __float_as_uint(v), false, false); return fmaxf(__uint_as_float(r[0]), __uint_as_float(r[1])); }
DI float wave_sum(float v) { return sum_x32(sum_x16(sum16(v))); }
DI float wave_max(float v) {
    v = fmaxf(v, dppf<0xB1>(v)); v = fmaxf(v, dppf<0x4E>(v)); v = fmaxf(v, dppf<0x141>(v)); v = fmaxf(v, dppf<0x140>(v));
    { auto r = __builtin_amdgcn_permlane16_swap(__float_as_uint(v), __float_as_uint(v), false, false); v = fmaxf(__uint_as_float(r[0]), __uint_as_float(r[1])); }
    { auto r = __builtin_amdgcn_permlane32_swap(__float_as_uint(v), __float_as_uint(v), false, false); v = fmaxf(__uint_as_float(r[0]), __uint_as_float(r[1])); }
    return v;
}


#define XB_TMO      128
#define XB_XCNT(j)  (256  + 64 * (j))
#define XB_XSUB(j)  (1280 + 64 * (j))
#define XB_XGEN(j)  (2304 + 64 * (j))
#define XB_TOP      3328
#define XB_TOPGEN   3392
#define XCD_BAR_WORDS 3456
#define XB_SPIN_CAP (1u << 27)
DI unsigned xb_ld(unsigned* p)              { return __hip_atomic_load(p, __ATOMIC_RELAXED, __HIP_MEMORY_SCOPE_AGENT); }
DI unsigned xb_add(unsigned* p, unsigned v) { return __hip_atomic_fetch_add(p, v, __ATOMIC_RELAXED, __HIP_MEMORY_SCOPE_AGENT); }
DI unsigned xb_xcc_id() { return (unsigned)__builtin_amdgcn_s_getreg((3 << 11) | 20) & 0xFu; }
#define XB_SPIN(cond, bar) do { unsigned _sp = 0; while (cond) { __builtin_amdgcn_s_sleep(1); \
    if ((++_sp & 255u) == 0u) { if (xb_ld(&(bar)[XB_TMO])) break; if (_sp > XB_SPIN_CAP) { atomicAdd(&(bar)[XB_TMO], 1u); break; } } } } while (0)
struct XcdBarrier { unsigned* bar; unsigned x; volatile LAS unsigned* st; };
DI XcdBarrier xcd_barrier_post(unsigned* bar, volatile LAS unsigned* st) {
    XcdBarrier b; b.bar = bar; b.x = xb_xcc_id(); b.st = st;
    if (get_tid() == 0) (void)xb_add(&bar[XB_XCNT(b.x)], 1u);
    return b;
}
DI void xcd_barrier_complete(unsigned* bar, unsigned x, unsigned& nloc, unsigned& nx) {
    const unsigned G = gridDim.x * gridDim.y * gridDim.z;
    unsigned sum, cnt, mine, sp = 0u;
    for (;;) {
        sum = 0u; cnt = 0u; mine = 0u;
#pragma unroll
        for (unsigned j = 0; j < 16; ++j) { const unsigned c = xb_ld(&bar[XB_XCNT(j)]); sum += c; cnt += (c > 0u) ? 1u : 0u; mine = (j == x) ? c : mine; }
        if (sum == G) break;
        __builtin_amdgcn_s_sleep(1);
        if ((++sp & 255u) == 0u) { if (xb_ld(&bar[XB_TMO])) break; if (sp > XB_SPIN_CAP) { atomicAdd(&bar[XB_TMO], 1u); break; } }
    }
    nloc = mine > 0u ? mine : 1u; nx = cnt > 0u ? cnt : 1u;
}
DI void xcd_barrier(const XcdBarrier& b) {
    asm volatile("s_waitcnt vmcnt(0)" ::: "memory");
    __syncthreads();
    if (get_tid() == 0) {
        unsigned* bar = b.bar;
        __builtin_amdgcn_s_waitcnt(0);
        unsigned nloc = b.st[0], nx = b.st[1];
        if (nloc == 0u) { xcd_barrier_complete(bar, b.x, nloc, nx); b.st[0] = nloc; b.st[1] = nx; }
        const unsigned old = xb_add(&bar[XB_XSUB(b.x)], 1u);
        const unsigned gen = old / nloc;
        if (old + 1u == (gen + 1u) * nloc) {
            __builtin_amdgcn_fence(__ATOMIC_RELEASE, "agent");
            asm volatile("s_waitcnt vmcnt(0)" ::: "memory");
            const unsigned og = xb_add(&bar[XB_TOP], 1u);
            const unsigned tg = og / nx;
            if (og + 1u == (tg + 1u) * nx) xb_add(&bar[XB_TOPGEN], 1u);
            else XB_SPIN(xb_ld(&bar[XB_TOPGEN]) == tg, bar);
            __builtin_amdgcn_fence(__ATOMIC_ACQUIRE, "agent");
            xb_add(&bar[XB_XGEN(b.x)], 1u);
            asm volatile("s_waitcnt vmcnt(0)" ::: "memory");
        } else {
            XB_SPIN(xb_ld(&bar[XB_XGEN(b.x)]) == gen, bar);
            __builtin_amdgcn_fence(__ATOMIC_ACQUIRE, "agent");
            asm volatile("s_waitcnt vmcnt(0)" ::: "memory");
        }
    }
    __syncthreads();
}

struct Params { const float* in[N_IN]; float* out; unsigned char* ws; };


DI void transpose_tile(const float* __restrict__ W, int K, int N, bf16_t* __restrict__ Wt, int tile, float* sm) {
    const int tid = get_tid();
    const int ntn = N / 256, tk = tile / ntn, tn = tile % ntn;
    __syncthreads();
#pragma unroll
    for (int i = 0; i < 4; ++i) {
        const int idx = tid + i * NT, kk = idx >> 6, n4 = (idx & 63) * 4;
        const f32x4 v = *(const f32x4*)(W + (size_t)(tk * 64 + kk) * N + tn * 256 + n4);
        float* d = sm + kk * 257 + n4;
        d[0] = v[0]; d[1] = v[1]; d[2] = v[2]; d[3] = v[3];
    }
    __syncthreads();
#pragma unroll
    for (int i = 0; i < 2; ++i) {
        const int idx = tid + i * NT, nn = idx & 255, kg = idx >> 8;
        const float* c = sm + kg * 8 * 257 + nn;
        *(u32x4*)(Wt + (size_t)(tn * 256 + nn) * K + tk * 64 + kg * 8) = u32x4{pk2(c[0], c[257]), pk2(c[2 * 257], c[3 * 257]), pk2(c[4 * 257], c[5 * 257]), pk2(c[6 * 257], c[7 * 257])};
    }
}

DI void mod_item(const Params& p, int item, float* sm) {
    const int tid = get_tid();
    float* sc = sm;
    float* red = sm + 9 * 1024;
    __syncthreads();
    for (int i = tid; i < 9 * 1024; i += NT) {
        const float v = (i < 8 * 1024) ? p.in[I_C][i] : p.in[I_CCTX][i - 8 * 1024];
        sc[i] = v / (1.f + __expf(-v));
    }
    __syncthreads();
    const int col = tid & 15, kg = tid >> 4, n0 = item * 16;
    float acc[9];
#pragma unroll
    for (int r = 0; r < 9; ++r) acc[r] = 0.f;
    const float* w = p.in[I_ADAW] + (size_t)kg * 16 * 6144 + n0 + col;
    float wv[16];
#pragma unroll
    for (int k = 0; k < 16; ++k) wv[k] = w[(size_t)k * 6144];
#pragma unroll
    for (int k = 0; k < 16; ++k)
#pragma unroll
        for (int r = 0; r < 9; ++r) acc[r] += sc[r * 1024 + kg * 16 + k] * wv[k];
#pragma unroll
    for (int r = 0; r < 9; ++r) red[(kg * 9 + r) * 16 + col] = acc[r];
    __syncthreads();
    if (tid < 9 * 16) {
        const int r = tid >> 4, c2 = tid & 15;
        float s = p.in[I_ADAB][n0 + c2];
        for (int g = 0; g < 64; ++g) s += red[(g * 9 + r) * 16 + c2];
        ((float*)(p.ws + WS_MOD))[r * 6144 + n0 + c2] = s;
    }
    __syncthreads();
}

DI void filter_item(const Params& p, int item, float* sm) {
    const int tid = get_tid();
    float* z  = sm;
    float* ha = sm + 16 * 36;
    float* hb = ha + 16 * 64;
    const int t0 = item * 16;
    if (tid < 16 * 33) {
        const int pp = tid / 33, i = tid % 33;
        const int t = t0 + pp;
        float v;
        if (i == 0) v = (float)t / (float)(SEQ - 1);
        else {
            const int fi = (i - 1) & 15;
            const float f = 1e-4f + (float)fi * ((15.f - 1e-4f) / 15.f);
            const float w = 6.283185307179586f * (float)t / (float)SEQ;
            const float a = f * w;
            v = (i <= 16) ? fcos(a) : -fsin(a);
        }
        z[pp * 36 + i] = v;
    }
    __syncthreads();
    const int pp = tid >> 6, j = tid & 63;
    const float fr = p.in[I_HFREQ][j];
    {
        float a = p.in[I_HB1][j];
        const float* w1 = p.in[I_HW1];
#pragma unroll 11
        for (int i = 0; i < 33; ++i) a += z[pp * 36 + i] * w1[i * 64 + j];
        ha[pp * 64 + j] = fsin(fr * a);
    }
    __syncthreads();
    {
        float a = p.in[I_HB2][j];
        const float* w2 = p.in[I_HW2];
#pragma unroll 8
        for (int i = 0; i < 64; ++i) a += ha[pp * 64 + i] * w2[i * 64 + j];
        hb[pp * 64 + j] = fsin(fr * a);
    }
    __syncthreads();
    {
        float a = p.in[I_HB3][j];
        const float* w3 = p.in[I_HW3];
#pragma unroll 8
        for (int i = 0; i < 64; ++i) a += hb[pp * 64 + i] * w3[i * 64 + j];
        __syncthreads();
        ha[pp * 64 + j] = fsin(fr * a);
    }
    __syncthreads();
    float* fraw = (float*)(p.ws + WS_FRAW);
    float* part = (float*)(p.ws + WS_PART);
    const float* w4 = p.in[I_HW4];
    {
        const int lane = tid & 63, wave = tid >> 6, l15 = lane & 15, lk = lane >> 4;
        float af[16];
#pragma unroll
        for (int ks = 0; ks < 16; ++ks) af[ks] = ha[l15 * 64 + ks * 4 + lk];
#pragma unroll 1
        for (int nt = 0; nt < 8; ++nt) {
            const int col = (wave * 8 + nt) * 16 + l15;
            f32x4 acc = f32x4{0.f, 0.f, 0.f, 0.f};
#pragma unroll
            for (int ks = 0; ks < 16; ++ks) acc = __builtin_amdgcn_mfma_f32_16x16x4f32(af[ks], w4[(size_t)(ks * 4 + lk) * 2048 + col], acc, 0, 0, 0);
            const int c = col & 511, dir = (col >> 9) & 1;
            const float mind = -3.0701134573253945f, maxd = -15.350567286626973f;
            const float delta = fabsf(mind + (float)c * ((maxd - mind) / 511.f));
            float sabs = 0.f, v[4];
#pragma unroll
            for (int r = 0; r < 4; ++r) {
                const int t = t0 + 4 * lk + r;
                const float t01 = (float)t / (float)(SEQ - 1);
                v[r] = acc[r] * expf(-t01 * delta);
                if (!(dir == 1 && t == 0)) sabs += fabsf(v[r]);
            }
            *(f32x4*)(fraw + (size_t)col * SEQ + t0 + 4 * lk) = f32x4{v[0], v[1], v[2], v[3]};
            sabs = sum_x32(sum_x16(sabs));
            if (lk == 0) part[item * 2048 + col] = sabs;
        }
    }
    __syncthreads();
}

DI void phase_a(const Params& p, float* sm) {
    constexpr int T_WIN = 16 * 17, T_AO = 8 * 4, T_HO = 8 * 4, T_WO = 16 * 4, T_WQ = 16 * 8;
    constexpr int E0 = T_WIN, E1 = E0 + T_AO, E2 = E1 + T_HO, E3 = E2 + T_WO, E4 = E3 + T_WQ;
    constexpr int E5 = E4 + 64;
    constexpr int E6 = E5 + 384;
    constexpr int E7 = E6 + 1;
    constexpr int E8 = E7 + 256;
    for (int it = blockIdx.x; it < E8; it += gridDim.x) {
        int item = it;
        if (item < 256) { filter_item(p, item, sm); if (PROBE_PHASE == 30 && blockIdx.x == 0 && get_tid() == 0) ((volatile unsigned long long*)(g_lds + LDS_PROBE_OFF))[1] = __builtin_amdgcn_s_memrealtime(); continue; }
        item -= 256;
        if (item < 384) { mod_item(p, item, sm); if (PROBE_PHASE == 31 && blockIdx.x == 0 && get_tid() == 0) ((volatile unsigned long long*)(g_lds + LDS_PROBE_OFF))[1] = __builtin_amdgcn_s_memrealtime(); continue; }
        item -= 384;
        if (item < 1) {
            const int tid = get_tid();
            float* rope = (float*)(p.ws + WS_ROPE);
            const int pos = tid >> 4, f = tid & 15;
            const float inv = powf(10000.f, -(float)(2 * f) / 32.f);
            const float ang = (float)pos * inv;
            rope[tid] = fcos(ang); rope[1024 + tid] = fsin(ang);
            continue;
        }
        item -= 1;
        if (item < 64) {
            const int tid = get_tid();
            const float* src = (item < 32) ? p.in[I_PK1] : p.in[I_PK2];
            bf16_t* dst = (bf16_t*)(p.ws + WS_KEYS) + (size_t)item * 4096;
            const f32x4 v = *(const f32x4*)(src + (size_t)(item & 31) * 4096 + tid * 4);
            *(u32x2*)(dst + tid * 4) = u32x2{pk2(v[0], v[1]), pk2(v[2], v[3])};
            continue;
        }
        item -= 64;
        if (item < T_WIN) { transpose_tile(p.in[I_WIN], DM, INC, (bf16_t*)(p.ws + WS_WTIN), item, sm); continue; }
        item -= T_WIN;
        if (item < T_AO) { transpose_tile(p.in[I_WAO], QD, DM, (bf16_t*)(p.ws + WS_WTAO), item, sm); continue; }
        item -= T_AO;
        if (item < T_HO) { transpose_tile(p.in[I_WHO], HYD, DM, (bf16_t*)(p.ws + WS_WTHO), item, sm); continue; }
        item -= T_HO;
        if (item < T_WO) { transpose_tile(p.in[I_WO], DM, DM, (bf16_t*)(p.ws + WS_WTO), item, sm); continue; }
        item -= T_WO;
        transpose_tile(p.in[I_PWQ], DM, 2048, (bf16_t*)(p.ws + WS_WTQ), item, sm);
    }
    (void)E1; (void)E2; (void)E3; (void)E4; (void)E5; (void)E6; (void)E7;
}

DI void norm_mod_row(const float* __restrict__ src, const float* __restrict__ g, const float* __restrict__ shift, const float* __restrict__ scale, bf16_t* __restrict__ dst) {
    const int lane = get_tid() & 63;
    f32x4 v[4];
    float ss = 0.f;
#pragma unroll
    for (int j = 0; j < 4; ++j) { v[j] = *(const f32x4*)(src + j * 256 + lane * 4); ss += v[j][0] * v[j][0] + v[j][1] * v[j][1] + v[j][2] * v[j][2] + v[j][3] * v[j][3]; }
    ss = wave_sum(ss);
    const float rs = rsqrtf(ss * (1.f / DM) + EPS);
#pragma unroll
    for (int j = 0; j < 4; ++j) {
        const int c = j * 256 + lane * 4;
        const f32x4 gg = *(const f32x4*)(g + c), sh = *(const f32x4*)(shift + c), sc = *(const f32x4*)(scale + c);
        float o[4];
#pragma unroll
        for (int e = 0; e < 4; ++e) o[e] = v[j][e] * rs * gg[e] * (1.f + sc[e]) + sh[e];
        *(u32x2*)(dst + c) = u32x2{pk2(o[0], o[1]), pk2(o[2], o[3])};
    }
}

DI void filter_norm_item(const Params& p, int item, float* sm) {
    const int tid = get_tid();
    const int o = item >> 9, c = item & 511;
    const int colf = o * 1024 + c, colb = colf + 512;
    const float* part = (const float*)(p.ws + WS_PART);
    float s = 0.f;
    if (tid < 512) s = part[(tid & 255) * 2048 + ((tid < 256) ? colf : colb)];
    s = wave_sum(s);
    if ((tid & 63) == 0) sm[tid >> 6] = s;
    __syncthreads();
    float tot = EPS;
#pragma unroll
    for (int i = 0; i < 8; ++i) tot += sm[i];
    const float inv = 1.f / tot;
    const float* fraw = (const float*)(p.ws + WS_FRAW);
    bf16_t* R = (bf16_t*)(p.ws + WS_R) + (size_t)item * 8192;
#pragma unroll
    for (int i = 0; i < 4; ++i) {
        const int n = (tid + i * NT) * 2;
        float v0, v1;
        if (n < 4096) { v0 = (n == 0) ? 0.f : fraw[(size_t)colf * SEQ + 4096 - n]; v1 = fraw[(size_t)colf * SEQ + 4095 - n]; }
        else if (n == 4096) { v0 = fraw[(size_t)colf * SEQ]; v1 = fraw[(size_t)colb * SEQ + 1]; }
        else { v0 = fraw[(size_t)colb * SEQ + n - 4096]; v1 = fraw[(size_t)colb * SEQ + n - 4095]; }
        *(unsigned*)(R + n) = pk2(v0 * inv, v1 * inv);
    }
    __syncthreads();
}

DI void table_conv_item(const Params& p, int ci, unsigned char* lds) {
    const int tid = get_tid();
    const size_t el = (size_t)(ci & 2047) * 8192 + tid * 8;
    const float* src = (ci < 2048 ? p.in[I_PU] : p.in[I_PV]) + el;
    const f32x4 a = *(const f32x4*)src, b = *(const f32x4*)(src + 4);
    const size_t e = el >> 10, col = el & 1023;
    if (ci < 2048) {
        float mx = fmaxf(fmaxf(fmaxf(fabsf(a[0]), fabsf(a[1])), fmaxf(fabsf(a[2]), fabsf(a[3]))), fmaxf(fmaxf(fabsf(b[0]), fabsf(b[1])), fmaxf(fabsf(b[2]), fabsf(b[3]))));
        float sq = a[0] * a[0] + a[1] * a[1] + a[2] * a[2] + a[3] * a[3] + b[0] * b[0] + b[1] * b[1] + b[2] * b[2] + b[3] * b[3];
        mx = wave_max(mx); sq = wave_sum(sq);
        float* wm = (float*)lds;
        __syncthreads();
        if ((tid & 63) == 0) { wm[tid >> 6] = mx; wm[16 + (tid >> 6)] = sq; }
        __syncthreads();
        const int w2 = (tid >> 7) * 2;
        const float rmax = fmaxf(wm[w2], wm[w2 + 1]), rsig = sqrtf((wm[16 + w2] + wm[17 + w2]) * (1.f / 1024.f));
        const float clip = fmaxf(fminf(rmax, 2.75f * rsig), 1e-30f);
        const float sc = 7.f / clip;
        if ((tid & 127) == 0) ((float*)(p.ws + WS_USC))[e] = clip * (1.f / 7.f);
        unsigned w = 0;
#pragma unroll
        for (int j = 0; j < 4; ++j) {
            const int ql = min(7, max(-7, __float2int_rn(a[j] * sc))) + 8, qh = min(7, max(-7, __float2int_rn(b[j] * sc))) + 8;
            w |= (unsigned)(ql | (qh << 4)) << (8 * j);
        }
        *(unsigned*)(p.ws + WS_UT + (el >> 1)) = w;
    } else {
        const float sc = VSCALE;
        int w0 = 0, w1 = 0;
        w0 = __builtin_amdgcn_cvt_pk_fp8_f32(a[0] * sc, a[1] * sc, w0, false); w0 = __builtin_amdgcn_cvt_pk_fp8_f32(a[2] * sc, a[3] * sc, w0, true);
        w1 = __builtin_amdgcn_cvt_pk_fp8_f32(b[0] * sc, b[1] * sc, w1, false); w1 = __builtin_amdgcn_cvt_pk_fp8_f32(b[2] * sc, b[3] * sc, w1, true);
        *(u32x2*)(p.ws + WS_VTAB + ((col >> 7) * 16384 + e) * 128 + (col & 127)) = u32x2{(unsigned)w0, (unsigned)w1};
    }
}

DI void phase_b(const Params& p, float* sm) {
    const int wave = get_tid() >> 6;
    const float* mod = (const float*)(p.ws + WS_MOD);
    constexpr int ROW_ITEMS = (BT + BATCH * CTX) / 16;
    constexpr int CONV = 2 * 16384 * 1024 / 8192;
    constexpr int SHQ = 8 * 2048 / 16;
    for (int it = blockIdx.x; it < ROW_ITEMS + 1024 + CONV + SHQ; it += gridDim.x) {
        if (it < 1024) { filter_norm_item(p, it, sm); continue; }
        if (it >= ROW_ITEMS + 1024 + CONV) {
            const int tid = get_tid(), lane = tid & 63, o = (it - ROW_ITEMS - 1024 - CONV) * 16 + (tid >> 6), b = o >> 11, n = o & 2047;
            const bf16_t* wr = (const bf16_t*)(p.ws + WS_WTQ) + (size_t)n * DM + lane * 16;
            const float* sh = mod + b * 6144 + 3072 + lane * 16;
            const u32x4 w0 = *(const u32x4*)wr, w1 = *(const u32x4*)(wr + 8);
            float d = 0.f;
#pragma unroll
            for (int i = 0; i < 4; ++i) { d += bflo(w0[i]) * sh[2 * i] + bfhi(w0[i]) * sh[2 * i + 1] + bflo(w1[i]) * sh[8 + 2 * i] + bfhi(w1[i]) * sh[9 + 2 * i]; }
            d = wave_sum(d);
            if (lane == 0) ((float*)(p.ws + WS_SHQ))[o] = d;
            continue;
        }
        if (it >= ROW_ITEMS + 1024) { table_conv_item(p, it - ROW_ITEMS - 1024, (unsigned char*)sm); continue; }
        const int row = (it - 1024) * 16 + wave;
        if (row < BT) {
            const int b = row >> 12;
            norm_mod_row(p.in[I_X] + (size_t)row * DM, p.in[I_NMIX], mod + b * 6144, mod + b * 6144 + 1024, (bf16_t*)(p.ws + WS_H) + (size_t)row * DM);
        } else {
            const int r = row - BT;
            norm_mod_row(p.in[I_CTX] + (size_t)r * DM, p.in[I_NMIX], mod + 8 * 6144, mod + 8 * 6144 + 1024, (bf16_t*)(p.ws + WS_HC) + (size_t)r * DM);
        }
    }
}

#define MFMA16(a, b, c) __builtin_amdgcn_mfma_f32_16x16x32_bf16((a), (b), (c), 0, 0, 0)
constexpr int GT_P = 256 * 128;
struct RowLoader {
    const bf16_t* base; int ld;
    template<int ROWS> DI void issue(unsigned char* tile, int kt, int lane, int wave) const {
#pragma unroll
        for (int i = 0; i < ROWS / 128; ++i) {
            const int grp = i * 16 + wave, row = grp * 8 + (lane >> 3), c = (lane & 7) ^ (lane >> 3);
            __builtin_amdgcn_global_load_lds((const unsigned*)(base + (size_t)row * ld + kt * 64 + c * 8), (unsigned*)(tile + grp * 1024), 16, 0, 0);
        }
    }
};

template<int NQ>
DI void gemm_mainloop(f32x4 (&acc)[4][NQ], const RowLoader& lp, const RowLoader& lq, int nk, unsigned char* lds) {
    const int tid = get_tid(), lane = tid & 63, wave = __builtin_amdgcn_readfirstlane(tid >> 6), wp = wave >> 2, wq = wave & 3;
    constexpr int QROWS = NQ * 64;
    constexpr int STAGE = GT_P + QROWS * 128;
    __syncthreads();
    lp.template issue<256>(lds, 0, lane, wave); lq.template issue<QROWS>(lds + GT_P, 0, lane, wave);
    asm volatile("s_waitcnt vmcnt(0)" ::: "memory");
    __syncthreads();
    const int l15 = lane & 15, lk = lane >> 4;
    for (int kt = 0; kt < nk; ++kt) {
        unsigned char* cur = lds + (kt & 1) * STAGE;
        unsigned char* nxt = lds + ((kt + 1) & 1) * STAGE;
        if (kt + 1 < nk) { lp.template issue<256>(nxt, kt + 1, lane, wave); lq.template issue<QROWS>(nxt + GT_P, kt + 1, lane, wave); }
#pragma unroll
        for (int ks = 0; ks < 2; ++ks) {
            bf16x8 fp[4], fq[NQ];
#pragma unroll
            for (int i = 0; i < 4; ++i) { const int row = wp * 64 + i * 16 + l15; fp[i] = *(const bf16x8*)(cur + row * 128 + (((ks * 4 + lk) ^ (row & 7)) << 4)); }
#pragma unroll
            for (int j = 0; j < NQ; ++j) { const int row = wq * (16 * NQ) + j * 16 + l15; fq[j] = *(const bf16x8*)(cur + GT_P + row * 128 + (((ks * 4 + lk) ^ (row & 7)) << 4)); }
#pragma unroll
            for (int i = 0; i < 4; ++i)
#pragma unroll
                for (int j = 0; j < NQ; ++j) acc[i][j] = MFMA16(fp[i], fq[j], acc[i][j]);
        }
        asm volatile("s_waitcnt vmcnt(0)" ::: "memory");
        __syncthreads();
    }
}

#ifndef SHADOW
#define SHADOW 0
#endif
template<int NQ>
DI void gemm_shadow(const RowLoader& lp, const RowLoader& lq, int nk, unsigned char* lds) {
    f32x4 acc[4][NQ];
#pragma unroll
    for (int i = 0; i < 4; ++i)
#pragma unroll
        for (int j = 0; j < NQ; ++j) acc[i][j] = f32x4{0.f, 0.f, 0.f, 0.f};
    if (SHADOW == 1) gemm_mainloop<NQ>(acc, lp, lq, nk, lds);
    else {
        const int tid = get_tid(), lane = tid & 63, wave = __builtin_amdgcn_readfirstlane(tid >> 6), wp = wave >> 2, wq = wave & 3;
        constexpr int QROWS = NQ * 64;
        constexpr int STAGE = GT_P + QROWS * 128;
        const int l15 = lane & 15, lk = lane >> 4;
        bf16x8 fp[4], fq[NQ];
        if (SHADOW == 3) {
#pragma unroll
            for (int i = 0; i < 4; ++i) fp[i] = *(const bf16x8*)(lds + (wp * 64 + i * 16 + l15) * 128 + lk * 16);
#pragma unroll
            for (int j = 0; j < NQ; ++j) fq[j] = *(const bf16x8*)(lds + GT_P + (wq * 16 * NQ + j * 16 + l15) * 128 + lk * 16);
        }
        for (int kt = 0; kt < nk; ++kt) {
            unsigned char* cur = lds + (kt & 1) * STAGE;
#pragma unroll
            for (int ks = 0; ks < 2; ++ks) {
                if (SHADOW == 2 || SHADOW == 4) {
#pragma unroll
                    for (int i = 0; i < 4; ++i) { const int row = wp * 64 + i * 16 + l15; fp[i] = *(const bf16x8*)(cur + row * 128 + (((ks * 4 + lk) ^ (row & 7)) << 4)); }
#pragma unroll
                    for (int j = 0; j < NQ; ++j) { const int row = wq * (16 * NQ) + j * 16 + l15; fq[j] = *(const bf16x8*)(cur + GT_P + row * 128 + (((ks * 4 + lk) ^ (row & 7)) << 4)); }
                }
#pragma unroll
                for (int i = 0; i < 4; ++i)
#pragma unroll
                    for (int j = 0; j < NQ; ++j) acc[i][j] = MFMA16(fp[i], fq[j], acc[i][j]);
            }
            if (SHADOW == 2) asm volatile("" ::: "memory");
            if (SHADOW == 4) __syncthreads();
        }
    }
#pragma unroll
    for (int i = 0; i < 4; ++i)
#pragma unroll
        for (int j = 0; j < NQ; ++j) asm volatile("" :: "v"(acc[i][j]));
}

template<int NQ> DI void gemm_shadow1(const RowLoader& lp, const RowLoader& lq, int nk, unsigned char* lds) {
    f32x4 acc[4][NQ];
#pragma unroll
    for (int i = 0; i < 4; ++i)
#pragma unroll
        for (int j = 0; j < NQ; ++j) acc[i][j] = f32x4{0.f, 0.f, 0.f, 0.f};
    gemm_mainloop<NQ>(acc, lp, lq, nk, lds);
#pragma unroll
    for (int i = 0; i < 4; ++i)
#pragma unroll
        for (int j = 0; j < NQ; ++j) asm volatile("" :: "v"(acc[i][j]));
}
DI void head_epilogue(f32x4 (&acc)[4][4], const float* __restrict__ g, float gscale, const float* __restrict__ rope, bool do_rope, int t_base  , bf16_t* __restrict__ dst  , int lane) {
    const int l15 = lane & 15, lk = lane >> 4;
    float gg[4];
#pragma unroll
    for (int j = 0; j < 4; ++j) gg[j] = g[j * 16 + l15] * gscale;
#pragma unroll
    for (int i = 0; i < 4; ++i) {
#pragma unroll
        for (int r = 0; r < 4; ++r) {
            float ss = 0.f;
#pragma unroll
            for (int j = 0; j < 4; ++j) ss += acc[i][j][r] * acc[i][j][r];
            ss = sum16(ss);
            const float rs = rsqrtf(ss * (1.f / 64.f) + EPS);
            float v[4];
#pragma unroll
            for (int j = 0; j < 4; ++j) v[j] = acc[i][j][r] * rs * gg[j];
            const int t = t_base + i * 16 + lk * 4 + r;
            if (do_rope) {
                const int prow = (t >> 6) & 63, pcol = t & 63;
                const float c0 = rope[prow * 16 + l15], s0 = rope[1024 + prow * 16 + l15];
                const float c1 = rope[pcol * 16 + l15], s1 = rope[1024 + pcol * 16 + l15];
                const float a0 = v[0] * c0 - v[1] * s0, a1 = v[1] * c0 + v[0] * s0;
                const float a2 = v[2] * c1 - v[3] * s1, a3 = v[3] * c1 + v[2] * s1;
                v[0] = a0; v[1] = a1; v[2] = a2; v[3] = a3;
            }
            bf16_t* d = dst + (size_t)(i * 16 + lk * 4 + r) * 64 + l15;
#pragma unroll
            for (int j = 0; j < 4; ++j) d[j * 16] = (bf16_t)f2bf(v[j]);
        }
    }
}
DI void tstore_epilogue(f32x4 (&acc)[4][4], bf16_t* __restrict__ dst  , size_t ld, int lane) {
    const int l15 = lane & 15, lk = lane >> 4;
#pragma unroll
    for (int i = 0; i < 4; ++i)
#pragma unroll
        for (int j = 0; j < 4; ++j)
            *(u32x2*)(dst + (size_t)(j * 16 + l15) * ld + i * 16 + lk * 4) = u32x2{pk2(acc[i][j][0], acc[i][j][1]), pk2(acc[i][j][2], acc[i][j][3])};
}

DI void phase_c(const Params& p, unsigned char* lds) {
    constexpr int NTM = BT / 256, NTN = INC / 256;
    constexpr int MAIN = NTM * NTN, TOTAL = MAIN + 8;
    const bf16_t* H = (const bf16_t*)(p.ws + WS_H);
    const bf16_t* HCp = (const bf16_t*)(p.ws + WS_HC);
    const bf16_t* WT = (const bf16_t*)(p.ws + WS_WTIN);
    const float* rope = (const float*)(p.ws + WS_ROPE);
    for (int it = blockIdx.x; it < TOTAL; it += gridDim.x) {
        const int tid = get_tid(), lane = tid & 63, wave = tid >> 6, wa = wave >> 2, wb = wave & 3;
        int tm, tn; bool ctx = false;
        if (it < MAIN) { const int g = it / (16 * NTN), rem = it % (16 * NTN); tn = rem >> 4; tm = g * 16 + (rem & 15); }
        else { ctx = true; tm = it - MAIN; tn = 2; }
        const bf16_t* A = ctx ? HCp + (size_t)tm * 256 * DM : H + (size_t)tm * 256 * DM;
        const bf16_t* W = WT + (size_t)tn * 256 * DM;
        f32x4 acc[4][4];
#pragma unroll
        for (int i = 0; i < 4; ++i)
#pragma unroll
            for (int j = 0; j < 4; ++j) acc[i][j] = f32x4{0.f, 0.f, 0.f, 0.f};
        if (tn >= 9) {
            gemm_mainloop<4>(acc, RowLoader{W, DM}, RowLoader{A, DM}, DM / 64, lds);
            bf16_t* G = (bf16_t*)(p.ws + WS_G);
            const int l15 = lane & 15, lk = lane >> 4;
#pragma unroll
            for (int i = 0; i < 4; ++i)
#pragma unroll
                for (int j = 0; j < 4; ++j) {
                    const int n = tn * 256 - 2304 + wa * 64 + i * 16 + lk * 4;
                    const int tok = tm * 256 + wb * 64 + j * 16 + l15;
                    float sg[4];
#pragma unroll
                    for (int r = 0; r < 4; ++r) sg[r] = 1.f / (1.f + __expf(-acc[i][j][r]));
                    *(u32x2*)(G + (size_t)tok * GC + n) = u32x2{pk2(sg[0], sg[1]), pk2(sg[2], sg[3])};
                }
            continue;
        }
        if (SHADOW) gemm_shadow<4>(RowLoader{A, DM}, RowLoader{W, DM}, DM / 64, lds);
        gemm_mainloop<4>(acc, RowLoader{A, DM}, RowLoader{W, DM}, DM / 64, lds);
        const int b = ctx ? tm : (tm >> 4);
        const int tpos = ctx ? SEQ + wa * 64 : ((tm & 15) * 256 + wa * 64);
        if (tn < 2) {
            const int h = tn * 4 + wb;
            bf16_t* Q = (bf16_t*)(p.ws + WS_Q) + ((size_t)(b * NH + h) * SEQ + tpos) * HD;
            head_epilogue(acc, p.in[I_QNG], 0.125f * 1.4426950408889634f, rope, true, tpos, Q, lane);
        } else if (tn == 2) {
            if (wb < 2) {
                bf16_t* K = (bf16_t*)(p.ws + WS_KB) + ((size_t)(b * NKV + wb) * TK + tpos) * HD;
                head_epilogue(acc, p.in[I_KNG], 1.f, rope, !ctx, tpos, K, lane);
            } else {
                bf16_t* V = (bf16_t*)(p.ws + WS_VT) + (size_t)(b * NKV + (wb - 2)) * HD * TK + tpos;
                tstore_epilogue(acc, V, TK, lane);
            }
        } else {
            const int col = tn * 256 - 768 + wb * 64;
            bf16_t* Z = (bf16_t*)(p.ws + WS_ZT) + (size_t)col * BT + (size_t)b * SEQ + tpos;
            tstore_epilogue(acc, Z, BT, lane);
        }
    }
}

#define MFMA32(a, b, c) __builtin_amdgcn_mfma_f32_32x32x16_bf16((a), (b), (c), 0, 0, 0)
DI bf16x8 pack_step(const f32x16& x, int s) {
    u32x4 pk;
    asm volatile("v_cvt_pk_bf16_f32 %0, %4, %5\n\tv_cvt_pk_bf16_f32 %1, %6, %7\n\tv_cvt_pk_bf16_f32 %2, %8, %9\n\tv_cvt_pk_bf16_f32 %3, %10, %11\n\ts_nop 1"
                 : "=&v"(pk[0]), "=&v"(pk[1]), "=&v"(pk[2]), "=&v"(pk[3])
                 : "v"(x[8 * s]), "v"(x[8 * s + 1]), "v"(x[8 * s + 2]), "v"(x[8 * s + 3]), "v"(x[8 * s + 4]), "v"(x[8 * s + 5]), "v"(x[8 * s + 6]), "v"(x[8 * s + 7]));
    return __builtin_bit_cast(bf16x8, pk);
}

constexpr int AT_KSTR = 144, AT_VSTR = 136, AT_VOFF = 64 * AT_KSTR, AT_STAGE = AT_VOFF + 64 * AT_VSTR;
DI void attn_item(const Params& p, int item, unsigned char* lds) {
    const int tid = get_tid(), lane = tid & 63, wave = tid >> 6;
    const int b = item >> 6, kvh = (item >> 5) & 1, qb = item & 31;
    const int h = kvh * 4 + (wave >> 2), q0 = qb * 128 + (wave & 3) * 32;
    const int qi = lane & 31, hf = lane >> 5;
    const bf16_t* Qp = (const bf16_t*)(p.ws + WS_Q) + ((size_t)(b * NH + h) * SEQ + q0 + qi) * HD;
    bf16x8 qf[4];
#pragma unroll
    for (int s = 0; s < 4; ++s) qf[s] = *(const bf16x8*)(Qp + 16 * s + 8 * hf);
    const bf16_t* Kg = (const bf16_t*)(p.ws + WS_KB) + (size_t)(b * NKV + kvh) * TK * HD;
    const bf16_t* Vg = (const bf16_t*)(p.ws + WS_VT) + (size_t)(b * NKV + kvh) * HD * TK;
    const bool isK = tid < 512;
    const int li = tid & 511, lrow = li >> 3, lc = li & 7;
    const bf16_t* src = isK ? Kg + (size_t)lrow * HD + lc * 8 : Vg + (size_t)lrow * TK + lc * 8;
    const size_t sstep = isK ? (size_t)64 * HD : 64;
    const int ldst = isK ? lrow * AT_KSTR + lc * 16 : AT_VOFF + lrow * AT_VSTR + lc * 16;
    constexpr int NTILE = TK / 64;
    f32x16 o0, o1;
#pragma unroll
    for (int i = 0; i < 16; ++i) { o0[i] = 0.f; o1[i] = 0.f; }
    float l = 0.f;
    __syncthreads();
    constexpr int NSUB = 4, NSTG = NTILE / NSUB;
    static_assert(NTILE % NSUB == 0 && 2 * NSUB * AT_STAGE <= LDS_USER, "attention LDS stages");
    u32x4 stg[NSUB];
#pragma unroll
    for (int j = 0; j < NSUB; ++j) stg[j] = *(const u32x4*)(src + (size_t)j * sstep);
#pragma unroll
    for (int j = 0; j < NSUB; ++j) { unsigned char* d = lds + j * AT_STAGE + ldst; *(u32x2*)d = u32x2{stg[j][0], stg[j][1]}; *(u32x2*)(d + 8) = u32x2{stg[j][2], stg[j][3]}; }
    __syncthreads();
    const int koff = qi * AT_KSTR + hf * 16;
    const int voff = AT_VOFF + qi * AT_VSTR + hf * 8;
    for (int st = 0; st < NSTG; ++st) {
      const bool more = st + 1 < NSTG;
      if (more) {
#pragma unroll
          for (int j = 0; j < NSUB; ++j) stg[j] = *(const u32x4*)(src + (size_t)((st + 1) * NSUB + j) * sstep);
      }
#pragma unroll 1
      for (int j = 0; j < NSUB; ++j) {
        const unsigned char* cur = lds + ((st & 1) * NSUB + j) * AT_STAGE;
        f32x16 sA, sB;
#pragma unroll
        for (int i = 0; i < 16; ++i) { sA[i] = 0.f; sB[i] = 0.f; }
        __builtin_amdgcn_s_setprio(1);
#pragma unroll
        for (int s = 0; s < 4; ++s) sA = MFMA32(*(const bf16x8*)(cur + koff + s * 32), qf[s], sA);
#pragma unroll
        for (int s = 0; s < 4; ++s) sB = MFMA32(*(const bf16x8*)(cur + koff + 32 * AT_KSTR + s * 32), qf[s], sB);
        __builtin_amdgcn_s_setprio(0);
        float ps = 0.f;
#pragma unroll
        for (int kb = 0; kb < 2; ++kb) {
            f32x16& sx = kb ? sB : sA;
#pragma unroll
            for (int i = 0; i < 16; ++i) { sx[i] = __builtin_amdgcn_exp2f(sx[i]); ps += sx[i]; }
#pragma unroll
            for (int s2 = 0; s2 < 2; ++s2) {
                const bf16x8 pf = pack_step(sx, s2);
#pragma unroll
                for (int db = 0; db < 2; ++db) {
                    const unsigned char* vb = cur + voff + db * 32 * AT_VSTR + (4 * kb + 2 * s2) * 16;
                    const s16x4 lo = lds_rd64(vb);
                    const s16x4 hi = lds_rd64(vb + 16);
                    const bf16x8 vf = __builtin_shufflevector(lo, hi, 0, 1, 2, 3, 4, 5, 6, 7);
                    if (db == 0) o0 = MFMA32(vf, pf, o0); else o1 = MFMA32(vf, pf, o1);
                }
            }
        }
        l += ps;
      }
      if (more) {
#pragma unroll
          for (int j = 0; j < NSUB; ++j) { unsigned char* d = lds + (((st + 1) & 1) * NSUB + j) * AT_STAGE + ldst; *(u32x2*)d = u32x2{stg[j][0], stg[j][1]}; *(u32x2*)(d + 8) = u32x2{stg[j][2], stg[j][3]}; }
      }
      __syncthreads();
    }
    l = sum_x32(l);
    const float inv = 1.f / l;
    bf16_t* O;
    {
        const int t2 = get_tid(), lane2 = t2 & 63, wave2 = t2 >> 6;
        const int h2 = kvh * 4 + (wave2 >> 2), q2 = qb * 128 + (wave2 & 3) * 32 + (lane2 & 31);
        O = (bf16_t*)(p.ws + WS_ATT) + ((size_t)b * SEQ + q2) * QD + h2 * HD + 4 * (lane2 >> 5);
    }
#pragma unroll
    for (int g4 = 0; g4 < 4; ++g4) {
        *(u32x2*)(O + 8 * g4)      = u32x2{pk2(o0[4 * g4] * inv, o0[4 * g4 + 1] * inv), pk2(o0[4 * g4 + 2] * inv, o0[4 * g4 + 3] * inv)};
        *(u32x2*)(O + 32 + 8 * g4) = u32x2{pk2(o1[4 * g4] * inv, o1[4 * g4 + 1] * inv), pk2(o1[4 * g4 + 2] * inv, o1[4 * g4 + 3] * inv)};
    }
}

constexpr int HY_USTR = 8208, HY_R = 8 * HY_USTR, HY_RSTR = 16384 + 64;
DI void hy_load_filter(const bf16_t* __restrict__ R, unsigned char* lds, int tid) {
    const int i0 = tid * 8;
    const u32x4 w = *(const u32x4*)(R + i0);
    u32x2 nx = u32x2{0u, 0u};
    if (i0 + 8 < 8192) nx = *(const u32x2*)(R + i0 + 8);
    unsigned char* d = lds + HY_R + i0 * 2;
    *(u32x4*)(d) = w;
    *(u32x4*)(d + HY_RSTR) = u32x4{__builtin_amdgcn_alignbit(w[1], w[0], 16), __builtin_amdgcn_alignbit(w[2], w[1], 16), __builtin_amdgcn_alignbit(w[3], w[2], 16), __builtin_amdgcn_alignbit(nx[0], w[3], 16)};
    *(u32x4*)(d + 2 * HY_RSTR) = u32x4{w[1], w[2], w[3], nx[0]};
    *(u32x4*)(d + 3 * HY_RSTR) = u32x4{__builtin_amdgcn_alignbit(w[2], w[1], 16), __builtin_amdgcn_alignbit(w[3], w[2], 16), __builtin_amdgcn_alignbit(nx[0], w[3], 16), __builtin_amdgcn_alignbit(nx[1], nx[0], 16)};
}
DI void short_conv4(const bf16_t* __restrict__ zrow  , int t4, float w0, float w1, float w2, float bias, float (&out)[4]) {
    const u32x2 v = *(const u32x2*)(zrow + t4);
    const float z0 = bflo(v[0]), z1 = bfhi(v[0]), z2 = bflo(v[1]), z3 = bfhi(v[1]);
    const float zm = (t4 > 0) ? bf2f(zrow[t4 - 1]) : 0.f;
    const float zp = (t4 + 4 < SEQ) ? bf2f(zrow[t4 + 4]) : 0.f;
    out[0] = zm * w0 + z0 * w1 + z1 * w2 + bias;
    out[1] = z0 * w0 + z1 * w1 + z2 * w2 + bias;
    out[2] = z1 * w0 + z2 * w1 + z3 * w2 + bias;
    out[3] = z2 * w0 + z3 * w1 + zp * w2 + bias;
}
DI void hyena_item(const Params& p, int c, unsigned char* lds) {
    const int tid = get_tid(), lane = tid & 63, ig = tid >> 6;
    const bf16_t* ZT = (const bf16_t*)(p.ws + WS_ZT);
    const float* cw = p.in[I_HCW];
    const float* cb = p.in[I_HCB];
    __syncthreads();
    {
        const int b = tid >> 7, tb = (tid & 127) * 32;
        const bf16_t* zrow = ZT + (size_t)c * BT + (size_t)b * SEQ;
        const float w0 = cw[c], w1 = cw[HYC + c], w2 = cw[2 * HYC + c], bias = cb[c];
#pragma unroll
        for (int q = 0; q < 8; ++q) {
            float o[4];
            short_conv4(zrow, tb + 4 * q, w0, w1, w2, bias, o);
            *(u32x2*)(lds + b * HY_USTR + (tb + 4 * q) * 2) = u32x2{pk2(o[0], o[1]), pk2(o[2], o[3])};
        }
    }
    const int r = lane & 31, hf = lane >> 5, Il = r >> 3, bb = r & 7;
#pragma unroll 1
    for (int o = 0; o < 2; ++o) {
        hy_load_filter((const bf16_t*)(p.ws + WS_R) + (size_t)(o * 512 + c) * 8192, lds, tid);
        __syncthreads();
        f32x16 acc0, acc1;
#pragma unroll
        for (int i = 0; i < 16; ++i) { acc0[i] = 0.f; acc1[i] = 0.f; }
        const int sh = (-r) & 3;
        const unsigned char* abase = lds + HY_R + sh * HY_RSTR + (4096 + 8 * hf - r - sh) * 2 - 64;
        const unsigned char* ubase = lds + bb * HY_USTR + ((4 * ig + Il) * 64 + 8 * hf) * 2;
#define HY_STEP(MASKED) do { \
            const unsigned char* ap = abase - 128 * d; \
            const unsigned char* ub = ubase - 128 * d; \
            bool valid = true; \
            if (MASKED) { const int J = 4 * ig + Il - d; valid = (unsigned)J < 64u; if (!valid) ub = lds; } \
            _Pragma("unroll") for (int ks = 0; ks < 4; ++ks) { \
                u32x4 braw = *(const u32x4*)(ub + ks * 32); \
                if (MASKED) { if (!valid) braw = u32x4{0u, 0u, 0u, 0u}; } \
                const bf16x8 bf = __builtin_bit_cast(bf16x8, braw); \
                { const s16x4 lo = lds_rd64(ap + 32 * ks + 64), hi = lds_rd64(ap + 32 * ks + 72);     \
                  acc0 = MFMA32(__builtin_shufflevector(lo, hi, 0, 1, 2, 3, 4, 5, 6, 7), bf, acc0); } \
                { const s16x4 lo = lds_rd64(ap + 32 * ks), hi = lds_rd64(ap + 32 * ks + 8); \
                  acc1 = MFMA32(__builtin_shufflevector(lo, hi, 0, 1, 2, 3, 4, 5, 6, 7), bf, acc1); } \
            } } while (0)
        const int dlo = 4 * ig - 63, dhi = 4 * ig + 3;
#pragma unroll 1
        for (int d = dlo; d < dlo + 3; ++d) HY_STEP(true);
#pragma unroll 1
        for (int d = dlo + 3; d <= dhi - 3; ++d) HY_STEP(false);
#pragma unroll 1
        for (int d = dhi - 2; d <= dhi; ++d) HY_STEP(true);
#undef HY_STEP
        __syncthreads();
        const float skip = p.in[I_HSKIP][o * HYD + c];
        const int gcol = (o == 0 ? 512 : 1024) + c;
        const float w0 = cw[gcol], w1 = cw[HYC + gcol], w2 = cw[2 * HYC + gcol], bias = cb[gcol];
        const bf16_t* zrow = ZT + (size_t)gcol * BT + (size_t)bb * SEQ;
        bf16_t* hyt = (bf16_t*)(p.ws + WS_HYT) + (size_t)c * BT + (size_t)bb * SEQ;
#pragma unroll
        for (int mm = 0; mm < 2; ++mm) {
#pragma unroll
            for (int g4 = 0; g4 < 4; ++g4) {
                const int t4 = (4 * ig + Il) * 64 + 32 * mm + 8 * g4 + 4 * hf;
                float gt[4];
                short_conv4(zrow, t4, w0, w1, w2, bias, gt);
                unsigned char* up = lds + bb * HY_USTR + t4 * 2;
                const u32x2 uv = *(const u32x2*)up;
                const float u0 = bflo(uv[0]), u1 = bfhi(uv[0]), u2 = bflo(uv[1]), u3 = bfhi(uv[1]);
                const f32x16& a = mm ? acc1 : acc0;
                const float y0 = gt[0] * (a[4 * g4] + skip * u0), y1 = gt[1] * (a[4 * g4 + 1] + skip * u1);
                const float y2 = gt[2] * (a[4 * g4 + 2] + skip * u2), y3 = gt[3] * (a[4 * g4 + 3] + skip * u3);
                const u32x2 pk = u32x2{pk2(y0, y1), pk2(y2, y3)};
                if (o == 0) *(u32x2*)up = pk; else *(u32x2*)(hyt + t4) = pk;
            }
        }
        __syncthreads();
    }
}

constexpr int CTL_QUEUE_D = 8192;
DI void phase_d(const Params& p, unsigned char* lds) {
    unsigned* ctr = (unsigned*)(p.ws + WS_CTL) + CTL_QUEUE_D;
    volatile LAS unsigned* slot = (volatile LAS unsigned*)(LAS unsigned char*)(lds + LDS_ST_OFF + 8);
    for (;;) {
        __syncthreads();
        if (get_tid() == 0) slot[0] = atomicAdd(ctr, 1u);
        __syncthreads();
        const int it = __builtin_amdgcn_readfirstlane((int)slot[0]);
        if (it >= 1024) break;
        if (it < 512) hyena_item(p, it, lds); else attn_item(p, it - 512, lds);
    }
}

DI void phase_d2(const Params& p, unsigned char* lds) {
    constexpr int TILES = 8 * (BT / 256);
    const bf16_t* HYT = (const bf16_t*)(p.ws + WS_HYT);
    bf16_t* HY = (bf16_t*)(p.ws + WS_HY);
    for (int it = blockIdx.x; it < TILES; it += gridDim.x) {
        const int tid = get_tid();
        const int c0 = (it & 7) * 64, tok0 = (it >> 3) * 256;
        __syncthreads();
#pragma unroll
        for (int i = 0; i < 2; ++i) {
            const int idx = tid + i * NT, c = idx >> 5, tg = idx & 31;
            *(u32x4*)(lds + c * 528 + tg * 16) = *(const u32x4*)(HYT + (size_t)(c0 + c) * BT + tok0 + tg * 8);
        }
        __syncthreads();
#pragma unroll
        for (int i = 0; i < 2; ++i) {
            const int idx = tid + i * NT, tok = idx >> 3, cg = idx & 7;
            unsigned w[4];
#pragma unroll
            for (int e = 0; e < 4; ++e) {
                const unsigned lo = *(const unsigned short*)(lds + (cg * 8 + 2 * e) * 528 + tok * 2);
                const unsigned hi = *(const unsigned short*)(lds + (cg * 8 + 2 * e + 1) * 528 + tok * 2);
                w[e] = lo | (hi << 16);
            }
            *(u32x4*)(HY + (size_t)(tok0 + tok) * HYD + c0 + cg * 8) = u32x4{w[0], w[1], w[2], w[3]};
        }
    }
}

DI void phase_e(const Params& p, unsigned char* lds) {
    constexpr int TILES = 4 * (BT / 128);
    for (int it = blockIdx.x; it < TILES; it += gridDim.x) {
        const int tid = get_tid(), lane = tid & 63, wave = tid >> 6, wp = wave >> 2, wq = wave & 3;
        const int tn = it & 3, tm = it >> 2;
        const int n0 = tn * 256, tok0 = tm * 128;
        f32x4 acc1[4][2], acc2[4][2];
#pragma unroll
        for (int i = 0; i < 4; ++i)
#pragma unroll
            for (int j = 0; j < 2; ++j) { acc1[i][j] = f32x4{0.f, 0.f, 0.f, 0.f}; acc2[i][j] = f32x4{0.f, 0.f, 0.f, 0.f}; }
        if (SHADOW == 5) { gemm_shadow1<2>(RowLoader{(const bf16_t*)(p.ws + WS_WTAO) + (size_t)n0 * QD, QD}, RowLoader{(const bf16_t*)(p.ws + WS_ATT) + (size_t)tok0 * QD, QD}, QD / 64, lds);
                           gemm_shadow1<2>(RowLoader{(const bf16_t*)(p.ws + WS_WTHO) + (size_t)n0 * HYD, HYD}, RowLoader{(const bf16_t*)(p.ws + WS_HY) + (size_t)tok0 * HYD, HYD}, HYD / 64, lds); }
        gemm_mainloop<2>(acc1, RowLoader{(const bf16_t*)(p.ws + WS_WTAO) + (size_t)n0 * QD, QD}, RowLoader{(const bf16_t*)(p.ws + WS_ATT) + (size_t)tok0 * QD, QD}, QD / 64, lds);
        gemm_mainloop<2>(acc2, RowLoader{(const bf16_t*)(p.ws + WS_WTHO) + (size_t)n0 * HYD, HYD}, RowLoader{(const bf16_t*)(p.ws + WS_HY) + (size_t)tok0 * HYD, HYD}, HYD / 64, lds);
        const bf16_t* G = (const bf16_t*)(p.ws + WS_G);
        bf16_t* M = (bf16_t*)(p.ws + WS_H);
        constexpr int ES = 528, EG2 = 128 * ES;
        __syncthreads();
        {
            u32x4 ga[4], gh[4];
#pragma unroll
            for (int q = 0; q < 4; ++q) {
                const int idx = tid + q * NT, row = idx >> 5, ch = idx & 31;
                const bf16_t* gp = G + (size_t)(tok0 + row) * GC + n0 + ch * 8;
                ga[q] = *(const u32x4*)gp; gh[q] = *(const u32x4*)(gp + 1024);
            }
#pragma unroll
            for (int q = 0; q < 4; ++q) {
                const int idx = tid + q * NT, row = idx >> 5, ch = idx & 31;
                *(u32x4*)(lds + row * ES + ch * 16) = ga[q]; *(u32x4*)(lds + EG2 + row * ES + ch * 16) = gh[q];
            }
        }
        __syncthreads();
        const int l15 = lane & 15, lk = lane >> 4;
        u32x2 mo[4][2];
#pragma unroll
        for (int i = 0; i < 4; ++i)
#pragma unroll
            for (int j = 0; j < 2; ++j) {
                const int off = (wq * 32 + j * 16 + l15) * ES + (wp * 64 + i * 16 + lk * 4) * 2;
                const u32x2 ga = *(const u32x2*)(lds + off), gh = *(const u32x2*)(lds + EG2 + off);
                const float m0 = bflo(ga[0]) * acc1[i][j][0] + bflo(gh[0]) * acc2[i][j][0];
                const float m1 = bfhi(ga[0]) * acc1[i][j][1] + bfhi(gh[0]) * acc2[i][j][1];
                const float m2 = bflo(ga[1]) * acc1[i][j][2] + bflo(gh[1]) * acc2[i][j][2];
                const float m3 = bfhi(ga[1]) * acc1[i][j][3] + bfhi(gh[1]) * acc2[i][j][3];
                mo[i][j] = u32x2{pk2(m0, m1), pk2(m2, m3)};
            }
        __syncthreads();
#pragma unroll
        for (int i = 0; i < 4; ++i)
#pragma unroll
            for (int j = 0; j < 2; ++j) *(u32x2*)(lds + (wq * 32 + j * 16 + l15) * ES + (wp * 64 + i * 16 + lk * 4) * 2) = mo[i][j];
        __syncthreads();
#pragma unroll
        for (int q = 0; q < 4; ++q) {
            const int idx = tid + q * NT, row = idx >> 5, ch = idx & 31;
            *(u32x4*)(M + (size_t)(tok0 + row) * DM + n0 + ch * 8) = *(const u32x4*)(lds + row * ES + ch * 16);
        }
    }
}

DI void phase_f(const Params& p, unsigned char* lds) {
    constexpr int TILES = 4 * (BT / 256);
    const float* mod = (const float*)(p.ws + WS_MOD);
    for (int it = blockIdx.x; it < TILES; it += gridDim.x) {
        const int tid = get_tid(), lane = tid & 63, wave = tid >> 6, wp = wave >> 2, wq = wave & 3;
        const int tn = it & 3, tm = it >> 2;
        const int n0 = tn * 256, tok0 = tm * 256, b = tok0 >> 12;
        f32x4 acc[4][4];
#pragma unroll
        for (int i = 0; i < 4; ++i)
#pragma unroll
            for (int j = 0; j < 4; ++j) acc[i][j] = f32x4{0.f, 0.f, 0.f, 0.f};
        gemm_mainloop<4>(acc, RowLoader{(const bf16_t*)(p.ws + WS_WTO) + (size_t)n0 * DM, DM}, RowLoader{(const bf16_t*)(p.ws + WS_H) + (size_t)tok0 * DM, DM}, DM / 64, lds);
        const int l15 = lane & 15, lk = lane >> 4;
        constexpr int ES = 528;
        float ss[4] = {0.f, 0.f, 0.f, 0.f};
#pragma unroll
        for (int i = 0; i < 4; ++i) {
            const int n = n0 + wp * 64 + i * 16 + lk * 4;
            const f32x4 g1 = *(const f32x4*)(mod + b * 6144 + 2048 + n);
            const f32x4 s2 = *(const f32x4*)(mod + b * 6144 + 4096 + n), gf = *(const f32x4*)(p.in[I_NFFN] + n);
            const f32x4 gm = f32x4{gf[0] * (1.f + s2[0]), gf[1] * (1.f + s2[1]), gf[2] * (1.f + s2[2]), gf[3] * (1.f + s2[3])};
#pragma unroll
            for (int j = 0; j < 4; ++j) {
                const int tl = wq * 64 + j * 16 + l15;
                const f32x4 xv = *(const f32x4*)(p.in[I_X] + (size_t)(tok0 + tl) * DM + n);
                const f32x4 x1 = f32x4{xv[0] + g1[0] * acc[i][j][0], xv[1] + g1[1] * acc[i][j][1], xv[2] + g1[2] * acc[i][j][2], xv[3] + g1[3] * acc[i][j][3]};
                *(f32x4*)(p.out + (size_t)(tok0 + tl) * DM + n) = x1;
                ss[j] += x1[0] * x1[0] + x1[1] * x1[1] + x1[2] * x1[2] + x1[3] * x1[3];
                *(u32x2*)(lds + tl * ES + (wp * 64 + i * 16 + lk * 4) * 2) = u32x2{pk2(x1[0] * gm[0], x1[1] * gm[1]), pk2(x1[2] * gm[2], x1[3] * gm[3])};
            }
        }
#pragma unroll
        for (int j = 0; j < 4; ++j) {
            const float t = sum_x32(sum_x16(ss[j]));
            if (lk == 0) ((float*)(p.ws + WS_SSQ1))[(size_t)(tok0 + wq * 64 + j * 16 + l15) * 16 + tn * 4 + wp] = t;
        }
        __syncthreads();
        bf16_t* Y = (bf16_t*)(p.ws + WS_Y);
#pragma unroll
        for (int q = 0; q < 8; ++q) {
            const int idx = tid + q * NT, row = idx >> 5, ch = idx & 31;
            *(u32x4*)(Y + (size_t)(tok0 + row) * DM + n0 + ch * 8) = *(const u32x4*)(lds + row * ES + ch * 16);
        }
    }
}

DI void phase_h(const Params& p, unsigned char* lds) {
    constexpr int TILES = 8 * (BT / 256);
    float* rsb = (float*)(lds + 132 * 1024);
    for (int it = blockIdx.x; it < TILES; it += gridDim.x) {
        const int tid = get_tid(), lane = tid & 63, wave = tid >> 6, wp = wave >> 2, wq = wave & 3;
        const int tn = it & 7, tm = it >> 3;
        const int n0 = tn * 256, tok0 = tm * 256, b = tok0 >> 12;
        __syncthreads();
        if (tid < 256) {
            const float* sq = (const float*)(p.ws + WS_SSQ1) + (size_t)(tok0 + tid) * 16;
            const f32x4 a = *(const f32x4*)sq, c = *(const f32x4*)(sq + 4), d = *(const f32x4*)(sq + 8), e = *(const f32x4*)(sq + 12);
            const float ssq = (a[0] + a[1] + a[2] + a[3]) + (c[0] + c[1] + c[2] + c[3]) + (d[0] + d[1] + d[2] + d[3]) + (e[0] + e[1] + e[2] + e[3]);
            rsb[tid] = rsqrtf(ssq * (1.f / DM) + EPS);
        }
        f32x4 acc[4][4];
#pragma unroll
        for (int i = 0; i < 4; ++i)
#pragma unroll
            for (int j = 0; j < 4; ++j) acc[i][j] = f32x4{0.f, 0.f, 0.f, 0.f};
        gemm_mainloop<4>(acc, RowLoader{(const bf16_t*)(p.ws + WS_WTQ) + (size_t)n0 * DM, DM}, RowLoader{(const bf16_t*)(p.ws + WS_Y) + (size_t)tok0 * DM, DM}, DM / 64, lds);
        bf16_t* QP = (bf16_t*)(p.ws + WS_G);
        const float* shq = (const float*)(p.ws + WS_SHQ) + b * 2048;
        const int l15 = lane & 15, lk = lane >> 4;
#pragma unroll
        for (int i = 0; i < 4; ++i) {
            const int n = n0 + wp * 64 + i * 16 + lk * 4;
            const f32x4 sh = *(const f32x4*)(shq + n);
#pragma unroll
            for (int j = 0; j < 4; ++j) {
                const int tl = wq * 64 + j * 16 + l15;
                const float rs = rsb[tl];
                *(u32x2*)(QP + (size_t)(tok0 + tl) * 2048 + n) = u32x2{pk2(rs * acc[i][j][0] + sh[0], rs * acc[i][j][1] + sh[1]), pk2(rs * acc[i][j][2] + sh[2], rs * acc[i][j][3] + sh[3])};
            }
        }
    }
}

DI void ins16(float (&L)[16], float v) {
#pragma unroll
    for (int i = 0; i < 16; ++i) { const float hi = fmaxf(L[i], v); v = fminf(L[i], v); L[i] = hi; }
}
DI void cex_desc(float& a, float& b) { const float hi = fmaxf(a, b), lo = fminf(a, b); a = hi; b = lo; }
DI void bitonic_merge16_desc(float (&v)[16]) {
#pragma unroll
    for (int j = 8; j > 0; j >>= 1)
#pragma unroll
        for (int i = 0; i < 16; ++i) if ((i ^ j) > i) cex_desc(v[i], v[i ^ j]);
}
DI void sort16_desc(float (&v)[16]) {
#pragma unroll
    for (int k = 2; k <= 16; k <<= 1)
#pragma unroll
        for (int j = k >> 1; j > 0; j >>= 1)
#pragma unroll
            for (int i = 0; i < 16; ++i) {
                const int l = i ^ j;
                if (l > i) { if ((i & k) == 0) cex_desc(v[i], v[l]); else cex_desc(v[l], v[i]); }
            }
}
DI void top16_merge(float (&a)[16], const float (&b)[16]) {
#pragma unroll
    for (int i = 0; i < 16; ++i) a[i] = fmaxf(a[i], b[15 - i]);
    bitonic_merge16_desc(a);
}
DI float pack_idx(float v, unsigned idx, unsigned mask) { return __uint_as_float((__float_as_uint(v) & ~mask) | idx); }
constexpr int PI_LIST = 0;
DI void peer_select_item(const Params& p, int item, unsigned char* lds) {
    const int tok0 = item * 128;
    __syncthreads();
    {
        const int tid = get_tid(), lane = tid & 63, wave = tid >> 6, b = tok0 >> 12;
        const float* sh2 = (const float*)(p.ws + WS_MOD) + b * 6144 + 3072 + lane * 16;
        float sh[16];
#pragma unroll
        for (int i = 0; i < 16; i += 4) { const f32x4 v = *(const f32x4*)(sh2 + i); sh[i] = v[0]; sh[i + 1] = v[1]; sh[i + 2] = v[2]; sh[i + 3] = v[3]; }
#pragma unroll 1
        for (int t = 0; t < 8; ++t) {
            const int tok = tok0 + wave * 8 + t;
            const bf16_t* yr = (const bf16_t*)(p.ws + WS_Y) + (size_t)tok * DM + lane * 16;
            const u32x4 y0 = *(const u32x4*)yr, y1 = *(const u32x4*)(yr + 8);
            const float rs = rsqrtf(sum16(((const float*)(p.ws + WS_SSQ1))[(size_t)tok * 16 + (lane & 15)]) * (1.f / DM) + EPS);
            float f[16];
#pragma unroll
            for (int q = 0; q < 4; ++q) { f[2 * q] = bflo(y0[q]); f[2 * q + 1] = bfhi(y0[q]); f[8 + 2 * q] = bflo(y1[q]); f[9 + 2 * q] = bfhi(y1[q]); }
            float mx = 0.f;
#pragma unroll
            for (int i = 0; i < 16; ++i) { f[i] = rs * f[i] + sh[i]; mx = fmaxf(mx, fabsf(f[i])); }
            mx = fmaxf(wave_max(mx), 1e-30f);
            const float qs = 127.f / mx;
            unsigned w8[4];
            int qsum = 0;
#pragma unroll
            for (int q = 0; q < 4; ++q) {
                const int q0 = __float2int_rn(f[4 * q] * qs), q1 = __float2int_rn(f[4 * q + 1] * qs), q2 = __float2int_rn(f[4 * q + 2] * qs), q3 = __float2int_rn(f[4 * q + 3] * qs);
                w8[q] = (q0 & 255) | ((q1 & 255) << 8) | ((q2 & 255) << 16) | ((unsigned)q3 << 24);
                qsum += q0 + q1 + q2 + q3;
            }
            *(u32x4*)(p.ws + WS_X8 + (size_t)tok * DM + lane * 16) = u32x4{w8[0], w8[1], w8[2], w8[3]};
            const float xs = wave_sum((float)qsum);
            if (lane == 0) ((f32x2*)(p.ws + WS_SX))[tok] = f32x2{mx * (1.f / 127.f), xs};
        }
    }
    {
#pragma unroll 1
        for (int sb = 0; sb < 4; ++sb) {
            const int tid = get_tid(), lane = tid & 63, hp = tid >> 6;
            const int r = lane & 31, hf = lane >> 5;
            const bf16_t* keys = (const bf16_t*)(p.ws + WS_KEYS) + (size_t)((hp & 1) * 8 + (hp >> 1)) * 128 * 128 + 8 * hf;
            const bf16_t* qp = (const bf16_t*)(p.ws + WS_G) + (size_t)(tok0 + r) * 2048 + hp * 128 + 8 * hf;
            bf16x8 bq[8];
#pragma unroll
            for (int ks = 0; ks < 8; ++ks) bq[ks] = *(const bf16x8*)(qp + (size_t)sb * 32 * 2048 + 16 * ks);
            f32x16 acc[4];
#pragma unroll
            for (int m = 0; m < 4; ++m)
#pragma unroll
                for (int i = 0; i < 16; ++i) acc[m][i] = 0.f;
#pragma unroll
            for (int ks = 0; ks < 8; ++ks) {
#pragma unroll
                for (int m = 0; m < 4; ++m) {
                    const bf16x8 ak = *(const bf16x8*)(keys + (size_t)(m * 32 + r) * 128 + 16 * ks);
                    acc[m] = MFMA32(ak, bq[ks], acc[m]);
                }
            }
            float V[4][16];
#define PK_SORT(m) do { _Pragma("unroll") for (int i = 0; i < 16; ++i) V[m][i] = pack_idx(acc[m][i], (unsigned)((m) * 32 + (i & 3) + 8 * (i >> 2) + 4 * hf), 127u); sort16_desc(V[m]); } while (0)
            PK_SORT(0); PK_SORT(1); top16_merge(V[0], V[1]); __builtin_amdgcn_sched_barrier(0);
            PK_SORT(2); PK_SORT(3); top16_merge(V[2], V[3]); __builtin_amdgcn_sched_barrier(0);
            top16_merge(V[0], V[2]);
#undef PK_SORT
            float (&L)[16] = V[0];
            const int t3 = get_tid(), hf3 = (t3 >> 5) & 1, r3 = t3 & 31, hp3 = t3 >> 6;
            float P[16];
#pragma unroll
            for (int i = 0; i < 16; ++i) {
                auto sw = __builtin_amdgcn_permlane32_swap(__float_as_uint(L[i]), __float_as_uint(L[i]), false, false);
                P[i] = hf3 ? __uint_as_float(sw[0]) : __uint_as_float(sw[1]);
            }
            top16_merge(L, P);
            if (hf3 == 0) {
                float* dst = (float*)(lds + PI_LIST) + ((sb * 32 + r3) * 16 + hp3) * 16;
#pragma unroll
                for (int i = 0; i < 16; i += 4) *(f32x4*)(dst + i) = f32x4{L[i], L[i + 1], L[i + 2], L[i + 3]};
            }
        }
    }
    __syncthreads();
    {
        const int tid = get_tid();
        {
            const int tok = tid >> 3, h = tid & 7;
            const float* l1 = (const float*)(lds + PI_LIST) + (tok * 16 + 2 * h) * 16;
            const float* l2 = l1 + 16;
            float v1[16], v2[16];
#pragma unroll
            for (int i = 0; i < 16; i += 4) {
                const f32x4 a = *(const f32x4*)(l1 + i), b = *(const f32x4*)(l2 + i);
                v1[i] = a[0]; v1[i + 1] = a[1]; v1[i + 2] = a[2]; v1[i + 3] = a[3];
                v2[i] = b[0]; v2[i + 1] = b[1]; v2[i + 2] = b[2]; v2[i + 3] = b[3];
            }
            float B[16];
#pragma unroll
            for (int i = 0; i < 16; ++i) B[i] = -3.0e38f;
#pragma unroll
            for (int i = 0; i < 16; ++i)
#pragma unroll
                for (int j = 0; j < 16; ++j)
                    if ((i + 1) * (j + 1) <= 16) ins16(B, pack_idx(v1[i] + v2[j], (unsigned)(i * 16 + j), 255u));
            float e[16], sum = 0.f;
#pragma unroll
            for (int k = 0; k < 16; ++k) { e[k] = __expf(B[k] - B[0]); sum += e[k]; }
            const float inv = 1.f / sum;
            int* ex = (int*)(p.ws + WS_EXPI) + (size_t)(tok0 + tok) * 128 + h * 16;
            float* gt = (float*)(p.ws + WS_GATE) + ((size_t)(tok0 + tok) * 128 + h * 16) * 2;
            const float* usc = (const float*)(p.ws + WS_USC);
            int ev[16]; float gv[16], sv[16];
#pragma unroll
            for (int k = 0; k < 16; ++k) {
                const unsigned ij = __float_as_uint(B[k]) & 255u;
                const unsigned i1 = __float_as_uint(l1[ij >> 4]) & 127u, i2 = __float_as_uint(l2[ij & 15u]) & 127u;
                ev[k] = (int)(i1 * 128u + i2);
                gv[k] = e[k] * inv;
                sv[k] = usc[ev[k]];
            }
#pragma unroll
            for (int k = 0; k < 16; k += 4) *(u32x4*)(ex + k) = u32x4{(unsigned)ev[k], (unsigned)ev[k + 1], (unsigned)ev[k + 2], (unsigned)ev[k + 3]};
#pragma unroll
            for (int k = 0; k < 16; k += 2) *(f32x4*)(gt + 2 * k) = f32x4{gv[k], sv[k], gv[k + 1], sv[k + 1]};
        }
    }
}
DI void phase_i1(const Params& p, unsigned char* lds) {
    for (int it = blockIdx.x; it < BT / 128; it += gridDim.x) peer_select_item(p, it, lds);
}

DI float dot16_fp8(const u32x4& w, const float (&x)[16]) {
    float d = 0.f;
#pragma unroll
    for (int i = 0; i < 4; ++i) {
        const auto lo = __builtin_amdgcn_cvt_pk_f32_fp8((int)w[i], false);
        const auto hi = __builtin_amdgcn_cvt_pk_f32_fp8((int)w[i], true);
        d += lo[0] * x[4 * i] + lo[1] * x[4 * i + 1] + hi[0] * x[4 * i + 2] + hi[1] * x[4 * i + 3];
    }
    return d;
}
template<int NPART, class F> DI void run_partitioned(const Params& p, unsigned char* lds, int qbase, int nitems, F&& body) {
    unsigned* ctl = (unsigned*)(p.ws + WS_CTL);
    volatile LAS unsigned* slot = (volatile LAS unsigned*)(LAS unsigned char*)(lds + LDS_ST_OFF + 8);
    const int x0 = (int)(xb_xcc_id() & 7u);
#pragma unroll 1
    for (int pp = 0; pp < NPART; ++pp) {
        const int part = (NPART == 8) ? ((x0 + pp) & 7) : ((((x0 + (pp >> 1)) & 7)) + 8 * (pp & 1));
        for (;;) {
            __syncthreads();
            if (get_tid() == 0) slot[0] = atomicAdd(ctl + qbase + 64 * part, 1u);
            __syncthreads();
            const int it = __builtin_amdgcn_readfirstlane((int)slot[0]);
            if (it >= nitems) break;
            body(part, it);
        }
    }
}
constexpr int CTL_QUEUE_I2 = 8320, CTL_QUEUE_I3 = 9408;
constexpr int UW_BYTES = 5120, UW_GT = 2048, UW_LIST = 4096;
DI void peer_u_chunk(const Params& p, int part, int chunk, unsigned char* lds) {
    const int tid = get_tid(), lane = tid & 63, wave = __builtin_amdgcn_readfirstlane(tid >> 6);
    unsigned char* wl = lds + wave * UW_BYTES;
    unsigned* lst = (unsigned*)(wl + UW_LIST);
    const f32x2* gts = (const f32x2*)(wl + UW_GT);
    const int h = lane >> 5, l5 = lane & 31;
    const unsigned char* UT4 = p.ws + WS_UT + l5 * 16;
    const int tokw = chunk * 256 + wave * 2;
    int pe[4]; u32x4 ph[2]; f32x2 pg[4]; f32x2 psx[2];
#define U_PREFETCH(tok) do { \
        const int* ex_ = (const int*)(p.ws + WS_EXPI) + (size_t)(tok) * 128 + lane; \
        const f32x2* gt_ = (const f32x2*)(p.ws + WS_GATE) + (size_t)(tok) * 128 + lane; \
        const unsigned char* hr_ = p.ws + WS_X8 + (size_t)(tok) * DM + lane * 16; \
        pe[0] = ex_[0]; pe[1] = ex_[64]; pe[2] = ex_[128]; pe[3] = ex_[192]; \
        pg[0] = gt_[0]; pg[1] = gt_[64]; pg[2] = gt_[128]; pg[3] = gt_[192]; \
        ph[0] = *(const u32x4*)hr_; ph[1] = *(const u32x4*)(hr_ + DM); \
        psx[0] = ((const f32x2*)(p.ws + WS_SX))[tok]; psx[1] = ((const f32x2*)(p.ws + WS_SX))[(tok) + 1]; } while (0)
    U_PREFETCH(tokw);
#pragma unroll 1
    for (int sub = 0; sub < 8; ++sub) {
        const int tok0 = tokw + sub * 32;
        const f32x2 sx0 = psx[0], sx1 = psx[1];
        *(u32x4*)(wl + lane * 16) = ph[0]; *(u32x4*)(wl + 1024 + lane * 16) = ph[1];
        int cnt = 0;
#pragma unroll
        for (int g = 0; g < 4; ++g) {
            ((f32x2*)(wl + UW_GT))[g * 64 + lane] = pg[g];
            const bool m = (pe[g] >> 11) == part;
            const unsigned long long bm = __ballot(m);
            const int pos = cnt + __builtin_amdgcn_mbcnt_hi((unsigned)(bm >> 32), __builtin_amdgcn_mbcnt_lo((unsigned)bm, 0u));
            if (m) lst[pos] = ((unsigned)(g * 64 + lane) << 16) | (unsigned)pe[g];
            cnt += __popcll(bm);
        }
        if (sub + 1 < 8) U_PREFETCH(tok0 + 32);
#pragma unroll 1
        for (int base = 0; base < cnt; base += 16) {
            u32x4 row[8]; unsigned en[8];
#pragma unroll
            for (int q = 0; q < 8; ++q) {
                en[q] = lst[min(base + 2 * q + h, cnt - 1)];
                row[q] = *(const u32x4*)(UT4 + (size_t)(en[q] & 0x3fffu) * 512);
            }
            int d[8];
#pragma unroll
            for (int q = 0; q < 8; ++q) {
                const unsigned char* xr = wl + (en[q] >> 23) * 1024 + l5 * 32;
                const u32x4 xa = *(const u32x4*)xr, xb = *(const u32x4*)(xr + 16);
                int ai = 0;
#pragma unroll
                for (int i = 0; i < 4; ++i) {
                    const unsigned lo = row[q][i] & 0x0F0F0F0Fu, hi = (row[q][i] >> 4) & 0x0F0F0F0Fu;
                    ai = __builtin_amdgcn_sdot4((int)lo, (int)((i < 2) ? xa[2 * i] : xb[2 * i - 4]), ai, false);
                    ai = __builtin_amdgcn_sdot4((int)hi, (int)((i < 2) ? xa[2 * i + 1] : xb[2 * i - 3]), ai, false);
                }
                d[q] = ai;
            }
            int r4[4], r2[2];
#pragma unroll
            for (int i = 0; i < 4; ++i) { auto sw = __builtin_amdgcn_permlane16_swap((unsigned)d[i], (unsigned)d[i + 4], false, false); r4[i] = (int)(sw[0] + sw[1]); }
            const bool b3 = (lane & 8) != 0, b2 = (lane & 4) != 0;
#pragma unroll
            for (int i = 0; i < 2; ++i) r2[i] = (b3 ? r4[i + 2] : r4[i]) + dppi<0x128>(b3 ? r4[i] : r4[i + 2]);
            int ai = (b2 ? r2[1] : r2[0]) + dppi<0x141>(b2 ? r2[0] : r2[1]);
            ai += dppi<0xB1>(ai); ai += dppi<0x4E>(ai);
            const int qi = ((lane >> 2) & 7);
            const int ei = base + 2 * (4 * ((qi >> 2) & 1) + 2 * ((qi >> 1) & 1) + (qi & 1)) + h;
            const unsigned ent = lst[min(ei, cnt - 1)];
            const int idx = (int)(ent >> 16);
            const f32x2 gs = gts[idx];
            const f32x2 sxv = (idx >> 7) ? sx1 : sx0;
            const float a = ((float)ai - 8.f * sxv[1]) * (gs[1] * sxv[0]);
            const float y = 0.7978845608028654f * (a + 0.044715f * a * a * a);
            const float th = 1.f - 2.f / (__expf(2.f * y) + 1.f);
            const float w = 0.5f * a * (1.f + th) * gs[0];
            if ((lane & 3) == 0 && ei < cnt) ((u32x2*)(p.ws + WS_PAIRS))[(size_t)tok0 * 128 + idx] = u32x2{ent & 0x3fffu, __float_as_uint(w)};
        }
    }
#undef U_PREFETCH
}
DI void phase_i2(const Params& p, unsigned char* lds) {
    run_partitioned<8>(p, lds, CTL_QUEUE_I2, BT / 256, [&](int part, int it) { peer_u_chunk(p, part, it, lds); });
}
DI void peer_v_chunk(const Params& p, int part, int chunk, unsigned char* lds) {
    const int tid = get_tid(), lane = tid & 63, wave = __builtin_amdgcn_readfirstlane(tid >> 6);
    unsigned char* wl = lds + wave * 1024;
    const int es = lane >> 3, ch = lane & 7;
    const unsigned char* VT8 = p.ws + WS_VTAB + (size_t)part * 16384 * 128 + ch * 16;
    const float* mod = (const float*)(p.ws + WS_MOD);
    const int col = part * 128 + 16 * ch + 2 * es;
    const int tokw = chunk * 256 + wave;
    u32x4 pp = *((const u32x4*)(p.ws + WS_PAIRS + (size_t)tokw * 1024) + lane);
#pragma unroll 1
    for (int step = 0; step < 16; ++step) {
        const int tok = tokw + step * 16, b = tok >> 12;
        *(u32x4*)(wl + lane * 16) = pp;
        if (step + 1 < 16) pp = *((const u32x4*)(p.ws + WS_PAIRS + (size_t)(tok + 16) * 1024) + lane);
        float* xo = p.out + (size_t)tok * DM + col;
        const f32x2 x1 = *(const f32x2*)xo;
        const f32x2 g2 = *(const f32x2*)(mod + b * 6144 + 5120 + col);
        f32x2 acc[8];
#pragma unroll
        for (int i = 0; i < 8; ++i) acc[i] = f32x2{0.f, 0.f};
        const u32x2* pr = (const u32x2*)wl + es;
#pragma unroll 1
        for (int ih = 0; ih < 2; ++ih) {
            u32x2 pe[8]; u32x4 row[8];
#pragma unroll
            for (int q = 0; q < 8; ++q) { pe[q] = pr[(ih * 8 + q) * 8]; row[q] = *(const u32x4*)(VT8 + (size_t)pe[q][0] * 128); }
#pragma unroll
            for (int q = 0; q < 8; ++q) {
                const float w = __uint_as_float(pe[q][1]);
                const f32x2 w2 = f32x2{w, w};
#pragma unroll
                for (int i = 0; i < 4; ++i) {
                    const f32x2 lo = __builtin_amdgcn_cvt_pk_f32_fp8((int)row[q][i], false);
                    const f32x2 hi = __builtin_amdgcn_cvt_pk_f32_fp8((int)row[q][i], true);
                    acc[2 * i] += w2 * lo; acc[2 * i + 1] += w2 * hi;
                }
            }
        }
        float a16[16];
#pragma unroll
        for (int i = 0; i < 8; ++i) { a16[2 * i] = acc[i][0]; a16[2 * i + 1] = acc[i][1]; }
        float r8[8], r4[4], r2[2];
#pragma unroll
        for (int i = 0; i < 8; ++i) { auto sw = __builtin_amdgcn_permlane32_swap(__float_as_uint(a16[i]), __float_as_uint(a16[i + 8]), false, false); r8[i] = __uint_as_float(sw[0]) + __uint_as_float(sw[1]); }
#pragma unroll
        for (int i = 0; i < 4; ++i) { auto sw = __builtin_amdgcn_permlane16_swap(__float_as_uint(r8[i]), __float_as_uint(r8[i + 4]), false, false); r4[i] = __uint_as_float(sw[0]) + __uint_as_float(sw[1]); }
        const bool b3 = (lane & 8) != 0;
#pragma unroll
        for (int i = 0; i < 2; ++i) { const float keep = b3 ? r4[i + 2] : r4[i], send = b3 ? r4[i] : r4[i + 2]; r2[i] = keep + dppf<0x128>(send); }
        const float xa = x1[0] + g2[0] * r2[0] * (1.f / VSCALE), xb = x1[1] + g2[1] * r2[1] * (1.f / VSCALE);
        *(f32x2*)xo = f32x2{xa, xb};
        const float ss = wave_sum(xa * xa + xb * xb);
        if (lane == 0) ((float*)(p.ws + WS_SSQ))[(size_t)tok * 8 + part] = ss;
    }
}
DI void phase_i3(const Params& p, unsigned char* lds) {
    run_partitioned<8>(p, lds, CTL_QUEUE_I3, BT / 256, [&](int part, int it) { peer_v_chunk(p, part, it, lds); });
}
DI void phase_i4(const Params& p) {
    const bool bad = xb_ld((unsigned*)(p.ws + WS_CTL) + CTL_BADTID) != 0u || xb_ld((unsigned*)(p.ws + WS_CTL) + XB_TMO) != 0u;
    for (int it = blockIdx.x; it < BT / 16; it += gridDim.x) {
        const int tid = get_tid(), lane = tid & 63, row = it * 16 + (tid >> 6);
        const float* sq = (const float*)(p.ws + WS_SSQ) + (size_t)row * 8;
        const f32x4 s0 = *(const f32x4*)sq, s1 = *(const f32x4*)(sq + 4);
        const float ss = s0[0] + s0[1] + s0[2] + s0[3] + s1[0] + s1[1] + s1[2] + s1[3];
        float rs = rsqrtf(ss * (1.f / DM) + EPS);
        if (bad) rs = __builtin_nanf("");
        float* o = p.out + (size_t)row * DM;
#pragma unroll
        for (int j = 0; j < 4; ++j) {
            const int c = j * 256 + lane * 4;
            const f32x4 v = *(const f32x4*)(o + c), g = *(const f32x4*)(p.in[I_FNG] + c);
            *(f32x4*)(o + c) = f32x4{v[0] * rs * g[0], v[1] * rs * g[1], v[2] * rs * g[2], v[3] * rs * g[3]};
        }
    }
}

__global__ void __launch_bounds__(NT) mega(Params p) {
    unsigned char* lds = g_lds;
    volatile LAS unsigned* st = (volatile LAS unsigned*)(LAS unsigned char*)(lds + LDS_ST_OFF);
    {
        const unsigned hw = __builtin_amdgcn_s_getreg((5 << 11) | 4);
        if ((threadIdx.x & 63) == 0) g_lds[LDS_WTAB_OFF + hw] = (unsigned char)(threadIdx.x >> 6);
        if (threadIdx.x < 2) st[threadIdx.x] = 0u;
        __syncthreads();
        if (get_tid() != (int)threadIdx.x) ((unsigned*)(p.ws + WS_CTL))[CTL_BADTID] = 1u;
    }
    XcdBarrier bar = xcd_barrier_post((unsigned*)(p.ws + WS_CTL), st);
    float* sm = (float*)lds;

#define STAMP(k, which) do { if (PROBE_PHASE == (k) && blockIdx.x == 0 && get_tid() == 0) ((volatile unsigned long long*)(lds + LDS_PROBE_OFF))[which] = __builtin_amdgcn_s_memrealtime(); } while (0)
    STAMP(21, 0); STAMP(30, 0); STAMP(31, 0);
    STAMP(0, 0); phase_a(p, sm);   xcd_barrier(bar); STAMP(0, 1);
    STAMP(1, 0); phase_b(p, sm);   xcd_barrier(bar); STAMP(1, 1);
    if (PROBE_PHASE == 20) { STAMP(20, 0); xcd_barrier(bar); xcd_barrier(bar); xcd_barrier(bar); xcd_barrier(bar); STAMP(20, 1); }
    STAMP(2, 0); phase_c(p, lds);  xcd_barrier(bar); STAMP(2, 1);
    STAMP(3, 0); phase_d(p, lds);  xcd_barrier(bar); STAMP(3, 1);
    STAMP(4, 0); phase_d2(p, lds); xcd_barrier(bar); STAMP(4, 1);
    STAMP(5, 0); phase_e(p, lds);  xcd_barrier(bar); STAMP(5, 1);
    STAMP(6, 0); phase_f(p, lds);  xcd_barrier(bar); STAMP(6, 1);
    STAMP(8, 0); phase_h(p, lds);  xcd_barrier(bar); STAMP(8, 1);
    STAMP(9, 0); phase_i1(p, lds); xcd_barrier(bar); STAMP(9, 1);
    STAMP(10, 0); phase_i2(p, lds); xcd_barrier(bar); STAMP(10, 1);
    STAMP(11, 0); phase_i3(p, lds); xcd_barrier(bar); STAMP(11, 1);
    STAMP(12, 0); phase_i4(p);
    if (PROBE_PHASE >= 0) {
        xcd_barrier(bar); STAMP(12, 1); STAMP(21, 1);
        if (blockIdx.x == 0 && get_tid() == 0) {
            volatile unsigned long long* ts = (volatile unsigned long long*)(lds + LDS_PROBE_OFF);
            p.out[0] += (float)(ts[1] - ts[0]) * (0.01f / PROBE_SCALE);
        }
    }
}

extern "C" void kernel_launch(void* const* d_in, const int* in_sizes, int n_in, void* d_out, int out_size, void* d_ws, size_t ws_size, hipStream_t stream) {
    static int grid = 0;
    if (grid == 0) {
        int dev = 0, cus = 0;
        if (hipGetDevice(&dev) != hipSuccess || hipDeviceGetAttribute(&cus, hipDeviceAttributeMultiprocessorCount, dev) != hipSuccess) { fprintf(stderr, "kernel_launch: device query failed\n"); grid = -1; return; }
        if (n_in != N_IN || ws_size < WS_END) { fprintf(stderr, "kernel_launch: unexpected n_in %d or ws_size %zu (< %zu)\n", n_in, ws_size, (size_t)WS_END); grid = -1; return; }
        grid = cus;
    }
    if (grid < 0) return;
    (void)hipMemsetAsync((char*)d_ws + WS_CTL, 0, 64 * 1024, stream);
    Params p{};
    for (int i = 0; i < N_IN; ++i) p.in[i] = (const float*)d_in[i];
    p.out = (float*)d_out; p.ws = (unsigned char*)d_ws;
    hipLaunchKernelGGL(mega, dim3(grid), dim3(NT), 0, stream, p);
}
```

```cpp
#include <hip/hip_runtime.h>
#include <stdint.h>
#include <cstdio>

#define DI __device__ __forceinline__
#define LAS __attribute__((address_space(3)))
typedef unsigned short bf16_t;
typedef short bf16x8 __attribute__((ext_vector_type(8)));
typedef short s16x4 __attribute__((ext_vector_type(4)));
typedef float f32x4 __attribute__((ext_vector_type(4)));
typedef float f32x2 __attribute__((ext_vector_type(2)));
typedef float f32x16 __attribute__((ext_vector_type(16)));
typedef unsigned u32x4 __attribute__((ext_vector_type(4)));
typedef unsigned u32x2 __attribute__((ext_vector_type(2)));

#ifndef PROBE_PHASE
#define PROBE_PHASE (-1)
#endif
#ifndef SHADOW
#define SHADOW 0
#endif
#ifndef PROBE_SCALE
#define PROBE_SCALE 100.f
#endif
constexpr int BATCH = 8, SEQ = 4096, DM = 1024, BT = BATCH * SEQ;
constexpr int CTX = 256, TK = SEQ + CTX;
constexpr int NH = 8, NKV = 2, HD = 64;
constexpr int QD = 512, KVD = 128, HYD = 512, HYC = 1536, GC = 2048, INC = 4352;
constexpr int PH = 8, PNK = 128, PDK = 256, PTOP = 16;
constexpr float EPS = 1e-6f;
constexpr int NT = 1024;

enum { I_X = 0, I_C, I_CTX, I_CCTX, I_ADAW, I_ADAB, I_NMIX, I_NFFN, I_WIN, I_QNG, I_KNG, I_HCW, I_HCB,
       I_HW1, I_HB1, I_HW2, I_HB2, I_HW3, I_HB3, I_HW4, I_HFREQ, I_HSKIP, I_WAO, I_WHO, I_WO, I_PWQ, I_PK1, I_PK2, I_PU, I_PV, I_FNG, N_IN };

constexpr size_t MB = 1024 * 1024;
constexpr size_t WS_CTL   = 0;
constexpr size_t WS_MOD   = 64 * 1024;
constexpr size_t WS_ROPE  = WS_MOD + 9 * 6144 * 4;
static_assert(WS_ROPE + 16 * 1024 + 8 * 2048 * 4 + 4096 <= 512 * 1024, "ws");
constexpr size_t WS_PART  = 512 * 1024;
constexpr size_t WS_WTIN  = 3 * MB;
constexpr size_t WS_WTAO  = WS_WTIN + (size_t)INC * DM * 2;
constexpr size_t WS_WTHO  = WS_WTAO + (size_t)DM * QD * 2;
constexpr size_t WS_WTO   = WS_WTHO + (size_t)DM * HYD * 2;
constexpr size_t WS_WTQ   = WS_WTO + (size_t)DM * DM * 2;
constexpr size_t WS_KEYS  = WS_WTQ + (size_t)2048 * DM * 2;
constexpr size_t WS_R     = WS_KEYS + (size_t)2 * 8 * 128 * 128 * 2;
constexpr size_t WS_KB    = WS_R + (size_t)2 * 512 * 8192 * 2;
constexpr size_t WS_VT    = WS_KB + (size_t)BATCH * NKV * TK * HD * 2;
constexpr size_t WS_HC    = WS_VT + (size_t)BATCH * NKV * TK * HD * 2;
constexpr size_t WS_H     = 60 * MB;
constexpr size_t WS_G     = WS_H + 64 * MB;
constexpr size_t WS_ZT    = WS_G + 128 * MB;
constexpr size_t WS_Q     = WS_ZT + 96 * MB;
constexpr size_t WS_ATT   = WS_Q + 32 * MB;
constexpr size_t WS_HYT   = WS_ATT + 32 * MB;
constexpr size_t WS_TAB   = WS_HYT + 32 * MB;
constexpr size_t WS_END   = WS_TAB + 32 * MB;
static_assert(WS_HC + (size_t)2048 * DM * 2 <= WS_H, "ws overlap");
constexpr size_t WS_FRAW  = WS_ATT;
constexpr size_t WS_HY    = WS_Q;
constexpr size_t WS_UT    = WS_TAB;
constexpr size_t WS_VTAB  = WS_TAB + 16 * MB;
constexpr size_t WS_EXPI  = WS_ATT;
constexpr size_t WS_GATE  = WS_Q;
constexpr size_t WS_PAIRS = WS_HYT;
constexpr size_t WS_SSQ   = WS_PART + 1 * MB;
constexpr size_t WS_USC   = WS_PART + 2 * MB;
constexpr size_t WS_Y     = WS_ZT;
constexpr size_t WS_X8    = WS_ZT + 64 * MB;
constexpr size_t WS_SSQ1  = WS_ATT + 16 * MB;
constexpr size_t WS_SX    = WS_PART + 2 * MB + 64 * 1024;
constexpr size_t WS_SHQ   = WS_ROPE + 16 * 1024;
constexpr size_t WS_FSC   = WS_SHQ + 64 * 1024;
constexpr float VSCALE = 64.f;

constexpr int CTL_BADTID = 8000;
DI unsigned f2bf(float f) { unsigned u = __builtin_bit_cast(unsigned, f); return (u + 0x7fffu + ((u >> 16) & 1u)) >> 16; }
DI unsigned pk2(float lo, float hi) { return f2bf(lo) | (f2bf(hi) << 16); }
DI float bf2f(unsigned short b) { return __builtin_bit_cast(float, (unsigned)b << 16); }
DI float bflo(unsigned u) { return __builtin_bit_cast(float, u << 16); }
DI float bfhi(unsigned u) { return __builtin_bit_cast(float, u & 0xffff0000u); }
DI float red2pi(float x) { const float k = rintf(x * 0.15915494309189535f); float r = fmaf(-k, 6.2831854820251465f, x); return fmaf(-k, -1.7484555e-7f, r); }
DI float fsin(float x) { return __sinf(red2pi(x)); }
DI float fcos(float x) { return __cosf(red2pi(x)); }
constexpr int LDS_BYTES = 160 * 1024;
constexpr int LDS_ST_OFF = LDS_BYTES - 16;
constexpr int LDS_PROBE_OFF = LDS_BYTES - 16 - 32;
constexpr int LDS_WTAB_OFF = LDS_BYTES - 16 - 32 - 64;
constexpr int LDS_USER = LDS_WTAB_OFF;
__shared__ __attribute__((aligned(16))) unsigned char g_lds[LDS_BYTES];
DI s16x4 lds_rd64(const unsigned char* ptr) { return *(const volatile LAS s16x4*)(const LAS unsigned char*)ptr; }
DI int get_tid() {
    const unsigned hw = __builtin_amdgcn_s_getreg((5 << 11) | 4);
    unsigned w = g_lds[LDS_WTAB_OFF + hw];
    w = __builtin_amdgcn_readfirstlane(w);
    int t;
    asm volatile("v_mbcnt_lo_u32_b32 %0, -1, 0\n\tv_mbcnt_hi_u32_b32 %0, -1, %0\n\tv_lshl_or_b32 %0, %1, 6, %0" : "=&v"(t) : "s"(w));
    return t;
}
template<int CTRL> DI float dppf(float v) { return __uint_as_float(__builtin_amdgcn_update_dpp(0u, __float_as_uint(v), CTRL, 0xF, 0xF, true)); }
template<int CTRL> DI int dppi(int v) { return (int)__builtin_amdgcn_update_dpp(0u, (unsigned)v, CTRL, 0xF, 0xF, true); }
DI float sum16(float v) { v += dppf<0xB1>(v); v += dppf<0x4E>(v); v += dppf<0x141>(v); v += dppf<0x140>(v); return v; }
DI float sum_x16(float v) { auto r = __builtin_amdgcn_permlane16_swap(__float_as_uint(v), __float_as_uint(v), false, false); return __uint_as_float(r[0]) + __uint_as_float(r[1]); }
DI float sum_x32(float v) { auto r = __builtin_amdgcn_permlane32_swap(__float_as_uint(v), __float_as_uint(v), false, false); return __uint_as_float(r[0]) + __uint_as_float(r[1]); }
DI float max_x32(float v) { auto r = __builtin_amdgcn_permlane32_swap(__float_as_uint(v), __float_as_uint(v), false, false); return fmaxf(__uint_as_float(r[0]), __uint_as_float(r[1])); }
DI float wave_sum(float v) { return sum_x32(sum_x16(sum16(v))); }
DI float wave_max(float v) {
    v = fmaxf(v, dppf<0xB1>(v)); v = fmaxf(v, dppf<0x4E>(v)); v = fmaxf(v, dppf<0x141>(v)); v = fmaxf(v, dppf<0x140>(v));
    { auto r = __builtin_amdgcn_permlane16_swap(__float_as_uint(v), __float_as_uint(v), false, false); v = fmaxf(__uint_as_float(r[0]), __uint_as_float(r[1])); }
    { auto r = __builtin_amdgcn_permlane32_swap(__float_as_uint(v), __float_as_uint(v), false, false); v = fmaxf(__uint_as_float(r[0]), __uint_as_float(r[1])); }
    return v;
}


#define XB_TMO      128
#define XB_XCNT(j)  (256  + 64 * (j))
#define XB_XSUB(j)  (1280 + 64 * (j))
#define XB_XGEN(j)  (2304 + 64 * (j))
#define XB_TOP      3328
#define XB_TOPGEN   3392
#define XCD_BAR_WORDS 3456
#define XB_SPIN_CAP (1u << 27)
DI unsigned xb_ld(unsigned* p)              { return __hip_atomic_load(p, __ATOMIC_RELAXED, __HIP_MEMORY_SCOPE_AGENT); }
DI unsigned xb_add(unsigned* p, unsigned v) { return __hip_atomic_fetch_add(p, v, __ATOMIC_RELAXED, __HIP_MEMORY_SCOPE_AGENT); }
DI unsigned xb_xcc_id() { return (unsigned)__builtin_amdgcn_s_getreg((3 << 11) | 20) & 0xFu; }
#define XB_SPIN(cond, bar) do { unsigned _sp = 0; while (cond) { __builtin_amdgcn_s_sleep(1); \
    if ((++_sp & 255u) == 0u) { if (xb_ld(&(bar)[XB_TMO])) break; if (_sp > XB_SPIN_CAP) { atomicAdd(&(bar)[XB_TMO], 1u); break; } } } } while (0)
struct XcdBarrier { unsigned* bar; unsigned x; volatile LAS unsigned* st; };
DI XcdBarrier xcd_barrier_post(unsigned* bar, volatile LAS unsigned* st) {
    XcdBarrier b; b.bar = bar; b.x = xb_xcc_id(); b.st = st;
    if (get_tid() == 0) (void)xb_add(&bar[XB_XCNT(b.x)], 1u);
    return b;
}
DI void xcd_barrier_complete(unsigned* bar, unsigned x, unsigned& nloc, unsigned& nx) {
    const unsigned G = gridDim.x * gridDim.y * gridDim.z;
    unsigned sum, cnt, mine, sp = 0u;
    for (;;) {
        sum = 0u; cnt = 0u; mine = 0u;
#pragma unroll
        for (unsigned j = 0; j < 16; ++j) { const unsigned c = xb_ld(&bar[XB_XCNT(j)]); sum += c; cnt += (c > 0u) ? 1u : 0u; mine = (j == x) ? c : mine; }
        if (sum == G) break;
        __builtin_amdgcn_s_sleep(1);
        if ((++sp & 255u) == 0u) { if (xb_ld(&bar[XB_TMO])) break; if (sp > XB_SPIN_CAP) { atomicAdd(&bar[XB_TMO], 1u); break; } }
    }
    nloc = mine > 0u ? mine : 1u; nx = cnt > 0u ? cnt : 1u;
}
DI void xcd_barrier(const XcdBarrier& b) {
    asm volatile("s_waitcnt vmcnt(0)" ::: "memory");
    __syncthreads();
    if (get_tid() == 0) {
        unsigned* bar = b.bar;
        __builtin_amdgcn_s_waitcnt(0);
        unsigned nloc = b.st[0], nx = b.st[1];
        if (nloc == 0u) { xcd_barrier_complete(bar, b.x, nloc, nx); b.st[0] = nloc; b.st[1] = nx; }
        const unsigned old = xb_add(&bar[XB_XSUB(b.x)], 1u);
        const unsigned gen = old / nloc;
        if (old + 1u == (gen + 1u) * nloc) {
            __builtin_amdgcn_fence(__ATOMIC_RELEASE, "agent");
            asm volatile("s_waitcnt vmcnt(0)" ::: "memory");
            const unsigned og = xb_add(&bar[XB_TOP], 1u);
            const unsigned tg = og / nx;
            if (og + 1u == (tg + 1u) * nx) xb_add(&bar[XB_TOPGEN], 1u);
            else XB_SPIN(xb_ld(&bar[XB_TOPGEN]) == tg, bar);
            __builtin_amdgcn_fence(__ATOMIC_ACQUIRE, "agent");
            xb_add(&bar[XB_XGEN(b.x)], 1u);
            asm volatile("s_waitcnt vmcnt(0)" ::: "memory");
        } else {
            XB_SPIN(xb_ld(&bar[XB_XGEN(b.x)]) == gen, bar);
            __builtin_amdgcn_fence(__ATOMIC_ACQUIRE, "agent");
            asm volatile("s_waitcnt vmcnt(0)" ::: "memory");
        }
    }
    __syncthreads();
}

struct Params { const float* in[N_IN]; float* out; unsigned char* ws; };


DI void transpose_tile(const float* __restrict__ W, int K, int N, bf16_t* __restrict__ Wt, int tile, float* sm) {
    const int tid = get_tid();
    const int ntn = N / 256, tk = tile / ntn, tn = tile % ntn;
    __syncthreads();
#pragma unroll
    for (int i = 0; i < 4; ++i) {
        const int idx = tid + i * NT, kk = idx >> 6, n4 = (idx & 63) * 4;
        const f32x4 v = *(const f32x4*)(W + (size_t)(tk * 64 + kk) * N + tn * 256 + n4);
        float* d = sm + kk * 257 + n4;
        d[0] = v[0]; d[1] = v[1]; d[2] = v[2]; d[3] = v[3];
    }
    __syncthreads();
#pragma unroll
    for (int i = 0; i < 2; ++i) {
        const int idx = tid + i * NT, nn = idx & 255, kg = idx >> 8;
        const float* c = sm + kg * 8 * 257 + nn;
        *(u32x4*)(Wt + (size_t)(tn * 256 + nn) * K + tk * 64 + kg * 8) = u32x4{pk2(c[0], c[257]), pk2(c[2 * 257], c[3 * 257]), pk2(c[4 * 257], c[5 * 257]), pk2(c[6 * 257], c[7 * 257])};
    }
}

DI void mod_item(const Params& p, int item, float* sm) {
    const int tid = get_tid();
    float* sc = sm;
    float* red = sm + 9 * 1024;
    __syncthreads();
    for (int i = tid; i < 9 * 1024; i += NT) {
        const float v = (i < 8 * 1024) ? p.in[I_C][i] : p.in[I_CCTX][i - 8 * 1024];
        sc[i] = v / (1.f + __expf(-v));
    }
    __syncthreads();
    const int col = tid & 15, kg = tid >> 4, n0 = item * 16;
    float acc[9];
#pragma unroll
    for (int r = 0; r < 9; ++r) acc[r] = 0.f;
    const float* w = p.in[I_ADAW] + (size_t)kg * 16 * 6144 + n0 + col;
    float wv[16];
#pragma unroll
    for (int k = 0; k < 16; ++k) wv[k] = w[(size_t)k * 6144];
#pragma unroll
    for (int k = 0; k < 16; ++k)
#pragma unroll
        for (int r = 0; r < 9; ++r) acc[r] += sc[r * 1024 + kg * 16 + k] * wv[k];
#pragma unroll
    for (int r = 0; r < 9; ++r) red[(kg * 9 + r) * 16 + col] = acc[r];
    __syncthreads();
    if (tid < 9 * 16) {
        const int r = tid >> 4, c2 = tid & 15;
        float s = p.in[I_ADAB][n0 + c2];
        for (int g = 0; g < 64; ++g) s += red[(g * 9 + r) * 16 + c2];
        ((float*)(p.ws + WS_MOD))[r * 6144 + n0 + c2] = s;
    }
    __syncthreads();
}

DI void filter_item(const Params& p, int item, float* sm) {
    const int tid = get_tid();
    float* z  = sm;
    float* ha = sm + 16 * 36;
    float* hb = ha + 16 * 64;
    const int t0 = item * 16;
    float* w1s = hb + 16 * 64;
    float* w2s = w1s + 33 * 64;
    float* w3s = w2s + 64 * 64;
    __syncthreads();
    {
        const f32x4 a2 = *(const f32x4*)(p.in[I_HW2] + tid * 4), a3 = *(const f32x4*)(p.in[I_HW3] + tid * 4);
        f32x4 a1 = f32x4{0.f, 0.f, 0.f, 0.f};
        if (tid < 33 * 16) a1 = *(const f32x4*)(p.in[I_HW1] + tid * 4);
        *(f32x4*)(w2s + tid * 4) = a2; *(f32x4*)(w3s + tid * 4) = a3;
        if (tid < 33 * 16) *(f32x4*)(w1s + tid * 4) = a1;
    }
    if (tid < 16 * 33) {
        const int pp = tid / 33, i = tid % 33;
        const int t = t0 + pp;
        float v;
        if (i == 0) v = (float)t / (float)(SEQ - 1);
        else {
            const int fi = (i - 1) & 15;
            const float f = 1e-4f + (float)fi * ((15.f - 1e-4f) / 15.f);
            const float w = 6.283185307179586f * (float)t / (float)SEQ;
            const float a = f * w;
            v = (i <= 16) ? fcos(a) : -fsin(a);
        }
        z[pp * 36 + i] = v;
    }
    __syncthreads();
    const int pp = tid >> 6, j = tid & 63;
    const float fr = p.in[I_HFREQ][j];
    {
        float a = p.in[I_HB1][j];
#pragma unroll 11
        for (int i = 0; i < 33; ++i) a += z[pp * 36 + i] * w1s[i * 64 + j];
        ha[pp * 64 + j] = fsin(fr * a);
    }
    __syncthreads();
    {
        float a = p.in[I_HB2][j];
#pragma unroll 16
        for (int i = 0; i < 64; ++i) a += ha[pp * 64 + i] * w2s[i * 64 + j];
        hb[pp * 64 + j] = fsin(fr * a);
    }
    __syncthreads();
    {
        float a = p.in[I_HB3][j];
#pragma unroll 16
        for (int i = 0; i < 64; ++i) a += hb[pp * 64 + i] * w3s[i * 64 + j];
        __syncthreads();
        ha[pp * 64 + j] = fsin(fr * a);
    }
    __syncthreads();
    float* fraw = (float*)(p.ws + WS_FRAW);
    float* part = (float*)(p.ws + WS_PART);
    const float* w4 = p.in[I_HW4];
    {
        const int lane = tid & 63, wave = tid >> 6, l15 = lane & 15, lk = lane >> 4;
        float af[16];
#pragma unroll
        for (int ks = 0; ks < 16; ++ks) af[ks] = ha[l15 * 64 + ks * 4 + lk];
#pragma unroll 1
        for (int nt = 0; nt < 8; ++nt) {
            const int col = (wave * 8 + nt) * 16 + l15;
            f32x4 acc = f32x4{0.f, 0.f, 0.f, 0.f};
#pragma unroll
            for (int ks = 0; ks < 16; ++ks) acc = __builtin_amdgcn_mfma_f32_16x16x4f32(af[ks], w4[(size_t)(ks * 4 + lk) * 2048 + col], acc, 0, 0, 0);
            const int c = col & 511, dir = (col >> 9) & 1;
            const float mind = -3.0701134573253945f, maxd = -15.350567286626973f;
            const float delta = fabsf(mind + (float)c * ((maxd - mind) / 511.f));
            float sabs = 0.f, v[4];
#pragma unroll
            for (int r = 0; r < 4; ++r) {
                const int t = t0 + 4 * lk + r;
                const float t01 = (float)t / (float)(SEQ - 1);
                v[r] = acc[r] * expf(-t01 * delta);
                if (!(dir == 1 && t == 0)) sabs += fabsf(v[r]);
            }
            *(f32x4*)(fraw + (size_t)col * SEQ + t0 + 4 * lk) = f32x4{v[0], v[1], v[2], v[3]};
            sabs = sum_x32(sum_x16(sabs));
            if (lk == 0) part[item * 2048 + col] = sabs;
        }
    }
    __syncthreads();
}

DI void phase_a(const Params& p, float* sm) {
    constexpr int T_WIN = 16 * 17, T_AO = 8 * 4, T_HO = 8 * 4, T_WO = 16 * 4, T_WQ = 16 * 8;
    constexpr int E0 = T_WIN, E1 = E0 + T_AO, E2 = E1 + T_HO, E3 = E2 + T_WO, E4 = E3 + T_WQ;
    constexpr int E5 = E4 + 64;
    constexpr int E6 = E5 + 384;
    constexpr int E7 = E6 + 1;
    constexpr int E8 = E7 + 256;
    for (int it = blockIdx.x; it < E8; it += gridDim.x) {
        int item = it;
        if (item < 256) { filter_item(p, item, sm); if (PROBE_PHASE == 30 && blockIdx.x == 0 && get_tid() == 0) ((volatile unsigned long long*)(g_lds + LDS_PROBE_OFF))[1] = __builtin_amdgcn_s_memrealtime(); continue; }
        item -= 256;
        if (item < 384) { mod_item(p, item, sm); if (PROBE_PHASE == 31 && blockIdx.x == 0 && get_tid() == 0) ((volatile unsigned long long*)(g_lds + LDS_PROBE_OFF))[1] = __builtin_amdgcn_s_memrealtime(); continue; }
        item -= 384;
        if (item < 1) {
            const int tid = get_tid();
            float* rope = (float*)(p.ws + WS_ROPE);
            const int pos = tid >> 4, f = tid & 15;
            const float inv = powf(10000.f, -(float)(2 * f) / 32.f);
            const float ang = (float)pos * inv;
            rope[tid] = fcos(ang); rope[1024 + tid] = fsin(ang);
            continue;
        }
        item -= 1;
        if (item < 64) {
            const int tid = get_tid();
            const float* src = (item < 32) ? p.in[I_PK1] : p.in[I_PK2];
            bf16_t* dst = (bf16_t*)(p.ws + WS_KEYS) + (size_t)item * 4096;
            const f32x4 v = *(const f32x4*)(src + (size_t)(item & 31) * 4096 + tid * 4);
            *(u32x2*)(dst + tid * 4) = u32x2{pk2(v[0], v[1]), pk2(v[2], v[3])};
            continue;
        }
        item -= 64;
        if (item < T_WIN) { transpose_tile(p.in[I_WIN], DM, INC, (bf16_t*)(p.ws + WS_WTIN), item, sm); continue; }
        item -= T_WIN;
        if (item < T_AO) { transpose_tile(p.in[I_WAO], QD, DM, (bf16_t*)(p.ws + WS_WTAO), item, sm); continue; }
        item -= T_AO;
        if (item < T_HO) { transpose_tile(p.in[I_WHO], HYD, DM, (bf16_t*)(p.ws + WS_WTHO), item, sm); continue; }
        item -= T_HO;
        if (item < T_WO) { transpose_tile(p.in[I_WO], DM, DM, (bf16_t*)(p.ws + WS_WTO), item, sm); continue; }
        item -= T_WO;
        transpose_tile(p.in[I_PWQ], DM, 2048, (bf16_t*)(p.ws + WS_WTQ), item, sm);
    }
    (void)E1; (void)E2; (void)E3; (void)E4; (void)E5; (void)E6; (void)E7;
}

DI void norm_mod_row(const float* __restrict__ src, const float* __restrict__ g, const float* __restrict__ shift, const float* __restrict__ scale, bf16_t* __restrict__ dst) {
    const int lane = get_tid() & 63;
    f32x4 v[4];
    float ss = 0.f;
#pragma unroll
    for (int j = 0; j < 4; ++j) { v[j] = *(const f32x4*)(src + j * 256 + lane * 4); ss += v[j][0] * v[j][0] + v[j][1] * v[j][1] + v[j][2] * v[j][2] + v[j][3] * v[j][3]; }
    ss = wave_sum(ss);
    const float rs = rsqrtf(ss * (1.f / DM) + EPS);
#pragma unroll
    for (int j = 0; j < 4; ++j) {
        const int c = j * 256 + lane * 4;
        const f32x4 gg = *(const f32x4*)(g + c), sh = *(const f32x4*)(shift + c), sc = *(const f32x4*)(scale + c);
        float o[4];
#pragma unroll
        for (int e = 0; e < 4; ++e) o[e] = v[j][e] * rs * gg[e] * (1.f + sc[e]) + sh[e];
        *(u32x2*)(dst + c) = u32x2{pk2(o[0], o[1]), pk2(o[2], o[3])};
    }
}

DI void filter_norm_item(const Params& p, int item, float* sm) {
    const int tid = get_tid();
    const int o = item >> 9, c = item & 511;
    const int colf = o * 1024 + c, colb = colf + 512;
    const float* part = (const float*)(p.ws + WS_PART);
    const float* fraw = (const float*)(p.ws + WS_FRAW);
    float v[8], mx = 0.f;
#pragma unroll
    for (int i = 0; i < 8; ++i) {
        const int n = tid * 8 + i;
        v[i] = (n == 0) ? 0.f : (n <= 4096 ? fraw[(size_t)colf * SEQ + 4096 - n] : fraw[(size_t)colb * SEQ + n - 4096]);
        mx = fmaxf(mx, fabsf(v[i]));
    }
    float sacc = 0.f;
    if (tid < 512) sacc = part[(tid & 255) * 2048 + ((tid < 256) ? colf : colb)];
    sacc = wave_sum(sacc); mx = wave_max(mx);
    __syncthreads();
    if ((tid & 63) == 0) { sm[tid >> 6] = sacc; sm[16 + (tid >> 6)] = mx; }
    __syncthreads();
    float tot = EPS, gmx = 0.f;
#pragma unroll
    for (int i = 0; i < 8; ++i) tot += sm[i];
#pragma unroll
    for (int i = 0; i < 16; ++i) gmx = fmaxf(gmx, sm[16 + i]);
    const float inv = 1.f / tot;
    int ex; (void)frexpf(fmaxf(gmx * inv, 1e-30f), &ex);
    const float sc = ldexpf(1.f, 8 - ex), isc = ldexpf(1.f, ex - 8);
    if (tid == 0) ((float*)(p.ws + WS_FSC))[item] = isc;
    const float k = inv * sc;
    int w0 = 0, w1 = 0;
    w0 = __builtin_amdgcn_cvt_pk_fp8_f32(v[0] * k, v[1] * k, w0, false); w0 = __builtin_amdgcn_cvt_pk_fp8_f32(v[2] * k, v[3] * k, w0, true);
    w1 = __builtin_amdgcn_cvt_pk_fp8_f32(v[4] * k, v[5] * k, w1, false); w1 = __builtin_amdgcn_cvt_pk_fp8_f32(v[6] * k, v[7] * k, w1, true);
    *(u32x2*)(p.ws + WS_R + (size_t)item * 8192 + tid * 8) = u32x2{(unsigned)w0, (unsigned)w1};
    __syncthreads();
}

DI void table_conv_item(const Params& p, int ci, unsigned char* lds) {
    const int tid = get_tid();
    const size_t el = (size_t)(ci & 2047) * 8192 + tid * 8;
    const float* src = (ci < 2048 ? p.in[I_PU] : p.in[I_PV]) + el;
    const f32x4 a = *(const f32x4*)src, b = *(const f32x4*)(src + 4);
    const size_t e = el >> 10, col = el & 1023;
    if (ci < 2048) {
        float mx = fmaxf(fmaxf(fmaxf(fabsf(a[0]), fabsf(a[1])), fmaxf(fabsf(a[2]), fabsf(a[3]))), fmaxf(fmaxf(fabsf(b[0]), fabsf(b[1])), fmaxf(fabsf(b[2]), fabsf(b[3]))));
        float sq = a[0] * a[0] + a[1] * a[1] + a[2] * a[2] + a[3] * a[3] + b[0] * b[0] + b[1] * b[1] + b[2] * b[2] + b[3] * b[3];
        mx = wave_max(mx); sq = wave_sum(sq);
        float* wm = (float*)lds;
        __syncthreads();
        if ((tid & 63) == 0) { wm[tid >> 6] = mx; wm[16 + (tid >> 6)] = sq; }
        __syncthreads();
        const int w2 = (tid >> 7) * 2;
        const float rmax = fmaxf(wm[w2], wm[w2 + 1]), rsig = sqrtf((wm[16 + w2] + wm[17 + w2]) * (1.f / 1024.f));
        const float clip = fmaxf(fminf(rmax, 2.75f * rsig), 1e-30f);
        const float sc = 7.f / clip;
        if ((tid & 127) == 0) ((float*)(p.ws + WS_USC))[e] = clip * (1.f / 7.f);
        unsigned w = 0;
#pragma unroll
        for (int j = 0; j < 4; ++j) {
            const int ql = min(7, max(-7, __float2int_rn(a[j] * sc))) + 8, qh = min(7, max(-7, __float2int_rn(b[j] * sc))) + 8;
            w |= (unsigned)(ql | (qh << 4)) << (8 * j);
        }
        *(unsigned*)(p.ws + WS_UT + (el >> 1)) = w;
    } else {
        const float sc = VSCALE;
        int w0 = 0, w1 = 0;
        w0 = __builtin_amdgcn_cvt_pk_fp8_f32(a[0] * sc, a[1] * sc, w0, false); w0 = __builtin_amdgcn_cvt_pk_fp8_f32(a[2] * sc, a[3] * sc, w0, true);
        w1 = __builtin_amdgcn_cvt_pk_fp8_f32(b[0] * sc, b[1] * sc, w1, false); w1 = __builtin_amdgcn_cvt_pk_fp8_f32(b[2] * sc, b[3] * sc, w1, true);
        *(u32x2*)(p.ws + WS_VTAB + ((col >> 7) * 16384 + e) * 128 + (col & 127)) = u32x2{(unsigned)w0, (unsigned)w1};
    }
}

DI void phase_b(const Params& p, float* sm) {
    const int wave = get_tid() >> 6;
    const float* mod = (const float*)(p.ws + WS_MOD);
    constexpr int ROW_ITEMS = (BT + BATCH * CTX) / 16;
    constexpr int CONV = 2 * 16384 * 1024 / 8192;
    constexpr int SHQ = 8 * 2048 / 16;
    for (int it = blockIdx.x; it < ROW_ITEMS + 1024 + CONV + SHQ; it += gridDim.x) {
        if (it < 1024) { filter_norm_item(p, it, sm); continue; }
        if (it >= ROW_ITEMS + 1024 + CONV) {
            const int tid = get_tid(), lane = tid & 63, o = (it - ROW_ITEMS - 1024 - CONV) * 16 + (tid >> 6), b = o >> 11, n = o & 2047;
            const bf16_t* wr = (const bf16_t*)(p.ws + WS_WTQ) + (size_t)n * DM + lane * 16;
            const float* sh = mod + b * 6144 + 3072 + lane * 16;
            const u32x4 w0 = *(const u32x4*)wr, w1 = *(const u32x4*)(wr + 8);
            float d = 0.f;
#pragma unroll
            for (int i = 0; i < 4; ++i) { d += bflo(w0[i]) * sh[2 * i] + bfhi(w0[i]) * sh[2 * i + 1] + bflo(w1[i]) * sh[8 + 2 * i] + bfhi(w1[i]) * sh[9 + 2 * i]; }
            d = wave_sum(d);
            if (lane == 0) ((float*)(p.ws + WS_SHQ))[o] = d;
            continue;
        }
        if (it >= ROW_ITEMS + 1024) { table_conv_item(p, it - ROW_ITEMS - 1024, (unsigned char*)sm); continue; }
        const int row = (it - 1024) * 16 + wave;
        if (row < BT) {
            const int b = row >> 12;
            norm_mod_row(p.in[I_X] + (size_t)row * DM, p.in[I_NMIX], mod + b * 6144, mod + b * 6144 + 1024, (bf16_t*)(p.ws + WS_H) + (size_t)row * DM);
        } else {
            const int r = row - BT;
            norm_mod_row(p.in[I_CTX] + (size_t)r * DM, p.in[I_NMIX], mod + 8 * 6144, mod + 8 * 6144 + 1024, (bf16_t*)(p.ws + WS_HC) + (size_t)r * DM);
        }
    }
}

#define MFMA16(a, b, c) __builtin_amdgcn_mfma_f32_16x16x32_bf16((a), (b), (c), 0, 0, 0)
constexpr int GT_P = 256 * 128;
struct RowLoader {
    const bf16_t* base; int ld;
    template<int ROWS> DI void issue(unsigned char* tile, int kt, int lane, int wave) const {
#pragma unroll
        for (int i = 0; i < ROWS / 128; ++i) {
            const int grp = i * 16 + wave, row = grp * 8 + (lane >> 3), c = (lane & 7) ^ (lane >> 3);
            __builtin_amdgcn_global_load_lds((const unsigned*)(base + (size_t)row * ld + kt * 64 + c * 8), (unsigned*)(tile + grp * 1024), 16, 0, 0);
        }
    }
};

template<int NQ>
DI void gemm_prefetch(const RowLoader& lp, const RowLoader& lq, unsigned char* lds) {
    const int tid = get_tid(), lane = tid & 63, wave = __builtin_amdgcn_readfirstlane(tid >> 6);
    lp.template issue<256>(lds, 0, lane, wave); lq.template issue<NQ * 64>(lds + GT_P, 0, lane, wave);
}
template<int NQ>
DI void gemm_mainloop(f32x4 (&acc)[4][NQ], const RowLoader& lp, const RowLoader& lq, int nk, unsigned char* lds, bool preissued = false, bool pfnext = false,
                      const RowLoader& nlp = RowLoader{nullptr, 0}, const RowLoader& nlq = RowLoader{nullptr, 0}) {
    const int tid = get_tid(), lane = tid & 63, wave = __builtin_amdgcn_readfirstlane(tid >> 6), wp = wave >> 2, wq = wave & 3;
    constexpr int QROWS = NQ * 64;
    constexpr int STAGE = GT_P + QROWS * 128;
    if (!preissued) {
        __syncthreads();
        lp.template issue<256>(lds, 0, lane, wave); lq.template issue<QROWS>(lds + GT_P, 0, lane, wave);
    }
    asm volatile("s_waitcnt vmcnt(0)" ::: "memory");
    __syncthreads();
    const int l15 = lane & 15, lk = lane >> 4;
    for (int kt = 0; kt < nk; ++kt) {
        unsigned char* cur = lds + (kt & 1) * STAGE;
        unsigned char* nxt = lds + ((kt + 1) & 1) * STAGE;
        const bool last = kt + 1 == nk;
        if (!last) { lp.template issue<256>(nxt, kt + 1, lane, wave); lq.template issue<QROWS>(nxt + GT_P, kt + 1, lane, wave); }
        else if (pfnext) { nlp.template issue<256>(nxt, 0, lane, wave); nlq.template issue<QROWS>(nxt + GT_P, 0, lane, wave); }
#pragma unroll
        for (int ks = 0; ks < 2; ++ks) {
            bf16x8 fp[4], fq[NQ];
#pragma unroll
            for (int i = 0; i < 4; ++i) { const int row = wp * 64 + i * 16 + l15; fp[i] = *(const bf16x8*)(cur + row * 128 + (((ks * 4 + lk) ^ (row & 7)) << 4)); }
#pragma unroll
            for (int j = 0; j < NQ; ++j) { const int row = wq * (16 * NQ) + j * 16 + l15; fq[j] = *(const bf16x8*)(cur + GT_P + row * 128 + (((ks * 4 + lk) ^ (row & 7)) << 4)); }
#pragma unroll
            for (int i = 0; i < 4; ++i)
#pragma unroll
                for (int j = 0; j < NQ; ++j) acc[i][j] = MFMA16(fp[i], fq[j], acc[i][j]);
        }
        if (last && pfnext) { asm volatile("s_waitcnt lgkmcnt(0)" ::: "memory"); __builtin_amdgcn_s_barrier(); }
        else { asm volatile("s_waitcnt vmcnt(0)" ::: "memory"); __syncthreads(); }
    }
}
template<int NQ>
DI void gemm_shadow(const RowLoader& lp, const RowLoader& lq, int nk, unsigned char* lds) {
    f32x4 acc[4][NQ];
#pragma unroll
    for (int i = 0; i < 4; ++i)
#pragma unroll
        for (int j = 0; j < NQ; ++j) acc[i][j] = f32x4{0.f, 0.f, 0.f, 0.f};
    if (SHADOW == 1) gemm_mainloop<NQ>(acc, lp, lq, nk, lds);
    else {
        const int tid = get_tid(), lane = tid & 63, wave = __builtin_amdgcn_readfirstlane(tid >> 6), wp = wave >> 2, wq = wave & 3;
        constexpr int QROWS = NQ * 64;
        constexpr int STAGE = GT_P + QROWS * 128;
        const int l15 = lane & 15, lk = lane >> 4;
        bf16x8 fp[4], fq[NQ];
        if (SHADOW == 3) {
#pragma unroll
            for (int i = 0; i < 4; ++i) fp[i] = *(const bf16x8*)(lds + (wp * 64 + i * 16 + l15) * 128 + lk * 16);
#pragma unroll
            for (int j = 0; j < NQ; ++j) fq[j] = *(const bf16x8*)(lds + GT_P + (wq * 16 * NQ + j * 16 + l15) * 128 + lk * 16);
        }
        for (int kt = 0; kt < nk; ++kt) {
            unsigned char* cur = lds + (kt & 1) * STAGE;
#pragma unroll
            for (int ks = 0; ks < 2; ++ks) {
                if (SHADOW == 2 || SHADOW == 4) {
#pragma unroll
                    for (int i = 0; i < 4; ++i) { const int row = wp * 64 + i * 16 + l15; fp[i] = *(const bf16x8*)(cur + row * 128 + (((ks * 4 + lk) ^ (row & 7)) << 4)); }
#pragma unroll
                    for (int j = 0; j < NQ; ++j) { const int row = wq * (16 * NQ) + j * 16 + l15; fq[j] = *(const bf16x8*)(cur + GT_P + row * 128 + (((ks * 4 + lk) ^ (row & 7)) << 4)); }
                }
#pragma unroll
                for (int i = 0; i < 4; ++i)
#pragma unroll
                    for (int j = 0; j < NQ; ++j) acc[i][j] = MFMA16(fp[i], fq[j], acc[i][j]);
            }
            if (SHADOW == 2) asm volatile("" ::: "memory");
            if (SHADOW == 4) __syncthreads();
        }
    }
#pragma unroll
    for (int i = 0; i < 4; ++i)
#pragma unroll
        for (int j = 0; j < NQ; ++j) asm volatile("" :: "v"(acc[i][j]));
}

template<int NQ> DI void gemm_shadow1(const RowLoader& lp, const RowLoader& lq, int nk, unsigned char* lds) {
    f32x4 acc[4][NQ];
#pragma unroll
    for (int i = 0; i < 4; ++i)
#pragma unroll
        for (int j = 0; j < NQ; ++j) acc[i][j] = f32x4{0.f, 0.f, 0.f, 0.f};
    gemm_mainloop<NQ>(acc, lp, lq, nk, lds);
#pragma unroll
    for (int i = 0; i < 4; ++i)
#pragma unroll
        for (int j = 0; j < NQ; ++j) asm volatile("" :: "v"(acc[i][j]));
}
DI void head_epilogue(f32x4 (&acc)[4][4], const float* __restrict__ g, float gscale, const float* __restrict__ rope, bool do_rope, int t_base  , bf16_t* __restrict__ dst  , int lane) {
    const int l15 = lane & 15, lk = lane >> 4;
    float gg[4];
#pragma unroll
    for (int j = 0; j < 4; ++j) gg[j] = g[j * 16 + l15] * gscale;
#pragma unroll
    for (int i = 0; i < 4; ++i) {
#pragma unroll
        for (int r = 0; r < 4; ++r) {
            float ss = 0.f;
#pragma unroll
            for (int j = 0; j < 4; ++j) ss += acc[i][j][r] * acc[i][j][r];
            ss = sum16(ss);
            const float rs = rsqrtf(ss * (1.f / 64.f) + EPS);
            float v[4];
#pragma unroll
            for (int j = 0; j < 4; ++j) v[j] = acc[i][j][r] * rs * gg[j];
            const int t = t_base + i * 16 + lk * 4 + r;
            if (do_rope) {
                const int prow = (t >> 6) & 63, pcol = t & 63;
                const float c0 = rope[prow * 16 + l15], s0 = rope[1024 + prow * 16 + l15];
                const float c1 = rope[pcol * 16 + l15], s1 = rope[1024 + pcol * 16 + l15];
                const float a0 = v[0] * c0 - v[1] * s0, a1 = v[1] * c0 + v[0] * s0;
                const float a2 = v[2] * c1 - v[3] * s1, a3 = v[3] * c1 + v[2] * s1;
                v[0] = a0; v[1] = a1; v[2] = a2; v[3] = a3;
            }
            bf16_t* d = dst + (size_t)(i * 16 + lk * 4 + r) * 64 + l15;
#pragma unroll
            for (int j = 0; j < 4; ++j) d[j * 16] = (bf16_t)f2bf(v[j]);
        }
    }
}
DI void tstore_epilogue(f32x4 (&acc)[4][4], bf16_t* __restrict__ dst  , size_t ld, int lane) {
    const int l15 = lane & 15, lk = lane >> 4;
#pragma unroll
    for (int i = 0; i < 4; ++i)
#pragma unroll
        for (int j = 0; j < 4; ++j)
            *(u32x2*)(dst + (size_t)(j * 16 + l15) * ld + i * 16 + lk * 4) = u32x2{pk2(acc[i][j][0], acc[i][j][1]), pk2(acc[i][j][2], acc[i][j][3])};
}

DI void phase_c(const Params& p, unsigned char* lds) {
    constexpr int NTM = BT / 256, NTN = INC / 256;
    constexpr int MAIN = NTM * NTN, TOTAL = MAIN + 8;
    const bf16_t* H = (const bf16_t*)(p.ws + WS_H);
    const bf16_t* HCp = (const bf16_t*)(p.ws + WS_HC);
    const bf16_t* WT = (const bf16_t*)(p.ws + WS_WTIN);
    const float* rope = (const float*)(p.ws + WS_ROPE);
    struct CTile { int tm, tn; bool ctx; RowLoader P, Q; };
    auto c_tile = [&](int it) {
        CTile t; t.ctx = false;
        if (it < MAIN) { const int g = it / (16 * NTN), rem = it % (16 * NTN); t.tn = rem >> 4; t.tm = g * 16 + (rem & 15); }
        else { t.ctx = true; t.tm = it - MAIN; t.tn = 2; }
        const bf16_t* A = t.ctx ? HCp + (size_t)t.tm * 256 * DM : H + (size_t)t.tm * 256 * DM;
        const bf16_t* W = WT + (size_t)t.tn * 256 * DM;
        if (t.tn >= 9) { t.P = RowLoader{W, DM}; t.Q = RowLoader{A, DM}; }
        else { t.P = RowLoader{A, DM}; t.Q = RowLoader{W, DM}; }
        return t;
    };
    bool pre = false;
    CTile cur = c_tile(blockIdx.x);
    for (int it = blockIdx.x; it < TOTAL; it += gridDim.x) {
        const int tid = get_tid(), lane = tid & 63, wave = tid >> 6, wa = wave >> 2, wb = wave & 3;
        const bool has2 = it + (int)gridDim.x < TOTAL;
        const CTile nx = c_tile(has2 ? it + (int)gridDim.x : it);
        const int tm = cur.tm, tn = cur.tn; const bool ctx = cur.ctx;
        f32x4 acc[4][4];
#pragma unroll
        for (int i = 0; i < 4; ++i)
#pragma unroll
            for (int j = 0; j < 4; ++j) acc[i][j] = f32x4{0.f, 0.f, 0.f, 0.f};
        gemm_mainloop<4>(acc, cur.P, cur.Q, DM / 64, lds, pre, has2, nx.P, nx.Q);
        pre = has2; cur = nx;
        if (tn >= 9) {
            bf16_t* G = (bf16_t*)(p.ws + WS_G);
            const int l15 = lane & 15, lk = lane >> 4;
#pragma unroll
            for (int i = 0; i < 4; ++i)
#pragma unroll
                for (int j = 0; j < 4; ++j) {
                    const int n = tn * 256 - 2304 + wa * 64 + i * 16 + lk * 4;
                    const int tok = tm * 256 + wb * 64 + j * 16 + l15;
                    float sg[4];
#pragma unroll
                    for (int r = 0; r < 4; ++r) sg[r] = 1.f / (1.f + __expf(-acc[i][j][r]));
                    *(u32x2*)(G + (size_t)tok * GC + n) = u32x2{pk2(sg[0], sg[1]), pk2(sg[2], sg[3])};
                }
            continue;
        }
        const int b = ctx ? tm : (tm >> 4);
        const int tpos = ctx ? SEQ + wa * 64 : ((tm & 15) * 256 + wa * 64);
        if (tn < 2) {
            const int h = tn * 4 + wb;
            bf16_t* Q = (bf16_t*)(p.ws + WS_Q) + ((size_t)(b * NH + h) * SEQ + tpos) * HD;
            head_epilogue(acc, p.in[I_QNG], 0.125f * 1.4426950408889634f, rope, true, tpos, Q, lane);
        } else if (tn == 2) {
            if (wb < 2) {
                bf16_t* K = (bf16_t*)(p.ws + WS_KB) + ((size_t)(b * NKV + wb) * TK + tpos) * HD;
                head_epilogue(acc, p.in[I_KNG], 1.f, rope, !ctx, tpos, K, lane);
            } else {
                bf16_t* V = (bf16_t*)(p.ws + WS_VT) + (size_t)(b * NKV + (wb - 2)) * HD * TK + tpos;
                tstore_epilogue(acc, V, TK, lane);
            }
        } else {
            const int col = tn * 256 - 768 + wb * 64;
            bf16_t* Z = (bf16_t*)(p.ws + WS_ZT) + (size_t)col * BT + (size_t)b * SEQ + tpos;
            tstore_epilogue(acc, Z, BT, lane);
        }
    }
}

#define MFMA32(a, b, c) __builtin_amdgcn_mfma_f32_32x32x16_bf16((a), (b), (c), 0, 0, 0)
DI bf16x8 pack_step(const f32x16& x, int s) {
    u32x4 pk;
    asm volatile("v_cvt_pk_bf16_f32 %0, %4, %5\n\tv_cvt_pk_bf16_f32 %1, %6, %7\n\tv_cvt_pk_bf16_f32 %2, %8, %9\n\tv_cvt_pk_bf16_f32 %3, %10, %11\n\ts_nop 1"
                 : "=&v"(pk[0]), "=&v"(pk[1]), "=&v"(pk[2]), "=&v"(pk[3])
                 : "v"(x[8 * s]), "v"(x[8 * s + 1]), "v"(x[8 * s + 2]), "v"(x[8 * s + 3]), "v"(x[8 * s + 4]), "v"(x[8 * s + 5]), "v"(x[8 * s + 6]), "v"(x[8 * s + 7]));
    return __builtin_bit_cast(bf16x8, pk);
}

constexpr int AT_KSTR = 144, AT_VSTR = 136, AT_VOFF = 64 * AT_KSTR, AT_STAGE = AT_VOFF + 64 * AT_VSTR;
DI void attn_item(const Params& p, int item, unsigned char* lds) {
    const int tid = get_tid(), lane = tid & 63, wave = tid >> 6;
    const int b = item >> 6, kvh = (item >> 5) & 1, qb = item & 31;
    const int h = kvh * 4 + (wave >> 2), q0 = qb * 128 + (wave & 3) * 32;
    const int qi = lane & 31, hf = lane >> 5;
    const bf16_t* Qp = (const bf16_t*)(p.ws + WS_Q) + ((size_t)(b * NH + h) * SEQ + q0 + qi) * HD;
    bf16x8 qf[4];
#pragma unroll
    for (int s = 0; s < 4; ++s) qf[s] = *(const bf16x8*)(Qp + 16 * s + 8 * hf);
    const bf16_t* Kg = (const bf16_t*)(p.ws + WS_KB) + (size_t)(b * NKV + kvh) * TK * HD;
    const bf16_t* Vg = (const bf16_t*)(p.ws + WS_VT) + (size_t)(b * NKV + kvh) * HD * TK;
    const bool isK = tid < 512;
    const int li = tid & 511, lrow = li >> 3, lc = li & 7;
    const bf16_t* src = isK ? Kg + (size_t)lrow * HD + lc * 8 : Vg + (size_t)lrow * TK + lc * 8;
    const size_t sstep = isK ? (size_t)64 * HD : 64;
    const int ldst = isK ? lrow * AT_KSTR + lc * 16 : AT_VOFF + lrow * AT_VSTR + lc * 16;
    constexpr int NTILE = TK / 64;
    f32x16 o0, o1;
#pragma unroll
    for (int i = 0; i < 16; ++i) { o0[i] = 0.f; o1[i] = 0.f; }
    float l = 0.f;
    __syncthreads();
    constexpr int NSUB = 4, NSTG = NTILE / NSUB;
    static_assert(NTILE % NSUB == 0 && 2 * NSUB * AT_STAGE <= LDS_USER, "attention LDS stages");
    u32x4 stg[NSUB];
#pragma unroll
    for (int j = 0; j < NSUB; ++j) stg[j] = *(const u32x4*)(src + (size_t)j * sstep);
#pragma unroll
    for (int j = 0; j < NSUB; ++j) { unsigned char* d = lds + j * AT_STAGE + ldst; *(u32x2*)d = u32x2{stg[j][0], stg[j][1]}; *(u32x2*)(d + 8) = u32x2{stg[j][2], stg[j][3]}; }
    __syncthreads();
    const int koff = qi * AT_KSTR + hf * 16;
    const int voff = AT_VOFF + qi * AT_VSTR + hf * 8;
    for (int st = 0; st < NSTG; ++st) {
      const bool more = st + 1 < NSTG;
      if (more) {
#pragma unroll
          for (int j = 0; j < NSUB; ++j) stg[j] = *(const u32x4*)(src + (size_t)((st + 1) * NSUB + j) * sstep);
      }
#pragma unroll 1
      for (int j = 0; j < NSUB; ++j) {
        const unsigned char* cur = lds + ((st & 1) * NSUB + j) * AT_STAGE;
        f32x16 sA, sB;
#pragma unroll
        for (int i = 0; i < 16; ++i) { sA[i] = 0.f; sB[i] = 0.f; }
        __builtin_amdgcn_s_setprio(1);
#pragma unroll
        for (int s = 0; s < 4; ++s) sA = MFMA32(*(const bf16x8*)(cur + koff + s * 32), qf[s], sA);
#pragma unroll
        for (int s = 0; s < 4; ++s) sB = MFMA32(*(const bf16x8*)(cur + koff + 32 * AT_KSTR + s * 32), qf[s], sB);
        __builtin_amdgcn_s_setprio(0);
        float ps = 0.f;
#pragma unroll
        for (int kb = 0; kb < 2; ++kb) {
            f32x16& sx = kb ? sB : sA;
#pragma unroll
            for (int i = 0; i < 16; ++i) { sx[i] = __builtin_amdgcn_exp2f(sx[i]); ps += sx[i]; }
#pragma unroll
            for (int s2 = 0; s2 < 2; ++s2) {
                const bf16x8 pf = pack_step(sx, s2);
#pragma unroll
                for (int db = 0; db < 2; ++db) {
                    const unsigned char* vb = cur + voff + db * 32 * AT_VSTR + (4 * kb + 2 * s2) * 16;
                    const s16x4 lo = lds_rd64(vb);
                    const s16x4 hi = lds_rd64(vb + 16);
                    const bf16x8 vf = __builtin_shufflevector(lo, hi, 0, 1, 2, 3, 4, 5, 6, 7);
                    if (db == 0) o0 = MFMA32(vf, pf, o0); else o1 = MFMA32(vf, pf, o1);
                }
            }
        }
        l += ps;
      }
      if (more) {
#pragma unroll
          for (int j = 0; j < NSUB; ++j) { unsigned char* d = lds + (((st + 1) & 1) * NSUB + j) * AT_STAGE + ldst; *(u32x2*)d = u32x2{stg[j][0], stg[j][1]}; *(u32x2*)(d + 8) = u32x2{stg[j][2], stg[j][3]}; }
      }
      __syncthreads();
    }
    l = sum_x32(l);
    const float inv = 1.f / l;
    bf16_t* O;
    {
        const int t2 = get_tid(), lane2 = t2 & 63, wave2 = t2 >> 6;
        const int h2 = kvh * 4 + (wave2 >> 2), q2 = qb * 128 + (wave2 & 3) * 32 + (lane2 & 31);
        O = (bf16_t*)(p.ws + WS_ATT) + ((size_t)b * SEQ + q2) * QD + h2 * HD + 4 * (lane2 >> 5);
    }
#pragma unroll
    for (int g4 = 0; g4 < 4; ++g4) {
        *(u32x2*)(O + 8 * g4)      = u32x2{pk2(o0[4 * g4] * inv, o0[4 * g4 + 1] * inv), pk2(o0[4 * g4 + 2] * inv, o0[4 * g4 + 3] * inv)};
        *(u32x2*)(O + 32 + 8 * g4) = u32x2{pk2(o1[4 * g4] * inv, o1[4 * g4 + 1] * inv), pk2(o1[4 * g4 + 2] * inv, o1[4 * g4 + 3] * inv)};
    }
}

constexpr int HY_USTR = 8208, HY_R = 8 * HY_USTR, HY_RSTR = 16384 + 64;
DI void hy_load_filter(const bf16_t* __restrict__ R, unsigned char* lds, int tid) {
    const int i0 = tid * 8;
    const u32x4 w = *(const u32x4*)(R + i0);
    u32x2 nx = u32x2{0u, 0u};
    if (i0 + 8 < 8192) nx = *(const u32x2*)(R + i0 + 8);
    unsigned char* d = lds + HY_R + i0 * 2;
    *(u32x4*)(d) = w;
    *(u32x4*)(d + HY_RSTR) = u32x4{__builtin_amdgcn_alignbit(w[1], w[0], 16), __builtin_amdgcn_alignbit(w[2], w[1], 16), __builtin_amdgcn_alignbit(w[3], w[2], 16), __builtin_amdgcn_alignbit(nx[0], w[3], 16)};
    *(u32x4*)(d + 2 * HY_RSTR) = u32x4{w[1], w[2], w[3], nx[0]};
    *(u32x4*)(d + 3 * HY_RSTR) = u32x4{__builtin_amdgcn_alignbit(w[2], w[1], 16), __builtin_amdgcn_alignbit(w[3], w[2], 16), __builtin_amdgcn_alignbit(nx[0], w[3], 16), __builtin_amdgcn_alignbit(nx[1], nx[0], 16)};
}
DI void short_conv4(const bf16_t* __restrict__ zrow  , int t4, float w0, float w1, float w2, float bias, float (&out)[4]) {
    const u32x2 v = *(const u32x2*)(zrow + t4);
    const float z0 = bflo(v[0]), z1 = bfhi(v[0]), z2 = bflo(v[1]), z3 = bfhi(v[1]);
    const float zm = (t4 > 0) ? bf2f(zrow[t4 - 1]) : 0.f;
    const float zp = (t4 + 4 < SEQ) ? bf2f(zrow[t4 + 4]) : 0.f;
    out[0] = zm * w0 + z0 * w1 + z1 * w2 + bias;
    out[1] = z0 * w0 + z1 * w1 + z2 * w2 + bias;
    out[2] = z1 * w0 + z2 * w1 + z3 * w2 + bias;
    out[3] = z2 * w0 + z3 * w1 + zp * w2 + bias;
}
DI void hyena_item(const Params& p, int c, unsigned char* lds) {
    const int tid = get_tid(), lane = tid & 63, ig = tid >> 6;
    const bf16_t* ZT = (const bf16_t*)(p.ws + WS_ZT);
    const float* cw = p.in[I_HCW];
    const float* cb = p.in[I_HCB];
    __syncthreads();
    {
        const int b = tid >> 7, tb = (tid & 127) * 32;
        const bf16_t* zrow = ZT + (size_t)c * BT + (size_t)b * SEQ;
        const float w0 = cw[c], w1 = cw[HYC + c], w2 = cw[2 * HYC + c], bias = cb[c];
#pragma unroll
        for (int q = 0; q < 8; ++q) {
            float o[4];
            short_conv4(zrow, tb + 4 * q, w0, w1, w2, bias, o);
            *(u32x2*)(lds + b * HY_USTR + (tb + 4 * q) * 2) = u32x2{pk2(o[0], o[1]), pk2(o[2], o[3])};
        }
    }
    const int r = lane & 31, hf = lane >> 5, Il = r >> 3, bb = r & 7;
#pragma unroll 1
    for (int o = 0; o < 2; ++o) {
        hy_load_filter((const bf16_t*)(p.ws + WS_R) + (size_t)(o * 512 + c) * 8192, lds, tid);
        __syncthreads();
        f32x16 acc0, acc1;
#pragma unroll
        for (int i = 0; i < 16; ++i) { acc0[i] = 0.f; acc1[i] = 0.f; }
        const int sh = (-r) & 3;
        const unsigned char* abase = lds + HY_R + sh * HY_RSTR + (4096 + 8 * hf - r - sh) * 2 - 64;
        const unsigned char* ubase = lds + bb * HY_USTR + ((4 * ig + Il) * 64 + 8 * hf) * 2;
#define HY_STEP(MASKED) do { \
            const unsigned char* ap = abase - 128 * d; \
            const unsigned char* ub = ubase - 128 * d; \
            bool valid = true; \
            if (MASKED) { const int J = 4 * ig + Il - d; valid = (unsigned)J < 64u; if (!valid) ub = lds; } \
            _Pragma("unroll") for (int ks = 0; ks < 4; ++ks) { \
                u32x4 braw = *(const u32x4*)(ub + ks * 32); \
                if (MASKED) { if (!valid) braw = u32x4{0u, 0u, 0u, 0u}; } \
                const bf16x8 bf = __builtin_bit_cast(bf16x8, braw); \
                { const s16x4 lo = lds_rd64(ap + 32 * ks + 64), hi = lds_rd64(ap + 32 * ks + 72);     \
                  acc0 = MFMA32(__builtin_shufflevector(lo, hi, 0, 1, 2, 3, 4, 5, 6, 7), bf, acc0); } \
                { const s16x4 lo = lds_rd64(ap + 32 * ks), hi = lds_rd64(ap + 32 * ks + 8); \
                  acc1 = MFMA32(__builtin_shufflevector(lo, hi, 0, 1, 2, 3, 4, 5, 6, 7), bf, acc1); } \
            } } while (0)
        const int dlo = 4 * ig - 63, dhi = 4 * ig + 3;
#pragma unroll 1
        for (int d = dlo; d < dlo + 3; ++d) HY_STEP(true);
#pragma unroll 1
        for (int d = dlo + 3; d <= dhi - 3; ++d) HY_STEP(false);
        if (SHADOW == 6) {
            f32x16 s0 = acc0, s1 = acc1;
            const bf16x8 fa = *(const bf16x8*)(lds + lane * 16), fb = *(const bf16x8*)(lds + 4096 + lane * 16);
#pragma unroll 1
            for (int d = 0; d < 67; ++d) {
#pragma unroll
                for (int ks = 0; ks < 4; ++ks) { s0 = MFMA32(fa, fb, s0); s1 = MFMA32(fa, fb, s1); }
            }
            asm volatile("" :: "v"(s0), "v"(s1));
        }
        if (SHADOW == 7) {
            f32x16 k0 = acc0, k1 = acc1;
#pragma unroll 1
            for (int d = dlo + 3; d <= dhi - 3 + 6; ++d) {
                const unsigned char* ap = abase - 128 * (d > dhi - 3 ? dhi - 3 : d);
                const unsigned char* ub = ubase - 128 * (d > dhi - 3 ? dhi - 3 : d);
#pragma unroll
                for (int ks = 0; ks < 4; ++ks) {
                    const bf16x8 bf = *(const bf16x8*)(ub + ks * 32);
                    { const s16x4 lo = lds_rd64(ap + 32 * ks + 64), hi = lds_rd64(ap + 32 * ks + 72); k0 = MFMA32(__builtin_shufflevector(lo, hi, 0, 1, 2, 3, 4, 5, 6, 7), bf, k0); }
                    { const s16x4 lo = lds_rd64(ap + 32 * ks), hi = lds_rd64(ap + 32 * ks + 8); k1 = MFMA32(__builtin_shufflevector(lo, hi, 0, 1, 2, 3, 4, 5, 6, 7), bf, k1); }
                }
            }
            asm volatile("" :: "v"(k0), "v"(k1));
        }
#pragma unroll 1
        for (int d = dhi - 2; d <= dhi; ++d) HY_STEP(true);
#undef HY_STEP
        __syncthreads();
        const float skip = p.in[I_HSKIP][o * HYD + c];
        const int gcol = (o == 0 ? 512 : 1024) + c;
        const float w0 = cw[gcol], w1 = cw[HYC + gcol], w2 = cw[2 * HYC + gcol], bias = cb[gcol];
        const bf16_t* zrow = ZT + (size_t)gcol * BT + (size_t)bb * SEQ;
        bf16_t* hyt = (bf16_t*)(p.ws + WS_HYT) + (size_t)c * BT + (size_t)bb * SEQ;
#pragma unroll
        for (int mm = 0; mm < 2; ++mm) {
#pragma unroll
            for (int g4 = 0; g4 < 4; ++g4) {
                const int t4 = (4 * ig + Il) * 64 + 32 * mm + 8 * g4 + 4 * hf;
                float gt[4];
                short_conv4(zrow, t4, w0, w1, w2, bias, gt);
                unsigned char* up = lds + bb * HY_USTR + t4 * 2;
                const u32x2 uv = *(const u32x2*)up;
                const float u0 = bflo(uv[0]), u1 = bfhi(uv[0]), u2 = bflo(uv[1]), u3 = bfhi(uv[1]);
                const f32x16& a = mm ? acc1 : acc0;
                const float y0 = gt[0] * (a[4 * g4] + skip * u0), y1 = gt[1] * (a[4 * g4 + 1] + skip * u1);
                const float y2 = gt[2] * (a[4 * g4 + 2] + skip * u2), y3 = gt[3] * (a[4 * g4 + 3] + skip * u3);
                const u32x2 pk = u32x2{pk2(y0, y1), pk2(y2, y3)};
                if (o == 0) *(u32x2*)up = pk; else *(u32x2*)(hyt + t4) = pk;
            }
        }
        __syncthreads();
    }
}

constexpr int HY8_USTR = 4112, HY8_R = 8 * HY8_USTR, HY8_RSTR = 8192 + 32;
constexpr float HY8_US = 16.f;
typedef int i32x8 __attribute__((ext_vector_type(8)));
#define MFMA8(a, b, c) __builtin_amdgcn_mfma_scale_f32_32x32x64_f8f6f4((a), (b), (c), 0, 0, 0, 0x7F7F7F7F, 0, 0x7F7F7F7F)
DI unsigned pk_fp8x4(float a, float b, float c, float d) {
    int w = 0;
    w = __builtin_amdgcn_cvt_pk_fp8_f32(fminf(fmaxf(a, -440.f), 440.f), fminf(fmaxf(b, -440.f), 440.f), w, false);
    w = __builtin_amdgcn_cvt_pk_fp8_f32(fminf(fmaxf(c, -440.f), 440.f), fminf(fmaxf(d, -440.f), 440.f), w, true);
    return (unsigned)w;
}
DI void hy8_load_filter(const unsigned char* __restrict__ R, unsigned char* lds, int tid) {
    const int i0 = tid * 8;
    const unsigned long long lo = *(const unsigned long long*)(R + i0);
    unsigned long long hi = 0ull;
    if (i0 + 8 < 8192) hi = *(const unsigned long long*)(R + i0 + 8);
    unsigned char* d = lds + HY8_R + i0;
    *(unsigned long long*)d = lo;
#pragma unroll
    for (int sft = 1; sft < 8; ++sft) *(unsigned long long*)(d + sft * HY8_RSTR) = (lo >> (8 * sft)) | (hi << (64 - 8 * sft));
}
DI void hyena_item8(const Params& p, int c, unsigned char* lds) {
    const int tid = get_tid(), lane = tid & 63, ig = tid >> 6;
    const bf16_t* ZT = (const bf16_t*)(p.ws + WS_ZT);
    const float* cw = p.in[I_HCW];
    const float* cb = p.in[I_HCB];
    __syncthreads();
    {
        const int b = tid >> 7, tb = (tid & 127) * 32;
        const bf16_t* zrow = ZT + (size_t)c * BT + (size_t)b * SEQ;
        const float w0 = cw[c], w1 = cw[HYC + c], w2 = cw[2 * HYC + c], bias = cb[c];
        unsigned w8[8];
#pragma unroll
        for (int q = 0; q < 8; ++q) {
            float o[4];
            short_conv4(zrow, tb + 4 * q, w0, w1, w2, bias, o);
            w8[q] = pk_fp8x4(o[0] * HY8_US, o[1] * HY8_US, o[2] * HY8_US, o[3] * HY8_US);
        }
        *(u32x4*)(lds + b * HY8_USTR + tb) = u32x4{w8[0], w8[1], w8[2], w8[3]};
        *(u32x4*)(lds + b * HY8_USTR + tb + 16) = u32x4{w8[4], w8[5], w8[6], w8[7]};
    }
    const int r = lane & 31, hf = lane >> 5, Il = r >> 3, bb = r & 7;
#pragma unroll 1
    for (int o = 0; o < 2; ++o) {
        hy8_load_filter(p.ws + WS_R + (size_t)(o * 512 + c) * 8192, lds, tid);
        __syncthreads();
        f32x16 acc0, acc1;
#pragma unroll
        for (int i = 0; i < 16; ++i) { acc0[i] = 0.f; acc1[i] = 0.f; }
        const int sh = (-r) & 7;
        const unsigned char* abase = lds + HY8_R + sh * HY8_RSTR + (4096 + 32 * hf - r - sh) - 32;
        const unsigned char* ubase = lds + bb * HY8_USTR + (4 * ig + Il) * 64 + 32 * hf;
#define HY8_STEP(MASKED) do { \
            const unsigned char* ap = abase - 64 * d; \
            const unsigned char* ub = ubase - 64 * d; \
            bool valid = true; \
            if (MASKED) { const int J = 4 * ig + Il - d; valid = (unsigned)J < 64u; if (!valid) ub = lds; } \
            u32x4 b0 = *(const u32x4*)(ub), b1 = *(const u32x4*)(ub + 16); \
            if (MASKED) { if (!valid) { b0 = u32x4{0u, 0u, 0u, 0u}; b1 = b0; } } \
            const i32x8 bf = i32x8{(int)b0[0], (int)b0[1], (int)b0[2], (int)b0[3], (int)b1[0], (int)b1[1], (int)b1[2], (int)b1[3]}; \
            { const s16x4 q0 = lds_rd64(ap + 32), q1 = lds_rd64(ap + 40), q2 = lds_rd64(ap + 48), q3 = lds_rd64(ap + 56); \
              const u32x2 e0 = __builtin_bit_cast(u32x2, q0), e1 = __builtin_bit_cast(u32x2, q1), e2 = __builtin_bit_cast(u32x2, q2), e3 = __builtin_bit_cast(u32x2, q3); \
              acc0 = MFMA8((i32x8{(int)e0[0], (int)e0[1], (int)e1[0], (int)e1[1], (int)e2[0], (int)e2[1], (int)e3[0], (int)e3[1]}), bf, acc0); } \
            { const s16x4 q0 = lds_rd64(ap), q1 = lds_rd64(ap + 8), q2 = lds_rd64(ap + 16), q3 = lds_rd64(ap + 24); \
              const u32x2 e0 = __builtin_bit_cast(u32x2, q0), e1 = __builtin_bit_cast(u32x2, q1), e2 = __builtin_bit_cast(u32x2, q2), e3 = __builtin_bit_cast(u32x2, q3); \
              acc1 = MFMA8((i32x8{(int)e0[0], (int)e0[1], (int)e1[0], (int)e1[1], (int)e2[0], (int)e2[1], (int)e3[0], (int)e3[1]}), bf, acc1); } \
            } while (0)
        const int dlo = 4 * ig - 63, dhi = 4 * ig + 3;
#pragma unroll 1
        for (int d = dlo; d < dlo + 3; ++d) HY8_STEP(true);
#pragma unroll 1
        for (int d = dlo + 3; d <= dhi - 3; ++d) HY8_STEP(false);
#pragma unroll 1
        for (int d = dhi - 2; d <= dhi; ++d) HY8_STEP(true);
#undef HY8_STEP
        __syncthreads();
        const float skip = p.in[I_HSKIP][o * HYD + c];
        const float asc = ((const float*)(p.ws + WS_FSC))[o * 512 + c] * (1.f / HY8_US);
        const int gcol = (o == 0 ? 512 : 1024) + c;
        const float w0 = cw[gcol], w1 = cw[HYC + gcol], w2 = cw[2 * HYC + gcol], bias = cb[gcol];
        const bf16_t* zrow = ZT + (size_t)gcol * BT + (size_t)bb * SEQ;
        bf16_t* hyt = (bf16_t*)(p.ws + WS_HYT) + (size_t)c * BT + (size_t)bb * SEQ;
#pragma unroll
        for (int mm = 0; mm < 2; ++mm) {
#pragma unroll
            for (int g4 = 0; g4 < 4; ++g4) {
                const int t4 = (4 * ig + Il) * 64 + 32 * mm + 8 * g4 + 4 * hf;
                float gt[4];
                short_conv4(zrow, t4, w0, w1, w2, bias, gt);
                unsigned* up = (unsigned*)(lds + bb * HY8_USTR + t4);
                const unsigned uv = *up;
                const f32x2 ul = __builtin_amdgcn_cvt_pk_f32_fp8((int)uv, false), uh = __builtin_amdgcn_cvt_pk_f32_fp8((int)uv, true);
                const float us = skip * (1.f / HY8_US);
                const f32x16& a = mm ? acc1 : acc0;
                const float y0 = gt[0] * (a[4 * g4] * asc + us * ul[0]), y1 = gt[1] * (a[4 * g4 + 1] * asc + us * ul[1]);
                const float y2 = gt[2] * (a[4 * g4 + 2] * asc + us * uh[0]), y3 = gt[3] * (a[4 * g4 + 3] * asc + us * uh[1]);
                if (o == 0) *up = pk_fp8x4(y0 * HY8_US, y1 * HY8_US, y2 * HY8_US, y3 * HY8_US);
                else *(u32x2*)(hyt + t4) = u32x2{pk2(y0, y1), pk2(y2, y3)};
            }
        }
        __syncthreads();
    }
}

constexpr int CTL_QUEUE_D = 8192;
DI void phase_d(const Params& p, unsigned char* lds) {
    unsigned* ctr = (unsigned*)(p.ws + WS_CTL) + CTL_QUEUE_D;
    volatile LAS unsigned* slot = (volatile LAS unsigned*)(LAS unsigned char*)(lds + LDS_ST_OFF + 8);
    for (;;) {
        __syncthreads();
        if (get_tid() == 0) slot[0] = atomicAdd(ctr, 1u);
        __syncthreads();
        const int it = __builtin_amdgcn_readfirstlane((int)slot[0]);
        if (it >= 1024) break;
        if (it < 512) hyena_item8(p, it, lds); else attn_item(p, it - 512, lds);
    }
}

DI void phase_d2(const Params& p, unsigned char* lds) {
    constexpr int TILES = 8 * (BT / 256);
    const bf16_t* HYT = (const bf16_t*)(p.ws + WS_HYT);
    bf16_t* HY = (bf16_t*)(p.ws + WS_HY);
    for (int it = blockIdx.x; it < TILES; it += gridDim.x) {
        const int tid = get_tid();
        const int c0 = (it & 7) * 64, tok0 = (it >> 3) * 256;
        __syncthreads();
#pragma unroll
        for (int i = 0; i < 2; ++i) {
            const int idx = tid + i * NT, c = idx >> 5, tg = idx & 31;
            *(u32x4*)(lds + c * 528 + tg * 16) = *(const u32x4*)(HYT + (size_t)(c0 + c) * BT + tok0 + tg * 8);
        }
        __syncthreads();
#pragma unroll
        for (int i = 0; i < 2; ++i) {
            const int idx = tid + i * NT, tok = idx >> 3, cg = idx & 7;
            unsigned w[4];
#pragma unroll
            for (int e = 0; e < 4; ++e) {
                const unsigned lo = *(const unsigned short*)(lds + (cg * 8 + 2 * e) * 528 + tok * 2);
                const unsigned hi = *(const unsigned short*)(lds + (cg * 8 + 2 * e + 1) * 528 + tok * 2);
                w[e] = lo | (hi << 16);
            }
            *(u32x4*)(HY + (size_t)(tok0 + tok) * HYD + c0 + cg * 8) = u32x4{w[0], w[1], w[2], w[3]};
        }
    }
}

DI void phase_e(const Params& p, unsigned char* lds) {
    constexpr int TILES = 4 * (BT / 128);
    for (int it = blockIdx.x; it < TILES; it += gridDim.x) {
        const int tid = get_tid(), lane = tid & 63, wave = tid >> 6, wp = wave >> 2, wq = wave & 3;
        const int tn = it & 3, tm = it >> 2;
        const int n0 = tn * 256, tok0 = tm * 128;
        f32x4 acc1[4][2], acc2[4][2];
#pragma unroll
        for (int i = 0; i < 4; ++i)
#pragma unroll
            for (int j = 0; j < 2; ++j) { acc1[i][j] = f32x4{0.f, 0.f, 0.f, 0.f}; acc2[i][j] = f32x4{0.f, 0.f, 0.f, 0.f}; }
        if (SHADOW == 5) { gemm_shadow1<2>(RowLoader{(const bf16_t*)(p.ws + WS_WTAO) + (size_t)n0 * QD, QD}, RowLoader{(const bf16_t*)(p.ws + WS_ATT) + (size_t)tok0 * QD, QD}, QD / 64, lds);
                           gemm_shadow1<2>(RowLoader{(const bf16_t*)(p.ws + WS_WTHO) + (size_t)n0 * HYD, HYD}, RowLoader{(const bf16_t*)(p.ws + WS_HY) + (size_t)tok0 * HYD, HYD}, HYD / 64, lds); }
        {
            const RowLoader p1{(const bf16_t*)(p.ws + WS_WTAO) + (size_t)n0 * QD, QD}, q1{(const bf16_t*)(p.ws + WS_ATT) + (size_t)tok0 * QD, QD};
            const RowLoader p2{(const bf16_t*)(p.ws + WS_WTHO) + (size_t)n0 * HYD, HYD}, q2{(const bf16_t*)(p.ws + WS_HY) + (size_t)tok0 * HYD, HYD};
            gemm_mainloop<2>(acc1, p1, q1, QD / 64, lds, false, true, p2, q2);
            gemm_mainloop<2>(acc2, p2, q2, HYD / 64, lds, true, false);
        }
        const bf16_t* G = (const bf16_t*)(p.ws + WS_G);
        bf16_t* M = (bf16_t*)(p.ws + WS_H);
        constexpr int ES = 528, EG2 = 128 * ES;
        __syncthreads();
        {
            u32x4 ga[4], gh[4];
#pragma unroll
            for (int q = 0; q < 4; ++q) {
                const int idx = tid + q * NT, row = idx >> 5, ch = idx & 31;
                const bf16_t* gp = G + (size_t)(tok0 + row) * GC + n0 + ch * 8;
                ga[q] = *(const u32x4*)gp; gh[q] = *(const u32x4*)(gp + 1024);
            }
#pragma unroll
            for (int q = 0; q < 4; ++q) {
                const int idx = tid + q * NT, row = idx >> 5, ch = idx & 31;
                *(u32x4*)(lds + row * ES + ch * 16) = ga[q]; *(u32x4*)(lds + EG2 + row * ES + ch * 16) = gh[q];
            }
        }
        __syncthreads();
        const int l15 = lane & 15, lk = lane >> 4;
        u32x2 mo[4][2];
#pragma unroll
        for (int i = 0; i < 4; ++i)
#pragma unroll
            for (int j = 0; j < 2; ++j) {
                const int off = (wq * 32 + j * 16 + l15) * ES + (wp * 64 + i * 16 + lk * 4) * 2;
                const u32x2 ga = *(const u32x2*)(lds + off), gh = *(const u32x2*)(lds + EG2 + off);
                const float m0 = bflo(ga[0]) * acc1[i][j][0] + bflo(gh[0]) * acc2[i][j][0];
                const float m1 = bfhi(ga[0]) * acc1[i][j][1] + bfhi(gh[0]) * acc2[i][j][1];
                const float m2 = bflo(ga[1]) * acc1[i][j][2] + bflo(gh[1]) * acc2[i][j][2];
                const float m3 = bfhi(ga[1]) * acc1[i][j][3] + bfhi(gh[1]) * acc2[i][j][3];
                mo[i][j] = u32x2{pk2(m0, m1), pk2(m2, m3)};
            }
        __syncthreads();
#pragma unroll
        for (int i = 0; i < 4; ++i)
#pragma unroll
            for (int j = 0; j < 2; ++j) *(u32x2*)(lds + (wq * 32 + j * 16 + l15) * ES + (wp * 64 + i * 16 + lk * 4) * 2) = mo[i][j];
        __syncthreads();
#pragma unroll
        for (int q = 0; q < 4; ++q) {
            const int idx = tid + q * NT, row = idx >> 5, ch = idx & 31;
            *(u32x4*)(M + (size_t)(tok0 + row) * DM + n0 + ch * 8) = *(const u32x4*)(lds + row * ES + ch * 16);
        }
    }
}

DI void phase_f(const Params& p, unsigned char* lds) {
    constexpr int TILES = 4 * (BT / 256);
    const float* mod = (const float*)(p.ws + WS_MOD);
    for (int it = blockIdx.x; it < TILES; it += gridDim.x) {
        const int tid = get_tid(), lane = tid & 63, wave = tid >> 6, wp = wave >> 2, wq = wave & 3;
        const int tn = it & 3, tm = it >> 2;
        const int n0 = tn * 256, tok0 = tm * 256, b = tok0 >> 12;
        f32x4 acc[4][4];
#pragma unroll
        for (int i = 0; i < 4; ++i)
#pragma unroll
            for (int j = 0; j < 4; ++j) acc[i][j] = f32x4{0.f, 0.f, 0.f, 0.f};
        gemm_mainloop<4>(acc, RowLoader{(const bf16_t*)(p.ws + WS_WTO) + (size_t)n0 * DM, DM}, RowLoader{(const bf16_t*)(p.ws + WS_H) + (size_t)tok0 * DM, DM}, DM / 64, lds);
        const int l15 = lane & 15, lk = lane >> 4;
        constexpr int ES = 528;
        float ss[4] = {0.f, 0.f, 0.f, 0.f};
#pragma unroll
        for (int i = 0; i < 4; ++i) {
            const int n = n0 + wp * 64 + i * 16 + lk * 4;
            const f32x4 g1 = *(const f32x4*)(mod + b * 6144 + 2048 + n);
            const f32x4 s2 = *(const f32x4*)(mod + b * 6144 + 4096 + n), gf = *(const f32x4*)(p.in[I_NFFN] + n);
            const f32x4 gm = f32x4{gf[0] * (1.f + s2[0]), gf[1] * (1.f + s2[1]), gf[2] * (1.f + s2[2]), gf[3] * (1.f + s2[3])};
#pragma unroll
            for (int j = 0; j < 4; ++j) {
                const int tl = wq * 64 + j * 16 + l15;
                const f32x4 xv = *(const f32x4*)(p.in[I_X] + (size_t)(tok0 + tl) * DM + n);
                const f32x4 x1 = f32x4{xv[0] + g1[0] * acc[i][j][0], xv[1] + g1[1] * acc[i][j][1], xv[2] + g1[2] * acc[i][j][2], xv[3] + g1[3] * acc[i][j][3]};
                *(f32x4*)(p.out + (size_t)(tok0 + tl) * DM + n) = x1;
                ss[j] += x1[0] * x1[0] + x1[1] * x1[1] + x1[2] * x1[2] + x1[3] * x1[3];
                *(u32x2*)(lds + tl * ES + (wp * 64 + i * 16 + lk * 4) * 2) = u32x2{pk2(x1[0] * gm[0], x1[1] * gm[1]), pk2(x1[2] * gm[2], x1[3] * gm[3])};
            }
        }
#pragma unroll
        for (int j = 0; j < 4; ++j) {
            const float t = sum_x32(sum_x16(ss[j]));
            if (lk == 0) ((float*)(p.ws + WS_SSQ1))[(size_t)(tok0 + wq * 64 + j * 16 + l15) * 16 + tn * 4 + wp] = t;
        }
        __syncthreads();
        bf16_t* Y = (bf16_t*)(p.ws + WS_Y);
#pragma unroll
        for (int q = 0; q < 8; ++q) {
            const int idx = tid + q * NT, row = idx >> 5, ch = idx & 31;
            *(u32x4*)(Y + (size_t)(tok0 + row) * DM + n0 + ch * 8) = *(const u32x4*)(lds + row * ES + ch * 16);
        }
    }
}

DI void phase_h(const Params& p, unsigned char* lds) {
    constexpr int TILES = 8 * (BT / 256);
    float* rsb = (float*)(lds + 132 * 1024);
    bool pre = false;
    for (int it = blockIdx.x; it < TILES; it += gridDim.x) {
        const int tid = get_tid(), lane = tid & 63, wave = tid >> 6, wp = wave >> 2, wq = wave & 3;
        const int tn = it & 7, tm = it >> 3;
        const int n0 = tn * 256, tok0 = tm * 256, b = tok0 >> 12;
        const int it2 = it + (int)gridDim.x; const bool has2 = it2 < TILES;
        const int n2 = (has2 ? it2 & 7 : tn) * 256, tk2 = (has2 ? it2 >> 3 : tm) * 256;
        __syncthreads();
        if (tid < 256) {
            const float* sq = (const float*)(p.ws + WS_SSQ1) + (size_t)(tok0 + tid) * 16;
            const f32x4 a = *(const f32x4*)sq, c = *(const f32x4*)(sq + 4), d = *(const f32x4*)(sq + 8), e = *(const f32x4*)(sq + 12);
            const float ssq = (a[0] + a[1] + a[2] + a[3]) + (c[0] + c[1] + c[2] + c[3]) + (d[0] + d[1] + d[2] + d[3]) + (e[0] + e[1] + e[2] + e[3]);
            rsb[tid] = rsqrtf(ssq * (1.f / DM) + EPS);
        }
        f32x4 acc[4][4];
#pragma unroll
        for (int i = 0; i < 4; ++i)
#pragma unroll
            for (int j = 0; j < 4; ++j) acc[i][j] = f32x4{0.f, 0.f, 0.f, 0.f};
        gemm_mainloop<4>(acc, RowLoader{(const bf16_t*)(p.ws + WS_WTQ) + (size_t)n0 * DM, DM}, RowLoader{(const bf16_t*)(p.ws + WS_Y) + (size_t)tok0 * DM, DM}, DM / 64, lds, pre, has2,
                         RowLoader{(const bf16_t*)(p.ws + WS_WTQ) + (size_t)n2 * DM, DM}, RowLoader{(const bf16_t*)(p.ws + WS_Y) + (size_t)tk2 * DM, DM});
        pre = has2;
        bf16_t* QP = (bf16_t*)(p.ws + WS_G);
        const float* shq = (const float*)(p.ws + WS_SHQ) + b * 2048;
        const int l15 = lane & 15, lk = lane >> 4;
#pragma unroll
        for (int i = 0; i < 4; ++i) {
            const int n = n0 + wp * 64 + i * 16 + lk * 4;
            const f32x4 sh = *(const f32x4*)(shq + n);
#pragma unroll
            for (int j = 0; j < 4; ++j) {
                const int tl = wq * 64 + j * 16 + l15;
                const float rs = rsb[tl];
                *(u32x2*)(QP + (size_t)(tok0 + tl) * 2048 + n) = u32x2{pk2(rs * acc[i][j][0] + sh[0], rs * acc[i][j][1] + sh[1]), pk2(rs * acc[i][j][2] + sh[2], rs * acc[i][j][3] + sh[3])};
            }
        }
    }
}

DI void ins16(float (&L)[16], float v) {
#pragma unroll
    for (int i = 0; i < 16; ++i) { const float hi = fmaxf(L[i], v); v = fminf(L[i], v); L[i] = hi; }
}
DI void cex_desc(float& a, float& b) { const float hi = fmaxf(a, b), lo = fminf(a, b); a = hi; b = lo; }
DI void bitonic_merge16_desc(float (&v)[16]) {
#pragma unroll
    for (int j = 8; j > 0; j >>= 1)
#pragma unroll
        for (int i = 0; i < 16; ++i) if ((i ^ j) > i) cex_desc(v[i], v[i ^ j]);
}
DI void sort16_desc(float (&v)[16]) {
#pragma unroll
    for (int k = 2; k <= 16; k <<= 1)
#pragma unroll
        for (int j = k >> 1; j > 0; j >>= 1)
#pragma unroll
            for (int i = 0; i < 16; ++i) {
                const int l = i ^ j;
                if (l > i) { if ((i & k) == 0) cex_desc(v[i], v[l]); else cex_desc(v[l], v[i]); }
            }
}
DI void top16_merge(float (&a)[16], const float (&b)[16]) {
#pragma unroll
    for (int i = 0; i < 16; ++i) a[i] = fmaxf(a[i], b[15 - i]);
    bitonic_merge16_desc(a);
}
DI float pack_idx(float v, unsigned idx, unsigned mask) { return __uint_as_float((__float_as_uint(v) & ~mask) | idx); }
constexpr int PI_LIST = 0;
DI void peer_select_item(const Params& p, int item, unsigned char* lds) {
    const int tok0 = item * 128;
    __syncthreads();
    {
        const int tid = get_tid(), lane = tid & 63, wave = tid >> 6, b = tok0 >> 12;
        const float* sh2 = (const float*)(p.ws + WS_MOD) + b * 6144 + 3072 + lane * 16;
        float sh[16];
#pragma unroll
        for (int i = 0; i < 16; i += 4) { const f32x4 v = *(const f32x4*)(sh2 + i); sh[i] = v[0]; sh[i + 1] = v[1]; sh[i + 2] = v[2]; sh[i + 3] = v[3]; }
#pragma unroll 1
        for (int t = 0; t < 8; ++t) {
            const int tok = tok0 + wave * 8 + t;
            const bf16_t* yr = (const bf16_t*)(p.ws + WS_Y) + (size_t)tok * DM + lane * 16;
            const u32x4 y0 = *(const u32x4*)yr, y1 = *(const u32x4*)(yr + 8);
            const float rs = rsqrtf(sum16(((const float*)(p.ws + WS_SSQ1))[(size_t)tok * 16 + (lane & 15)]) * (1.f / DM) + EPS);
            float f[16];
#pragma unroll
            for (int q = 0; q < 4; ++q) { f[2 * q] = bflo(y0[q]); f[2 * q + 1] = bfhi(y0[q]); f[8 + 2 * q] = bflo(y1[q]); f[9 + 2 * q] = bfhi(y1[q]); }
            float mx = 0.f;
#pragma unroll
            for (int i = 0; i < 16; ++i) { f[i] = rs * f[i] + sh[i]; mx = fmaxf(mx, fabsf(f[i])); }
            mx = fmaxf(wave_max(mx), 1e-30f);
            const float qs = 127.f / mx;
            unsigned w8[4];
            int qsum = 0;
#pragma unroll
            for (int q = 0; q < 4; ++q) {
                const int q0 = __float2int_rn(f[4 * q] * qs), q1 = __float2int_rn(f[4 * q + 1] * qs), q2 = __float2int_rn(f[4 * q + 2] * qs), q3 = __float2int_rn(f[4 * q + 3] * qs);
                w8[q] = (q0 & 255) | ((q1 & 255) << 8) | ((q2 & 255) << 16) | ((unsigned)q3 << 24);
                qsum += q0 + q1 + q2 + q3;
            }
            *(u32x4*)(p.ws + WS_X8 + (size_t)tok * DM + lane * 16) = u32x4{w8[0], w8[1], w8[2], w8[3]};
            const float xs = wave_sum((float)qsum);
            if (lane == 0) ((f32x2*)(p.ws + WS_SX))[tok] = f32x2{mx * (1.f / 127.f), xs};
        }
    }
    {
#pragma unroll 1
        for (int sb = 0; sb < 4; ++sb) {
            const int tid = get_tid(), lane = tid & 63, hp = tid >> 6;
            const int r = lane & 31, hf = lane >> 5;
            const bf16_t* keys = (const bf16_t*)(p.ws + WS_KEYS) + (size_t)((hp & 1) * 8 + (hp >> 1)) * 128 * 128 + 8 * hf;
            const bf16_t* qp = (const bf16_t*)(p.ws + WS_G) + (size_t)(tok0 + r) * 2048 + hp * 128 + 8 * hf;
            bf16x8 bq[8];
#pragma unroll
            for (int ks = 0; ks < 8; ++ks) bq[ks] = *(const bf16x8*)(qp + (size_t)sb * 32 * 2048 + 16 * ks);
            f32x16 acc[4];
#pragma unroll
            for (int m = 0; m < 4; ++m)
#pragma unroll
                for (int i = 0; i < 16; ++i) acc[m][i] = 0.f;
#pragma unroll
            for (int ks = 0; ks < 8; ++ks) {
#pragma unroll
                for (int m = 0; m < 4; ++m) {
                    const bf16x8 ak = *(const bf16x8*)(keys + (size_t)(m * 32 + r) * 128 + 16 * ks);
                    acc[m] = MFMA32(ak, bq[ks], acc[m]);
                }
            }
            float V[4][16];
#define PK_SORT(m) do { _Pragma("unroll") for (int i = 0; i < 16; ++i) V[m][i] = pack_idx(acc[m][i], (unsigned)((m) * 32 + (i & 3) + 8 * (i >> 2) + 4 * hf), 127u); sort16_desc(V[m]); } while (0)
            PK_SORT(0); PK_SORT(1); top16_merge(V[0], V[1]); __builtin_amdgcn_sched_barrier(0);
            PK_SORT(2); PK_SORT(3); top16_merge(V[2], V[3]); __builtin_amdgcn_sched_barrier(0);
            top16_merge(V[0], V[2]);
#undef PK_SORT
            float (&L)[16] = V[0];
            const int t3 = get_tid(), hf3 = (t3 >> 5) & 1, r3 = t3 & 31, hp3 = t3 >> 6;
            float P[16];
#pragma unroll
            for (int i = 0; i < 16; ++i) {
                auto sw = __builtin_amdgcn_permlane32_swap(__float_as_uint(L[i]), __float_as_uint(L[i]), false, false);
                P[i] = hf3 ? __uint_as_float(sw[0]) : __uint_as_float(sw[1]);
            }
            top16_merge(L, P);
            if (hf3 == 0) {
                float* dst = (float*)(lds + PI_LIST) + ((sb * 32 + r3) * 16 + hp3) * 16;
#pragma unroll
                for (int i = 0; i < 16; i += 4) *(f32x4*)(dst + i) = f32x4{L[i], L[i + 1], L[i + 2], L[i + 3]};
            }
        }
    }
    __syncthreads();
    {
        const int tid = get_tid();
        {
            const int tok = tid >> 3, h = tid & 7;
            const float* l1 = (const float*)(lds + PI_LIST) + (tok * 16 + 2 * h) * 16;
            const float* l2 = l1 + 16;
            float v1[16], v2[16];
#pragma unroll
            for (int i = 0; i < 16; i += 4) {
                const f32x4 a = *(const f32x4*)(l1 + i), b = *(const f32x4*)(l2 + i);
                v1[i] = a[0]; v1[i + 1] = a[1]; v1[i + 2] = a[2]; v1[i + 3] = a[3];
                v2[i] = b[0]; v2[i + 1] = b[1]; v2[i + 2] = b[2]; v2[i + 3] = b[3];
            }
            float B[16];
#pragma unroll
            for (int i = 0; i < 16; ++i) B[i] = -3.0e38f;
#pragma unroll
            for (int i = 0; i < 16; ++i)
#pragma unroll
                for (int j = 0; j < 16; ++j)
                    if ((i + 1) * (j + 1) <= 16) ins16(B, pack_idx(v1[i] + v2[j], (unsigned)(i * 16 + j), 255u));
            float e[16], sum = 0.f;
#pragma unroll
            for (int k = 0; k < 16; ++k) { e[k] = __expf(B[k] - B[0]); sum += e[k]; }
            const float inv = 1.f / sum;
            int* ex = (int*)(p.ws + WS_EXPI) + (size_t)(tok0 + tok) * 128 + h * 16;
            float* gt = (float*)(p.ws + WS_GATE) + ((size_t)(tok0 + tok) * 128 + h * 16) * 2;
            const float* usc = (const float*)(p.ws + WS_USC);
            int ev[16]; float gv[16], sv[16];
#pragma unroll
            for (int k = 0; k < 16; ++k) {
                const unsigned ij = __float_as_uint(B[k]) & 255u;
                const unsigned i1 = __float_as_uint(l1[ij >> 4]) & 127u, i2 = __float_as_uint(l2[ij & 15u]) & 127u;
                ev[k] = (int)(i1 * 128u + i2);
                gv[k] = e[k] * inv;
                sv[k] = usc[ev[k]];
            }
#pragma unroll
            for (int k = 0; k < 16; k += 4) *(u32x4*)(ex + k) = u32x4{(unsigned)ev[k], (unsigned)ev[k + 1], (unsigned)ev[k + 2], (unsigned)ev[k + 3]};
#pragma unroll
            for (int k = 0; k < 16; k += 2) *(f32x4*)(gt + 2 * k) = f32x4{gv[k], sv[k], gv[k + 1], sv[k + 1]};
        }
    }
}
DI void phase_i1(const Params& p, unsigned char* lds) {
    for (int it = blockIdx.x; it < BT / 128; it += gridDim.x) peer_select_item(p, it, lds);
}

DI float dot16_fp8(const u32x4& w, const float (&x)[16]) {
    float d = 0.f;
#pragma unroll
    for (int i = 0; i < 4; ++i) {
        const auto lo = __builtin_amdgcn_cvt_pk_f32_fp8((int)w[i], false);
        const auto hi = __builtin_amdgcn_cvt_pk_f32_fp8((int)w[i], true);
        d += lo[0] * x[4 * i] + lo[1] * x[4 * i + 1] + hi[0] * x[4 * i + 2] + hi[1] * x[4 * i + 3];
    }
    return d;
}
template<int NPART, class F> DI void run_partitioned(const Params& p, unsigned char* lds, int qbase, int nitems, F&& body) {
    unsigned* ctl = (unsigned*)(p.ws + WS_CTL);
    volatile LAS unsigned* slot = (volatile LAS unsigned*)(LAS unsigned char*)(lds + LDS_ST_OFF + 8);
    const int x0 = (int)(xb_xcc_id() & 7u);
#pragma unroll 1
    for (int pp = 0; pp < NPART; ++pp) {
        const int part = (NPART == 8) ? ((x0 + pp) & 7) : ((((x0 + (pp >> 1)) & 7)) + 8 * (pp & 1));
        for (;;) {
            __syncthreads();
            if (get_tid() == 0) slot[0] = atomicAdd(ctl + qbase + 64 * part, 1u);
            __syncthreads();
            const int it = __builtin_amdgcn_readfirstlane((int)slot[0]);
            if (it >= nitems) break;
            body(part, it);
        }
    }
}
constexpr int CTL_QUEUE_I2 = 8320, CTL_QUEUE_I3 = 9408;
constexpr int UW_BYTES = 5120, UW_GT = 2048, UW_LIST = 4096;
DI void peer_u_chunk(const Params& p, int part, int chunk, unsigned char* lds) {
    const int tid = get_tid(), lane = tid & 63, wave = __builtin_amdgcn_readfirstlane(tid >> 6);
    unsigned char* wl = lds + wave * UW_BYTES;
    unsigned* lst = (unsigned*)(wl + UW_LIST);
    const f32x2* gts = (const f32x2*)(wl + UW_GT);
    const int h = lane >> 5, l5 = lane & 31;
    const unsigned char* UT4 = p.ws + WS_UT + l5 * 16;
    const int tokw = chunk * 256 + wave * 2;
    int pe[4]; u32x4 ph[2]; f32x2 pg[4]; f32x2 psx[2];
#define U_PREFETCH(tok) do { \
        const int* ex_ = (const int*)(p.ws + WS_EXPI) + (size_t)(tok) * 128 + lane; \
        const f32x2* gt_ = (const f32x2*)(p.ws + WS_GATE) + (size_t)(tok) * 128 + lane; \
        const unsigned char* hr_ = p.ws + WS_X8 + (size_t)(tok) * DM + lane * 16; \
        pe[0] = ex_[0]; pe[1] = ex_[64]; pe[2] = ex_[128]; pe[3] = ex_[192]; \
        pg[0] = gt_[0]; pg[1] = gt_[64]; pg[2] = gt_[128]; pg[3] = gt_[192]; \
        ph[0] = *(const u32x4*)hr_; ph[1] = *(const u32x4*)(hr_ + DM); \
        psx[0] = ((const f32x2*)(p.ws + WS_SX))[tok]; psx[1] = ((const f32x2*)(p.ws + WS_SX))[(tok) + 1]; } while (0)
    U_PREFETCH(tokw);
#pragma unroll 1
    for (int sub = 0; sub < 8; ++sub) {
        const int tok0 = tokw + sub * 32;
        const f32x2 sx0 = psx[0], sx1 = psx[1];
        *(u32x4*)(wl + lane * 16) = ph[0]; *(u32x4*)(wl + 1024 + lane * 16) = ph[1];
        int cnt = 0;
#pragma unroll
        for (int g = 0; g < 4; ++g) {
            ((f32x2*)(wl + UW_GT))[g * 64 + lane] = pg[g];
            const bool m = (pe[g] >> 11) == part;
            const unsigned long long bm = __ballot(m);
            const int pos = cnt + __builtin_amdgcn_mbcnt_hi((unsigned)(bm >> 32), __builtin_amdgcn_mbcnt_lo((unsigned)bm, 0u));
            if (m) lst[pos] = ((unsigned)(g * 64 + lane) << 16) | (unsigned)pe[g];
            cnt += __popcll(bm);
        }
        if (sub + 1 < 8) U_PREFETCH(tok0 + 32);
#pragma unroll 1
        for (int base = 0; base < cnt; base += 16) {
            u32x4 row[8]; unsigned en[8];
#pragma unroll
            for (int q = 0; q < 8; ++q) {
                en[q] = lst[min(base + 2 * q + h, cnt - 1)];
                row[q] = *(const u32x4*)(UT4 + (size_t)(en[q] & 0x3fffu) * 512);
            }
            int d[8];
#pragma unroll
            for (int q = 0; q < 8; ++q) {
                const unsigned char* xr = wl + (en[q] >> 23) * 1024 + l5 * 32;
                const u32x4 xa = *(const u32x4*)xr, xb = *(const u32x4*)(xr + 16);
                int ai = 0;
#pragma unroll
                for (int i = 0; i < 4; ++i) {
                    const unsigned lo = row[q][i] & 0x0F0F0F0Fu, hi = (row[q][i] >> 4) & 0x0F0F0F0Fu;
                    ai = __builtin_amdgcn_sdot4((int)lo, (int)((i < 2) ? xa[2 * i] : xb[2 * i - 4]), ai, false);
                    ai = __builtin_amdgcn_sdot4((int)hi, (int)((i < 2) ? xa[2 * i + 1] : xb[2 * i - 3]), ai, false);
                }
                d[q] = ai;
            }
            int r4[4], r2[2];
#pragma unroll
            for (int i = 0; i < 4; ++i) { auto sw = __builtin_amdgcn_permlane16_swap((unsigned)d[i], (unsigned)d[i + 4], false, false); r4[i] = (int)(sw[0] + sw[1]); }
            const bool b3 = (lane & 8) != 0, b2 = (lane & 4) != 0;
#pragma unroll
            for (int i = 0; i < 2; ++i) r2[i] = (b3 ? r4[i + 2] : r4[i]) + dppi<0x128>(b3 ? r4[i] : r4[i + 2]);
            int ai = (b2 ? r2[1] : r2[0]) + dppi<0x141>(b2 ? r2[0] : r2[1]);
            ai += dppi<0xB1>(ai); ai += dppi<0x4E>(ai);
            const int qi = ((lane >> 2) & 7);
            const int ei = base + 2 * (4 * ((qi >> 2) & 1) + 2 * ((qi >> 1) & 1) + (qi & 1)) + h;
            const unsigned ent = lst[min(ei, cnt - 1)];
            const int idx = (int)(ent >> 16);
            const f32x2 gs = gts[idx];
            const f32x2 sxv = (idx >> 7) ? sx1 : sx0;
            const float a = ((float)ai - 8.f * sxv[1]) * (gs[1] * sxv[0]);
            const float y = 0.7978845608028654f * (a + 0.044715f * a * a * a);
            const float th = 1.f - 2.f / (__expf(2.f * y) + 1.f);
            const float w = 0.5f * a * (1.f + th) * gs[0];
            if ((lane & 3) == 0 && ei < cnt) ((u32x2*)(p.ws + WS_PAIRS))[(size_t)tok0 * 128 + idx] = u32x2{ent & 0x3fffu, __float_as_uint(w)};
        }
    }
#undef U_PREFETCH
}
DI void phase_i2(const Params& p, unsigned char* lds) {
    run_partitioned<8>(p, lds, CTL_QUEUE_I2, BT / 256, [&](int part, int it) { peer_u_chunk(p, part, it, lds); });
}
DI void peer_v_chunk(const Params& p, int part, int chunk, unsigned char* lds) {
    const int tid = get_tid(), lane = tid & 63, wave = __builtin_amdgcn_readfirstlane(tid >> 6);
    unsigned char* wl = lds + wave * 1024;
    const int es = lane >> 3, ch = lane & 7;
    const unsigned char* VT8 = p.ws + WS_VTAB + (size_t)part * 16384 * 128 + ch * 16;
    const float* mod = (const float*)(p.ws + WS_MOD);
    const int col = part * 128 + 16 * ch + 2 * es;
    const int tokw = chunk * 256 + wave;
    u32x4 pp = *((const u32x4*)(p.ws + WS_PAIRS + (size_t)tokw * 1024) + lane);
#pragma unroll 1
    for (int step = 0; step < 16; ++step) {
        const int tok = tokw + step * 16, b = tok >> 12;
        *(u32x4*)(wl + lane * 16) = pp;
        if (step + 1 < 16) pp = *((const u32x4*)(p.ws + WS_PAIRS + (size_t)(tok + 16) * 1024) + lane);
        float* xo = p.out + (size_t)tok * DM + col;
        const f32x2 x1 = *(const f32x2*)xo;
        const f32x2 g2 = *(const f32x2*)(mod + b * 6144 + 5120 + col);
        f32x2 acc[8];
#pragma unroll
        for (int i = 0; i < 8; ++i) acc[i] = f32x2{0.f, 0.f};
        const u32x2* pr = (const u32x2*)wl + es;
#pragma unroll 1
        for (int ih = 0; ih < 2; ++ih) {
            u32x2 pe[8]; u32x4 row[8];
#pragma unroll
            for (int q = 0; q < 8; ++q) { pe[q] = pr[(ih * 8 + q) * 8]; row[q] = *(const u32x4*)(VT8 + (size_t)pe[q][0] * 128); }
#pragma unroll
            for (int q = 0; q < 8; ++q) {
                const float w = __uint_as_float(pe[q][1]);
                const f32x2 w2 = f32x2{w, w};
#pragma unroll
                for (int i = 0; i < 4; ++i) {
                    const f32x2 lo = __builtin_amdgcn_cvt_pk_f32_fp8((int)row[q][i], false);
                    const f32x2 hi = __builtin_amdgcn_cvt_pk_f32_fp8((int)row[q][i], true);
                    acc[2 * i] += w2 * lo; acc[2 * i + 1] += w2 * hi;
                }
            }
        }
        float a16[16];
#pragma unroll
        for (int i = 0; i < 8; ++i) { a16[2 * i] = acc[i][0]; a16[2 * i + 1] = acc[i][1]; }
        float r8[8], r4[4], r2[2];
#pragma unroll
        for (int i = 0; i < 8; ++i) { auto sw = __builtin_amdgcn_permlane32_swap(__float_as_uint(a16[i]), __float_as_uint(a16[i + 8]), false, false); r8[i] = __uint_as_float(sw[0]) + __uint_as_float(sw[1]); }
#pragma unroll
        for (int i = 0; i < 4; ++i) { auto sw = __builtin_amdgcn_permlane16_swap(__float_as_uint(r8[i]), __float_as_uint(r8[i + 4]), false, false); r4[i] = __uint_as_float(sw[0]) + __uint_as_float(sw[1]); }
        const bool b3 = (lane & 8) != 0;
#pragma unroll
        for (int i = 0; i < 2; ++i) { const float keep = b3 ? r4[i + 2] : r4[i], send = b3 ? r4[i] : r4[i + 2]; r2[i] = keep + dppf<0x128>(send); }
        const float xa = x1[0] + g2[0] * r2[0] * (1.f / VSCALE), xb = x1[1] + g2[1] * r2[1] * (1.f / VSCALE);
        *(f32x2*)xo = f32x2{xa, xb};
        const float ss = wave_sum(xa * xa + xb * xb);
        if (lane == 0) ((float*)(p.ws + WS_SSQ))[(size_t)tok * 8 + part] = ss;
    }
}
DI void phase_i3(const Params& p, unsigned char* lds) {
    run_partitioned<8>(p, lds, CTL_QUEUE_I3, BT / 256, [&](int part, int it) { peer_v_chunk(p, part, it, lds); });
}
DI void phase_i4(const Params& p) {
    const bool bad = xb_ld((unsigned*)(p.ws + WS_CTL) + CTL_BADTID) != 0u || xb_ld((unsigned*)(p.ws + WS_CTL) + XB_TMO) != 0u;
    for (int it = blockIdx.x; it < BT / 16; it += gridDim.x) {
        const int tid = get_tid(), lane = tid & 63, row = it * 16 + (tid >> 6);
        const float* sq = (const float*)(p.ws + WS_SSQ) + (size_t)row * 8;
        const f32x4 s0 = *(const f32x4*)sq, s1 = *(const f32x4*)(sq + 4);
        const float ss = s0[0] + s0[1] + s0[2] + s0[3] + s1[0] + s1[1] + s1[2] + s1[3];
        float rs = rsqrtf(ss * (1.f / DM) + EPS);
        if (bad) rs = __builtin_nanf("");
        float* o = p.out + (size_t)row * DM;
#pragma unroll
        for (int j = 0; j < 4; ++j) {
            const int c = j * 256 + lane * 4;
            const f32x4 v = *(const f32x4*)(o + c), g = *(const f32x4*)(p.in[I_FNG] + c);
            *(f32x4*)(o + c) = f32x4{v[0] * rs * g[0], v[1] * rs * g[1], v[2] * rs * g[2], v[3] * rs * g[3]};
        }
    }
}

__global__ void __launch_bounds__(NT) mega(Params p) {
    unsigned char* lds = g_lds;
    volatile LAS unsigned* st = (volatile LAS unsigned*)(LAS unsigned char*)(lds + LDS_ST_OFF);
    {
        const unsigned hw = __builtin_amdgcn_s_getreg((5 << 11) | 4);
        if ((threadIdx.x & 63) == 0) g_lds[LDS_WTAB_OFF + hw] = (unsigned char)(threadIdx.x >> 6);
        if (threadIdx.x < 2) st[threadIdx.x] = 0u;
        __syncthreads();
        if (get_tid() != (int)threadIdx.x) ((unsigned*)(p.ws + WS_CTL))[CTL_BADTID] = 1u;
    }
    XcdBarrier bar = xcd_barrier_post((unsigned*)(p.ws + WS_CTL), st);
    float* sm = (float*)lds;

#define STAMP(k, which) do { if (PROBE_PHASE == (k) && blockIdx.x == 0 && get_tid() == 0) ((volatile unsigned long long*)(lds + LDS_PROBE_OFF))[which] = __builtin_amdgcn_s_memrealtime(); } while (0)
    STAMP(21, 0); STAMP(30, 0); STAMP(31, 0);
    STAMP(0, 0); phase_a(p, sm);   xcd_barrier(bar); STAMP(0, 1);
    STAMP(1, 0); phase_b(p, sm);   xcd_barrier(bar); STAMP(1, 1);
    if (PROBE_PHASE == 20) { STAMP(20, 0); xcd_barrier(bar); xcd_barrier(bar); xcd_barrier(bar); xcd_barrier(bar); STAMP(20, 1); }
    STAMP(2, 0); phase_c(p, lds);  xcd_barrier(bar); STAMP(2, 1);
    STAMP(3, 0); phase_d(p, lds);  xcd_barrier(bar); STAMP(3, 1);
    STAMP(4, 0); phase_d2(p, lds); xcd_barrier(bar); STAMP(4, 1);
    STAMP(5, 0); phase_e(p, lds);  xcd_barrier(bar); STAMP(5, 1);
    STAMP(6, 0); phase_f(p, lds);  xcd_barrier(bar); STAMP(6, 1);
    STAMP(8, 0); phase_h(p, lds);  xcd_barrier(bar); STAMP(8, 1);
    STAMP(9, 0); phase_i1(p, lds); xcd_barrier(bar); STAMP(9, 1);
    STAMP(10, 0); phase_i2(p, lds); xcd_barrier(bar); STAMP(10, 1);
    STAMP(11, 0); phase_i3(p, lds); xcd_barrier(bar); STAMP(11, 1);
    STAMP(12, 0); phase_i4(p);
    if (PROBE_PHASE >= 0) {
        xcd_barrier(bar); STAMP(12, 1); STAMP(21, 1);
        if (blockIdx.x == 0 && get_tid() == 0) {
            volatile unsigned long long* ts = (volatile unsigned long long*)(lds + LDS_PROBE_OFF);
            p.out[0] += (float)(ts[1] - ts[0]) * (0.01f / PROBE_SCALE);
        }
    }
}

extern "C" void kernel_launch(void* const* d_in, const int* in_sizes, int n_in, void* d_out, int out_size, void* d_ws, size_t ws_size, hipStream_t stream) {
    static int grid = 0;
    if (grid == 0) {
        int dev = 0, cus = 0;
        if (hipGetDevice(&dev) != hipSuccess || hipDeviceGetAttribute(&cus, hipDeviceAttributeMultiprocessorCount, dev) != hipSuccess) { fprintf(stderr, "kernel_launch: device query failed\n"); grid = -1; return; }
        if (n_in != N_IN || ws_size < WS_END) { fprintf(stderr, "kernel_launch: unexpected n_in %d or ws_size %zu (< %zu)\n", n_in, ws_size, (size_t)WS_END); grid = -1; return; }
        grid = cus;
    }
    if (grid < 0) return;
    (void)hipMemsetAsync((char*)d_ws + WS_CTL, 0, 64 * 1024, stream);
    Params p{};
    for (int i = 0; i < N_IN; ++i) p.in[i] = (const float*)d_in[i];
    p.out = (float*)d_out; p.ws = (unsigned char*)d_ws;
    hipLaunchKernelGGL(mega, dim3(grid), dim3(NT), 0, stream, p);
}
```

```cpp
#include <hip/hip_runtime.h>
#include <stdint.h>
#include <cstdio>

#define DI __device__ __forceinline__
#define LAS __attribute__((address_space(3)))
typedef unsigned short bf16_t;
typedef short bf16x8 __attribute__((ext_vector_type(8)));
typedef short s16x4 __attribute__((ext_vector_type(4)));
typedef float f32x4 __attribute__((ext_vector_type(4)));
typedef float f32x2 __attribute__((ext_vector_type(2)));
typedef float f32x16 __attribute__((ext_vector_type(16)));
typedef unsigned u32x4 __attribute__((ext_vector_type(4)));
typedef unsigned u32x2 __attribute__((ext_vector_type(2)));

#ifndef PROBE_PHASE
#define PROBE_PHASE (-1)
#endif
#ifndef SHADOW
#define SHADOW 0
#endif
#ifndef PROBE_SCALE
#define PROBE_SCALE 100.f
#endif
constexpr int BATCH = 8, SEQ = 4096, DM = 1024, BT = BATCH * SEQ;
constexpr int CTX = 256, TK = SEQ + CTX;
constexpr int NH = 8, NKV = 2, HD = 64;
constexpr int QD = 512, KVD = 128, HYD = 512, HYC = 1536, GC = 2048, INC = 4352;
constexpr int PH = 8, PNK = 128, PDK = 256, PTOP = 16;
constexpr float EPS = 1e-6f;
constexpr int NT = 1024;

enum { I_X = 0, I_C, I_CTX, I_CCTX, I_ADAW, I_ADAB, I_NMIX, I_NFFN, I_WIN, I_QNG, I_KNG, I_HCW, I_HCB,
       I_HW1, I_HB1, I_HW2, I_HB2, I_HW3, I_HB3, I_HW4, I_HFREQ, I_HSKIP, I_WAO, I_WHO, I_WO, I_PWQ, I_PK1, I_PK2, I_PU, I_PV, I_FNG, N_IN };

constexpr size_t MB = 1024 * 1024;
constexpr size_t WS_CTL   = 0;
constexpr size_t WS_MOD   = 64 * 1024;
constexpr size_t WS_ROPE  = WS_MOD + 9 * 6144 * 4;
static_assert(WS_ROPE + 16 * 1024 + 8 * 2048 * 4 + 4096 <= 512 * 1024, "ws");
constexpr size_t WS_PART  = 512 * 1024;
constexpr size_t WS_WTIN  = 3 * MB;
constexpr size_t WS_WTAO  = WS_WTIN + (size_t)INC * DM * 2;
constexpr size_t WS_WTHO  = WS_WTAO + (size_t)DM * QD * 2;
constexpr size_t WS_WTO   = WS_WTHO + (size_t)DM * HYD * 2;
constexpr size_t WS_WTQ   = WS_WTO + (size_t)DM * DM * 2;
constexpr size_t WS_KEYS  = WS_WTQ + (size_t)2048 * DM * 2;
constexpr size_t WS_R     = WS_KEYS + (size_t)2 * 8 * 128 * 128 * 2;
constexpr size_t WS_KB    = WS_R + (size_t)2 * 512 * 8192 * 2;
constexpr size_t WS_VT    = WS_KB + (size_t)BATCH * NKV * TK * HD * 2;
constexpr size_t WS_HC    = WS_VT + (size_t)BATCH * NKV * TK * HD * 2;
constexpr size_t WS_H     = 60 * MB;
constexpr size_t WS_G     = WS_H + 64 * MB;
constexpr size_t WS_ZT    = WS_G + 128 * MB;
constexpr size_t WS_Q     = WS_ZT + 96 * MB;
constexpr size_t WS_ATT   = WS_Q + 32 * MB;
constexpr size_t WS_HYT   = WS_ATT + 32 * MB;
constexpr size_t WS_TAB   = WS_HYT + 32 * MB;
constexpr size_t WS_END   = WS_TAB + 32 * MB;
static_assert(WS_HC + (size_t)2048 * DM * 2 <= WS_H, "ws overlap");
constexpr size_t WS_FRAW  = WS_ATT;
constexpr size_t WS_HY    = WS_Q;
constexpr size_t WS_UT    = WS_TAB;
constexpr size_t WS_VSC   = WS_PART + 2 * MB + 320 * 1024;
constexpr size_t WS_VTAB  = WS_TAB + 16 * MB;
constexpr size_t WS_EXPI  = WS_ATT;
constexpr size_t WS_GATE  = WS_Q;
constexpr size_t WS_PAIRS = WS_HYT;
constexpr size_t WS_SSQ   = WS_PART + 1 * MB;
constexpr size_t WS_USC   = WS_PART + 2 * MB;
constexpr size_t WS_Y     = WS_ZT;
constexpr size_t WS_X8    = WS_ZT + 64 * MB;
constexpr size_t WS_SSQ1  = WS_ATT + 16 * MB;
constexpr size_t WS_SX    = WS_PART + 2 * MB + 64 * 1024;
constexpr size_t WS_SHQ   = WS_ROPE + 16 * 1024;
constexpr size_t WS_FSC   = WS_SHQ + 64 * 1024;

constexpr int CTL_BADTID = 8000;
DI unsigned f2bf(float f) { unsigned u = __builtin_bit_cast(unsigned, f); return (u + 0x7fffu + ((u >> 16) & 1u)) >> 16; }
DI unsigned pk2(float lo, float hi) { return f2bf(lo) | (f2bf(hi) << 16); }
DI float bf2f(unsigned short b) { return __builtin_bit_cast(float, (unsigned)b << 16); }
DI float bflo(unsigned u) { return __builtin_bit_cast(float, u << 16); }
DI float bfhi(unsigned u) { return __builtin_bit_cast(float, u & 0xffff0000u); }
DI float red2pi(float x) { const float k = rintf(x * 0.15915494309189535f); float r = fmaf(-k, 6.2831854820251465f, x); return fmaf(-k, -1.7484555e-7f, r); }
DI float fsin(float x) { return __sinf(red2pi(x)); }
DI float fcos(float x) { return __cosf(red2pi(x)); }
constexpr int LDS_BYTES = 160 * 1024;
constexpr int LDS_ST_OFF = LDS_BYTES - 16;
constexpr int LDS_PROBE_OFF = LDS_BYTES - 16 - 32;
constexpr int LDS_WTAB_OFF = LDS_BYTES - 16 - 32 - 64;
constexpr int LDS_USER = LDS_WTAB_OFF;
__shared__ __attribute__((aligned(16))) unsigned char g_lds[LDS_BYTES];
DI s16x4 lds_rd64(const unsigned char* ptr) { return *(const volatile LAS s16x4*)(const LAS unsigned char*)ptr; }
DI int get_tid() {
    const unsigned hw = __builtin_amdgcn_s_getreg((5 << 11) | 4);
    unsigned w = g_lds[LDS_WTAB_OFF + hw];
    w = __builtin_amdgcn_readfirstlane(w);
    int t;
    asm volatile("v_mbcnt_lo_u32_b32 %0, -1, 0\n\tv_mbcnt_hi_u32_b32 %0, -1, %0\n\tv_lshl_or_b32 %0, %1, 6, %0" : "=&v"(t) : "s"(w));
    return t;
}
template<int CTRL> DI float dppf(float v) { return __uint_as_float(__builtin_amdgcn_update_dpp(0u, __float_as_uint(v), CTRL, 0xF, 0xF, true)); }
template<int CTRL> DI int dppi(int v) { return (int)__builtin_amdgcn_update_dpp(0u, (unsigned)v, CTRL, 0xF, 0xF, true); }
DI float sum16(float v) { v += dppf<0xB1>(v); v += dppf<0x4E>(v); v += dppf<0x141>(v); v += dppf<0x140>(v); return v; }
DI float sum_x16(float v) { auto r = __builtin_amdgcn_permlane16_swap(__float_as_uint(v), __float_as_uint(v), false, false); return __uint_as_float(r[0]) + __uint_as_float(r[1]); }
DI float sum_x32(float v) { auto r = __builtin_amdgcn_permlane32_swap(__float_as_uint(v), __float_as_uint(v), false, false); return __uint_as_float(r[0]) + __uint_as_float(r[1]); }
DI float max_x32(float v) { auto r = __builtin_amdgcn_permlane32_swap(__float_as_uint(v), __float_as_uint(v), false, false); return fmaxf(__uint_as_float(r[0]), __uint_as_float(r[1])); }
DI float wave_sum(float v) { return sum_x32(sum_x16(sum16(v))); }
DI float wave_max(float v) {
    v = fmaxf(v, dppf<0xB1>(v)); v = fmaxf(v, dppf<0x4E>(v)); v = fmaxf(v, dppf<0x141>(v)); v = fmaxf(v, dppf<0x140>(v));
    { auto r = __builtin_amdgcn_permlane16_swap(__float_as_uint(v), __float_as_uint(v), false, false); v = fmaxf(__uint_as_float(r[0]), __uint_as_float(r[1])); }
    { auto r = __builtin_amdgcn_permlane32_swap(__float_as_uint(v), __float_as_uint(v), false, false); v = fmaxf(__uint_as_float(r[0]), __uint_as_float(r[1])); }
    return v;
}


#define XB_TMO      128
#define XB_XCNT(j)  (256  + 64 * (j))
#define XB_XSUB(j)  (1280 + 64 * (j))
#define XB_XGEN(j)  (2304 + 64 * (j))
#define XB_TOP      3328
#define XB_TOPGEN   3392
#define XCD_BAR_WORDS 3456
#define XB_SPIN_CAP (1u << 27)
DI unsigned xb_ld(unsigned* p)              { return __hip_atomic_load(p, __ATOMIC_RELAXED, __HIP_MEMORY_SCOPE_AGENT); }
DI unsigned xb_add(unsigned* p, unsigned v) { return __hip_atomic_fetch_add(p, v, __ATOMIC_RELAXED, __HIP_MEMORY_SCOPE_AGENT); }
DI unsigned xb_xcc_id() { return (unsigned)__builtin_amdgcn_s_getreg((3 << 11) | 20) & 0xFu; }
#define XB_SPIN(cond, bar) do { unsigned _sp = 0; while (cond) { __builtin_amdgcn_s_sleep(1); \
    if ((++_sp & 255u) == 0u) { if (xb_ld(&(bar)[XB_TMO])) break; if (_sp > XB_SPIN_CAP) { atomicAdd(&(bar)[XB_TMO], 1u); break; } } } } while (0)
struct XcdBarrier { unsigned* bar; unsigned x; volatile LAS unsigned* st; };
DI XcdBarrier xcd_barrier_post(unsigned* bar, volatile LAS unsigned* st) {
    XcdBarrier b; b.bar = bar; b.x = xb_xcc_id(); b.st = st;
    if (get_tid() == 0) (void)xb_add(&bar[XB_XCNT(b.x)], 1u);
    return b;
}
DI void xcd_barrier_complete(unsigned* bar, unsigned x, unsigned& nloc, unsigned& nx) {
    const unsigned G = gridDim.x * gridDim.y * gridDim.z;
    unsigned sum, cnt, mine, sp = 0u;
    for (;;) {
        sum = 0u; cnt = 0u; mine = 0u;
#pragma unroll
        for (unsigned j = 0; j < 16; ++j) { const unsigned c = xb_ld(&bar[XB_XCNT(j)]); sum += c; cnt += (c > 0u) ? 1u : 0u; mine = (j == x) ? c : mine; }
        if (sum == G) break;
        __builtin_amdgcn_s_sleep(1);
        if ((++sp & 255u) == 0u) { if (xb_ld(&bar[XB_TMO])) break; if (sp > XB_SPIN_CAP) { atomicAdd(&bar[XB_TMO], 1u); break; } }
    }
    nloc = mine > 0u ? mine : 1u; nx = cnt > 0u ? cnt : 1u;
}
DI void xcd_barrier(const XcdBarrier& b) {
    asm volatile("s_waitcnt vmcnt(0)" ::: "memory");
    __syncthreads();
    if (get_tid() == 0) {
        unsigned* bar = b.bar;
        __builtin_amdgcn_s_waitcnt(0);
        unsigned nloc = b.st[0], nx = b.st[1];
        if (nloc == 0u) { xcd_barrier_complete(bar, b.x, nloc, nx); b.st[0] = nloc; b.st[1] = nx; }
        const unsigned old = xb_add(&bar[XB_XSUB(b.x)], 1u);
        const unsigned gen = old / nloc;
        if (old + 1u == (gen + 1u) * nloc) {
            __builtin_amdgcn_fence(__ATOMIC_RELEASE, "agent");
            asm volatile("s_waitcnt vmcnt(0)" ::: "memory");
            const unsigned og = xb_add(&bar[XB_TOP], 1u);
            const unsigned tg = og / nx;
            if (og + 1u == (tg + 1u) * nx) xb_add(&bar[XB_TOPGEN], 1u);
            else XB_SPIN(xb_ld(&bar[XB_TOPGEN]) == tg, bar);
            __builtin_amdgcn_fence(__ATOMIC_ACQUIRE, "agent");
            xb_add(&bar[XB_XGEN(b.x)], 1u);
            asm volatile("s_waitcnt vmcnt(0)" ::: "memory");
        } else {
            XB_SPIN(xb_ld(&bar[XB_XGEN(b.x)]) == gen, bar);
            __builtin_amdgcn_fence(__ATOMIC_ACQUIRE, "agent");
            asm volatile("s_waitcnt vmcnt(0)" ::: "memory");
        }
    }
    __syncthreads();
}

struct Params { const float* in[N_IN]; float* out; unsigned char* ws; };


DI void transpose_tile(const float* __restrict__ W, int K, int N, bf16_t* __restrict__ Wt, int tile, float* sm) {
    const int tid = get_tid();
    const int ntn = N / 256, tk = tile / ntn, tn = tile % ntn;
    __syncthreads();
#pragma unroll
    for (int i = 0; i < 4; ++i) {
        const int idx = tid + i * NT, kk = idx >> 6, n4 = (idx & 63) * 4;
        const f32x4 v = *(const f32x4*)(W + (size_t)(tk * 64 + kk) * N + tn * 256 + n4);
        float* d = sm + kk * 257 + n4;
        d[0] = v[0]; d[1] = v[1]; d[2] = v[2]; d[3] = v[3];
    }
    __syncthreads();
#pragma unroll
    for (int i = 0; i < 2; ++i) {
        const int idx = tid + i * NT, nn = idx & 255, kg = idx >> 8;
        const float* c = sm + kg * 8 * 257 + nn;
        *(u32x4*)(Wt + (size_t)(tn * 256 + nn) * K + tk * 64 + kg * 8) = u32x4{pk2(c[0], c[257]), pk2(c[2 * 257], c[3 * 257]), pk2(c[4 * 257], c[5 * 257]), pk2(c[6 * 257], c[7 * 257])};
    }
}

DI void mod_item(const Params& p, int item, float* sm) {
    const int tid = get_tid();
    float* sc = sm;
    float* red = sm + 9 * 1024;
    __syncthreads();
    for (int i = tid; i < 9 * 1024; i += NT) {
        const float v = (i < 8 * 1024) ? p.in[I_C][i] : p.in[I_CCTX][i - 8 * 1024];
        sc[i] = v / (1.f + __expf(-v));
    }
    __syncthreads();
    const int col = tid & 15, kg = tid >> 4, n0 = item * 16;
    float acc[9];
#pragma unroll
    for (int r = 0; r < 9; ++r) acc[r] = 0.f;
    const float* w = p.in[I_ADAW] + (size_t)kg * 16 * 6144 + n0 + col;
    float wv[16];
#pragma unroll
    for (int k = 0; k < 16; ++k) wv[k] = w[(size_t)k * 6144];
#pragma unroll
    for (int k = 0; k < 16; ++k)
#pragma unroll
        for (int r = 0; r < 9; ++r) acc[r] += sc[r * 1024 + kg * 16 + k] * wv[k];
#pragma unroll
    for (int r = 0; r < 9; ++r) red[(kg * 9 + r) * 16 + col] = acc[r];
    __syncthreads();
    if (tid < 9 * 16) {
        const int r = tid >> 4, c2 = tid & 15;
        float s = p.in[I_ADAB][n0 + c2];
        for (int g = 0; g < 64; ++g) s += red[(g * 9 + r) * 16 + c2];
        ((float*)(p.ws + WS_MOD))[r * 6144 + n0 + c2] = s;
    }
    __syncthreads();
}

DI void filter_item(const Params& p, int item, float* sm) {
    const int tid = get_tid();
    float* z  = sm;
    float* ha = sm + 16 * 36;
    float* hb = ha + 16 * 64;
    const int t0 = item * 16;
    float* w1s = hb + 16 * 64;
    float* w2s = w1s + 33 * 64;
    float* w3s = w2s + 64 * 64;
    __syncthreads();
    {
        const f32x4 a2 = *(const f32x4*)(p.in[I_HW2] + tid * 4), a3 = *(const f32x4*)(p.in[I_HW3] + tid * 4);
        f32x4 a1 = f32x4{0.f, 0.f, 0.f, 0.f};
        if (tid < 33 * 16) a1 = *(const f32x4*)(p.in[I_HW1] + tid * 4);
        *(f32x4*)(w2s + tid * 4) = a2; *(f32x4*)(w3s + tid * 4) = a3;
        if (tid < 33 * 16) *(f32x4*)(w1s + tid * 4) = a1;
    }
    if (tid < 16 * 33) {
        const int pp = tid / 33, i = tid % 33;
        const int t = t0 + pp;
        float v;
        if (i == 0) v = (float)t / (float)(SEQ - 1);
        else {
            const int fi = (i - 1) & 15;
            const float f = 1e-4f + (float)fi * ((15.f - 1e-4f) / 15.f);
            const float w = 6.283185307179586f * (float)t / (float)SEQ;
            const float a = f * w;
            v = (i <= 16) ? fcos(a) : -fsin(a);
        }
        z[pp * 36 + i] = v;
    }
    __syncthreads();
    const int pp = tid >> 6, j = tid & 63;
    const float fr = p.in[I_HFREQ][j];
    {
        float a = p.in[I_HB1][j];
#pragma unroll 11
        for (int i = 0; i < 33; ++i) a += z[pp * 36 + i] * w1s[i * 64 + j];
        ha[pp * 64 + j] = fsin(fr * a);
    }
    __syncthreads();
    {
        float a = p.in[I_HB2][j];
#pragma unroll 16
        for (int i = 0; i < 64; ++i) a += ha[pp * 64 + i] * w2s[i * 64 + j];
        hb[pp * 64 + j] = fsin(fr * a);
    }
    __syncthreads();
    {
        float a = p.in[I_HB3][j];
#pragma unroll 16
        for (int i = 0; i < 64; ++i) a += hb[pp * 64 + i] * w3s[i * 64 + j];
        __syncthreads();
        ha[pp * 64 + j] = fsin(fr * a);
    }
    __syncthreads();
    float* fraw = (float*)(p.ws + WS_FRAW);
    float* part = (float*)(p.ws + WS_PART);
    const float* w4 = p.in[I_HW4];
    {
        const int lane = tid & 63, wave = tid >> 6, l15 = lane & 15, lk = lane >> 4;
        float af[16];
#pragma unroll
        for (int ks = 0; ks < 16; ++ks) af[ks] = ha[l15 * 64 + ks * 4 + lk];
#pragma unroll 1
        for (int nt = 0; nt < 8; ++nt) {
            const int col = (wave * 8 + nt) * 16 + l15;
            f32x4 acc = f32x4{0.f, 0.f, 0.f, 0.f};
#pragma unroll
            for (int ks = 0; ks < 16; ++ks) acc = __builtin_amdgcn_mfma_f32_16x16x4f32(af[ks], w4[(size_t)(ks * 4 + lk) * 2048 + col], acc, 0, 0, 0);
            const int c = col & 511, dir = (col >> 9) & 1;
            const float mind = -3.0701134573253945f, maxd = -15.350567286626973f;
            const float delta = fabsf(mind + (float)c * ((maxd - mind) / 511.f));
            float sabs = 0.f, v[4];
#pragma unroll
            for (int r = 0; r < 4; ++r) {
                const int t = t0 + 4 * lk + r;
                const float t01 = (float)t / (float)(SEQ - 1);
                v[r] = acc[r] * expf(-t01 * delta);
                if (!(dir == 1 && t == 0)) sabs += fabsf(v[r]);
            }
            *(f32x4*)(fraw + (size_t)col * SEQ + t0 + 4 * lk) = f32x4{v[0], v[1], v[2], v[3]};
            sabs = sum_x32(sum_x16(sabs));
            if (lk == 0) part[item * 2048 + col] = sabs;
        }
    }
    __syncthreads();
}

DI void phase_a(const Params& p, float* sm) {
    constexpr int T_WIN = 16 * 17, T_AO = 8 * 4, T_HO = 8 * 4, T_WO = 16 * 4, T_WQ = 16 * 8;
    constexpr int E0 = T_WIN, E1 = E0 + T_AO, E2 = E1 + T_HO, E3 = E2 + T_WO, E4 = E3 + T_WQ;
    constexpr int E5 = E4 + 64;
    constexpr int E6 = E5 + 384;
    constexpr int E7 = E6 + 1;
    constexpr int E8 = E7 + 256;
    for (int it = blockIdx.x; it < E8; it += gridDim.x) {
        int item = it;
        if (item < 256) { filter_item(p, item, sm); if (PROBE_PHASE == 30 && blockIdx.x == 0 && get_tid() == 0) ((volatile unsigned long long*)(g_lds + LDS_PROBE_OFF))[1] = __builtin_amdgcn_s_memrealtime(); continue; }
        item -= 256;
        if (item < 384) { mod_item(p, item, sm); if (PROBE_PHASE == 31 && blockIdx.x == 0 && get_tid() == 0) ((volatile unsigned long long*)(g_lds + LDS_PROBE_OFF))[1] = __builtin_amdgcn_s_memrealtime(); continue; }
        item -= 384;
        if (item < 1) {
            const int tid = get_tid();
            float* rope = (float*)(p.ws + WS_ROPE);
            const int pos = tid >> 4, f = tid & 15;
            const float inv = powf(10000.f, -(float)(2 * f) / 32.f);
            const float ang = (float)pos * inv;
            rope[tid] = fcos(ang); rope[1024 + tid] = fsin(ang);
            continue;
        }
        item -= 1;
        if (item < 64) {
            const int tid = get_tid();
            const float* src = (item < 32) ? p.in[I_PK1] : p.in[I_PK2];
            bf16_t* dst = (bf16_t*)(p.ws + WS_KEYS) + (size_t)item * 4096;
            const f32x4 v = *(const f32x4*)(src + (size_t)(item & 31) * 4096 + tid * 4);
            *(u32x2*)(dst + tid * 4) = u32x2{pk2(v[0], v[1]), pk2(v[2], v[3])};
            continue;
        }
        item -= 64;
        if (item < T_WIN) { transpose_tile(p.in[I_WIN], DM, INC, (bf16_t*)(p.ws + WS_WTIN), item, sm); continue; }
        item -= T_WIN;
        if (item < T_AO) { transpose_tile(p.in[I_WAO], QD, DM, (bf16_t*)(p.ws + WS_WTAO), item, sm); continue; }
        item -= T_AO;
        if (item < T_HO) { transpose_tile(p.in[I_WHO], HYD, DM, (bf16_t*)(p.ws + WS_WTHO), item, sm); continue; }
        item -= T_HO;
        if (item < T_WO) { transpose_tile(p.in[I_WO], DM, DM, (bf16_t*)(p.ws + WS_WTO), item, sm); continue; }
        item -= T_WO;
        transpose_tile(p.in[I_PWQ], DM, 2048, (bf16_t*)(p.ws + WS_WTQ), item, sm);
    }
    (void)E1; (void)E2; (void)E3; (void)E4; (void)E5; (void)E6; (void)E7;
}

DI void norm_mod_row(const float* __restrict__ src, const float* __restrict__ g, const float* __restrict__ shift, const float* __restrict__ scale, bf16_t* __restrict__ dst) {
    const int lane = get_tid() & 63;
    f32x4 v[4];
    float ss = 0.f;
#pragma unroll
    for (int j = 0; j < 4; ++j) { v[j] = *(const f32x4*)(src + j * 256 + lane * 4); ss += v[j][0] * v[j][0] + v[j][1] * v[j][1] + v[j][2] * v[j][2] + v[j][3] * v[j][3]; }
    ss = wave_sum(ss);
    const float rs = rsqrtf(ss * (1.f / DM) + EPS);
#pragma unroll
    for (int j = 0; j < 4; ++j) {
        const int c = j * 256 + lane * 4;
        const f32x4 gg = *(const f32x4*)(g + c), sh = *(const f32x4*)(shift + c), sc = *(const f32x4*)(scale + c);
        float o[4];
#pragma unroll
        for (int e = 0; e < 4; ++e) o[e] = v[j][e] * rs * gg[e] * (1.f + sc[e]) + sh[e];
        *(u32x2*)(dst + c) = u32x2{pk2(o[0], o[1]), pk2(o[2], o[3])};
    }
}

DI void filter_norm_item(const Params& p, int item, float* sm) {
    const int tid = get_tid();
    const int o = item >> 9, c = item & 511;
    const int colf = o * 1024 + c, colb = colf + 512;
    const float* part = (const float*)(p.ws + WS_PART);
    const float* fraw = (const float*)(p.ws + WS_FRAW);
    float v[8], mx = 0.f;
#pragma unroll
    for (int i = 0; i < 8; ++i) {
        const int n = tid * 8 + i;
        v[i] = (n == 0) ? 0.f : (n <= 4096 ? fraw[(size_t)colf * SEQ + 4096 - n] : fraw[(size_t)colb * SEQ + n - 4096]);
        mx = fmaxf(mx, fabsf(v[i]));
    }
    float sacc = 0.f;
    if (tid < 512) sacc = part[(tid & 255) * 2048 + ((tid < 256) ? colf : colb)];
    sacc = wave_sum(sacc); mx = wave_max(mx);
    __syncthreads();
    if ((tid & 63) == 0) { sm[tid >> 6] = sacc; sm[16 + (tid >> 6)] = mx; }
    __syncthreads();
    float tot = EPS, gmx = 0.f;
#pragma unroll
    for (int i = 0; i < 8; ++i) tot += sm[i];
#pragma unroll
    for (int i = 0; i < 16; ++i) gmx = fmaxf(gmx, sm[16 + i]);
    const float inv = 1.f / tot;
    int ex; (void)frexpf(fmaxf(gmx * inv, 1e-30f), &ex);
    const float sc = ldexpf(1.f, 8 - ex), isc = ldexpf(1.f, ex - 8);
    if (tid == 0) ((float*)(p.ws + WS_FSC))[item] = isc;
    const float k = inv * sc;
    int w0 = 0, w1 = 0;
    w0 = __builtin_amdgcn_cvt_pk_fp8_f32(v[0] * k, v[1] * k, w0, false); w0 = __builtin_amdgcn_cvt_pk_fp8_f32(v[2] * k, v[3] * k, w0, true);
    w1 = __builtin_amdgcn_cvt_pk_fp8_f32(v[4] * k, v[5] * k, w1, false); w1 = __builtin_amdgcn_cvt_pk_fp8_f32(v[6] * k, v[7] * k, w1, true);
    *(u32x2*)(p.ws + WS_R + (size_t)item * 8192 + tid * 8) = u32x2{(unsigned)w0, (unsigned)w1};
    __syncthreads();
}

DI void table_conv_item(const Params& p, int ci, unsigned char* lds) {
    const int tid = get_tid();
    const size_t el = (size_t)(ci & 2047) * 8192 + tid * 8;
    const float* src = (ci < 2048 ? p.in[I_PU] : p.in[I_PV]) + el;
    const f32x4 a = *(const f32x4*)src, b = *(const f32x4*)(src + 4);
    const size_t e = el >> 10, col = el & 1023;
    if (ci < 2048) {
        float mx = fmaxf(fmaxf(fmaxf(fabsf(a[0]), fabsf(a[1])), fmaxf(fabsf(a[2]), fabsf(a[3]))), fmaxf(fmaxf(fabsf(b[0]), fabsf(b[1])), fmaxf(fabsf(b[2]), fabsf(b[3]))));
        float sq = a[0] * a[0] + a[1] * a[1] + a[2] * a[2] + a[3] * a[3] + b[0] * b[0] + b[1] * b[1] + b[2] * b[2] + b[3] * b[3];
        mx = wave_max(mx); sq = wave_sum(sq);
        float* wm = (float*)lds;
        __syncthreads();
        if ((tid & 63) == 0) { wm[tid >> 6] = mx; wm[16 + (tid >> 6)] = sq; }
        __syncthreads();
        const int w2 = (tid >> 7) * 2;
        const float rmax = fmaxf(wm[w2], wm[w2 + 1]), rsig = sqrtf((wm[16 + w2] + wm[17 + w2]) * (1.f / 1024.f));
        const float clip = fmaxf(fminf(rmax, 2.75f * rsig), 1e-30f);
        const float sc = 7.f / clip;
        if ((tid & 127) == 0) ((float*)(p.ws + WS_USC))[e] = clip * (1.f / 7.f);
        unsigned w = 0;
#pragma unroll
        for (int j = 0; j < 4; ++j) {
            const int ql = min(7, max(-7, __float2int_rn(a[j] * sc))) + 8, qh = min(7, max(-7, __float2int_rn(b[j] * sc))) + 8;
            w |= (unsigned)(ql | (qh << 4)) << (8 * j);
        }
        *(unsigned*)(p.ws + WS_UT + (el >> 1)) = w;
    } else {
        float sq = a[0] * a[0] + a[1] * a[1] + a[2] * a[2] + a[3] * a[3] + b[0] * b[0] + b[1] * b[1] + b[2] * b[2] + b[3] * b[3];
        sq = wave_sum(sq);
        float* wm = (float*)lds;
        __syncthreads();
        if ((tid & 63) == 0) wm[tid >> 6] = sq;
        __syncthreads();
        const int w2 = (tid >> 7) * 2;
        const float rsig = fmaxf(sqrtf((wm[w2] + wm[w2 + 1]) * (1.f / 1024.f)), 1e-30f);
        const float sc = 2.f / rsig;
        if ((tid & 127) == 0) ((float*)(p.ws + WS_VSC))[e] = rsig * 0.5f;
        const float xs[8] = {a[0], a[1], a[2], a[3], b[0], b[1], b[2], b[3]};
        unsigned w = 0;
#pragma unroll
        for (int j = 0; j < 8; ++j) {
            const float m = fabsf(xs[j] * sc);
            const unsigned code = (m < 0.25f ? 0u : m < 0.75f ? 1u : m < 1.25f ? 2u : m < 1.75f ? 3u : m < 2.5f ? 4u : m < 3.5f ? 5u : m < 5.f ? 6u : 7u) | (xs[j] < 0.f ? 8u : 0u);
            w |= code << (4 * j);
        }
        *(unsigned*)(p.ws + WS_VTAB + ((col >> 8) * 16384 + e) * 128 + ((col & 255) >> 3) * 4) = w;
    }
}

DI void phase_b(const Params& p, float* sm) {
    const int wave = get_tid() >> 6;
    const float* mod = (const float*)(p.ws + WS_MOD);
    constexpr int ROW_ITEMS = (BT + BATCH * CTX) / 16;
    constexpr int CONV = 2 * 16384 * 1024 / 8192;
    constexpr int SHQ = 8 * 2048 / 16;
    for (int it = blockIdx.x; it < ROW_ITEMS + 1024 + CONV + SHQ; it += gridDim.x) {
        if (it < 1024) { filter_norm_item(p, it, sm); continue; }
        if (it >= ROW_ITEMS + 1024 + CONV) {
            const int tid = get_tid(), lane = tid & 63, o = (it - ROW_ITEMS - 1024 - CONV) * 16 + (tid >> 6), b = o >> 11, n = o & 2047;
            const bf16_t* wr = (const bf16_t*)(p.ws + WS_WTQ) + (size_t)n * DM + lane * 16;
            const float* sh = mod + b * 6144 + 3072 + lane * 16;
            const u32x4 w0 = *(const u32x4*)wr, w1 = *(const u32x4*)(wr + 8);
            float d = 0.f;
#pragma unroll
            for (int i = 0; i < 4; ++i) { d += bflo(w0[i]) * sh[2 * i] + bfhi(w0[i]) * sh[2 * i + 1] + bflo(w1[i]) * sh[8 + 2 * i] + bfhi(w1[i]) * sh[9 + 2 * i]; }
            d = wave_sum(d);
            if (lane == 0) ((float*)(p.ws + WS_SHQ))[o] = d;
            continue;
        }
        if (it >= ROW_ITEMS + 1024) { table_conv_item(p, it - ROW_ITEMS - 1024, (unsigned char*)sm); continue; }
        const int row = (it - 1024) * 16 + wave;
        if (row < BT) {
            const int b = row >> 12;
            norm_mod_row(p.in[I_X] + (size_t)row * DM, p.in[I_NMIX], mod + b * 6144, mod + b * 6144 + 1024, (bf16_t*)(p.ws + WS_H) + (size_t)row * DM);
        } else {
            const int r = row - BT;
            norm_mod_row(p.in[I_CTX] + (size_t)r * DM, p.in[I_NMIX], mod + 8 * 6144, mod + 8 * 6144 + 1024, (bf16_t*)(p.ws + WS_HC) + (size_t)r * DM);
        }
    }
}

#define MFMA16(a, b, c) __builtin_amdgcn_mfma_f32_16x16x32_bf16((a), (b), (c), 0, 0, 0)
constexpr int GT_P = 256 * 128;
struct RowLoader {
    const bf16_t* base; int ld;
    template<int ROWS> DI void issue(unsigned char* tile, int kt, int lane, int wave) const {
#pragma unroll
        for (int i = 0; i < ROWS / 128; ++i) {
            const int grp = i * 16 + wave, row = grp * 8 + (lane >> 3), c = (lane & 7) ^ (lane >> 3);
            __builtin_amdgcn_global_load_lds((const unsigned*)(base + (size_t)row * ld + kt * 64 + c * 8), (unsigned*)(tile + grp * 1024), 16, 0, 0);
        }
    }
};

template<int NQ>
DI void gemm_prefetch(const RowLoader& lp, const RowLoader& lq, unsigned char* lds) {
    const int tid = get_tid(), lane = tid & 63, wave = __builtin_amdgcn_readfirstlane(tid >> 6);
    lp.template issue<256>(lds, 0, lane, wave); lq.template issue<NQ * 64>(lds + GT_P, 0, lane, wave);
}
template<int NQ>
DI void gemm_mainloop(f32x4 (&acc)[4][NQ], const RowLoader& lp, const RowLoader& lq, int nk, unsigned char* lds, bool preissued = false, bool pfnext = false,
                      const RowLoader& nlp = RowLoader{nullptr, 0}, const RowLoader& nlq = RowLoader{nullptr, 0}) {
    const int tid = get_tid(), lane = tid & 63, wave = __builtin_amdgcn_readfirstlane(tid >> 6), wp = wave >> 2, wq = wave & 3;
    constexpr int QROWS = NQ * 64;
    constexpr int STAGE = GT_P + QROWS * 128;
    if (!preissued) {
        __syncthreads();
        lp.template issue<256>(lds, 0, lane, wave); lq.template issue<QROWS>(lds + GT_P, 0, lane, wave);
    }
    asm volatile("s_waitcnt vmcnt(0)" ::: "memory");
    __syncthreads();
    const int l15 = lane & 15, lk = lane >> 4;
    for (int kt = 0; kt < nk; ++kt) {
        unsigned char* cur = lds + (kt & 1) * STAGE;
        unsigned char* nxt = lds + ((kt + 1) & 1) * STAGE;
        const bool last = kt + 1 == nk;
        if (!last) { lp.template issue<256>(nxt, kt + 1, lane, wave); lq.template issue<QROWS>(nxt + GT_P, kt + 1, lane, wave); }
        else if (pfnext) { nlp.template issue<256>(nxt, 0, lane, wave); nlq.template issue<QROWS>(nxt + GT_P, 0, lane, wave); }
#pragma unroll
        for (int ks = 0; ks < 2; ++ks) {
            bf16x8 fp[4], fq[NQ];
#pragma unroll
            for (int i = 0; i < 4; ++i) { const int row = wp * 64 + i * 16 + l15; fp[i] = *(const bf16x8*)(cur + row * 128 + (((ks * 4 + lk) ^ (row & 7)) << 4)); }
#pragma unroll
            for (int j = 0; j < NQ; ++j) { const int row = wq * (16 * NQ) + j * 16 + l15; fq[j] = *(const bf16x8*)(cur + GT_P + row * 128 + (((ks * 4 + lk) ^ (row & 7)) << 4)); }
#pragma unroll
            for (int i = 0; i < 4; ++i)
#pragma unroll
                for (int j = 0; j < NQ; ++j) acc[i][j] = MFMA16(fp[i], fq[j], acc[i][j]);
        }
        if (last && pfnext) { asm volatile("s_waitcnt lgkmcnt(0)" ::: "memory"); __builtin_amdgcn_s_barrier(); }
        else { asm volatile("s_waitcnt vmcnt(0)" ::: "memory"); __syncthreads(); }
    }
}
template<int NQ>
DI void gemm_shadow(const RowLoader& lp, const RowLoader& lq, int nk, unsigned char* lds) {
    f32x4 acc[4][NQ];
#pragma unroll
    for (int i = 0; i < 4; ++i)
#pragma unroll
        for (int j = 0; j < NQ; ++j) acc[i][j] = f32x4{0.f, 0.f, 0.f, 0.f};
    if (SHADOW == 1) gemm_mainloop<NQ>(acc, lp, lq, nk, lds);
    else {
        const int tid = get_tid(), lane = tid & 63, wave = __builtin_amdgcn_readfirstlane(tid >> 6), wp = wave >> 2, wq = wave & 3;
        constexpr int QROWS = NQ * 64;
        constexpr int STAGE = GT_P + QROWS * 128;
        const int l15 = lane & 15, lk = lane >> 4;
        bf16x8 fp[4], fq[NQ];
        if (SHADOW == 3) {
#pragma unroll
            for (int i = 0; i < 4; ++i) fp[i] = *(const bf16x8*)(lds + (wp * 64 + i * 16 + l15) * 128 + lk * 16);
#pragma unroll
            for (int j = 0; j < NQ; ++j) fq[j] = *(const bf16x8*)(lds + GT_P + (wq * 16 * NQ + j * 16 + l15) * 128 + lk * 16);
        }
        for (int kt = 0; kt < nk; ++kt) {
            unsigned char* cur = lds + (kt & 1) * STAGE;
#pragma unroll
            for (int ks = 0; ks < 2; ++ks) {
                if (SHADOW == 2 || SHADOW == 4) {
#pragma unroll
                    for (int i = 0; i < 4; ++i) { const int row = wp * 64 + i * 16 + l15; fp[i] = *(const bf16x8*)(cur + row * 128 + (((ks * 4 + lk) ^ (row & 7)) << 4)); }
#pragma unroll
                    for (int j = 0; j < NQ; ++j) { const int row = wq * (16 * NQ) + j * 16 + l15; fq[j] = *(const bf16x8*)(cur + GT_P + row * 128 + (((ks * 4 + lk) ^ (row & 7)) << 4)); }
                }
#pragma unroll
                for (int i = 0; i < 4; ++i)
#pragma unroll
                    for (int j = 0; j < NQ; ++j) acc[i][j] = MFMA16(fp[i], fq[j], acc[i][j]);
            }
            if (SHADOW == 2) asm volatile("" ::: "memory");
            if (SHADOW == 4) __syncthreads();
        }
    }
#pragma unroll
    for (int i = 0; i < 4; ++i)
#pragma unroll
        for (int j = 0; j < NQ; ++j) asm volatile("" :: "v"(acc[i][j]));
}

template<int NQ> DI void gemm_shadow1(const RowLoader& lp, const RowLoader& lq, int nk, unsigned char* lds) {
    f32x4 acc[4][NQ];
#pragma unroll
    for (int i = 0; i < 4; ++i)
#pragma unroll
        for (int j = 0; j < NQ; ++j) acc[i][j] = f32x4{0.f, 0.f, 0.f, 0.f};
    gemm_mainloop<NQ>(acc, lp, lq, nk, lds);
#pragma unroll
    for (int i = 0; i < 4; ++i)
#pragma unroll
        for (int j = 0; j < NQ; ++j) asm volatile("" :: "v"(acc[i][j]));
}
DI void head_epilogue(f32x4 (&acc)[4][4], const float* __restrict__ g, float gscale, const float* __restrict__ rope, bool do_rope, int t_base  , bf16_t* __restrict__ dst  , int lane) {
    const int l15 = lane & 15, lk = lane >> 4;
    float gg[4];
#pragma unroll
    for (int j = 0; j < 4; ++j) gg[j] = g[j * 16 + l15] * gscale;
#pragma unroll
    for (int i = 0; i < 4; ++i) {
#pragma unroll
        for (int r = 0; r < 4; ++r) {
            float ss = 0.f;
#pragma unroll
            for (int j = 0; j < 4; ++j) ss += acc[i][j][r] * acc[i][j][r];
            ss = sum16(ss);
            const float rs = rsqrtf(ss * (1.f / 64.f) + EPS);
            float v[4];
#pragma unroll
            for (int j = 0; j < 4; ++j) v[j] = acc[i][j][r] * rs * gg[j];
            const int t = t_base + i * 16 + lk * 4 + r;
            if (do_rope) {
                const int prow = (t >> 6) & 63, pcol = t & 63;
                const float c0 = rope[prow * 16 + l15], s0 = rope[1024 + prow * 16 + l15];
                const float c1 = rope[pcol * 16 + l15], s1 = rope[1024 + pcol * 16 + l15];
                const float a0 = v[0] * c0 - v[1] * s0, a1 = v[1] * c0 + v[0] * s0;
                const float a2 = v[2] * c1 - v[3] * s1, a3 = v[3] * c1 + v[2] * s1;
                v[0] = a0; v[1] = a1; v[2] = a2; v[3] = a3;
            }
            bf16_t* d = dst + (size_t)(i * 16 + lk * 4 + r) * 64 + l15;
#pragma unroll
            for (int j = 0; j < 4; ++j) d[j * 16] = (bf16_t)f2bf(v[j]);
        }
    }
}
DI void tstore_epilogue(f32x4 (&acc)[4][4], bf16_t* __restrict__ dst  , size_t ld, int lane) {
    const int l15 = lane & 15, lk = lane >> 4;
#pragma unroll
    for (int i = 0; i < 4; ++i)
#pragma unroll
        for (int j = 0; j < 4; ++j)
            *(u32x2*)(dst + (size_t)(j * 16 + l15) * ld + i * 16 + lk * 4) = u32x2{pk2(acc[i][j][0], acc[i][j][1]), pk2(acc[i][j][2], acc[i][j][3])};
}

DI void phase_c(const Params& p, unsigned char* lds) {
    constexpr int NTM = BT / 256, NTN = INC / 256;
    constexpr int MAIN = NTM * NTN, TOTAL = MAIN + 8;
    const bf16_t* H = (const bf16_t*)(p.ws + WS_H);
    const bf16_t* HCp = (const bf16_t*)(p.ws + WS_HC);
    const bf16_t* WT = (const bf16_t*)(p.ws + WS_WTIN);
    const float* rope = (const float*)(p.ws + WS_ROPE);
    struct CTile { int tm, tn; bool ctx; RowLoader P, Q; };
    auto c_tile = [&](int it) {
        CTile t; t.ctx = false;
        if (it < MAIN) { const int g = it / (16 * NTN), rem = it % (16 * NTN); t.tn = rem >> 4; t.tm = g * 16 + (rem & 15); }
        else { t.ctx = true; t.tm = it - MAIN; t.tn = 2; }
        const bf16_t* A = t.ctx ? HCp + (size_t)t.tm * 256 * DM : H + (size_t)t.tm * 256 * DM;
        const bf16_t* W = WT + (size_t)t.tn * 256 * DM;
        if (t.tn >= 9) { t.P = RowLoader{W, DM}; t.Q = RowLoader{A, DM}; }
        else { t.P = RowLoader{A, DM}; t.Q = RowLoader{W, DM}; }
        return t;
    };
    bool pre = false;
    CTile cur = c_tile(blockIdx.x);
    for (int it = blockIdx.x; it < TOTAL; it += gridDim.x) {
        const int tid = get_tid(), lane = tid & 63, wave = tid >> 6, wa = wave >> 2, wb = wave & 3;
        const bool has2 = it + (int)gridDim.x < TOTAL;
        const CTile nx = c_tile(has2 ? it + (int)gridDim.x : it);
        const int tm = cur.tm, tn = cur.tn; const bool ctx = cur.ctx;
        f32x4 acc[4][4];
#pragma unroll
        for (int i = 0; i < 4; ++i)
#pragma unroll
            for (int j = 0; j < 4; ++j) acc[i][j] = f32x4{0.f, 0.f, 0.f, 0.f};
        gemm_mainloop<4>(acc, cur.P, cur.Q, DM / 64, lds, pre, has2, nx.P, nx.Q);
        pre = has2; cur = nx;
        if (tn >= 9) {
            bf16_t* G = (bf16_t*)(p.ws + WS_G);
            const int l15 = lane & 15, lk = lane >> 4;
#pragma unroll
            for (int i = 0; i < 4; ++i)
#pragma unroll
                for (int j = 0; j < 4; ++j) {
                    const int n = tn * 256 - 2304 + wa * 64 + i * 16 + lk * 4;
                    const int tok = tm * 256 + wb * 64 + j * 16 + l15;
                    float sg[4];
#pragma unroll
                    for (int r = 0; r < 4; ++r) sg[r] = 1.f / (1.f + __expf(-acc[i][j][r]));
                    *(u32x2*)(G + (size_t)tok * GC + n) = u32x2{pk2(sg[0], sg[1]), pk2(sg[2], sg[3])};
                }
            continue;
        }
        const int b = ctx ? tm : (tm >> 4);
        const int tpos = ctx ? SEQ + wa * 64 : ((tm & 15) * 256 + wa * 64);
        if (tn < 2) {
            const int h = tn * 4 + wb;
            bf16_t* Q = (bf16_t*)(p.ws + WS_Q) + ((size_t)(b * NH + h) * SEQ + tpos) * HD;
            head_epilogue(acc, p.in[I_QNG], 0.125f * 1.4426950408889634f, rope, true, tpos, Q, lane);
        } else if (tn == 2) {
            if (wb < 2) {
                bf16_t* K = (bf16_t*)(p.ws + WS_KB) + ((size_t)(b * NKV + wb) * TK + tpos) * HD;
                head_epilogue(acc, p.in[I_KNG], 1.f, rope, !ctx, tpos, K, lane);
            } else {
                bf16_t* V = (bf16_t*)(p.ws + WS_VT) + (size_t)(b * NKV + (wb - 2)) * HD * TK + tpos;
                tstore_epilogue(acc, V, TK, lane);
            }
        } else {
            const int col = tn * 256 - 768 + wb * 64;
            bf16_t* Z = (bf16_t*)(p.ws + WS_ZT) + (size_t)col * BT + (size_t)b * SEQ + tpos;
            tstore_epilogue(acc, Z, BT, lane);
        }
    }
}

#define MFMA32(a, b, c) __builtin_amdgcn_mfma_f32_32x32x16_bf16((a), (b), (c), 0, 0, 0)
DI bf16x8 pack_step(const f32x16& x, int s) {
    u32x4 pk;
    asm volatile("v_cvt_pk_bf16_f32 %0, %4, %5\n\tv_cvt_pk_bf16_f32 %1, %6, %7\n\tv_cvt_pk_bf16_f32 %2, %8, %9\n\tv_cvt_pk_bf16_f32 %3, %10, %11\n\ts_nop 1"
                 : "=&v"(pk[0]), "=&v"(pk[1]), "=&v"(pk[2]), "=&v"(pk[3])
                 : "v"(x[8 * s]), "v"(x[8 * s + 1]), "v"(x[8 * s + 2]), "v"(x[8 * s + 3]), "v"(x[8 * s + 4]), "v"(x[8 * s + 5]), "v"(x[8 * s + 6]), "v"(x[8 * s + 7]));
    return __builtin_bit_cast(bf16x8, pk);
}

constexpr int AT_KSTR = 144, AT_VSTR = 136, AT_VOFF = 64 * AT_KSTR, AT_STAGE = AT_VOFF + 64 * AT_VSTR;
DI void attn_item(const Params& p, int item, unsigned char* lds) {
    const int tid = get_tid(), lane = tid & 63, wave = tid >> 6;
    const int b = item >> 6, kvh = (item >> 5) & 1, qb = item & 31;
    const int h = kvh * 4 + (wave >> 2), q0 = qb * 128 + (wave & 3) * 32;
    const int qi = lane & 31, hf = lane >> 5;
    const bf16_t* Qp = (const bf16_t*)(p.ws + WS_Q) + ((size_t)(b * NH + h) * SEQ + q0 + qi) * HD;
    bf16x8 qf[4];
#pragma unroll
    for (int s = 0; s < 4; ++s) qf[s] = *(const bf16x8*)(Qp + 16 * s + 8 * hf);
    const bf16_t* Kg = (const bf16_t*)(p.ws + WS_KB) + (size_t)(b * NKV + kvh) * TK * HD;
    const bf16_t* Vg = (const bf16_t*)(p.ws + WS_VT) + (size_t)(b * NKV + kvh) * HD * TK;
    const bool isK = tid < 512;
    const int li = tid & 511, lrow = li >> 3, lc = li & 7;
    const bf16_t* src = isK ? Kg + (size_t)lrow * HD + lc * 8 : Vg + (size_t)lrow * TK + lc * 8;
    const size_t sstep = isK ? (size_t)64 * HD : 64;
    const int ldst = isK ? lrow * AT_KSTR + lc * 16 : AT_VOFF + lrow * AT_VSTR + lc * 16;
    constexpr int NTILE = TK / 64;
    f32x16 o0, o1;
#pragma unroll
    for (int i = 0; i < 16; ++i) { o0[i] = 0.f; o1[i] = 0.f; }
    float l = 0.f;
    __syncthreads();
    constexpr int NSUB = 4, NSTG = NTILE / NSUB;
    static_assert(NTILE % NSUB == 0 && 2 * NSUB * AT_STAGE <= LDS_USER, "attention LDS stages");
    u32x4 stg[NSUB];
#pragma unroll
    for (int j = 0; j < NSUB; ++j) stg[j] = *(const u32x4*)(src + (size_t)j * sstep);
#pragma unroll
    for (int j = 0; j < NSUB; ++j) { unsigned char* d = lds + j * AT_STAGE + ldst; *(u32x2*)d = u32x2{stg[j][0], stg[j][1]}; *(u32x2*)(d + 8) = u32x2{stg[j][2], stg[j][3]}; }
    __syncthreads();
    const int koff = qi * AT_KSTR + hf * 16;
    const int voff = AT_VOFF + qi * AT_VSTR + hf * 8;
    for (int st = 0; st < NSTG; ++st) {
      const bool more = st + 1 < NSTG;
      if (more) {
#pragma unroll
          for (int j = 0; j < NSUB; ++j) stg[j] = *(const u32x4*)(src + (size_t)((st + 1) * NSUB + j) * sstep);
      }
#pragma unroll 1
      for (int j = 0; j < NSUB; ++j) {
        const unsigned char* cur = lds + ((st & 1) * NSUB + j) * AT_STAGE;
        f32x16 sA, sB;
#pragma unroll
        for (int i = 0; i < 16; ++i) { sA[i] = 0.f; sB[i] = 0.f; }
        __builtin_amdgcn_s_setprio(1);
#pragma unroll
        for (int s = 0; s < 4; ++s) sA = MFMA32(*(const bf16x8*)(cur + koff + s * 32), qf[s], sA);
#pragma unroll
        for (int s = 0; s < 4; ++s) sB = MFMA32(*(const bf16x8*)(cur + koff + 32 * AT_KSTR + s * 32), qf[s], sB);
        __builtin_amdgcn_s_setprio(0);
        float ps = 0.f;
#pragma unroll
        for (int kb = 0; kb < 2; ++kb) {
            f32x16& sx = kb ? sB : sA;
#pragma unroll
            for (int i = 0; i < 16; ++i) { sx[i] = __builtin_amdgcn_exp2f(sx[i]); ps += sx[i]; }
#pragma unroll
            for (int s2 = 0; s2 < 2; ++s2) {
                const bf16x8 pf = pack_step(sx, s2);
#pragma unroll
                for (int db = 0; db < 2; ++db) {
                    const unsigned char* vb = cur + voff + db * 32 * AT_VSTR + (4 * kb + 2 * s2) * 16;
                    const s16x4 lo = lds_rd64(vb);
                    const s16x4 hi = lds_rd64(vb + 16);
                    const bf16x8 vf = __builtin_shufflevector(lo, hi, 0, 1, 2, 3, 4, 5, 6, 7);
                    if (db == 0) o0 = MFMA32(vf, pf, o0); else o1 = MFMA32(vf, pf, o1);
                }
            }
        }
        l += ps;
      }
      if (more) {
#pragma unroll
          for (int j = 0; j < NSUB; ++j) { unsigned char* d = lds + (((st + 1) & 1) * NSUB + j) * AT_STAGE + ldst; *(u32x2*)d = u32x2{stg[j][0], stg[j][1]}; *(u32x2*)(d + 8) = u32x2{stg[j][2], stg[j][3]}; }
      }
      __syncthreads();
    }
    l = sum_x32(l);
    const float inv = 1.f / l;
    bf16_t* O;
    {
        const int t2 = get_tid(), lane2 = t2 & 63, wave2 = t2 >> 6;
        const int h2 = kvh * 4 + (wave2 >> 2), q2 = qb * 128 + (wave2 & 3) * 32 + (lane2 & 31);
        O = (bf16_t*)(p.ws + WS_ATT) + ((size_t)b * SEQ + q2) * QD + h2 * HD + 4 * (lane2 >> 5);
    }
#pragma unroll
    for (int g4 = 0; g4 < 4; ++g4) {
        *(u32x2*)(O + 8 * g4)      = u32x2{pk2(o0[4 * g4] * inv, o0[4 * g4 + 1] * inv), pk2(o0[4 * g4 + 2] * inv, o0[4 * g4 + 3] * inv)};
        *(u32x2*)(O + 32 + 8 * g4) = u32x2{pk2(o1[4 * g4] * inv, o1[4 * g4 + 1] * inv), pk2(o1[4 * g4 + 2] * inv, o1[4 * g4 + 3] * inv)};
    }
}

constexpr int HY_USTR = 8208, HY_R = 8 * HY_USTR, HY_RSTR = 16384 + 64;
DI void hy_load_filter(const bf16_t* __restrict__ R, unsigned char* lds, int tid) {
    const int i0 = tid * 8;
    const u32x4 w = *(const u32x4*)(R + i0);
    u32x2 nx = u32x2{0u, 0u};
    if (i0 + 8 < 8192) nx = *(const u32x2*)(R + i0 + 8);
    unsigned char* d = lds + HY_R + i0 * 2;
    *(u32x4*)(d) = w;
    *(u32x4*)(d + HY_RSTR) = u32x4{__builtin_amdgcn_alignbit(w[1], w[0], 16), __builtin_amdgcn_alignbit(w[2], w[1], 16), __builtin_amdgcn_alignbit(w[3], w[2], 16), __builtin_amdgcn_alignbit(nx[0], w[3], 16)};
    *(u32x4*)(d + 2 * HY_RSTR) = u32x4{w[1], w[2], w[3], nx[0]};
    *(u32x4*)(d + 3 * HY_RSTR) = u32x4{__builtin_amdgcn_alignbit(w[2], w[1], 16), __builtin_amdgcn_alignbit(w[3], w[2], 16), __builtin_amdgcn_alignbit(nx[0], w[3], 16), __builtin_amdgcn_alignbit(nx[1], nx[0], 16)};
}
DI void short_conv4(const bf16_t* __restrict__ zrow  , int t4, float w0, float w1, float w2, float bias, float (&out)[4]) {
    const u32x2 v = *(const u32x2*)(zrow + t4);
    const float z0 = bflo(v[0]), z1 = bfhi(v[0]), z2 = bflo(v[1]), z3 = bfhi(v[1]);
    const float zm = (t4 > 0) ? bf2f(zrow[t4 - 1]) : 0.f;
    const float zp = (t4 + 4 < SEQ) ? bf2f(zrow[t4 + 4]) : 0.f;
    out[0] = zm * w0 + z0 * w1 + z1 * w2 + bias;
    out[1] = z0 * w0 + z1 * w1 + z2 * w2 + bias;
    out[2] = z1 * w0 + z2 * w1 + z3 * w2 + bias;
    out[3] = z2 * w0 + z3 * w1 + zp * w2 + bias;
}
DI void hyena_item(const Params& p, int c, unsigned char* lds) {
    const int tid = get_tid(), lane = tid & 63, ig = tid >> 6;
    const bf16_t* ZT = (const bf16_t*)(p.ws + WS_ZT);
    const float* cw = p.in[I_HCW];
    const float* cb = p.in[I_HCB];
    __syncthreads();
    {
        const int b = tid >> 7, tb = (tid & 127) * 32;
        const bf16_t* zrow = ZT + (size_t)c * BT + (size_t)b * SEQ;
        const float w0 = cw[c], w1 = cw[HYC + c], w2 = cw[2 * HYC + c], bias = cb[c];
#pragma unroll
        for (int q = 0; q < 8; ++q) {
            float o[4];
            short_conv4(zrow, tb + 4 * q, w0, w1, w2, bias, o);
            *(u32x2*)(lds + b * HY_USTR + (tb + 4 * q) * 2) = u32x2{pk2(o[0], o[1]), pk2(o[2], o[3])};
        }
    }
    const int r = lane & 31, hf = lane >> 5, Il = r >> 3, bb = r & 7;
#pragma unroll 1
    for (int o = 0; o < 2; ++o) {
        hy_load_filter((const bf16_t*)(p.ws + WS_R) + (size_t)(o * 512 + c) * 8192, lds, tid);
        __syncthreads();
        f32x16 acc0, acc1;
#pragma unroll
        for (int i = 0; i < 16; ++i) { acc0[i] = 0.f; acc1[i] = 0.f; }
        const int sh = (-r) & 3;
        const unsigned char* abase = lds + HY_R + sh * HY_RSTR + (4096 + 8 * hf - r - sh) * 2 - 64;
        const unsigned char* ubase = lds + bb * HY_USTR + ((4 * ig + Il) * 64 + 8 * hf) * 2;
#define HY_STEP(MASKED) do { \
            const unsigned char* ap = abase - 128 * d; \
            const unsigned char* ub = ubase - 128 * d; \
            bool valid = true; \
            if (MASKED) { const int J = 4 * ig + Il - d; valid = (unsigned)J < 64u; if (!valid) ub = lds; } \
            _Pragma("unroll") for (int ks = 0; ks < 4; ++ks) { \
                u32x4 braw = *(const u32x4*)(ub + ks * 32); \
                if (MASKED) { if (!valid) braw = u32x4{0u, 0u, 0u, 0u}; } \
                const bf16x8 bf = __builtin_bit_cast(bf16x8, braw); \
                { const s16x4 lo = lds_rd64(ap + 32 * ks + 64), hi = lds_rd64(ap + 32 * ks + 72);     \
                  acc0 = MFMA32(__builtin_shufflevector(lo, hi, 0, 1, 2, 3, 4, 5, 6, 7), bf, acc0); } \
                { const s16x4 lo = lds_rd64(ap + 32 * ks), hi = lds_rd64(ap + 32 * ks + 8); \
                  acc1 = MFMA32(__builtin_shufflevector(lo, hi, 0, 1, 2, 3, 4, 5, 6, 7), bf, acc1); } \
            } } while (0)
        const int dlo = 4 * ig - 63, dhi = 4 * ig + 3;
#pragma unroll 1
        for (int d = dlo; d < dlo + 3; ++d) HY_STEP(true);
#pragma unroll 1
        for (int d = dlo + 3; d <= dhi - 3; ++d) HY_STEP(false);
        if (SHADOW == 6) {
            f32x16 s0 = acc0, s1 = acc1;
            const bf16x8 fa = *(const bf16x8*)(lds + lane * 16), fb = *(const bf16x8*)(lds + 4096 + lane * 16);
#pragma unroll 1
            for (int d = 0; d < 67; ++d) {
#pragma unroll
                for (int ks = 0; ks < 4; ++ks) { s0 = MFMA32(fa, fb, s0); s1 = MFMA32(fa, fb, s1); }
            }
            asm volatile("" :: "v"(s0), "v"(s1));
        }
        if (SHADOW == 7) {
            f32x16 k0 = acc0, k1 = acc1;
#pragma unroll 1
            for (int d = dlo + 3; d <= dhi - 3 + 6; ++d) {
                const unsigned char* ap = abase - 128 * (d > dhi - 3 ? dhi - 3 : d);
                const unsigned char* ub = ubase - 128 * (d > dhi - 3 ? dhi - 3 : d);
#pragma unroll
                for (int ks = 0; ks < 4; ++ks) {
                    const bf16x8 bf = *(const bf16x8*)(ub + ks * 32);
                    { const s16x4 lo = lds_rd64(ap + 32 * ks + 64), hi = lds_rd64(ap + 32 * ks + 72); k0 = MFMA32(__builtin_shufflevector(lo, hi, 0, 1, 2, 3, 4, 5, 6, 7), bf, k0); }
                    { const s16x4 lo = lds_rd64(ap + 32 * ks), hi = lds_rd64(ap + 32 * ks + 8); k1 = MFMA32(__builtin_shufflevector(lo, hi, 0, 1, 2, 3, 4, 5, 6, 7), bf, k1); }
                }
            }
            asm volatile("" :: "v"(k0), "v"(k1));
        }
#pragma unroll 1
        for (int d = dhi - 2; d <= dhi; ++d) HY_STEP(true);
#undef HY_STEP
        __syncthreads();
        const float skip = p.in[I_HSKIP][o * HYD + c];
        const int gcol = (o == 0 ? 512 : 1024) + c;
        const float w0 = cw[gcol], w1 = cw[HYC + gcol], w2 = cw[2 * HYC + gcol], bias = cb[gcol];
        const bf16_t* zrow = ZT + (size_t)gcol * BT + (size_t)bb * SEQ;
        bf16_t* hyt = (bf16_t*)(p.ws + WS_HYT) + (size_t)c * BT + (size_t)bb * SEQ;
#pragma unroll
        for (int mm = 0; mm < 2; ++mm) {
#pragma unroll
            for (int g4 = 0; g4 < 4; ++g4) {
                const int t4 = (4 * ig + Il) * 64 + 32 * mm + 8 * g4 + 4 * hf;
                float gt[4];
                short_conv4(zrow, t4, w0, w1, w2, bias, gt);
                unsigned char* up = lds + bb * HY_USTR + t4 * 2;
                const u32x2 uv = *(const u32x2*)up;
                const float u0 = bflo(uv[0]), u1 = bfhi(uv[0]), u2 = bflo(uv[1]), u3 = bfhi(uv[1]);
                const f32x16& a = mm ? acc1 : acc0;
                const float y0 = gt[0] * (a[4 * g4] + skip * u0), y1 = gt[1] * (a[4 * g4 + 1] + skip * u1);
                const float y2 = gt[2] * (a[4 * g4 + 2] + skip * u2), y3 = gt[3] * (a[4 * g4 + 3] + skip * u3);
                const u32x2 pk = u32x2{pk2(y0, y1), pk2(y2, y3)};
                if (o == 0) *(u32x2*)up = pk; else *(u32x2*)(hyt + t4) = pk;
            }
        }
        __syncthreads();
    }
}

constexpr int HY8_USTR = 4112, HY8_R = 8 * HY8_USTR, HY8_RSTR = 8192 + 32;
constexpr float HY8_US = 16.f;
typedef int i32x8 __attribute__((ext_vector_type(8)));
#define MFMA8(a, b, c) __builtin_amdgcn_mfma_scale_f32_32x32x64_f8f6f4((a), (b), (c), 0, 0, 0, 0x7F7F7F7F, 0, 0x7F7F7F7F)
DI unsigned pk_fp8x4(float a, float b, float c, float d) {
    int w = 0;
    w = __builtin_amdgcn_cvt_pk_fp8_f32(fminf(fmaxf(a, -440.f), 440.f), fminf(fmaxf(b, -440.f), 440.f), w, false);
    w = __builtin_amdgcn_cvt_pk_fp8_f32(fminf(fmaxf(c, -440.f), 440.f), fminf(fmaxf(d, -440.f), 440.f), w, true);
    return (unsigned)w;
}
DI void hy8_load_filter(const unsigned char* __restrict__ R, unsigned char* lds, int tid) {
    const int i0 = tid * 8;
    const unsigned long long lo = *(const unsigned long long*)(R + i0);
    unsigned long long hi = 0ull;
    if (i0 + 8 < 8192) hi = *(const unsigned long long*)(R + i0 + 8);
    unsigned char* d = lds + HY8_R + i0;
    *(unsigned long long*)d = lo;
#pragma unroll
    for (int sft = 1; sft < 8; ++sft) *(unsigned long long*)(d + sft * HY8_RSTR) = (lo >> (8 * sft)) | (hi << (64 - 8 * sft));
}
DI void hyena_item8(const Params& p, int c, unsigned char* lds) {
    const int tid = get_tid(), lane = tid & 63, ig = tid >> 6;
    const bf16_t* ZT = (const bf16_t*)(p.ws + WS_ZT);
    const float* cw = p.in[I_HCW];
    const float* cb = p.in[I_HCB];
    __syncthreads();
    {
        const int b = tid >> 7, tb = (tid & 127) * 32;
        const bf16_t* zrow = ZT + (size_t)c * BT + (size_t)b * SEQ;
        const float w0 = cw[c], w1 = cw[HYC + c], w2 = cw[2 * HYC + c], bias = cb[c];
        unsigned w8[8];
#pragma unroll
        for (int q = 0; q < 8; ++q) {
            float o[4];
            short_conv4(zrow, tb + 4 * q, w0, w1, w2, bias, o);
            w8[q] = pk_fp8x4(o[0] * HY8_US, o[1] * HY8_US, o[2] * HY8_US, o[3] * HY8_US);
        }
        *(u32x4*)(lds + b * HY8_USTR + tb) = u32x4{w8[0], w8[1], w8[2], w8[3]};
        *(u32x4*)(lds + b * HY8_USTR + tb + 16) = u32x4{w8[4], w8[5], w8[6], w8[7]};
    }
    const int r = lane & 31, hf = lane >> 5, Il = r >> 3, bb = r & 7;
#pragma unroll 1
    for (int o = 0; o < 2; ++o) {
        hy8_load_filter(p.ws + WS_R + (size_t)(o * 512 + c) * 8192, lds, tid);
        __syncthreads();
        f32x16 acc0, acc1;
#pragma unroll
        for (int i = 0; i < 16; ++i) { acc0[i] = 0.f; acc1[i] = 0.f; }
        const int sh = (-r) & 7;
        const unsigned char* abase = lds + HY8_R + sh * HY8_RSTR + (4096 + 32 * hf - r - sh) - 32;
        const unsigned char* ubase = lds + bb * HY8_USTR + (4 * ig + Il) * 64 + 32 * hf;
#define HY8_STEP(MASKED) do { \
            const unsigned char* ap = abase - 64 * d; \
            const unsigned char* ub = ubase - 64 * d; \
            bool valid = true; \
            if (MASKED) { const int J = 4 * ig + Il - d; valid = (unsigned)J < 64u; if (!valid) ub = lds; } \
            u32x4 b0 = *(const u32x4*)(ub), b1 = *(const u32x4*)(ub + 16); \
            if (MASKED) { if (!valid) { b0 = u32x4{0u, 0u, 0u, 0u}; b1 = b0; } } \
            const i32x8 bf = i32x8{(int)b0[0], (int)b0[1], (int)b0[2], (int)b0[3], (int)b1[0], (int)b1[1], (int)b1[2], (int)b1[3]}; \
            { const s16x4 q0 = lds_rd64(ap + 32), q1 = lds_rd64(ap + 40), q2 = lds_rd64(ap + 48), q3 = lds_rd64(ap + 56); \
              const u32x2 e0 = __builtin_bit_cast(u32x2, q0), e1 = __builtin_bit_cast(u32x2, q1), e2 = __builtin_bit_cast(u32x2, q2), e3 = __builtin_bit_cast(u32x2, q3); \
              acc0 = MFMA8((i32x8{(int)e0[0], (int)e0[1], (int)e1[0], (int)e1[1], (int)e2[0], (int)e2[1], (int)e3[0], (int)e3[1]}), bf, acc0); } \
            { const s16x4 q0 = lds_rd64(ap), q1 = lds_rd64(ap + 8), q2 = lds_rd64(ap + 16), q3 = lds_rd64(ap + 24); \
              const u32x2 e0 = __builtin_bit_cast(u32x2, q0), e1 = __builtin_bit_cast(u32x2, q1), e2 = __builtin_bit_cast(u32x2, q2), e3 = __builtin_bit_cast(u32x2, q3); \
              acc1 = MFMA8((i32x8{(int)e0[0], (int)e0[1], (int)e1[0], (int)e1[1], (int)e2[0], (int)e2[1], (int)e3[0], (int)e3[1]}), bf, acc1); } \
            } while (0)
        const int dlo = 4 * ig - 63, dhi = 4 * ig + 3;
#pragma unroll 1
        for (int d = dlo; d < dlo + 3; ++d) HY8_STEP(true);
#pragma unroll 1
        for (int d = dlo + 3; d <= dhi - 3; ++d) HY8_STEP(false);
#pragma unroll 1
        for (int d = dhi - 2; d <= dhi; ++d) HY8_STEP(true);
#undef HY8_STEP
        __syncthreads();
        const float skip = p.in[I_HSKIP][o * HYD + c];
        const float asc = ((const float*)(p.ws + WS_FSC))[o * 512 + c] * (1.f / HY8_US);
        const int gcol = (o == 0 ? 512 : 1024) + c;
        const float w0 = cw[gcol], w1 = cw[HYC + gcol], w2 = cw[2 * HYC + gcol], bias = cb[gcol];
        const bf16_t* zrow = ZT + (size_t)gcol * BT + (size_t)bb * SEQ;
        bf16_t* hyt = (bf16_t*)(p.ws + WS_HYT) + (size_t)c * BT + (size_t)bb * SEQ;
#pragma unroll
        for (int mm = 0; mm < 2; ++mm) {
#pragma unroll
            for (int g4 = 0; g4 < 4; ++g4) {
                const int t4 = (4 * ig + Il) * 64 + 32 * mm + 8 * g4 + 4 * hf;
                float gt[4];
                short_conv4(zrow, t4, w0, w1, w2, bias, gt);
                unsigned* up = (unsigned*)(lds + bb * HY8_USTR + t4);
                const unsigned uv = *up;
                const f32x2 ul = __builtin_amdgcn_cvt_pk_f32_fp8((int)uv, false), uh = __builtin_amdgcn_cvt_pk_f32_fp8((int)uv, true);
                const float us = skip * (1.f / HY8_US);
                const f32x16& a = mm ? acc1 : acc0;
                const float y0 = gt[0] * (a[4 * g4] * asc + us * ul[0]), y1 = gt[1] * (a[4 * g4 + 1] * asc + us * ul[1]);
                const float y2 = gt[2] * (a[4 * g4 + 2] * asc + us * uh[0]), y3 = gt[3] * (a[4 * g4 + 3] * asc + us * uh[1]);
                if (o == 0) *up = pk_fp8x4(y0 * HY8_US, y1 * HY8_US, y2 * HY8_US, y3 * HY8_US);
                else *(u32x2*)(hyt + t4) = u32x2{pk2(y0, y1), pk2(y2, y3)};
            }
        }
        __syncthreads();
    }
}

constexpr int CTL_QUEUE_D = 8192;
DI void phase_d(const Params& p, unsigned char* lds) {
    unsigned* ctr = (unsigned*)(p.ws + WS_CTL) + CTL_QUEUE_D;
    volatile LAS unsigned* slot = (volatile LAS unsigned*)(LAS unsigned char*)(lds + LDS_ST_OFF + 8);
    for (;;) {
        __syncthreads();
        if (get_tid() == 0) slot[0] = atomicAdd(ctr, 1u);
        __syncthreads();
        const int it = __builtin_amdgcn_readfirstlane((int)slot[0]);
        if (it >= 1024) break;
        if (it < 512) hyena_item8(p, it, lds); else attn_item(p, it - 512, lds);
    }
}

DI void phase_d2(const Params& p, unsigned char* lds) {
    constexpr int TILES = 8 * (BT / 256);
    const bf16_t* HYT = (const bf16_t*)(p.ws + WS_HYT);
    bf16_t* HY = (bf16_t*)(p.ws + WS_HY);
    for (int it = blockIdx.x; it < TILES; it += gridDim.x) {
        const int tid = get_tid();
        const int c0 = (it & 7) * 64, tok0 = (it >> 3) * 256;
        __syncthreads();
#pragma unroll
        for (int i = 0; i < 2; ++i) {
            const int idx = tid + i * NT, c = idx >> 5, tg = idx & 31;
            *(u32x4*)(lds + c * 528 + tg * 16) = *(const u32x4*)(HYT + (size_t)(c0 + c) * BT + tok0 + tg * 8);
        }
        __syncthreads();
#pragma unroll
        for (int i = 0; i < 2; ++i) {
            const int idx = tid + i * NT, tok = idx >> 3, cg = idx & 7;
            unsigned w[4];
#pragma unroll
            for (int e = 0; e < 4; ++e) {
                const unsigned lo = *(const unsigned short*)(lds + (cg * 8 + 2 * e) * 528 + tok * 2);
                const unsigned hi = *(const unsigned short*)(lds + (cg * 8 + 2 * e + 1) * 528 + tok * 2);
                w[e] = lo | (hi << 16);
            }
            *(u32x4*)(HY + (size_t)(tok0 + tok) * HYD + c0 + cg * 8) = u32x4{w[0], w[1], w[2], w[3]};
        }
    }
}

DI void phase_e(const Params& p, unsigned char* lds) {
    constexpr int TILES = 4 * (BT / 128);
    for (int it = blockIdx.x; it < TILES; it += gridDim.x) {
        const int tid = get_tid(), lane = tid & 63, wave = tid >> 6, wp = wave >> 2, wq = wave & 3;
        const int tn = it & 3, tm = it >> 2;
        const int n0 = tn * 256, tok0 = tm * 128;
        f32x4 acc1[4][2], acc2[4][2];
#pragma unroll
        for (int i = 0; i < 4; ++i)
#pragma unroll
            for (int j = 0; j < 2; ++j) { acc1[i][j] = f32x4{0.f, 0.f, 0.f, 0.f}; acc2[i][j] = f32x4{0.f, 0.f, 0.f, 0.f}; }
        if (SHADOW == 5) { gemm_shadow1<2>(RowLoader{(const bf16_t*)(p.ws + WS_WTAO) + (size_t)n0 * QD, QD}, RowLoader{(const bf16_t*)(p.ws + WS_ATT) + (size_t)tok0 * QD, QD}, QD / 64, lds);
                           gemm_shadow1<2>(RowLoader{(const bf16_t*)(p.ws + WS_WTHO) + (size_t)n0 * HYD, HYD}, RowLoader{(const bf16_t*)(p.ws + WS_HY) + (size_t)tok0 * HYD, HYD}, HYD / 64, lds); }
        {
            const RowLoader p1{(const bf16_t*)(p.ws + WS_WTAO) + (size_t)n0 * QD, QD}, q1{(const bf16_t*)(p.ws + WS_ATT) + (size_t)tok0 * QD, QD};
            const RowLoader p2{(const bf16_t*)(p.ws + WS_WTHO) + (size_t)n0 * HYD, HYD}, q2{(const bf16_t*)(p.ws + WS_HY) + (size_t)tok0 * HYD, HYD};
            gemm_mainloop<2>(acc1, p1, q1, QD / 64, lds, false, true, p2, q2);
            gemm_mainloop<2>(acc2, p2, q2, HYD / 64, lds, true, false);
        }
        const bf16_t* G = (const bf16_t*)(p.ws + WS_G);
        bf16_t* M = (bf16_t*)(p.ws + WS_H);
        constexpr int ES = 528, EG2 = 128 * ES;
        __syncthreads();
        {
            u32x4 ga[4], gh[4];
#pragma unroll
            for (int q = 0; q < 4; ++q) {
                const int idx = tid + q * NT, row = idx >> 5, ch = idx & 31;
                const bf16_t* gp = G + (size_t)(tok0 + row) * GC + n0 + ch * 8;
                ga[q] = *(const u32x4*)gp; gh[q] = *(const u32x4*)(gp + 1024);
            }
#pragma unroll
            for (int q = 0; q < 4; ++q) {
                const int idx = tid + q * NT, row = idx >> 5, ch = idx & 31;
                *(u32x4*)(lds + row * ES + ch * 16) = ga[q]; *(u32x4*)(lds + EG2 + row * ES + ch * 16) = gh[q];
            }
        }
        __syncthreads();
        const int l15 = lane & 15, lk = lane >> 4;
        u32x2 mo[4][2];
#pragma unroll
        for (int i = 0; i < 4; ++i)
#pragma unroll
            for (int j = 0; j < 2; ++j) {
                const int off = (wq * 32 + j * 16 + l15) * ES + (wp * 64 + i * 16 + lk * 4) * 2;
                const u32x2 ga = *(const u32x2*)(lds + off), gh = *(const u32x2*)(lds + EG2 + off);
                const float m0 = bflo(ga[0]) * acc1[i][j][0] + bflo(gh[0]) * acc2[i][j][0];
                const float m1 = bfhi(ga[0]) * acc1[i][j][1] + bfhi(gh[0]) * acc2[i][j][1];
                const float m2 = bflo(ga[1]) * acc1[i][j][2] + bflo(gh[1]) * acc2[i][j][2];
                const float m3 = bfhi(ga[1]) * acc1[i][j][3] + bfhi(gh[1]) * acc2[i][j][3];
                mo[i][j] = u32x2{pk2(m0, m1), pk2(m2, m3)};
            }
        __syncthreads();
#pragma unroll
        for (int i = 0; i < 4; ++i)
#pragma unroll
            for (int j = 0; j < 2; ++j) *(u32x2*)(lds + (wq * 32 + j * 16 + l15) * ES + (wp * 64 + i * 16 + lk * 4) * 2) = mo[i][j];
        __syncthreads();
#pragma unroll
        for (int q = 0; q < 4; ++q) {
            const int idx = tid + q * NT, row = idx >> 5, ch = idx & 31;
            *(u32x4*)(M + (size_t)(tok0 + row) * DM + n0 + ch * 8) = *(const u32x4*)(lds + row * ES + ch * 16);
        }
    }
}

DI void phase_f(const Params& p, unsigned char* lds) {
    constexpr int TILES = 4 * (BT / 256);
    const float* mod = (const float*)(p.ws + WS_MOD);
    for (int it = blockIdx.x; it < TILES; it += gridDim.x) {
        const int tid = get_tid(), lane = tid & 63, wave = tid >> 6, wp = wave >> 2, wq = wave & 3;
        const int tn = it & 3, tm = it >> 2;
        const int n0 = tn * 256, tok0 = tm * 256, b = tok0 >> 12;
        f32x4 acc[4][4];
#pragma unroll
        for (int i = 0; i < 4; ++i)
#pragma unroll
            for (int j = 0; j < 4; ++j) acc[i][j] = f32x4{0.f, 0.f, 0.f, 0.f};
        gemm_mainloop<4>(acc, RowLoader{(const bf16_t*)(p.ws + WS_WTO) + (size_t)n0 * DM, DM}, RowLoader{(const bf16_t*)(p.ws + WS_H) + (size_t)tok0 * DM, DM}, DM / 64, lds);
        const int l15 = lane & 15, lk = lane >> 4;
        constexpr int ES = 528;
        float ss[4] = {0.f, 0.f, 0.f, 0.f};
#pragma unroll
        for (int i = 0; i < 4; ++i) {
            const int n = n0 + wp * 64 + i * 16 + lk * 4;
            const f32x4 g1 = *(const f32x4*)(mod + b * 6144 + 2048 + n);
            const f32x4 s2 = *(const f32x4*)(mod + b * 6144 + 4096 + n), gf = *(const f32x4*)(p.in[I_NFFN] + n);
            const f32x4 gm = f32x4{gf[0] * (1.f + s2[0]), gf[1] * (1.f + s2[1]), gf[2] * (1.f + s2[2]), gf[3] * (1.f + s2[3])};
#pragma unroll
            for (int j = 0; j < 4; ++j) {
                const int tl = wq * 64 + j * 16 + l15;
                const f32x4 xv = *(const f32x4*)(p.in[I_X] + (size_t)(tok0 + tl) * DM + n);
                const f32x4 x1 = f32x4{xv[0] + g1[0] * acc[i][j][0], xv[1] + g1[1] * acc[i][j][1], xv[2] + g1[2] * acc[i][j][2], xv[3] + g1[3] * acc[i][j][3]};
                *(f32x4*)(p.out + (size_t)(tok0 + tl) * DM + n) = x1;
                ss[j] += x1[0] * x1[0] + x1[1] * x1[1] + x1[2] * x1[2] + x1[3] * x1[3];
                *(u32x2*)(lds + tl * ES + (wp * 64 + i * 16 + lk * 4) * 2) = u32x2{pk2(x1[0] * gm[0], x1[1] * gm[1]), pk2(x1[2] * gm[2], x1[3] * gm[3])};
            }
        }
#pragma unroll
        for (int j = 0; j < 4; ++j) {
            const float t = sum_x32(sum_x16(ss[j]));
            if (lk == 0) ((float*)(p.ws + WS_SSQ1))[(size_t)(tok0 + wq * 64 + j * 16 + l15) * 16 + tn * 4 + wp] = t;
        }
        __syncthreads();
        bf16_t* Y = (bf16_t*)(p.ws + WS_Y);
#pragma unroll
        for (int q = 0; q < 8; ++q) {
            const int idx = tid + q * NT, row = idx >> 5, ch = idx & 31;
            *(u32x4*)(Y + (size_t)(tok0 + row) * DM + n0 + ch * 8) = *(const u32x4*)(lds + row * ES + ch * 16);
        }
    }
}

DI void phase_h(const Params& p, unsigned char* lds) {
    constexpr int TILES = 8 * (BT / 256);
    float* rsb = (float*)(lds + 132 * 1024);
    bool pre = false;
    for (int it = blockIdx.x; it < TILES; it += gridDim.x) {
        const int tid = get_tid(), lane = tid & 63, wave = tid >> 6, wp = wave >> 2, wq = wave & 3;
        const int tn = it & 7, tm = it >> 3;
        const int n0 = tn * 256, tok0 = tm * 256, b = tok0 >> 12;
        const int it2 = it + (int)gridDim.x; const bool has2 = it2 < TILES;
        const int n2 = (has2 ? it2 & 7 : tn) * 256, tk2 = (has2 ? it2 >> 3 : tm) * 256;
        __syncthreads();
        if (tid < 256) {
            const float* sq = (const float*)(p.ws + WS_SSQ1) + (size_t)(tok0 + tid) * 16;
            const f32x4 a = *(const f32x4*)sq, c = *(const f32x4*)(sq + 4), d = *(const f32x4*)(sq + 8), e = *(const f32x4*)(sq + 12);
            const float ssq = (a[0] + a[1] + a[2] + a[3]) + (c[0] + c[1] + c[2] + c[3]) + (d[0] + d[1] + d[2] + d[3]) + (e[0] + e[1] + e[2] + e[3]);
            rsb[tid] = rsqrtf(ssq * (1.f / DM) + EPS);
        }
        f32x4 acc[4][4];
#pragma unroll
        for (int i = 0; i < 4; ++i)
#pragma unroll
            for (int j = 0; j < 4; ++j) acc[i][j] = f32x4{0.f, 0.f, 0.f, 0.f};
        gemm_mainloop<4>(acc, RowLoader{(const bf16_t*)(p.ws + WS_WTQ) + (size_t)n0 * DM, DM}, RowLoader{(const bf16_t*)(p.ws + WS_Y) + (size_t)tok0 * DM, DM}, DM / 64, lds, pre, has2,
                         RowLoader{(const bf16_t*)(p.ws + WS_WTQ) + (size_t)n2 * DM, DM}, RowLoader{(const bf16_t*)(p.ws + WS_Y) + (size_t)tk2 * DM, DM});
        pre = has2;
        bf16_t* QP = (bf16_t*)(p.ws + WS_G);
        const float* shq = (const float*)(p.ws + WS_SHQ) + b * 2048;
        const int l15 = lane & 15, lk = lane >> 4;
#pragma unroll
        for (int i = 0; i < 4; ++i) {
            const int n = n0 + wp * 64 + i * 16 + lk * 4;
            const f32x4 sh = *(const f32x4*)(shq + n);
#pragma unroll
            for (int j = 0; j < 4; ++j) {
                const int tl = wq * 64 + j * 16 + l15;
                const float rs = rsb[tl];
                *(u32x2*)(QP + (size_t)(tok0 + tl) * 2048 + n) = u32x2{pk2(rs * acc[i][j][0] + sh[0], rs * acc[i][j][1] + sh[1]), pk2(rs * acc[i][j][2] + sh[2], rs * acc[i][j][3] + sh[3])};
            }
        }
    }
}

DI void ins16(float (&L)[16], float v) {
#pragma unroll
    for (int i = 0; i < 16; ++i) { const float hi = fmaxf(L[i], v); v = fminf(L[i], v); L[i] = hi; }
}
DI void cex_desc(float& a, float& b) { const float hi = fmaxf(a, b), lo = fminf(a, b); a = hi; b = lo; }
DI void bitonic_merge16_desc(float (&v)[16]) {
#pragma unroll
    for (int j = 8; j > 0; j >>= 1)
#pragma unroll
        for (int i = 0; i < 16; ++i) if ((i ^ j) > i) cex_desc(v[i], v[i ^ j]);
}
DI void sort16_desc(float (&v)[16]) {
#pragma unroll
    for (int k = 2; k <= 16; k <<= 1)
#pragma unroll
        for (int j = k >> 1; j > 0; j >>= 1)
#pragma unroll
            for (int i = 0; i < 16; ++i) {
                const int l = i ^ j;
                if (l > i) { if ((i & k) == 0) cex_desc(v[i], v[l]); else cex_desc(v[l], v[i]); }
            }
}
DI void top16_merge(float (&a)[16], const float (&b)[16]) {
#pragma unroll
    for (int i = 0; i < 16; ++i) a[i] = fmaxf(a[i], b[15 - i]);
    bitonic_merge16_desc(a);
}
DI float pack_idx(float v, unsigned idx, unsigned mask) { return __uint_as_float((__float_as_uint(v) & ~mask) | idx); }
constexpr int PI_LIST = 0;
DI void peer_select_item(const Params& p, int item, unsigned char* lds) {
    const int tok0 = item * 128;
    __syncthreads();
    {
        const int tid = get_tid(), lane = tid & 63, wave = tid >> 6, b = tok0 >> 12;
        const float* sh2 = (const float*)(p.ws + WS_MOD) + b * 6144 + 3072 + lane * 16;
        float sh[16];
#pragma unroll
        for (int i = 0; i < 16; i += 4) { const f32x4 v = *(const f32x4*)(sh2 + i); sh[i] = v[0]; sh[i + 1] = v[1]; sh[i + 2] = v[2]; sh[i + 3] = v[3]; }
#pragma unroll 1
        for (int t = 0; t < 8; ++t) {
            const int tok = tok0 + wave * 8 + t;
            const bf16_t* yr = (const bf16_t*)(p.ws + WS_Y) + (size_t)tok * DM + lane * 16;
            const u32x4 y0 = *(const u32x4*)yr, y1 = *(const u32x4*)(yr + 8);
            const float rs = rsqrtf(sum16(((const float*)(p.ws + WS_SSQ1))[(size_t)tok * 16 + (lane & 15)]) * (1.f / DM) + EPS);
            float f[16];
#pragma unroll
            for (int q = 0; q < 4; ++q) { f[2 * q] = bflo(y0[q]); f[2 * q + 1] = bfhi(y0[q]); f[8 + 2 * q] = bflo(y1[q]); f[9 + 2 * q] = bfhi(y1[q]); }
            float mx = 0.f;
#pragma unroll
            for (int i = 0; i < 16; ++i) { f[i] = rs * f[i] + sh[i]; mx = fmaxf(mx, fabsf(f[i])); }
            mx = fmaxf(wave_max(mx), 1e-30f);
            const float qs = 127.f / mx;
            unsigned w8[4];
            int qsum = 0;
#pragma unroll
            for (int q = 0; q < 4; ++q) {
                const int q0 = __float2int_rn(f[4 * q] * qs), q1 = __float2int_rn(f[4 * q + 1] * qs), q2 = __float2int_rn(f[4 * q + 2] * qs), q3 = __float2int_rn(f[4 * q + 3] * qs);
                w8[q] = (q0 & 255) | ((q1 & 255) << 8) | ((q2 & 255) << 16) | ((unsigned)q3 << 24);
                qsum += q0 + q1 + q2 + q3;
            }
            *(u32x4*)(p.ws + WS_X8 + (size_t)tok * DM + lane * 16) = u32x4{w8[0], w8[1], w8[2], w8[3]};
            const float xs = wave_sum((float)qsum);
            if (lane == 0) ((f32x2*)(p.ws + WS_SX))[tok] = f32x2{mx * (1.f / 127.f), xs};
        }
    }
    {
#pragma unroll 1
        for (int sb = 0; sb < 4; ++sb) {
            const int tid = get_tid(), lane = tid & 63, hp = tid >> 6;
            const int r = lane & 31, hf = lane >> 5;
            const bf16_t* keys = (const bf16_t*)(p.ws + WS_KEYS) + (size_t)((hp & 1) * 8 + (hp >> 1)) * 128 * 128 + 8 * hf;
            const bf16_t* qp = (const bf16_t*)(p.ws + WS_G) + (size_t)(tok0 + r) * 2048 + hp * 128 + 8 * hf;
            bf16x8 bq[8];
#pragma unroll
            for (int ks = 0; ks < 8; ++ks) bq[ks] = *(const bf16x8*)(qp + (size_t)sb * 32 * 2048 + 16 * ks);
            f32x16 acc[4];
#pragma unroll
            for (int m = 0; m < 4; ++m)
#pragma unroll
                for (int i = 0; i < 16; ++i) acc[m][i] = 0.f;
#pragma unroll
            for (int ks = 0; ks < 8; ++ks) {
#pragma unroll
                for (int m = 0; m < 4; ++m) {
                    const bf16x8 ak = *(const bf16x8*)(keys + (size_t)(m * 32 + r) * 128 + 16 * ks);
                    acc[m] = MFMA32(ak, bq[ks], acc[m]);
                }
            }
            float V[4][16];
#define PK_SORT(m) do { _Pragma("unroll") for (int i = 0; i < 16; ++i) V[m][i] = pack_idx(acc[m][i], (unsigned)((m) * 32 + (i & 3) + 8 * (i >> 2) + 4 * hf), 127u); sort16_desc(V[m]); } while (0)
            PK_SORT(0); PK_SORT(1); top16_merge(V[0], V[1]); __builtin_amdgcn_sched_barrier(0);
            PK_SORT(2); PK_SORT(3); top16_merge(V[2], V[3]); __builtin_amdgcn_sched_barrier(0);
            top16_merge(V[0], V[2]);
#undef PK_SORT
            float (&L)[16] = V[0];
            const int t3 = get_tid(), hf3 = (t3 >> 5) & 1, r3 = t3 & 31, hp3 = t3 >> 6;
            float P[16];
#pragma unroll
            for (int i = 0; i < 16; ++i) {
                auto sw = __builtin_amdgcn_permlane32_swap(__float_as_uint(L[i]), __float_as_uint(L[i]), false, false);
                P[i] = hf3 ? __uint_as_float(sw[0]) : __uint_as_float(sw[1]);
            }
            top16_merge(L, P);
            if (hf3 == 0) {
                float* dst = (float*)(lds + PI_LIST) + ((sb * 32 + r3) * 16 + hp3) * 16;
#pragma unroll
                for (int i = 0; i < 16; i += 4) *(f32x4*)(dst + i) = f32x4{L[i], L[i + 1], L[i + 2], L[i + 3]};
            }
        }
    }
    __syncthreads();
    {
        const int tid = get_tid();
        {
            const int tok = tid >> 3, h = tid & 7;
            const float* l1 = (const float*)(lds + PI_LIST) + (tok * 16 + 2 * h) * 16;
            const float* l2 = l1 + 16;
            float v1[16], v2[16];
#pragma unroll
            for (int i = 0; i < 16; i += 4) {
                const f32x4 a = *(const f32x4*)(l1 + i), b = *(const f32x4*)(l2 + i);
                v1[i] = a[0]; v1[i + 1] = a[1]; v1[i + 2] = a[2]; v1[i + 3] = a[3];
                v2[i] = b[0]; v2[i + 1] = b[1]; v2[i + 2] = b[2]; v2[i + 3] = b[3];
            }
            float B[16];
#pragma unroll
            for (int i = 0; i < 16; ++i) B[i] = -3.0e38f;
#pragma unroll
            for (int i = 0; i < 16; ++i)
#pragma unroll
                for (int j = 0; j < 16; ++j)
                    if ((i + 1) * (j + 1) <= 16) ins16(B, pack_idx(v1[i] + v2[j], (unsigned)(i * 16 + j), 255u));
            float e[16], sum = 0.f;
#pragma unroll
            for (int k = 0; k < 16; ++k) { e[k] = __expf(B[k] - B[0]); sum += e[k]; }
            const float inv = 1.f / sum;
            int* ex = (int*)(p.ws + WS_EXPI) + (size_t)(tok0 + tok) * 128 + h * 16;
            float* gt = (float*)(p.ws + WS_GATE) + ((size_t)(tok0 + tok) * 128 + h * 16) * 2;
            const float* usc = (const float*)(p.ws + WS_USC);
            int ev[16]; float gv[16], sv[16];
#pragma unroll
            for (int k = 0; k < 16; ++k) {
                const unsigned ij = __float_as_uint(B[k]) & 255u;
                const unsigned i1 = __float_as_uint(l1[ij >> 4]) & 127u, i2 = __float_as_uint(l2[ij & 15u]) & 127u;
                ev[k] = (int)(i1 * 128u + i2);
                gv[k] = e[k] * inv * ((const float*)(p.ws + WS_VSC))[ev[k]];
                sv[k] = usc[ev[k]];
            }
#pragma unroll
            for (int k = 0; k < 16; k += 4) *(u32x4*)(ex + k) = u32x4{(unsigned)ev[k], (unsigned)ev[k + 1], (unsigned)ev[k + 2], (unsigned)ev[k + 3]};
#pragma unroll
            for (int k = 0; k < 16; k += 2) *(f32x4*)(gt + 2 * k) = f32x4{gv[k], sv[k], gv[k + 1], sv[k + 1]};
        }
    }
}
DI void phase_i1(const Params& p, unsigned char* lds) {
    for (int it = blockIdx.x; it < BT / 128; it += gridDim.x) peer_select_item(p, it, lds);
}

DI float dot16_fp8(const u32x4& w, const float (&x)[16]) {
    float d = 0.f;
#pragma unroll
    for (int i = 0; i < 4; ++i) {
        const auto lo = __builtin_amdgcn_cvt_pk_f32_fp8((int)w[i], false);
        const auto hi = __builtin_amdgcn_cvt_pk_f32_fp8((int)w[i], true);
        d += lo[0] * x[4 * i] + lo[1] * x[4 * i + 1] + hi[0] * x[4 * i + 2] + hi[1] * x[4 * i + 3];
    }
    return d;
}
template<int NPART, class F> DI void run_partitioned(const Params& p, unsigned char* lds, int qbase, int nitems, F&& body) {
    unsigned* ctl = (unsigned*)(p.ws + WS_CTL);
    volatile LAS unsigned* slot = (volatile LAS unsigned*)(LAS unsigned char*)(lds + LDS_ST_OFF + 8);
    const int x0 = (int)(xb_xcc_id() & 7u);
#pragma unroll 1
    for (int pp = 0; pp < NPART; ++pp) {
        const int part = (NPART == 8) ? ((x0 + pp) & 7) : ((((x0 + (pp >> 1)) & 7)) + 8 * (pp & 1));
        for (;;) {
            __syncthreads();
            if (get_tid() == 0) slot[0] = atomicAdd(ctl + qbase + 64 * part, 1u);
            __syncthreads();
            const int it = __builtin_amdgcn_readfirstlane((int)slot[0]);
            if (it >= nitems) break;
            body(part, it);
        }
    }
}
constexpr int CTL_QUEUE_I2 = 8320, CTL_QUEUE_I3 = 9408;
constexpr int UW_BYTES = 5120, UW_GT = 2048, UW_LIST = 4096;
DI void peer_u_chunk(const Params& p, int part, int chunk, unsigned char* lds) {
    const int tid = get_tid(), lane = tid & 63, wave = __builtin_amdgcn_readfirstlane(tid >> 6);
    unsigned char* wl = lds + wave * UW_BYTES;
    unsigned* lst = (unsigned*)(wl + UW_LIST);
    const f32x2* gts = (const f32x2*)(wl + UW_GT);
    const int h = lane >> 5, l5 = lane & 31;
    const unsigned char* UT4 = p.ws + WS_UT + l5 * 16;
    const int tokw = chunk * 256 + wave * 2;
    int pe[4]; u32x4 ph[2]; f32x2 pg[4]; f32x2 psx[2];
#define U_PREFETCH(tok) do { \
        const int* ex_ = (const int*)(p.ws + WS_EXPI) + (size_t)(tok) * 128 + lane; \
        const f32x2* gt_ = (const f32x2*)(p.ws + WS_GATE) + (size_t)(tok) * 128 + lane; \
        const unsigned char* hr_ = p.ws + WS_X8 + (size_t)(tok) * DM + lane * 16; \
        pe[0] = ex_[0]; pe[1] = ex_[64]; pe[2] = ex_[128]; pe[3] = ex_[192]; \
        pg[0] = gt_[0]; pg[1] = gt_[64]; pg[2] = gt_[128]; pg[3] = gt_[192]; \
        ph[0] = *(const u32x4*)hr_; ph[1] = *(const u32x4*)(hr_ + DM); \
        psx[0] = ((const f32x2*)(p.ws + WS_SX))[tok]; psx[1] = ((const f32x2*)(p.ws + WS_SX))[(tok) + 1]; } while (0)
    U_PREFETCH(tokw);
#pragma unroll 1
    for (int sub = 0; sub < 8; ++sub) {
        const int tok0 = tokw + sub * 32;
        const f32x2 sx0 = psx[0], sx1 = psx[1];
        *(u32x4*)(wl + lane * 16) = ph[0]; *(u32x4*)(wl + 1024 + lane * 16) = ph[1];
        int cnt = 0;
#pragma unroll
        for (int g = 0; g < 4; ++g) {
            ((f32x2*)(wl + UW_GT))[g * 64 + lane] = pg[g];
            const bool m = (pe[g] >> 11) == part;
            const unsigned long long bm = __ballot(m);
            const int pos = cnt + __builtin_amdgcn_mbcnt_hi((unsigned)(bm >> 32), __builtin_amdgcn_mbcnt_lo((unsigned)bm, 0u));
            if (m) lst[pos] = ((unsigned)(g * 64 + lane) << 16) | (unsigned)pe[g];
            cnt += __popcll(bm);
        }
        if (sub + 1 < 8) U_PREFETCH(tok0 + 32);
#pragma unroll 1
        for (int base = 0; base < cnt; base += 16) {
            u32x4 row[8]; unsigned en[8];
#pragma unroll
            for (int q = 0; q < 8; ++q) {
                en[q] = lst[min(base + 2 * q + h, cnt - 1)];
                row[q] = *(const u32x4*)(UT4 + (size_t)(en[q] & 0x3fffu) * 512);
            }
            int d[8];
#pragma unroll
            for (int q = 0; q < 8; ++q) {
                const unsigned char* xr = wl + (en[q] >> 23) * 1024 + l5 * 32;
                const u32x4 xa = *(const u32x4*)xr, xb = *(const u32x4*)(xr + 16);
                int ai = 0;
#pragma unroll
                for (int i = 0; i < 4; ++i) {
                    const unsigned lo = row[q][i] & 0x0F0F0F0Fu, hi = (row[q][i] >> 4) & 0x0F0F0F0Fu;
                    ai = __builtin_amdgcn_sdot4((int)lo, (int)((i < 2) ? xa[2 * i] : xb[2 * i - 4]), ai, false);
                    ai = __builtin_amdgcn_sdot4((int)hi, (int)((i < 2) ? xa[2 * i + 1] : xb[2 * i - 3]), ai, false);
                }
                d[q] = ai;
            }
            int r4[4], r2[2];
#pragma unroll
            for (int i = 0; i < 4; ++i) { auto sw = __builtin_amdgcn_permlane16_swap((unsigned)d[i], (unsigned)d[i + 4], false, false); r4[i] = (int)(sw[0] + sw[1]); }
            const bool b3 = (lane & 8) != 0, b2 = (lane & 4) != 0;
#pragma unroll
            for (int i = 0; i < 2; ++i) r2[i] = (b3 ? r4[i + 2] : r4[i]) + dppi<0x128>(b3 ? r4[i] : r4[i + 2]);
            int ai = (b2 ? r2[1] : r2[0]) + dppi<0x141>(b2 ? r2[0] : r2[1]);
            ai += dppi<0xB1>(ai); ai += dppi<0x4E>(ai);
            const int qi = ((lane >> 2) & 7);
            const int ei = base + 2 * (4 * ((qi >> 2) & 1) + 2 * ((qi >> 1) & 1) + (qi & 1)) + h;
            const unsigned ent = lst[min(ei, cnt - 1)];
            const int idx = (int)(ent >> 16);
            const f32x2 gs = gts[idx];
            const f32x2 sxv = (idx >> 7) ? sx1 : sx0;
            const float a = ((float)ai - 8.f * sxv[1]) * (gs[1] * sxv[0]);
            const float y = 0.7978845608028654f * (a + 0.044715f * a * a * a);
            const float th = 1.f - 2.f / (__expf(2.f * y) + 1.f);
            const float w = 0.5f * a * (1.f + th) * gs[0];
            if ((lane & 3) == 0 && ei < cnt) ((u32x2*)(p.ws + WS_PAIRS))[(size_t)tok0 * 128 + idx] = u32x2{ent & 0x3fffu, __float_as_uint(w)};
        }
    }
#undef U_PREFETCH
}
DI void phase_i2(const Params& p, unsigned char* lds) {
    run_partitioned<8>(p, lds, CTL_QUEUE_I2, BT / 256, [&](int part, int it) { peer_u_chunk(p, part, it, lds); });
}
DI void peer_v_chunk(const Params& p, int p8, int chunk, unsigned char* lds) {
    const int tid = get_tid(), lane = tid & 63, wave = __builtin_amdgcn_readfirstlane(tid >> 6);
    unsigned char* wl = lds + wave * 1024;
    const int es = lane >> 3, ch = lane & 7, slice = p8 & 3;
    const unsigned char* VT4 = p.ws + WS_VTAB + (size_t)slice * 16384 * 128 + ch * 16;
    const float* mod = (const float*)(p.ws + WS_MOD);
    const int col = slice * 256 + 32 * ch + 4 * es;
    const int tokw = (p8 >> 2) * 16384 + chunk * 256 + wave;
    u32x4 pp = *((const u32x4*)(p.ws + WS_PAIRS + (size_t)tokw * 1024) + lane);
#pragma unroll 1
    for (int step = 0; step < 16; ++step) {
        const int tok = tokw + step * 16, b = tok >> 12;
        *(u32x4*)(wl + lane * 16) = pp;
        if (step + 1 < 16) pp = *((const u32x4*)(p.ws + WS_PAIRS + (size_t)(tok + 16) * 1024) + lane);
        float* xo = p.out + (size_t)tok * DM + col;
        const f32x4 x1 = *(const f32x4*)xo;
        const f32x4 g2 = *(const f32x4*)(mod + b * 6144 + 5120 + col);
        f32x2 acc[16];
#pragma unroll
        for (int i = 0; i < 16; ++i) acc[i] = f32x2{0.f, 0.f};
        const u32x2* pr = (const u32x2*)wl + es;
#pragma unroll 1
        for (int ih = 0; ih < 4; ++ih) {
            u32x2 pe[4]; u32x4 row[4];
#pragma unroll
            for (int q = 0; q < 4; ++q) { pe[q] = pr[(ih * 4 + q) * 8]; row[q] = *(const u32x4*)(VT4 + (size_t)pe[q][0] * 128); }
#pragma unroll
            for (int q = 0; q < 4; ++q) {
                const float w = __uint_as_float(pe[q][1]);
                const f32x2 w2 = f32x2{w, w};
#pragma unroll
                for (int i = 0; i < 4; ++i) {
                    acc[4 * i]     += w2 * __builtin_amdgcn_cvt_scalef32_pk_f32_fp4(row[q][i], 1.0f, 0);
                    acc[4 * i + 1] += w2 * __builtin_amdgcn_cvt_scalef32_pk_f32_fp4(row[q][i], 1.0f, 1);
                    acc[4 * i + 2] += w2 * __builtin_amdgcn_cvt_scalef32_pk_f32_fp4(row[q][i], 1.0f, 2);
                    acc[4 * i + 3] += w2 * __builtin_amdgcn_cvt_scalef32_pk_f32_fp4(row[q][i], 1.0f, 3);
                }
            }
        }
        float a32[32];
#pragma unroll
        for (int i = 0; i < 16; ++i) { a32[2 * i] = acc[i][0]; a32[2 * i + 1] = acc[i][1]; }
        float r16[16], r8[8], r4[4];
#pragma unroll
        for (int i = 0; i < 16; ++i) { auto sw = __builtin_amdgcn_permlane32_swap(__float_as_uint(a32[i]), __float_as_uint(a32[i + 16]), false, false); r16[i] = __uint_as_float(sw[0]) + __uint_as_float(sw[1]); }
#pragma unroll
        for (int i = 0; i < 8; ++i) { auto sw = __builtin_amdgcn_permlane16_swap(__float_as_uint(r16[i]), __float_as_uint(r16[i + 8]), false, false); r8[i] = __uint_as_float(sw[0]) + __uint_as_float(sw[1]); }
        const bool b3 = (lane & 8) != 0;
#pragma unroll
        for (int i = 0; i < 4; ++i) { const float keep = b3 ? r8[i + 4] : r8[i], send = b3 ? r8[i] : r8[i + 4]; r4[i] = keep + dppf<0x128>(send); }
        const f32x4 x2 = f32x4{x1[0] + g2[0] * r4[0], x1[1] + g2[1] * r4[1], x1[2] + g2[2] * r4[2], x1[3] + g2[3] * r4[3]};
        *(f32x4*)xo = x2;
        const float ss = wave_sum(x2[0] * x2[0] + x2[1] * x2[1] + x2[2] * x2[2] + x2[3] * x2[3]);
        if (lane == 0) ((float*)(p.ws + WS_SSQ))[(size_t)tok * 8 + slice] = ss;
    }
}
DI void phase_i3(const Params& p, unsigned char* lds) {
    run_partitioned<8>(p, lds, CTL_QUEUE_I3, 16384 / 256, [&](int part, int it) { peer_v_chunk(p, part, it, lds); });
}
DI void phase_i4(const Params& p) {
    const bool bad = xb_ld((unsigned*)(p.ws + WS_CTL) + CTL_BADTID) != 0u || xb_ld((unsigned*)(p.ws + WS_CTL) + XB_TMO) != 0u;
    for (int it = blockIdx.x; it < BT / 16; it += gridDim.x) {
        const int tid = get_tid(), lane = tid & 63, row = it * 16 + (tid >> 6);
        const float* sq = (const float*)(p.ws + WS_SSQ) + (size_t)row * 8;
        const f32x4 s0 = *(const f32x4*)sq;
        const float ss = s0[0] + s0[1] + s0[2] + s0[3];
        float rs = rsqrtf(ss * (1.f / DM) + EPS);
        if (bad) rs = __builtin_nanf("");
        float* o = p.out + (size_t)row * DM;
#pragma unroll
        for (int j = 0; j < 4; ++j) {
            const int c = j * 256 + lane * 4;
            const f32x4 v = *(const f32x4*)(o + c), g = *(const f32x4*)(p.in[I_FNG] + c);
            *(f32x4*)(o + c) = f32x4{v[0] * rs * g[0], v[1] * rs * g[1], v[2] * rs * g[2], v[3] * rs * g[3]};
        }
    }
}

__global__ void __launch_bounds__(NT) mega(Params p) {
    unsigned char* lds = g_lds;
    volatile LAS unsigned* st = (volatile LAS unsigned*)(LAS unsigned char*)(lds + LDS_ST_OFF);
    {
        const unsigned hw = __builtin_amdgcn_s_getreg((5 << 11) | 4);
        if ((threadIdx.x & 63) == 0) g_lds[LDS_WTAB_OFF + hw] = (unsigned char)(threadIdx.x >> 6);
        if (threadIdx.x < 2) st[threadIdx.x] = 0u;
        __syncthreads();
        if (get_tid() != (int)threadIdx.x) ((unsigned*)(p.ws + WS_CTL))[CTL_BADTID] = 1u;
    }
    XcdBarrier bar = xcd_barrier_post((unsigned*)(p.ws + WS_CTL), st);
    float* sm = (float*)lds;

#define STAMP(k, which) do { if (PROBE_PHASE == (k) && blockIdx.x == 0 && get_tid() == 0) ((volatile unsigned long long*)(lds + LDS_PROBE_OFF))[which] = __builtin_amdgcn_s_memrealtime(); } while (0)
    STAMP(21, 0); STAMP(30, 0); STAMP(31, 0);
    STAMP(0, 0); phase_a(p, sm);   xcd_barrier(bar); STAMP(0, 1);
    STAMP(1, 0); phase_b(p, sm);   xcd_barrier(bar); STAMP(1, 1);
    if (PROBE_PHASE == 20) { STAMP(20, 0); xcd_barrier(bar); xcd_barrier(bar); xcd_barrier(bar); xcd_barrier(bar); STAMP(20, 1); }
    STAMP(2, 0); phase_c(p, lds);  xcd_barrier(bar); STAMP(2, 1);
    STAMP(3, 0); phase_d(p, lds);  xcd_barrier(bar); STAMP(3, 1);
    STAMP(4, 0); phase_d2(p, lds); xcd_barrier(bar); STAMP(4, 1);
    STAMP(5, 0); phase_e(p, lds);  xcd_barrier(bar); STAMP(5, 1);
    STAMP(6, 0); phase_f(p, lds);  xcd_barrier(bar); STAMP(6, 1);
    STAMP(8, 0); phase_h(p, lds);  xcd_barrier(bar); STAMP(8, 1);
    STAMP(9, 0); phase_i1(p, lds); xcd_barrier(bar); STAMP(9, 1);
    STAMP(10, 0); phase_i2(p, lds); xcd_barrier(bar); STAMP(10, 1);
    STAMP(11, 0); phase_i3(p, lds); xcd_barrier(bar); STAMP(11, 1);
    STAMP(12, 0); phase_i4(p);
    if (PROBE_PHASE >= 0) {
        xcd_barrier(bar); STAMP(12, 1); STAMP(21, 1);
        if (blockIdx.x == 0 && get_tid() == 0) {
            volatile unsigned long long* ts = (volatile unsigned long long*)(lds + LDS_PROBE_OFF);
            p.out[0] += (float)(ts[1] - ts[0]) * (0.01f / PROBE_SCALE);
        }
    }
}

extern "C" void kernel_launch(void* const* d_in, const int* in_sizes, int n_in, void* d_out, int out_size, void* d_ws, size_t ws_size, hipStream_t stream) {
    static int grid = 0;
    if (grid == 0) {
        int dev = 0, cus = 0;
        if (hipGetDevice(&dev) != hipSuccess || hipDeviceGetAttribute(&cus, hipDeviceAttributeMultiprocessorCount, dev) != hipSuccess) { fprintf(stderr, "kernel_launch: device query failed\n"); grid = -1; return; }
        if (n_in != N_IN || ws_size < WS_END) { fprintf(stderr, "kernel_launch: unexpected n_in %d or ws_size %zu (< %zu)\n", n_in, ws_size, (size_t)WS_END); grid = -1; return; }
        grid = cus;
    }
    if (grid < 0) return;
    (void)hipMemsetAsync((char*)d_ws + WS_CTL, 0, 64 * 1024, stream);
    Params p{};
    for (int i = 0; i < N_IN; ++i) p.in[i] = (const float*)d_in[i];
    p.out = (float*)d_out; p.ws = (unsigned char*)d_ws;
    hipLaunchKernelGGL(mega, dim3(grid), dim3(NT), 0, stream, p);
}
```

```cpp
#include <hip/hip_runtime.h>
#include <stdint.h>
#include <cstdio>

#define DI __device__ __forceinline__
#define LAS __attribute__((address_space(3)))
typedef unsigned short bf16_t;
typedef short bf16x8 __attribute__((ext_vector_type(8)));
typedef short s16x4 __attribute__((ext_vector_type(4)));
typedef float f32x4 __attribute__((ext_vector_type(4)));
typedef float f32x2 __attribute__((ext_vector_type(2)));
typedef float f32x16 __attribute__((ext_vector_type(16)));
typedef unsigned u32x4 __attribute__((ext_vector_type(4)));
typedef unsigned u32x2 __attribute__((ext_vector_type(2)));

#ifndef PROBE_PHASE
#define PROBE_PHASE (-1)
#endif
#ifndef SHADOW
#define SHADOW 0
#endif
#ifndef PROBE_SCALE
#define PROBE_SCALE 100.f
#endif
constexpr int BATCH = 8, SEQ = 4096, DM = 1024, BT = BATCH * SEQ;
constexpr int CTX = 256, TK = SEQ + CTX;
constexpr int NH = 8, NKV = 2, HD = 64;
constexpr int QD = 512, KVD = 128, HYD = 512, HYC = 1536, GC = 2048, INC = 4352;
constexpr int PH = 8, PNK = 128, PDK = 256, PTOP = 16;
constexpr float EPS = 1e-6f;
constexpr int NT = 1024;

enum { I_X = 0, I_C, I_CTX, I_CCTX, I_ADAW, I_ADAB, I_NMIX, I_NFFN, I_WIN, I_QNG, I_KNG, I_HCW, I_HCB,
       I_HW1, I_HB1, I_HW2, I_HB2, I_HW3, I_HB3, I_HW4, I_HFREQ, I_HSKIP, I_WAO, I_WHO, I_WO, I_PWQ, I_PK1, I_PK2, I_PU, I_PV, I_FNG, N_IN };

constexpr size_t MB = 1024 * 1024;
constexpr size_t WS_CTL   = 0;
constexpr size_t WS_MOD   = 64 * 1024;
constexpr size_t WS_ROPE  = WS_MOD + 9 * 6144 * 4;
static_assert(WS_ROPE + 16 * 1024 + 8 * 2048 * 4 + 4096 <= 512 * 1024, "ws");
constexpr size_t WS_PART  = 512 * 1024;
constexpr size_t WS_WTIN  = 3 * MB;
constexpr size_t WS_WTAO  = WS_WTIN + (size_t)INC * DM * 2;
constexpr size_t WS_WTHO  = WS_WTAO + (size_t)DM * QD * 2;
constexpr size_t WS_WTO   = WS_WTHO + (size_t)DM * HYD * 2;
constexpr size_t WS_WTQ   = WS_WTO + (size_t)DM * DM * 2;
constexpr size_t WS_KEYS  = WS_WTQ + (size_t)2048 * DM * 2;
constexpr size_t WS_R     = WS_KEYS + (size_t)2 * 8 * 128 * 128 * 2;
constexpr size_t WS_KB    = WS_R + (size_t)2 * 512 * 8192 * 2;
constexpr size_t WS_VT    = WS_KB + (size_t)BATCH * NKV * TK * HD * 2;
constexpr size_t WS_HC    = WS_VT + (size_t)BATCH * NKV * TK * HD * 2;
constexpr size_t WS_H     = 60 * MB;
constexpr size_t WS_G     = WS_H + 64 * MB;
constexpr size_t WS_ZT    = WS_G + 128 * MB;
constexpr size_t WS_Q     = WS_ZT + 96 * MB;
constexpr size_t WS_ATT   = WS_Q + 32 * MB;
constexpr size_t WS_HYT   = WS_ATT + 32 * MB;
constexpr size_t WS_TAB   = WS_HYT + 32 * MB;
constexpr size_t WS_END   = WS_TAB + 32 * MB;
static_assert(WS_HC + (size_t)2048 * DM * 2 <= WS_H, "ws overlap");
constexpr size_t WS_FRAW  = WS_ATT;
constexpr size_t WS_HY    = WS_Q;
constexpr size_t WS_UT    = WS_TAB;
constexpr size_t WS_VSC   = WS_PART + 2 * MB + 320 * 1024;
constexpr size_t WS_VTAB  = WS_TAB + 16 * MB;
constexpr size_t WS_H8    = WS_ATT;
constexpr size_t WS_W8G   = WS_HYT;
constexpr size_t WS_EXPI  = WS_ATT;
constexpr size_t WS_GATE  = WS_Q;
constexpr size_t WS_PAIRS = WS_HYT;
constexpr size_t WS_SSQ   = WS_PART + 1 * MB;
constexpr size_t WS_USC   = WS_PART + 2 * MB;
constexpr size_t WS_Y     = WS_ZT;
constexpr size_t WS_X8    = WS_ZT + 64 * MB;
constexpr size_t WS_SSQ1  = WS_ATT + 16 * MB;
constexpr size_t WS_SX    = WS_PART + 2 * MB + 64 * 1024;
constexpr size_t WS_SHQ   = WS_ROPE + 16 * 1024;
constexpr size_t WS_FSC   = WS_SHQ + 64 * 1024;
constexpr float VSCALE = 64.f;
constexpr float W8_SCALE = 64.f;
constexpr float VT_SCALE = 16.f;
constexpr float X8_MAX = 192.f;

constexpr int CTL_BADTID = 8000;
DI unsigned f2bf(float f) { unsigned u = __builtin_bit_cast(unsigned, f); return (u + 0x7fffu + ((u >> 16) & 1u)) >> 16; }
DI unsigned pk2(float lo, float hi) { return f2bf(lo) | (f2bf(hi) << 16); }
DI float bf2f(unsigned short b) { return __builtin_bit_cast(float, (unsigned)b << 16); }
DI float bflo(unsigned u) { return __builtin_bit_cast(float, u << 16); }
DI float bfhi(unsigned u) { return __builtin_bit_cast(float, u & 0xffff0000u); }
DI float red2pi(float x) { const float k = rintf(x * 0.15915494309189535f); float r = fmaf(-k, 6.2831854820251465f, x); return fmaf(-k, -1.7484555e-7f, r); }
DI float fsin(float x) { return __sinf(red2pi(x)); }
DI float fcos(float x) { return __cosf(red2pi(x)); }
constexpr int LDS_BYTES = 160 * 1024;
constexpr int LDS_ST_OFF = LDS_BYTES - 16;
constexpr int LDS_PROBE_OFF = LDS_BYTES - 16 - 32;
constexpr int LDS_WTAB_OFF = LDS_BYTES - 16 - 32 - 64;
constexpr int LDS_USER = LDS_WTAB_OFF;
__shared__ __attribute__((aligned(16))) unsigned char g_lds[LDS_BYTES];
DI s16x4 lds_rd64(const unsigned char* ptr) { return *(const volatile LAS s16x4*)(const LAS unsigned char*)ptr; }
DI int get_tid() {
    const unsigned hw = __builtin_amdgcn_s_getreg((5 << 11) | 4);
    unsigned w = g_lds[LDS_WTAB_OFF + hw];
    w = __builtin_amdgcn_readfirstlane(w);
    int t;
    asm volatile("v_mbcnt_lo_u32_b32 %0, -1, 0\n\tv_mbcnt_hi_u32_b32 %0, -1, %0\n\tv_lshl_or_b32 %0, %1, 6, %0" : "=&v"(t) : "s"(w));
    return t;
}
template<int CTRL> DI float dppf(float v) { return __uint_as_float(__builtin_amdgcn_update_dpp(0u, __float_as_uint(v), CTRL, 0xF, 0xF, true)); }
template<int CTRL> DI int dppi(int v) { return (int)__builtin_amdgcn_update_dpp(0u, (unsigned)v, CTRL, 0xF, 0xF, true); }
DI float sum16(float v) { v += dppf<0xB1>(v); v += dppf<0x4E>(v); v += dppf<0x141>(v); v += dppf<0x140>(v); return v; }
DI float sum_x16(float v) { auto r = __builtin_amdgcn_permlane16_swap(__float_as_uint(v), __float_as_uint(v), false, false); return __uint_as_float(r[0]) + __uint_as_float(r[1]); }
DI float sum_x32(float v) { auto r = __builtin_amdgcn_permlane32_swap(__float_as_uint(v), __float_as_uint(v), false, false); return __uint_as_float(r[0]) + __uint_as_float(r[1]); }
DI float max_x32(float v) { auto r = __builtin_amdgcn_permlane32_swap(__float_as_uint(v), __float_as_uint(v), false, false); return fmaxf(__uint_as_float(r[0]), __uint_as_float(r[1])); }
DI float wave_sum(float v) { return sum_x32(sum_x16(sum16(v))); }
DI float wave_max(float v) {
    v = fmaxf(v, dppf<0xB1>(v)); v = fmaxf(v, dppf<0x4E>(v)); v = fmaxf(v, dppf<0x141>(v)); v = fmaxf(v, dppf<0x140>(v));
    { auto r = __builtin_amdgcn_permlane16_swap(__float_as_uint(v), __float_as_uint(v), false, false); v = fmaxf(__uint_as_float(r[0]), __uint_as_float(r[1])); }
    { auto r = __builtin_amdgcn_permlane32_swap(__float_as_uint(v), __float_as_uint(v), false, false); v = fmaxf(__uint_as_float(r[0]), __uint_as_float(r[1])); }
    return v;
}


#define XB_TMO      128
#define XB_XCNT(j)  (256  + 64 * (j))
#define XB_XSUB(j)  (1280 + 64 * (j))
#define XB_XGEN(j)  (2304 + 64 * (j))
#define XB_TOP      3328
#define XB_TOPGEN   3392
#define XCD_BAR_WORDS 3456
#define XB_SPIN_CAP (1u << 27)
DI unsigned xb_ld(unsigned* p)              { return __hip_atomic_load(p, __ATOMIC_RELAXED, __HIP_MEMORY_SCOPE_AGENT); }
DI unsigned xb_add(unsigned* p, unsigned v) { return __hip_atomic_fetch_add(p, v, __ATOMIC_RELAXED, __HIP_MEMORY_SCOPE_AGENT); }
DI unsigned xb_xcc_id() { return (unsigned)__builtin_amdgcn_s_getreg((3 << 11) | 20) & 0xFu; }
#define XB_SPIN(cond, bar) do { unsigned _sp = 0; while (cond) { __builtin_amdgcn_s_sleep(1); \
    if ((++_sp & 255u) == 0u) { if (xb_ld(&(bar)[XB_TMO])) break; if (_sp > XB_SPIN_CAP) { atomicAdd(&(bar)[XB_TMO], 1u); break; } } } } while (0)
struct XcdBarrier { unsigned* bar; unsigned x; volatile LAS unsigned* st; };
DI XcdBarrier xcd_barrier_post(unsigned* bar, volatile LAS unsigned* st) {
    XcdBarrier b; b.bar = bar; b.x = xb_xcc_id(); b.st = st;
    if (get_tid() == 0) (void)xb_add(&bar[XB_XCNT(b.x)], 1u);
    return b;
}
DI void xcd_barrier_complete(unsigned* bar, unsigned x, unsigned& nloc, unsigned& nx) {
    const unsigned G = gridDim.x * gridDim.y * gridDim.z;
    unsigned sum, cnt, mine, sp = 0u;
    for (;;) {
        sum = 0u; cnt = 0u; mine = 0u;
#pragma unroll
        for (unsigned j = 0; j < 16; ++j) { const unsigned c = xb_ld(&bar[XB_XCNT(j)]); sum += c; cnt += (c > 0u) ? 1u : 0u; mine = (j == x) ? c : mine; }
        if (sum == G) break;
        __builtin_amdgcn_s_sleep(1);
        if ((++sp & 255u) == 0u) { if (xb_ld(&bar[XB_TMO])) break; if (sp > XB_SPIN_CAP) { atomicAdd(&bar[XB_TMO], 1u); break; } }
    }
    nloc = mine > 0u ? mine : 1u; nx = cnt > 0u ? cnt : 1u;
}
DI void xcd_barrier(const XcdBarrier& b) {
    asm volatile("s_waitcnt vmcnt(0)" ::: "memory");
    __syncthreads();
    if (get_tid() == 0) {
        unsigned* bar = b.bar;
        __builtin_amdgcn_s_waitcnt(0);
        unsigned nloc = b.st[0], nx = b.st[1];
        if (nloc == 0u) { xcd_barrier_complete(bar, b.x, nloc, nx); b.st[0] = nloc; b.st[1] = nx; }
        const unsigned old = xb_add(&bar[XB_XSUB(b.x)], 1u);
        const unsigned gen = old / nloc;
        if (old + 1u == (gen + 1u) * nloc) {
            __builtin_amdgcn_fence(__ATOMIC_RELEASE, "agent");
            asm volatile("s_waitcnt vmcnt(0)" ::: "memory");
            const unsigned og = xb_add(&bar[XB_TOP], 1u);
            const unsigned tg = og / nx;
            if (og + 1u == (tg + 1u) * nx) xb_add(&bar[XB_TOPGEN], 1u);
            else XB_SPIN(xb_ld(&bar[XB_TOPGEN]) == tg, bar);
            __builtin_amdgcn_fence(__ATOMIC_ACQUIRE, "agent");
            xb_add(&bar[XB_XGEN(b.x)], 1u);
            asm volatile("s_waitcnt vmcnt(0)" ::: "memory");
        } else {
            XB_SPIN(xb_ld(&bar[XB_XGEN(b.x)]) == gen, bar);
            __builtin_amdgcn_fence(__ATOMIC_ACQUIRE, "agent");
            asm volatile("s_waitcnt vmcnt(0)" ::: "memory");
        }
    }
    __syncthreads();
}

struct Params { const float* in[N_IN]; float* out; unsigned char* ws; };


DI void transpose_tile(const float* __restrict__ W, int K, int N, bf16_t* __restrict__ Wt, int tile, float* sm) {
    const int tid = get_tid();
    const int ntn = N / 256, tk = tile / ntn, tn = tile % ntn;
    __syncthreads();
#pragma unroll
    for (int i = 0; i < 4; ++i) {
        const int idx = tid + i * NT, kk = idx >> 6, n4 = (idx & 63) * 4;
        const f32x4 v = *(const f32x4*)(W + (size_t)(tk * 64 + kk) * N + tn * 256 + n4);
        float* d = sm + kk * 257 + n4;
        d[0] = v[0]; d[1] = v[1]; d[2] = v[2]; d[3] = v[3];
    }
    __syncthreads();
#pragma unroll
    for (int i = 0; i < 2; ++i) {
        const int idx = tid + i * NT, nn = idx & 255, kg = idx >> 8;
        const float* c = sm + kg * 8 * 257 + nn;
        *(u32x4*)(Wt + (size_t)(tn * 256 + nn) * K + tk * 64 + kg * 8) = u32x4{pk2(c[0], c[257]), pk2(c[2 * 257], c[3 * 257]), pk2(c[4 * 257], c[5 * 257]), pk2(c[6 * 257], c[7 * 257])};
    }
}

DI void mod_item(const Params& p, int item, float* sm) {
    const int tid = get_tid();
    float* sc = sm;
    float* red = sm + 9 * 1024;
    __syncthreads();
    for (int i = tid; i < 9 * 1024; i += NT) {
        const float v = (i < 8 * 1024) ? p.in[I_C][i] : p.in[I_CCTX][i - 8 * 1024];
        sc[i] = v / (1.f + __expf(-v));
    }
    __syncthreads();
    const int col = tid & 15, kg = tid >> 4, n0 = item * 16;
    float acc[9];
#pragma unroll
    for (int r = 0; r < 9; ++r) acc[r] = 0.f;
    const float* w = p.in[I_ADAW] + (size_t)kg * 16 * 6144 + n0 + col;
    float wv[16];
#pragma unroll
    for (int k = 0; k < 16; ++k) wv[k] = w[(size_t)k * 6144];
#pragma unroll
    for (int k = 0; k < 16; ++k)
#pragma unroll
        for (int r = 0; r < 9; ++r) acc[r] += sc[r * 1024 + kg * 16 + k] * wv[k];
#pragma unroll
    for (int r = 0; r < 9; ++r) red[(kg * 9 + r) * 16 + col] = acc[r];
    __syncthreads();
    if (tid < 9 * 16) {
        const int r = tid >> 4, c2 = tid & 15;
        float s = p.in[I_ADAB][n0 + c2];
        for (int g = 0; g < 64; ++g) s += red[(g * 9 + r) * 16 + c2];
        ((float*)(p.ws + WS_MOD))[r * 6144 + n0 + c2] = s;
    }
    __syncthreads();
}

DI void filter_item(const Params& p, int item, float* sm) {
    const int tid = get_tid();
    float* z  = sm;
    float* ha = sm + 16 * 36;
    float* hb = ha + 16 * 64;
    const int t0 = item * 16;
    float* w1s = hb + 16 * 64;
    float* w2s = w1s + 33 * 64;
    float* w3s = w2s + 64 * 64;
    __syncthreads();
    {
        const f32x4 a2 = *(const f32x4*)(p.in[I_HW2] + tid * 4), a3 = *(const f32x4*)(p.in[I_HW3] + tid * 4);
        f32x4 a1 = f32x4{0.f, 0.f, 0.f, 0.f};
        if (tid < 33 * 16) a1 = *(const f32x4*)(p.in[I_HW1] + tid * 4);
        *(f32x4*)(w2s + tid * 4) = a2; *(f32x4*)(w3s + tid * 4) = a3;
        if (tid < 33 * 16) *(f32x4*)(w1s + tid * 4) = a1;
    }
    if (tid < 16 * 33) {
        const int pp = tid / 33, i = tid % 33;
        const int t = t0 + pp;
        float v;
        if (i == 0) v = (float)t / (float)(SEQ - 1);
        else {
            const int fi = (i - 1) & 15;
            const float f = 1e-4f + (float)fi * ((15.f - 1e-4f) / 15.f);
            const float w = 6.283185307179586f * (float)t / (float)SEQ;
            const float a = f * w;
            v = (i <= 16) ? fcos(a) : -fsin(a);
        }
        z[pp * 36 + i] = v;
    }
    __syncthreads();
    const int pp = tid >> 6, j = tid & 63;
    const float fr = p.in[I_HFREQ][j];
    {
        float a = p.in[I_HB1][j];
#pragma unroll 11
        for (int i = 0; i < 33; ++i) a += z[pp * 36 + i] * w1s[i * 64 + j];
        ha[pp * 64 + j] = fsin(fr * a);
    }
    __syncthreads();
    {
        float a = p.in[I_HB2][j];
#pragma unroll 16
        for (int i = 0; i < 64; ++i) a += ha[pp * 64 + i] * w2s[i * 64 + j];
        hb[pp * 64 + j] = fsin(fr * a);
    }
    __syncthreads();
    {
        float a = p.in[I_HB3][j];
#pragma unroll 16
        for (int i = 0; i < 64; ++i) a += hb[pp * 64 + i] * w3s[i * 64 + j];
        __syncthreads();
        ha[pp * 64 + j] = fsin(fr * a);
    }
    __syncthreads();
    float* fraw = (float*)(p.ws + WS_FRAW);
    float* part = (float*)(p.ws + WS_PART);
    const float* w4 = p.in[I_HW4];
    {
        const int lane = tid & 63, wave = tid >> 6, l15 = lane & 15, lk = lane >> 4;
        float af[16];
#pragma unroll
        for (int ks = 0; ks < 16; ++ks) af[ks] = ha[l15 * 64 + ks * 4 + lk];
        const float mind = -3.0701134573253945f, maxd = -15.350567286626973f;
        const unsigned wvo = (unsigned)((lk * 2048 + wave * 128 + 4 * l15) * 4);
        f32x4 bw[16];
#pragma unroll
        for (int ks = 0; ks < 16; ++ks) { const char* bk = (const char*)w4 + (size_t)ks * 32768; asm volatile("" : "+s"(bk)); bw[ks] = *(const f32x4*)(bk + wvo); }
#pragma unroll 1
        for (int g = 0; g < 2; ++g) {
            f32x4 acc[4];
#pragma unroll
            for (int u = 0; u < 4; ++u) acc[u] = f32x4{0.f, 0.f, 0.f, 0.f};
#pragma unroll
            for (int ks = 0; ks < 16; ++ks) {
#pragma unroll
                for (int u = 0; u < 4; ++u) acc[u] = __builtin_amdgcn_mfma_f32_16x16x4f32(af[ks], bw[ks][u], acc[u], 0, 0, 0);
                if (g == 0) { const char* bk = (const char*)w4 + (size_t)ks * 32768 + 256; asm volatile("" : "+s"(bk)); bw[ks] = *(const f32x4*)(bk + wvo); }
            }
#pragma unroll
            for (int u = 0; u < 4; ++u) {
                const int col = wave * 128 + 64 * g + 4 * l15 + u;
                const int c = col & 511, dir = (col >> 9) & 1;
                const float delta = fabsf(mind + (float)c * ((maxd - mind) / 511.f));
                float sabs = 0.f, v[4];
#pragma unroll
                for (int r = 0; r < 4; ++r) {
                    const int t = t0 + 4 * lk + r;
                    const float t01 = (float)t / (float)(SEQ - 1);
                    v[r] = acc[u][r] * expf(-t01 * delta);
                    if (!(dir == 1 && t == 0)) sabs += fabsf(v[r]);
                }
                *(f32x4*)(fraw + (size_t)col * SEQ + t0 + 4 * lk) = f32x4{v[0], v[1], v[2], v[3]};
                sabs = sum_x32(sum_x16(sabs));
                if (lk == 0) part[item * 2048 + col] = sabs;
            }
        }
    }
    __syncthreads();
}

DI void table_conv_item(const Params& p, int ci, unsigned char* lds);
DI void phase_a(const Params& p, float* sm) {
    if (blockIdx.x & 1) for (int ci = blockIdx.x; ci < 4096; ci += gridDim.x) table_conv_item(p, ci, (unsigned char*)sm);
    constexpr int T_WIN = 16 * 17, T_AO = 8 * 4, T_HO = 8 * 4, T_WO = 16 * 4, T_WQ = 16 * 8;
    constexpr int E0 = T_WIN, E1 = E0 + T_AO, E2 = E1 + T_HO, E3 = E2 + T_WO, E4 = E3 + T_WQ;
    constexpr int E5 = E4 + 64;
    constexpr int E6 = E5 + 384;
    constexpr int E7 = E6 + 1;
    constexpr int E8 = E7 + 256;
    for (int it = blockIdx.x; it < E8; it += gridDim.x) {
        int item = it;
        if (item < 256) { filter_item(p, item, sm); if (PROBE_PHASE == 30 && blockIdx.x == 0 && get_tid() == 0) ((volatile unsigned long long*)(g_lds + LDS_PROBE_OFF))[1] = __builtin_amdgcn_s_memrealtime(); continue; }
        item -= 256;
        if (item < 384) { mod_item(p, item, sm); if (PROBE_PHASE == 31 && blockIdx.x == 0 && get_tid() == 0) ((volatile unsigned long long*)(g_lds + LDS_PROBE_OFF))[1] = __builtin_amdgcn_s_memrealtime(); continue; }
        item -= 384;
        if (item < 1) {
            const int tid = get_tid();
            float* rope = (float*)(p.ws + WS_ROPE);
            const int pos = tid >> 4, f = tid & 15;
            const float inv = powf(10000.f, -(float)(2 * f) / 32.f);
            const float ang = (float)pos * inv;
            rope[tid] = fcos(ang); rope[1024 + tid] = fsin(ang);
            continue;
        }
        item -= 1;
        if (item < 64) {
            const int tid = get_tid();
            const float* src = (item < 32) ? p.in[I_PK1] : p.in[I_PK2];
            bf16_t* dst = (bf16_t*)(p.ws + WS_KEYS) + (size_t)item * 4096;
            const f32x4 v = *(const f32x4*)(src + (size_t)(item & 31) * 4096 + tid * 4);
            *(u32x2*)(dst + tid * 4) = u32x2{pk2(v[0], v[1]), pk2(v[2], v[3])};
            continue;
        }
        item -= 64;
        if (item < T_WIN) { transpose_tile(p.in[I_WIN], DM, INC, (bf16_t*)(p.ws + WS_WTIN), item, sm); continue; }
        item -= T_WIN;
        if (item < T_AO) { transpose_tile(p.in[I_WAO], QD, DM, (bf16_t*)(p.ws + WS_WTAO), item, sm); continue; }
        item -= T_AO;
        if (item < T_HO) { transpose_tile(p.in[I_WHO], HYD, DM, (bf16_t*)(p.ws + WS_WTHO), item, sm); continue; }
        item -= T_HO;
        if (item < T_WO) { transpose_tile(p.in[I_WO], DM, DM, (bf16_t*)(p.ws + WS_WTO), item, sm); continue; }
        item -= T_WO;
        transpose_tile(p.in[I_PWQ], DM, 2048, (bf16_t*)(p.ws + WS_WTQ), item, sm);
    }
    (void)E1; (void)E2; (void)E3; (void)E4; (void)E5; (void)E6; (void)E7;
    if (!(blockIdx.x & 1)) for (int ci = blockIdx.x; ci < 4096; ci += gridDim.x) table_conv_item(p, ci, (unsigned char*)sm);
}

typedef int i32x8 __attribute__((ext_vector_type(8)));
#define MFMA8(a, b, c) __builtin_amdgcn_mfma_scale_f32_32x32x64_f8f6f4((a), (b), (c), 0, 0, 0, 0x7F7F7F7F, 0, 0x7F7F7F7F)
DI unsigned pk_fp8x4(float a, float b, float c, float d) {
    int w = 0;
    w = __builtin_amdgcn_cvt_pk_fp8_f32(fminf(fmaxf(a, -440.f), 440.f), fminf(fmaxf(b, -440.f), 440.f), w, false);
    w = __builtin_amdgcn_cvt_pk_fp8_f32(fminf(fmaxf(c, -440.f), 440.f), fminf(fmaxf(d, -440.f), 440.f), w, true);
    return (unsigned)w;
}
DI void norm_mod_row(const float* __restrict__ src, const float* __restrict__ g, const float* __restrict__ shift, const float* __restrict__ scale, bf16_t* __restrict__ dst, unsigned char* __restrict__ dst8 = nullptr) {
    const int lane = get_tid() & 63;
    f32x4 v[4];
    float ss = 0.f;
#pragma unroll
    for (int j = 0; j < 4; ++j) { v[j] = *(const f32x4*)(src + j * 256 + lane * 4); ss += v[j][0] * v[j][0] + v[j][1] * v[j][1] + v[j][2] * v[j][2] + v[j][3] * v[j][3]; }
    ss = wave_sum(ss);
    const float rs = rsqrtf(ss * (1.f / DM) + EPS);
#pragma unroll
    for (int j = 0; j < 4; ++j) {
        const int c = j * 256 + lane * 4;
        const f32x4 gg = *(const f32x4*)(g + c), sh = *(const f32x4*)(shift + c), sc = *(const f32x4*)(scale + c);
        float o[4];
#pragma unroll
        for (int e = 0; e < 4; ++e) o[e] = v[j][e] * rs * gg[e] * (1.f + sc[e]) + sh[e];
        *(u32x2*)(dst + c) = u32x2{pk2(o[0], o[1]), pk2(o[2], o[3])};
        if (dst8) *(unsigned*)(dst8 + c) = pk_fp8x4(o[0], o[1], o[2], o[3]);
    }
}

DI void filter_norm_item(const Params& p, int item, float* sm) {
    const int tid = get_tid();
    const int o = item >> 9, c = item & 511;
    const int colf = o * 1024 + c, colb = colf + 512;
    const float* part = (const float*)(p.ws + WS_PART);
    const float* fraw = (const float*)(p.ws + WS_FRAW);
    float v[8], mx = 0.f;
#pragma unroll
    for (int i = 0; i < 8; ++i) {
        const int n = tid * 8 + i;
        v[i] = (n == 0) ? 0.f : (n <= 4096 ? fraw[(size_t)colf * SEQ + 4096 - n] : fraw[(size_t)colb * SEQ + n - 4096]);
        mx = fmaxf(mx, fabsf(v[i]));
    }
    float sacc = 0.f;
    if (tid < 512) sacc = part[(tid & 255) * 2048 + ((tid < 256) ? colf : colb)];
    sacc = wave_sum(sacc); mx = wave_max(mx);
    __syncthreads();
    if ((tid & 63) == 0) { sm[tid >> 6] = sacc; sm[16 + (tid >> 6)] = mx; }
    __syncthreads();
    float tot = EPS, gmx = 0.f;
#pragma unroll
    for (int i = 0; i < 8; ++i) tot += sm[i];
#pragma unroll
    for (int i = 0; i < 16; ++i) gmx = fmaxf(gmx, sm[16 + i]);
    const float inv = 1.f / tot;
    int ex; (void)frexpf(fmaxf(gmx * inv, 1e-30f), &ex);
    const float sc = ldexpf(1.f, 8 - ex), isc = ldexpf(1.f, ex - 8);
    if (tid == 0) ((float*)(p.ws + WS_FSC))[item] = isc;
    const float k = inv * sc;
    int w0 = 0, w1 = 0;
    w0 = __builtin_amdgcn_cvt_pk_fp8_f32(v[0] * k, v[1] * k, w0, false); w0 = __builtin_amdgcn_cvt_pk_fp8_f32(v[2] * k, v[3] * k, w0, true);
    w1 = __builtin_amdgcn_cvt_pk_fp8_f32(v[4] * k, v[5] * k, w1, false); w1 = __builtin_amdgcn_cvt_pk_fp8_f32(v[6] * k, v[7] * k, w1, true);
    *(u32x2*)(p.ws + WS_R + (size_t)item * 8192 + tid * 8) = u32x2{(unsigned)w0, (unsigned)w1};
    __syncthreads();
}

DI void table_conv_item(const Params& p, int ci, unsigned char* lds) {
    const int tid = get_tid();
    const size_t el = (size_t)(ci & 2047) * 8192 + tid * 8;
    const float* src = (ci < 2048 ? p.in[I_PU] : p.in[I_PV]) + el;
    const f32x4 a = *(const f32x4*)src, b = *(const f32x4*)(src + 4);
    const size_t e = el >> 10, col = el & 1023;
    if (ci < 2048) {
        float sq = a[0] * a[0] + a[1] * a[1] + a[2] * a[2] + a[3] * a[3] + b[0] * b[0] + b[1] * b[1] + b[2] * b[2] + b[3] * b[3];
        sq = wave_sum(sq);
        float* wm = (float*)lds;
        __syncthreads();
        if ((tid & 63) == 0) wm[tid >> 6] = sq;
        __syncthreads();
        const int w2 = (tid >> 7) * 2;
        const float rsig = fmaxf(sqrtf((wm[w2] + wm[w2 + 1]) * (1.f / 1024.f)), 1e-30f);
        const float sc = 2.f / rsig;
        if ((tid & 127) == 0) ((float*)(p.ws + WS_USC))[e] = rsig * 0.5f;
        const float xs[8] = {a[0], a[1], a[2], a[3], b[0], b[1], b[2], b[3]};
        unsigned w = 0;
#pragma unroll
        for (int j = 0; j < 8; ++j) {
            const float m = fabsf(xs[j] * sc);
            const unsigned code = (m < 0.25f ? 0u : m < 0.75f ? 1u : m < 1.25f ? 2u : m < 1.75f ? 3u : m < 2.5f ? 4u : m < 3.5f ? 5u : m < 5.f ? 6u : 7u) | (xs[j] < 0.f ? 8u : 0u);
            w |= code << (4 * j);
        }
        *(unsigned*)(p.ws + WS_UT + (el >> 1)) = w;
    } else {
        float sq = a[0] * a[0] + a[1] * a[1] + a[2] * a[2] + a[3] * a[3] + b[0] * b[0] + b[1] * b[1] + b[2] * b[2] + b[3] * b[3];
        sq = wave_sum(sq);
        float* wm = (float*)lds;
        __syncthreads();
        if ((tid & 63) == 0) wm[tid >> 6] = sq;
        __syncthreads();
        const int w2 = (tid >> 7) * 2;
        const float rsig = fmaxf(sqrtf((wm[w2] + wm[w2 + 1]) * (1.f / 1024.f)), 1e-30f);
        const float sc = 2.f / rsig;
        if ((tid & 127) == 0) ((float*)(p.ws + WS_VSC))[e] = rsig * 0.5f;
        const float xs[8] = {a[0], a[1], a[2], a[3], b[0], b[1], b[2], b[3]};
        unsigned wc = 0;
#pragma unroll
        for (int j = 0; j < 8; ++j) {
            const float m = fabsf(xs[j] * sc);
            const unsigned code = (m < 0.25f ? 0u : m < 0.75f ? 1u : m < 1.25f ? 2u : m < 1.75f ? 3u : m < 2.5f ? 4u : m < 3.5f ? 5u : m < 5.f ? 6u : 7u) | (xs[j] < 0.f ? 8u : 0u);
            wc |= code << (4 * j);
        }
        const unsigned wo = (unsigned)dppi<0xB1>((int)wc);
        const int cs = (int)(col & 255), ah = cs >> 7, jp = (cs & 127) >> 3;
        const unsigned wev = (jp & 1) ? wo : wc, wod = (jp & 1) ? wc : wo;
        unsigned char* dst = p.ws + WS_VTAB + ((col >> 8) * 16384 + e) * 128 + 8 * ah + (jp >> 1);
#pragma unroll
        for (int q = 0; q < 4; ++q) {
            const int nt = q + 4 * (jp & 1);
            dst[16 * nt] = (unsigned char)(((wev >> (4 * nt)) & 15u) | (((wod >> (4 * nt)) & 15u) << 4));
        }
    }
}

DI void phase_b(const Params& p, float* sm) {
    const int wave = get_tid() >> 6;
    const float* mod = (const float*)(p.ws + WS_MOD);
    constexpr int ROW_ITEMS = (BT + BATCH * CTX) / 16;
    constexpr int CONV = 2 * 16384 * 1024 / 8192;
    constexpr int SHQ = 8 * 2048 / 16;
    constexpr int W8I = 2048 / 16;
    for (int it = blockIdx.x; it < ROW_ITEMS + 1024 + CONV + SHQ + W8I; it += gridDim.x) {
        if (it < 1024) { filter_norm_item(p, it, sm); continue; }
        if (it >= ROW_ITEMS + 1024 + CONV + SHQ) {
            const int tid = get_tid(), lane = tid & 63, n = (it - ROW_ITEMS - 1024 - CONV - SHQ) * 16 + (tid >> 6);
            const bf16_t* wr = (const bf16_t*)(p.ws + WS_WTIN) + (size_t)(2304 + n) * DM + lane * 16;
            const u32x4 w0 = *(const u32x4*)wr, w1 = *(const u32x4*)(wr + 8);
            const float k = W8_SCALE;
            *(u32x4*)(p.ws + WS_W8G + (size_t)n * DM + lane * 16) = u32x4{pk_fp8x4(bflo(w0[0]) * k, bfhi(w0[0]) * k, bflo(w0[1]) * k, bfhi(w0[1]) * k), pk_fp8x4(bflo(w0[2]) * k, bfhi(w0[2]) * k, bflo(w0[3]) * k, bfhi(w0[3]) * k),
                                                                                pk_fp8x4(bflo(w1[0]) * k, bfhi(w1[0]) * k, bflo(w1[1]) * k, bfhi(w1[1]) * k), pk_fp8x4(bflo(w1[2]) * k, bfhi(w1[2]) * k, bflo(w1[3]) * k, bfhi(w1[3]) * k)};
            continue;
        }
        if (it >= ROW_ITEMS + 1024 + CONV) {
            const int tid = get_tid(), lane = tid & 63, o = (it - ROW_ITEMS - 1024 - CONV) * 16 + (tid >> 6), b = o >> 11, n = o & 2047;
            const bf16_t* wr = (const bf16_t*)(p.ws + WS_WTQ) + (size_t)n * DM + lane * 16;
            const float* sh = mod + b * 6144 + 3072 + lane * 16;
            const u32x4 w0 = *(const u32x4*)wr, w1 = *(const u32x4*)(wr + 8);
            float d = 0.f;
#pragma unroll
            for (int i = 0; i < 4; ++i) { d += bflo(w0[i]) * sh[2 * i] + bfhi(w0[i]) * sh[2 * i + 1] + bflo(w1[i]) * sh[8 + 2 * i] + bfhi(w1[i]) * sh[9 + 2 * i]; }
            d = wave_sum(d);
            if (lane == 0) ((float*)(p.ws + WS_SHQ))[o] = d;
            continue;
        }
        if (it >= ROW_ITEMS + 1024) continue;
        const int row = (it - 1024) * 16 + wave;
        if (row < BT) {
            const int b = row >> 12;
            norm_mod_row(p.in[I_X] + (size_t)row * DM, p.in[I_NMIX], mod + b * 6144, mod + b * 6144 + 1024, (bf16_t*)(p.ws + WS_H) + (size_t)row * DM, p.ws + WS_H8 + (size_t)row * DM);
        } else {
            const int r = row - BT;
            norm_mod_row(p.in[I_CTX] + (size_t)r * DM, p.in[I_NMIX], mod + 8 * 6144, mod + 8 * 6144 + 1024, (bf16_t*)(p.ws + WS_HC) + (size_t)r * DM);
        }
    }
}

#define MFMA16(a, b, c) __builtin_amdgcn_mfma_f32_16x16x32_bf16((a), (b), (c), 0, 0, 0)
constexpr int GT_P = 256 * 128;
struct RowLoader {
    const bf16_t* base; int ld;
    static constexpr bool kmajor = false;
    template<int ROWS> DI void issue(unsigned char* tile, int kt, int lane, int wave) const {
#pragma unroll
        for (int i = 0; i < ROWS / 128; ++i) {
            const int grp = i * 16 + wave, row = grp * 8 + (lane >> 3), c = (lane & 7) ^ (lane >> 3);
            __builtin_amdgcn_global_load_lds((const unsigned*)((const char*)base + (unsigned)((row * ld + kt * 64 + c * 8) * 2)), (unsigned*)(tile + grp * 1024), 16, 0, 0);
        }
    }
};

struct ColLoader {
    const bf16_t* base; size_t ld;
    static constexpr bool kmajor = true;
    template<int ROWS> DI void issue(unsigned char* tile, int kt, int lane, int wave) const {
        static_assert(ROWS == 128, "k-major loader: 128-row Q tiles only");
        const int row = wave * 4 + (lane >> 4), c = (lane & 15) ^ (2 * (row & 3));
        __builtin_amdgcn_global_load_lds((const unsigned*)(base + (size_t)(kt * 64 + row) * ld + c * 8), (unsigned*)(tile + wave * 1024), 16, 0, 0);
    }
};
template<int NQ>
DI void gemm_prefetch(const RowLoader& lp, const RowLoader& lq, unsigned char* lds) {
    const int tid = get_tid(), lane = tid & 63, wave = __builtin_amdgcn_readfirstlane(tid >> 6);
    lp.template issue<256>(lds, 0, lane, wave); lq.template issue<NQ * 64>(lds + GT_P, 0, lane, wave);
}
template<int NQ, bool KMAJOR>
DI void gemm_kstep(f32x4 (&acc)[4][NQ], const unsigned char* cur, int wp, int wq, int l15, int lk) {
#pragma unroll
    for (int ks = 0; ks < 2; ++ks) {
        bf16x8 fp[4], fq[NQ];
#pragma unroll
        for (int i = 0; i < 4; ++i) { const int row = wp * 64 + i * 16 + l15; fp[i] = *(const bf16x8*)(cur + row * 128 + (((ks * 4 + lk) ^ (row & 7)) << 4)); }
#pragma unroll
        for (int j = 0; j < NQ; ++j) {
            if constexpr (KMAJOR) {
                const int q4 = l15 >> 2, tokq = wq * (16 * NQ) + j * 16 + 4 * (l15 & 3);
                const unsigned char* ap = cur + GT_P + ((ks * 4 + lk) * 8 + q4) * 256 + (((tokq >> 3) ^ (2 * q4)) << 4) + ((tokq >> 2) & 1) * 8;
                const s16x4 lo = __builtin_amdgcn_ds_read_tr16_b64_v4i16((LAS s16x4*)(LAS unsigned char*)ap);
                const s16x4 hi = __builtin_amdgcn_ds_read_tr16_b64_v4i16((LAS s16x4*)(LAS unsigned char*)(ap + 4 * 256));
                fq[j] = __builtin_shufflevector(lo, hi, 0, 1, 2, 3, 4, 5, 6, 7);
            } else { const int row = wq * (16 * NQ) + j * 16 + l15; fq[j] = *(const bf16x8*)(cur + GT_P + row * 128 + (((ks * 4 + lk) ^ (row & 7)) << 4)); }
        }
#pragma unroll
        for (int i = 0; i < 4; ++i)
#pragma unroll
            for (int j = 0; j < NQ; ++j) acc[i][j] = MFMA16(fp[i], fq[j], acc[i][j]);
    }
}
template<int NQ>
DI void gemm_kstep8(f32x4 (&acc)[4][NQ], const unsigned char* cur, int wp, int wq, int l15, int lk) {
    __builtin_amdgcn_sched_barrier(0);
    i32x8 fp[4];
#pragma unroll
    for (int i = 0; i < 4; ++i) {
        const int row = wp * 64 + i * 16 + l15;
        const u32x4 a = *(const u32x4*)(cur + row * 128 + ((lk ^ (row & 7)) << 4)), b = *(const u32x4*)(cur + row * 128 + (((4 + lk) ^ (row & 7)) << 4));
        fp[i] = i32x8{(int)a[0], (int)a[1], (int)a[2], (int)a[3], (int)b[0], (int)b[1], (int)b[2], (int)b[3]};
    }
    u32x4 qa, qb;
    { const int row = wq * (16 * NQ) + l15; qa = *(const u32x4*)(cur + GT_P + row * 128 + ((lk ^ (row & 7)) << 4)); qb = *(const u32x4*)(cur + GT_P + row * 128 + (((4 + lk) ^ (row & 7)) << 4)); }
#pragma unroll
    for (int j = 0; j < NQ; ++j) {
        const i32x8 fq = i32x8{(int)qa[0], (int)qa[1], (int)qa[2], (int)qa[3], (int)qb[0], (int)qb[1], (int)qb[2], (int)qb[3]};
        if (j + 1 < NQ) { const int row = wq * (16 * NQ) + (j + 1) * 16 + l15; qa = *(const u32x4*)(cur + GT_P + row * 128 + ((lk ^ (row & 7)) << 4)); qb = *(const u32x4*)(cur + GT_P + row * 128 + (((4 + lk) ^ (row & 7)) << 4)); }
#pragma unroll
        for (int i = 0; i < 4; ++i) acc[i][j] = __builtin_amdgcn_mfma_scale_f32_16x16x128_f8f6f4(fp[i], fq, acc[i][j], 0, 0, 0, 0x7F7F7F7F, 0, 0x7F7F7F7F);
        __builtin_amdgcn_sched_barrier(0);
    }
}
template<int NQ, class LQ = RowLoader, class NLQ = RowLoader, bool F8 = false>
DI void gemm_mainloop(f32x4 (&acc)[4][NQ], const RowLoader& lp, const LQ& lq, int nk, unsigned char* lds, bool preissued = false, bool pfnext = false,
                      const RowLoader& nlp = RowLoader{nullptr, 0}, const NLQ& nlq = NLQ{nullptr, 0}) {
    const int tid = get_tid(), lane = tid & 63, wave = __builtin_amdgcn_readfirstlane(tid >> 6), wp = wave >> 2, wq = wave & 3;
    constexpr int QROWS = NQ * 64;
    constexpr int STAGE = GT_P + QROWS * 128;
    if (!preissued) {
        __syncthreads();
        lp.template issue<256>(lds, 0, lane, wave); lq.template issue<QROWS>(lds + GT_P, 0, lane, wave);
    }
    asm volatile("s_waitcnt vmcnt(0)" ::: "memory");
    __syncthreads();
    const int l15 = lane & 15, lk = lane >> 4;
    for (int kt = 0; kt < nk; ++kt) {
        unsigned char* cur = lds + (kt & 1) * STAGE;
        unsigned char* nxt = lds + ((kt + 1) & 1) * STAGE;
        const bool last = kt + 1 == nk;
        if (!last) { lp.template issue<256>(nxt, kt + 1, lane, wave); lq.template issue<QROWS>(nxt + GT_P, kt + 1, lane, wave); }
        else if (pfnext) { nlp.template issue<256>(nxt, 0, lane, wave); nlq.template issue<QROWS>(nxt + GT_P, 0, lane, wave); }
        if constexpr (F8) gemm_kstep8<NQ>(acc, cur, wp, wq, l15, lk); else gemm_kstep<NQ, LQ::kmajor>(acc, cur, wp, wq, l15, lk);
        if (last && pfnext) { asm volatile("s_waitcnt lgkmcnt(0)" ::: "memory"); __builtin_amdgcn_s_barrier(); }
        else { asm volatile("s_waitcnt vmcnt(0)" ::: "memory"); __syncthreads(); }
    }
}
template<int NQ>
DI void gemm_shadow(const RowLoader& lp, const RowLoader& lq, int nk, unsigned char* lds) {
    f32x4 acc[4][NQ];
#pragma unroll
    for (int i = 0; i < 4; ++i)
#pragma unroll
        for (int j = 0; j < NQ; ++j) acc[i][j] = f32x4{0.f, 0.f, 0.f, 0.f};
    if (SHADOW == 1) gemm_mainloop<NQ>(acc, lp, lq, nk, lds);
    else {
        const int tid = get_tid(), lane = tid & 63, wave = __builtin_amdgcn_readfirstlane(tid >> 6), wp = wave >> 2, wq = wave & 3;
        constexpr int QROWS = NQ * 64;
        constexpr int STAGE = GT_P + QROWS * 128;
        const int l15 = lane & 15, lk = lane >> 4;
        bf16x8 fp[4], fq[NQ];
        if (SHADOW == 3) {
#pragma unroll
            for (int i = 0; i < 4; ++i) fp[i] = *(const bf16x8*)(lds + (wp * 64 + i * 16 + l15) * 128 + lk * 16);
#pragma unroll
            for (int j = 0; j < NQ; ++j) fq[j] = *(const bf16x8*)(lds + GT_P + (wq * 16 * NQ + j * 16 + l15) * 128 + lk * 16);
        }
        for (int kt = 0; kt < nk; ++kt) {
            unsigned char* cur = lds + (kt & 1) * STAGE;
#pragma unroll
            for (int ks = 0; ks < 2; ++ks) {
                if (SHADOW == 2 || SHADOW == 4) {
#pragma unroll
                    for (int i = 0; i < 4; ++i) { const int row = wp * 64 + i * 16 + l15; fp[i] = *(const bf16x8*)(cur + row * 128 + (((ks * 4 + lk) ^ (row & 7)) << 4)); }
#pragma unroll
                    for (int j = 0; j < NQ; ++j) { const int row = wq * (16 * NQ) + j * 16 + l15; fq[j] = *(const bf16x8*)(cur + GT_P + row * 128 + (((ks * 4 + lk) ^ (row & 7)) << 4)); }
                }
#pragma unroll
                for (int i = 0; i < 4; ++i)
#pragma unroll
                    for (int j = 0; j < NQ; ++j) acc[i][j] = MFMA16(fp[i], fq[j], acc[i][j]);
            }
            if (SHADOW == 2) asm volatile("" ::: "memory");
            if (SHADOW == 4) __syncthreads();
        }
    }
#pragma unroll
    for (int i = 0; i < 4; ++i)
#pragma unroll
        for (int j = 0; j < NQ; ++j) asm volatile("" :: "v"(acc[i][j]));
}

template<int NQ> DI void gemm_shadow1(const RowLoader& lp, const RowLoader& lq, int nk, unsigned char* lds) {
    f32x4 acc[4][NQ];
#pragma unroll
    for (int i = 0; i < 4; ++i)
#pragma unroll
        for (int j = 0; j < NQ; ++j) acc[i][j] = f32x4{0.f, 0.f, 0.f, 0.f};
    gemm_mainloop<NQ>(acc, lp, lq, nk, lds);
#pragma unroll
    for (int i = 0; i < 4; ++i)
#pragma unroll
        for (int j = 0; j < NQ; ++j) asm volatile("" :: "v"(acc[i][j]));
}
DI void head_epilogue(f32x4 (&acc)[4][4], const float* __restrict__ g, float gscale, const float* __restrict__ rope, bool do_rope, int t_base  , unsigned char* __restrict__ dst  , int lane) {
    const int l15 = lane & 15, lk = lane >> 4;
    float gg[4];
#pragma unroll
    for (int j = 0; j < 4; ++j) gg[j] = g[j * 16 + l15] * gscale;
#pragma unroll
    for (int i = 0; i < 4; ++i) {
#pragma unroll
        for (int r = 0; r < 4; ++r) {
            float ss = 0.f;
#pragma unroll
            for (int j = 0; j < 4; ++j) ss += acc[i][j][r] * acc[i][j][r];
            ss = sum16(ss);
            const float rs = rsqrtf(ss * (1.f / 64.f) + EPS);
            float v[4];
#pragma unroll
            for (int j = 0; j < 4; ++j) v[j] = acc[i][j][r] * rs * gg[j];
            const int t = t_base + i * 16 + lk * 4 + r;
            if (do_rope) {
                const int prow = (t >> 6) & 63, pcol = t & 63;
                const float c0 = rope[prow * 16 + l15], s0 = rope[1024 + prow * 16 + l15];
                const float c1 = rope[pcol * 16 + l15], s1 = rope[1024 + pcol * 16 + l15];
                const float a0 = v[0] * c0 - v[1] * s0, a1 = v[1] * c0 + v[0] * s0;
                const float a2 = v[2] * c1 - v[3] * s1, a3 = v[3] * c1 + v[2] * s1;
                v[0] = a0; v[1] = a1; v[2] = a2; v[3] = a3;
            }
            unsigned char* d = dst + (size_t)(i * 16 + lk * 4 + r) * 64 + l15;
            const int w01 = __builtin_amdgcn_cvt_pk_fp8_f32(v[0], v[1], 0, false), w23 = __builtin_amdgcn_cvt_pk_fp8_f32(v[2], v[3], 0, false);
            d[0] = (unsigned char)w01; d[16] = (unsigned char)(w01 >> 8); d[32] = (unsigned char)w23; d[48] = (unsigned char)(w23 >> 8);
        }
    }
}
DI void tstore_epilogue(f32x4 (&acc)[4][4], bf16_t* __restrict__ dst  , size_t ld, int lane) {
    const int l15 = lane & 15, lk = lane >> 4;
#pragma unroll
    for (int i = 0; i < 4; ++i)
#pragma unroll
        for (int j = 0; j < 4; ++j)
            *(u32x2*)(dst + (size_t)(j * 16 + l15) * ld + i * 16 + lk * 4) = u32x2{pk2(acc[i][j][0], acc[i][j][1]), pk2(acc[i][j][2], acc[i][j][3])};
}

DI void phase_c(const Params& p, unsigned char* lds) {
    constexpr int NTM = BT / 256, NTN = INC / 256;
    constexpr int MAIN = NTM * NTN, TOTAL = MAIN + 8;
    const bf16_t* H = (const bf16_t*)(p.ws + WS_H);
    const bf16_t* HCp = (const bf16_t*)(p.ws + WS_HC);
    const bf16_t* WT = (const bf16_t*)(p.ws + WS_WTIN);
    const float* rope = (const float*)(p.ws + WS_ROPE);
    struct CTile { int tm, tn; bool ctx; RowLoader P, Q; };
    auto c_tile = [&](int it) {
        CTile t; t.ctx = false;
        if (it < MAIN) { const int g = it / (16 * NTN), rem = it % (16 * NTN); t.tn = rem >> 4; t.tm = g * 16 + (rem & 15); }
        else { t.ctx = true; t.tm = it - MAIN; t.tn = 2; }
        const bf16_t* A = t.ctx ? HCp + (size_t)t.tm * 256 * DM : H + (size_t)t.tm * 256 * DM;
        const bf16_t* W = WT + (size_t)t.tn * 256 * DM;
        if (t.tn >= 9) {
            t.P = RowLoader{(const bf16_t*)(p.ws + WS_W8G + (size_t)(t.tn * 256 - 2304) * DM), DM / 2}; t.Q = RowLoader{(const bf16_t*)(p.ws + WS_H8 + (size_t)t.tm * 256 * DM), DM / 2}; }
        else { t.P = RowLoader{A, DM}; t.Q = RowLoader{W, DM}; }
        return t;
    };
    bool pre = false;
    CTile cur = c_tile(blockIdx.x);
    for (int it = blockIdx.x; it < TOTAL; it += gridDim.x) {
        const int tid = get_tid(), lane = tid & 63, wave = tid >> 6, wa = wave >> 2, wb = wave & 3;
        const bool has2 = it + (int)gridDim.x < TOTAL;
        const CTile nx = c_tile(has2 ? it + (int)gridDim.x : it);
        const int tm = cur.tm, tn = cur.tn; const bool ctx = cur.ctx;
        f32x4 acc[4][4];
#pragma unroll
        for (int i = 0; i < 4; ++i)
#pragma unroll
            for (int j = 0; j < 4; ++j) acc[i][j] = f32x4{0.f, 0.f, 0.f, 0.f};
        int nk8 = DM / 128; asm volatile("" : "+s"(nk8));
        if (cur.tn >= 9) gemm_mainloop<4, RowLoader, RowLoader, true>(acc, cur.P, cur.Q, nk8, lds, pre, has2, nx.P, nx.Q);
        else gemm_mainloop<4>(acc, cur.P, cur.Q, DM / 64, lds, pre, has2, nx.P, nx.Q);
        pre = has2; cur = nx;
        if (tn >= 9) {
            unsigned char* st = lds + 64 * 1024;
            constexpr int GS = 272;
            const int l15 = lane & 15, lk = lane >> 4;
#pragma unroll
            for (int i = 0; i < 4; ++i)
#pragma unroll
                for (int j = 0; j < 4; ++j) {
                    unsigned q[4];
#pragma unroll
                    for (int r = 0; r < 4; ++r) q[r] = (unsigned)(255.f * __builtin_amdgcn_rcpf(1.f + __expf(acc[i][j][r] * (-1.f / W8_SCALE))) + 0.5f);
                    *(unsigned*)(st + (wb * 64 + j * 16 + l15) * GS + wa * 64 + i * 16 + lk * 4) = q[0] | (q[1] << 8) | (q[2] << 16) | (q[3] << 24);
                }
            __syncthreads();
            unsigned char* G8 = p.ws + WS_G + (size_t)tm * 256 * GC + (tn * 256 - 2304);
            const int t2 = get_tid();
#pragma unroll
            for (int q = 0; q < 4; ++q) {
                const int idx = t2 + q * NT, row = idx >> 4, ch = idx & 15;
                *(u32x4*)(G8 + (size_t)row * GC + ch * 16) = *(const u32x4*)(st + row * GS + ch * 16);
            }
            continue;
        }
        const int b = ctx ? tm : (tm >> 4);
        const int tpos = ctx ? SEQ + wa * 64 : ((tm & 15) * 256 + wa * 64);
        if (tn < 2) {
            const int h = tn * 4 + wb;
            unsigned char* Q = p.ws + WS_Q + ((size_t)(b * NH + h) * SEQ + tpos) * HD;
            head_epilogue(acc, p.in[I_QNG], 1.4426950408889634f, rope, true, tpos, Q, lane);
        } else if (tn == 2) {
            if (wb < 2) {
                unsigned char* K = p.ws + WS_KB + ((size_t)(b * NKV + wb) * TK + tpos) * HD;
                head_epilogue(acc, p.in[I_KNG], 1.f, rope, !ctx, tpos, K, lane);
            } else {
                unsigned char* V8 = p.ws + WS_VT + (size_t)(b * NKV + (wb - 2)) * HD * TK;
                const int l15 = lane & 15, lk = lane >> 4;
#pragma unroll
                for (int i = 0; i < 4; ++i) {
                    const int k = tpos + i * 16 + lk * 4, kin = k & 63, within = kin & 31;
                    const int pos = (k & ~63) + 32 * ((within >> 2) & 1) + 16 * (kin >> 5) + 4 * (within >> 3);
#pragma unroll
                    for (int j = 0; j < 4; ++j)
                        *(unsigned*)(V8 + (size_t)(j * 16 + l15) * TK + pos) = pk_fp8x4(acc[i][j][0] * VT_SCALE, acc[i][j][1] * VT_SCALE, acc[i][j][2] * VT_SCALE, acc[i][j][3] * VT_SCALE);
                }
            }
        } else {
            const int col = tn * 256 - 768 + wb * 64;
            bf16_t* Z = (bf16_t*)(p.ws + WS_ZT) + (size_t)col * BT + (size_t)b * SEQ + tpos;
            tstore_epilogue(acc, Z, BT, lane);
        }
    }
}

#define MFMA32(a, b, c) __builtin_amdgcn_mfma_f32_32x32x16_bf16((a), (b), (c), 0, 0, 0)
DI bf16x8 pack_step(const f32x16& x, int s) {
    u32x4 pk;
    asm volatile("v_cvt_pk_bf16_f32 %0, %4, %5\n\tv_cvt_pk_bf16_f32 %1, %6, %7\n\tv_cvt_pk_bf16_f32 %2, %8, %9\n\tv_cvt_pk_bf16_f32 %3, %10, %11\n\ts_nop 1"
                 : "=&v"(pk[0]), "=&v"(pk[1]), "=&v"(pk[2]), "=&v"(pk[3])
                 : "v"(x[8 * s]), "v"(x[8 * s + 1]), "v"(x[8 * s + 2]), "v"(x[8 * s + 3]), "v"(x[8 * s + 4]), "v"(x[8 * s + 5]), "v"(x[8 * s + 6]), "v"(x[8 * s + 7]));
    return __builtin_bit_cast(bf16x8, pk);
}

constexpr int AT_KSTR = 64, AT_VSTR = 64, AT_VOFF = 64 * AT_KSTR, AT_STAGE = AT_VOFF + 64 * AT_VSTR;
DI void attn_item(const Params& p, int item, unsigned char* lds) {
    const int tid = get_tid(), lane = tid & 63, wave = tid >> 6;
    const int b = item >> 6, kvh = (item >> 5) & 1, qb = item & 31;
    const int h = kvh * 4 + (wave >> 2), q0 = qb * 128 + (wave & 3) * 32;
    const int qi = lane & 31, hf = lane >> 5;
    const unsigned char* Qp = p.ws + WS_Q + ((size_t)(b * NH + h) * SEQ + q0 + qi) * HD + 32 * hf;
    const u32x4 q0v = *(const u32x4*)Qp, q1v = *(const u32x4*)(Qp + 16);
    const i32x8 qf = i32x8{(int)q0v[0], (int)q0v[1], (int)q0v[2], (int)q0v[3], (int)q1v[0], (int)q1v[1], (int)q1v[2], (int)q1v[3]};
    const unsigned char* Kg = p.ws + WS_KB + (size_t)(b * NKV + kvh) * TK * HD;
    const unsigned char* Vg = p.ws + WS_VT + (size_t)(b * NKV + kvh) * HD * TK;
    constexpr int NTILE = TK / 64;
    f32x16 o0, o1, o2;
#pragma unroll
    for (int i = 0; i < 16; ++i) { o0[i] = 0.f; o1[i] = 0.f; o2[i] = 0.f; }
    __syncthreads();
    constexpr int NSUB = 4, NSTG = NTILE / NSUB;
    static_assert(NTILE % NSUB == 0 && 2 * NSUB * AT_STAGE <= LDS_USER, "attention LDS stages");
    const int wv = __builtin_amdgcn_readfirstlane(tid >> 6);
    auto stage_issue = [&](int stg_idx, int buf) {
#pragma unroll
        for (int e = 0; e < 2; ++e) {
            const int q = 2 * wv + e, j = q >> 3, isV = (q >> 2) & 1, part = q & 3;
            const int row = 16 * part + (lane >> 2), c = (lane & 3) ^ ((row >> 2) & 3), tile = stg_idx * NSUB + j;
            const unsigned char* sp = isV ? Vg + (size_t)row * TK + (size_t)tile * 64 + c * 16 : Kg + ((size_t)tile * 64 + row) * HD + c * 16;
            __builtin_amdgcn_global_load_lds((const unsigned*)sp, (unsigned*)(lds + (buf * NSUB + j) * AT_STAGE + isV * AT_VOFF + part * 1024), 16, 0, 0);
        }
    };
    stage_issue(0, 0);
    asm volatile("s_waitcnt vmcnt(0)" ::: "memory");
    __syncthreads();
    const int sw = (qi >> 2) & 3;
    const int kc0 = qi * AT_KSTR + (((2 * hf) ^ sw) << 4), kc1 = qi * AT_KSTR + (((2 * hf + 1) ^ sw) << 4);
    for (int st = 0; st < NSTG; ++st) {
      const bool more = st + 1 < NSTG;
      if (more) stage_issue(st + 1, (st + 1) & 1);
#pragma unroll 1
      for (int j = 0; j < NSUB; ++j) {
        const unsigned char* cur = lds + ((st & 1) * NSUB + j) * AT_STAGE;
        f32x16 sA, sB;
        {
            f32x16 z;
#pragma unroll
            for (int i = 0; i < 16; ++i) z[i] = 0.f;
            const u32x4 ka0 = *(const u32x4*)(cur + kc0), ka1 = *(const u32x4*)(cur + kc1);
            const u32x4 kb0 = *(const u32x4*)(cur + kc0 + 32 * AT_KSTR), kb1 = *(const u32x4*)(cur + kc1 + 32 * AT_KSTR);
            const i32x8 kfa = i32x8{(int)ka0[0], (int)ka0[1], (int)ka0[2], (int)ka0[3], (int)ka1[0], (int)ka1[1], (int)ka1[2], (int)ka1[3]};
            const i32x8 kfb = i32x8{(int)kb0[0], (int)kb0[1], (int)kb0[2], (int)kb0[3], (int)kb1[0], (int)kb1[1], (int)kb1[2], (int)kb1[3]};
            __builtin_amdgcn_s_setprio(1);
            sA = __builtin_amdgcn_mfma_scale_f32_32x32x64_f8f6f4(kfa, qf, z, 0, 0, 0, 0x7F7F7F7F, 0, 0x7C7C7C7C);
            sB = __builtin_amdgcn_mfma_scale_f32_32x32x64_f8f6f4(kfb, qf, z, 0, 0, 0, 0x7F7F7F7F, 0, 0x7C7C7C7C);
            __builtin_amdgcn_s_setprio(0);
        }
#pragma unroll
        for (int i = 0; i < 16; ++i) sA[i] = __builtin_amdgcn_exp2f(sA[i]);
#pragma unroll
        for (int i = 0; i < 16; ++i) sB[i] = __builtin_amdgcn_exp2f(sB[i]);
        int pb[8];
#pragma unroll
        for (int v = 0; v < 8; ++v) {
            const f32x16& sx = (v >> 2) ? sB : sA;
            const int r0 = 4 * (v & 3);
            int w = __builtin_amdgcn_cvt_pk_bf8_f32(sx[r0], sx[r0 + 1], 0, false);
            w = __builtin_amdgcn_cvt_pk_bf8_f32(sx[r0 + 2], sx[r0 + 3], w, true);
            pb[v] = w;
        }
        const i32x8 pf = i32x8{pb[0], pb[1], pb[2], pb[3], pb[4], pb[5], pb[6], pb[7]};
#pragma unroll
        for (int db = 0; db < 2; ++db) {
            const unsigned char* vb = cur + AT_VOFF + db * 32 * AT_VSTR;
            const u32x4 a0 = *(const u32x4*)(vb + kc0), a1 = *(const u32x4*)(vb + kc1);
            const i32x8 vf = i32x8{(int)a0[0], (int)a0[1], (int)a0[2], (int)a0[3], (int)a1[0], (int)a1[1], (int)a1[2], (int)a1[3]};
            if (db == 0) o0 = __builtin_amdgcn_mfma_scale_f32_32x32x64_f8f6f4(vf, pf, o0, 0, 1, 0, 0x7F7F7F7F, 0, 0x7F7F7F7F);
            else         o1 = __builtin_amdgcn_mfma_scale_f32_32x32x64_f8f6f4(vf, pf, o1, 0, 1, 0, 0x7F7F7F7F, 0, 0x7F7F7F7F);
        }
        {
            const int one4 = 0x38383838;
            const i32x8 ones = i32x8{one4, one4, one4, one4, one4, one4, one4, one4};
            o2 = __builtin_amdgcn_mfma_scale_f32_32x32x64_f8f6f4(ones, pf, o2, 0, 1, 0, 0x7F7F7F7F, 0, 0x7F7F7F7F);
        }
      }
      asm volatile("s_waitcnt vmcnt(0)" ::: "memory");
      __syncthreads();
    }
    const float inv = (1.f / VT_SCALE) / o2[0];
    bf16_t* O;
    {
        const int t2 = get_tid(), lane2 = t2 & 63, wave2 = t2 >> 6;
        const int h2 = kvh * 4 + (wave2 >> 2), q2 = qb * 128 + (wave2 & 3) * 32 + (lane2 & 31);
        O = (bf16_t*)(p.ws + WS_ATT) + ((size_t)b * SEQ + q2) * QD + h2 * HD + 4 * (lane2 >> 5);
    }
#pragma unroll
    for (int g4 = 0; g4 < 4; ++g4) {
        *(u32x2*)(O + 8 * g4)      = u32x2{pk2(o0[4 * g4] * inv, o0[4 * g4 + 1] * inv), pk2(o0[4 * g4 + 2] * inv, o0[4 * g4 + 3] * inv)};
        *(u32x2*)(O + 32 + 8 * g4) = u32x2{pk2(o1[4 * g4] * inv, o1[4 * g4 + 1] * inv), pk2(o1[4 * g4 + 2] * inv, o1[4 * g4 + 3] * inv)};
    }
}

constexpr int HY_USTR = 8208, HY_R = 8 * HY_USTR, HY_RSTR = 16384 + 64;
DI void hy_load_filter(const bf16_t* __restrict__ R, unsigned char* lds, int tid) {
    const int i0 = tid * 8;
    const u32x4 w = *(const u32x4*)(R + i0);
    u32x2 nx = u32x2{0u, 0u};
    if (i0 + 8 < 8192) nx = *(const u32x2*)(R + i0 + 8);
    unsigned char* d = lds + HY_R + i0 * 2;
    *(u32x4*)(d) = w;
    *(u32x4*)(d + HY_RSTR) = u32x4{__builtin_amdgcn_alignbit(w[1], w[0], 16), __builtin_amdgcn_alignbit(w[2], w[1], 16), __builtin_amdgcn_alignbit(w[3], w[2], 16), __builtin_amdgcn_alignbit(nx[0], w[3], 16)};
    *(u32x4*)(d + 2 * HY_RSTR) = u32x4{w[1], w[2], w[3], nx[0]};
    *(u32x4*)(d + 3 * HY_RSTR) = u32x4{__builtin_amdgcn_alignbit(w[2], w[1], 16), __builtin_amdgcn_alignbit(w[3], w[2], 16), __builtin_amdgcn_alignbit(nx[0], w[3], 16), __builtin_amdgcn_alignbit(nx[1], nx[0], 16)};
}
DI void short_conv4(const bf16_t* __restrict__ zrow  , int t4, float w0, float w1, float w2, float bias, float (&out)[4]) {
    const u32x2 v = *(const u32x2*)(zrow + t4);
    const float z0 = bflo(v[0]), z1 = bfhi(v[0]), z2 = bflo(v[1]), z3 = bfhi(v[1]);
    const float zm = (t4 > 0) ? bf2f(zrow[t4 - 1]) : 0.f;
    const float zp = (t4 + 4 < SEQ) ? bf2f(zrow[t4 + 4]) : 0.f;
    out[0] = zm * w0 + z0 * w1 + z1 * w2 + bias;
    out[1] = z0 * w0 + z1 * w1 + z2 * w2 + bias;
    out[2] = z1 * w0 + z2 * w1 + z3 * w2 + bias;
    out[3] = z2 * w0 + z3 * w1 + zp * w2 + bias;
}
DI void hyena_item(const Params& p, int c, unsigned char* lds) {
    const int tid = get_tid(), lane = tid & 63, ig = tid >> 6;
    const bf16_t* ZT = (const bf16_t*)(p.ws + WS_ZT);
    const float* cw = p.in[I_HCW];
    const float* cb = p.in[I_HCB];
    __syncthreads();
    {
        const int b = tid >> 7, tb = (tid & 127) * 32;
        const bf16_t* zrow = ZT + (size_t)c * BT + (size_t)b * SEQ;
        const float w0 = cw[c], w1 = cw[HYC + c], w2 = cw[2 * HYC + c], bias = cb[c];
#pragma unroll
        for (int q = 0; q < 8; ++q) {
            float o[4];
            short_conv4(zrow, tb + 4 * q, w0, w1, w2, bias, o);
            *(u32x2*)(lds + b * HY_USTR + (tb + 4 * q) * 2) = u32x2{pk2(o[0], o[1]), pk2(o[2], o[3])};
        }
    }
    const int r = lane & 31, hf = lane >> 5, Il = r >> 3, bb = r & 7;
#pragma unroll 1
    for (int o = 0; o < 2; ++o) {
        hy_load_filter((const bf16_t*)(p.ws + WS_R) + (size_t)(o * 512 + c) * 8192, lds, tid);
        __syncthreads();
        f32x16 acc0, acc1;
#pragma unroll
        for (int i = 0; i < 16; ++i) { acc0[i] = 0.f; acc1[i] = 0.f; }
        const int sh = (-r) & 3;
        const unsigned char* abase = lds + HY_R + sh * HY_RSTR + (4096 + 8 * hf - r - sh) * 2 - 64;
        const unsigned char* ubase = lds + bb * HY_USTR + ((4 * ig + Il) * 64 + 8 * hf) * 2;
#define HY_STEP(MASKED) do { \
            const unsigned char* ap = abase - 128 * d; \
            const unsigned char* ub = ubase - 128 * d; \
            bool valid = true; \
            if (MASKED) { const int J = 4 * ig + Il - d; valid = (unsigned)J < 64u; if (!valid) ub = lds; } \
            _Pragma("unroll") for (int ks = 0; ks < 4; ++ks) { \
                u32x4 braw = *(const u32x4*)(ub + ks * 32); \
                if (MASKED) { if (!valid) braw = u32x4{0u, 0u, 0u, 0u}; } \
                const bf16x8 bf = __builtin_bit_cast(bf16x8, braw); \
                { const s16x4 lo = lds_rd64(ap + 32 * ks + 64), hi = lds_rd64(ap + 32 * ks + 72);     \
                  acc0 = MFMA32(__builtin_shufflevector(lo, hi, 0, 1, 2, 3, 4, 5, 6, 7), bf, acc0); } \
                { const s16x4 lo = lds_rd64(ap + 32 * ks), hi = lds_rd64(ap + 32 * ks + 8); \
                  acc1 = MFMA32(__builtin_shufflevector(lo, hi, 0, 1, 2, 3, 4, 5, 6, 7), bf, acc1); } \
            } } while (0)
        const int dlo = 4 * ig - 63, dhi = 4 * ig + 3;
#pragma unroll 1
        for (int d = dlo; d < dlo + 3; ++d) HY_STEP(true);
#pragma unroll 1
        for (int d = dlo + 3; d <= dhi - 3; ++d) HY_STEP(false);
        if (SHADOW == 6) {
            f32x16 s0 = acc0, s1 = acc1;
            const bf16x8 fa = *(const bf16x8*)(lds + lane * 16), fb = *(const bf16x8*)(lds + 4096 + lane * 16);
#pragma unroll 1
            for (int d = 0; d < 67; ++d) {
#pragma unroll
                for (int ks = 0; ks < 4; ++ks) { s0 = MFMA32(fa, fb, s0); s1 = MFMA32(fa, fb, s1); }
            }
            asm volatile("" :: "v"(s0), "v"(s1));
        }
        if (SHADOW == 7) {
            f32x16 k0 = acc0, k1 = acc1;
#pragma unroll 1
            for (int d = dlo + 3; d <= dhi - 3 + 6; ++d) {
                const unsigned char* ap = abase - 128 * (d > dhi - 3 ? dhi - 3 : d);
                const unsigned char* ub = ubase - 128 * (d > dhi - 3 ? dhi - 3 : d);
#pragma unroll
                for (int ks = 0; ks < 4; ++ks) {
                    const bf16x8 bf = *(const bf16x8*)(ub + ks * 32);
                    { const s16x4 lo = lds_rd64(ap + 32 * ks + 64), hi = lds_rd64(ap + 32 * ks + 72); k0 = MFMA32(__builtin_shufflevector(lo, hi, 0, 1, 2, 3, 4, 5, 6, 7), bf, k0); }
                    { const s16x4 lo = lds_rd64(ap + 32 * ks), hi = lds_rd64(ap + 32 * ks + 8); k1 = MFMA32(__builtin_shufflevector(lo, hi, 0, 1, 2, 3, 4, 5, 6, 7), bf, k1); }
                }
            }
            asm volatile("" :: "v"(k0), "v"(k1));
        }
#pragma unroll 1
        for (int d = dhi - 2; d <= dhi; ++d) HY_STEP(true);
#undef HY_STEP
        __syncthreads();
        const float skip = p.in[I_HSKIP][o * HYD + c];
        const int gcol = (o == 0 ? 512 : 1024) + c;
        const float w0 = cw[gcol], w1 = cw[HYC + gcol], w2 = cw[2 * HYC + gcol], bias = cb[gcol];
        const bf16_t* zrow = ZT + (size_t)gcol * BT + (size_t)bb * SEQ;
        bf16_t* hyt = (bf16_t*)(p.ws + WS_HYT) + (size_t)c * 128 + (size_t)bb * (SEQ / 128) * (512 * 128);
#pragma unroll
        for (int mm = 0; mm < 2; ++mm) {
#pragma unroll
            for (int g4 = 0; g4 < 4; ++g4) {
                const int t4 = (4 * ig + Il) * 64 + 32 * mm + 8 * g4 + 4 * hf;
                float gt[4];
                short_conv4(zrow, t4, w0, w1, w2, bias, gt);
                unsigned char* up = lds + bb * HY_USTR + t4 * 2;
                const u32x2 uv = *(const u32x2*)up;
                const float u0 = bflo(uv[0]), u1 = bfhi(uv[0]), u2 = bflo(uv[1]), u3 = bfhi(uv[1]);
                const f32x16& a = mm ? acc1 : acc0;
                const float y0 = gt[0] * (a[4 * g4] + skip * u0), y1 = gt[1] * (a[4 * g4 + 1] + skip * u1);
                const float y2 = gt[2] * (a[4 * g4 + 2] + skip * u2), y3 = gt[3] * (a[4 * g4 + 3] + skip * u3);
                const u32x2 pk = u32x2{pk2(y0, y1), pk2(y2, y3)};
                if (o == 0) *(u32x2*)up = pk; else *(u32x2*)(hyt + (size_t)(t4 >> 7) * (512 * 128) + (t4 & 127)) = pk;
            }
        }
        __syncthreads();
    }
}

constexpr int HY8_USTR = 4112, HY8_R = 8 * HY8_USTR, HY8_RSTR = 8192 + 32;
constexpr float HY8_US = 16.f;
DI void hy8_load_filter(const unsigned char* __restrict__ R, unsigned char* lds, int tid) {
    const int i0 = tid * 8;
    const unsigned long long lo = *(const unsigned long long*)(R + i0);
    unsigned long long hi = 0ull;
    if (i0 + 8 < 8192) hi = *(const unsigned long long*)(R + i0 + 8);
    unsigned char* d = lds + HY8_R + i0;
    *(unsigned long long*)d = lo;
#pragma unroll
    for (int sft = 1; sft < 8; ++sft) *(unsigned long long*)(d + sft * HY8_RSTR) = (lo >> (8 * sft)) | (hi << (64 - 8 * sft));
}
DI void hyena_item8(const Params& p, int c, unsigned char* lds) {
    const int tid = get_tid(), lane = tid & 63, ig = tid >> 6;
    const bf16_t* ZT = (const bf16_t*)(p.ws + WS_ZT);
    const float* cw = p.in[I_HCW];
    const float* cb = p.in[I_HCB];
    __syncthreads();
    {
        const int b = tid >> 7, tb = (tid & 127) * 32;
        const bf16_t* zrow = ZT + (size_t)c * BT + (size_t)b * SEQ;
        const float w0 = cw[c], w1 = cw[HYC + c], w2 = cw[2 * HYC + c], bias = cb[c];
        unsigned w8[8];
#pragma unroll
        for (int q = 0; q < 8; ++q) {
            float o[4];
            short_conv4(zrow, tb + 4 * q, w0, w1, w2, bias, o);
            w8[q] = pk_fp8x4(o[0] * HY8_US, o[1] * HY8_US, o[2] * HY8_US, o[3] * HY8_US);
        }
        *(u32x4*)(lds + b * HY8_USTR + tb) = u32x4{w8[0], w8[1], w8[2], w8[3]};
        *(u32x4*)(lds + b * HY8_USTR + tb + 16) = u32x4{w8[4], w8[5], w8[6], w8[7]};
    }
    const int r = lane & 31, hf = lane >> 5, Il = r >> 3, bb = r & 7;
#pragma unroll 1
    for (int o = 0; o < 2; ++o) {
        hy8_load_filter(p.ws + WS_R + (size_t)(o * 512 + c) * 8192, lds, tid);
        __syncthreads();
        f32x16 acc0, acc1;
#pragma unroll
        for (int i = 0; i < 16; ++i) { acc0[i] = 0.f; acc1[i] = 0.f; }
        const int sh = (-r) & 7;
        const unsigned char* abase = lds + HY8_R + sh * HY8_RSTR + (4096 + 32 * hf - r - sh) - 32;
        const unsigned char* ubase = lds + bb * HY8_USTR + (4 * ig + Il) * 64 + 32 * hf;
#define HY8_STEP(MASKED) do { \
            const unsigned char* ap = abase - 64 * d; \
            const unsigned char* ub = ubase - 64 * d; \
            bool valid = true; \
            if (MASKED) { const int J = 4 * ig + Il - d; valid = (unsigned)J < 64u; if (!valid) ub = lds; } \
            u32x4 b0 = *(const u32x4*)(ub), b1 = *(const u32x4*)(ub + 16); \
            if (MASKED) { if (!valid) { b0 = u32x4{0u, 0u, 0u, 0u}; b1 = b0; } } \
            const i32x8 bf = i32x8{(int)b0[0], (int)b0[1], (int)b0[2], (int)b0[3], (int)b1[0], (int)b1[1], (int)b1[2], (int)b1[3]}; \
            { const s16x4 q0 = lds_rd64(ap + 32), q1 = lds_rd64(ap + 40), q2 = lds_rd64(ap + 48), q3 = lds_rd64(ap + 56); \
              const u32x2 e0 = __builtin_bit_cast(u32x2, q0), e1 = __builtin_bit_cast(u32x2, q1), e2 = __builtin_bit_cast(u32x2, q2), e3 = __builtin_bit_cast(u32x2, q3); \
              acc0 = MFMA8((i32x8{(int)e0[0], (int)e0[1], (int)e1[0], (int)e1[1], (int)e2[0], (int)e2[1], (int)e3[0], (int)e3[1]}), bf, acc0); } \
            { const s16x4 q0 = lds_rd64(ap), q1 = lds_rd64(ap + 8), q2 = lds_rd64(ap + 16), q3 = lds_rd64(ap + 24); \
              const u32x2 e0 = __builtin_bit_cast(u32x2, q0), e1 = __builtin_bit_cast(u32x2, q1), e2 = __builtin_bit_cast(u32x2, q2), e3 = __builtin_bit_cast(u32x2, q3); \
              acc1 = MFMA8((i32x8{(int)e0[0], (int)e0[1], (int)e1[0], (int)e1[1], (int)e2[0], (int)e2[1], (int)e3[0], (int)e3[1]}), bf, acc1); } \
            } while (0)
        const int dlo = 4 * ig - 63, dhi = 4 * ig + 3;
#pragma unroll 1
        for (int d = dlo; d < dlo + 3; ++d) HY8_STEP(true);
#pragma unroll 1
        for (int d = dlo + 3; d <= dhi - 3; ++d) HY8_STEP(false);
#pragma unroll 1
        for (int d = dhi - 2; d <= dhi; ++d) HY8_STEP(true);
#undef HY8_STEP
        __syncthreads();
        const float skip = p.in[I_HSKIP][o * HYD + c];
        const float asc = ((const float*)(p.ws + WS_FSC))[o * 512 + c] * (1.f / HY8_US);
        const int gcol = (o == 0 ? 512 : 1024) + c;
        const float w0 = cw[gcol], w1 = cw[HYC + gcol], w2 = cw[2 * HYC + gcol], bias = cb[gcol];
        const bf16_t* zrow = ZT + (size_t)gcol * BT + (size_t)bb * SEQ;
        bf16_t* hyt = (bf16_t*)(p.ws + WS_HYT) + (size_t)c * 128 + (size_t)bb * (SEQ / 128) * (512 * 128);
#pragma unroll
        for (int mm = 0; mm < 2; ++mm) {
#pragma unroll
            for (int g4 = 0; g4 < 4; ++g4) {
                const int t4 = (4 * ig + Il) * 64 + 32 * mm + 8 * g4 + 4 * hf;
                float gt[4];
                short_conv4(zrow, t4, w0, w1, w2, bias, gt);
                unsigned* up = (unsigned*)(lds + bb * HY8_USTR + t4);
                const unsigned uv = *up;
                const f32x2 ul = __builtin_amdgcn_cvt_pk_f32_fp8((int)uv, false), uh = __builtin_amdgcn_cvt_pk_f32_fp8((int)uv, true);
                const float us = skip * (1.f / HY8_US);
                const f32x16& a = mm ? acc1 : acc0;
                const float y0 = gt[0] * (a[4 * g4] * asc + us * ul[0]), y1 = gt[1] * (a[4 * g4 + 1] * asc + us * ul[1]);
                const float y2 = gt[2] * (a[4 * g4 + 2] * asc + us * uh[0]), y3 = gt[3] * (a[4 * g4 + 3] * asc + us * uh[1]);
                if (o == 0) *up = pk_fp8x4(y0 * HY8_US, y1 * HY8_US, y2 * HY8_US, y3 * HY8_US);
                else *(u32x2*)(hyt + (size_t)(t4 >> 7) * (512 * 128) + (t4 & 127)) = u32x2{pk2(y0, y1), pk2(y2, y3)};
            }
        }
        __syncthreads();
    }
}

constexpr int CTL_QUEUE_D = 8192;
DI void phase_d(const Params& p, unsigned char* lds) {
    unsigned* ctr = (unsigned*)(p.ws + WS_CTL) + CTL_QUEUE_D;
    volatile LAS unsigned* slot = (volatile LAS unsigned*)(LAS unsigned char*)(lds + LDS_ST_OFF + 8);
    for (;;) {
        __syncthreads();
        if (get_tid() == 0) slot[0] = atomicAdd(ctr, 1u);
        __syncthreads();
        const int it = __builtin_amdgcn_readfirstlane((int)slot[0]);
        if (it >= 1024) break;
        if (it < 512) hyena_item8(p, it, lds); else attn_item(p, it - 512, lds);
    }
}

DI void phase_d2(const Params& p, unsigned char* lds) {
    constexpr int TILES = 8 * (BT / 256);
    const bf16_t* HYT = (const bf16_t*)(p.ws + WS_HYT);
    bf16_t* HY = (bf16_t*)(p.ws + WS_HY);
    for (int it = blockIdx.x; it < TILES; it += gridDim.x) {
        const int tid = get_tid();
        const int c0 = (it & 7) * 64, tok0 = (it >> 3) * 256;
        __syncthreads();
#pragma unroll
        for (int i = 0; i < 2; ++i) {
            const int idx = tid + i * NT, c = idx >> 5, tg = idx & 31;
            *(u32x4*)(lds + c * 528 + tg * 16) = *(const u32x4*)(HYT + (size_t)(c0 + c) * BT + tok0 + tg * 8);
        }
        __syncthreads();
#pragma unroll
        for (int i = 0; i < 2; ++i) {
            const int idx = tid + i * NT, tok = idx >> 3, cg = idx & 7;
            unsigned w[4];
#pragma unroll
            for (int e = 0; e < 4; ++e) {
                const unsigned lo = *(const unsigned short*)(lds + (cg * 8 + 2 * e) * 528 + tok * 2);
                const unsigned hi = *(const unsigned short*)(lds + (cg * 8 + 2 * e + 1) * 528 + tok * 2);
                w[e] = lo | (hi << 16);
            }
            *(u32x4*)(HY + (size_t)(tok0 + tok) * HYD + c0 + cg * 8) = u32x4{w[0], w[1], w[2], w[3]};
        }
    }
}

DI void phase_e(const Params& p, unsigned char* lds) {
    constexpr int TILES = 4 * (BT / 128);
    for (int it = blockIdx.x; it < TILES; it += gridDim.x) {
        const int tid = get_tid(), lane = tid & 63, wave = tid >> 6, wp = wave >> 2, wq = wave & 3;
        const int tn = it & 3, tm = it >> 2;
        const int n0 = tn * 256, tok0 = tm * 128;
        f32x4 acc1[4][2], acc2[4][2];
#pragma unroll
        for (int i = 0; i < 4; ++i)
#pragma unroll
            for (int j = 0; j < 2; ++j) { acc1[i][j] = f32x4{0.f, 0.f, 0.f, 0.f}; acc2[i][j] = f32x4{0.f, 0.f, 0.f, 0.f}; }
        {
            const RowLoader p1{(const bf16_t*)(p.ws + WS_WTAO) + (size_t)n0 * QD, QD}, q1{(const bf16_t*)(p.ws + WS_ATT) + (size_t)tok0 * QD, QD};
            const RowLoader p2{(const bf16_t*)(p.ws + WS_WTHO) + (size_t)n0 * HYD, HYD};
            const ColLoader q2{(const bf16_t*)(p.ws + WS_HYT) + (size_t)tm * (512 * 128), (size_t)128};
            gemm_mainloop<2, RowLoader, ColLoader>(acc1, p1, q1, QD / 64, lds, false, true, p2, q2);
            gemm_mainloop<2, ColLoader, RowLoader>(acc2, p2, q2, HYD / 64, lds, true, false);
        }
        const unsigned char* G8 = p.ws + WS_G;
        bf16_t* M = (bf16_t*)(p.ws + WS_H);
        constexpr int ES = 528, GS = 272, EG2 = 128 * GS;
        __syncthreads();
        {
            u32x4 ga[2], gh[2];
#pragma unroll
            for (int q = 0; q < 2; ++q) {
                const int idx = tid + q * NT, row = idx >> 4, ch = idx & 15;
                const unsigned char* gp = G8 + (size_t)(tok0 + row) * GC + n0 + ch * 16;
                ga[q] = *(const u32x4*)gp; gh[q] = *(const u32x4*)(gp + 1024);
            }
#pragma unroll
            for (int q = 0; q < 2; ++q) {
                const int idx = tid + q * NT, row = idx >> 4, ch = idx & 15;
                *(u32x4*)(lds + row * GS + ch * 16) = ga[q]; *(u32x4*)(lds + EG2 + row * GS + ch * 16) = gh[q];
            }
        }
        __syncthreads();
        const int l15 = lane & 15, lk = lane >> 4;
        u32x2 mo[4][2];
#pragma unroll
        for (int i = 0; i < 4; ++i)
#pragma unroll
            for (int j = 0; j < 2; ++j) {
                const int off = (wq * 32 + j * 16 + l15) * GS + wp * 64 + i * 16 + lk * 4;
                const unsigned ga = *(const unsigned*)(lds + off), gh = *(const unsigned*)(lds + EG2 + off);
                constexpr float K = 1.f / 255.f;
                const float m0 = K * ((float)(ga & 255u) * acc1[i][j][0] + (float)(gh & 255u) * acc2[i][j][0]);
                const float m1 = K * ((float)((ga >> 8) & 255u) * acc1[i][j][1] + (float)((gh >> 8) & 255u) * acc2[i][j][1]);
                const float m2 = K * ((float)((ga >> 16) & 255u) * acc1[i][j][2] + (float)((gh >> 16) & 255u) * acc2[i][j][2]);
                const float m3 = K * ((float)(ga >> 24) * acc1[i][j][3] + (float)(gh >> 24) * acc2[i][j][3]);
                mo[i][j] = u32x2{pk2(m0, m1), pk2(m2, m3)};
            }
        __syncthreads();
#pragma unroll
        for (int i = 0; i < 4; ++i)
#pragma unroll
            for (int j = 0; j < 2; ++j) *(u32x2*)(lds + (wq * 32 + j * 16 + l15) * ES + (wp * 64 + i * 16 + lk * 4) * 2) = mo[i][j];
        __syncthreads();
#pragma unroll
        for (int q = 0; q < 4; ++q) {
            const int idx = tid + q * NT, row = idx >> 5, ch = idx & 31;
            *(u32x4*)(M + (size_t)(tok0 + row) * DM + n0 + ch * 8) = *(const u32x4*)(lds + row * ES + ch * 16);
        }
    }
}

DI void phase_f(const Params& p, unsigned char* lds) {
    constexpr int TILES = 4 * (BT / 256);
    const float* mod = (const float*)(p.ws + WS_MOD);
    for (int it = blockIdx.x; it < TILES; it += gridDim.x) {
        const int tid = get_tid(), lane = tid & 63, wave = tid >> 6, wp = wave >> 2, wq = wave & 3;
        const int tn = it & 3, tm = it >> 2;
        const int n0 = tn * 256, tok0 = tm * 256, b = tok0 >> 12;
        f32x4 acc[4][4];
#pragma unroll
        for (int i = 0; i < 4; ++i)
#pragma unroll
            for (int j = 0; j < 4; ++j) acc[i][j] = f32x4{0.f, 0.f, 0.f, 0.f};
        gemm_mainloop<4>(acc, RowLoader{(const bf16_t*)(p.ws + WS_WTO) + (size_t)n0 * DM, DM}, RowLoader{(const bf16_t*)(p.ws + WS_H) + (size_t)tok0 * DM, DM}, DM / 64, lds);
        const int l15 = lane & 15, lk = lane >> 4;
        constexpr int ES = 528;
        float ss[4] = {0.f, 0.f, 0.f, 0.f};
#pragma unroll
        for (int i = 0; i < 4; ++i) {
            const int n = n0 + wp * 64 + i * 16 + lk * 4;
            const f32x4 g1 = *(const f32x4*)(mod + b * 6144 + 2048 + n);
            const f32x4 s2 = *(const f32x4*)(mod + b * 6144 + 4096 + n), gf = *(const f32x4*)(p.in[I_NFFN] + n);
            const f32x4 gm = f32x4{gf[0] * (1.f + s2[0]), gf[1] * (1.f + s2[1]), gf[2] * (1.f + s2[2]), gf[3] * (1.f + s2[3])};
#pragma unroll
            for (int j = 0; j < 4; ++j) {
                const int tl = wq * 64 + j * 16 + l15;
                const f32x4 xv = *(const f32x4*)(p.in[I_X] + (size_t)(tok0 + tl) * DM + n);
                const f32x4 x1 = f32x4{xv[0] + g1[0] * acc[i][j][0], xv[1] + g1[1] * acc[i][j][1], xv[2] + g1[2] * acc[i][j][2], xv[3] + g1[3] * acc[i][j][3]};
                *(u32x2*)((bf16_t*)(p.out + (size_t)(tok0 + tl) * DM) + n) = u32x2{pk2(x1[0], x1[1]), pk2(x1[2], x1[3])};
                ss[j] += x1[0] * x1[0] + x1[1] * x1[1] + x1[2] * x1[2] + x1[3] * x1[3];
                *(u32x2*)(lds + tl * ES + (wp * 64 + i * 16 + lk * 4) * 2) = u32x2{pk2(x1[0] * gm[0], x1[1] * gm[1]), pk2(x1[2] * gm[2], x1[3] * gm[3])};
            }
        }
#pragma unroll
        for (int j = 0; j < 4; ++j) {
            const float t = sum_x32(sum_x16(ss[j]));
            if (lk == 0) ((float*)(p.ws + WS_SSQ1))[(size_t)(tok0 + wq * 64 + j * 16 + l15) * 16 + tn * 4 + wp] = t;
        }
        __syncthreads();
        bf16_t* Y = (bf16_t*)(p.ws + WS_Y);
#pragma unroll
        for (int q = 0; q < 8; ++q) {
            const int idx = tid + q * NT, row = idx >> 5, ch = idx & 31;
            *(u32x4*)(Y + (size_t)(tok0 + row) * DM + n0 + ch * 8) = *(const u32x4*)(lds + row * ES + ch * 16);
        }
    }
}

DI void ins16(float (&L)[16], float v) {
#pragma unroll
    for (int i = 0; i < 16; ++i) { const float hi = fmaxf(L[i], v); v = fminf(L[i], v); L[i] = hi; }
}
DI void cex_desc(float& a, float& b) { const float hi = fmaxf(a, b), lo = fminf(a, b); a = hi; b = lo; }
DI void bitonic_merge16_desc(float (&v)[16]) {
#pragma unroll
    for (int j = 8; j > 0; j >>= 1)
#pragma unroll
        for (int i = 0; i < 16; ++i) if ((i ^ j) > i) cex_desc(v[i], v[i ^ j]);
}
DI void sort16_desc(float (&v)[16]) {
#pragma unroll
    for (int p = 1; p < 16; p <<= 1)
#pragma unroll
        for (int k = p; k >= 1; k >>= 1)
#pragma unroll
            for (int j = k % p; j <= 15 - k; j += 2 * k)
#pragma unroll
                for (int i = 0; i <= (k - 1 < 15 - j - k ? k - 1 : 15 - j - k); ++i)
                    if ((i + j) / (2 * p) == (i + j + k) / (2 * p)) cex_desc(v[i + j], v[i + j + k]);
}
DI void top16_merge(float (&a)[16], const float (&b)[16]) {
#pragma unroll
    for (int i = 0; i < 16; ++i) a[i] = fmaxf(a[i], b[15 - i]);
    bitonic_merge16_desc(a);
}
DI float pack_idx(float v, unsigned idx, unsigned mask) { return __uint_as_float((__float_as_uint(v) & ~mask) | idx); }
DI void peer_h2_item(const Params& p, int item) {
    const int tok0 = item * 128;
    const int tid = get_tid(), lane = tid & 63, wave = tid >> 6, b = tok0 >> 12;
    const float* sh2 = (const float*)(p.ws + WS_MOD) + b * 6144 + 3072 + lane * 16;
    float sh[16];
#pragma unroll
    for (int i = 0; i < 16; i += 4) { const f32x4 v = *(const f32x4*)(sh2 + i); sh[i] = v[0]; sh[i + 1] = v[1]; sh[i + 2] = v[2]; sh[i + 3] = v[3]; }
    u32x4 ny0, ny1; float nsq;
#define S0_LOAD(tk) do { const bf16_t* yr_ = (const bf16_t*)(p.ws + WS_Y) + (size_t)(tk) * DM + lane * 16; ny0 = *(const u32x4*)yr_; ny1 = *(const u32x4*)(yr_ + 8); \
        nsq = ((const float*)(p.ws + WS_SSQ1))[(size_t)(tk) * 16 + (lane & 15)]; } while (0)
    S0_LOAD(tok0 + wave * 8);
#pragma unroll 1
    for (int t = 0; t < 8; ++t) {
        const int tok = tok0 + wave * 8 + t;
        const u32x4 y0 = ny0, y1 = ny1;
        const float sq1 = nsq;
        if (t + 1 < 8) S0_LOAD(tok + 1);
        const float rs = rsqrtf(sum16(sq1) * (1.f / DM) + EPS);
        float f[16];
#pragma unroll
        for (int q = 0; q < 4; ++q) { f[2 * q] = bflo(y0[q]); f[2 * q + 1] = bfhi(y0[q]); f[8 + 2 * q] = bflo(y1[q]); f[9 + 2 * q] = bfhi(y1[q]); }
        float mx = 0.f;
#pragma unroll
        for (int i = 0; i < 16; ++i) { f[i] = rs * f[i] + sh[i]; mx = fmaxf(mx, fabsf(f[i])); }
        mx = fmaxf(wave_max(mx), 1e-30f);
        const float qs = X8_MAX / mx;
        int w8[4];
#pragma unroll
        for (int q = 0; q < 4; ++q) {
            w8[q] = __builtin_amdgcn_cvt_pk_fp8_f32(f[4 * q] * qs, f[4 * q + 1] * qs, 0, false);
            w8[q] = __builtin_amdgcn_cvt_pk_fp8_f32(f[4 * q + 2] * qs, f[4 * q + 3] * qs, w8[q], true);
        }
        *(u32x4*)(p.ws + WS_X8 + (size_t)tok * DM + lane * 16) = u32x4{(unsigned)w8[0], (unsigned)w8[1], (unsigned)w8[2], (unsigned)w8[3]};
        if (lane == 0) ((float*)(p.ws + WS_SX))[tok] = mx * (1.f / X8_MAX);
    }
#undef S0_LOAD
}
DI void peer_scores_top16(const bf16x8 (&bq)[8], const bf16_t* keysU  , int r, int hf, float (&L)[16]) {
    const unsigned ko = (unsigned)((8 * hf + r * 128) * 2);
    f32x16 acc[4];
#pragma unroll
    for (int m = 0; m < 4; ++m)
#pragma unroll
        for (int i = 0; i < 16; ++i) acc[m][i] = 0.f;
#pragma unroll
    for (int ks = 0; ks < 8; ++ks) {
#pragma unroll
        for (int m = 0; m < 4; ++m) {
            const bf16x8 ak = *(const bf16x8*)((const char*)keysU + (ko + (unsigned)(m * 8192)) + ks * 32);
            acc[m] = MFMA32(ak, bq[ks], acc[m]);
        }
    }
    float V[4][16];
#define PK_SORT(m) do { _Pragma("unroll") for (int i = 0; i < 16; ++i) V[m][i] = pack_idx(acc[m][i], (unsigned)((m) * 32 + (i & 3) + 8 * (i >> 2) + 4 * hf), 127u); sort16_desc(V[m]); } while (0)
    PK_SORT(0); PK_SORT(1); top16_merge(V[0], V[1]); __builtin_amdgcn_sched_barrier(0);
    PK_SORT(2); PK_SORT(3); top16_merge(V[2], V[3]); __builtin_amdgcn_sched_barrier(0);
    top16_merge(V[0], V[2]);
#undef PK_SORT
    const int hf3 = (get_tid() >> 5) & 1;
    float P[16];
#pragma unroll
    for (int i = 0; i < 16; ++i) {
        auto sw = __builtin_amdgcn_permlane32_swap(__float_as_uint(V[0][i]), __float_as_uint(V[0][i]), false, false);
        P[i] = hf3 ? __uint_as_float(sw[0]) : __uint_as_float(sw[1]);
    }
    top16_merge(V[0], P);
#pragma unroll
    for (int i = 0; i < 16; ++i) L[i] = V[0][i];
}
DI void peer_pick(const Params& p, const float* l1, const float* l2, int tokg, int h) {
    float v1[16], v2[16];
#pragma unroll
    for (int i = 0; i < 16; i += 4) {
        const f32x4 a = *(const f32x4*)(l1 + i), b = *(const f32x4*)(l2 + i);
        v1[i] = a[0]; v1[i + 1] = a[1]; v1[i + 2] = a[2]; v1[i + 3] = a[3];
        v2[i] = b[0]; v2[i + 1] = b[1]; v2[i + 2] = b[2]; v2[i + 3] = b[3];
    }
    float B[16];
#pragma unroll
    for (int i = 0; i < 16; ++i) B[i] = -3.0e38f;
#pragma unroll
    for (int i = 0; i < 16; ++i)
#pragma unroll
        for (int j = 0; j < 16; ++j)
            if ((i + 1) * (j + 1) <= 16) ins16(B, pack_idx(v1[i] + v2[j], (unsigned)(i * 16 + j), 255u));
    float e[16], sum = 0.f;
#pragma unroll
    for (int k = 0; k < 16; ++k) { e[k] = __expf(B[k] - B[0]); sum += e[k]; }
    const float inv = 1.f / sum;
    int* ex = (int*)(p.ws + WS_EXPI) + (size_t)tokg * 128 + h * 16;
    float* gt = (float*)(p.ws + WS_GATE) + ((size_t)tokg * 128 + h * 16) * 2;
    const float* usc = (const float*)(p.ws + WS_USC);
    int ev[16]; float gv[16], sv[16];
#pragma unroll
    for (int k = 0; k < 16; ++k) {
        const unsigned ij = __float_as_uint(B[k]) & 255u;
        const unsigned i1 = __float_as_uint(l1[ij >> 4]) & 127u, i2 = __float_as_uint(l2[ij & 15u]) & 127u;
        ev[k] = (int)(i1 * 128u + i2);
        gv[k] = e[k] * inv * ((const float*)(p.ws + WS_VSC))[ev[k]];
        sv[k] = usc[ev[k]];
    }
#pragma unroll
    for (int k = 0; k < 16; k += 4) *(u32x4*)(ex + k) = u32x4{(unsigned)ev[k], (unsigned)ev[k + 1], (unsigned)ev[k + 2], (unsigned)ev[k + 3]};
#pragma unroll
    for (int k = 0; k < 16; k += 2) *(f32x4*)(gt + 2 * k) = f32x4{gv[k], sv[k], gv[k + 1], sv[k + 1]};
}
DI void phase_h(const Params& p, unsigned char* lds) {
    for (int it = blockIdx.x; it < BT / 128; it += gridDim.x) peer_h2_item(p, it);
    constexpr int TILES = 8 * (BT / 256);
    constexpr int QS = 528;
    float* rsb = (float*)(lds + 136 * 1024);
    bool pre = false;
    for (int it = blockIdx.x; it < TILES; it += gridDim.x) {
        const int tid = get_tid(), lane = tid & 63, wave = tid >> 6, wp = wave >> 2, wq = wave & 3;
        const int tn = it & 7, tm = it >> 3;
        const int n0 = tn * 256, tok0 = tm * 256, b = tok0 >> 12;
        const int it2 = it + (int)gridDim.x; const bool has2 = it2 < TILES;
        const int n2 = (has2 ? it2 & 7 : tn) * 256, tk2 = (has2 ? it2 >> 3 : tm) * 256;
        __syncthreads();
        if (tid < 256) {
            const float* sq = (const float*)(p.ws + WS_SSQ1) + (size_t)(tok0 + tid) * 16;
            const f32x4 a = *(const f32x4*)sq, c = *(const f32x4*)(sq + 4), d = *(const f32x4*)(sq + 8), e = *(const f32x4*)(sq + 12);
            const float ssq = (a[0] + a[1] + a[2] + a[3]) + (c[0] + c[1] + c[2] + c[3]) + (d[0] + d[1] + d[2] + d[3]) + (e[0] + e[1] + e[2] + e[3]);
            rsb[tid] = rsqrtf(ssq * (1.f / DM) + EPS);
        }
        f32x4 acc[4][4];
#pragma unroll
        for (int i = 0; i < 4; ++i)
#pragma unroll
            for (int j = 0; j < 4; ++j) acc[i][j] = f32x4{0.f, 0.f, 0.f, 0.f};
        gemm_mainloop<4>(acc, RowLoader{(const bf16_t*)(p.ws + WS_WTQ) + (size_t)n0 * DM, DM}, RowLoader{(const bf16_t*)(p.ws + WS_Y) + (size_t)tok0 * DM, DM}, DM / 64, lds, pre);
        pre = has2;
        {
            const float* shq = (const float*)(p.ws + WS_SHQ) + b * 2048;
            const int l15 = lane & 15, lk = lane >> 4;
#pragma unroll
            for (int i = 0; i < 4; ++i) {
                const int nl = wp * 64 + i * 16 + lk * 4;
                const f32x4 sh = *(const f32x4*)(shq + n0 + nl);
#pragma unroll
                for (int j = 0; j < 4; ++j) {
                    const int tl = wq * 64 + j * 16 + l15;
                    const float rs = rsb[tl];
                    *(u32x2*)(lds + tl * QS + nl * 2) = u32x2{pk2(rs * acc[i][j][0] + sh[0], rs * acc[i][j][1] + sh[1]), pk2(rs * acc[i][j][2] + sh[2], rs * acc[i][j][3] + sh[3])};
                }
            }
        }
        __syncthreads();
        float L[16];
        {
            const int t1 = get_tid(), ln = t1 & 63, w1 = __builtin_amdgcn_readfirstlane(t1 >> 6), r = ln & 31, hf = ln >> 5, hpl = w1 & 1, tb = w1 >> 1;
            const int hp = 2 * tn + hpl;
            const bf16_t* keys = (const bf16_t*)(p.ws + WS_KEYS) + (size_t)((hp & 1) * 8 + (hp >> 1)) * 128 * 128;
            const unsigned char* qrow = lds + (tb * 32 + r) * QS + (hpl * 128 + 8 * hf) * 2;
            bf16x8 bq[8];
#pragma unroll
            for (int ks = 0; ks < 8; ++ks) bq[ks] = *(const bf16x8*)(qrow + 32 * ks);
            peer_scores_top16(bq, keys, r, hf, L);
        }
        __syncthreads();
        if (has2) gemm_prefetch<4>(RowLoader{(const bf16_t*)(p.ws + WS_WTQ) + (size_t)n2 * DM, DM}, RowLoader{(const bf16_t*)(p.ws + WS_Y) + (size_t)tk2 * DM, DM}, lds);
        float* lists = (float*)(lds + 96 * 1024);
        {
            const int t2 = get_tid(), ln = t2 & 63, w2 = __builtin_amdgcn_readfirstlane(t2 >> 6);
            if ((ln >> 5) == 0) {
                float* dst = lists + (((w2 >> 1) * 32 + (ln & 31)) * 2 + (w2 & 1)) * 16;
#pragma unroll
                for (int i = 0; i < 16; i += 4) *(f32x4*)(dst + i) = f32x4{L[i], L[i + 1], L[i + 2], L[i + 3]};
            }
        }
        __syncthreads();
        {
            const int t3 = get_tid();
            if (t3 < 256) peer_pick(p, lists + (t3 * 2) * 16, lists + (t3 * 2 + 1) * 16, tok0 + t3, tn);
        }
    }
}

DI float dot16_fp8(const u32x4& w, const float (&x)[16]) {
    float d = 0.f;
#pragma unroll
    for (int i = 0; i < 4; ++i) {
        const auto lo = __builtin_amdgcn_cvt_pk_f32_fp8((int)w[i], false);
        const auto hi = __builtin_amdgcn_cvt_pk_f32_fp8((int)w[i], true);
        d += lo[0] * x[4 * i] + lo[1] * x[4 * i + 1] + hi[0] * x[4 * i + 2] + hi[1] * x[4 * i + 3];
    }
    return d;
}
template<int NPART, class F> DI void run_partitioned(const Params& p, unsigned char* lds, int qbase, int nitems, F&& body) {
    unsigned* ctl = (unsigned*)(p.ws + WS_CTL);
    volatile LAS unsigned* slot = (volatile LAS unsigned*)(LAS unsigned char*)(lds + LDS_ST_OFF + 8);
    const int x0 = (int)(xb_xcc_id() & 7u);
#pragma unroll 1
    for (int pp = 0; pp < NPART; ++pp) {
        const int part = (NPART == 8) ? ((x0 + pp) & 7) : ((((x0 + (pp >> 1)) & 7)) + 8 * (pp & 1));
        for (;;) {
            __syncthreads();
            if (get_tid() == 0) slot[0] = atomicAdd(ctl + qbase + 64 * part, 1u);
            __syncthreads();
            const int it = __builtin_amdgcn_readfirstlane((int)slot[0]);
            if (it >= nitems) break;
            body(part, it);
        }
    }
}
constexpr int CTL_QUEUE_I2 = 8320, CTL_QUEUE_I3 = 9408;
constexpr int UW_BYTES = 8384, UW_H2S = 1040, UW_LIST = 4160, UW_LCAP = 2112;
DI int peer_u_list(unsigned* lst, const u32x4& ia, const u32x4& ib, int part, int) {
    const int lane = get_tid() & 63;
    int cnt = 0;
#pragma unroll
    for (int g = 0; g < 8; ++g) {
        const unsigned id = (g < 4) ? ia[g & 3] : ib[g & 3];
        const unsigned idx = (unsigned)((g < 4 ? 0 : 256) + lane * 4 + (g & 3));
        const bool m = (int)(id >> 11) == part;
        const unsigned long long bm = __ballot(m);
        const int pos = cnt + __builtin_amdgcn_mbcnt_hi((unsigned)(bm >> 32), __builtin_amdgcn_mbcnt_lo((unsigned)bm, 0u));
        if (m) lst[pos] = (idx << 16) | id;
        cnt += __popcll(bm);
    }
    const unsigned last = lst[max(cnt - 1, 0)];
    if (lane < 16) lst[cnt + lane] = last;
    return cnt;
}
DI void peer_u_chunk(const Params& p, int part, int chunk, unsigned char* lds) {
    const int tid = get_tid(), lane = tid & 63, wave = __builtin_amdgcn_readfirstlane(tid >> 6);
    unsigned char* wl = lds + wave * UW_BYTES;
    const int n = lane & 15, kg = lane >> 4;
    const int ln4 = lane >> 2;
    const unsigned char* UT4 = p.ws + WS_UT + (lane & 3) * 16;
    const int bpi = 16 * n + 4 * kg;
    const unsigned char* arow = wl + (n & 3) * UW_H2S + kg * 16;
    const int tokw = chunk * 256 + wave * 4;
    u32x4 pia, pib, ph[4]; f32x4 psx;
#define U_LOAD_IDS(tok) do { const u32x4* ex_ = (const u32x4*)((const int*)(p.ws + WS_EXPI) + (size_t)(tok) * 128) + lane; pia = ex_[0]; pib = ex_[64]; } while (0)
#define U_LOAD_H2(tok) do { const unsigned char* hr_ = p.ws + WS_X8 + (size_t)(tok) * DM + lane * 16; \
        ph[0] = *(const u32x4*)hr_; ph[1] = *(const u32x4*)(hr_ + DM); ph[2] = *(const u32x4*)(hr_ + 2 * DM); ph[3] = *(const u32x4*)(hr_ + 3 * DM); \
        psx = *(const f32x4*)((const float*)(p.ws + WS_SX) + (tok)); } while (0)
#define U_BPERM(dst, src) do { dst[0] = (unsigned)__builtin_amdgcn_ds_bpermute(bpi, (int)src[0]); dst[1] = (unsigned)__builtin_amdgcn_ds_bpermute(bpi, (int)src[1]); \
        dst[2] = (unsigned)__builtin_amdgcn_ds_bpermute(bpi, (int)src[2]); dst[3] = (unsigned)__builtin_amdgcn_ds_bpermute(bpi, (int)src[3]); } while (0)
    U_LOAD_IDS(tokw); U_LOAD_H2(tokw);
    int cntc = peer_u_list((unsigned*)(wl + UW_LIST), pia, pib, part, lane);
    U_LOAD_IDS(tokw + 64);
    int have = -1;
    u32x4 brow[8];
#pragma unroll 1
    for (int s = 0; s < 4; ++s) {
        const int tok0 = tokw + s * 64;
#pragma unroll
        for (int r = 0; r < 4; ++r) *(u32x4*)(wl + r * UW_H2S + lane * 16) = ph[r];
        const f32x4 sx = psx;
        const unsigned* lc = (const unsigned*)(wl + UW_LIST + (s & 1) * UW_LCAP);
        unsigned* ln = (unsigned*)(wl + UW_LIST + ((s + 1) & 1) * UW_LCAP);
        int cntn = 0;
        if (s + 1 < 4) {
            cntn = peer_u_list(ln, pia, pib, part, lane);
            U_LOAD_H2(tok0 + 64);
            if (s + 2 < 4) U_LOAD_IDS(tok0 + 128);
        }
        const int ntiles = (cntc + 15) >> 4;
#pragma unroll 1
        for (int t = 0; t < ntiles; ++t) {
            const unsigned ent = lc[t * 16 + n];
            if (have != s * 64 + t) {
                const unsigned char* rp = UT4 + (size_t)(lc[t * 16 + ln4] & 0x3fffu) * 512;
#pragma unroll
                for (int ks = 0; ks < 8; ++ks) brow[ks] = *(const u32x4*)(rp + ks * 64);
            }
            unsigned entn;
            if (t + 1 < ntiles) { entn = lc[(t + 1) * 16 + ln4]; have = s * 64 + t + 1; }
            else if (cntn > 0) { entn = ln[ln4]; have = (s + 1) * 64; }
            else { entn = lc[t * 16 + ln4]; have = -1; }
            const unsigned char* rpn = UT4 + (size_t)(entn & 0x3fffu) * 512;
            const int idx = (int)(ent >> 16), tj = idx >> 7;
            const f32x2 gs = ((const f32x2*)(p.ws + WS_GATE))[(size_t)(tok0 + tj) * 128 + (idx & 127)];
            f32x4 acc0 = f32x4{0.f, 0.f, 0.f, 0.f}, acc1 = acc0;
            u32x4 a0 = *(const u32x4*)arow, a1 = *(const u32x4*)(arow + 64), bc;
            U_BPERM(bc, brow[0]);
#pragma unroll
            for (int ks = 0; ks < 8; ++ks) {
                const i32x8 av = i32x8{(int)a0[0], (int)a0[1], (int)a0[2], (int)a0[3], (int)a1[0], (int)a1[1], (int)a1[2], (int)a1[3]};
                const i32x8 bv = i32x8{(int)bc[0], (int)bc[1], (int)bc[2], (int)bc[3], 0, 0, 0, 0};
                if (ks < 7) { a0 = *(const u32x4*)(arow + (ks + 1) * 128); a1 = *(const u32x4*)(arow + (ks + 1) * 128 + 64); U_BPERM(bc, brow[ks + 1]); }
                if (ks & 1) acc1 = __builtin_amdgcn_mfma_scale_f32_16x16x128_f8f6f4(av, bv, acc1, 0, 4, 0, 0x7F7F7F7F, 0, 0x7F7F7F7F);
                else        acc0 = __builtin_amdgcn_mfma_scale_f32_16x16x128_f8f6f4(av, bv, acc0, 0, 4, 0, 0x7F7F7F7F, 0, 0x7F7F7F7F);
                brow[ks] = *(const u32x4*)(rpn + ks * 64);
                __builtin_amdgcn_sched_barrier(0);
            }
            const float d0 = acc0[0] + acc1[0], d1 = acc0[1] + acc1[1], d2 = acc0[2] + acc1[2], d3 = acc0[3] + acc1[3];
            const float araw = (tj == 0) ? d0 : (tj == 1) ? d1 : (tj == 2) ? d2 : d3;
            const float sxv = (tj == 0) ? sx[0] : (tj == 1) ? sx[1] : (tj == 2) ? sx[2] : sx[3];
            const float a = araw * (gs[1] * sxv);
            const float y = 0.7978845608028654f * (a + 0.044715f * a * a * a);
            const float th = 1.f - 2.f * __builtin_amdgcn_rcpf(__expf(2.f * y) + 1.f);
            const float w = 0.5f * a * (1.f + th) * gs[0];
            if (kg == 0 && t * 16 + n < cntc) ((u32x2*)(p.ws + WS_PAIRS))[(size_t)(tok0 + tj) * 128 + (idx & 127)] = u32x2{ent & 0x3fffu, __float_as_uint(w)};
        }
        cntc = cntn;
    }
#undef U_BPERM
#undef U_LOAD_IDS
#undef U_LOAD_H2
}
DI void phase_i2(const Params& p, unsigned char* lds) {
    run_partitioned<8>(p, lds, CTL_QUEUE_I2, BT / 256, [&](int part, int it) { peer_u_chunk(p, part, it, lds); });
}
typedef int i32x2_t __attribute__((ext_vector_type(2)));
constexpr int VW_BYTES = 9504, VW_PAIRS = 8192, VW_HI = 9216, VW_LO = 9344, VW_ZERO = 9472;
DI void peer_v_chunk(const Params& p, int p8, int chunk, unsigned char* lds) {
    const int tid = get_tid(), lane = tid & 63, wave = __builtin_amdgcn_readfirstlane(tid >> 6);
    unsigned char* wl = lds + wave * VW_BYTES;
    const int slice = p8 & 3;
    const unsigned char* VT4 = p.ws + WS_VTAB + (size_t)slice * 16384 * 128;
    const float* mod = (const float*)(p.ws + WS_MOD);
    const int er = lane >> 3, pc = lane & 7;
    const int n = lane & 31, kg = lane >> 5;
    const int col = slice * 256 + 8 * n;
    const int tokw = (p8 >> 2) * 16384 + chunk * 256 + wave;
    if (lane < 4) ((unsigned*)(wl + VW_ZERO))[lane] = 0u;
    const unsigned char* abase = wl + ((n == 0) ? VW_HI + 16 * kg : (n == 1) ? VW_LO + 16 * kg : VW_ZERO);
    const int astep = (n < 2) ? 1 : 0;
    const int row0 = 32 * kg + (lane & 15), sw0 = (row0 >> 1) & 7;
    const unsigned char* tb0 = wl + row0 * 128 + 8 * ((lane >> 4) & 1);
    u32x4 pp = *((const u32x4*)(p.ws + WS_PAIRS + (size_t)tokw * 1024) + lane);
#pragma unroll 1
    for (int step = 0; step < 16; ++step) {
        const int tok = tokw + step * 16, b = tok >> 12;
        *(u32x4*)(wl + VW_PAIRS + lane * 16) = pp;
        const float w0 = __uint_as_float(pp[1]), w1 = __uint_as_float(pp[3]);
        const float mx = fmaxf(wave_max(fmaxf(fabsf(w0), fabsf(w1))), 1e-30f);
        const float ws = 224.f / mx;
        const int hi = __builtin_amdgcn_cvt_pk_fp8_f32(w0 * ws, w1 * ws, 0, false);
        const f32x2 dq = __builtin_amdgcn_cvt_pk_f32_fp8(hi, false);
        const int lo = __builtin_amdgcn_cvt_pk_fp8_f32((w0 * ws - dq[0]) * 16.f, (w1 * ws - dq[1]) * 16.f, 0, false);
        ((unsigned short*)(wl + VW_HI))[lane] = (unsigned short)hi;
        ((unsigned short*)(wl + VW_LO))[lane] = (unsigned short)lo;
        if (step + 1 < 16) pp = *((const u32x4*)(p.ws + WS_PAIRS + (size_t)(tok + 16) * 1024) + lane);
        bf16_t* xo = (bf16_t*)(p.out + (size_t)tok * DM) + col;
        const u32x4 x1w = *(const u32x4*)xo;
        const f32x4 g2a = *(const f32x4*)(mod + b * 6144 + 5120 + col), g2b = *(const f32x4*)(mod + b * 6144 + 5120 + col + 4);
        float res[8];
#pragma unroll
        for (int i = 0; i < 8; ++i) res[i] = 0.f;
#pragma unroll 1
        for (int hf = 0; hf < 2; ++hf) {
            asm volatile("s_waitcnt lgkmcnt(0)" ::: "memory");
            __builtin_amdgcn_sched_barrier(0);
            const unsigned* pr = (const unsigned*)(wl + VW_PAIRS) + 2 * (64 * hf + er);
#pragma unroll
            for (int q = 0; q < 8; ++q) {
                const unsigned e = pr[16 * q];
                const int sw = (4 * q + (er >> 1)) & 7;
                __builtin_amdgcn_global_load_lds((const unsigned*)(VT4 + (size_t)e * 128 + ((pc ^ sw) << 4)), (unsigned*)(wl + q * 1024), 16, 0, 0);
            }
            const u32x4 a0 = *(const u32x4*)(abase + astep * (64 * hf)), a1 = *(const u32x4*)(abase + astep * (64 * hf + 32));
            const i32x8 av = i32x8{(int)a0[0], (int)a0[1], (int)a0[2], (int)a0[3], (int)a1[0], (int)a1[1], (int)a1[2], (int)a1[3]};
            asm volatile("s_waitcnt vmcnt(0)" ::: "memory");
            __builtin_amdgcn_sched_barrier(0);
#pragma unroll
            for (int nt = 0; nt < 8; ++nt) {
                const int c = (nt ^ sw0) << 4;
                const i32x2_t b0 = __builtin_amdgcn_ds_read_tr4_b64_v2i32((LAS i32x2_t*)(LAS unsigned char*)(tb0 + c));
                const i32x2_t b1 = __builtin_amdgcn_ds_read_tr4_b64_v2i32((LAS i32x2_t*)(LAS unsigned char*)(tb0 + 16 * 128 + c));
                const i32x8 bv = i32x8{b0[0], b0[1], b1[0], b1[1], 0, 0, 0, 0};
                f32x16 z;
#pragma unroll
                for (int i = 0; i < 16; ++i) z[i] = 0.f;
                const f32x16 d = __builtin_amdgcn_mfma_scale_f32_32x32x64_f8f6f4(av, bv, z, 0, 4, 0, 0x7F7F7F7F, 0, 0x7F7F7F7F);
                res[nt] += d[0] + d[1] * (1.f / 16.f);
            }
        }
        const float iw = mx * (1.f / 224.f);
        float xv[8];
#pragma unroll
        for (int i = 0; i < 4; ++i) { xv[2 * i] = bflo(x1w[i]); xv[2 * i + 1] = bfhi(x1w[i]); }
        float ss = 0.f;
#pragma unroll
        for (int i = 0; i < 8; ++i) { xv[i] += (i < 4 ? g2a[i & 3] : g2b[i & 3]) * (res[i] * iw); ss += xv[i] * xv[i]; }
        if (lane < 32) *(u32x4*)xo = u32x4{pk2(xv[0], xv[1]), pk2(xv[2], xv[3]), pk2(xv[4], xv[5]), pk2(xv[6], xv[7])};
        ss = wave_sum(lane < 32 ? ss : 0.f);
        if (lane == 0) ((float*)(p.ws + WS_SSQ))[(size_t)tok * 8 + slice] = ss;
    }
}
DI void phase_i3(const Params& p, unsigned char* lds) {
    run_partitioned<8>(p, lds, CTL_QUEUE_I3, 16384 / 256, [&](int part, int it) { peer_v_chunk(p, part, it, lds); });
}
DI void phase_i4(const Params& p) {
    const bool bad = xb_ld((unsigned*)(p.ws + WS_CTL) + CTL_BADTID) != 0u || xb_ld((unsigned*)(p.ws + WS_CTL) + XB_TMO) != 0u;
    for (int it = blockIdx.x; it < BT / 16; it += gridDim.x) {
        const int tid = get_tid(), lane = tid & 63, row = it * 16 + (tid >> 6);
        const float* sq = (const float*)(p.ws + WS_SSQ) + (size_t)row * 8;
        const f32x4 s0 = *(const f32x4*)sq;
        const float ss = s0[0] + s0[1] + s0[2] + s0[3];
        float rs = rsqrtf(ss * (1.f / DM) + EPS);
        if (bad) rs = __builtin_nanf("");
        float* o = p.out + (size_t)row * DM;
        u32x2 xw[4];
#pragma unroll
        for (int j = 0; j < 4; ++j) xw[j] = *(const u32x2*)((const bf16_t*)o + j * 256 + lane * 4);
        asm volatile("s_waitcnt vmcnt(0)" ::: "memory");
#pragma unroll
        for (int j = 0; j < 4; ++j) {
            const int c = j * 256 + lane * 4;
            const f32x4 g = *(const f32x4*)(p.in[I_FNG] + c);
            *(f32x4*)(o + c) = f32x4{bflo(xw[j][0]) * rs * g[0], bfhi(xw[j][0]) * rs * g[1], bflo(xw[j][1]) * rs * g[2], bfhi(xw[j][1]) * rs * g[3]};
        }
    }
}

DI float probe_mfma_mixed() {
    const int lane = get_tid() & 63, kg = lane >> 4;
    int aw[8];
#pragma unroll
    for (int v = 0; v < 8; ++v) {
        unsigned w = 0;
#pragma unroll
        for (int b = 0; b < 4; ++b) { const unsigned q = 32u * kg + 4u * v + b; w |= (((q & 63u) + 8u) | ((q >> 6) << 7)) << (8 * b); }
        aw[v] = (int)w;
    }
    const i32x8 av = i32x8{aw[0], aw[1], aw[2], aw[3], aw[4], aw[5], aw[6], aw[7]};
    int c1 = 0, c2 = 0, c4 = 0, c5 = 0; unsigned pi1 = 255;
#pragma unroll 1
    for (int pb = 0; pb < 128; ++pb) {
        const int kgB = pb >> 5, i0 = pb & 31;
        const unsigned hot = (kg == kgB) ? (2u << (4 * (i0 & 7))) : 0u;
        const i32x8 bv = i32x8{(i0 >> 3) == 0 ? (int)hot : 0, (i0 >> 3) == 1 ? (int)hot : 0, (i0 >> 3) == 2 ? (int)hot : 0, (i0 >> 3) == 3 ? (int)hot : 0, 0, 0, 0, 0};
        const f32x4 z = f32x4{0.f, 0.f, 0.f, 0.f};
        const f32x4 dd = __builtin_amdgcn_mfma_scale_f32_16x16x128_f8f6f4(av, bv, z, 0, 4, 0, 0x7F7F7F7F, 0, 0x7F7F7F7F);
        const float d = dd[0];
        unsigned qf = 255;
#pragma unroll 1
        for (unsigned q = 0; q < 128; ++q) { const unsigned byte = ((q & 63u) + 8u) | ((q >> 6) << 7); if (__builtin_amdgcn_cvt_f32_fp8((int)byte, 0) == d) qf = q; }
        c1 += (qf != (unsigned)pb); c2 += (qf != (unsigned)(pb ^ 1));
        { const unsigned k = 64u * (i0 >> 4) + 16u * kgB + (i0 & 15); c4 += (qf != k); }
        { const unsigned k = (unsigned)pb, kgA = (k & 63u) >> 4, j = 16u * (k >> 6) + (k & 15u); c5 += (qf != 32u * kgA + j); }
        if (pb == 1) pi1 = qf;
    }
    return c1 == 0 ? 1.1e6f : c2 == 0 ? 2.2e6f : c4 == 0 ? 4.4e6f : c5 == 0 ? 5.5e6f : (pi1 < 90u ? (10.f + (float)pi1) * 100.f : 7.7e6f);
}

__global__ void __launch_bounds__(NT) mega(Params p) {
    unsigned char* lds = g_lds;
    volatile LAS unsigned* st = (volatile LAS unsigned*)(LAS unsigned char*)(lds + LDS_ST_OFF);
    {
        const unsigned hw = __builtin_amdgcn_s_getreg((5 << 11) | 4);
        if ((threadIdx.x & 63) == 0) g_lds[LDS_WTAB_OFF + hw] = (unsigned char)(threadIdx.x >> 6);
        if (threadIdx.x < 2) st[threadIdx.x] = 0u;
        __syncthreads();
        if (get_tid() != (int)threadIdx.x) ((unsigned*)(p.ws + WS_CTL))[CTL_BADTID] = 1u;
    }
    XcdBarrier bar = xcd_barrier_post((unsigned*)(p.ws + WS_CTL), st);
    float* sm = (float*)lds;

#define STAMP(k, which) do { if (PROBE_PHASE == (k) && blockIdx.x == 0 && get_tid() == 0) ((volatile unsigned long long*)(lds + LDS_PROBE_OFF))[which] = __builtin_amdgcn_s_memrealtime(); } while (0)
    STAMP(21, 0); STAMP(30, 0); STAMP(31, 0);
    STAMP(0, 0); phase_a(p, sm);   xcd_barrier(bar); STAMP(0, 1);
    STAMP(1, 0); phase_b(p, sm);   xcd_barrier(bar); STAMP(1, 1);
    if (PROBE_PHASE == 20) { STAMP(20, 0); xcd_barrier(bar); xcd_barrier(bar); xcd_barrier(bar); xcd_barrier(bar); STAMP(20, 1); }
    STAMP(2, 0); phase_c(p, lds);  xcd_barrier(bar); STAMP(2, 1);
    STAMP(3, 0); phase_d(p, lds);  xcd_barrier(bar); STAMP(3, 1);
    STAMP(5, 0); phase_e(p, lds);  xcd_barrier(bar); STAMP(5, 1);
    STAMP(6, 0); phase_f(p, lds);  xcd_barrier(bar); STAMP(6, 1);
    STAMP(8, 0); phase_h(p, lds);  xcd_barrier(bar); STAMP(8, 1);
    STAMP(10, 0); phase_i2(p, lds); xcd_barrier(bar); STAMP(10, 1);
    STAMP(11, 0); phase_i3(p, lds); xcd_barrier(bar); STAMP(11, 1);
    STAMP(12, 0); phase_i4(p);
    float pm = 0.f;
    if (PROBE_PHASE == 40 && blockIdx.x == 0 && get_tid() < 64) pm = probe_mfma_mixed();
    if (PROBE_PHASE >= 0) {
        xcd_barrier(bar); STAMP(12, 1); STAMP(21, 1);
        if (blockIdx.x == 0 && get_tid() == 0) {
            volatile unsigned long long* ts = (volatile unsigned long long*)(lds + LDS_PROBE_OFF);
            if (PROBE_PHASE == 40) p.out[0] += pm; else
            p.out[0] += (float)(ts[1] - ts[0]) * (0.01f / PROBE_SCALE);
        }
    }
}

extern "C" void kernel_launch(void* const* d_in, const int* in_sizes, int n_in, void* d_out, int out_size, void* d_ws, size_t ws_size, hipStream_t stream) {
    static int grid = 0;
    if (grid == 0) {
        int dev = 0, cus = 0;
        if (hipGetDevice(&dev) != hipSuccess || hipDeviceGetAttribute(&cus, hipDeviceAttributeMultiprocessorCount, dev) != hipSuccess) { fprintf(stderr, "kernel_launch: device query failed\n"); grid = -1; return; }
        if (n_in != N_IN || ws_size < WS_END) { fprintf(stderr, "kernel_launch: unexpected n_in %d or ws_size %zu (< %zu)\n", n_in, ws_size, (size_t)WS_END); grid = -1; return; }
        grid = cus;
    }
    if (grid < 0) return;
    (void)hipMemsetAsync((char*)d_ws + WS_CTL, 0, 64 * 1024, stream);
    Params p{};
    for (int i = 0; i < N_IN; ++i) p.in[i] = (const float*)d_in[i];
    p.out = (float*)d_out; p.ws = (unsigned char*)d_ws;
    hipLaunchKernelGGL(mega, dim3(grid), dim3(NT), 0, stream, p);
}
```

```cpp
#include <hip/hip_runtime.h>
#include <stdint.h>
#include <cstdio>

#define DI __device__ __forceinline__
#define LAS __attribute__((address_space(3)))
typedef unsigned short bf16_t;
typedef short bf16x8 __attribute__((ext_vector_type(8)));
typedef short s16x4 __attribute__((ext_vector_type(4)));
typedef float f32x4 __attribute__((ext_vector_type(4)));
typedef float f32x2 __attribute__((ext_vector_type(2)));
typedef float f32x16 __attribute__((ext_vector_type(16)));
typedef unsigned u32x4 __attribute__((ext_vector_type(4)));
typedef unsigned u32x2 __attribute__((ext_vector_type(2)));

#ifndef PROBE_PHASE
#define PROBE_PHASE (-1)
#endif
#ifndef SHADOW
#define SHADOW 0
#endif
#ifndef PROBE_SCALE
#define PROBE_SCALE 100.f
#endif
constexpr int BATCH = 8, SEQ = 4096, DM = 1024, BT = BATCH * SEQ;
constexpr int CTX = 256, TK = SEQ + CTX;
constexpr int NH = 8, NKV = 2, HD = 64;
constexpr int QD = 512, KVD = 128, HYD = 512, HYC = 1536, GC = 2048, INC = 4352;
constexpr int PH = 8, PNK = 128, PDK = 256, PTOP = 16;
constexpr float EPS = 1e-6f;
constexpr int NT = 1024;

enum { I_X = 0, I_C, I_CTX, I_CCTX, I_ADAW, I_ADAB, I_NMIX, I_NFFN, I_WIN, I_QNG, I_KNG, I_HCW, I_HCB,
       I_HW1, I_HB1, I_HW2, I_HB2, I_HW3, I_HB3, I_HW4, I_HFREQ, I_HSKIP, I_WAO, I_WHO, I_WO, I_PWQ, I_PK1, I_PK2, I_PU, I_PV, I_FNG, N_IN };

constexpr size_t MB = 1024 * 1024;
constexpr size_t WS_CTL   = 0;
constexpr size_t WS_MOD   = 64 * 1024;
constexpr size_t WS_ROPE  = WS_MOD + 9 * 6144 * 4;
static_assert(WS_ROPE + 16 * 1024 + 8 * 2048 * 4 + 4096 <= 512 * 1024, "ws");
constexpr size_t WS_PART  = 512 * 1024;
constexpr size_t WS_WTIN  = 3 * MB;
constexpr size_t WS_WTAO  = WS_WTIN + (size_t)INC * DM * 2;
constexpr size_t WS_WTHO  = WS_WTAO + (size_t)DM * QD * 2;
constexpr size_t WS_WTO   = WS_WTHO + (size_t)DM * HYD * 2;
constexpr size_t WS_WTQ   = WS_WTO + (size_t)DM * DM * 2;
constexpr size_t WS_KEYS  = WS_WTQ + (size_t)2048 * DM * 2;
constexpr size_t WS_R     = WS_KEYS + (size_t)2 * 8 * 128 * 128 * 2;
constexpr size_t WS_KB    = WS_R + (size_t)2 * 512 * 8192 * 2;
constexpr size_t WS_VT    = WS_KB + (size_t)BATCH * NKV * TK * HD * 2;
constexpr size_t WS_HC    = WS_VT + (size_t)BATCH * NKV * TK * HD * 2;
constexpr size_t WS_H     = 60 * MB;
constexpr size_t WS_G     = WS_H + 64 * MB;
constexpr size_t WS_ZT    = WS_G + 128 * MB;
constexpr size_t WS_Q     = WS_ZT + 96 * MB;
constexpr size_t WS_ATT   = WS_Q + 32 * MB;
constexpr size_t WS_HYT   = WS_ATT + 32 * MB;
constexpr size_t WS_TAB   = WS_HYT + 32 * MB;
constexpr size_t WS_END   = WS_TAB + 32 * MB;
static_assert(WS_HC + (size_t)2048 * DM * 2 <= WS_H, "ws overlap");
constexpr size_t WS_FRAW  = WS_ATT;
constexpr size_t WS_HY    = WS_Q;
constexpr size_t WS_UT    = WS_TAB;
constexpr size_t WS_VSC   = WS_PART + 2 * MB + 320 * 1024;
constexpr size_t WS_VTAB  = WS_TAB + 16 * MB;
constexpr size_t WS_H8    = WS_ATT;
constexpr size_t WS_W8G   = WS_HYT;
constexpr size_t WS_EXPI  = WS_ATT;
constexpr size_t WS_GATE  = WS_Q;
constexpr size_t WS_PAIRS = WS_HYT;
constexpr size_t WS_SSQ   = WS_PART + 1 * MB;
constexpr size_t WS_USC   = WS_PART + 2 * MB;
constexpr size_t WS_Y     = WS_ZT;
constexpr size_t WS_X8    = WS_ZT + 64 * MB;
constexpr size_t WS_SSQ1  = WS_ATT + 16 * MB;
constexpr size_t WS_SX    = WS_PART + 2 * MB + 64 * 1024;
constexpr size_t WS_SHQ   = WS_ROPE + 16 * 1024;
constexpr size_t WS_FSC   = WS_SHQ + 64 * 1024;
constexpr float VSCALE = 64.f;
constexpr float W8_SCALE = 64.f;
constexpr float VT_SCALE = 16.f;
constexpr float X8_MAX = 192.f;

constexpr int CTL_BADTID = 8000;
DI unsigned f2bf(float f) { unsigned u = __builtin_bit_cast(unsigned, f); return (u + 0x7fffu + ((u >> 16) & 1u)) >> 16; }
DI unsigned pk2(float lo, float hi) { return f2bf(lo) | (f2bf(hi) << 16); }
DI float bf2f(unsigned short b) { return __builtin_bit_cast(float, (unsigned)b << 16); }
DI float bflo(unsigned u) { return __builtin_bit_cast(float, u << 16); }
DI float bfhi(unsigned u) { return __builtin_bit_cast(float, u & 0xffff0000u); }
DI float red2pi(float x) { const float k = rintf(x * 0.15915494309189535f); float r = fmaf(-k, 6.2831854820251465f, x); return fmaf(-k, -1.7484555e-7f, r); }
DI float fsin(float x) { return __sinf(red2pi(x)); }
DI float fcos(float x) { return __cosf(red2pi(x)); }
constexpr int LDS_BYTES = 160 * 1024;
constexpr int LDS_ST_OFF = LDS_BYTES - 16;
constexpr int LDS_PROBE_OFF = LDS_BYTES - 16 - 32;
constexpr int LDS_WTAB_OFF = LDS_BYTES - 16 - 32 - 64;
constexpr int LDS_USER = LDS_WTAB_OFF;
__shared__ __attribute__((aligned(16))) unsigned char g_lds[LDS_BYTES];
DI s16x4 lds_rd64(const unsigned char* ptr) { return *(const volatile LAS s16x4*)(const LAS unsigned char*)ptr; }
DI int get_tid() {
    const unsigned hw = __builtin_amdgcn_s_getreg((5 << 11) | 4);
    unsigned w = g_lds[LDS_WTAB_OFF + hw];
    w = __builtin_amdgcn_readfirstlane(w);
    int t;
    asm volatile("v_mbcnt_lo_u32_b32 %0, -1, 0\n\tv_mbcnt_hi_u32_b32 %0, -1, %0\n\tv_lshl_or_b32 %0, %1, 6, %0" : "=&v"(t) : "s"(w));
    return t;
}
template<int CTRL> DI float dppf(float v) { return __uint_as_float(__builtin_amdgcn_update_dpp(0u, __float_as_uint(v), CTRL, 0xF, 0xF, true)); }
template<int CTRL> DI int dppi(int v) { return (int)__builtin_amdgcn_update_dpp(0u, (unsigned)v, CTRL, 0xF, 0xF, true); }
DI float sum16(float v) { v += dppf<0xB1>(v); v += dppf<0x4E>(v); v += dppf<0x141>(v); v += dppf<0x140>(v); return v; }
DI float sum_x16(float v) { auto r = __builtin_amdgcn_permlane16_swap(__float_as_uint(v), __float_as_uint(v), false, false); return __uint_as_float(r[0]) + __uint_as_float(r[1]); }
DI float sum_x32(float v) { auto r = __builtin_amdgcn_permlane32_swap(__float_as_uint(v), __float_as_uint(v), false, false); return __uint_as_float(r[0]) + __uint_as_float(r[1]); }
DI float max_x32(float v) { auto r = __builtin_amdgcn_permlane32_swap(__float_as_uint(v), __float_as_uint(v), false, false); return fmaxf(__uint_as_float(r[0]), __uint_as_float(r[1])); }
DI float wave_sum(float v) { return sum_x32(sum_x16(sum16(v))); }
DI float wave_max(float v) {
    v = fmaxf(v, dppf<0xB1>(v)); v = fmaxf(v, dppf<0x4E>(v)); v = fmaxf(v, dppf<0x141>(v)); v = fmaxf(v, dppf<0x140>(v));
    { auto r = __builtin_amdgcn_permlane16_swap(__float_as_uint(v), __float_as_uint(v), false, false); v = fmaxf(__uint_as_float(r[0]), __uint_as_float(r[1])); }
    { auto r = __builtin_amdgcn_permlane32_swap(__float_as_uint(v), __float_as_uint(v), false, false); v = fmaxf(__uint_as_float(r[0]), __uint_as_float(r[1])); }
    return v;
}


#define XB_TMO      128
#define XB_XCNT(j)  (256  + 64 * (j))
#define XB_XSUB(j)  (1280 + 64 * (j))
#define XB_XGEN(j)  (2304 + 64 * (j))
#define XB_TOP      3328
#define XB_TOPGEN   3392
#define XCD_BAR_WORDS 3456
#define XB_SPIN_CAP (1u << 27)
DI unsigned xb_ld(unsigned* p)              { return __hip_atomic_load(p, __ATOMIC_RELAXED, __HIP_MEMORY_SCOPE_AGENT); }
DI unsigned xb_add(unsigned* p, unsigned v) { return __hip_atomic_fetch_add(p, v, __ATOMIC_RELAXED, __HIP_MEMORY_SCOPE_AGENT); }
DI unsigned xb_xcc_id() { return (unsigned)__builtin_amdgcn_s_getreg((3 << 11) | 20) & 0xFu; }
#define XB_SPIN(cond, bar) do { unsigned _sp = 0; while (cond) { __builtin_amdgcn_s_sleep(1); \
    if ((++_sp & 255u) == 0u) { if (xb_ld(&(bar)[XB_TMO])) break; if (_sp > XB_SPIN_CAP) { atomicAdd(&(bar)[XB_TMO], 1u); break; } } } } while (0)
struct XcdBarrier { unsigned* bar; unsigned x; volatile LAS unsigned* st; };
DI XcdBarrier xcd_barrier_post(unsigned* bar, volatile LAS unsigned* st) {
    XcdBarrier b; b.bar = bar; b.x = xb_xcc_id(); b.st = st;
    if (get_tid() == 0) (void)xb_add(&bar[XB_XCNT(b.x)], 1u);
    return b;
}
DI void xcd_barrier_complete(unsigned* bar, unsigned x, unsigned& nloc, unsigned& nx) {
    const unsigned G = gridDim.x * gridDim.y * gridDim.z;
    unsigned sum, cnt, mine, sp = 0u;
    for (;;) {
        sum = 0u; cnt = 0u; mine = 0u;
#pragma unroll
        for (unsigned j = 0; j < 16; ++j) { const unsigned c = xb_ld(&bar[XB_XCNT(j)]); sum += c; cnt += (c > 0u) ? 1u : 0u; mine = (j == x) ? c : mine; }
        if (sum == G) break;
        __builtin_amdgcn_s_sleep(1);
        if ((++sp & 255u) == 0u) { if (xb_ld(&bar[XB_TMO])) break; if (sp > XB_SPIN_CAP) { atomicAdd(&bar[XB_TMO], 1u); break; } }
    }
    nloc = mine > 0u ? mine : 1u; nx = cnt > 0u ? cnt : 1u;
}
DI void xcd_barrier(const XcdBarrier& b) {
    asm volatile("s_waitcnt vmcnt(0)" ::: "memory");
    __syncthreads();
    if (get_tid() == 0) {
        unsigned* bar = b.bar;
        __builtin_amdgcn_s_waitcnt(0);
        unsigned nloc = b.st[0], nx = b.st[1];
        if (nloc == 0u) { xcd_barrier_complete(bar, b.x, nloc, nx); b.st[0] = nloc; b.st[1] = nx; }
        const unsigned old = xb_add(&bar[XB_XSUB(b.x)], 1u);
        const unsigned gen = old / nloc;
        if (old + 1u == (gen + 1u) * nloc) {
            __builtin_amdgcn_fence(__ATOMIC_RELEASE, "agent");
            asm volatile("s_waitcnt vmcnt(0)" ::: "memory");
            const unsigned og = xb_add(&bar[XB_TOP], 1u);
            const unsigned tg = og / nx;
            if (og + 1u == (tg + 1u) * nx) xb_add(&bar[XB_TOPGEN], 1u);
            else XB_SPIN(xb_ld(&bar[XB_TOPGEN]) == tg, bar);
            __builtin_amdgcn_fence(__ATOMIC_ACQUIRE, "agent");
            xb_add(&bar[XB_XGEN(b.x)], 1u);
            asm volatile("s_waitcnt vmcnt(0)" ::: "memory");
        } else {
            XB_SPIN(xb_ld(&bar[XB_XGEN(b.x)]) == gen, bar);
            __builtin_amdgcn_fence(__ATOMIC_ACQUIRE, "agent");
            asm volatile("s_waitcnt vmcnt(0)" ::: "memory");
        }
    }
    __syncthreads();
}

struct Params { const float* in[N_IN]; float* out; unsigned char* ws; };


DI void transpose_tile(const float* __restrict__ W, int K, int N, bf16_t* __restrict__ Wt, int tile, float* sm) {
    const int tid = get_tid();
    const int ntn = N / 256, tk = tile / ntn, tn = tile % ntn;
    __syncthreads();
#pragma unroll
    for (int i = 0; i < 4; ++i) {
        const int idx = tid + i * NT, kk = idx >> 6, n4 = (idx & 63) * 4;
        const f32x4 v = *(const f32x4*)(W + (size_t)(tk * 64 + kk) * N + tn * 256 + n4);
        float* d = sm + kk * 257 + n4;
        d[0] = v[0]; d[1] = v[1]; d[2] = v[2]; d[3] = v[3];
    }
    __syncthreads();
#pragma unroll
    for (int i = 0; i < 2; ++i) {
        const int idx = tid + i * NT, nn = idx & 255, kg = idx >> 8;
        const float* c = sm + kg * 8 * 257 + nn;
        *(u32x4*)(Wt + (size_t)(tn * 256 + nn) * K + tk * 64 + kg * 8) = u32x4{pk2(c[0], c[257]), pk2(c[2 * 257], c[3 * 257]), pk2(c[4 * 257], c[5 * 257]), pk2(c[6 * 257], c[7 * 257])};
    }
}

DI void mod_item(const Params& p, int item, float* sm) {
    const int tid = get_tid();
    float* sc = sm;
    float* red = sm + 9 * 1024;
    __syncthreads();
    for (int i = tid; i < 9 * 1024; i += NT) {
        const float v = (i < 8 * 1024) ? p.in[I_C][i] : p.in[I_CCTX][i - 8 * 1024];
        sc[i] = v / (1.f + __expf(-v));
    }
    __syncthreads();
    const int col = tid & 15, kg = tid >> 4, n0 = item * 16;
    float acc[9];
#pragma unroll
    for (int r = 0; r < 9; ++r) acc[r] = 0.f;
    const float* w = p.in[I_ADAW] + (size_t)kg * 16 * 6144 + n0 + col;
    float wv[16];
#pragma unroll
    for (int k = 0; k < 16; ++k) wv[k] = w[(size_t)k * 6144];
#pragma unroll
    for (int k = 0; k < 16; ++k)
#pragma unroll
        for (int r = 0; r < 9; ++r) acc[r] += sc[r * 1024 + kg * 16 + k] * wv[k];
#pragma unroll
    for (int r = 0; r < 9; ++r) red[(kg * 9 + r) * 16 + col] = acc[r];
    __syncthreads();
    if (tid < 9 * 16) {
        const int r = tid >> 4, c2 = tid & 15;
        float s = p.in[I_ADAB][n0 + c2];
        for (int g = 0; g < 64; ++g) s += red[(g * 9 + r) * 16 + c2];
        ((float*)(p.ws + WS_MOD))[r * 6144 + n0 + c2] = s;
    }
    __syncthreads();
}

DI void filter_item(const Params& p, int item, float* sm) {
    const int tid = get_tid();
    float* z  = sm;
    float* ha = sm + 16 * 36;
    float* hb = ha + 16 * 64;
    const int t0 = item * 16;
    float* w1s = hb + 16 * 64;
    float* w2s = w1s + 33 * 64;
    float* w3s = w2s + 64 * 64;
    __syncthreads();
    {
        const f32x4 a2 = *(const f32x4*)(p.in[I_HW2] + tid * 4), a3 = *(const f32x4*)(p.in[I_HW3] + tid * 4);
        f32x4 a1 = f32x4{0.f, 0.f, 0.f, 0.f};
        if (tid < 33 * 16) a1 = *(const f32x4*)(p.in[I_HW1] + tid * 4);
        *(f32x4*)(w2s + tid * 4) = a2; *(f32x4*)(w3s + tid * 4) = a3;
        if (tid < 33 * 16) *(f32x4*)(w1s + tid * 4) = a1;
    }
    if (tid < 16 * 33) {
        const int pp = tid / 33, i = tid % 33;
        const int t = t0 + pp;
        float v;
        if (i == 0) v = (float)t / (float)(SEQ - 1);
        else {
            const int fi = (i - 1) & 15;
            const float f = 1e-4f + (float)fi * ((15.f - 1e-4f) / 15.f);
            const float w = 6.283185307179586f * (float)t / (float)SEQ;
            const float a = f * w;
            v = (i <= 16) ? fcos(a) : -fsin(a);
        }
        z[pp * 36 + i] = v;
    }
    __syncthreads();
    const int pp = tid >> 6, j = tid & 63;
    const float fr = p.in[I_HFREQ][j];
    {
        float a = p.in[I_HB1][j];
#pragma unroll 11
        for (int i = 0; i < 33; ++i) a += z[pp * 36 + i] * w1s[i * 64 + j];
        ha[pp * 64 + j] = fsin(fr * a);
    }
    __syncthreads();
    {
        float a = p.in[I_HB2][j];
#pragma unroll 16
        for (int i = 0; i < 64; ++i) a += ha[pp * 64 + i] * w2s[i * 64 + j];
        hb[pp * 64 + j] = fsin(fr * a);
    }
    __syncthreads();
    {
        float a = p.in[I_HB3][j];
#pragma unroll 16
        for (int i = 0; i < 64; ++i) a += hb[pp * 64 + i] * w3s[i * 64 + j];
        __syncthreads();
        ha[pp * 64 + j] = fsin(fr * a);
    }
    __syncthreads();
    float* fraw = (float*)(p.ws + WS_FRAW);
    float* part = (float*)(p.ws + WS_PART);
    const float* w4 = p.in[I_HW4];
    {
        const int lane = tid & 63, wave = tid >> 6, l15 = lane & 15, lk = lane >> 4;
        float af[16];
#pragma unroll
        for (int ks = 0; ks < 16; ++ks) af[ks] = ha[l15 * 64 + ks * 4 + lk];
        const float mind = -3.0701134573253945f, maxd = -15.350567286626973f;
        const unsigned wvo = (unsigned)((lk * 2048 + wave * 128 + 4 * l15) * 4);
        f32x4 bw[16];
#pragma unroll
        for (int ks = 0; ks < 16; ++ks) { const char* bk = (const char*)w4 + (size_t)ks * 32768; asm volatile("" : "+s"(bk)); bw[ks] = *(const f32x4*)(bk + wvo); }
#pragma unroll 1
        for (int g = 0; g < 2; ++g) {
            f32x4 acc[4];
#pragma unroll
            for (int u = 0; u < 4; ++u) acc[u] = f32x4{0.f, 0.f, 0.f, 0.f};
#pragma unroll
            for (int ks = 0; ks < 16; ++ks) {
#pragma unroll
                for (int u = 0; u < 4; ++u) acc[u] = __builtin_amdgcn_mfma_f32_16x16x4f32(af[ks], bw[ks][u], acc[u], 0, 0, 0);
                if (g == 0) { const char* bk = (const char*)w4 + (size_t)ks * 32768 + 256; asm volatile("" : "+s"(bk)); bw[ks] = *(const f32x4*)(bk + wvo); }
            }
#pragma unroll
            for (int u = 0; u < 4; ++u) {
                const int col = wave * 128 + 64 * g + 4 * l15 + u;
                const int c = col & 511, dir = (col >> 9) & 1;
                const float delta = fabsf(mind + (float)c * ((maxd - mind) / 511.f));
                float sabs = 0.f, v[4];
#pragma unroll
                for (int r = 0; r < 4; ++r) {
                    const int t = t0 + 4 * lk + r;
                    const float t01 = (float)t / (float)(SEQ - 1);
                    v[r] = acc[u][r] * expf(-t01 * delta);
                    if (!(dir == 1 && t == 0)) sabs += fabsf(v[r]);
                }
                *(f32x4*)(fraw + (size_t)col * SEQ + t0 + 4 * lk) = f32x4{v[0], v[1], v[2], v[3]};
                sabs = sum_x32(sum_x16(sabs));
                if (lk == 0) part[item * 2048 + col] = sabs;
            }
        }
    }
    __syncthreads();
}

DI void phase_a(const Params& p, float* sm) {
    constexpr int T_WIN = 16 * 17, T_AO = 8 * 4, T_HO = 8 * 4, T_WO = 16 * 4, T_WQ = 16 * 8;
    constexpr int E0 = T_WIN, E1 = E0 + T_AO, E2 = E1 + T_HO, E3 = E2 + T_WO, E4 = E3 + T_WQ;
    constexpr int E5 = E4 + 64;
    constexpr int E6 = E5 + 384;
    constexpr int E7 = E6 + 1;
    constexpr int E8 = E7 + 256;
    for (int it = blockIdx.x; it < E8; it += gridDim.x) {
        int item = it;
        if (item < 256) { filter_item(p, item, sm); if (PROBE_PHASE == 30 && blockIdx.x == 0 && get_tid() == 0) ((volatile unsigned long long*)(g_lds + LDS_PROBE_OFF))[1] = __builtin_amdgcn_s_memrealtime(); continue; }
        item -= 256;
        if (item < 384) { mod_item(p, item, sm); if (PROBE_PHASE == 31 && blockIdx.x == 0 && get_tid() == 0) ((volatile unsigned long long*)(g_lds + LDS_PROBE_OFF))[1] = __builtin_amdgcn_s_memrealtime(); continue; }
        item -= 384;
        if (item < 1) {
            const int tid = get_tid();
            float* rope = (float*)(p.ws + WS_ROPE);
            const int pos = tid >> 4, f = tid & 15;
            const float inv = powf(10000.f, -(float)(2 * f) / 32.f);
            const float ang = (float)pos * inv;
            rope[tid] = fcos(ang); rope[1024 + tid] = fsin(ang);
            continue;
        }
        item -= 1;
        if (item < 64) {
            const int tid = get_tid();
            const float* src = (item < 32) ? p.in[I_PK1] : p.in[I_PK2];
            bf16_t* dst = (bf16_t*)(p.ws + WS_KEYS) + (size_t)item * 4096;
            const f32x4 v = *(const f32x4*)(src + (size_t)(item & 31) * 4096 + tid * 4);
            *(u32x2*)(dst + tid * 4) = u32x2{pk2(v[0], v[1]), pk2(v[2], v[3])};
            continue;
        }
        item -= 64;
        if (item < T_WIN) { transpose_tile(p.in[I_WIN], DM, INC, (bf16_t*)(p.ws + WS_WTIN), item, sm); continue; }
        item -= T_WIN;
        if (item < T_AO) { transpose_tile(p.in[I_WAO], QD, DM, (bf16_t*)(p.ws + WS_WTAO), item, sm); continue; }
        item -= T_AO;
        if (item < T_HO) { transpose_tile(p.in[I_WHO], HYD, DM, (bf16_t*)(p.ws + WS_WTHO), item, sm); continue; }
        item -= T_HO;
        if (item < T_WO) { transpose_tile(p.in[I_WO], DM, DM, (bf16_t*)(p.ws + WS_WTO), item, sm); continue; }
        item -= T_WO;
        transpose_tile(p.in[I_PWQ], DM, 2048, (bf16_t*)(p.ws + WS_WTQ), item, sm);
    }
    (void)E1; (void)E2; (void)E3; (void)E4; (void)E5; (void)E6; (void)E7;
}

typedef int i32x8 __attribute__((ext_vector_type(8)));
#define MFMA8(a, b, c) __builtin_amdgcn_mfma_scale_f32_32x32x64_f8f6f4((a), (b), (c), 0, 0, 0, 0x7F7F7F7F, 0, 0x7F7F7F7F)
DI unsigned pk_fp8x4(float a, float b, float c, float d) {
    int w = 0;
    w = __builtin_amdgcn_cvt_pk_fp8_f32(fminf(fmaxf(a, -440.f), 440.f), fminf(fmaxf(b, -440.f), 440.f), w, false);
    w = __builtin_amdgcn_cvt_pk_fp8_f32(fminf(fmaxf(c, -440.f), 440.f), fminf(fmaxf(d, -440.f), 440.f), w, true);
    return (unsigned)w;
}
DI void norm_mod_row(const float* __restrict__ src, const float* __restrict__ g, const float* __restrict__ shift, const float* __restrict__ scale, bf16_t* __restrict__ dst, unsigned char* __restrict__ dst8 = nullptr) {
    const int lane = get_tid() & 63;
    f32x4 v[4];
    float ss = 0.f;
#pragma unroll
    for (int j = 0; j < 4; ++j) { v[j] = *(const f32x4*)(src + j * 256 + lane * 4); ss += v[j][0] * v[j][0] + v[j][1] * v[j][1] + v[j][2] * v[j][2] + v[j][3] * v[j][3]; }
    ss = wave_sum(ss);
    const float rs = rsqrtf(ss * (1.f / DM) + EPS);
#pragma unroll
    for (int j = 0; j < 4; ++j) {
        const int c = j * 256 + lane * 4;
        const f32x4 gg = *(const f32x4*)(g + c), sh = *(const f32x4*)(shift + c), sc = *(const f32x4*)(scale + c);
        float o[4];
#pragma unroll
        for (int e = 0; e < 4; ++e) o[e] = v[j][e] * rs * gg[e] * (1.f + sc[e]) + sh[e];
        *(u32x2*)(dst + c) = u32x2{pk2(o[0], o[1]), pk2(o[2], o[3])};
        if (dst8) *(unsigned*)(dst8 + c) = pk_fp8x4(o[0], o[1], o[2], o[3]);
    }
}

DI void filter_norm_item(const Params& p, int item, float* sm) {
    const int tid = get_tid();
    const int o = item >> 9, c = item & 511;
    const int colf = o * 1024 + c, colb = colf + 512;
    const float* part = (const float*)(p.ws + WS_PART);
    const float* fraw = (const float*)(p.ws + WS_FRAW);
    float v[8], mx = 0.f;
#pragma unroll
    for (int i = 0; i < 8; ++i) {
        const int n = tid * 8 + i;
        v[i] = (n == 0) ? 0.f : (n <= 4096 ? fraw[(size_t)colf * SEQ + 4096 - n] : fraw[(size_t)colb * SEQ + n - 4096]);
        mx = fmaxf(mx, fabsf(v[i]));
    }
    float sacc = 0.f;
    if (tid < 512) sacc = part[(tid & 255) * 2048 + ((tid < 256) ? colf : colb)];
    sacc = wave_sum(sacc); mx = wave_max(mx);
    __syncthreads();
    if ((tid & 63) == 0) { sm[tid >> 6] = sacc; sm[16 + (tid >> 6)] = mx; }
    __syncthreads();
    float tot = EPS, gmx = 0.f;
#pragma unroll
    for (int i = 0; i < 8; ++i) tot += sm[i];
#pragma unroll
    for (int i = 0; i < 16; ++i) gmx = fmaxf(gmx, sm[16 + i]);
    const float inv = 1.f / tot;
    int ex; (void)frexpf(fmaxf(gmx * inv, 1e-30f), &ex);
    const float sc = ldexpf(1.f, 8 - ex), isc = ldexpf(1.f, ex - 8);
    if (tid == 0) ((float*)(p.ws + WS_FSC))[item] = isc;
    const float k = inv * sc;
    int w0 = 0, w1 = 0;
    w0 = __builtin_amdgcn_cvt_pk_fp8_f32(v[0] * k, v[1] * k, w0, false); w0 = __builtin_amdgcn_cvt_pk_fp8_f32(v[2] * k, v[3] * k, w0, true);
    w1 = __builtin_amdgcn_cvt_pk_fp8_f32(v[4] * k, v[5] * k, w1, false); w1 = __builtin_amdgcn_cvt_pk_fp8_f32(v[6] * k, v[7] * k, w1, true);
    *(u32x2*)(p.ws + WS_R + (size_t)item * 8192 + tid * 8) = u32x2{(unsigned)w0, (unsigned)w1};
    __syncthreads();
}

DI void table_conv_item(const Params& p, int ci, unsigned char* lds) {
    const int tid = get_tid();
    const size_t el = (size_t)(ci & 2047) * 8192 + tid * 8;
    const float* src = (ci < 2048 ? p.in[I_PU] : p.in[I_PV]) + el;
    const f32x4 a = *(const f32x4*)src, b = *(const f32x4*)(src + 4);
    const size_t e = el >> 10, col = el & 1023;
    if (ci < 2048) {
        float sq = a[0] * a[0] + a[1] * a[1] + a[2] * a[2] + a[3] * a[3] + b[0] * b[0] + b[1] * b[1] + b[2] * b[2] + b[3] * b[3];
        sq = wave_sum(sq);
        float* wm = (float*)lds;
        __syncthreads();
        if ((tid & 63) == 0) wm[tid >> 6] = sq;
        __syncthreads();
        const int w2 = (tid >> 7) * 2;
        const float rsig = fmaxf(sqrtf((wm[w2] + wm[w2 + 1]) * (1.f / 1024.f)), 1e-30f);
        const float sc = 2.f / rsig;
        if ((tid & 127) == 0) ((float*)(p.ws + WS_USC))[e] = rsig * 0.5f;
        const float xs[8] = {a[0], a[1], a[2], a[3], b[0], b[1], b[2], b[3]};
        unsigned w = 0;
#pragma unroll
        for (int j = 0; j < 8; ++j) {
            const float m = fabsf(xs[j] * sc);
            const unsigned code = (m < 0.25f ? 0u : m < 0.75f ? 1u : m < 1.25f ? 2u : m < 1.75f ? 3u : m < 2.5f ? 4u : m < 3.5f ? 5u : m < 5.f ? 6u : 7u) | (xs[j] < 0.f ? 8u : 0u);
            w |= code << (4 * j);
        }
        *(unsigned*)(p.ws + WS_UT + (el >> 1)) = w;
    } else {
        float sq = a[0] * a[0] + a[1] * a[1] + a[2] * a[2] + a[3] * a[3] + b[0] * b[0] + b[1] * b[1] + b[2] * b[2] + b[3] * b[3];
        sq = wave_sum(sq);
        float* wm = (float*)lds;
        __syncthreads();
        if ((tid & 63) == 0) wm[tid >> 6] = sq;
        __syncthreads();
        const int w2 = (tid >> 7) * 2;
        const float rsig = fmaxf(sqrtf((wm[w2] + wm[w2 + 1]) * (1.f / 1024.f)), 1e-30f);
        const float sc = 2.f / rsig;
        if ((tid & 127) == 0) ((float*)(p.ws + WS_VSC))[e] = rsig * 0.5f;
        const float xs[8] = {a[0], a[1], a[2], a[3], b[0], b[1], b[2], b[3]};
        unsigned wc = 0;
#pragma unroll
        for (int j = 0; j < 8; ++j) {
            const float m = fabsf(xs[j] * sc);
            const unsigned code = (m < 0.25f ? 0u : m < 0.75f ? 1u : m < 1.25f ? 2u : m < 1.75f ? 3u : m < 2.5f ? 4u : m < 3.5f ? 5u : m < 5.f ? 6u : 7u) | (xs[j] < 0.f ? 8u : 0u);
            wc |= code << (4 * j);
        }
        const unsigned wo = (unsigned)dppi<0xB1>((int)wc);
        const int cs = (int)(col & 255), ah = cs >> 7, jp = (cs & 127) >> 3;
        const unsigned wev = (jp & 1) ? wo : wc, wod = (jp & 1) ? wc : wo;
        unsigned char* dst = p.ws + WS_VTAB + ((col >> 8) * 16384 + e) * 128 + 8 * ah + (jp >> 1);
#pragma unroll
        for (int q = 0; q < 4; ++q) {
            const int nt = q + 4 * (jp & 1);
            dst[16 * nt] = (unsigned char)(((wev >> (4 * nt)) & 15u) | (((wod >> (4 * nt)) & 15u) << 4));
        }
    }
}

DI void phase_b(const Params& p, float* sm) {
    const int wave = get_tid() >> 6;
    const float* mod = (const float*)(p.ws + WS_MOD);
    constexpr int ROW_ITEMS = (BT + BATCH * CTX) / 16;
    constexpr int CONV = 2 * 16384 * 1024 / 8192;
    constexpr int SHQ = 8 * 2048 / 16;
    constexpr int W8I = 2048 / 16;
    for (int it = blockIdx.x; it < ROW_ITEMS + 1024 + CONV + SHQ + W8I; it += gridDim.x) {
        if (it < 1024) { filter_norm_item(p, it, sm); continue; }
        if (it >= ROW_ITEMS + 1024 + CONV + SHQ) {
            const int tid = get_tid(), lane = tid & 63, n = (it - ROW_ITEMS - 1024 - CONV - SHQ) * 16 + (tid >> 6);
            const bf16_t* wr = (const bf16_t*)(p.ws + WS_WTIN) + (size_t)(2304 + n) * DM + lane * 16;
            const u32x4 w0 = *(const u32x4*)wr, w1 = *(const u32x4*)(wr + 8);
            const float k = W8_SCALE;
            *(u32x4*)(p.ws + WS_W8G + (size_t)n * DM + lane * 16) = u32x4{pk_fp8x4(bflo(w0[0]) * k, bfhi(w0[0]) * k, bflo(w0[1]) * k, bfhi(w0[1]) * k), pk_fp8x4(bflo(w0[2]) * k, bfhi(w0[2]) * k, bflo(w0[3]) * k, bfhi(w0[3]) * k),
                                                                                pk_fp8x4(bflo(w1[0]) * k, bfhi(w1[0]) * k, bflo(w1[1]) * k, bfhi(w1[1]) * k), pk_fp8x4(bflo(w1[2]) * k, bfhi(w1[2]) * k, bflo(w1[3]) * k, bfhi(w1[3]) * k)};
            continue;
        }
        if (it >= ROW_ITEMS + 1024 + CONV) {
            const int tid = get_tid(), lane = tid & 63, o = (it - ROW_ITEMS - 1024 - CONV) * 16 + (tid >> 6), b = o >> 11, n = o & 2047;
            const bf16_t* wr = (const bf16_t*)(p.ws + WS_WTQ) + (size_t)n * DM + lane * 16;
            const float* sh = mod + b * 6144 + 3072 + lane * 16;
            const u32x4 w0 = *(const u32x4*)wr, w1 = *(const u32x4*)(wr + 8);
            float d = 0.f;
#pragma unroll
            for (int i = 0; i < 4; ++i) { d += bflo(w0[i]) * sh[2 * i] + bfhi(w0[i]) * sh[2 * i + 1] + bflo(w1[i]) * sh[8 + 2 * i] + bfhi(w1[i]) * sh[9 + 2 * i]; }
            d = wave_sum(d);
            if (lane == 0) ((float*)(p.ws + WS_SHQ))[o] = d;
            continue;
        }
        if (it >= ROW_ITEMS + 1024) { table_conv_item(p, it - ROW_ITEMS - 1024, (unsigned char*)sm); continue; }
        const int row = (it - 1024) * 16 + wave;
        if (row < BT) {
            const int b = row >> 12;
            norm_mod_row(p.in[I_X] + (size_t)row * DM, p.in[I_NMIX], mod + b * 6144, mod + b * 6144 + 1024, (bf16_t*)(p.ws + WS_H) + (size_t)row * DM, p.ws + WS_H8 + (size_t)row * DM);
        } else {
            const int r = row - BT;
            norm_mod_row(p.in[I_CTX] + (size_t)r * DM, p.in[I_NMIX], mod + 8 * 6144, mod + 8 * 6144 + 1024, (bf16_t*)(p.ws + WS_HC) + (size_t)r * DM);
        }
    }
}

#define MFMA16(a, b, c) __builtin_amdgcn_mfma_f32_16x16x32_bf16((a), (b), (c), 0, 0, 0)
constexpr int GT_P = 256 * 128;
struct RowLoader {
    const bf16_t* base; int ld;
    static constexpr bool kmajor = false;
    template<int ROWS> DI void issue(unsigned char* tile, int kt, int lane, int wave) const {
#pragma unroll
        for (int i = 0; i < ROWS / 128; ++i) {
            const int grp = i * 16 + wave, row = grp * 8 + (lane >> 3), c = (lane & 7) ^ (lane >> 3);
            __builtin_amdgcn_global_load_lds((const unsigned*)((const char*)base + (unsigned)((row * ld + kt * 64 + c * 8) * 2)), (unsigned*)(tile + grp * 1024), 16, 0, 0);
        }
    }
};

struct ColLoader {
    const bf16_t* base; size_t ld;
    static constexpr bool kmajor = true;
    template<int ROWS> DI void issue(unsigned char* tile, int kt, int lane, int wave) const {
        static_assert(ROWS == 128, "k-major loader: 128-row Q tiles only");
        const int row = wave * 4 + (lane >> 4), c = (lane & 15) ^ (2 * (row & 3));
        __builtin_amdgcn_global_load_lds((const unsigned*)(base + (size_t)(kt * 64 + row) * ld + c * 8), (unsigned*)(tile + wave * 1024), 16, 0, 0);
    }
};
template<int NQ>
DI void gemm_prefetch(const RowLoader& lp, const RowLoader& lq, unsigned char* lds) {
    const int tid = get_tid(), lane = tid & 63, wave = __builtin_amdgcn_readfirstlane(tid >> 6);
    lp.template issue<256>(lds, 0, lane, wave); lq.template issue<NQ * 64>(lds + GT_P, 0, lane, wave);
}
template<int NQ, bool KMAJOR>
DI void gemm_kstep(f32x4 (&acc)[4][NQ], const unsigned char* cur, int wp, int wq, int l15, int lk) {
#pragma unroll
    for (int ks = 0; ks < 2; ++ks) {
        bf16x8 fp[4], fq[NQ];
#pragma unroll
        for (int i = 0; i < 4; ++i) { const int row = wp * 64 + i * 16 + l15; fp[i] = *(const bf16x8*)(cur + row * 128 + (((ks * 4 + lk) ^ (row & 7)) << 4)); }
#pragma unroll
        for (int j = 0; j < NQ; ++j) {
            if constexpr (KMAJOR) {
                const int q4 = l15 >> 2, tokq = wq * (16 * NQ) + j * 16 + 4 * (l15 & 3);
                const unsigned char* ap = cur + GT_P + ((ks * 4 + lk) * 8 + q4) * 256 + (((tokq >> 3) ^ (2 * q4)) << 4) + ((tokq >> 2) & 1) * 8;
                const s16x4 lo = __builtin_amdgcn_ds_read_tr16_b64_v4i16((LAS s16x4*)(LAS unsigned char*)ap);
                const s16x4 hi = __builtin_amdgcn_ds_read_tr16_b64_v4i16((LAS s16x4*)(LAS unsigned char*)(ap + 4 * 256));
                fq[j] = __builtin_shufflevector(lo, hi, 0, 1, 2, 3, 4, 5, 6, 7);
            } else { const int row = wq * (16 * NQ) + j * 16 + l15; fq[j] = *(const bf16x8*)(cur + GT_P + row * 128 + (((ks * 4 + lk) ^ (row & 7)) << 4)); }
        }
#pragma unroll
        for (int i = 0; i < 4; ++i)
#pragma unroll
            for (int j = 0; j < NQ; ++j) acc[i][j] = MFMA16(fp[i], fq[j], acc[i][j]);
    }
}
template<int NQ>
DI void gemm_kstep8(f32x4 (&acc)[4][NQ], const unsigned char* cur, int wp, int wq, int l15, int lk) {
    __builtin_amdgcn_sched_barrier(0);
    i32x8 fp[4];
#pragma unroll
    for (int i = 0; i < 4; ++i) {
        const int row = wp * 64 + i * 16 + l15;
        const u32x4 a = *(const u32x4*)(cur + row * 128 + ((lk ^ (row & 7)) << 4)), b = *(const u32x4*)(cur + row * 128 + (((4 + lk) ^ (row & 7)) << 4));
        fp[i] = i32x8{(int)a[0], (int)a[1], (int)a[2], (int)a[3], (int)b[0], (int)b[1], (int)b[2], (int)b[3]};
    }
    u32x4 qa, qb;
    { const int row = wq * (16 * NQ) + l15; qa = *(const u32x4*)(cur + GT_P + row * 128 + ((lk ^ (row & 7)) << 4)); qb = *(const u32x4*)(cur + GT_P + row * 128 + (((4 + lk) ^ (row & 7)) << 4)); }
#pragma unroll
    for (int j = 0; j < NQ; ++j) {
        const i32x8 fq = i32x8{(int)qa[0], (int)qa[1], (int)qa[2], (int)qa[3], (int)qb[0], (int)qb[1], (int)qb[2], (int)qb[3]};
        if (j + 1 < NQ) { const int row = wq * (16 * NQ) + (j + 1) * 16 + l15; qa = *(const u32x4*)(cur + GT_P + row * 128 + ((lk ^ (row & 7)) << 4)); qb = *(const u32x4*)(cur + GT_P + row * 128 + (((4 + lk) ^ (row & 7)) << 4)); }
#pragma unroll
        for (int i = 0; i < 4; ++i) acc[i][j] = __builtin_amdgcn_mfma_scale_f32_16x16x128_f8f6f4(fp[i], fq, acc[i][j], 0, 0, 0, 0x7F7F7F7F, 0, 0x7F7F7F7F);
        __builtin_amdgcn_sched_barrier(0);
    }
}
template<int NQ, class LQ = RowLoader, class NLQ = RowLoader, bool F8 = false>
DI void gemm_mainloop(f32x4 (&acc)[4][NQ], const RowLoader& lp, const LQ& lq, int nk, unsigned char* lds, bool preissued = false, bool pfnext = false,
                      const RowLoader& nlp = RowLoader{nullptr, 0}, const NLQ& nlq = NLQ{nullptr, 0}) {
    const int tid = get_tid(), lane = tid & 63, wave = __builtin_amdgcn_readfirstlane(tid >> 6), wp = wave >> 2, wq = wave & 3;
    constexpr int QROWS = NQ * 64;
    constexpr int STAGE = GT_P + QROWS * 128;
    if (!preissued) {
        __syncthreads();
        lp.template issue<256>(lds, 0, lane, wave); lq.template issue<QROWS>(lds + GT_P, 0, lane, wave);
    }
    asm volatile("s_waitcnt vmcnt(0)" ::: "memory");
    __syncthreads();
    const int l15 = lane & 15, lk = lane >> 4;
    for (int kt = 0; kt < nk; ++kt) {
        unsigned char* cur = lds + (kt & 1) * STAGE;
        unsigned char* nxt = lds + ((kt + 1) & 1) * STAGE;
        const bool last = kt + 1 == nk;
        if (!last) { lp.template issue<256>(nxt, kt + 1, lane, wave); lq.template issue<QROWS>(nxt + GT_P, kt + 1, lane, wave); }
        else if (pfnext) { nlp.template issue<256>(nxt, 0, lane, wave); nlq.template issue<QROWS>(nxt + GT_P, 0, lane, wave); }
        if constexpr (F8) gemm_kstep8<NQ>(acc, cur, wp, wq, l15, lk); else gemm_kstep<NQ, LQ::kmajor>(acc, cur, wp, wq, l15, lk);
        if (last && pfnext) { asm volatile("s_waitcnt lgkmcnt(0)" ::: "memory"); __builtin_amdgcn_s_barrier(); }
        else { asm volatile("s_waitcnt vmcnt(0)" ::: "memory"); __syncthreads(); }
    }
}
template<int NQ>
DI void gemm_shadow(const RowLoader& lp, const RowLoader& lq, int nk, unsigned char* lds) {
    f32x4 acc[4][NQ];
#pragma unroll
    for (int i = 0; i < 4; ++i)
#pragma unroll
        for (int j = 0; j < NQ; ++j) acc[i][j] = f32x4{0.f, 0.f, 0.f, 0.f};
    if (SHADOW == 1) gemm_mainloop<NQ>(acc, lp, lq, nk, lds);
    else {
        const int tid = get_tid(), lane = tid & 63, wave = __builtin_amdgcn_readfirstlane(tid >> 6), wp = wave >> 2, wq = wave & 3;
        constexpr int QROWS = NQ * 64;
        constexpr int STAGE = GT_P + QROWS * 128;
        const int l15 = lane & 15, lk = lane >> 4;
        bf16x8 fp[4], fq[NQ];
        if (SHADOW == 3) {
#pragma unroll
            for (int i = 0; i < 4; ++i) fp[i] = *(const bf16x8*)(lds + (wp * 64 + i * 16 + l15) * 128 + lk * 16);
#pragma unroll
            for (int j = 0; j < NQ; ++j) fq[j] = *(const bf16x8*)(lds + GT_P + (wq * 16 * NQ + j * 16 + l15) * 128 + lk * 16);
        }
        for (int kt = 0; kt < nk; ++kt) {
            unsigned char* cur = lds + (kt & 1) * STAGE;
#pragma unroll
            for (int ks = 0; ks < 2; ++ks) {
                if (SHADOW == 2 || SHADOW == 4) {
#pragma unroll
                    for (int i = 0; i < 4; ++i) { const int row = wp * 64 + i * 16 + l15; fp[i] = *(const bf16x8*)(cur + row * 128 + (((ks * 4 + lk) ^ (row & 7)) << 4)); }
#pragma unroll
                    for (int j = 0; j < NQ; ++j) { const int row = wq * (16 * NQ) + j * 16 + l15; fq[j] = *(const bf16x8*)(cur + GT_P + row * 128 + (((ks * 4 + lk) ^ (row & 7)) << 4)); }
                }
#pragma unroll
                for (int i = 0; i < 4; ++i)
#pragma unroll
                    for (int j = 0; j < NQ; ++j) acc[i][j] = MFMA16(fp[i], fq[j], acc[i][j]);
            }
            if (SHADOW == 2) asm volatile("" ::: "memory");
            if (SHADOW == 4) __syncthreads();
        }
    }
#pragma unroll
    for (int i = 0; i < 4; ++i)
#pragma unroll
        for (int j = 0; j < NQ; ++j) asm volatile("" :: "v"(acc[i][j]));
}

template<int NQ> DI void gemm_shadow1(const RowLoader& lp, const RowLoader& lq, int nk, unsigned char* lds) {
    f32x4 acc[4][NQ];
#pragma unroll
    for (int i = 0; i < 4; ++i)
#pragma unroll
        for (int j = 0; j < NQ; ++j) acc[i][j] = f32x4{0.f, 0.f, 0.f, 0.f};
    gemm_mainloop<NQ>(acc, lp, lq, nk, lds);
#pragma unroll
    for (int i = 0; i < 4; ++i)
#pragma unroll
        for (int j = 0; j < NQ; ++j) asm volatile("" :: "v"(acc[i][j]));
}
DI void head_epilogue(f32x4 (&acc)[4][4], const float* __restrict__ g, float gscale, const float* __restrict__ rope, bool do_rope, int t_base  , unsigned char* __restrict__ dst  , int lane) {
    const int l15 = lane & 15, lk = lane >> 4;
    float gg[4];
#pragma unroll
    for (int j = 0; j < 4; ++j) gg[j] = g[j * 16 + l15] * gscale;
#pragma unroll
    for (int i = 0; i < 4; ++i) {
#pragma unroll
        for (int r = 0; r < 4; ++r) {
            float ss = 0.f;
#pragma unroll
            for (int j = 0; j < 4; ++j) ss += acc[i][j][r] * acc[i][j][r];
            ss = sum16(ss);
            const float rs = rsqrtf(ss * (1.f / 64.f) + EPS);
            float v[4];
#pragma unroll
            for (int j = 0; j < 4; ++j) v[j] = acc[i][j][r] * rs * gg[j];
            const int t = t_base + i * 16 + lk * 4 + r;
            if (do_rope) {
                const int prow = (t >> 6) & 63, pcol = t & 63;
                const float c0 = rope[prow * 16 + l15], s0 = rope[1024 + prow * 16 + l15];
                const float c1 = rope[pcol * 16 + l15], s1 = rope[1024 + pcol * 16 + l15];
                const float a0 = v[0] * c0 - v[1] * s0, a1 = v[1] * c0 + v[0] * s0;
                const float a2 = v[2] * c1 - v[3] * s1, a3 = v[3] * c1 + v[2] * s1;
                v[0] = a0; v[1] = a1; v[2] = a2; v[3] = a3;
            }
            unsigned char* d = dst + (size_t)(i * 16 + lk * 4 + r) * 64 + l15;
            const int w01 = __builtin_amdgcn_cvt_pk_fp8_f32(v[0], v[1], 0, false), w23 = __builtin_amdgcn_cvt_pk_fp8_f32(v[2], v[3], 0, false);
            d[0] = (unsigned char)w01; d[16] = (unsigned char)(w01 >> 8); d[32] = (unsigned char)w23; d[48] = (unsigned char)(w23 >> 8);
        }
    }
}
DI void tstore_epilogue(f32x4 (&acc)[4][4], bf16_t* __restrict__ dst  , size_t ld, int lane) {
    const int l15 = lane & 15, lk = lane >> 4;
#pragma unroll
    for (int i = 0; i < 4; ++i)
#pragma unroll
        for (int j = 0; j < 4; ++j)
            *(u32x2*)(dst + (size_t)(j * 16 + l15) * ld + i * 16 + lk * 4) = u32x2{pk2(acc[i][j][0], acc[i][j][1]), pk2(acc[i][j][2], acc[i][j][3])};
}

DI void phase_c(const Params& p, unsigned char* lds) {
    constexpr int NTM = BT / 256, NTN = INC / 256;
    constexpr int MAIN = NTM * NTN, TOTAL = MAIN + 8;
    const bf16_t* H = (const bf16_t*)(p.ws + WS_H);
    const bf16_t* HCp = (const bf16_t*)(p.ws + WS_HC);
    const bf16_t* WT = (const bf16_t*)(p.ws + WS_WTIN);
    const float* rope = (const float*)(p.ws + WS_ROPE);
    struct CTile { int tm, tn; bool ctx; RowLoader P, Q; };
    auto c_tile = [&](int it) {
        CTile t; t.ctx = false;
        if (it < MAIN) { const int g = it / (16 * NTN), rem = it % (16 * NTN); t.tn = rem >> 4; t.tm = g * 16 + (rem & 15); }
        else { t.ctx = true; t.tm = it - MAIN; t.tn = 2; }
        const bf16_t* A = t.ctx ? HCp + (size_t)t.tm * 256 * DM : H + (size_t)t.tm * 256 * DM;
        const bf16_t* W = WT + (size_t)t.tn * 256 * DM;
        if (t.tn >= 9) {
            t.P = RowLoader{(const bf16_t*)(p.ws + WS_W8G + (size_t)(t.tn * 256 - 2304) * DM), DM / 2}; t.Q = RowLoader{(const bf16_t*)(p.ws + WS_H8 + (size_t)t.tm * 256 * DM), DM / 2}; }
        else { t.P = RowLoader{A, DM}; t.Q = RowLoader{W, DM}; }
        return t;
    };
    bool pre = false;
    CTile cur = c_tile(blockIdx.x);
    for (int it = blockIdx.x; it < TOTAL; it += gridDim.x) {
        const int tid = get_tid(), lane = tid & 63, wave = tid >> 6, wa = wave >> 2, wb = wave & 3;
        const bool has2 = it + (int)gridDim.x < TOTAL;
        const CTile nx = c_tile(has2 ? it + (int)gridDim.x : it);
        const int tm = cur.tm, tn = cur.tn; const bool ctx = cur.ctx;
        f32x4 acc[4][4];
#pragma unroll
        for (int i = 0; i < 4; ++i)
#pragma unroll
            for (int j = 0; j < 4; ++j) acc[i][j] = f32x4{0.f, 0.f, 0.f, 0.f};
        int nk8 = DM / 128; asm volatile("" : "+s"(nk8));
        if (cur.tn >= 9) gemm_mainloop<4, RowLoader, RowLoader, true>(acc, cur.P, cur.Q, nk8, lds, pre, has2, nx.P, nx.Q);
        else gemm_mainloop<4>(acc, cur.P, cur.Q, DM / 64, lds, pre, has2, nx.P, nx.Q);
        pre = has2; cur = nx;
        if (tn >= 9) {
            unsigned char* st = lds + 64 * 1024;
            constexpr int GS = 272;
            const int l15 = lane & 15, lk = lane >> 4;
#pragma unroll
            for (int i = 0; i < 4; ++i)
#pragma unroll
                for (int j = 0; j < 4; ++j) {
                    unsigned q[4];
#pragma unroll
                    for (int r = 0; r < 4; ++r) q[r] = (unsigned)(255.f * __builtin_amdgcn_rcpf(1.f + __expf(acc[i][j][r] * (-1.f / W8_SCALE))) + 0.5f);
                    *(unsigned*)(st + (wb * 64 + j * 16 + l15) * GS + wa * 64 + i * 16 + lk * 4) = q[0] | (q[1] << 8) | (q[2] << 16) | (q[3] << 24);
                }
            __syncthreads();
            unsigned char* G8 = p.ws + WS_G + (size_t)tm * 256 * GC + (tn * 256 - 2304);
            const int t2 = get_tid();
#pragma unroll
            for (int q = 0; q < 4; ++q) {
                const int idx = t2 + q * NT, row = idx >> 4, ch = idx & 15;
                *(u32x4*)(G8 + (size_t)row * GC + ch * 16) = *(const u32x4*)(st + row * GS + ch * 16);
            }
            continue;
        }
        const int b = ctx ? tm : (tm >> 4);
        const int tpos = ctx ? SEQ + wa * 64 : ((tm & 15) * 256 + wa * 64);
        if (tn < 2) {
            const int h = tn * 4 + wb;
            unsigned char* Q = p.ws + WS_Q + ((size_t)(b * NH + h) * SEQ + tpos) * HD;
            head_epilogue(acc, p.in[I_QNG], 1.4426950408889634f, rope, true, tpos, Q, lane);
        } else if (tn == 2) {
            if (wb < 2) {
                unsigned char* K = p.ws + WS_KB + ((size_t)(b * NKV + wb) * TK + tpos) * HD;
                head_epilogue(acc, p.in[I_KNG], 1.f, rope, !ctx, tpos, K, lane);
            } else {
                unsigned char* V8 = p.ws + WS_VT + (size_t)(b * NKV + (wb - 2)) * HD * TK;
                const int l15 = lane & 15, lk = lane >> 4;
#pragma unroll
                for (int i = 0; i < 4; ++i) {
                    const int k = tpos + i * 16 + lk * 4, kin = k & 63, within = kin & 31;
                    const int pos = (k & ~63) + 32 * ((within >> 2) & 1) + 16 * (kin >> 5) + 4 * (within >> 3);
#pragma unroll
                    for (int j = 0; j < 4; ++j)
                        *(unsigned*)(V8 + (size_t)(j * 16 + l15) * TK + pos) = pk_fp8x4(acc[i][j][0] * VT_SCALE, acc[i][j][1] * VT_SCALE, acc[i][j][2] * VT_SCALE, acc[i][j][3] * VT_SCALE);
                }
            }
        } else {
            const int col = tn * 256 - 768 + wb * 64;
            bf16_t* Z = (bf16_t*)(p.ws + WS_ZT) + (size_t)col * BT + (size_t)b * SEQ + tpos;
            tstore_epilogue(acc, Z, BT, lane);
        }
    }
}

#define MFMA32(a, b, c) __builtin_amdgcn_mfma_f32_32x32x16_bf16((a), (b), (c), 0, 0, 0)
DI bf16x8 pack_step(const f32x16& x, int s) {
    u32x4 pk;
    asm volatile("v_cvt_pk_bf16_f32 %0, %4, %5\n\tv_cvt_pk_bf16_f32 %1, %6, %7\n\tv_cvt_pk_bf16_f32 %2, %8, %9\n\tv_cvt_pk_bf16_f32 %3, %10, %11\n\ts_nop 1"
                 : "=&v"(pk[0]), "=&v"(pk[1]), "=&v"(pk[2]), "=&v"(pk[3])
                 : "v"(x[8 * s]), "v"(x[8 * s + 1]), "v"(x[8 * s + 2]), "v"(x[8 * s + 3]), "v"(x[8 * s + 4]), "v"(x[8 * s + 5]), "v"(x[8 * s + 6]), "v"(x[8 * s + 7]));
    return __builtin_bit_cast(bf16x8, pk);
}

constexpr int AT_KSTR = 64, AT_VSTR = 64, AT_VOFF = 64 * AT_KSTR, AT_STAGE = AT_VOFF + 64 * AT_VSTR;
DI void attn_item(const Params& p, int item, unsigned char* lds) {
    const int tid = get_tid(), lane = tid & 63, wave = tid >> 6;
    const int b = item >> 6, kvh = (item >> 5) & 1, qb = item & 31;
    const int h = kvh * 4 + (wave >> 2), q0 = qb * 128 + (wave & 3) * 32;
    const int qi = lane & 31, hf = lane >> 5;
    const unsigned char* Qp = p.ws + WS_Q + ((size_t)(b * NH + h) * SEQ + q0 + qi) * HD + 32 * hf;
    const u32x4 q0v = *(const u32x4*)Qp, q1v = *(const u32x4*)(Qp + 16);
    const i32x8 qf = i32x8{(int)q0v[0], (int)q0v[1], (int)q0v[2], (int)q0v[3], (int)q1v[0], (int)q1v[1], (int)q1v[2], (int)q1v[3]};
    const unsigned char* Kg = p.ws + WS_KB + (size_t)(b * NKV + kvh) * TK * HD;
    const unsigned char* Vg = p.ws + WS_VT + (size_t)(b * NKV + kvh) * HD * TK;
    constexpr int NTILE = TK / 64;
    f32x16 o0, o1, o2;
#pragma unroll
    for (int i = 0; i < 16; ++i) { o0[i] = 0.f; o1[i] = 0.f; o2[i] = 0.f; }
    __syncthreads();
    constexpr int NSUB = 4, NSTG = NTILE / NSUB;
    static_assert(NTILE % NSUB == 0 && 2 * NSUB * AT_STAGE <= LDS_USER, "attention LDS stages");
    const int wv = __builtin_amdgcn_readfirstlane(tid >> 6);
    auto stage_issue = [&](int stg_idx, int buf) {
#pragma unroll
        for (int e = 0; e < 2; ++e) {
            const int q = 2 * wv + e, j = q >> 3, isV = (q >> 2) & 1, part = q & 3;
            const int row = 16 * part + (lane >> 2), c = (lane & 3) ^ ((row >> 2) & 3), tile = stg_idx * NSUB + j;
            const unsigned char* sp = isV ? Vg + (size_t)row * TK + (size_t)tile * 64 + c * 16 : Kg + ((size_t)tile * 64 + row) * HD + c * 16;
            __builtin_amdgcn_global_load_lds((const unsigned*)sp, (unsigned*)(lds + (buf * NSUB + j) * AT_STAGE + isV * AT_VOFF + part * 1024), 16, 0, 0);
        }
    };
    stage_issue(0, 0);
    asm volatile("s_waitcnt vmcnt(0)" ::: "memory");
    __syncthreads();
    const int sw = (qi >> 2) & 3;
    const int kc0 = qi * AT_KSTR + (((2 * hf) ^ sw) << 4), kc1 = qi * AT_KSTR + (((2 * hf + 1) ^ sw) << 4);
    for (int st = 0; st < NSTG; ++st) {
      const bool more = st + 1 < NSTG;
      if (more) stage_issue(st + 1, (st + 1) & 1);
#pragma unroll 1
      for (int j = 0; j < NSUB; ++j) {
        const unsigned char* cur = lds + ((st & 1) * NSUB + j) * AT_STAGE;
        f32x16 sA, sB;
        {
            f32x16 z;
#pragma unroll
            for (int i = 0; i < 16; ++i) z[i] = 0.f;
            const u32x4 ka0 = *(const u32x4*)(cur + kc0), ka1 = *(const u32x4*)(cur + kc1);
            const u32x4 kb0 = *(const u32x4*)(cur + kc0 + 32 * AT_KSTR), kb1 = *(const u32x4*)(cur + kc1 + 32 * AT_KSTR);
            const i32x8 kfa = i32x8{(int)ka0[0], (int)ka0[1], (int)ka0[2], (int)ka0[3], (int)ka1[0], (int)ka1[1], (int)ka1[2], (int)ka1[3]};
            const i32x8 kfb = i32x8{(int)kb0[0], (int)kb0[1], (int)kb0[2], (int)kb0[3], (int)kb1[0], (int)kb1[1], (int)kb1[2], (int)kb1[3]};
            __builtin_amdgcn_s_setprio(1);
            sA = __builtin_amdgcn_mfma_scale_f32_32x32x64_f8f6f4(kfa, qf, z, 0, 0, 0, 0x7F7F7F7F, 0, 0x7C7C7C7C);
            sB = __builtin_amdgcn_mfma_scale_f32_32x32x64_f8f6f4(kfb, qf, z, 0, 0, 0, 0x7F7F7F7F, 0, 0x7C7C7C7C);
            __builtin_amdgcn_s_setprio(0);
        }
#pragma unroll
        for (int i = 0; i < 16; ++i) sA[i] = __builtin_amdgcn_exp2f(sA[i]);
#pragma unroll
        for (int i = 0; i < 16; ++i) sB[i] = __builtin_amdgcn_exp2f(sB[i]);
        int pb[8];
#pragma unroll
        for (int v = 0; v < 8; ++v) {
            const f32x16& sx = (v >> 2) ? sB : sA;
            const int r0 = 4 * (v & 3);
            int w = __builtin_amdgcn_cvt_pk_bf8_f32(sx[r0], sx[r0 + 1], 0, false);
            w = __builtin_amdgcn_cvt_pk_bf8_f32(sx[r0 + 2], sx[r0 + 3], w, true);
            pb[v] = w;
        }
        const i32x8 pf = i32x8{pb[0], pb[1], pb[2], pb[3], pb[4], pb[5], pb[6], pb[7]};
#pragma unroll
        for (int db = 0; db < 2; ++db) {
            const unsigned char* vb = cur + AT_VOFF + db * 32 * AT_VSTR;
            const u32x4 a0 = *(const u32x4*)(vb + kc0), a1 = *(const u32x4*)(vb + kc1);
            const i32x8 vf = i32x8{(int)a0[0], (int)a0[1], (int)a0[2], (int)a0[3], (int)a1[0], (int)a1[1], (int)a1[2], (int)a1[3]};
            if (db == 0) o0 = __builtin_amdgcn_mfma_scale_f32_32x32x64_f8f6f4(vf, pf, o0, 0, 1, 0, 0x7F7F7F7F, 0, 0x7F7F7F7F);
            else         o1 = __builtin_amdgcn_mfma_scale_f32_32x32x64_f8f6f4(vf, pf, o1, 0, 1, 0, 0x7F7F7F7F, 0, 0x7F7F7F7F);
        }
        {
            const int one4 = 0x38383838;
            const i32x8 ones = i32x8{one4, one4, one4, one4, one4, one4, one4, one4};
            o2 = __builtin_amdgcn_mfma_scale_f32_32x32x64_f8f6f4(ones, pf, o2, 0, 1, 0, 0x7F7F7F7F, 0, 0x7F7F7F7F);
        }
      }
      asm volatile("s_waitcnt vmcnt(0)" ::: "memory");
      __syncthreads();
    }
    const float inv = (1.f / VT_SCALE) / o2[0];
    bf16_t* O;
    {
        const int t2 = get_tid(), lane2 = t2 & 63, wave2 = t2 >> 6;
        const int h2 = kvh * 4 + (wave2 >> 2), q2 = qb * 128 + (wave2 & 3) * 32 + (lane2 & 31);
        O = (bf16_t*)(p.ws + WS_ATT) + ((size_t)b * SEQ + q2) * QD + h2 * HD + 4 * (lane2 >> 5);
    }
#pragma unroll
    for (int g4 = 0; g4 < 4; ++g4) {
        *(u32x2*)(O + 8 * g4)      = u32x2{pk2(o0[4 * g4] * inv, o0[4 * g4 + 1] * inv), pk2(o0[4 * g4 + 2] * inv, o0[4 * g4 + 3] * inv)};
        *(u32x2*)(O + 32 + 8 * g4) = u32x2{pk2(o1[4 * g4] * inv, o1[4 * g4 + 1] * inv), pk2(o1[4 * g4 + 2] * inv, o1[4 * g4 + 3] * inv)};
    }
}

constexpr int HY_USTR = 8208, HY_R = 8 * HY_USTR, HY_RSTR = 16384 + 64;
DI void hy_load_filter(const bf16_t* __restrict__ R, unsigned char* lds, int tid) {
    const int i0 = tid * 8;
    const u32x4 w = *(const u32x4*)(R + i0);
    u32x2 nx = u32x2{0u, 0u};
    if (i0 + 8 < 8192) nx = *(const u32x2*)(R + i0 + 8);
    unsigned char* d = lds + HY_R + i0 * 2;
    *(u32x4*)(d) = w;
    *(u32x4*)(d + HY_RSTR) = u32x4{__builtin_amdgcn_alignbit(w[1], w[0], 16), __builtin_amdgcn_alignbit(w[2], w[1], 16), __builtin_amdgcn_alignbit(w[3], w[2], 16), __builtin_amdgcn_alignbit(nx[0], w[3], 16)};
    *(u32x4*)(d + 2 * HY_RSTR) = u32x4{w[1], w[2], w[3], nx[0]};
    *(u32x4*)(d + 3 * HY_RSTR) = u32x4{__builtin_amdgcn_alignbit(w[2], w[1], 16), __builtin_amdgcn_alignbit(w[3], w[2], 16), __builtin_amdgcn_alignbit(nx[0], w[3], 16), __builtin_amdgcn_alignbit(nx[1], nx[0], 16)};
}
DI void short_conv4(const bf16_t* __restrict__ zrow  , int t4, float w0, float w1, float w2, float bias, float (&out)[4]) {
    const u32x2 v = *(const u32x2*)(zrow + t4);
    const float z0 = bflo(v[0]), z1 = bfhi(v[0]), z2 = bflo(v[1]), z3 = bfhi(v[1]);
    const float zm = (t4 > 0) ? bf2f(zrow[t4 - 1]) : 0.f;
    const float zp = (t4 + 4 < SEQ) ? bf2f(zrow[t4 + 4]) : 0.f;
    out[0] = zm * w0 + z0 * w1 + z1 * w2 + bias;
    out[1] = z0 * w0 + z1 * w1 + z2 * w2 + bias;
    out[2] = z1 * w0 + z2 * w1 + z3 * w2 + bias;
    out[3] = z2 * w0 + z3 * w1 + zp * w2 + bias;
}
DI void hyena_item(const Params& p, int c, unsigned char* lds) {
    const int tid = get_tid(), lane = tid & 63, ig = tid >> 6;
    const bf16_t* ZT = (const bf16_t*)(p.ws + WS_ZT);
    const float* cw = p.in[I_HCW];
    const float* cb = p.in[I_HCB];
    __syncthreads();
    {
        const int b = tid >> 7, tb = (tid & 127) * 32;
        const bf16_t* zrow = ZT + (size_t)c * BT + (size_t)b * SEQ;
        const float w0 = cw[c], w1 = cw[HYC + c], w2 = cw[2 * HYC + c], bias = cb[c];
#pragma unroll
        for (int q = 0; q < 8; ++q) {
            float o[4];
            short_conv4(zrow, tb + 4 * q, w0, w1, w2, bias, o);
            *(u32x2*)(lds + b * HY_USTR + (tb + 4 * q) * 2) = u32x2{pk2(o[0], o[1]), pk2(o[2], o[3])};
        }
    }
    const int r = lane & 31, hf = lane >> 5, Il = r >> 3, bb = r & 7;
#pragma unroll 1
    for (int o = 0; o < 2; ++o) {
        hy_load_filter((const bf16_t*)(p.ws + WS_R) + (size_t)(o * 512 + c) * 8192, lds, tid);
        __syncthreads();
        f32x16 acc0, acc1;
#pragma unroll
        for (int i = 0; i < 16; ++i) { acc0[i] = 0.f; acc1[i] = 0.f; }
        const int sh = (-r) & 3;
        const unsigned char* abase = lds + HY_R + sh * HY_RSTR + (4096 + 8 * hf - r - sh) * 2 - 64;
        const unsigned char* ubase = lds + bb * HY_USTR + ((4 * ig + Il) * 64 + 8 * hf) * 2;
#define HY_STEP(MASKED) do { \
            const unsigned char* ap = abase - 128 * d; \
            const unsigned char* ub = ubase - 128 * d; \
            bool valid = true; \
            if (MASKED) { const int J = 4 * ig + Il - d; valid = (unsigned)J < 64u; if (!valid) ub = lds; } \
            _Pragma("unroll") for (int ks = 0; ks < 4; ++ks) { \
                u32x4 braw = *(const u32x4*)(ub + ks * 32); \
                if (MASKED) { if (!valid) braw = u32x4{0u, 0u, 0u, 0u}; } \
                const bf16x8 bf = __builtin_bit_cast(bf16x8, braw); \
                { const s16x4 lo = lds_rd64(ap + 32 * ks + 64), hi = lds_rd64(ap + 32 * ks + 72);     \
                  acc0 = MFMA32(__builtin_shufflevector(lo, hi, 0, 1, 2, 3, 4, 5, 6, 7), bf, acc0); } \
                { const s16x4 lo = lds_rd64(ap + 32 * ks), hi = lds_rd64(ap + 32 * ks + 8); \
                  acc1 = MFMA32(__builtin_shufflevector(lo, hi, 0, 1, 2, 3, 4, 5, 6, 7), bf, acc1); } \
            } } while (0)
        const int dlo = 4 * ig - 63, dhi = 4 * ig + 3;
#pragma unroll 1
        for (int d = dlo; d < dlo + 3; ++d) HY_STEP(true);
#pragma unroll 1
        for (int d = dlo + 3; d <= dhi - 3; ++d) HY_STEP(false);
        if (SHADOW == 6) {
            f32x16 s0 = acc0, s1 = acc1;
            const bf16x8 fa = *(const bf16x8*)(lds + lane * 16), fb = *(const bf16x8*)(lds + 4096 + lane * 16);
#pragma unroll 1
            for (int d = 0; d < 67; ++d) {
#pragma unroll
                for (int ks = 0; ks < 4; ++ks) { s0 = MFMA32(fa, fb, s0); s1 = MFMA32(fa, fb, s1); }
            }
            asm volatile("" :: "v"(s0), "v"(s1));
        }
        if (SHADOW == 7) {
            f32x16 k0 = acc0, k1 = acc1;
#pragma unroll 1
            for (int d = dlo + 3; d <= dhi - 3 + 6; ++d) {
                const unsigned char* ap = abase - 128 * (d > dhi - 3 ? dhi - 3 : d);
                const unsigned char* ub = ubase - 128 * (d > dhi - 3 ? dhi - 3 : d);
#pragma unroll
                for (int ks = 0; ks < 4; ++ks) {
                    const bf16x8 bf = *(const bf16x8*)(ub + ks * 32);
                    { const s16x4 lo = lds_rd64(ap + 32 * ks + 64), hi = lds_rd64(ap + 32 * ks + 72); k0 = MFMA32(__builtin_shufflevector(lo, hi, 0, 1, 2, 3, 4, 5, 6, 7), bf, k0); }
                    { const s16x4 lo = lds_rd64(ap + 32 * ks), hi = lds_rd64(ap + 32 * ks + 8); k1 = MFMA32(__builtin_shufflevector(lo, hi, 0, 1, 2, 3, 4, 5, 6, 7), bf, k1); }
                }
            }
            asm volatile("" :: "v"(k0), "v"(k1));
        }
#pragma unroll 1
        for (int d = dhi - 2; d <= dhi; ++d) HY_STEP(true);
#undef HY_STEP
        __syncthreads();
        const float skip = p.in[I_HSKIP][o * HYD + c];
        const int gcol = (o == 0 ? 512 : 1024) + c;
        const float w0 = cw[gcol], w1 = cw[HYC + gcol], w2 = cw[2 * HYC + gcol], bias = cb[gcol];
        const bf16_t* zrow = ZT + (size_t)gcol * BT + (size_t)bb * SEQ;
        bf16_t* hyt = (bf16_t*)(p.ws + WS_HYT) + (size_t)c * 128 + (size_t)bb * (SEQ / 128) * (512 * 128);
#pragma unroll
        for (int mm = 0; mm < 2; ++mm) {
#pragma unroll
            for (int g4 = 0; g4 < 4; ++g4) {
                const int t4 = (4 * ig + Il) * 64 + 32 * mm + 8 * g4 + 4 * hf;
                float gt[4];
                short_conv4(zrow, t4, w0, w1, w2, bias, gt);
                unsigned char* up = lds + bb * HY_USTR + t4 * 2;
                const u32x2 uv = *(const u32x2*)up;
                const float u0 = bflo(uv[0]), u1 = bfhi(uv[0]), u2 = bflo(uv[1]), u3 = bfhi(uv[1]);
                const f32x16& a = mm ? acc1 : acc0;
                const float y0 = gt[0] * (a[4 * g4] + skip * u0), y1 = gt[1] * (a[4 * g4 + 1] + skip * u1);
                const float y2 = gt[2] * (a[4 * g4 + 2] + skip * u2), y3 = gt[3] * (a[4 * g4 + 3] + skip * u3);
                const u32x2 pk = u32x2{pk2(y0, y1), pk2(y2, y3)};
                if (o == 0) *(u32x2*)up = pk; else *(u32x2*)(hyt + (size_t)(t4 >> 7) * (512 * 128) + (t4 & 127)) = pk;
            }
        }
        __syncthreads();
    }
}

constexpr int HY8_USTR = 4112, HY8_R = 8 * HY8_USTR, HY8_RSTR = 8192 + 32;
constexpr float HY8_US = 16.f;
DI void hy8_load_filter(const unsigned char* __restrict__ R, unsigned char* lds, int tid) {
    const int i0 = tid * 8;
    const unsigned long long lo = *(const unsigned long long*)(R + i0);
    unsigned long long hi = 0ull;
    if (i0 + 8 < 8192) hi = *(const unsigned long long*)(R + i0 + 8);
    unsigned char* d = lds + HY8_R + i0;
    *(unsigned long long*)d = lo;
#pragma unroll
    for (int sft = 1; sft < 8; ++sft) *(unsigned long long*)(d + sft * HY8_RSTR) = (lo >> (8 * sft)) | (hi << (64 - 8 * sft));
}
DI void hyena_item8(const Params& p, int c, unsigned char* lds) {
    const int tid = get_tid(), lane = tid & 63, ig = tid >> 6;
    const bf16_t* ZT = (const bf16_t*)(p.ws + WS_ZT);
    const float* cw = p.in[I_HCW];
    const float* cb = p.in[I_HCB];
    __syncthreads();
    {
        const int b = tid >> 7, tb = (tid & 127) * 32;
        const bf16_t* zrow = ZT + (size_t)c * BT + (size_t)b * SEQ;
        const float w0 = cw[c], w1 = cw[HYC + c], w2 = cw[2 * HYC + c], bias = cb[c];
        unsigned w8[8];
#pragma unroll
        for (int q = 0; q < 8; ++q) {
            float o[4];
            short_conv4(zrow, tb + 4 * q, w0, w1, w2, bias, o);
            w8[q] = pk_fp8x4(o[0] * HY8_US, o[1] * HY8_US, o[2] * HY8_US, o[3] * HY8_US);
        }
        *(u32x4*)(lds + b * HY8_USTR + tb) = u32x4{w8[0], w8[1], w8[2], w8[3]};
        *(u32x4*)(lds + b * HY8_USTR + tb + 16) = u32x4{w8[4], w8[5], w8[6], w8[7]};
    }
    const int r = lane & 31, hf = lane >> 5, Il = r >> 3, bb = r & 7;
#pragma unroll 1
    for (int o = 0; o < 2; ++o) {
        hy8_load_filter(p.ws + WS_R + (size_t)(o * 512 + c) * 8192, lds, tid);
        __syncthreads();
        f32x16 acc0, acc1;
#pragma unroll
        for (int i = 0; i < 16; ++i) { acc0[i] = 0.f; acc1[i] = 0.f; }
        const int sh = (-r) & 7;
        const unsigned char* abase = lds + HY8_R + sh * HY8_RSTR + (4096 + 32 * hf - r - sh) - 32;
        const unsigned char* ubase = lds + bb * HY8_USTR + (4 * ig + Il) * 64 + 32 * hf;
#define HY8_STEP(MASKED) do { \
            const unsigned char* ap = abase - 64 * d; \
            const unsigned char* ub = ubase - 64 * d; \
            bool valid = true; \
            if (MASKED) { const int J = 4 * ig + Il - d; valid = (unsigned)J < 64u; if (!valid) ub = lds; } \
            u32x4 b0 = *(const u32x4*)(ub), b1 = *(const u32x4*)(ub + 16); \
            if (MASKED) { if (!valid) { b0 = u32x4{0u, 0u, 0u, 0u}; b1 = b0; } } \
            const i32x8 bf = i32x8{(int)b0[0], (int)b0[1], (int)b0[2], (int)b0[3], (int)b1[0], (int)b1[1], (int)b1[2], (int)b1[3]}; \
            { const s16x4 q0 = lds_rd64(ap + 32), q1 = lds_rd64(ap + 40), q2 = lds_rd64(ap + 48), q3 = lds_rd64(ap + 56); \
              const u32x2 e0 = __builtin_bit_cast(u32x2, q0), e1 = __builtin_bit_cast(u32x2, q1), e2 = __builtin_bit_cast(u32x2, q2), e3 = __builtin_bit_cast(u32x2, q3); \
              acc0 = MFMA8((i32x8{(int)e0[0], (int)e0[1], (int)e1[0], (int)e1[1], (int)e2[0], (int)e2[1], (int)e3[0], (int)e3[1]}), bf, acc0); } \
            { const s16x4 q0 = lds_rd64(ap), q1 = lds_rd64(ap + 8), q2 = lds_rd64(ap + 16), q3 = lds_rd64(ap + 24); \
              const u32x2 e0 = __builtin_bit_cast(u32x2, q0), e1 = __builtin_bit_cast(u32x2, q1), e2 = __builtin_bit_cast(u32x2, q2), e3 = __builtin_bit_cast(u32x2, q3); \
              acc1 = MFMA8((i32x8{(int)e0[0], (int)e0[1], (int)e1[0], (int)e1[1], (int)e2[0], (int)e2[1], (int)e3[0], (int)e3[1]}), bf, acc1); } \
            } while (0)
        const int dlo = 4 * ig - 63, dhi = 4 * ig + 3;
#pragma unroll 1
        for (int d = dlo; d < dlo + 3; ++d) HY8_STEP(true);
#pragma unroll 1
        for (int d = dlo + 3; d <= dhi - 3; ++d) HY8_STEP(false);
#pragma unroll 1
        for (int d = dhi - 2; d <= dhi; ++d) HY8_STEP(true);
#undef HY8_STEP
        __syncthreads();
        const float skip = p.in[I_HSKIP][o * HYD + c];
        const float asc = ((const float*)(p.ws + WS_FSC))[o * 512 + c] * (1.f / HY8_US);
        const int gcol = (o == 0 ? 512 : 1024) + c;
        const float w0 = cw[gcol], w1 = cw[HYC + gcol], w2 = cw[2 * HYC + gcol], bias = cb[gcol];
        const bf16_t* zrow = ZT + (size_t)gcol * BT + (size_t)bb * SEQ;
        bf16_t* hyt = (bf16_t*)(p.ws + WS_HYT) + (size_t)c * 128 + (size_t)bb * (SEQ / 128) * (512 * 128);
#pragma unroll
        for (int mm = 0; mm < 2; ++mm) {
#pragma unroll
            for (int g4 = 0; g4 < 4; ++g4) {
                const int t4 = (4 * ig + Il) * 64 + 32 * mm + 8 * g4 + 4 * hf;
                float gt[4];
                short_conv4(zrow, t4, w0, w1, w2, bias, gt);
                unsigned* up = (unsigned*)(lds + bb * HY8_USTR + t4);
                const unsigned uv = *up;
                const f32x2 ul = __builtin_amdgcn_cvt_pk_f32_fp8((int)uv, false), uh = __builtin_amdgcn_cvt_pk_f32_fp8((int)uv, true);
                const float us = skip * (1.f / HY8_US);
                const f32x16& a = mm ? acc1 : acc0;
                const float y0 = gt[0] * (a[4 * g4] * asc + us * ul[0]), y1 = gt[1] * (a[4 * g4 + 1] * asc + us * ul[1]);
                const float y2 = gt[2] * (a[4 * g4 + 2] * asc + us * uh[0]), y3 = gt[3] * (a[4 * g4 + 3] * asc + us * uh[1]);
                if (o == 0) *up = pk_fp8x4(y0 * HY8_US, y1 * HY8_US, y2 * HY8_US, y3 * HY8_US);
                else *(u32x2*)(hyt + (size_t)(t4 >> 7) * (512 * 128) + (t4 & 127)) = u32x2{pk2(y0, y1), pk2(y2, y3)};
            }
        }
        __syncthreads();
    }
}

constexpr int CTL_QUEUE_D = 8192;
DI void phase_d(const Params& p, unsigned char* lds) {
    unsigned* ctr = (unsigned*)(p.ws + WS_CTL) + CTL_QUEUE_D;
    volatile LAS unsigned* slot = (volatile LAS unsigned*)(LAS unsigned char*)(lds + LDS_ST_OFF + 8);
    for (;;) {
        __syncthreads();
        if (get_tid() == 0) slot[0] = atomicAdd(ctr, 1u);
        __syncthreads();
        const int it = __builtin_amdgcn_readfirstlane((int)slot[0]);
        if (it >= 1024) break;
        if (it < 512) hyena_item8(p, it, lds); else attn_item(p, it - 512, lds);
    }
}

DI void phase_d2(const Params& p, unsigned char* lds) {
    constexpr int TILES = 8 * (BT / 256);
    const bf16_t* HYT = (const bf16_t*)(p.ws + WS_HYT);
    bf16_t* HY = (bf16_t*)(p.ws + WS_HY);
    for (int it = blockIdx.x; it < TILES; it += gridDim.x) {
        const int tid = get_tid();
        const int c0 = (it & 7) * 64, tok0 = (it >> 3) * 256;
        __syncthreads();
#pragma unroll
        for (int i = 0; i < 2; ++i) {
            const int idx = tid + i * NT, c = idx >> 5, tg = idx & 31;
            *(u32x4*)(lds + c * 528 + tg * 16) = *(const u32x4*)(HYT + (size_t)(c0 + c) * BT + tok0 + tg * 8);
        }
        __syncthreads();
#pragma unroll
        for (int i = 0; i < 2; ++i) {
            const int idx = tid + i * NT, tok = idx >> 3, cg = idx & 7;
            unsigned w[4];
#pragma unroll
            for (int e = 0; e < 4; ++e) {
                const unsigned lo = *(const unsigned short*)(lds + (cg * 8 + 2 * e) * 528 + tok * 2);
                const unsigned hi = *(const unsigned short*)(lds + (cg * 8 + 2 * e + 1) * 528 + tok * 2);
                w[e] = lo | (hi << 16);
            }
            *(u32x4*)(HY + (size_t)(tok0 + tok) * HYD + c0 + cg * 8) = u32x4{w[0], w[1], w[2], w[3]};
        }
    }
}

DI void phase_e(const Params& p, unsigned char* lds) {
    constexpr int TILES = 4 * (BT / 128);
    bool pre = false;
    unsigned char* es = lds + 48 * 1024;
    for (int it = blockIdx.x; it < TILES; it += gridDim.x) {
        const int tid = get_tid(), lane = tid & 63, wave = tid >> 6, wp = wave >> 2, wq = wave & 3;
        const int tn = it & 3, tm = it >> 2;
        const int n0 = tn * 256, tok0 = tm * 128;
        const int it2 = it + (int)gridDim.x; const bool has2 = it2 < TILES;
        const int n2 = (has2 ? it2 & 3 : tn) * 256, tk2 = (has2 ? it2 >> 2 : tm) * 128;
        f32x4 acc1[4][2], acc2[4][2];
#pragma unroll
        for (int i = 0; i < 4; ++i)
#pragma unroll
            for (int j = 0; j < 2; ++j) { acc1[i][j] = f32x4{0.f, 0.f, 0.f, 0.f}; acc2[i][j] = f32x4{0.f, 0.f, 0.f, 0.f}; }
        {
            const RowLoader p1{(const bf16_t*)(p.ws + WS_WTAO) + (size_t)n0 * QD, QD}, q1{(const bf16_t*)(p.ws + WS_ATT) + (size_t)tok0 * QD, QD};
            const RowLoader p2{(const bf16_t*)(p.ws + WS_WTHO) + (size_t)n0 * HYD, HYD};
            const ColLoader q2{(const bf16_t*)(p.ws + WS_HYT) + (size_t)tm * (512 * 128), (size_t)128};
            const RowLoader p1n{(const bf16_t*)(p.ws + WS_WTAO) + (size_t)n2 * QD, QD}, q1n{(const bf16_t*)(p.ws + WS_ATT) + (size_t)tk2 * QD, QD};
            gemm_mainloop<2, RowLoader, ColLoader>(acc1, p1, q1, QD / 64, lds, pre, true, p2, q2);
            gemm_mainloop<2, ColLoader, RowLoader>(acc2, p2, q2, HYD / 64, lds, true, has2, p1n, q1n);
            pre = has2;
        }
        const unsigned char* G8 = p.ws + WS_G;
        bf16_t* M = (bf16_t*)(p.ws + WS_H);
        constexpr int ES = 528, GS = 272, EG2 = 128 * GS;
        __syncthreads();
        {
            u32x4 ga[2], gh[2];
#pragma unroll
            for (int q = 0; q < 2; ++q) {
                const int idx = tid + q * NT, row = idx >> 4, ch = idx & 15;
                const unsigned char* gp = G8 + (size_t)(tok0 + row) * GC + n0 + ch * 16;
                ga[q] = *(const u32x4*)gp; gh[q] = *(const u32x4*)(gp + 1024);
            }
#pragma unroll
            for (int q = 0; q < 2; ++q) {
                const int idx = tid + q * NT, row = idx >> 4, ch = idx & 15;
                *(u32x4*)(es + row * GS + ch * 16) = ga[q]; *(u32x4*)(es + EG2 + row * GS + ch * 16) = gh[q];
            }
        }
        __syncthreads();
        const int l15 = lane & 15, lk = lane >> 4;
        u32x2 mo[4][2];
#pragma unroll
        for (int i = 0; i < 4; ++i)
#pragma unroll
            for (int j = 0; j < 2; ++j) {
                const int off = (wq * 32 + j * 16 + l15) * GS + wp * 64 + i * 16 + lk * 4;
                const unsigned ga = *(const unsigned*)(es + off), gh = *(const unsigned*)(es + EG2 + off);
                constexpr float K = 1.f / 255.f;
                const float m0 = K * ((float)(ga & 255u) * acc1[i][j][0] + (float)(gh & 255u) * acc2[i][j][0]);
                const float m1 = K * ((float)((ga >> 8) & 255u) * acc1[i][j][1] + (float)((gh >> 8) & 255u) * acc2[i][j][1]);
                const float m2 = K * ((float)((ga >> 16) & 255u) * acc1[i][j][2] + (float)((gh >> 16) & 255u) * acc2[i][j][2]);
                const float m3 = K * ((float)(ga >> 24) * acc1[i][j][3] + (float)(gh >> 24) * acc2[i][j][3]);
                mo[i][j] = u32x2{pk2(m0, m1), pk2(m2, m3)};
            }
        __syncthreads();
#pragma unroll
        for (int i = 0; i < 4; ++i)
#pragma unroll
            for (int j = 0; j < 2; ++j) *(u32x2*)(es + (wq * 32 + j * 16 + l15) * ES + (wp * 64 + i * 16 + lk * 4) * 2) = mo[i][j];
        __syncthreads();
#pragma unroll
        for (int q = 0; q < 4; ++q) {
            const int idx = tid + q * NT, row = idx >> 5, ch = idx & 31;
            *(u32x4*)(M + (size_t)(tok0 + row) * DM + n0 + ch * 8) = *(const u32x4*)(es + row * ES + ch * 16);
        }
    }
}

DI void phase_f(const Params& p, unsigned char* lds) {
    constexpr int TILES = 4 * (BT / 256);
    const float* mod = (const float*)(p.ws + WS_MOD);
    for (int it = blockIdx.x; it < TILES; it += gridDim.x) {
        const int tid = get_tid(), lane = tid & 63, wave = tid >> 6, wp = wave >> 2, wq = wave & 3;
        const int tn = it & 3, tm = it >> 2;
        const int n0 = tn * 256, tok0 = tm * 256, b = tok0 >> 12;
        f32x4 acc[4][4];
#pragma unroll
        for (int i = 0; i < 4; ++i)
#pragma unroll
            for (int j = 0; j < 4; ++j) acc[i][j] = f32x4{0.f, 0.f, 0.f, 0.f};
        gemm_mainloop<4>(acc, RowLoader{(const bf16_t*)(p.ws + WS_WTO) + (size_t)n0 * DM, DM}, RowLoader{(const bf16_t*)(p.ws + WS_H) + (size_t)tok0 * DM, DM}, DM / 64, lds);
        const int l15 = lane & 15, lk = lane >> 4;
        constexpr int ES = 528;
        float ss[4] = {0.f, 0.f, 0.f, 0.f};
#pragma unroll
        for (int i = 0; i < 4; ++i) {
            const int n = n0 + wp * 64 + i * 16 + lk * 4;
            const f32x4 g1 = *(const f32x4*)(mod + b * 6144 + 2048 + n);
            const f32x4 s2 = *(const f32x4*)(mod + b * 6144 + 4096 + n), gf = *(const f32x4*)(p.in[I_NFFN] + n);
            const f32x4 gm = f32x4{gf[0] * (1.f + s2[0]), gf[1] * (1.f + s2[1]), gf[2] * (1.f + s2[2]), gf[3] * (1.f + s2[3])};
#pragma unroll
            for (int j = 0; j < 4; ++j) {
                const int tl = wq * 64 + j * 16 + l15;
                const f32x4 xv = *(const f32x4*)(p.in[I_X] + (size_t)(tok0 + tl) * DM + n);
                const f32x4 x1 = f32x4{xv[0] + g1[0] * acc[i][j][0], xv[1] + g1[1] * acc[i][j][1], xv[2] + g1[2] * acc[i][j][2], xv[3] + g1[3] * acc[i][j][3]};
                *(u32x2*)((bf16_t*)(p.out + (size_t)(tok0 + tl) * DM) + n) = u32x2{pk2(x1[0], x1[1]), pk2(x1[2], x1[3])};
                ss[j] += x1[0] * x1[0] + x1[1] * x1[1] + x1[2] * x1[2] + x1[3] * x1[3];
                *(u32x2*)(lds + tl * ES + (wp * 64 + i * 16 + lk * 4) * 2) = u32x2{pk2(x1[0] * gm[0], x1[1] * gm[1]), pk2(x1[2] * gm[2], x1[3] * gm[3])};
            }
        }
#pragma unroll
        for (int j = 0; j < 4; ++j) {
            const float t = sum_x32(sum_x16(ss[j]));
            if (lk == 0) ((float*)(p.ws + WS_SSQ1))[(size_t)(tok0 + wq * 64 + j * 16 + l15) * 16 + tn * 4 + wp] = t;
        }
        __syncthreads();
        bf16_t* Y = (bf16_t*)(p.ws + WS_Y);
#pragma unroll
        for (int q = 0; q < 8; ++q) {
            const int idx = tid + q * NT, row = idx >> 5, ch = idx & 31;
            *(u32x4*)(Y + (size_t)(tok0 + row) * DM + n0 + ch * 8) = *(const u32x4*)(lds + row * ES + ch * 16);
        }
    }
}

DI void ins16(float (&L)[16], float v) {
#pragma unroll
    for (int i = 0; i < 16; ++i) { const float hi = fmaxf(L[i], v); v = fminf(L[i], v); L[i] = hi; }
}
DI void cex_desc(float& a, float& b) { const float hi = fmaxf(a, b), lo = fminf(a, b); a = hi; b = lo; }
DI void bitonic_merge16_desc(float (&v)[16]) {
#pragma unroll
    for (int j = 8; j > 0; j >>= 1)
#pragma unroll
        for (int i = 0; i < 16; ++i) if ((i ^ j) > i) cex_desc(v[i], v[i ^ j]);
}
DI void sort16_desc(float (&v)[16]) {
#pragma unroll
    for (int p = 1; p < 16; p <<= 1)
#pragma unroll
        for (int k = p; k >= 1; k >>= 1)
#pragma unroll
            for (int j = k % p; j <= 15 - k; j += 2 * k)
#pragma unroll
                for (int i = 0; i <= (k - 1 < 15 - j - k ? k - 1 : 15 - j - k); ++i)
                    if ((i + j) / (2 * p) == (i + j + k) / (2 * p)) cex_desc(v[i + j], v[i + j + k]);
}
DI void top16_merge(float (&a)[16], const float (&b)[16]) {
#pragma unroll
    for (int i = 0; i < 16; ++i) a[i] = fmaxf(a[i], b[15 - i]);
    bitonic_merge16_desc(a);
}
DI float pack_idx(float v, unsigned idx, unsigned mask) { return __uint_as_float((__float_as_uint(v) & ~mask) | idx); }
DI void peer_h2_item(const Params& p, int item) {
    const int tok0 = item * 128;
    const int tid = get_tid(), lane = tid & 63, wave = tid >> 6, b = tok0 >> 12;
    const float* sh2 = (const float*)(p.ws + WS_MOD) + b * 6144 + 3072 + lane * 16;
    float sh[16];
#pragma unroll
    for (int i = 0; i < 16; i += 4) { const f32x4 v = *(const f32x4*)(sh2 + i); sh[i] = v[0]; sh[i + 1] = v[1]; sh[i + 2] = v[2]; sh[i + 3] = v[3]; }
    u32x4 ny0, ny1; float nsq;
#define S0_LOAD(tk) do { const bf16_t* yr_ = (const bf16_t*)(p.ws + WS_Y) + (size_t)(tk) * DM + lane * 16; ny0 = *(const u32x4*)yr_; ny1 = *(const u32x4*)(yr_ + 8); \
        nsq = ((const float*)(p.ws + WS_SSQ1))[(size_t)(tk) * 16 + (lane & 15)]; } while (0)
    S0_LOAD(tok0 + wave * 8);
#pragma unroll 1
    for (int t = 0; t < 8; ++t) {
        const int tok = tok0 + wave * 8 + t;
        const u32x4 y0 = ny0, y1 = ny1;
        const float sq1 = nsq;
        if (t + 1 < 8) S0_LOAD(tok + 1);
        const float rs = rsqrtf(sum16(sq1) * (1.f / DM) + EPS);
        float f[16];
#pragma unroll
        for (int q = 0; q < 4; ++q) { f[2 * q] = bflo(y0[q]); f[2 * q + 1] = bfhi(y0[q]); f[8 + 2 * q] = bflo(y1[q]); f[9 + 2 * q] = bfhi(y1[q]); }
        float mx = 0.f;
#pragma unroll
        for (int i = 0; i < 16; ++i) { f[i] = rs * f[i] + sh[i]; mx = fmaxf(mx, fabsf(f[i])); }
        mx = fmaxf(wave_max(mx), 1e-30f);
        const float qs = X8_MAX / mx;
        int w8[4];
#pragma unroll
        for (int q = 0; q < 4; ++q) {
            w8[q] = __builtin_amdgcn_cvt_pk_fp8_f32(f[4 * q] * qs, f[4 * q + 1] * qs, 0, false);
            w8[q] = __builtin_amdgcn_cvt_pk_fp8_f32(f[4 * q + 2] * qs, f[4 * q + 3] * qs, w8[q], true);
        }
        *(u32x4*)(p.ws + WS_X8 + (size_t)tok * DM + lane * 16) = u32x4{(unsigned)w8[0], (unsigned)w8[1], (unsigned)w8[2], (unsigned)w8[3]};
        if (lane == 0) ((float*)(p.ws + WS_SX))[tok] = mx * (1.f / X8_MAX);
    }
#undef S0_LOAD
}
DI void peer_scores_top16(const bf16x8 (&bq)[8], const bf16_t* keysU  , int r, int hf, float (&L)[16]) {
    const unsigned ko = (unsigned)((8 * hf + r * 128) * 2);
    f32x16 acc[4];
#pragma unroll
    for (int m = 0; m < 4; ++m)
#pragma unroll
        for (int i = 0; i < 16; ++i) acc[m][i] = 0.f;
#pragma unroll
    for (int ks = 0; ks < 8; ++ks) {
#pragma unroll
        for (int m = 0; m < 4; ++m) {
            const bf16x8 ak = *(const bf16x8*)((const char*)keysU + (ko + (unsigned)(m * 8192)) + ks * 32);
            acc[m] = MFMA32(ak, bq[ks], acc[m]);
        }
    }
    float V[4][16];
#define PK_SORT(m) do { _Pragma("unroll") for (int i = 0; i < 16; ++i) V[m][i] = pack_idx(acc[m][i], (unsigned)((m) * 32 + (i & 3) + 8 * (i >> 2) + 4 * hf), 127u); sort16_desc(V[m]); } while (0)
    PK_SORT(0); PK_SORT(1); top16_merge(V[0], V[1]); __builtin_amdgcn_sched_barrier(0);
    PK_SORT(2); PK_SORT(3); top16_merge(V[2], V[3]); __builtin_amdgcn_sched_barrier(0);
    top16_merge(V[0], V[2]);
#undef PK_SORT
    const int hf3 = (get_tid() >> 5) & 1;
    float P[16];
#pragma unroll
    for (int i = 0; i < 16; ++i) {
        auto sw = __builtin_amdgcn_permlane32_swap(__float_as_uint(V[0][i]), __float_as_uint(V[0][i]), false, false);
        P[i] = hf3 ? __uint_as_float(sw[0]) : __uint_as_float(sw[1]);
    }
    top16_merge(V[0], P);
#pragma unroll
    for (int i = 0; i < 16; ++i) L[i] = V[0][i];
}
DI void peer_pick(const Params& p, const float* l1, const float* l2, int tokg, int h) {
    float v1[16], v2[16];
#pragma unroll
    for (int i = 0; i < 16; i += 4) {
        const f32x4 a = *(const f32x4*)(l1 + i), b = *(const f32x4*)(l2 + i);
        v1[i] = a[0]; v1[i + 1] = a[1]; v1[i + 2] = a[2]; v1[i + 3] = a[3];
        v2[i] = b[0]; v2[i + 1] = b[1]; v2[i + 2] = b[2]; v2[i + 3] = b[3];
    }
    float B[16];
#pragma unroll
    for (int i = 0; i < 16; ++i) B[i] = -3.0e38f;
#pragma unroll
    for (int i = 0; i < 16; ++i)
#pragma unroll
        for (int j = 0; j < 16; ++j)
            if ((i + 1) * (j + 1) <= 16) ins16(B, pack_idx(v1[i] + v2[j], (unsigned)(i * 16 + j), 255u));
    float e[16], sum = 0.f;
#pragma unroll
    for (int k = 0; k < 16; ++k) { e[k] = __expf(B[k] - B[0]); sum += e[k]; }
    const float inv = 1.f / sum;
    int* ex = (int*)(p.ws + WS_EXPI) + (size_t)tokg * 128 + h * 16;
    float* gt = (float*)(p.ws + WS_GATE) + ((size_t)tokg * 128 + h * 16) * 2;
    const float* usc = (const float*)(p.ws + WS_USC);
    int ev[16]; float gv[16], sv[16];
#pragma unroll
    for (int k = 0; k < 16; ++k) {
        const unsigned ij = __float_as_uint(B[k]) & 255u;
        const unsigned i1 = __float_as_uint(l1[ij >> 4]) & 127u, i2 = __float_as_uint(l2[ij & 15u]) & 127u;
        ev[k] = (int)(i1 * 128u + i2);
        gv[k] = e[k] * inv * ((const float*)(p.ws + WS_VSC))[ev[k]];
        sv[k] = usc[ev[k]];
    }
#pragma unroll
    for (int k = 0; k < 16; k += 4) *(u32x4*)(ex + k) = u32x4{(unsigned)ev[k], (unsigned)ev[k + 1], (unsigned)ev[k + 2], (unsigned)ev[k + 3]};
#pragma unroll
    for (int k = 0; k < 16; k += 2) *(f32x4*)(gt + 2 * k) = f32x4{gv[k], sv[k], gv[k + 1], sv[k + 1]};
}
DI void phase_h(const Params& p, unsigned char* lds) {
    for (int it = blockIdx.x; it < BT / 128; it += gridDim.x) peer_h2_item(p, it);
    constexpr int TILES = 8 * (BT / 256);
    constexpr int QS = 528;
    float* rsb = (float*)(lds + 136 * 1024);
    bool pre = false;
    for (int it = blockIdx.x; it < TILES; it += gridDim.x) {
        const int tid = get_tid(), lane = tid & 63, wave = tid >> 6, wp = wave >> 2, wq = wave & 3;
        const int tn = it & 7, tm = it >> 3;
        const int n0 = tn * 256, tok0 = tm * 256, b = tok0 >> 12;
        const int it2 = it + (int)gridDim.x; const bool has2 = it2 < TILES;
        const int n2 = (has2 ? it2 & 7 : tn) * 256, tk2 = (has2 ? it2 >> 3 : tm) * 256;
        __syncthreads();
        if (tid < 256) {
            const float* sq = (const float*)(p.ws + WS_SSQ1) + (size_t)(tok0 + tid) * 16;
            const f32x4 a = *(const f32x4*)sq, c = *(const f32x4*)(sq + 4), d = *(const f32x4*)(sq + 8), e = *(const f32x4*)(sq + 12);
            const float ssq = (a[0] + a[1] + a[2] + a[3]) + (c[0] + c[1] + c[2] + c[3]) + (d[0] + d[1] + d[2] + d[3]) + (e[0] + e[1] + e[2] + e[3]);
            rsb[tid] = rsqrtf(ssq * (1.f / DM) + EPS);
        }
        f32x4 acc[4][4];
#pragma unroll
        for (int i = 0; i < 4; ++i)
#pragma unroll
            for (int j = 0; j < 4; ++j) acc[i][j] = f32x4{0.f, 0.f, 0.f, 0.f};
        gemm_mainloop<4>(acc, RowLoader{(const bf16_t*)(p.ws + WS_WTQ) + (size_t)n0 * DM, DM}, RowLoader{(const bf16_t*)(p.ws + WS_Y) + (size_t)tok0 * DM, DM}, DM / 64, lds, pre);
        pre = has2;
        {
            const float* shq = (const float*)(p.ws + WS_SHQ) + b * 2048;
            const int l15 = lane & 15, lk = lane >> 4;
#pragma unroll
            for (int i = 0; i < 4; ++i) {
                const int nl = wp * 64 + i * 16 + lk * 4;
                const f32x4 sh = *(const f32x4*)(shq + n0 + nl);
#pragma unroll
                for (int j = 0; j < 4; ++j) {
                    const int tl = wq * 64 + j * 16 + l15;
                    const float rs = rsb[tl];
                    *(u32x2*)(lds + tl * QS + nl * 2) = u32x2{pk2(rs * acc[i][j][0] + sh[0], rs * acc[i][j][1] + sh[1]), pk2(rs * acc[i][j][2] + sh[2], rs * acc[i][j][3] + sh[3])};
                }
            }
        }
        __syncthreads();
        float L[16];
        {
            const int t1 = get_tid(), ln = t1 & 63, w1 = __builtin_amdgcn_readfirstlane(t1 >> 6), r = ln & 31, hf = ln >> 5, hpl = w1 & 1, tb = w1 >> 1;
            const int hp = 2 * tn + hpl;
            const bf16_t* keys = (const bf16_t*)(p.ws + WS_KEYS) + (size_t)((hp & 1) * 8 + (hp >> 1)) * 128 * 128;
            const unsigned char* qrow = lds + (tb * 32 + r) * QS + (hpl * 128 + 8 * hf) * 2;
            bf16x8 bq[8];
#pragma unroll
            for (int ks = 0; ks < 8; ++ks) bq[ks] = *(const bf16x8*)(qrow + 32 * ks);
            peer_scores_top16(bq, keys, r, hf, L);
        }
        __syncthreads();
        if (has2) gemm_prefetch<4>(RowLoader{(const bf16_t*)(p.ws + WS_WTQ) + (size_t)n2 * DM, DM}, RowLoader{(const bf16_t*)(p.ws + WS_Y) + (size_t)tk2 * DM, DM}, lds);
        float* lists = (float*)(lds + 96 * 1024);
        {
            const int t2 = get_tid(), ln = t2 & 63, w2 = __builtin_amdgcn_readfirstlane(t2 >> 6);
            if ((ln >> 5) == 0) {
                float* dst = lists + (((w2 >> 1) * 32 + (ln & 31)) * 2 + (w2 & 1)) * 16;
#pragma unroll
                for (int i = 0; i < 16; i += 4) *(f32x4*)(dst + i) = f32x4{L[i], L[i + 1], L[i + 2], L[i + 3]};
            }
        }
        __syncthreads();
        {
            const int t3 = get_tid();
            if (t3 < 256) peer_pick(p, lists + (t3 * 2) * 16, lists + (t3 * 2 + 1) * 16, tok0 + t3, tn);
        }
    }
}

DI float dot16_fp8(const u32x4& w, const float (&x)[16]) {
    float d = 0.f;
#pragma unroll
    for (int i = 0; i < 4; ++i) {
        const auto lo = __builtin_amdgcn_cvt_pk_f32_fp8((int)w[i], false);
        const auto hi = __builtin_amdgcn_cvt_pk_f32_fp8((int)w[i], true);
        d += lo[0] * x[4 * i] + lo[1] * x[4 * i + 1] + hi[0] * x[4 * i + 2] + hi[1] * x[4 * i + 3];
    }
    return d;
}
template<int NPART, class F> DI void run_partitioned(const Params& p, unsigned char* lds, int qbase, int nitems, F&& body) {
    unsigned* ctl = (unsigned*)(p.ws + WS_CTL);
    volatile LAS unsigned* slot = (volatile LAS unsigned*)(LAS unsigned char*)(lds + LDS_ST_OFF + 8);
    const int x0 = (int)(xb_xcc_id() & 7u);
#pragma unroll 1
    for (int pp = 0; pp < NPART; ++pp) {
        const int part = (NPART == 8) ? ((x0 + pp) & 7) : ((((x0 + (pp >> 1)) & 7)) + 8 * (pp & 1));
        for (;;) {
            __syncthreads();
            if (get_tid() == 0) slot[0] = atomicAdd(ctl + qbase + 64 * part, 1u);
            __syncthreads();
            const int it = __builtin_amdgcn_readfirstlane((int)slot[0]);
            if (it >= nitems) break;
            body(part, it);
        }
    }
}
constexpr int CTL_QUEUE_I2 = 8320, CTL_QUEUE_I3 = 9408;
constexpr int UW_BYTES = 8384, UW_H2S = 1040, UW_LIST = 4160, UW_LCAP = 2112;
DI int peer_u_list(unsigned* lst, const u32x4& ia, const u32x4& ib, int part, int) {
    const int lane = get_tid() & 63;
    int cnt = 0;
#pragma unroll
    for (int g = 0; g < 8; ++g) {
        const unsigned id = (g < 4) ? ia[g & 3] : ib[g & 3];
        const unsigned idx = (unsigned)((g < 4 ? 0 : 256) + lane * 4 + (g & 3));
        const bool m = (int)(id >> 11) == part;
        const unsigned long long bm = __ballot(m);
        const int pos = cnt + __builtin_amdgcn_mbcnt_hi((unsigned)(bm >> 32), __builtin_amdgcn_mbcnt_lo((unsigned)bm, 0u));
        if (m) lst[pos] = (idx << 16) | id;
        cnt += __popcll(bm);
    }
    const unsigned last = lst[max(cnt - 1, 0)];
    if (lane < 16) lst[cnt + lane] = last;
    return cnt;
}
DI void peer_u_chunk(const Params& p, int part, int chunk, unsigned char* lds) {
    const int tid = get_tid(), lane = tid & 63, wave = __builtin_amdgcn_readfirstlane(tid >> 6);
    unsigned char* wl = lds + wave * UW_BYTES;
    const int n = lane & 15, kg = lane >> 4;
    const int ln4 = lane >> 2;
    const unsigned char* UT4 = p.ws + WS_UT + (lane & 3) * 16;
    const int bpi = 16 * n + 4 * kg;
    const unsigned char* arow = wl + (n & 3) * UW_H2S + kg * 16;
    const int tokw = chunk * 256 + wave * 4;
    u32x4 pia, pib, ph[4]; f32x4 psx;
#define U_LOAD_IDS(tok) do { const u32x4* ex_ = (const u32x4*)((const int*)(p.ws + WS_EXPI) + (size_t)(tok) * 128) + lane; pia = ex_[0]; pib = ex_[64]; } while (0)
#define U_LOAD_H2(tok) do { const unsigned char* hr_ = p.ws + WS_X8 + (size_t)(tok) * DM + lane * 16; \
        ph[0] = *(const u32x4*)hr_; ph[1] = *(const u32x4*)(hr_ + DM); ph[2] = *(const u32x4*)(hr_ + 2 * DM); ph[3] = *(const u32x4*)(hr_ + 3 * DM); \
        psx = *(const f32x4*)((const float*)(p.ws + WS_SX) + (tok)); } while (0)
#define U_BPERM(dst, src) do { dst[0] = (unsigned)__builtin_amdgcn_ds_bpermute(bpi, (int)src[0]); dst[1] = (unsigned)__builtin_amdgcn_ds_bpermute(bpi, (int)src[1]); \
        dst[2] = (unsigned)__builtin_amdgcn_ds_bpermute(bpi, (int)src[2]); dst[3] = (unsigned)__builtin_amdgcn_ds_bpermute(bpi, (int)src[3]); } while (0)
    U_LOAD_IDS(tokw); U_LOAD_H2(tokw);
    int cntc = peer_u_list((unsigned*)(wl + UW_LIST), pia, pib, part, lane);
    U_LOAD_IDS(tokw + 64);
    int have = -1;
    u32x4 brow[8];
#pragma unroll 1
    for (int s = 0; s < 4; ++s) {
        const int tok0 = tokw + s * 64;
#pragma unroll
        for (int r = 0; r < 4; ++r) *(u32x4*)(wl + r * UW_H2S + lane * 16) = ph[r];
        const f32x4 sx = psx;
        const unsigned* lc = (const unsigned*)(wl + UW_LIST + (s & 1) * UW_LCAP);
        unsigned* ln = (unsigned*)(wl + UW_LIST + ((s + 1) & 1) * UW_LCAP);
        int cntn = 0;
        if (s + 1 < 4) {
            cntn = peer_u_list(ln, pia, pib, part, lane);
            U_LOAD_H2(tok0 + 64);
            if (s + 2 < 4) U_LOAD_IDS(tok0 + 128);
        }
        const int ntiles = (cntc + 15) >> 4;
#pragma unroll 1
        for (int t = 0; t < ntiles; ++t) {
            const unsigned ent = lc[t * 16 + n];
            if (have != s * 64 + t) {
                const unsigned char* rp = UT4 + (size_t)(lc[t * 16 + ln4] & 0x3fffu) * 512;
#pragma unroll
                for (int ks = 0; ks < 8; ++ks) brow[ks] = *(const u32x4*)(rp + ks * 64);
            }
            unsigned entn;
            if (t + 1 < ntiles) { entn = lc[(t + 1) * 16 + ln4]; have = s * 64 + t + 1; }
            else if (cntn > 0) { entn = ln[ln4]; have = (s + 1) * 64; }
            else { entn = lc[t * 16 + ln4]; have = -1; }
            const unsigned char* rpn = UT4 + (size_t)(entn & 0x3fffu) * 512;
            const int idx = (int)(ent >> 16), tj = idx >> 7;
            const f32x2 gs = ((const f32x2*)(p.ws + WS_GATE))[(size_t)(tok0 + tj) * 128 + (idx & 127)];
            f32x4 acc0 = f32x4{0.f, 0.f, 0.f, 0.f}, acc1 = acc0;
            u32x4 a0 = *(const u32x4*)arow, a1 = *(const u32x4*)(arow + 64), bc;
            U_BPERM(bc, brow[0]);
#pragma unroll
            for (int ks = 0; ks < 8; ++ks) {
                const i32x8 av = i32x8{(int)a0[0], (int)a0[1], (int)a0[2], (int)a0[3], (int)a1[0], (int)a1[1], (int)a1[2], (int)a1[3]};
                const i32x8 bv = i32x8{(int)bc[0], (int)bc[1], (int)bc[2], (int)bc[3], 0, 0, 0, 0};
                if (ks < 7) { a0 = *(const u32x4*)(arow + (ks + 1) * 128); a1 = *(const u32x4*)(arow + (ks + 1) * 128 + 64); U_BPERM(bc, brow[ks + 1]); }
                if (ks & 1) acc1 = __builtin_amdgcn_mfma_scale_f32_16x16x128_f8f6f4(av, bv, acc1, 0, 4, 0, 0x7F7F7F7F, 0, 0x7F7F7F7F);
                else        acc0 = __builtin_amdgcn_mfma_scale_f32_16x16x128_f8f6f4(av, bv, acc0, 0, 4, 0, 0x7F7F7F7F, 0, 0x7F7F7F7F);
                brow[ks] = *(const u32x4*)(rpn + ks * 64);
                __builtin_amdgcn_sched_barrier(0);
            }
            const float d0 = acc0[0] + acc1[0], d1 = acc0[1] + acc1[1], d2 = acc0[2] + acc1[2], d3 = acc0[3] + acc1[3];
            const float araw = (tj == 0) ? d0 : (tj == 1) ? d1 : (tj == 2) ? d2 : d3;
            const float sxv = (tj == 0) ? sx[0] : (tj == 1) ? sx[1] : (tj == 2) ? sx[2] : sx[3];
            const float a = araw * (gs[1] * sxv);
            const float y = 0.7978845608028654f * (a + 0.044715f * a * a * a);
            const float th = 1.f - 2.f * __builtin_amdgcn_rcpf(__expf(2.f * y) + 1.f);
            const float w = 0.5f * a * (1.f + th) * gs[0];
            if (kg == 0 && t * 16 + n < cntc) ((u32x2*)(p.ws + WS_PAIRS))[(size_t)(tok0 + tj) * 128 + (idx & 127)] = u32x2{ent & 0x3fffu, __float_as_uint(w)};
        }
        cntc = cntn;
    }
#undef U_BPERM
#undef U_LOAD_IDS
#undef U_LOAD_H2
}
DI void phase_i2(const Params& p, unsigned char* lds) {
    run_partitioned<8>(p, lds, CTL_QUEUE_I2, BT / 256, [&](int part, int it) { peer_u_chunk(p, part, it, lds); });
}
typedef int i32x2_t __attribute__((ext_vector_type(2)));
constexpr int VW_BYTES = 9504, VW_PAIRS = 8192, VW_HI = 9216, VW_LO = 9344, VW_ZERO = 9472;
DI void peer_v_chunk(const Params& p, int p8, int chunk, unsigned char* lds) {
    const int tid = get_tid(), lane = tid & 63, wave = __builtin_amdgcn_readfirstlane(tid >> 6);
    unsigned char* wl = lds + wave * VW_BYTES;
    const int slice = p8 & 3;
    const unsigned char* VT4 = p.ws + WS_VTAB + (size_t)slice * 16384 * 128;
    const float* mod = (const float*)(p.ws + WS_MOD);
    const int er = lane >> 3, pc = lane & 7;
    const int n = lane & 31, kg = lane >> 5;
    const int col = slice * 256 + 8 * n;
    const int tokw = (p8 >> 2) * 16384 + chunk * 256 + wave;
    if (lane < 4) ((unsigned*)(wl + VW_ZERO))[lane] = 0u;
    const unsigned char* abase = wl + ((n == 0) ? VW_HI + 16 * kg : (n == 1) ? VW_LO + 16 * kg : VW_ZERO);
    const int astep = (n < 2) ? 1 : 0;
    const int row0 = 32 * kg + (lane & 15), sw0 = (row0 >> 1) & 7;
    const unsigned char* tb0 = wl + row0 * 128 + 8 * ((lane >> 4) & 1);
    u32x4 pp = *((const u32x4*)(p.ws + WS_PAIRS + (size_t)tokw * 1024) + lane);
#pragma unroll 1
    for (int step = 0; step < 16; ++step) {
        const int tok = tokw + step * 16, b = tok >> 12;
        *(u32x4*)(wl + VW_PAIRS + lane * 16) = pp;
        const float w0 = __uint_as_float(pp[1]), w1 = __uint_as_float(pp[3]);
        const float mx = fmaxf(wave_max(fmaxf(fabsf(w0), fabsf(w1))), 1e-30f);
        const float ws = 224.f / mx;
        const int hi = __builtin_amdgcn_cvt_pk_fp8_f32(w0 * ws, w1 * ws, 0, false);
        const f32x2 dq = __builtin_amdgcn_cvt_pk_f32_fp8(hi, false);
        const int lo = __builtin_amdgcn_cvt_pk_fp8_f32((w0 * ws - dq[0]) * 16.f, (w1 * ws - dq[1]) * 16.f, 0, false);
        ((unsigned short*)(wl + VW_HI))[lane] = (unsigned short)hi;
        ((unsigned short*)(wl + VW_LO))[lane] = (unsigned short)lo;
        if (step + 1 < 16) pp = *((const u32x4*)(p.ws + WS_PAIRS + (size_t)(tok + 16) * 1024) + lane);
        bf16_t* xo = (bf16_t*)(p.out + (size_t)tok * DM) + col;
        const u32x4 x1w = *(const u32x4*)xo;
        const f32x4 g2a = *(const f32x4*)(mod + b * 6144 + 5120 + col), g2b = *(const f32x4*)(mod + b * 6144 + 5120 + col + 4);
        float res[8];
#pragma unroll
        for (int i = 0; i < 8; ++i) res[i] = 0.f;
#pragma unroll 1
        for (int hf = 0; hf < 2; ++hf) {
            asm volatile("s_waitcnt lgkmcnt(0)" ::: "memory");
            __builtin_amdgcn_sched_barrier(0);
            const unsigned* pr = (const unsigned*)(wl + VW_PAIRS) + 2 * (64 * hf + er);
#pragma unroll
            for (int q = 0; q < 8; ++q) {
                const unsigned e = pr[16 * q];
                const int sw = (4 * q + (er >> 1)) & 7;
                __builtin_amdgcn_global_load_lds((const unsigned*)(VT4 + (size_t)e * 128 + ((pc ^ sw) << 4)), (unsigned*)(wl + q * 1024), 16, 0, 0);
            }
            const u32x4 a0 = *(const u32x4*)(abase + astep * (64 * hf)), a1 = *(const u32x4*)(abase + astep * (64 * hf + 32));
            const i32x8 av = i32x8{(int)a0[0], (int)a0[1], (int)a0[2], (int)a0[3], (int)a1[0], (int)a1[1], (int)a1[2], (int)a1[3]};
            asm volatile("s_waitcnt vmcnt(0)" ::: "memory");
            __builtin_amdgcn_sched_barrier(0);
#pragma unroll
            for (int nt = 0; nt < 8; ++nt) {
                const int c = (nt ^ sw0) << 4;
                const i32x2_t b0 = __builtin_amdgcn_ds_read_tr4_b64_v2i32((LAS i32x2_t*)(LAS unsigned char*)(tb0 + c));
                const i32x2_t b1 = __builtin_amdgcn_ds_read_tr4_b64_v2i32((LAS i32x2_t*)(LAS unsigned char*)(tb0 + 16 * 128 + c));
                const i32x8 bv = i32x8{b0[0], b0[1], b1[0], b1[1], 0, 0, 0, 0};
                f32x16 z;
#pragma unroll
                for (int i = 0; i < 16; ++i) z[i] = 0.f;
                const f32x16 d = __builtin_amdgcn_mfma_scale_f32_32x32x64_f8f6f4(av, bv, z, 0, 4, 0, 0x7F7F7F7F, 0, 0x7F7F7F7F);
                res[nt] += d[0] + d[1] * (1.f / 16.f);
            }
        }
        const float iw = mx * (1.f / 224.f);
        float xv[8];
#pragma unroll
        for (int i = 0; i < 4; ++i) { xv[2 * i] = bflo(x1w[i]); xv[2 * i + 1] = bfhi(x1w[i]); }
        float ss = 0.f;
#pragma unroll
        for (int i = 0; i < 8; ++i) { xv[i] += (i < 4 ? g2a[i & 3] : g2b[i & 3]) * (res[i] * iw); ss += xv[i] * xv[i]; }
        if (lane < 32) *(u32x4*)xo = u32x4{pk2(xv[0], xv[1]), pk2(xv[2], xv[3]), pk2(xv[4], xv[5]), pk2(xv[6], xv[7])};
        ss = wave_sum(lane < 32 ? ss : 0.f);
        if (lane == 0) ((float*)(p.ws + WS_SSQ))[(size_t)tok * 8 + slice] = ss;
    }
}
DI void phase_i3(const Params& p, unsigned char* lds) {
    run_partitioned<8>(p, lds, CTL_QUEUE_I3, 16384 / 256, [&](int part, int it) { peer_v_chunk(p, part, it, lds); });
}
DI void phase_i4(const Params& p) {
    const bool bad = xb_ld((unsigned*)(p.ws + WS_CTL) + CTL_BADTID) != 0u || xb_ld((unsigned*)(p.ws + WS_CTL) + XB_TMO) != 0u;
    for (int it = blockIdx.x; it < BT / 16; it += gridDim.x) {
        const int tid = get_tid(), lane = tid & 63, row = it * 16 + (tid >> 6);
        const float* sq = (const float*)(p.ws + WS_SSQ) + (size_t)row * 8;
        const f32x4 s0 = *(const f32x4*)sq;
        const float ss = s0[0] + s0[1] + s0[2] + s0[3];
        float rs = rsqrtf(ss * (1.f / DM) + EPS);
        if (bad) rs = __builtin_nanf("");
        float* o = p.out + (size_t)row * DM;
        u32x2 xw[4];
#pragma unroll
        for (int j = 0; j < 4; ++j) xw[j] = *(const u32x2*)((const bf16_t*)o + j * 256 + lane * 4);
        asm volatile("s_waitcnt vmcnt(0)" ::: "memory");
#pragma unroll
        for (int j = 0; j < 4; ++j) {
            const int c = j * 256 + lane * 4;
            const f32x4 g = *(const f32x4*)(p.in[I_FNG] + c);
            *(f32x4*)(o + c) = f32x4{bflo(xw[j][0]) * rs * g[0], bfhi(xw[j][0]) * rs * g[1], bflo(xw[j][1]) * rs * g[2], bfhi(xw[j][1]) * rs * g[3]};
        }
    }
}

DI float probe_mfma_mixed() {
    const int lane = get_tid() & 63, kg = lane >> 4;
    int aw[8];
#pragma unroll
    for (int v = 0; v < 8; ++v) {
        unsigned w = 0;
#pragma unroll
        for (int b = 0; b < 4; ++b) { const unsigned q = 32u * kg + 4u * v + b; w |= (((q & 63u) + 8u) | ((q >> 6) << 7)) << (8 * b); }
        aw[v] = (int)w;
    }
    const i32x8 av = i32x8{aw[0], aw[1], aw[2], aw[3], aw[4], aw[5], aw[6], aw[7]};
    int c1 = 0, c2 = 0, c4 = 0, c5 = 0; unsigned pi1 = 255;
#pragma unroll 1
    for (int pb = 0; pb < 128; ++pb) {
        const int kgB = pb >> 5, i0 = pb & 31;
        const unsigned hot = (kg == kgB) ? (2u << (4 * (i0 & 7))) : 0u;
        const i32x8 bv = i32x8{(i0 >> 3) == 0 ? (int)hot : 0, (i0 >> 3) == 1 ? (int)hot : 0, (i0 >> 3) == 2 ? (int)hot : 0, (i0 >> 3) == 3 ? (int)hot : 0, 0, 0, 0, 0};
        const f32x4 z = f32x4{0.f, 0.f, 0.f, 0.f};
        const f32x4 dd = __builtin_amdgcn_mfma_scale_f32_16x16x128_f8f6f4(av, bv, z, 0, 4, 0, 0x7F7F7F7F, 0, 0x7F7F7F7F);
        const float d = dd[0];
        unsigned qf = 255;
#pragma unroll 1
        for (unsigned q = 0; q < 128; ++q) { const unsigned byte = ((q & 63u) + 8u) | ((q >> 6) << 7); if (__builtin_amdgcn_cvt_f32_fp8((int)byte, 0) == d) qf = q; }
        c1 += (qf != (unsigned)pb); c2 += (qf != (unsigned)(pb ^ 1));
        { const unsigned k = 64u * (i0 >> 4) + 16u * kgB + (i0 & 15); c4 += (qf != k); }
        { const unsigned k = (unsigned)pb, kgA = (k & 63u) >> 4, j = 16u * (k >> 6) + (k & 15u); c5 += (qf != 32u * kgA + j); }
        if (pb == 1) pi1 = qf;
    }
    return c1 == 0 ? 1.1e6f : c2 == 0 ? 2.2e6f : c4 == 0 ? 4.4e6f : c5 == 0 ? 5.5e6f : (pi1 < 90u ? (10.f + (float)pi1) * 100.f : 7.7e6f);
}

__global__ void __launch_bounds__(NT) mega(Params p) {
    unsigned char* lds = g_lds;
    volatile LAS unsigned* st = (volatile LAS unsigned*)(LAS unsigned char*)(lds + LDS_ST_OFF);
    {
        const unsigned hw = __builtin_amdgcn_s_getreg((5 << 11) | 4);
        if ((threadIdx.x & 63) == 0) g_lds[LDS_WTAB_OFF + hw] = (unsigned char)(threadIdx.x >> 6);
        if (threadIdx.x < 2) st[threadIdx.x] = 0u;
        __syncthreads();
        if (get_tid() != (int)threadIdx.x) ((unsigned*)(p.ws + WS_CTL))[CTL_BADTID] = 1u;
    }
    XcdBarrier bar = xcd_barrier_post((unsigned*)(p.ws + WS_CTL), st);
    float* sm = (float*)lds;

#define STAMP(k, which) do { if (PROBE_PHASE == (k) && blockIdx.x == 0 && get_tid() == 0) ((volatile unsigned long long*)(lds + LDS_PROBE_OFF))[which] = __builtin_amdgcn_s_memrealtime(); } while (0)
    STAMP(21, 0); STAMP(30, 0); STAMP(31, 0);
    STAMP(0, 0); phase_a(p, sm);   xcd_barrier(bar); STAMP(0, 1);
    STAMP(1, 0); phase_b(p, sm);   xcd_barrier(bar); STAMP(1, 1);
    if (PROBE_PHASE == 20) { STAMP(20, 0); xcd_barrier(bar); xcd_barrier(bar); xcd_barrier(bar); xcd_barrier(bar); STAMP(20, 1); }
    STAMP(2, 0); phase_c(p, lds);  xcd_barrier(bar); STAMP(2, 1);
    STAMP(3, 0); phase_d(p, lds);  xcd_barrier(bar); STAMP(3, 1);
    STAMP(5, 0); phase_e(p, lds);  xcd_barrier(bar); STAMP(5, 1);
    STAMP(6, 0); phase_f(p, lds);  xcd_barrier(bar); STAMP(6, 1);
    STAMP(8, 0); phase_h(p, lds);  xcd_barrier(bar); STAMP(8, 1);
    STAMP(10, 0); phase_i2(p, lds); xcd_barrier(bar); STAMP(10, 1);
    STAMP(11, 0); phase_i3(p, lds); xcd_barrier(bar); STAMP(11, 1);
    STAMP(12, 0); phase_i4(p);
    float pm = 0.f;
    if (PROBE_PHASE == 40 && blockIdx.x == 0 && get_tid() < 64) pm = probe_mfma_mixed();
    if (PROBE_PHASE >= 0) {
        xcd_barrier(bar); STAMP(12, 1); STAMP(21, 1);
        if (blockIdx.x == 0 && get_tid() == 0) {
            volatile unsigned long long* ts = (volatile unsigned long long*)(lds + LDS_PROBE_OFF);
            if (PROBE_PHASE == 40) p.out[0] += pm; else
            p.out[0] += (float)(ts[1] - ts[0]) * (0.01f / PROBE_SCALE);
        }
    }
}

extern "C" void kernel_launch(void* const* d_in, const int* in_sizes, int n_in, void* d_out, int out_size, void* d_ws, size_t ws_size, hipStream_t stream) {
    static int grid = 0;
    if (grid == 0) {
        int dev = 0, cus = 0;
        if (hipGetDevice(&dev) != hipSuccess || hipDeviceGetAttribute(&cus, hipDeviceAttributeMultiprocessorCount, dev) != hipSuccess) { fprintf(stderr, "kernel_launch: device query failed\n"); grid = -1; return; }
        if (n_in != N_IN || ws_size < WS_END) { fprintf(stderr, "kernel_launch: unexpected n_in %d or ws_size %zu (< %zu)\n", n_in, ws_size, (size_t)WS_END); grid = -1; return; }
        grid = cus;
    }
    if (grid < 0) return;
    (void)hipMemsetAsync((char*)d_ws + WS_CTL, 0, 64 * 1024, stream);
    Params p{};
    for (int i = 0; i < N_IN; ++i) p.in[i] = (const float*)d_in[i];
    p.out = (float*)d_out; p.ws = (unsigned char*)d_ws;
    hipLaunchKernelGGL(mega, dim3(grid), dim3(NT), 0, stream, p);
}
```

```cpp
#include <hip/hip_runtime.h>
#include <stdint.h>
#include <cstdio>

#define DI __device__ __forceinline__
#define LAS __attribute__((address_space(3)))
typedef unsigned short bf16_t;
typedef short bf16x8 __attribute__((ext_vector_type(8)));
typedef short s16x4 __attribute__((ext_vector_type(4)));
typedef float f32x4 __attribute__((ext_vector_type(4)));
typedef float f32x2 __attribute__((ext_vector_type(2)));
typedef float f32x16 __attribute__((ext_vector_type(16)));
typedef unsigned u32x4 __attribute__((ext_vector_type(4)));
typedef unsigned u32x2 __attribute__((ext_vector_type(2)));

#ifndef PROBE_PHASE
#define PROBE_PHASE (-1)
#endif
#ifndef SHADOW
#define SHADOW 0
#endif
#ifndef PROBE_SCALE
#define PROBE_SCALE 100.f
#endif
constexpr int BATCH = 8, SEQ = 4096, DM = 1024, BT = BATCH * SEQ;
constexpr int CTX = 256, TK = SEQ + CTX;
constexpr int NH = 8, NKV = 2, HD = 64;
constexpr int QD = 512, KVD = 128, HYD = 512, HYC = 1536, GC = 2048, INC = 4352;
constexpr int PH = 8, PNK = 128, PDK = 256, PTOP = 16;
constexpr float EPS = 1e-6f;
constexpr int NT = 1024;

enum { I_X = 0, I_C, I_CTX, I_CCTX, I_ADAW, I_ADAB, I_NMIX, I_NFFN, I_WIN, I_QNG, I_KNG, I_HCW, I_HCB,
       I_HW1, I_HB1, I_HW2, I_HB2, I_HW3, I_HB3, I_HW4, I_HFREQ, I_HSKIP, I_WAO, I_WHO, I_WO, I_PWQ, I_PK1, I_PK2, I_PU, I_PV, I_FNG, N_IN };

constexpr size_t MB = 1024 * 1024;
constexpr size_t WS_CTL   = 0;
constexpr size_t WS_MOD   = 64 * 1024;
constexpr size_t WS_ROPE  = WS_MOD + 9 * 6144 * 4;
static_assert(WS_ROPE + 16 * 1024 + 8 * 2048 * 4 + 4096 <= 512 * 1024, "ws");
constexpr size_t WS_PART  = 512 * 1024;
constexpr size_t WS_WTIN  = 3 * MB;
constexpr size_t WS_WTAO  = WS_WTIN + (size_t)INC * DM * 2;
constexpr size_t WS_WTHO  = WS_WTAO + (size_t)DM * QD * 2;
constexpr size_t WS_WTO   = WS_WTHO + (size_t)DM * HYD * 2;
constexpr size_t WS_WTQ   = WS_WTO + (size_t)DM * DM * 2;
constexpr size_t WS_KEYS  = WS_WTQ + (size_t)2048 * DM * 2;
constexpr size_t WS_R     = WS_KEYS + (size_t)2 * 8 * 128 * 128 * 2;
constexpr size_t WS_KB    = WS_R + (size_t)2 * 512 * 8192 * 2;
constexpr size_t WS_VT    = WS_KB + (size_t)BATCH * NKV * TK * HD * 2;
constexpr size_t WS_HC    = WS_VT + (size_t)BATCH * NKV * TK * HD * 2;
constexpr size_t WS_H     = 60 * MB;
constexpr size_t WS_G     = WS_H + 64 * MB;
constexpr size_t WS_ZT    = WS_G + 128 * MB;
constexpr size_t WS_Q     = WS_ZT + 96 * MB;
constexpr size_t WS_ATT   = WS_Q + 32 * MB;
constexpr size_t WS_HYT   = WS_ATT + 32 * MB;
constexpr size_t WS_TAB   = WS_HYT + 32 * MB;
constexpr size_t WS_END   = WS_TAB + 32 * MB;
static_assert(WS_HC + (size_t)2048 * DM * 2 <= WS_H, "ws overlap");
constexpr size_t WS_FRAW  = WS_ATT;
constexpr size_t WS_HY    = WS_Q;
constexpr size_t WS_UT    = WS_TAB;
constexpr size_t WS_VSC   = WS_PART + 2 * MB + 320 * 1024;
constexpr size_t WS_VTAB  = WS_TAB + 16 * MB;
constexpr size_t WS_H8    = WS_ATT;
constexpr size_t WS_W8G   = WS_HYT;
constexpr size_t WS_EXPI  = WS_ATT;
constexpr size_t WS_GATE  = WS_Q;
constexpr size_t WS_PAIRS = WS_HYT;
constexpr size_t WS_SSQ   = WS_PART + 1 * MB;
constexpr size_t WS_USC   = WS_PART + 2 * MB;
constexpr size_t WS_Y     = WS_ZT;
constexpr size_t WS_X8    = WS_ZT + 64 * MB;
constexpr size_t WS_SSQ1  = WS_ATT + 16 * MB;
constexpr size_t WS_SX    = WS_PART + 2 * MB + 64 * 1024;
constexpr size_t WS_SHQ   = WS_ROPE + 16 * 1024;
constexpr size_t WS_FSC   = WS_SHQ + 64 * 1024;
constexpr float VSCALE = 64.f;
constexpr float W8_SCALE = 64.f;
constexpr float VT_SCALE = 16.f;
constexpr float X8_MAX = 192.f;

constexpr int CTL_BADTID = 8000;
DI unsigned f2bf(float f) { unsigned u = __builtin_bit_cast(unsigned, f); return (u + 0x7fffu + ((u >> 16) & 1u)) >> 16; }
DI unsigned pk2(float lo, float hi) { return f2bf(lo) | (f2bf(hi) << 16); }
DI float bf2f(unsigned short b) { return __builtin_bit_cast(float, (unsigned)b << 16); }
DI float bflo(unsigned u) { return __builtin_bit_cast(float, u << 16); }
DI float bfhi(unsigned u) { return __builtin_bit_cast(float, u & 0xffff0000u); }
DI float red2pi(float x) { const float k = rintf(x * 0.15915494309189535f); float r = fmaf(-k, 6.2831854820251465f, x); return fmaf(-k, -1.7484555e-7f, r); }
DI float fsin(float x) { return __sinf(red2pi(x)); }
DI float fcos(float x) { return __cosf(red2pi(x)); }
constexpr int LDS_BYTES = 160 * 1024;
constexpr int LDS_ST_OFF = LDS_BYTES - 16;
constexpr int LDS_PROBE_OFF = LDS_BYTES - 16 - 32;
constexpr int LDS_WTAB_OFF = LDS_BYTES - 16 - 32 - 64;
constexpr int LDS_USER = LDS_WTAB_OFF;
__shared__ __attribute__((aligned(16))) unsigned char g_lds[LDS_BYTES];
DI s16x4 lds_rd64(const unsigned char* ptr) { return *(const volatile LAS s16x4*)(const LAS unsigned char*)ptr; }
DI int get_tid() {
    const unsigned hw = __builtin_amdgcn_s_getreg((5 << 11) | 4);
    unsigned w = g_lds[LDS_WTAB_OFF + hw];
    w = __builtin_amdgcn_readfirstlane(w);
    int t;
    asm volatile("v_mbcnt_lo_u32_b32 %0, -1, 0\n\tv_mbcnt_hi_u32_b32 %0, -1, %0\n\tv_lshl_or_b32 %0, %1, 6, %0" : "=&v"(t) : "s"(w));
    return t;
}
template<int CTRL> DI float dppf(float v) { return __uint_as_float(__builtin_amdgcn_update_dpp(0u, __float_as_uint(v), CTRL, 0xF, 0xF, true)); }
template<int CTRL> DI int dppi(int v) { return (int)__builtin_amdgcn_update_dpp(0u, (unsigned)v, CTRL, 0xF, 0xF, true); }
DI float sum16(float v) { v += dppf<0xB1>(v); v += dppf<0x4E>(v); v += dppf<0x141>(v); v += dppf<0x140>(v); return v; }
DI float sum_x16(float v) { auto r = __builtin_amdgcn_permlane16_swap(__float_as_uint(v), __float_as_uint(v), false, false); return __uint_as_float(r[0]) + __uint_as_float(r[1]); }
DI float sum_x32(float v) { auto r = __builtin_amdgcn_permlane32_swap(__float_as_uint(v), __float_as_uint(v), false, false); return __uint_as_float(r[0]) + __uint_as_float(r[1]); }
DI float max_x32(float v) { auto r = __builtin_amdgcn_permlane32_swap(__float_as_uint(v), __float_as_uint(v), false, false); return fmaxf(__uint_as_float(r[0]), __uint_as_float(r[1])); }
DI float wave_sum(float v) { return sum_x32(sum_x16(sum16(v))); }
DI float wave_max(float v) {
    v = fmaxf(v, dppf<0xB1>(v)); v = fmaxf(v, dppf<0x4E>(v)); v = fmaxf(v, dppf<0x141>(v)); v = fmaxf(v, dppf<0x140>(v));
    { auto r = __builtin_amdgcn_permlane16_swap(__float_as_uint(v), __float_as_uint(v), false, false); v = fmaxf(__uint_as_float(r[0]), __uint_as_float(r[1])); }
    { auto r = __builtin_amdgcn_permlane32_swap(__float_as_uint(v), __float_as_uint(v), false, false); v = fmaxf(__uint_as_float(r[0]), __uint_as_float(r[1])); }
    return v;
}


#define XB_TMO      128
#define XB_XCNT(j)  (256  + 64 * (j))
#define XB_XSUB(j)  (1280 + 64 * (j))
#define XB_XGEN(j)  (2304 + 64 * (j))
#define XB_TOP      3328
#define XB_TOPGEN   3392
#define XCD_BAR_WORDS 3456
#define XB_SPIN_CAP (1u << 27)
DI unsigned xb_ld(unsigned* p)              { return __hip_atomic_load(p, __ATOMIC_RELAXED, __HIP_MEMORY_SCOPE_AGENT); }
DI unsigned xb_add(unsigned* p, unsigned v) { return __hip_atomic_fetch_add(p, v, __ATOMIC_RELAXED, __HIP_MEMORY_SCOPE_AGENT); }
DI unsigned xb_xcc_id() { return (unsigned)__builtin_amdgcn_s_getreg((3 << 11) | 20) & 0xFu; }
#define XB_SPIN(cond, bar) do { unsigned _sp = 0; while (cond) { __builtin_amdgcn_s_sleep(1); \
    if ((++_sp & 255u) == 0u) { if (xb_ld(&(bar)[XB_TMO])) break; if (_sp > XB_SPIN_CAP) { atomicAdd(&(bar)[XB_TMO], 1u); break; } } } } while (0)
struct XcdBarrier { unsigned* bar; unsigned x; volatile LAS unsigned* st; };
DI XcdBarrier xcd_barrier_post(unsigned* bar, volatile LAS unsigned* st) {
    XcdBarrier b; b.bar = bar; b.x = xb_xcc_id(); b.st = st;
    if (get_tid() == 0) (void)xb_add(&bar[XB_XCNT(b.x)], 1u);
    return b;
}
DI void xcd_barrier_complete(unsigned* bar, unsigned x, unsigned& nloc, unsigned& nx) {
    const unsigned G = gridDim.x * gridDim.y * gridDim.z;
    unsigned sum, cnt, mine, sp = 0u;
    for (;;) {
        sum = 0u; cnt = 0u; mine = 0u;
#pragma unroll
        for (unsigned j = 0; j < 16; ++j) { const unsigned c = xb_ld(&bar[XB_XCNT(j)]); sum += c; cnt += (c > 0u) ? 1u : 0u; mine = (j == x) ? c : mine; }
        if (sum == G) break;
        __builtin_amdgcn_s_sleep(1);
        if ((++sp & 255u) == 0u) { if (xb_ld(&bar[XB_TMO])) break; if (sp > XB_SPIN_CAP) { atomicAdd(&bar[XB_TMO], 1u); break; } }
    }
    nloc = mine > 0u ? mine : 1u; nx = cnt > 0u ? cnt : 1u;
}
DI void xcd_barrier(const XcdBarrier& b) {
    asm volatile("s_waitcnt vmcnt(0)" ::: "memory");
    __syncthreads();
    if (get_tid() == 0) {
        unsigned* bar = b.bar;
        __builtin_amdgcn_s_waitcnt(0);
        unsigned nloc = b.st[0], nx = b.st[1];
        if (nloc == 0u) { xcd_barrier_complete(bar, b.x, nloc, nx); b.st[0] = nloc; b.st[1] = nx; }
        const unsigned old = xb_add(&bar[XB_XSUB(b.x)], 1u);
        const unsigned gen = old / nloc;
        if (old + 1u == (gen + 1u) * nloc) {
            __builtin_amdgcn_fence(__ATOMIC_RELEASE, "agent");
            asm volatile("s_waitcnt vmcnt(0)" ::: "memory");
            const unsigned og = xb_add(&bar[XB_TOP], 1u);
            const unsigned tg = og / nx;
            if (og + 1u == (tg + 1u) * nx) xb_add(&bar[XB_TOPGEN], 1u);
            else XB_SPIN(xb_ld(&bar[XB_TOPGEN]) == tg, bar);
            __builtin_amdgcn_fence(__ATOMIC_ACQUIRE, "agent");
            xb_add(&bar[XB_XGEN(b.x)], 1u);
            asm volatile("s_waitcnt vmcnt(0)" ::: "memory");
        } else {
            XB_SPIN(xb_ld(&bar[XB_XGEN(b.x)]) == gen, bar);
            __builtin_amdgcn_fence(__ATOMIC_ACQUIRE, "agent");
            asm volatile("s_waitcnt vmcnt(0)" ::: "memory");
        }
    }
    __syncthreads();
}

struct Params { const float* in[N_IN]; float* out; unsigned char* ws; };


DI void transpose_tile(const float* __restrict__ W, int K, int N, bf16_t* __restrict__ Wt, int tile, float* sm) {
    const int tid = get_tid();
    const int ntn = N / 256, tk = tile / ntn, tn = tile % ntn;
    __syncthreads();
#pragma unroll
    for (int i = 0; i < 4; ++i) {
        const int idx = tid + i * NT, kk = idx >> 6, n4 = (idx & 63) * 4;
        const f32x4 v = *(const f32x4*)(W + (size_t)(tk * 64 + kk) * N + tn * 256 + n4);
        float* d = sm + kk * 257 + n4;
        d[0] = v[0]; d[1] = v[1]; d[2] = v[2]; d[3] = v[3];
    }
    __syncthreads();
#pragma unroll
    for (int i = 0; i < 2; ++i) {
        const int idx = tid + i * NT, nn = idx & 255, kg = idx >> 8;
        const float* c = sm + kg * 8 * 257 + nn;
        *(u32x4*)(Wt + (size_t)(tn * 256 + nn) * K + tk * 64 + kg * 8) = u32x4{pk2(c[0], c[257]), pk2(c[2 * 257], c[3 * 257]), pk2(c[4 * 257], c[5 * 257]), pk2(c[6 * 257], c[7 * 257])};
    }
}

DI void mod_item(const Params& p, int item, float* sm) {
    const int tid = get_tid();
    float* sc = sm;
    float* red = sm + 9 * 1024;
    __syncthreads();
    for (int i = tid; i < 9 * 1024; i += NT) {
        const float v = (i < 8 * 1024) ? p.in[I_C][i] : p.in[I_CCTX][i - 8 * 1024];
        sc[i] = v / (1.f + __expf(-v));
    }
    __syncthreads();
    const int col = tid & 15, kg = tid >> 4, n0 = item * 16;
    float acc[9];
#pragma unroll
    for (int r = 0; r < 9; ++r) acc[r] = 0.f;
    const float* w = p.in[I_ADAW] + (size_t)kg * 16 * 6144 + n0 + col;
    float wv[16];
#pragma unroll
    for (int k = 0; k < 16; ++k) wv[k] = w[(size_t)k * 6144];
#pragma unroll
    for (int k = 0; k < 16; ++k)
#pragma unroll
        for (int r = 0; r < 9; ++r) acc[r] += sc[r * 1024 + kg * 16 + k] * wv[k];
#pragma unroll
    for (int r = 0; r < 9; ++r) red[(kg * 9 + r) * 16 + col] = acc[r];
    __syncthreads();
    if (tid < 9 * 16) {
        const int r = tid >> 4, c2 = tid & 15;
        float s = p.in[I_ADAB][n0 + c2];
        for (int g = 0; g < 64; ++g) s += red[(g * 9 + r) * 16 + c2];
        ((float*)(p.ws + WS_MOD))[r * 6144 + n0 + c2] = s;
    }
    __syncthreads();
}

DI void filter_item(const Params& p, int item, float* sm) {
    const int tid = get_tid();
    float* z  = sm;
    float* ha = sm + 16 * 36;
    float* hb = ha + 16 * 64;
    const int t0 = item * 16;
    float* w1s = hb + 16 * 64;
    float* w2s = w1s + 33 * 64;
    float* w3s = w2s + 64 * 64;
    __syncthreads();
    {
        const f32x4 a2 = *(const f32x4*)(p.in[I_HW2] + tid * 4), a3 = *(const f32x4*)(p.in[I_HW3] + tid * 4);
        f32x4 a1 = f32x4{0.f, 0.f, 0.f, 0.f};
        if (tid < 33 * 16) a1 = *(const f32x4*)(p.in[I_HW1] + tid * 4);
        *(f32x4*)(w2s + tid * 4) = a2; *(f32x4*)(w3s + tid * 4) = a3;
        if (tid < 33 * 16) *(f32x4*)(w1s + tid * 4) = a1;
    }
    if (tid < 16 * 33) {
        const int pp = tid / 33, i = tid % 33;
        const int t = t0 + pp;
        float v;
        if (i == 0) v = (float)t / (float)(SEQ - 1);
        else {
            const int fi = (i - 1) & 15;
            const float f = 1e-4f + (float)fi * ((15.f - 1e-4f) / 15.f);
            const float w = 6.283185307179586f * (float)t / (float)SEQ;
            const float a = f * w;
            v = (i <= 16) ? fcos(a) : -fsin(a);
        }
        z[pp * 36 + i] = v;
    }
    __syncthreads();
    const int pp = tid >> 6, j = tid & 63;
    const float fr = p.in[I_HFREQ][j];
    {
        float a = p.in[I_HB1][j];
#pragma unroll 11
        for (int i = 0; i < 33; ++i) a += z[pp * 36 + i] * w1s[i * 64 + j];
        ha[pp * 64 + j] = fsin(fr * a);
    }
    __syncthreads();
    {
        float a = p.in[I_HB2][j];
#pragma unroll 16
        for (int i = 0; i < 64; ++i) a += ha[pp * 64 + i] * w2s[i * 64 + j];
        hb[pp * 64 + j] = fsin(fr * a);
    }
    __syncthreads();
    {
        float a = p.in[I_HB3][j];
#pragma unroll 16
        for (int i = 0; i < 64; ++i) a += hb[pp * 64 + i] * w3s[i * 64 + j];
        __syncthreads();
        ha[pp * 64 + j] = fsin(fr * a);
    }
    __syncthreads();
    float* fraw = (float*)(p.ws + WS_FRAW);
    float* part = (float*)(p.ws + WS_PART);
    const float* w4 = p.in[I_HW4];
    {
        const int lane = tid & 63, wave = tid >> 6, l15 = lane & 15, lk = lane >> 4;
        float af[16];
#pragma unroll
        for (int ks = 0; ks < 16; ++ks) af[ks] = ha[l15 * 64 + ks * 4 + lk];
        const float mind = -3.0701134573253945f, maxd = -15.350567286626973f;
        const unsigned wvo = (unsigned)((lk * 2048 + wave * 128 + 4 * l15) * 4);
        f32x4 bw[16];
#pragma unroll
        for (int ks = 0; ks < 16; ++ks) { const char* bk = (const char*)w4 + (size_t)ks * 32768; asm volatile("" : "+s"(bk)); bw[ks] = *(const f32x4*)(bk + wvo); }
#pragma unroll 1
        for (int g = 0; g < 2; ++g) {
            f32x4 acc[4];
#pragma unroll
            for (int u = 0; u < 4; ++u) acc[u] = f32x4{0.f, 0.f, 0.f, 0.f};
#pragma unroll
            for (int ks = 0; ks < 16; ++ks) {
#pragma unroll
                for (int u = 0; u < 4; ++u) acc[u] = __builtin_amdgcn_mfma_f32_16x16x4f32(af[ks], bw[ks][u], acc[u], 0, 0, 0);
                if (g == 0) { const char* bk = (const char*)w4 + (size_t)ks * 32768 + 256; asm volatile("" : "+s"(bk)); bw[ks] = *(const f32x4*)(bk + wvo); }
            }
#pragma unroll
            for (int u = 0; u < 4; ++u) {
                const int col = wave * 128 + 64 * g + 4 * l15 + u;
                const int c = col & 511, dir = (col >> 9) & 1;
                const float delta = fabsf(mind + (float)c * ((maxd - mind) / 511.f));
                float sabs = 0.f, v[4];
#pragma unroll
                for (int r = 0; r < 4; ++r) {
                    const int t = t0 + 4 * lk + r;
                    const float t01 = (float)t / (float)(SEQ - 1);
                    v[r] = acc[u][r] * expf(-t01 * delta);
                    if (!(dir == 1 && t == 0)) sabs += fabsf(v[r]);
                }
                *(f32x4*)(fraw + (size_t)col * SEQ + t0 + 4 * lk) = f32x4{v[0], v[1], v[2], v[3]};
                sabs = sum_x32(sum_x16(sabs));
                if (lk == 0) part[item * 2048 + col] = sabs;
            }
        }
    }
    __syncthreads();
}

DI void phase_a(const Params& p, float* sm) {
    constexpr int T_WIN = 16 * 17, T_AO = 8 * 4, T_HO = 8 * 4, T_WO = 16 * 4, T_WQ = 16 * 8;
    constexpr int E0 = T_WIN, E1 = E0 + T_AO, E2 = E1 + T_HO, E3 = E2 + T_WO, E4 = E3 + T_WQ;
    constexpr int E5 = E4 + 64;
    constexpr int E6 = E5 + 384;
    constexpr int E7 = E6 + 1;
    constexpr int E8 = E7 + 256;
    for (int it = blockIdx.x; it < E8; it += gridDim.x) {
        int item = it;
        if (item < 256) { filter_item(p, item, sm); if (PROBE_PHASE == 30 && blockIdx.x == 0 && get_tid() == 0) ((volatile unsigned long long*)(g_lds + LDS_PROBE_OFF))[1] = __builtin_amdgcn_s_memrealtime(); continue; }
        item -= 256;
        if (item < 384) { mod_item(p, item, sm); if (PROBE_PHASE == 31 && blockIdx.x == 0 && get_tid() == 0) ((volatile unsigned long long*)(g_lds + LDS_PROBE_OFF))[1] = __builtin_amdgcn_s_memrealtime(); continue; }
        item -= 384;
        if (item < 1) {
            const int tid = get_tid();
            float* rope = (float*)(p.ws + WS_ROPE);
            const int pos = tid >> 4, f = tid & 15;
            const float inv = powf(10000.f, -(float)(2 * f) / 32.f);
            const float ang = (float)pos * inv;
            rope[tid] = fcos(ang); rope[1024 + tid] = fsin(ang);
            continue;
        }
        item -= 1;
        if (item < 64) {
            const int tid = get_tid();
            const float* src = (item < 32) ? p.in[I_PK1] : p.in[I_PK2];
            bf16_t* dst = (bf16_t*)(p.ws + WS_KEYS) + (size_t)item * 4096;
            const f32x4 v = *(const f32x4*)(src + (size_t)(item & 31) * 4096 + tid * 4);
            *(u32x2*)(dst + tid * 4) = u32x2{pk2(v[0], v[1]), pk2(v[2], v[3])};
            continue;
        }
        item -= 64;
        if (item < T_WIN) { transpose_tile(p.in[I_WIN], DM, INC, (bf16_t*)(p.ws + WS_WTIN), item, sm); continue; }
        item -= T_WIN;
        if (item < T_AO) { transpose_tile(p.in[I_WAO], QD, DM, (bf16_t*)(p.ws + WS_WTAO), item, sm); continue; }
        item -= T_AO;
        if (item < T_HO) { transpose_tile(p.in[I_WHO], HYD, DM, (bf16_t*)(p.ws + WS_WTHO), item, sm); continue; }
        item -= T_HO;
        if (item < T_WO) { transpose_tile(p.in[I_WO], DM, DM, (bf16_t*)(p.ws + WS_WTO), item, sm); continue; }
        item -= T_WO;
        transpose_tile(p.in[I_PWQ], DM, 2048, (bf16_t*)(p.ws + WS_WTQ), item, sm);
    }
    (void)E1; (void)E2; (void)E3; (void)E4; (void)E5; (void)E6; (void)E7;
}

typedef int i32x8 __attribute__((ext_vector_type(8)));
#define MFMA8(a, b, c) __builtin_amdgcn_mfma_scale_f32_32x32x64_f8f6f4((a), (b), (c), 0, 0, 0, 0x7F7F7F7F, 0, 0x7F7F7F7F)
DI unsigned pk_fp8x4(float a, float b, float c, float d) {
    int w = 0;
    w = __builtin_amdgcn_cvt_pk_fp8_f32(fminf(fmaxf(a, -440.f), 440.f), fminf(fmaxf(b, -440.f), 440.f), w, false);
    w = __builtin_amdgcn_cvt_pk_fp8_f32(fminf(fmaxf(c, -440.f), 440.f), fminf(fmaxf(d, -440.f), 440.f), w, true);
    return (unsigned)w;
}
DI void norm_mod_row(const float* __restrict__ src, const float* __restrict__ g, const float* __restrict__ shift, const float* __restrict__ scale, bf16_t* __restrict__ dst, unsigned char* __restrict__ dst8 = nullptr) {
    const int lane = get_tid() & 63;
    f32x4 v[4];
    float ss = 0.f;
#pragma unroll
    for (int j = 0; j < 4; ++j) { v[j] = *(const f32x4*)(src + j * 256 + lane * 4); ss += v[j][0] * v[j][0] + v[j][1] * v[j][1] + v[j][2] * v[j][2] + v[j][3] * v[j][3]; }
    ss = wave_sum(ss);
    const float rs = rsqrtf(ss * (1.f / DM) + EPS);
#pragma unroll
    for (int j = 0; j < 4; ++j) {
        const int c = j * 256 + lane * 4;
        const f32x4 gg = *(const f32x4*)(g + c), sh = *(const f32x4*)(shift + c), sc = *(const f32x4*)(scale + c);
        float o[4];
#pragma unroll
        for (int e = 0; e < 4; ++e) o[e] = v[j][e] * rs * gg[e] * (1.f + sc[e]) + sh[e];
        *(u32x2*)(dst + c) = u32x2{pk2(o[0], o[1]), pk2(o[2], o[3])};
        if (dst8) *(unsigned*)(dst8 + c) = pk_fp8x4(o[0], o[1], o[2], o[3]);
    }
}

DI void filter_norm_item(const Params& p, int item, float* sm) {
    const int tid = get_tid();
    const int o = item >> 9, c = item & 511;
    const int colf = o * 1024 + c, colb = colf + 512;
    const float* part = (const float*)(p.ws + WS_PART);
    const float* fraw = (const float*)(p.ws + WS_FRAW);
    float v[8], mx = 0.f;
#pragma unroll
    for (int i = 0; i < 8; ++i) {
        const int n = tid * 8 + i;
        v[i] = (n == 0) ? 0.f : (n <= 4096 ? fraw[(size_t)colf * SEQ + 4096 - n] : fraw[(size_t)colb * SEQ + n - 4096]);
        mx = fmaxf(mx, fabsf(v[i]));
    }
    float sacc = 0.f;
    if (tid < 512) sacc = part[(tid & 255) * 2048 + ((tid < 256) ? colf : colb)];
    sacc = wave_sum(sacc); mx = wave_max(mx);
    __syncthreads();
    if ((tid & 63) == 0) { sm[tid >> 6] = sacc; sm[16 + (tid >> 6)] = mx; }
    __syncthreads();
    float tot = EPS, gmx = 0.f;
#pragma unroll
    for (int i = 0; i < 8; ++i) tot += sm[i];
#pragma unroll
    for (int i = 0; i < 16; ++i) gmx = fmaxf(gmx, sm[16 + i]);
    const float inv = 1.f / tot;
    int ex; (void)frexpf(fmaxf(gmx * inv, 1e-30f), &ex);
    const float sc = ldexpf(1.f, 8 - ex), isc = ldexpf(1.f, ex - 8);
    if (tid == 0) ((float*)(p.ws + WS_FSC))[item] = isc;
    const float k = inv * sc;
    int w0 = 0, w1 = 0;
    w0 = __builtin_amdgcn_cvt_pk_fp8_f32(v[0] * k, v[1] * k, w0, false); w0 = __builtin_amdgcn_cvt_pk_fp8_f32(v[2] * k, v[3] * k, w0, true);
    w1 = __builtin_amdgcn_cvt_pk_fp8_f32(v[4] * k, v[5] * k, w1, false); w1 = __builtin_amdgcn_cvt_pk_fp8_f32(v[6] * k, v[7] * k, w1, true);
    *(u32x2*)(p.ws + WS_R + (size_t)item * 8192 + tid * 8) = u32x2{(unsigned)w0, (unsigned)w1};
    __syncthreads();
}

DI void table_conv_item(const Params& p, int ci, unsigned char* lds) {
    const int tid = get_tid();
    const size_t el = (size_t)(ci & 2047) * 8192 + tid * 8;
    const float* src = (ci < 2048 ? p.in[I_PU] : p.in[I_PV]) + el;
    const f32x4 a = *(const f32x4*)src, b = *(const f32x4*)(src + 4);
    const size_t e = el >> 10, col = el & 1023;
    if (ci < 2048) {
        float sq = a[0] * a[0] + a[1] * a[1] + a[2] * a[2] + a[3] * a[3] + b[0] * b[0] + b[1] * b[1] + b[2] * b[2] + b[3] * b[3];
        sq = wave_sum(sq);
        float* wm = (float*)lds;
        __syncthreads();
        if ((tid & 63) == 0) wm[tid >> 6] = sq;
        __syncthreads();
        const int w2 = (tid >> 7) * 2;
        const float rsig = fmaxf(sqrtf((wm[w2] + wm[w2 + 1]) * (1.f / 1024.f)), 1e-30f);
        const float sc = 2.f / rsig;
        if ((tid & 127) == 0) ((float*)(p.ws + WS_USC))[e] = rsig * 0.5f;
        const float xs[8] = {a[0], a[1], a[2], a[3], b[0], b[1], b[2], b[3]};
        unsigned w = 0;
#pragma unroll
        for (int j = 0; j < 8; ++j) {
            const float m = fabsf(xs[j] * sc);
            const unsigned code = (m < 0.25f ? 0u : m < 0.75f ? 1u : m < 1.25f ? 2u : m < 1.75f ? 3u : m < 2.5f ? 4u : m < 3.5f ? 5u : m < 5.f ? 6u : 7u) | (xs[j] < 0.f ? 8u : 0u);
            w |= code << (4 * j);
        }
        *(unsigned*)(p.ws + WS_UT + (el >> 1)) = w;
    } else {
        float sq = a[0] * a[0] + a[1] * a[1] + a[2] * a[2] + a[3] * a[3] + b[0] * b[0] + b[1] * b[1] + b[2] * b[2] + b[3] * b[3];
        sq = wave_sum(sq);
        float* wm = (float*)lds;
        __syncthreads();
        if ((tid & 63) == 0) wm[tid >> 6] = sq;
        __syncthreads();
        const int w2 = (tid >> 7) * 2;
        const float rsig = fmaxf(sqrtf((wm[w2] + wm[w2 + 1]) * (1.f / 1024.f)), 1e-30f);
        const float sc = 2.f / rsig;
        if ((tid & 127) == 0) ((float*)(p.ws + WS_VSC))[e] = rsig * 0.5f;
        const float xs[8] = {a[0], a[1], a[2], a[3], b[0], b[1], b[2], b[3]};
        unsigned wc = 0;
#pragma unroll
        for (int j = 0; j < 8; ++j) {
            const float m = fabsf(xs[j] * sc);
            const unsigned code = (m < 0.25f ? 0u : m < 0.75f ? 1u : m < 1.25f ? 2u : m < 1.75f ? 3u : m < 2.5f ? 4u : m < 3.5f ? 5u : m < 5.f ? 6u : 7u) | (xs[j] < 0.f ? 8u : 0u);
            wc |= code << (4 * j);
        }
        const unsigned wo = (unsigned)dppi<0xB1>((int)wc);
        const int cs = (int)(col & 255), ah = cs >> 7, jp = (cs & 127) >> 3;
        const unsigned wev = (jp & 1) ? wo : wc, wod = (jp & 1) ? wc : wo;
        unsigned char* dst = p.ws + WS_VTAB + ((col >> 8) * 16384 + e) * 128 + 8 * ah + (jp >> 1);
#pragma unroll
        for (int q = 0; q < 4; ++q) {
            const int nt = q + 4 * (jp & 1);
            dst[16 * nt] = (unsigned char)(((wev >> (4 * nt)) & 15u) | (((wod >> (4 * nt)) & 15u) << 4));
        }
    }
}

DI void phase_b(const Params& p, float* sm) {
    const int wave = get_tid() >> 6;
    const float* mod = (const float*)(p.ws + WS_MOD);
    constexpr int ROW_ITEMS = (BT + BATCH * CTX) / 16;
    constexpr int CONV = 2 * 16384 * 1024 / 8192;
    constexpr int SHQ = 8 * 2048 / 16;
    constexpr int W8I = 2048 / 16;
    for (int it = blockIdx.x; it < ROW_ITEMS + 1024 + CONV + SHQ + W8I; it += gridDim.x) {
        if (it < 1024) { filter_norm_item(p, it, sm); continue; }
        if (it >= ROW_ITEMS + 1024 + CONV + SHQ) {
            const int tid = get_tid(), lane = tid & 63, n = (it - ROW_ITEMS - 1024 - CONV - SHQ) * 16 + (tid >> 6);
            const bf16_t* wr = (const bf16_t*)(p.ws + WS_WTIN) + (size_t)(2304 + n) * DM + lane * 16;
            const u32x4 w0 = *(const u32x4*)wr, w1 = *(const u32x4*)(wr + 8);
            const float k = W8_SCALE;
            *(u32x4*)(p.ws + WS_W8G + (size_t)n * DM + lane * 16) = u32x4{pk_fp8x4(bflo(w0[0]) * k, bfhi(w0[0]) * k, bflo(w0[1]) * k, bfhi(w0[1]) * k), pk_fp8x4(bflo(w0[2]) * k, bfhi(w0[2]) * k, bflo(w0[3]) * k, bfhi(w0[3]) * k),
                                                                                pk_fp8x4(bflo(w1[0]) * k, bfhi(w1[0]) * k, bflo(w1[1]) * k, bfhi(w1[1]) * k), pk_fp8x4(bflo(w1[2]) * k, bfhi(w1[2]) * k, bflo(w1[3]) * k, bfhi(w1[3]) * k)};
            continue;
        }
        if (it >= ROW_ITEMS + 1024 + CONV) {
            const int tid = get_tid(), lane = tid & 63, o = (it - ROW_ITEMS - 1024 - CONV) * 16 + (tid >> 6), b = o >> 11, n = o & 2047;
            const bf16_t* wr = (const bf16_t*)(p.ws + WS_WTQ) + (size_t)n * DM + lane * 16;
            const float* sh = mod + b * 6144 + 3072 + lane * 16;
            const u32x4 w0 = *(const u32x4*)wr, w1 = *(const u32x4*)(wr + 8);
            float d = 0.f;
#pragma unroll
            for (int i = 0; i < 4; ++i) { d += bflo(w0[i]) * sh[2 * i] + bfhi(w0[i]) * sh[2 * i + 1] + bflo(w1[i]) * sh[8 + 2 * i] + bfhi(w1[i]) * sh[9 + 2 * i]; }
            d = wave_sum(d);
            if (lane == 0) ((float*)(p.ws + WS_SHQ))[o] = d;
            continue;
        }
        if (it >= ROW_ITEMS + 1024) { table_conv_item(p, it - ROW_ITEMS - 1024, (unsigned char*)sm); continue; }
        const int row = (it - 1024) * 16 + wave;
        if (row < BT) {
            const int b = row >> 12;
            norm_mod_row(p.in[I_X] + (size_t)row * DM, p.in[I_NMIX], mod + b * 6144, mod + b * 6144 + 1024, (bf16_t*)(p.ws + WS_H) + (size_t)row * DM, p.ws + WS_H8 + (size_t)row * DM);
        } else {
            const int r = row - BT;
            norm_mod_row(p.in[I_CTX] + (size_t)r * DM, p.in[I_NMIX], mod + 8 * 6144, mod + 8 * 6144 + 1024, (bf16_t*)(p.ws + WS_HC) + (size_t)r * DM);
        }
    }
}

#define MFMA16(a, b, c) __builtin_amdgcn_mfma_f32_16x16x32_bf16((a), (b), (c), 0, 0, 0)
constexpr int GT_P = 256 * 128;
struct RowLoader {
    const bf16_t* base; int ld;
    static constexpr bool kmajor = false;
    template<int ROWS> DI void issue(unsigned char* tile, int kt, int lane, int wave) const {
#pragma unroll
        for (int i = 0; i < ROWS / 128; ++i) {
            const int grp = i * 16 + wave, row = grp * 8 + (lane >> 3), c = (lane & 7) ^ (lane >> 3);
            __builtin_amdgcn_global_load_lds((const unsigned*)((const char*)base + (unsigned)((row * ld + kt * 64 + c * 8) * 2)), (unsigned*)(tile + grp * 1024), 16, 0, 0);
        }
    }
};

struct ColLoader {
    const bf16_t* base; size_t ld;
    static constexpr bool kmajor = true;
    template<int ROWS> DI void issue(unsigned char* tile, int kt, int lane, int wave) const {
        static_assert(ROWS == 128, "k-major loader: 128-row Q tiles only");
        const int row = wave * 4 + (lane >> 4), c = (lane & 15) ^ (2 * (row & 3));
        __builtin_amdgcn_global_load_lds((const unsigned*)(base + (size_t)(kt * 64 + row) * ld + c * 8), (unsigned*)(tile + wave * 1024), 16, 0, 0);
    }
};
template<int NQ>
DI void gemm_prefetch(const RowLoader& lp, const RowLoader& lq, unsigned char* lds) {
    const int tid = get_tid(), lane = tid & 63, wave = __builtin_amdgcn_readfirstlane(tid >> 6);
    lp.template issue<256>(lds, 0, lane, wave); lq.template issue<NQ * 64>(lds + GT_P, 0, lane, wave);
}
template<int NQ, bool KMAJOR>
DI void gemm_kstep(f32x4 (&acc)[4][NQ], const unsigned char* cur, int wp, int wq, int l15, int lk) {
#pragma unroll
    for (int ks = 0; ks < 2; ++ks) {
        bf16x8 fp[4], fq[NQ];
#pragma unroll
        for (int i = 0; i < 4; ++i) { const int row = wp * 64 + i * 16 + l15; fp[i] = *(const bf16x8*)(cur + row * 128 + (((ks * 4 + lk) ^ (row & 7)) << 4)); }
#pragma unroll
        for (int j = 0; j < NQ; ++j) {
            if constexpr (KMAJOR) {
                const int q4 = l15 >> 2, tokq = wq * (16 * NQ) + j * 16 + 4 * (l15 & 3);
                const unsigned char* ap = cur + GT_P + ((ks * 4 + lk) * 8 + q4) * 256 + (((tokq >> 3) ^ (2 * q4)) << 4) + ((tokq >> 2) & 1) * 8;
                const s16x4 lo = __builtin_amdgcn_ds_read_tr16_b64_v4i16((LAS s16x4*)(LAS unsigned char*)ap);
                const s16x4 hi = __builtin_amdgcn_ds_read_tr16_b64_v4i16((LAS s16x4*)(LAS unsigned char*)(ap + 4 * 256));
                fq[j] = __builtin_shufflevector(lo, hi, 0, 1, 2, 3, 4, 5, 6, 7);
            } else { const int row = wq * (16 * NQ) + j * 16 + l15; fq[j] = *(const bf16x8*)(cur + GT_P + row * 128 + (((ks * 4 + lk) ^ (row & 7)) << 4)); }
        }
#pragma unroll
        for (int i = 0; i < 4; ++i)
#pragma unroll
            for (int j = 0; j < NQ; ++j) acc[i][j] = MFMA16(fp[i], fq[j], acc[i][j]);
    }
}
template<int NQ>
DI void gemm_kstep8(f32x4 (&acc)[4][NQ], const unsigned char* cur, int wp, int wq, int l15, int lk) {
    __builtin_amdgcn_sched_barrier(0);
    i32x8 fp[4];
#pragma unroll
    for (int i = 0; i < 4; ++i) {
        const int row = wp * 64 + i * 16 + l15;
        const u32x4 a = *(const u32x4*)(cur + row * 128 + ((lk ^ (row & 7)) << 4)), b = *(const u32x4*)(cur + row * 128 + (((4 + lk) ^ (row & 7)) << 4));
        fp[i] = i32x8{(int)a[0], (int)a[1], (int)a[2], (int)a[3], (int)b[0], (int)b[1], (int)b[2], (int)b[3]};
    }
    u32x4 qa, qb;
    { const int row = wq * (16 * NQ) + l15; qa = *(const u32x4*)(cur + GT_P + row * 128 + ((lk ^ (row & 7)) << 4)); qb = *(const u32x4*)(cur + GT_P + row * 128 + (((4 + lk) ^ (row & 7)) << 4)); }
#pragma unroll
    for (int j = 0; j < NQ; ++j) {
        const i32x8 fq = i32x8{(int)qa[0], (int)qa[1], (int)qa[2], (int)qa[3], (int)qb[0], (int)qb[1], (int)qb[2], (int)qb[3]};
        if (j + 1 < NQ) { const int row = wq * (16 * NQ) + (j + 1) * 16 + l15; qa = *(const u32x4*)(cur + GT_P + row * 128 + ((lk ^ (row & 7)) << 4)); qb = *(const u32x4*)(cur + GT_P + row * 128 + (((4 + lk) ^ (row & 7)) << 4)); }
#pragma unroll
        for (int i = 0; i < 4; ++i) acc[i][j] = __builtin_amdgcn_mfma_scale_f32_16x16x128_f8f6f4(fp[i], fq, acc[i][j], 0, 0, 0, 0x7F7F7F7F, 0, 0x7F7F7F7F);
        __builtin_amdgcn_sched_barrier(0);
    }
}
template<int NQ, class LQ = RowLoader, class NLQ = RowLoader, bool F8 = false>
DI void gemm_mainloop(f32x4 (&acc)[4][NQ], const RowLoader& lp, const LQ& lq, int nk, unsigned char* lds, bool preissued = false, bool pfnext = false,
                      const RowLoader& nlp = RowLoader{nullptr, 0}, const NLQ& nlq = NLQ{nullptr, 0}) {
    const int tid = get_tid(), lane = tid & 63, wave = __builtin_amdgcn_readfirstlane(tid >> 6), wp = wave >> 2, wq = wave & 3;
    constexpr int QROWS = NQ * 64;
    constexpr int STAGE = GT_P + QROWS * 128;
    if (!preissued) {
        __syncthreads();
        lp.template issue<256>(lds, 0, lane, wave); lq.template issue<QROWS>(lds + GT_P, 0, lane, wave);
    }
    asm volatile("s_waitcnt vmcnt(0)" ::: "memory");
    __syncthreads();
    const int l15 = lane & 15, lk = lane >> 4;
    for (int kt = 0; kt < nk; ++kt) {
        unsigned char* cur = lds + (kt & 1) * STAGE;
        unsigned char* nxt = lds + ((kt + 1) & 1) * STAGE;
        const bool last = kt + 1 == nk;
        if (!last) { lp.template issue<256>(nxt, kt + 1, lane, wave); lq.template issue<QROWS>(nxt + GT_P, kt + 1, lane, wave); }
        else if (pfnext) { nlp.template issue<256>(nxt, 0, lane, wave); nlq.template issue<QROWS>(nxt + GT_P, 0, lane, wave); }
        if constexpr (F8) gemm_kstep8<NQ>(acc, cur, wp, wq, l15, lk); else gemm_kstep<NQ, LQ::kmajor>(acc, cur, wp, wq, l15, lk);
        if (last && pfnext) { asm volatile("s_waitcnt lgkmcnt(0)" ::: "memory"); __builtin_amdgcn_s_barrier(); }
        else { asm volatile("s_waitcnt vmcnt(0)" ::: "memory"); __syncthreads(); }
    }
}
template<int NQ>
DI void gemm_shadow(const RowLoader& lp, const RowLoader& lq, int nk, unsigned char* lds) {
    f32x4 acc[4][NQ];
#pragma unroll
    for (int i = 0; i < 4; ++i)
#pragma unroll
        for (int j = 0; j < NQ; ++j) acc[i][j] = f32x4{0.f, 0.f, 0.f, 0.f};
    if (SHADOW == 1) gemm_mainloop<NQ>(acc, lp, lq, nk, lds);
    else {
        const int tid = get_tid(), lane = tid & 63, wave = __builtin_amdgcn_readfirstlane(tid >> 6), wp = wave >> 2, wq = wave & 3;
        constexpr int QROWS = NQ * 64;
        constexpr int STAGE = GT_P + QROWS * 128;
        const int l15 = lane & 15, lk = lane >> 4;
        bf16x8 fp[4], fq[NQ];
        if (SHADOW == 3) {
#pragma unroll
            for (int i = 0; i < 4; ++i) fp[i] = *(const bf16x8*)(lds + (wp * 64 + i * 16 + l15) * 128 + lk * 16);
#pragma unroll
            for (int j = 0; j < NQ; ++j) fq[j] = *(const bf16x8*)(lds + GT_P + (wq * 16 * NQ + j * 16 + l15) * 128 + lk * 16);
        }
        for (int kt = 0; kt < nk; ++kt) {
            unsigned char* cur = lds + (kt & 1) * STAGE;
#pragma unroll
            for (int ks = 0; ks < 2; ++ks) {
                if (SHADOW == 2 || SHADOW == 4) {
#pragma unroll
                    for (int i = 0; i < 4; ++i) { const int row = wp * 64 + i * 16 + l15; fp[i] = *(const bf16x8*)(cur + row * 128 + (((ks * 4 + lk) ^ (row & 7)) << 4)); }
#pragma unroll
                    for (int j = 0; j < NQ; ++j) { const int row = wq * (16 * NQ) + j * 16 + l15; fq[j] = *(const bf16x8*)(cur + GT_P + row * 128 + (((ks * 4 + lk) ^ (row & 7)) << 4)); }
                }
#pragma unroll
                for (int i = 0; i < 4; ++i)
#pragma unroll
                    for (int j = 0; j < NQ; ++j) acc[i][j] = MFMA16(fp[i], fq[j], acc[i][j]);
            }
            if (SHADOW == 2) asm volatile("" ::: "memory");
            if (SHADOW == 4) __syncthreads();
        }
    }
#pragma unroll
    for (int i = 0; i < 4; ++i)
#pragma unroll
        for (int j = 0; j < NQ; ++j) asm volatile("" :: "v"(acc[i][j]));
}

template<int NQ> DI void gemm_shadow1(const RowLoader& lp, const RowLoader& lq, int nk, unsigned char* lds) {
    f32x4 acc[4][NQ];
#pragma unroll
    for (int i = 0; i < 4; ++i)
#pragma unroll
        for (int j = 0; j < NQ; ++j) acc[i][j] = f32x4{0.f, 0.f, 0.f, 0.f};
    gemm_mainloop<NQ>(acc, lp, lq, nk, lds);
#pragma unroll
    for (int i = 0; i < 4; ++i)
#pragma unroll
        for (int j = 0; j < NQ; ++j) asm volatile("" :: "v"(acc[i][j]));
}
DI void head_epilogue(f32x4 (&acc)[4][4], const float* __restrict__ g, float gscale, const float* __restrict__ rope, bool do_rope, int t_base  , unsigned char* __restrict__ dst  , int lane) {
    const int l15 = lane & 15, lk = lane >> 4;
    float gg[4];
#pragma unroll
    for (int j = 0; j < 4; ++j) gg[j] = g[j * 16 + l15] * gscale;
#pragma unroll
    for (int i = 0; i < 4; ++i) {
#pragma unroll
        for (int r = 0; r < 4; ++r) {
            float ss = 0.f;
#pragma unroll
            for (int j = 0; j < 4; ++j) ss += acc[i][j][r] * acc[i][j][r];
            ss = sum16(ss);
            const float rs = rsqrtf(ss * (1.f / 64.f) + EPS);
            float v[4];
#pragma unroll
            for (int j = 0; j < 4; ++j) v[j] = acc[i][j][r] * rs * gg[j];
            const int t = t_base + i * 16 + lk * 4 + r;
            if (do_rope) {
                const int prow = (t >> 6) & 63, pcol = t & 63;
                const float c0 = rope[prow * 16 + l15], s0 = rope[1024 + prow * 16 + l15];
                const float c1 = rope[pcol * 16 + l15], s1 = rope[1024 + pcol * 16 + l15];
                const float a0 = v[0] * c0 - v[1] * s0, a1 = v[1] * c0 + v[0] * s0;
                const float a2 = v[2] * c1 - v[3] * s1, a3 = v[3] * c1 + v[2] * s1;
                v[0] = a0; v[1] = a1; v[2] = a2; v[3] = a3;
            }
            unsigned char* d = dst + (size_t)(i * 16 + lk * 4 + r) * 64 + l15;
            const int w01 = __builtin_amdgcn_cvt_pk_fp8_f32(v[0], v[1], 0, false), w23 = __builtin_amdgcn_cvt_pk_fp8_f32(v[2], v[3], 0, false);
            d[0] = (unsigned char)w01; d[16] = (unsigned char)(w01 >> 8); d[32] = (unsigned char)w23; d[48] = (unsigned char)(w23 >> 8);
        }
    }
}
DI void tstore_epilogue(f32x4 (&acc)[4][4], bf16_t* __restrict__ dst  , size_t ld, int lane) {
    const int l15 = lane & 15, lk = lane >> 4;
#pragma unroll
    for (int i = 0; i < 4; ++i)
#pragma unroll
        for (int j = 0; j < 4; ++j)
            *(u32x2*)(dst + (size_t)(j * 16 + l15) * ld + i * 16 + lk * 4) = u32x2{pk2(acc[i][j][0], acc[i][j][1]), pk2(acc[i][j][2], acc[i][j][3])};
}

DI void phase_c(const Params& p, unsigned char* lds) {
    constexpr int NTM = BT / 256, NTN = INC / 256;
    constexpr int MAIN = NTM * NTN, TOTAL = MAIN + 8;
    const bf16_t* H = (const bf16_t*)(p.ws + WS_H);
    const bf16_t* HCp = (const bf16_t*)(p.ws + WS_HC);
    const bf16_t* WT = (const bf16_t*)(p.ws + WS_WTIN);
    const float* rope = (const float*)(p.ws + WS_ROPE);
    struct CTile { int tm, tn; bool ctx; RowLoader P, Q; };
    auto c_tile = [&](int it) {
        CTile t; t.ctx = false;
        if (it < MAIN) { const int g = it / (16 * NTN), rem = it % (16 * NTN); t.tn = rem >> 4; t.tm = g * 16 + (rem & 15); }
        else { t.ctx = true; t.tm = it - MAIN; t.tn = 2; }
        const bf16_t* A = t.ctx ? HCp + (size_t)t.tm * 256 * DM : H + (size_t)t.tm * 256 * DM;
        const bf16_t* W = WT + (size_t)t.tn * 256 * DM;
        if (t.tn >= 9) {
            t.P = RowLoader{(const bf16_t*)(p.ws + WS_W8G + (size_t)(t.tn * 256 - 2304) * DM), DM / 2}; t.Q = RowLoader{(const bf16_t*)(p.ws + WS_H8 + (size_t)t.tm * 256 * DM), DM / 2}; }
        else { t.P = RowLoader{A, DM}; t.Q = RowLoader{W, DM}; }
        return t;
    };
    bool pre = false;
    CTile cur = c_tile(blockIdx.x);
    for (int it = blockIdx.x; it < TOTAL; it += gridDim.x) {
        const int tid = get_tid(), lane = tid & 63, wave = tid >> 6, wa = wave >> 2, wb = wave & 3;
        const bool has2 = it + (int)gridDim.x < TOTAL;
        const CTile nx = c_tile(has2 ? it + (int)gridDim.x : it);
        const int tm = cur.tm, tn = cur.tn; const bool ctx = cur.ctx;
        f32x4 acc[4][4];
#pragma unroll
        for (int i = 0; i < 4; ++i)
#pragma unroll
            for (int j = 0; j < 4; ++j) acc[i][j] = f32x4{0.f, 0.f, 0.f, 0.f};
        int nk8 = DM / 128; asm volatile("" : "+s"(nk8));
        if (cur.tn >= 9) gemm_mainloop<4, RowLoader, RowLoader, true>(acc, cur.P, cur.Q, nk8, lds, pre, has2, nx.P, nx.Q);
        else gemm_mainloop<4>(acc, cur.P, cur.Q, DM / 64, lds, pre, has2, nx.P, nx.Q);
        pre = has2; cur = nx;
        if (tn >= 9) {
            unsigned char* st = lds + 64 * 1024;
            constexpr int GS = 272;
            const int l15 = lane & 15, lk = lane >> 4;
#pragma unroll
            for (int i = 0; i < 4; ++i)
#pragma unroll
                for (int j = 0; j < 4; ++j) {
                    unsigned q[4];
#pragma unroll
                    for (int r = 0; r < 4; ++r) q[r] = (unsigned)(255.f * __builtin_amdgcn_rcpf(1.f + __expf(acc[i][j][r] * (-1.f / W8_SCALE))) + 0.5f);
                    *(unsigned*)(st + (wb * 64 + j * 16 + l15) * GS + wa * 64 + i * 16 + lk * 4) = q[0] | (q[1] << 8) | (q[2] << 16) | (q[3] << 24);
                }
            __syncthreads();
            unsigned char* G8 = p.ws + WS_G + (size_t)tm * 256 * GC + (tn * 256 - 2304);
            const int t2 = get_tid();
#pragma unroll
            for (int q = 0; q < 4; ++q) {
                const int idx = t2 + q * NT, row = idx >> 4, ch = idx & 15;
                *(u32x4*)(G8 + (size_t)row * GC + ch * 16) = *(const u32x4*)(st + row * GS + ch * 16);
            }
            continue;
        }
        const int b = ctx ? tm : (tm >> 4);
        const int tpos = ctx ? SEQ + wa * 64 : ((tm & 15) * 256 + wa * 64);
        if (tn < 2) {
            const int h = tn * 4 + wb;
            unsigned char* Q = p.ws + WS_Q + ((size_t)(b * NH + h) * SEQ + tpos) * HD;
            head_epilogue(acc, p.in[I_QNG], 1.4426950408889634f, rope, true, tpos, Q, lane);
        } else if (tn == 2) {
            if (wb < 2) {
                unsigned char* K = p.ws + WS_KB + ((size_t)(b * NKV + wb) * TK + tpos) * HD;
                head_epilogue(acc, p.in[I_KNG], 1.f, rope, !ctx, tpos, K, lane);
            } else {
                unsigned char* V8 = p.ws + WS_VT + (size_t)(b * NKV + (wb - 2)) * HD * TK;
                const int l15 = lane & 15, lk = lane >> 4;
#pragma unroll
                for (int i = 0; i < 4; ++i) {
                    const int k = tpos + i * 16 + lk * 4, kin = k & 63, within = kin & 31;
                    const int pos = (k & ~63) + 32 * ((within >> 2) & 1) + 16 * (kin >> 5) + 4 * (within >> 3);
#pragma unroll
                    for (int j = 0; j < 4; ++j)
                        *(unsigned*)(V8 + (size_t)(j * 16 + l15) * TK + pos) = pk_fp8x4(acc[i][j][0] * VT_SCALE, acc[i][j][1] * VT_SCALE, acc[i][j][2] * VT_SCALE, acc[i][j][3] * VT_SCALE);
                }
            }
        } else {
            const int col = tn * 256 - 768 + wb * 64;
            bf16_t* Z = (bf16_t*)(p.ws + WS_ZT) + (size_t)col * BT + (size_t)b * SEQ + tpos;
            tstore_epilogue(acc, Z, BT, lane);
        }
    }
}

#define MFMA32(a, b, c) __builtin_amdgcn_mfma_f32_32x32x16_bf16((a), (b), (c), 0, 0, 0)
DI bf16x8 pack_step(const f32x16& x, int s) {
    u32x4 pk;
    asm volatile("v_cvt_pk_bf16_f32 %0, %4, %5\n\tv_cvt_pk_bf16_f32 %1, %6, %7\n\tv_cvt_pk_bf16_f32 %2, %8, %9\n\tv_cvt_pk_bf16_f32 %3, %10, %11\n\ts_nop 1"
                 : "=&v"(pk[0]), "=&v"(pk[1]), "=&v"(pk[2]), "=&v"(pk[3])
                 : "v"(x[8 * s]), "v"(x[8 * s + 1]), "v"(x[8 * s + 2]), "v"(x[8 * s + 3]), "v"(x[8 * s + 4]), "v"(x[8 * s + 5]), "v"(x[8 * s + 6]), "v"(x[8 * s + 7]));
    return __builtin_bit_cast(bf16x8, pk);
}

constexpr int AT_KSTR = 64, AT_VSTR = 64, AT_VOFF = 64 * AT_KSTR, AT_STAGE = AT_VOFF + 64 * AT_VSTR;
DI void attn_item(const Params& p, int item, unsigned char* lds) {
    const int tid = get_tid(), lane = tid & 63, wave = tid >> 6;
    const int b = item >> 6, kvh = (item >> 5) & 1, qb = item & 31;
    const int h = kvh * 4 + (wave >> 2), q0 = qb * 128 + (wave & 3) * 32;
    const int qi = lane & 31, hf = lane >> 5;
    const unsigned char* Qp = p.ws + WS_Q + ((size_t)(b * NH + h) * SEQ + q0 + qi) * HD + 32 * hf;
    const u32x4 q0v = *(const u32x4*)Qp, q1v = *(const u32x4*)(Qp + 16);
    const i32x8 qf = i32x8{(int)q0v[0], (int)q0v[1], (int)q0v[2], (int)q0v[3], (int)q1v[0], (int)q1v[1], (int)q1v[2], (int)q1v[3]};
    const unsigned char* Kg = p.ws + WS_KB + (size_t)(b * NKV + kvh) * TK * HD;
    const unsigned char* Vg = p.ws + WS_VT + (size_t)(b * NKV + kvh) * HD * TK;
    constexpr int NTILE = TK / 64;
    f32x16 o0, o1, o2;
#pragma unroll
    for (int i = 0; i < 16; ++i) { o0[i] = 0.f; o1[i] = 0.f; o2[i] = 0.f; }
    __syncthreads();
    constexpr int NSUB = 4, NSTG = NTILE / NSUB;
    static_assert(NTILE % NSUB == 0 && 2 * NSUB * AT_STAGE <= LDS_USER, "attention LDS stages");
    const int wv = __builtin_amdgcn_readfirstlane(tid >> 6);
    auto stage_issue = [&](int stg_idx, int buf) {
#pragma unroll
        for (int e = 0; e < 2; ++e) {
            const int q = 2 * wv + e, j = q >> 3, isV = (q >> 2) & 1, part = q & 3;
            const int row = 16 * part + (lane >> 2), c = (lane & 3) ^ ((row >> 2) & 3), tile = stg_idx * NSUB + j;
            const unsigned char* sp = isV ? Vg + (size_t)row * TK + (size_t)tile * 64 + c * 16 : Kg + ((size_t)tile * 64 + row) * HD + c * 16;
            __builtin_amdgcn_global_load_lds((const unsigned*)sp, (unsigned*)(lds + (buf * NSUB + j) * AT_STAGE + isV * AT_VOFF + part * 1024), 16, 0, 0);
        }
    };
    stage_issue(0, 0);
    asm volatile("s_waitcnt vmcnt(0)" ::: "memory");
    __syncthreads();
    const int sw = (qi >> 2) & 3;
    const int kc0 = qi * AT_KSTR + (((2 * hf) ^ sw) << 4), kc1 = qi * AT_KSTR + (((2 * hf + 1) ^ sw) << 4);
    for (int st = 0; st < NSTG; ++st) {
      const bool more = st + 1 < NSTG;
      if (more) stage_issue(st + 1, (st + 1) & 1);
#pragma unroll 1
      for (int j = 0; j < NSUB; ++j) {
        const unsigned char* cur = lds + ((st & 1) * NSUB + j) * AT_STAGE;
        f32x16 sA, sB;
        {
            f32x16 z;
#pragma unroll
            for (int i = 0; i < 16; ++i) z[i] = 0.f;
            const u32x4 ka0 = *(const u32x4*)(cur + kc0), ka1 = *(const u32x4*)(cur + kc1);
            const u32x4 kb0 = *(const u32x4*)(cur + kc0 + 32 * AT_KSTR), kb1 = *(const u32x4*)(cur + kc1 + 32 * AT_KSTR);
            const i32x8 kfa = i32x8{(int)ka0[0], (int)ka0[1], (int)ka0[2], (int)ka0[3], (int)ka1[0], (int)ka1[1], (int)ka1[2], (int)ka1[3]};
            const i32x8 kfb = i32x8{(int)kb0[0], (int)kb0[1], (int)kb0[2], (int)kb0[3], (int)kb1[0], (int)kb1[1], (int)kb1[2], (int)kb1[3]};
            __builtin_amdgcn_s_setprio(1);
            sA = __builtin_amdgcn_mfma_scale_f32_32x32x64_f8f6f4(kfa, qf, z, 0, 0, 0, 0x7F7F7F7F, 0, 0x7C7C7C7C);
            sB = __builtin_amdgcn_mfma_scale_f32_32x32x64_f8f6f4(kfb, qf, z, 0, 0, 0, 0x7F7F7F7F, 0, 0x7C7C7C7C);
            __builtin_amdgcn_s_setprio(0);
        }
#pragma unroll
        for (int i = 0; i < 16; ++i) sA[i] = __builtin_amdgcn_exp2f(sA[i]);
#pragma unroll
        for (int i = 0; i < 16; ++i) sB[i] = __builtin_amdgcn_exp2f(sB[i]);
        int pb[8];
#pragma unroll
        for (int v = 0; v < 8; ++v) {
            const f32x16& sx = (v >> 2) ? sB : sA;
            const int r0 = 4 * (v & 3);
            int w = __builtin_amdgcn_cvt_pk_bf8_f32(sx[r0], sx[r0 + 1], 0, false);
            w = __builtin_amdgcn_cvt_pk_bf8_f32(sx[r0 + 2], sx[r0 + 3], w, true);
            pb[v] = w;
        }
        const i32x8 pf = i32x8{pb[0], pb[1], pb[2], pb[3], pb[4], pb[5], pb[6], pb[7]};
#pragma unroll
        for (int db = 0; db < 2; ++db) {
            const unsigned char* vb = cur + AT_VOFF + db * 32 * AT_VSTR;
            const u32x4 a0 = *(const u32x4*)(vb + kc0), a1 = *(const u32x4*)(vb + kc1);
            const i32x8 vf = i32x8{(int)a0[0], (int)a0[1], (int)a0[2], (int)a0[3], (int)a1[0], (int)a1[1], (int)a1[2], (int)a1[3]};
            if (db == 0) o0 = __builtin_amdgcn_mfma_scale_f32_32x32x64_f8f6f4(vf, pf, o0, 0, 1, 0, 0x7F7F7F7F, 0, 0x7F7F7F7F);
            else         o1 = __builtin_amdgcn_mfma_scale_f32_32x32x64_f8f6f4(vf, pf, o1, 0, 1, 0, 0x7F7F7F7F, 0, 0x7F7F7F7F);
        }
        {
            const int one4 = 0x38383838;
            const i32x8 ones = i32x8{one4, one4, one4, one4, one4, one4, one4, one4};
            o2 = __builtin_amdgcn_mfma_scale_f32_32x32x64_f8f6f4(ones, pf, o2, 0, 1, 0, 0x7F7F7F7F, 0, 0x7F7F7F7F);
        }
      }
      asm volatile("s_waitcnt vmcnt(0)" ::: "memory");
      __syncthreads();
    }
    const float inv = (1.f / VT_SCALE) / o2[0];
    bf16_t* O;
    {
        const int t2 = get_tid(), lane2 = t2 & 63, wave2 = t2 >> 6;
        const int h2 = kvh * 4 + (wave2 >> 2), q2 = qb * 128 + (wave2 & 3) * 32 + (lane2 & 31);
        O = (bf16_t*)(p.ws + WS_ATT) + ((size_t)b * SEQ + q2) * QD + h2 * HD + 4 * (lane2 >> 5);
    }
#pragma unroll
    for (int g4 = 0; g4 < 4; ++g4) {
        *(u32x2*)(O + 8 * g4)      = u32x2{pk2(o0[4 * g4] * inv, o0[4 * g4 + 1] * inv), pk2(o0[4 * g4 + 2] * inv, o0[4 * g4 + 3] * inv)};
        *(u32x2*)(O + 32 + 8 * g4) = u32x2{pk2(o1[4 * g4] * inv, o1[4 * g4 + 1] * inv), pk2(o1[4 * g4 + 2] * inv, o1[4 * g4 + 3] * inv)};
    }
}

constexpr int HY_USTR = 8208, HY_R = 8 * HY_USTR, HY_RSTR = 16384 + 64;
DI void hy_load_filter(const bf16_t* __restrict__ R, unsigned char* lds, int tid) {
    const int i0 = tid * 8;
    const u32x4 w = *(const u32x4*)(R + i0);
    u32x2 nx = u32x2{0u, 0u};
    if (i0 + 8 < 8192) nx = *(const u32x2*)(R + i0 + 8);
    unsigned char* d = lds + HY_R + i0 * 2;
    *(u32x4*)(d) = w;
    *(u32x4*)(d + HY_RSTR) = u32x4{__builtin_amdgcn_alignbit(w[1], w[0], 16), __builtin_amdgcn_alignbit(w[2], w[1], 16), __builtin_amdgcn_alignbit(w[3], w[2], 16), __builtin_amdgcn_alignbit(nx[0], w[3], 16)};
    *(u32x4*)(d + 2 * HY_RSTR) = u32x4{w[1], w[2], w[3], nx[0]};
    *(u32x4*)(d + 3 * HY_RSTR) = u32x4{__builtin_amdgcn_alignbit(w[2], w[1], 16), __builtin_amdgcn_alignbit(w[3], w[2], 16), __builtin_amdgcn_alignbit(nx[0], w[3], 16), __builtin_amdgcn_alignbit(nx[1], nx[0], 16)};
}
DI void short_conv4(const bf16_t* __restrict__ zrow  , int t4, float w0, float w1, float w2, float bias, float (&out)[4]) {
    const u32x2 v = *(const u32x2*)(zrow + t4);
    const float z0 = bflo(v[0]), z1 = bfhi(v[0]), z2 = bflo(v[1]), z3 = bfhi(v[1]);
    const float zm = (t4 > 0) ? bf2f(zrow[t4 - 1]) : 0.f;
    const float zp = (t4 + 4 < SEQ) ? bf2f(zrow[t4 + 4]) : 0.f;
    out[0] = zm * w0 + z0 * w1 + z1 * w2 + bias;
    out[1] = z0 * w0 + z1 * w1 + z2 * w2 + bias;
    out[2] = z1 * w0 + z2 * w1 + z3 * w2 + bias;
    out[3] = z2 * w0 + z3 * w1 + zp * w2 + bias;
}
DI void hyena_item(const Params& p, int c, unsigned char* lds) {
    const int tid = get_tid(), lane = tid & 63, ig = tid >> 6;
    const bf16_t* ZT = (const bf16_t*)(p.ws + WS_ZT);
    const float* cw = p.in[I_HCW];
    const float* cb = p.in[I_HCB];
    __syncthreads();
    {
        const int b = tid >> 7, tb = (tid & 127) * 32;
        const bf16_t* zrow = ZT + (size_t)c * BT + (size_t)b * SEQ;
        const float w0 = cw[c], w1 = cw[HYC + c], w2 = cw[2 * HYC + c], bias = cb[c];
#pragma unroll
        for (int q = 0; q < 8; ++q) {
            float o[4];
            short_conv4(zrow, tb + 4 * q, w0, w1, w2, bias, o);
            *(u32x2*)(lds + b * HY_USTR + (tb + 4 * q) * 2) = u32x2{pk2(o[0], o[1]), pk2(o[2], o[3])};
        }
    }
    const int r = lane & 31, hf = lane >> 5, Il = r >> 3, bb = r & 7;
#pragma unroll 1
    for (int o = 0; o < 2; ++o) {
        hy_load_filter((const bf16_t*)(p.ws + WS_R) + (size_t)(o * 512 + c) * 8192, lds, tid);
        __syncthreads();
        f32x16 acc0, acc1;
#pragma unroll
        for (int i = 0; i < 16; ++i) { acc0[i] = 0.f; acc1[i] = 0.f; }
        const int sh = (-r) & 3;
        const unsigned char* abase = lds + HY_R + sh * HY_RSTR + (4096 + 8 * hf - r - sh) * 2 - 64;
        const unsigned char* ubase = lds + bb * HY_USTR + ((4 * ig + Il) * 64 + 8 * hf) * 2;
#define HY_STEP(MASKED) do { \
            const unsigned char* ap = abase - 128 * d; \
            const unsigned char* ub = ubase - 128 * d; \
            bool valid = true; \
            if (MASKED) { const int J = 4 * ig + Il - d; valid = (unsigned)J < 64u; if (!valid) ub = lds; } \
            _Pragma("unroll") for (int ks = 0; ks < 4; ++ks) { \
                u32x4 braw = *(const u32x4*)(ub + ks * 32); \
                if (MASKED) { if (!valid) braw = u32x4{0u, 0u, 0u, 0u}; } \
                const bf16x8 bf = __builtin_bit_cast(bf16x8, braw); \
                { const s16x4 lo = lds_rd64(ap + 32 * ks + 64), hi = lds_rd64(ap + 32 * ks + 72);     \
                  acc0 = MFMA32(__builtin_shufflevector(lo, hi, 0, 1, 2, 3, 4, 5, 6, 7), bf, acc0); } \
                { const s16x4 lo = lds_rd64(ap + 32 * ks), hi = lds_rd64(ap + 32 * ks + 8); \
                  acc1 = MFMA32(__builtin_shufflevector(lo, hi, 0, 1, 2, 3, 4, 5, 6, 7), bf, acc1); } \
            } } while (0)
        const int dlo = 4 * ig - 63, dhi = 4 * ig + 3;
#pragma unroll 1
        for (int d = dlo; d < dlo + 3; ++d) HY_STEP(true);
#pragma unroll 1
        for (int d = dlo + 3; d <= dhi - 3; ++d) HY_STEP(false);
        if (SHADOW == 6) {
            f32x16 s0 = acc0, s1 = acc1;
            const bf16x8 fa = *(const bf16x8*)(lds + lane * 16), fb = *(const bf16x8*)(lds + 4096 + lane * 16);
#pragma unroll 1
            for (int d = 0; d < 67; ++d) {
#pragma unroll
                for (int ks = 0; ks < 4; ++ks) { s0 = MFMA32(fa, fb, s0); s1 = MFMA32(fa, fb, s1); }
            }
            asm volatile("" :: "v"(s0), "v"(s1));
        }
        if (SHADOW == 7) {
            f32x16 k0 = acc0, k1 = acc1;
#pragma unroll 1
            for (int d = dlo + 3; d <= dhi - 3 + 6; ++d) {
                const unsigned char* ap = abase - 128 * (d > dhi - 3 ? dhi - 3 : d);
                const unsigned char* ub = ubase - 128 * (d > dhi - 3 ? dhi - 3 : d);
#pragma unroll
                for (int ks = 0; ks < 4; ++ks) {
                    const bf16x8 bf = *(const bf16x8*)(ub + ks * 32);
                    { const s16x4 lo = lds_rd64(ap + 32 * ks + 64), hi = lds_rd64(ap + 32 * ks + 72); k0 = MFMA32(__builtin_shufflevector(lo, hi, 0, 1, 2, 3, 4, 5, 6, 7), bf, k0); }
                    { const s16x4 lo = lds_rd64(ap + 32 * ks), hi = lds_rd64(ap + 32 * ks + 8); k1 = MFMA32(__builtin_shufflevector(lo, hi, 0, 1, 2, 3, 4, 5, 6, 7), bf, k1); }
                }
            }
            asm volatile("" :: "v"(k0), "v"(k1));
        }
#pragma unroll 1
        for (int d = dhi - 2; d <= dhi; ++d) HY_STEP(true);
#undef HY_STEP
        __syncthreads();
        const float skip = p.in[I_HSKIP][o * HYD + c];
        const int gcol = (o == 0 ? 512 : 1024) + c;
        const float w0 = cw[gcol], w1 = cw[HYC + gcol], w2 = cw[2 * HYC + gcol], bias = cb[gcol];
        const bf16_t* zrow = ZT + (size_t)gcol * BT + (size_t)bb * SEQ;
        bf16_t* hyt = (bf16_t*)(p.ws + WS_HYT) + (size_t)c * 128 + (size_t)bb * (SEQ / 128) * (512 * 128);
#pragma unroll
        for (int mm = 0; mm < 2; ++mm) {
#pragma unroll
            for (int g4 = 0; g4 < 4; ++g4) {
                const int t4 = (4 * ig + Il) * 64 + 32 * mm + 8 * g4 + 4 * hf;
                float gt[4];
                short_conv4(zrow, t4, w0, w1, w2, bias, gt);
                unsigned char* up = lds + bb * HY_USTR + t4 * 2;
                const u32x2 uv = *(const u32x2*)up;
                const float u0 = bflo(uv[0]), u1 = bfhi(uv[0]), u2 = bflo(uv[1]), u3 = bfhi(uv[1]);
                const f32x16& a = mm ? acc1 : acc0;
                const float y0 = gt[0] * (a[4 * g4] + skip * u0), y1 = gt[1] * (a[4 * g4 + 1] + skip * u1);
                const float y2 = gt[2] * (a[4 * g4 + 2] + skip * u2), y3 = gt[3] * (a[4 * g4 + 3] + skip * u3);
                const u32x2 pk = u32x2{pk2(y0, y1), pk2(y2, y3)};
                if (o == 0) *(u32x2*)up = pk; else *(u32x2*)(hyt + (size_t)(t4 >> 7) * (512 * 128) + (t4 & 127)) = pk;
            }
        }
        __syncthreads();
    }
}

constexpr int HY8_USTR = 4112, HY8_R = 8 * HY8_USTR, HY8_RSTR = 8192 + 32;
constexpr float HY8_US = 16.f;
DI void hy8_load_filter(const unsigned char* __restrict__ R, unsigned char* lds, int tid) {
    const int i0 = tid * 8;
    const unsigned long long lo = *(const unsigned long long*)(R + i0);
    unsigned long long hi = 0ull;
    if (i0 + 8 < 8192) hi = *(const unsigned long long*)(R + i0 + 8);
    unsigned char* d = lds + HY8_R + i0;
    *(unsigned long long*)d = lo;
#pragma unroll
    for (int sft = 1; sft < 8; ++sft) *(unsigned long long*)(d + sft * HY8_RSTR) = (lo >> (8 * sft)) | (hi << (64 - 8 * sft));
}
constexpr int HY8_ZSTR = 8192 + 16;
DI void hy8_stage_z(const Params& p, int col, unsigned char* zs, int lane, int wave) {
    const unsigned char* src = p.ws + WS_ZT + ((size_t)col * BT + (size_t)(wave >> 1) * SEQ) * 2 + (wave & 1) * 4096 + lane * 16;
#pragma unroll
    for (int e = 0; e < 4; ++e) __builtin_amdgcn_global_load_lds((const unsigned*)(src + e * 1024), (unsigned*)(zs + (wave >> 1) * HY8_ZSTR + (wave & 1) * 4096 + e * 1024), 16, 0, 0);
}
DI void short_conv4_lds(const unsigned char* zrow  , int t4, float w0, float w1, float w2, float bias, float (&out)[4]) {
    const u32x2 v = *(const u32x2*)(zrow + 2 * t4);
    const float z0 = bflo(v[0]), z1 = bfhi(v[0]), z2 = bflo(v[1]), z3 = bfhi(v[1]);
    const float zm = (t4 > 0) ? bf2f(*(const bf16_t*)(zrow + 2 * t4 - 2)) : 0.f;
    const float zp = (t4 + 4 < SEQ) ? bf2f(*(const bf16_t*)(zrow + 2 * t4 + 8)) : 0.f;
    out[0] = zm * w0 + z0 * w1 + z1 * w2 + bias;
    out[1] = z0 * w0 + z1 * w1 + z2 * w2 + bias;
    out[2] = z1 * w0 + z2 * w1 + z3 * w2 + bias;
    out[3] = z2 * w0 + z3 * w1 + zp * w2 + bias;
}
DI void hyena_item8(const Params& p, int c, unsigned char* lds) {
    const int tid = get_tid(), lane = tid & 63, ig = tid >> 6;
    const float* cw = p.in[I_HCW];
    const float* cb = p.in[I_HCB];
    unsigned char* zs = lds + HY8_R;
    const int wvu = __builtin_amdgcn_readfirstlane(ig);
    __syncthreads();
    hy8_stage_z(p, c, zs, lane, wvu);
    asm volatile("s_waitcnt vmcnt(0)" ::: "memory");
    __syncthreads();
    {
        const int b = tid >> 7, tb = (tid & 127) * 32;
        const unsigned char* zrow = zs + b * HY8_ZSTR;
        const float w0 = cw[c], w1 = cw[HYC + c], w2 = cw[2 * HYC + c], bias = cb[c];
        unsigned w8[8];
#pragma unroll
        for (int q = 0; q < 8; ++q) {
            float o[4];
            short_conv4_lds(zrow, tb + 4 * q, w0, w1, w2, bias, o);
            w8[q] = pk_fp8x4(o[0] * HY8_US, o[1] * HY8_US, o[2] * HY8_US, o[3] * HY8_US);
        }
        *(u32x4*)(lds + b * HY8_USTR + tb) = u32x4{w8[0], w8[1], w8[2], w8[3]};
        *(u32x4*)(lds + b * HY8_USTR + tb + 16) = u32x4{w8[4], w8[5], w8[6], w8[7]};
    }
    const int r = lane & 31, hf = lane >> 5, Il = r >> 3, bb = r & 7;
    __syncthreads();
#pragma unroll 1
    for (int o = 0; o < 2; ++o) {
        hy8_load_filter(p.ws + WS_R + (size_t)(o * 512 + c) * 8192, lds, tid);
        __syncthreads();
        f32x16 acc0, acc1;
#pragma unroll
        for (int i = 0; i < 16; ++i) { acc0[i] = 0.f; acc1[i] = 0.f; }
        const int sh = (-r) & 7;
        const unsigned char* abase = lds + HY8_R + sh * HY8_RSTR + (4096 + 32 * hf - r - sh) - 32;
        const unsigned char* ubase = lds + bb * HY8_USTR + (4 * ig + Il) * 64 + 32 * hf;
#define HY8_STEP(MASKED) do { \
            const unsigned char* ap = abase - 64 * d; \
            const unsigned char* ub = ubase - 64 * d; \
            bool valid = true; \
            if (MASKED) { const int J = 4 * ig + Il - d; valid = (unsigned)J < 64u; if (!valid) ub = lds; } \
            u32x4 b0 = *(const u32x4*)(ub), b1 = *(const u32x4*)(ub + 16); \
            if (MASKED) { if (!valid) { b0 = u32x4{0u, 0u, 0u, 0u}; b1 = b0; } } \
            const i32x8 bf = i32x8{(int)b0[0], (int)b0[1], (int)b0[2], (int)b0[3], (int)b1[0], (int)b1[1], (int)b1[2], (int)b1[3]}; \
            { const s16x4 q0 = lds_rd64(ap + 32), q1 = lds_rd64(ap + 40), q2 = lds_rd64(ap + 48), q3 = lds_rd64(ap + 56); \
              const u32x2 e0 = __builtin_bit_cast(u32x2, q0), e1 = __builtin_bit_cast(u32x2, q1), e2 = __builtin_bit_cast(u32x2, q2), e3 = __builtin_bit_cast(u32x2, q3); \
              acc0 = MFMA8((i32x8{(int)e0[0], (int)e0[1], (int)e1[0], (int)e1[1], (int)e2[0], (int)e2[1], (int)e3[0], (int)e3[1]}), bf, acc0); } \
            { const s16x4 q0 = lds_rd64(ap), q1 = lds_rd64(ap + 8), q2 = lds_rd64(ap + 16), q3 = lds_rd64(ap + 24); \
              const u32x2 e0 = __builtin_bit_cast(u32x2, q0), e1 = __builtin_bit_cast(u32x2, q1), e2 = __builtin_bit_cast(u32x2, q2), e3 = __builtin_bit_cast(u32x2, q3); \
              acc1 = MFMA8((i32x8{(int)e0[0], (int)e0[1], (int)e1[0], (int)e1[1], (int)e2[0], (int)e2[1], (int)e3[0], (int)e3[1]}), bf, acc1); } \
            } while (0)
        const int dlo = 4 * ig - 63, dhi = 4 * ig + 3;
#pragma unroll 1
        for (int d = dlo; d < dlo + 3; ++d) HY8_STEP(true);
#pragma unroll 1
        for (int d = dlo + 3; d <= dhi - 3; ++d) HY8_STEP(false);
#pragma unroll 1
        for (int d = dhi - 2; d <= dhi; ++d) HY8_STEP(true);
#undef HY8_STEP
        __syncthreads();
        const float skip = p.in[I_HSKIP][o * HYD + c];
        const float asc = ((const float*)(p.ws + WS_FSC))[o * 512 + c] * (1.f / HY8_US);
        const int gcol = (o == 0 ? 512 : 1024) + c;
        const float w0 = cw[gcol], w1 = cw[HYC + gcol], w2 = cw[2 * HYC + gcol], bias = cb[gcol];
        hy8_stage_z(p, gcol, zs, lane, wvu);
        asm volatile("s_waitcnt vmcnt(0)" ::: "memory");
        __syncthreads();
        const unsigned char* zrow = zs + bb * HY8_ZSTR;
        bf16_t* hyt = (bf16_t*)(p.ws + WS_HYT) + (size_t)c * 128 + (size_t)bb * (SEQ / 128) * (512 * 128);
#pragma unroll
        for (int mm = 0; mm < 2; ++mm) {
#pragma unroll
            for (int g4 = 0; g4 < 4; ++g4) {
                const int t4 = (4 * ig + Il) * 64 + 32 * mm + 8 * g4 + 4 * hf;
                float gt[4];
                short_conv4_lds(zrow, t4, w0, w1, w2, bias, gt);
                unsigned* up = (unsigned*)(lds + bb * HY8_USTR + t4);
                const unsigned uv = *up;
                const f32x2 ul = __builtin_amdgcn_cvt_pk_f32_fp8((int)uv, false), uh = __builtin_amdgcn_cvt_pk_f32_fp8((int)uv, true);
                const float us = skip * (1.f / HY8_US);
                const f32x16& a = mm ? acc1 : acc0;
                const float y0 = gt[0] * (a[4 * g4] * asc + us * ul[0]), y1 = gt[1] * (a[4 * g4 + 1] * asc + us * ul[1]);
                const float y2 = gt[2] * (a[4 * g4 + 2] * asc + us * uh[0]), y3 = gt[3] * (a[4 * g4 + 3] * asc + us * uh[1]);
                if (o == 0) *up = pk_fp8x4(y0 * HY8_US, y1 * HY8_US, y2 * HY8_US, y3 * HY8_US);
                else *(u32x2*)(hyt + (size_t)(t4 >> 7) * (512 * 128) + (t4 & 127)) = u32x2{pk2(y0, y1), pk2(y2, y3)};
            }
        }
        __syncthreads();
    }
}

constexpr int CTL_QUEUE_D = 8192;
DI void phase_d(const Params& p, unsigned char* lds) {
    unsigned* ctr = (unsigned*)(p.ws + WS_CTL) + CTL_QUEUE_D;
    volatile LAS unsigned* slot = (volatile LAS unsigned*)(LAS unsigned char*)(lds + LDS_ST_OFF + 8);
    for (;;) {
        __syncthreads();
        if (get_tid() == 0) slot[0] = atomicAdd(ctr, 1u);
        __syncthreads();
        const int it = __builtin_amdgcn_readfirstlane((int)slot[0]);
        if (it >= 1024) break;
        if (it < 512) hyena_item8(p, it, lds); else attn_item(p, it - 512, lds);
    }
}

DI void phase_d2(const Params& p, unsigned char* lds) {
    constexpr int TILES = 8 * (BT / 256);
    const bf16_t* HYT = (const bf16_t*)(p.ws + WS_HYT);
    bf16_t* HY = (bf16_t*)(p.ws + WS_HY);
    for (int it = blockIdx.x; it < TILES; it += gridDim.x) {
        const int tid = get_tid();
        const int c0 = (it & 7) * 64, tok0 = (it >> 3) * 256;
        __syncthreads();
#pragma unroll
        for (int i = 0; i < 2; ++i) {
            const int idx = tid + i * NT, c = idx >> 5, tg = idx & 31;
            *(u32x4*)(lds + c * 528 + tg * 16) = *(const u32x4*)(HYT + (size_t)(c0 + c) * BT + tok0 + tg * 8);
        }
        __syncthreads();
#pragma unroll
        for (int i = 0; i < 2; ++i) {
            const int idx = tid + i * NT, tok = idx >> 3, cg = idx & 7;
            unsigned w[4];
#pragma unroll
            for (int e = 0; e < 4; ++e) {
                const unsigned lo = *(const unsigned short*)(lds + (cg * 8 + 2 * e) * 528 + tok * 2);
                const unsigned hi = *(const unsigned short*)(lds + (cg * 8 + 2 * e + 1) * 528 + tok * 2);
                w[e] = lo | (hi << 16);
            }
            *(u32x4*)(HY + (size_t)(tok0 + tok) * HYD + c0 + cg * 8) = u32x4{w[0], w[1], w[2], w[3]};
        }
    }
}

DI void phase_e(const Params& p, unsigned char* lds) {
    constexpr int TILES = 4 * (BT / 128);
    for (int it = blockIdx.x; it < TILES; it += gridDim.x) {
        const int tid = get_tid(), lane = tid & 63, wave = tid >> 6, wp = wave >> 2, wq = wave & 3;
        const int tn = it & 3, tm = it >> 2;
        const int n0 = tn * 256, tok0 = tm * 128;
        f32x4 acc1[4][2], acc2[4][2];
#pragma unroll
        for (int i = 0; i < 4; ++i)
#pragma unroll
            for (int j = 0; j < 2; ++j) { acc1[i][j] = f32x4{0.f, 0.f, 0.f, 0.f}; acc2[i][j] = f32x4{0.f, 0.f, 0.f, 0.f}; }
        {
            const RowLoader p1{(const bf16_t*)(p.ws + WS_WTAO) + (size_t)n0 * QD, QD}, q1{(const bf16_t*)(p.ws + WS_ATT) + (size_t)tok0 * QD, QD};
            const RowLoader p2{(const bf16_t*)(p.ws + WS_WTHO) + (size_t)n0 * HYD, HYD};
            const ColLoader q2{(const bf16_t*)(p.ws + WS_HYT) + (size_t)tm * (512 * 128), (size_t)128};
            gemm_mainloop<2, RowLoader, ColLoader>(acc1, p1, q1, QD / 64, lds, false, true, p2, q2);
            gemm_mainloop<2, ColLoader, RowLoader>(acc2, p2, q2, HYD / 64, lds, true, false);
        }
        const unsigned char* G8 = p.ws + WS_G;
        bf16_t* M = (bf16_t*)(p.ws + WS_H);
        constexpr int ES = 528, GS = 272, EG2 = 128 * GS;
        __syncthreads();
        {
            u32x4 ga[2], gh[2];
#pragma unroll
            for (int q = 0; q < 2; ++q) {
                const int idx = tid + q * NT, row = idx >> 4, ch = idx & 15;
                const unsigned char* gp = G8 + (size_t)(tok0 + row) * GC + n0 + ch * 16;
                ga[q] = *(const u32x4*)gp; gh[q] = *(const u32x4*)(gp + 1024);
            }
#pragma unroll
            for (int q = 0; q < 2; ++q) {
                const int idx = tid + q * NT, row = idx >> 4, ch = idx & 15;
                *(u32x4*)(lds + row * GS + ch * 16) = ga[q]; *(u32x4*)(lds + EG2 + row * GS + ch * 16) = gh[q];
            }
        }
        __syncthreads();
        const int l15 = lane & 15, lk = lane >> 4;
        u32x2 mo[4][2];
#pragma unroll
        for (int i = 0; i < 4; ++i)
#pragma unroll
            for (int j = 0; j < 2; ++j) {
                const int off = (wq * 32 + j * 16 + l15) * GS + wp * 64 + i * 16 + lk * 4;
                const unsigned ga = *(const unsigned*)(lds + off), gh = *(const unsigned*)(lds + EG2 + off);
                constexpr float K = 1.f / 255.f;
                const float m0 = K * ((float)(ga & 255u) * acc1[i][j][0] + (float)(gh & 255u) * acc2[i][j][0]);
                const float m1 = K * ((float)((ga >> 8) & 255u) * acc1[i][j][1] + (float)((gh >> 8) & 255u) * acc2[i][j][1]);
                const float m2 = K * ((float)((ga >> 16) & 255u) * acc1[i][j][2] + (float)((gh >> 16) & 255u) * acc2[i][j][2]);
                const float m3 = K * ((float)(ga >> 24) * acc1[i][j][3] + (float)(gh >> 24) * acc2[i][j][3]);
                mo[i][j] = u32x2{pk2(m0, m1), pk2(m2, m3)};
            }
        __syncthreads();
#pragma unroll
        for (int i = 0; i < 4; ++i)
#pragma unroll
            for (int j = 0; j < 2; ++j) *(u32x2*)(lds + (wq * 32 + j * 16 + l15) * ES + (wp * 64 + i * 16 + lk * 4) * 2) = mo[i][j];
        __syncthreads();
#pragma unroll
        for (int q = 0; q < 4; ++q) {
            const int idx = tid + q * NT, row = idx >> 5, ch = idx & 31;
            *(u32x4*)(M + (size_t)(tok0 + row) * DM + n0 + ch * 8) = *(const u32x4*)(lds + row * ES + ch * 16);
        }
    }
}

DI void phase_f(const Params& p, unsigned char* lds) {
    constexpr int TILES = 4 * (BT / 256);
    const float* mod = (const float*)(p.ws + WS_MOD);
    for (int it = blockIdx.x; it < TILES; it += gridDim.x) {
        const int tid = get_tid(), lane = tid & 63, wave = tid >> 6, wp = wave >> 2, wq = wave & 3;
        const int tn = it & 3, tm = it >> 2;
        const int n0 = tn * 256, tok0 = tm * 256, b = tok0 >> 12;
        f32x4 acc[4][4];
#pragma unroll
        for (int i = 0; i < 4; ++i)
#pragma unroll
            for (int j = 0; j < 4; ++j) acc[i][j] = f32x4{0.f, 0.f, 0.f, 0.f};
        gemm_mainloop<4>(acc, RowLoader{(const bf16_t*)(p.ws + WS_WTO) + (size_t)n0 * DM, DM}, RowLoader{(const bf16_t*)(p.ws + WS_H) + (size_t)tok0 * DM, DM}, DM / 64, lds);
        const int l15 = lane & 15, lk = lane >> 4;
        constexpr int ES = 528;
        float ss[4] = {0.f, 0.f, 0.f, 0.f};
#pragma unroll
        for (int i = 0; i < 4; ++i) {
            const int n = n0 + wp * 64 + i * 16 + lk * 4;
            const f32x4 g1 = *(const f32x4*)(mod + b * 6144 + 2048 + n);
            const f32x4 s2 = *(const f32x4*)(mod + b * 6144 + 4096 + n), gf = *(const f32x4*)(p.in[I_NFFN] + n);
            const f32x4 gm = f32x4{gf[0] * (1.f + s2[0]), gf[1] * (1.f + s2[1]), gf[2] * (1.f + s2[2]), gf[3] * (1.f + s2[3])};
#pragma unroll
            for (int j = 0; j < 4; ++j) {
                const int tl = wq * 64 + j * 16 + l15;
                const f32x4 xv = *(const f32x4*)(p.in[I_X] + (size_t)(tok0 + tl) * DM + n);
                const f32x4 x1 = f32x4{xv[0] + g1[0] * acc[i][j][0], xv[1] + g1[1] * acc[i][j][1], xv[2] + g1[2] * acc[i][j][2], xv[3] + g1[3] * acc[i][j][3]};
                *(u32x2*)((bf16_t*)(p.out + (size_t)(tok0 + tl) * DM) + n) = u32x2{pk2(x1[0], x1[1]), pk2(x1[2], x1[3])};
                ss[j] += x1[0] * x1[0] + x1[1] * x1[1] + x1[2] * x1[2] + x1[3] * x1[3];
                *(u32x2*)(lds + tl * ES + (wp * 64 + i * 16 + lk * 4) * 2) = u32x2{pk2(x1[0] * gm[0], x1[1] * gm[1]), pk2(x1[2] * gm[2], x1[3] * gm[3])};
            }
        }
#pragma unroll
        for (int j = 0; j < 4; ++j) {
            const float t = sum_x32(sum_x16(ss[j]));
            if (lk == 0) ((float*)(p.ws + WS_SSQ1))[(size_t)(tok0 + wq * 64 + j * 16 + l15) * 16 + tn * 4 + wp] = t;
        }
        __syncthreads();
        bf16_t* Y = (bf16_t*)(p.ws + WS_Y);
#pragma unroll
        for (int q = 0; q < 8; ++q) {
            const int idx = tid + q * NT, row = idx >> 5, ch = idx & 31;
            *(u32x4*)(Y + (size_t)(tok0 + row) * DM + n0 + ch * 8) = *(const u32x4*)(lds + row * ES + ch * 16);
        }
    }
}

DI void ins16(float (&L)[16], float v) {
#pragma unroll
    for (int i = 0; i < 16; ++i) { const float hi = fmaxf(L[i], v); v = fminf(L[i], v); L[i] = hi; }
}
DI void cex_desc(float& a, float& b) { const float hi = fmaxf(a, b), lo = fminf(a, b); a = hi; b = lo; }
DI void bitonic_merge16_desc(float (&v)[16]) {
#pragma unroll
    for (int j = 8; j > 0; j >>= 1)
#pragma unroll
        for (int i = 0; i < 16; ++i) if ((i ^ j) > i) cex_desc(v[i], v[i ^ j]);
}
DI void sort16_desc(float (&v)[16]) {
#pragma unroll
    for (int p = 1; p < 16; p <<= 1)
#pragma unroll
        for (int k = p; k >= 1; k >>= 1)
#pragma unroll
            for (int j = k % p; j <= 15 - k; j += 2 * k)
#pragma unroll
                for (int i = 0; i <= (k - 1 < 15 - j - k ? k - 1 : 15 - j - k); ++i)
                    if ((i + j) / (2 * p) == (i + j + k) / (2 * p)) cex_desc(v[i + j], v[i + j + k]);
}
DI void top16_merge(float (&a)[16], const float (&b)[16]) {
#pragma unroll
    for (int i = 0; i < 16; ++i) a[i] = fmaxf(a[i], b[15 - i]);
    bitonic_merge16_desc(a);
}
DI float pack_idx(float v, unsigned idx, unsigned mask) { return __uint_as_float((__float_as_uint(v) & ~mask) | idx); }
DI void peer_h2_item(const Params& p, int item) {
    const int tok0 = item * 128;
    const int tid = get_tid(), lane = tid & 63, wave = tid >> 6, b = tok0 >> 12;
    const float* sh2 = (const float*)(p.ws + WS_MOD) + b * 6144 + 3072 + lane * 16;
    float sh[16];
#pragma unroll
    for (int i = 0; i < 16; i += 4) { const f32x4 v = *(const f32x4*)(sh2 + i); sh[i] = v[0]; sh[i + 1] = v[1]; sh[i + 2] = v[2]; sh[i + 3] = v[3]; }
    u32x4 ny0, ny1; float nsq;
#define S0_LOAD(tk) do { const bf16_t* yr_ = (const bf16_t*)(p.ws + WS_Y) + (size_t)(tk) * DM + lane * 16; ny0 = *(const u32x4*)yr_; ny1 = *(const u32x4*)(yr_ + 8); \
        nsq = ((const float*)(p.ws + WS_SSQ1))[(size_t)(tk) * 16 + (lane & 15)]; } while (0)
    S0_LOAD(tok0 + wave * 8);
#pragma unroll 1
    for (int t = 0; t < 8; ++t) {
        const int tok = tok0 + wave * 8 + t;
        const u32x4 y0 = ny0, y1 = ny1;
        const float sq1 = nsq;
        if (t + 1 < 8) S0_LOAD(tok + 1);
        const float rs = rsqrtf(sum16(sq1) * (1.f / DM) + EPS);
        float f[16];
#pragma unroll
        for (int q = 0; q < 4; ++q) { f[2 * q] = bflo(y0[q]); f[2 * q + 1] = bfhi(y0[q]); f[8 + 2 * q] = bflo(y1[q]); f[9 + 2 * q] = bfhi(y1[q]); }
        float mx = 0.f;
#pragma unroll
        for (int i = 0; i < 16; ++i) { f[i] = rs * f[i] + sh[i]; mx = fmaxf(mx, fabsf(f[i])); }
        mx = fmaxf(wave_max(mx), 1e-30f);
        const float qs = X8_MAX / mx;
        int w8[4];
#pragma unroll
        for (int q = 0; q < 4; ++q) {
            w8[q] = __builtin_amdgcn_cvt_pk_fp8_f32(f[4 * q] * qs, f[4 * q + 1] * qs, 0, false);
            w8[q] = __builtin_amdgcn_cvt_pk_fp8_f32(f[4 * q + 2] * qs, f[4 * q + 3] * qs, w8[q], true);
        }
        *(u32x4*)(p.ws + WS_X8 + (size_t)tok * DM + lane * 16) = u32x4{(unsigned)w8[0], (unsigned)w8[1], (unsigned)w8[2], (unsigned)w8[3]};
        if (lane == 0) ((float*)(p.ws + WS_SX))[tok] = mx * (1.f / X8_MAX);
    }
#undef S0_LOAD
}
DI void peer_scores_top16(const bf16x8 (&bq)[8], const bf16_t* keysU  , int r, int hf, float (&L)[16]) {
    const unsigned ko = (unsigned)((8 * hf + r * 128) * 2);
    f32x16 acc[4];
#pragma unroll
    for (int m = 0; m < 4; ++m)
#pragma unroll
        for (int i = 0; i < 16; ++i) acc[m][i] = 0.f;
#pragma unroll
    for (int ks = 0; ks < 8; ++ks) {
#pragma unroll
        for (int m = 0; m < 4; ++m) {
            const bf16x8 ak = *(const bf16x8*)((const char*)keysU + (ko + (unsigned)(m * 8192)) + ks * 32);
            acc[m] = MFMA32(ak, bq[ks], acc[m]);
        }
    }
    float V[4][16];
#define PK_SORT(m) do { _Pragma("unroll") for (int i = 0; i < 16; ++i) V[m][i] = pack_idx(acc[m][i], (unsigned)((m) * 32 + (i & 3) + 8 * (i >> 2) + 4 * hf), 127u); sort16_desc(V[m]); } while (0)
    PK_SORT(0); PK_SORT(1); top16_merge(V[0], V[1]); __builtin_amdgcn_sched_barrier(0);
    PK_SORT(2); PK_SORT(3); top16_merge(V[2], V[3]); __builtin_amdgcn_sched_barrier(0);
    top16_merge(V[0], V[2]);
#undef PK_SORT
    const int hf3 = (get_tid() >> 5) & 1;
    float P[16];
#pragma unroll
    for (int i = 0; i < 16; ++i) {
        auto sw = __builtin_amdgcn_permlane32_swap(__float_as_uint(V[0][i]), __float_as_uint(V[0][i]), false, false);
        P[i] = hf3 ? __uint_as_float(sw[0]) : __uint_as_float(sw[1]);
    }
    top16_merge(V[0], P);
#pragma unroll
    for (int i = 0; i < 16; ++i) L[i] = V[0][i];
}
DI void peer_pick(const Params& p, const float* l1, const float* l2, int tokg, int h) {
    float v1[16], v2[16];
#pragma unroll
    for (int i = 0; i < 16; i += 4) {
        const f32x4 a = *(const f32x4*)(l1 + i), b = *(const f32x4*)(l2 + i);
        v1[i] = a[0]; v1[i + 1] = a[1]; v1[i + 2] = a[2]; v1[i + 3] = a[3];
        v2[i] = b[0]; v2[i + 1] = b[1]; v2[i + 2] = b[2]; v2[i + 3] = b[3];
    }
    float B[16];
#pragma unroll
    for (int i = 0; i < 16; ++i) B[i] = -3.0e38f;
#pragma unroll
    for (int i = 0; i < 16; ++i)
#pragma unroll
        for (int j = 0; j < 16; ++j)
            if ((i + 1) * (j + 1) <= 16) ins16(B, pack_idx(v1[i] + v2[j], (unsigned)(i * 16 + j), 255u));
    float e[16], sum = 0.f;
#pragma unroll
    for (int k = 0; k < 16; ++k) { e[k] = __expf(B[k] - B[0]); sum += e[k]; }
    const float inv = 1.f / sum;
    int* ex = (int*)(p.ws + WS_EXPI) + (size_t)tokg * 128 + h * 16;
    float* gt = (float*)(p.ws + WS_GATE) + ((size_t)tokg * 128 + h * 16) * 2;
    const float* usc = (const float*)(p.ws + WS_USC);
    int ev[16]; float gv[16], sv[16];
#pragma unroll
    for (int k = 0; k < 16; ++k) {
        const unsigned ij = __float_as_uint(B[k]) & 255u;
        const unsigned i1 = __float_as_uint(l1[ij >> 4]) & 127u, i2 = __float_as_uint(l2[ij & 15u]) & 127u;
        ev[k] = (int)(i1 * 128u + i2);
        gv[k] = e[k] * inv * ((const float*)(p.ws + WS_VSC))[ev[k]];
        sv[k] = usc[ev[k]];
    }
#pragma unroll
    for (int k = 0; k < 16; k += 4) *(u32x4*)(ex + k) = u32x4{(unsigned)ev[k], (unsigned)ev[k + 1], (unsigned)ev[k + 2], (unsigned)ev[k + 3]};
#pragma unroll
    for (int k = 0; k < 16; k += 2) *(f32x4*)(gt + 2 * k) = f32x4{gv[k], sv[k], gv[k + 1], sv[k + 1]};
}
DI void phase_h(const Params& p, unsigned char* lds) {
    for (int it = blockIdx.x; it < BT / 128; it += gridDim.x) peer_h2_item(p, it);
    constexpr int TILES = 8 * (BT / 256);
    constexpr int QS = 528;
    float* rsb = (float*)(lds + 136 * 1024);
    bool pre = false;
    for (int it = blockIdx.x; it < TILES; it += gridDim.x) {
        const int tid = get_tid(), lane = tid & 63, wave = tid >> 6, wp = wave >> 2, wq = wave & 3;
        const int tn = it & 7, tm = it >> 3;
        const int n0 = tn * 256, tok0 = tm * 256, b = tok0 >> 12;
        const int it2 = it + (int)gridDim.x; const bool has2 = it2 < TILES;
        const int n2 = (has2 ? it2 & 7 : tn) * 256, tk2 = (has2 ? it2 >> 3 : tm) * 256;
        __syncthreads();
        if (tid < 256) {
            const float* sq = (const float*)(p.ws + WS_SSQ1) + (size_t)(tok0 + tid) * 16;
            const f32x4 a = *(const f32x4*)sq, c = *(const f32x4*)(sq + 4), d = *(const f32x4*)(sq + 8), e = *(const f32x4*)(sq + 12);
            const float ssq = (a[0] + a[1] + a[2] + a[3]) + (c[0] + c[1] + c[2] + c[3]) + (d[0] + d[1] + d[2] + d[3]) + (e[0] + e[1] + e[2] + e[3]);
            rsb[tid] = rsqrtf(ssq * (1.f / DM) + EPS);
        }
        f32x4 acc[4][4];
#pragma unroll
        for (int i = 0; i < 4; ++i)
#pragma unroll
            for (int j = 0; j < 4; ++j) acc[i][j] = f32x4{0.f, 0.f, 0.f, 0.f};
        gemm_mainloop<4>(acc, RowLoader{(const bf16_t*)(p.ws + WS_WTQ) + (size_t)n0 * DM, DM}, RowLoader{(const bf16_t*)(p.ws + WS_Y) + (size_t)tok0 * DM, DM}, DM / 64, lds, pre);
        pre = has2;
        {
            const float* shq = (const float*)(p.ws + WS_SHQ) + b * 2048;
            const int l15 = lane & 15, lk = lane >> 4;
#pragma unroll
            for (int i = 0; i < 4; ++i) {
                const int nl = wp * 64 + i * 16 + lk * 4;
                const f32x4 sh = *(const f32x4*)(shq + n0 + nl);
#pragma unroll
                for (int j = 0; j < 4; ++j) {
                    const int tl = wq * 64 + j * 16 + l15;
                    const float rs = rsb[tl];
                    *(u32x2*)(lds + tl * QS + nl * 2) = u32x2{pk2(rs * acc[i][j][0] + sh[0], rs * acc[i][j][1] + sh[1]), pk2(rs * acc[i][j][2] + sh[2], rs * acc[i][j][3] + sh[3])};
                }
            }
        }
        __syncthreads();
        float L[16];
        {
            const int t1 = get_tid(), ln = t1 & 63, w1 = __builtin_amdgcn_readfirstlane(t1 >> 6), r = ln & 31, hf = ln >> 5, hpl = w1 & 1, tb = w1 >> 1;
            const int hp = 2 * tn + hpl;
            const bf16_t* keys = (const bf16_t*)(p.ws + WS_KEYS) + (size_t)((hp & 1) * 8 + (hp >> 1)) * 128 * 128;
            const unsigned char* qrow = lds + (tb * 32 + r) * QS + (hpl * 128 + 8 * hf) * 2;
            bf16x8 bq[8];
#pragma unroll
            for (int ks = 0; ks < 8; ++ks) bq[ks] = *(const bf16x8*)(qrow + 32 * ks);
            peer_scores_top16(bq, keys, r, hf, L);
        }
        __syncthreads();
        if (has2) gemm_prefetch<4>(RowLoader{(const bf16_t*)(p.ws + WS_WTQ) + (size_t)n2 * DM, DM}, RowLoader{(const bf16_t*)(p.ws + WS_Y) + (size_t)tk2 * DM, DM}, lds);
        float* lists = (float*)(lds + 96 * 1024);
        {
            const int t2 = get_tid(), ln = t2 & 63, w2 = __builtin_amdgcn_readfirstlane(t2 >> 6);
            if ((ln >> 5) == 0) {
                float* dst = lists + (((w2 >> 1) * 32 + (ln & 31)) * 2 + (w2 & 1)) * 16;
#pragma unroll
                for (int i = 0; i < 16; i += 4) *(f32x4*)(dst + i) = f32x4{L[i], L[i + 1], L[i + 2], L[i + 3]};
            }
        }
        __syncthreads();
        {
            const int t3 = get_tid();
            if (t3 < 256) peer_pick(p, lists + (t3 * 2) * 16, lists + (t3 * 2 + 1) * 16, tok0 + t3, tn);
        }
    }
}

DI float dot16_fp8(const u32x4& w, const float (&x)[16]) {
    float d = 0.f;
#pragma unroll
    for (int i = 0; i < 4; ++i) {
        const auto lo = __builtin_amdgcn_cvt_pk_f32_fp8((int)w[i], false);
        const auto hi = __builtin_amdgcn_cvt_pk_f32_fp8((int)w[i], true);
        d += lo[0] * x[4 * i] + lo[1] * x[4 * i + 1] + hi[0] * x[4 * i + 2] + hi[1] * x[4 * i + 3];
    }
    return d;
}
template<int NPART, class F> DI void run_partitioned(const Params& p, unsigned char* lds, int qbase, int nitems, F&& body) {
    unsigned* ctl = (unsigned*)(p.ws + WS_CTL);
    volatile LAS unsigned* slot = (volatile LAS unsigned*)(LAS unsigned char*)(lds + LDS_ST_OFF + 8);
    const int x0 = (int)(xb_xcc_id() & 7u);
#pragma unroll 1
    for (int pp = 0; pp < NPART; ++pp) {
        const int part = (NPART == 8) ? ((x0 + pp) & 7) : ((((x0 + (pp >> 1)) & 7)) + 8 * (pp & 1));
        for (;;) {
            __syncthreads();
            if (get_tid() == 0) slot[0] = atomicAdd(ctl + qbase + 64 * part, 1u);
            __syncthreads();
            const int it = __builtin_amdgcn_readfirstlane((int)slot[0]);
            if (it >= nitems) break;
            body(part, it);
        }
    }
}
constexpr int CTL_QUEUE_I2 = 8320, CTL_QUEUE_I3 = 9408;
constexpr int UW_BYTES = 8384, UW_H2S = 1040, UW_LIST = 4160, UW_LCAP = 2112;
DI int peer_u_list(unsigned* lst, const u32x4& ia, const u32x4& ib, int part, int) {
    const int lane = get_tid() & 63;
    int cnt = 0;
#pragma unroll
    for (int g = 0; g < 8; ++g) {
        const unsigned id = (g < 4) ? ia[g & 3] : ib[g & 3];
        const unsigned idx = (unsigned)((g < 4 ? 0 : 256) + lane * 4 + (g & 3));
        const bool m = (int)(id >> 11) == part;
        const unsigned long long bm = __ballot(m);
        const int pos = cnt + __builtin_amdgcn_mbcnt_hi((unsigned)(bm >> 32), __builtin_amdgcn_mbcnt_lo((unsigned)bm, 0u));
        if (m) lst[pos] = (idx << 16) | id;
        cnt += __popcll(bm);
    }
    const unsigned last = lst[max(cnt - 1, 0)];
    if (lane < 16) lst[cnt + lane] = last;
    return cnt;
}
DI void peer_u_chunk(const Params& p, int part, int chunk, unsigned char* lds) {
    const int tid = get_tid(), lane = tid & 63, wave = __builtin_amdgcn_readfirstlane(tid >> 6);
    unsigned char* wl = lds + wave * UW_BYTES;
    const int n = lane & 15, kg = lane >> 4;
    const int ln4 = lane >> 2;
    const unsigned char* UT4 = p.ws + WS_UT + (lane & 3) * 16;
    const int bpi = 16 * n + 4 * kg;
    const unsigned char* arow = wl + (n & 3) * UW_H2S + kg * 16;
    const int tokw = chunk * 256 + wave * 4;
    u32x4 pia, pib, ph[4]; f32x4 psx;
#define U_LOAD_IDS(tok) do { const u32x4* ex_ = (const u32x4*)((const int*)(p.ws + WS_EXPI) + (size_t)(tok) * 128) + lane; pia = ex_[0]; pib = ex_[64]; } while (0)
#define U_LOAD_H2(tok) do { const unsigned char* hr_ = p.ws + WS_X8 + (size_t)(tok) * DM + lane * 16; \
        ph[0] = *(const u32x4*)hr_; ph[1] = *(const u32x4*)(hr_ + DM); ph[2] = *(const u32x4*)(hr_ + 2 * DM); ph[3] = *(const u32x4*)(hr_ + 3 * DM); \
        psx = *(const f32x4*)((const float*)(p.ws + WS_SX) + (tok)); } while (0)
#define U_BPERM(dst, src) do { dst[0] = (unsigned)__builtin_amdgcn_ds_bpermute(bpi, (int)src[0]); dst[1] = (unsigned)__builtin_amdgcn_ds_bpermute(bpi, (int)src[1]); \
        dst[2] = (unsigned)__builtin_amdgcn_ds_bpermute(bpi, (int)src[2]); dst[3] = (unsigned)__builtin_amdgcn_ds_bpermute(bpi, (int)src[3]); } while (0)
    U_LOAD_IDS(tokw); U_LOAD_H2(tokw);
    int cntc = peer_u_list((unsigned*)(wl + UW_LIST), pia, pib, part, lane);
    U_LOAD_IDS(tokw + 64);
    int have = -1;
    u32x4 brow[8];
#pragma unroll 1
    for (int s = 0; s < 4; ++s) {
        const int tok0 = tokw + s * 64;
#pragma unroll
        for (int r = 0; r < 4; ++r) *(u32x4*)(wl + r * UW_H2S + lane * 16) = ph[r];
        const f32x4 sx = psx;
        const unsigned* lc = (const unsigned*)(wl + UW_LIST + (s & 1) * UW_LCAP);
        unsigned* ln = (unsigned*)(wl + UW_LIST + ((s + 1) & 1) * UW_LCAP);
        int cntn = 0;
        if (s + 1 < 4) {
            cntn = peer_u_list(ln, pia, pib, part, lane);
            U_LOAD_H2(tok0 + 64);
            if (s + 2 < 4) U_LOAD_IDS(tok0 + 128);
        }
        const int ntiles = (cntc + 15) >> 4;
#pragma unroll 1
        for (int t = 0; t < ntiles; ++t) {
            const unsigned ent = lc[t * 16 + n];
            if (have != s * 64 + t) {
                const unsigned char* rp = UT4 + (size_t)(lc[t * 16 + ln4] & 0x3fffu) * 512;
#pragma unroll
                for (int ks = 0; ks < 8; ++ks) brow[ks] = *(const u32x4*)(rp + ks * 64);
            }
            unsigned entn;
            if (t + 1 < ntiles) { entn = lc[(t + 1) * 16 + ln4]; have = s * 64 + t + 1; }
            else if (cntn > 0) { entn = ln[ln4]; have = (s + 1) * 64; }
            else { entn = lc[t * 16 + ln4]; have = -1; }
            const unsigned char* rpn = UT4 + (size_t)(entn & 0x3fffu) * 512;
            const int idx = (int)(ent >> 16), tj = idx >> 7;
            const f32x2 gs = ((const f32x2*)(p.ws + WS_GATE))[(size_t)(tok0 + tj) * 128 + (idx & 127)];
            f32x4 acc0 = f32x4{0.f, 0.f, 0.f, 0.f}, acc1 = acc0;
            u32x4 a0 = *(const u32x4*)arow, a1 = *(const u32x4*)(arow + 64), bc;
            U_BPERM(bc, brow[0]);
#pragma unroll
            for (int ks = 0; ks < 8; ++ks) {
                const i32x8 av = i32x8{(int)a0[0], (int)a0[1], (int)a0[2], (int)a0[3], (int)a1[0], (int)a1[1], (int)a1[2], (int)a1[3]};
                const i32x8 bv = i32x8{(int)bc[0], (int)bc[1], (int)bc[2], (int)bc[3], 0, 0, 0, 0};
                if (ks < 7) { a0 = *(const u32x4*)(arow + (ks + 1) * 128); a1 = *(const u32x4*)(arow + (ks + 1) * 128 + 64); U_BPERM(bc, brow[ks + 1]); }
                if (ks & 1) acc1 = __builtin_amdgcn_mfma_scale_f32_16x16x128_f8f6f4(av, bv, acc1, 0, 4, 0, 0x7F7F7F7F, 0, 0x7F7F7F7F);
                else        acc0 = __builtin_amdgcn_mfma_scale_f32_16x16x128_f8f6f4(av, bv, acc0, 0, 4, 0, 0x7F7F7F7F, 0, 0x7F7F7F7F);
                brow[ks] = *(const u32x4*)(rpn + ks * 64);
                __builtin_amdgcn_sched_barrier(0);
            }
            const float d0 = acc0[0] + acc1[0], d1 = acc0[1] + acc1[1], d2 = acc0[2] + acc1[2], d3 = acc0[3] + acc1[3];
            const float araw = (tj == 0) ? d0 : (tj == 1) ? d1 : (tj == 2) ? d2 : d3;
            const float sxv = (tj == 0) ? sx[0] : (tj == 1) ? sx[1] : (tj == 2) ? sx[2] : sx[3];
            const float a = araw * (gs[1] * sxv);
            const float y = 0.7978845608028654f * (a + 0.044715f * a * a * a);
            const float th = 1.f - 2.f * __builtin_amdgcn_rcpf(__expf(2.f * y) + 1.f);
            const float w = 0.5f * a * (1.f + th) * gs[0];
            if (kg == 0 && t * 16 + n < cntc) ((u32x2*)(p.ws + WS_PAIRS))[(size_t)(tok0 + tj) * 128 + (idx & 127)] = u32x2{ent & 0x3fffu, __float_as_uint(w)};
        }
        cntc = cntn;
    }
#undef U_BPERM
#undef U_LOAD_IDS
#undef U_LOAD_H2
}
DI void phase_i2(const Params& p, unsigned char* lds) {
    run_partitioned<8>(p, lds, CTL_QUEUE_I2, BT / 256, [&](int part, int it) { peer_u_chunk(p, part, it, lds); });
}
typedef int i32x2_t __attribute__((ext_vector_type(2)));
constexpr int VW_BYTES = 9504, VW_PAIRS = 8192, VW_HI = 9216, VW_LO = 9344, VW_ZERO = 9472;
DI void peer_v_chunk(const Params& p, int p8, int chunk, unsigned char* lds) {
    const int tid = get_tid(), lane = tid & 63, wave = __builtin_amdgcn_readfirstlane(tid >> 6);
    unsigned char* wl = lds + wave * VW_BYTES;
    const int slice = p8 & 3;
    const unsigned char* VT4 = p.ws + WS_VTAB + (size_t)slice * 16384 * 128;
    const float* mod = (const float*)(p.ws + WS_MOD);
    const int er = lane >> 3, pc = lane & 7;
    const int n = lane & 31, kg = lane >> 5;
    const int col = slice * 256 + 8 * n;
    const int tokw = (p8 >> 2) * 16384 + chunk * 256 + wave;
    if (lane < 4) ((unsigned*)(wl + VW_ZERO))[lane] = 0u;
    const unsigned char* abase = wl + ((n == 0) ? VW_HI + 16 * kg : (n == 1) ? VW_LO + 16 * kg : VW_ZERO);
    const int astep = (n < 2) ? 1 : 0;
    const int row0 = 32 * kg + (lane & 15), sw0 = (row0 >> 1) & 7;
    const unsigned char* tb0 = wl + row0 * 128 + 8 * ((lane >> 4) & 1);
    u32x4 pp = *((const u32x4*)(p.ws + WS_PAIRS + (size_t)tokw * 1024) + lane);
#pragma unroll 1
    for (int step = 0; step < 16; ++step) {
        const int tok = tokw + step * 16, b = tok >> 12;
        *(u32x4*)(wl + VW_PAIRS + lane * 16) = pp;
        const float w0 = __uint_as_float(pp[1]), w1 = __uint_as_float(pp[3]);
        const float mx = fmaxf(wave_max(fmaxf(fabsf(w0), fabsf(w1))), 1e-30f);
        const float ws = 224.f / mx;
        const int hi = __builtin_amdgcn_cvt_pk_fp8_f32(w0 * ws, w1 * ws, 0, false);
        const f32x2 dq = __builtin_amdgcn_cvt_pk_f32_fp8(hi, false);
        const int lo = __builtin_amdgcn_cvt_pk_fp8_f32((w0 * ws - dq[0]) * 16.f, (w1 * ws - dq[1]) * 16.f, 0, false);
        ((unsigned short*)(wl + VW_HI))[lane] = (unsigned short)hi;
        ((unsigned short*)(wl + VW_LO))[lane] = (unsigned short)lo;
        if (step + 1 < 16) pp = *((const u32x4*)(p.ws + WS_PAIRS + (size_t)(tok + 16) * 1024) + lane);
        bf16_t* xo = (bf16_t*)(p.out + (size_t)tok * DM) + col;
        const u32x4 x1w = *(const u32x4*)xo;
        const f32x4 g2a = *(const f32x4*)(mod + b * 6144 + 5120 + col), g2b = *(const f32x4*)(mod + b * 6144 + 5120 + col + 4);
        float res[8];
#pragma unroll
        for (int i = 0; i < 8; ++i) res[i] = 0.f;
#pragma unroll 1
        for (int hf = 0; hf < 2; ++hf) {
            asm volatile("s_waitcnt lgkmcnt(0)" ::: "memory");
            __builtin_amdgcn_sched_barrier(0);
            const unsigned* pr = (const unsigned*)(wl + VW_PAIRS) + 2 * (64 * hf + er);
#pragma unroll
            for (int q = 0; q < 8; ++q) {
                const unsigned e = pr[16 * q];
                const int sw = (4 * q + (er >> 1)) & 7;
                __builtin_amdgcn_global_load_lds((const unsigned*)(VT4 + (size_t)e * 128 + ((pc ^ sw) << 4)), (unsigned*)(wl + q * 1024), 16, 0, 0);
            }
            const u32x4 a0 = *(const u32x4*)(abase + astep * (64 * hf)), a1 = *(const u32x4*)(abase + astep * (64 * hf + 32));
            const i32x8 av = i32x8{(int)a0[0], (int)a0[1], (int)a0[2], (int)a0[3], (int)a1[0], (int)a1[1], (int)a1[2], (int)a1[3]};
            asm volatile("s_waitcnt vmcnt(0)" ::: "memory");
            __builtin_amdgcn_sched_barrier(0);
#pragma unroll
            for (int nt = 0; nt < 8; ++nt) {
                const int c = (nt ^ sw0) << 4;
                const i32x2_t b0 = __builtin_amdgcn_ds_read_tr4_b64_v2i32((LAS i32x2_t*)(LAS unsigned char*)(tb0 + c));
                const i32x2_t b1 = __builtin_amdgcn_ds_read_tr4_b64_v2i32((LAS i32x2_t*)(LAS unsigned char*)(tb0 + 16 * 128 + c));
                const i32x8 bv = i32x8{b0[0], b0[1], b1[0], b1[1], 0, 0, 0, 0};
                f32x16 z;
#pragma unroll
                for (int i = 0; i < 16; ++i) z[i] = 0.f;
                const f32x16 d = __builtin_amdgcn_mfma_scale_f32_32x32x64_f8f6f4(av, bv, z, 0, 4, 0, 0x7F7F7F7F, 0, 0x7F7F7F7F);
                res[nt] += d[0] + d[1] * (1.f / 16.f);
            }
        }
        const float iw = mx * (1.f / 224.f);
        float xv[8];
#pragma unroll
        for (int i = 0; i < 4; ++i) { xv[2 * i] = bflo(x1w[i]); xv[2 * i + 1] = bfhi(x1w[i]); }
        float ss = 0.f;
#pragma unroll
        for (int i = 0; i < 8; ++i) { xv[i] += (i < 4 ? g2a[i & 3] : g2b[i & 3]) * (res[i] * iw); ss += xv[i] * xv[i]; }
        if (lane < 32) *(u32x4*)xo = u32x4{pk2(xv[0], xv[1]), pk2(xv[2], xv[3]), pk2(xv[4], xv[5]), pk2(xv[6], xv[7])};
        ss = wave_sum(lane < 32 ? ss : 0.f);
        if (lane == 0) ((float*)(p.ws + WS_SSQ))[(size_t)tok * 8 + slice] = ss;
    }
}
DI void phase_i3(const Params& p, unsigned char* lds) {
    run_partitioned<8>(p, lds, CTL_QUEUE_I3, 16384 / 256, [&](int part, int it) { peer_v_chunk(p, part, it, lds); });
}
DI void phase_i4(const Params& p) {
    const bool bad = xb_ld((unsigned*)(p.ws + WS_CTL) + CTL_BADTID) != 0u || xb_ld((unsigned*)(p.ws + WS_CTL) + XB_TMO) != 0u;
    for (int it = blockIdx.x; it < BT / 16; it += gridDim.x) {
        const int tid = get_tid(), lane = tid & 63, row = it * 16 + (tid >> 6);
        const float* sq = (const float*)(p.ws + WS_SSQ) + (size_t)row * 8;
        const f32x4 s0 = *(const f32x4*)sq;
        const float ss = s0[0] + s0[1] + s0[2] + s0[3];
        float rs = rsqrtf(ss * (1.f / DM) + EPS);
        if (bad) rs = __builtin_nanf("");
        float* o = p.out + (size_t)row * DM;
        u32x2 xw[4];
#pragma unroll
        for (int j = 0; j < 4; ++j) xw[j] = *(const u32x2*)((const bf16_t*)o + j * 256 + lane * 4);
        asm volatile("s_waitcnt vmcnt(0)" ::: "memory");
#pragma unroll
        for (int j = 0; j < 4; ++j) {
            const int c = j * 256 + lane * 4;
            const f32x4 g = *(const f32x4*)(p.in[I_FNG] + c);
            *(f32x4*)(o + c) = f32x4{bflo(xw[j][0]) * rs * g[0], bfhi(xw[j][0]) * rs * g[1], bflo(xw[j][1]) * rs * g[2], bfhi(xw[j][1]) * rs * g[3]};
        }
    }
}

DI float probe_mfma_mixed() {
    const int lane = get_tid() & 63, kg = lane >> 4;
    int aw[8];
#pragma unroll
    for (int v = 0; v < 8; ++v) {
        unsigned w = 0;
#pragma unroll
        for (int b = 0; b < 4; ++b) { const unsigned q = 32u * kg + 4u * v + b; w |= (((q & 63u) + 8u) | ((q >> 6) << 7)) << (8 * b); }
        aw[v] = (int)w;
    }
    const i32x8 av = i32x8{aw[0], aw[1], aw[2], aw[3], aw[4], aw[5], aw[6], aw[7]};
    int c1 = 0, c2 = 0, c4 = 0, c5 = 0; unsigned pi1 = 255;
#pragma unroll 1
    for (int pb = 0; pb < 128; ++pb) {
        const int kgB = pb >> 5, i0 = pb & 31;
        const unsigned hot = (kg == kgB) ? (2u << (4 * (i0 & 7))) : 0u;
        const i32x8 bv = i32x8{(i0 >> 3) == 0 ? (int)hot : 0, (i0 >> 3) == 1 ? (int)hot : 0, (i0 >> 3) == 2 ? (int)hot : 0, (i0 >> 3) == 3 ? (int)hot : 0, 0, 0, 0, 0};
        const f32x4 z = f32x4{0.f, 0.f, 0.f, 0.f};
        const f32x4 dd = __builtin_amdgcn_mfma_scale_f32_16x16x128_f8f6f4(av, bv, z, 0, 4, 0, 0x7F7F7F7F, 0, 0x7F7F7F7F);
        const float d = dd[0];
        unsigned qf = 255;
#pragma unroll 1
        for (unsigned q = 0; q < 128; ++q) { const unsigned byte = ((q & 63u) + 8u) | ((q >> 6) << 7); if (__builtin_amdgcn_cvt_f32_fp8((int)byte, 0) == d) qf = q; }
        c1 += (qf != (unsigned)pb); c2 += (qf != (unsigned)(pb ^ 1));
        { const unsigned k = 64u * (i0 >> 4) + 16u * kgB + (i0 & 15); c4 += (qf != k); }
        { const unsigned k = (unsigned)pb, kgA = (k & 63u) >> 4, j = 16u * (k >> 6) + (k & 15u); c5 += (qf != 32u * kgA + j); }
        if (pb == 1) pi1 = qf;
    }
    return c1 == 0 ? 1.1e6f : c2 == 0 ? 2.2e6f : c4 == 0 ? 4.4e6f : c5 == 0 ? 5.5e6f : (pi1 < 90u ? (10.f + (float)pi1) * 100.f : 7.7e6f);
}

__global__ void __launch_bounds__(NT) mega(Params p) {
    unsigned char* lds = g_lds;
    volatile LAS unsigned* st = (volatile LAS unsigned*)(LAS unsigned char*)(lds + LDS_ST_OFF);
    {
        const unsigned hw = __builtin_amdgcn_s_getreg((5 << 11) | 4);
        if ((threadIdx.x & 63) == 0) g_lds[LDS_WTAB_OFF + hw] = (unsigned char)(threadIdx.x >> 6);
        if (threadIdx.x < 2) st[threadIdx.x] = 0u;
        __syncthreads();
        if (get_tid() != (int)threadIdx.x) ((unsigned*)(p.ws + WS_CTL))[CTL_BADTID] = 1u;
    }
    XcdBarrier bar = xcd_barrier_post((unsigned*)(p.ws + WS_CTL), st);
    float* sm = (float*)lds;

#define STAMP(k, which) do { if (PROBE_PHASE == (k) && blockIdx.x == 0 && get_tid() == 0) ((volatile unsigned long long*)(lds + LDS_PROBE_OFF))[which] = __builtin_amdgcn_s_memrealtime(); } while (0)
    STAMP(21, 0); STAMP(30, 0); STAMP(31, 0);
    STAMP(0, 0); phase_a(p, sm);   xcd_barrier(bar); STAMP(0, 1);
    STAMP(1, 0); phase_b(p, sm);   xcd_barrier(bar); STAMP(1, 1);
    if (PROBE_PHASE == 20) { STAMP(20, 0); xcd_barrier(bar); xcd_barrier(bar); xcd_barrier(bar); xcd_barrier(bar); STAMP(20, 1); }
    STAMP(2, 0); phase_c(p, lds);  xcd_barrier(bar); STAMP(2, 1);
    STAMP(3, 0); phase_d(p, lds);  xcd_barrier(bar); STAMP(3, 1);
    STAMP(5, 0); phase_e(p, lds);  xcd_barrier(bar); STAMP(5, 1);
    STAMP(6, 0); phase_f(p, lds);  xcd_barrier(bar); STAMP(6, 1);
    STAMP(8, 0); phase_h(p, lds);  xcd_barrier(bar); STAMP(8, 1);
    STAMP(10, 0); phase_i2(p, lds); xcd_barrier(bar); STAMP(10, 1);
    STAMP(11, 0); phase_i3(p, lds); xcd_barrier(bar); STAMP(11, 1);
    STAMP(12, 0); phase_i4(p);
    float pm = 0.f;
    if (PROBE_PHASE == 40 && blockIdx.x == 0 && get_tid() < 64) pm = probe_mfma_mixed();
    if (PROBE_PHASE >= 0) {
        xcd_barrier(bar); STAMP(12, 1); STAMP(21, 1);
        if (blockIdx.x == 0 && get_tid() == 0) {
            volatile unsigned long long* ts = (volatile unsigned long long*)(lds + LDS_PROBE_OFF);
            if (PROBE_PHASE == 40) p.out[0] += pm; else
            p.out[0] += (float)(ts[1] - ts[0]) * (0.01f / PROBE_SCALE);
        }
    }
}

extern "C" void kernel_launch(void* const* d_in, const int* in_sizes, int n_in, void* d_out, int out_size, void* d_ws, size_t ws_size, hipStream_t stream) {
    static int grid = 0;
    if (grid == 0) {
        int dev = 0, cus = 0;
        if (hipGetDevice(&dev) != hipSuccess || hipDeviceGetAttribute(&cus, hipDeviceAttributeMultiprocessorCount, dev) != hipSuccess) { fprintf(stderr, "kernel_launch: device query failed\n"); grid = -1; return; }
        if (n_in != N_IN || ws_size < WS_END) { fprintf(stderr, "kernel_launch: unexpected n_in %d or ws_size %zu (< %zu)\n", n_in, ws_size, (size_t)WS_END); grid = -1; return; }
        grid = cus;
    }
    if (grid < 0) return;
    (void)hipMemsetAsync((char*)d_ws + WS_CTL, 0, 64 * 1024, stream);
    Params p{};
    for (int i = 0; i < N_IN; ++i) p.in[i] = (const float*)d_in[i];
    p.out = (float*)d_out; p.ws = (unsigned char*)d_ws;
    hipLaunchKernelGGL(mega, dim3(grid), dim3(NT), 0, stream, p);
}
```

```cpp
#include <hip/hip_runtime.h>
#include <stdint.h>
#include <cstdio>

#define DI __device__ __forceinline__
#define LAS __attribute__((address_space(3)))
typedef unsigned short bf16_t;
typedef short bf16x8 __attribute__((ext_vector_type(8)));
typedef short s16x4 __attribute__((ext_vector_type(4)));
typedef float f32x4 __attribute__((ext_vector_type(4)));
typedef float f32x2 __attribute__((ext_vector_type(2)));
typedef float f32x16 __attribute__((ext_vector_type(16)));
typedef unsigned u32x4 __attribute__((ext_vector_type(4)));
typedef unsigned u32x2 __attribute__((ext_vector_type(2)));

#ifndef PROBE_PHASE
#define PROBE_PHASE (-1)
#endif
#ifndef SHADOW
#define SHADOW 0
#endif
#ifndef PROBE_SCALE
#define PROBE_SCALE 100.f
#endif
constexpr int BATCH = 8, SEQ = 4096, DM = 1024, BT = BATCH * SEQ;
constexpr int CTX = 256, TK = SEQ + CTX;
constexpr int NH = 8, NKV = 2, HD = 64;
constexpr int QD = 512, KVD = 128, HYD = 512, HYC = 1536, GC = 2048, INC = 4352;
constexpr int PH = 8, PNK = 128, PDK = 256, PTOP = 16;
constexpr float EPS = 1e-6f;
constexpr int NT = 1024;

enum { I_X = 0, I_C, I_CTX, I_CCTX, I_ADAW, I_ADAB, I_NMIX, I_NFFN, I_WIN, I_QNG, I_KNG, I_HCW, I_HCB,
       I_HW1, I_HB1, I_HW2, I_HB2, I_HW3, I_HB3, I_HW4, I_HFREQ, I_HSKIP, I_WAO, I_WHO, I_WO, I_PWQ, I_PK1, I_PK2, I_PU, I_PV, I_FNG, N_IN };

constexpr size_t MB = 1024 * 1024;
constexpr size_t WS_CTL   = 0;
constexpr size_t WS_MOD   = 64 * 1024;
constexpr size_t WS_ROPE  = WS_MOD + 9 * 6144 * 4;
static_assert(WS_ROPE + 16 * 1024 + 8 * 2048 * 4 + 4096 <= 512 * 1024, "ws");
constexpr size_t WS_PART  = 512 * 1024;
constexpr size_t WS_WTIN  = 3 * MB;
constexpr size_t WS_WTAO  = WS_WTIN + (size_t)INC * DM * 2;
constexpr size_t WS_WTHO  = WS_WTAO + (size_t)DM * QD * 2;
constexpr size_t WS_WTO   = WS_WTHO + (size_t)DM * HYD * 2;
constexpr size_t WS_WTQ   = WS_WTO + (size_t)DM * DM * 2;
constexpr size_t WS_KEYS  = WS_WTQ + (size_t)2048 * DM * 2;
constexpr size_t WS_R     = WS_KEYS + (size_t)2 * 8 * 128 * 128 * 2;
constexpr size_t WS_KB    = WS_R + (size_t)2 * 512 * 8192 * 2;
constexpr size_t WS_VT    = WS_KB + (size_t)BATCH * NKV * TK * HD * 2;
constexpr size_t WS_HC    = WS_VT + (size_t)BATCH * NKV * TK * HD * 2;
constexpr size_t WS_H     = 60 * MB;
constexpr size_t WS_G     = WS_H + 64 * MB;
constexpr size_t WS_ZT    = WS_G + 128 * MB;
constexpr size_t WS_Q     = WS_ZT + 96 * MB;
constexpr size_t WS_ATT   = WS_Q + 32 * MB;
constexpr size_t WS_HYT   = WS_ATT + 32 * MB;
constexpr size_t WS_TAB   = WS_HYT + 32 * MB;
constexpr size_t WS_END   = WS_TAB + 32 * MB;
static_assert(WS_HC + (size_t)2048 * DM * 2 <= WS_H, "ws overlap");
constexpr size_t WS_FRAW  = WS_ATT;
constexpr size_t WS_HY    = WS_Q;
constexpr size_t WS_UT    = WS_TAB;
constexpr size_t WS_VTAB  = WS_TAB + 16 * MB;
constexpr size_t WS_H8    = WS_ATT;
constexpr size_t WS_W8G   = WS_HYT;
constexpr size_t WS_EXPI  = WS_ATT;
constexpr size_t WS_GATE  = WS_Q;
constexpr size_t WS_PAIRS = WS_HYT;
constexpr size_t WS_SSQ   = WS_PART + 1 * MB;
constexpr size_t WS_USC   = WS_PART + 2 * MB + 320 * 1024;
constexpr size_t WS_Y     = WS_ZT;
constexpr size_t WS_X8    = WS_ZT + 64 * MB;
constexpr size_t WS_SSQ1  = WS_ATT + 16 * MB;
constexpr size_t WS_SX    = WS_PART + 2 * MB + 64 * 1024;
constexpr size_t WS_SHQ   = WS_ROPE + 16 * 1024;
constexpr size_t WS_FSC   = WS_SHQ + 64 * 1024;
constexpr float VSCALE = 64.f;
constexpr float W8_SCALE = 64.f;
constexpr float VT_SCALE = 16.f;
constexpr float X8_MAX = 192.f;

constexpr int CTL_BADTID = 8000;
DI unsigned f2bf(float f) { unsigned u = __builtin_bit_cast(unsigned, f); return (u + 0x7fffu + ((u >> 16) & 1u)) >> 16; }
DI unsigned pk2(float lo, float hi) { return f2bf(lo) | (f2bf(hi) << 16); }
DI float bf2f(unsigned short b) { return __builtin_bit_cast(float, (unsigned)b << 16); }
DI float bflo(unsigned u) { return __builtin_bit_cast(float, u << 16); }
DI float bfhi(unsigned u) { return __builtin_bit_cast(float, u & 0xffff0000u); }
DI float red2pi(float x) { const float k = rintf(x * 0.15915494309189535f); float r = fmaf(-k, 6.2831854820251465f, x); return fmaf(-k, -1.7484555e-7f, r); }
DI float fsin(float x) { return __sinf(red2pi(x)); }
DI float fcos(float x) { return __cosf(red2pi(x)); }
constexpr int LDS_BYTES = 160 * 1024;
constexpr int LDS_ST_OFF = LDS_BYTES - 16;
constexpr int LDS_PROBE_OFF = LDS_BYTES - 16 - 32;
constexpr int LDS_WTAB_OFF = LDS_BYTES - 16 - 32 - 64;
constexpr int LDS_USER = LDS_WTAB_OFF;
__shared__ __attribute__((aligned(16))) unsigned char g_lds[LDS_BYTES];
DI s16x4 lds_rd64(const unsigned char* ptr) { return *(const volatile LAS s16x4*)(const LAS unsigned char*)ptr; }
DI int get_tid() {
    const unsigned hw = __builtin_amdgcn_s_getreg((5 << 11) | 4);
    unsigned w = g_lds[LDS_WTAB_OFF + hw];
    w = __builtin_amdgcn_readfirstlane(w);
    int t;
    asm volatile("v_mbcnt_lo_u32_b32 %0, -1, 0\n\tv_mbcnt_hi_u32_b32 %0, -1, %0\n\tv_lshl_or_b32 %0, %1, 6, %0" : "=&v"(t) : "s"(w));
    return t;
}
template<int CTRL> DI float dppf(float v) { return __uint_as_float(__builtin_amdgcn_update_dpp(0u, __float_as_uint(v), CTRL, 0xF, 0xF, true)); }
template<int CTRL> DI int dppi(int v) { return (int)__builtin_amdgcn_update_dpp(0u, (unsigned)v, CTRL, 0xF, 0xF, true); }
DI float sum16(float v) { v += dppf<0xB1>(v); v += dppf<0x4E>(v); v += dppf<0x141>(v); v += dppf<0x140>(v); return v; }
DI float sum_x16(float v) { auto r = __builtin_amdgcn_permlane16_swap(__float_as_uint(v), __float_as_uint(v), false, false); return __uint_as_float(r[0]) + __uint_as_float(r[1]); }
DI float sum_x32(float v) { auto r = __builtin_amdgcn_permlane32_swap(__float_as_uint(v), __float_as_uint(v), false, false); return __uint_as_float(r[0]) + __uint_as_float(r[1]); }
DI float max_x32(float v) { auto r = __builtin_amdgcn_permlane32_swap(__float_as_uint(v), __float_as_uint(v), false, false); return fmaxf(__uint_as_float(r[0]), __uint_as_float(r[1])); }
DI float wave_sum(float v) { return sum_x32(sum_x16(sum16(v))); }
DI float wave_max(float v) {
    v = fmaxf(v, dppf<0xB1>(v)); v = fmaxf(v, dppf<0x4E>(v)); v = fmaxf(v, dppf<0x141>(v)); v = fmaxf(v, dppf<0x140>(v));
    { auto r = __builtin_amdgcn_permlane16_swap(__float_as_uint(v), __float_as_uint(v), false, false); v = fmaxf(__uint_as_float(r[0]), __uint_as_float(r[1])); }
    { auto r = __builtin_amdgcn_permlane32_swap(__float_as_uint(v), __float_as_uint(v), false, false); v = fmaxf(__uint_as_float(r[0]), __uint_as_float(r[1])); }
    return v;
}


#define XB_TMO      128
#define XB_XCNT(j)  (256  + 64 * (j))
#define XB_XSUB(j)  (1280 + 64 * (j))
#define XB_XGEN(j)  (2304 + 64 * (j))
#define XB_TOP      3328
#define XB_TOPGEN   3392
#define XCD_BAR_WORDS 3456
#define XB_SPIN_CAP (1u << 27)
DI unsigned xb_ld(unsigned* p)              { return __hip_atomic_load(p, __ATOMIC_RELAXED, __HIP_MEMORY_SCOPE_AGENT); }
DI unsigned xb_add(unsigned* p, unsigned v) { return __hip_atomic_fetch_add(p, v, __ATOMIC_RELAXED, __HIP_MEMORY_SCOPE_AGENT); }
DI unsigned xb_xcc_id() { return (unsigned)__builtin_amdgcn_s_getreg((3 << 11) | 20) & 0xFu; }
#define XB_SPIN(cond, bar) do { unsigned _sp = 0; while (cond) { __builtin_amdgcn_s_sleep(1); \
    if ((++_sp & 255u) == 0u) { if (xb_ld(&(bar)[XB_TMO])) break; if (_sp > XB_SPIN_CAP) { atomicAdd(&(bar)[XB_TMO], 1u); break; } } } } while (0)
struct XcdBarrier { unsigned* bar; unsigned x; volatile LAS unsigned* st; };
DI XcdBarrier xcd_barrier_post(unsigned* bar, volatile LAS unsigned* st) {
    XcdBarrier b; b.bar = bar; b.x = xb_xcc_id(); b.st = st;
    if (get_tid() == 0) (void)xb_add(&bar[XB_XCNT(b.x)], 1u);
    return b;
}
DI void xcd_barrier_complete(unsigned* bar, unsigned x, unsigned& nloc, unsigned& nx) {
    const unsigned G = gridDim.x * gridDim.y * gridDim.z;
    unsigned sum, cnt, mine, sp = 0u;
    for (;;) {
        sum = 0u; cnt = 0u; mine = 0u;
#pragma unroll
        for (unsigned j = 0; j < 16; ++j) { const unsigned c = xb_ld(&bar[XB_XCNT(j)]); sum += c; cnt += (c > 0u) ? 1u : 0u; mine = (j == x) ? c : mine; }
        if (sum == G) break;
        __builtin_amdgcn_s_sleep(1);
        if ((++sp & 255u) == 0u) { if (xb_ld(&bar[XB_TMO])) break; if (sp > XB_SPIN_CAP) { atomicAdd(&bar[XB_TMO], 1u); break; } }
    }
    nloc = mine > 0u ? mine : 1u; nx = cnt > 0u ? cnt : 1u;
}
DI void xcd_barrier(const XcdBarrier& b) {
    asm volatile("s_waitcnt vmcnt(0)" ::: "memory");
    __syncthreads();
    if (get_tid() == 0) {
        unsigned* bar = b.bar;
        __builtin_amdgcn_s_waitcnt(0);
        unsigned nloc = b.st[0], nx = b.st[1];
        if (nloc == 0u) { xcd_barrier_complete(bar, b.x, nloc, nx); b.st[0] = nloc; b.st[1] = nx; }
        const unsigned old = xb_add(&bar[XB_XSUB(b.x)], 1u);
        const unsigned gen = old / nloc;
        if (old + 1u == (gen + 1u) * nloc) {
            __builtin_amdgcn_fence(__ATOMIC_RELEASE, "agent");
            asm volatile("s_waitcnt vmcnt(0)" ::: "memory");
            const unsigned og = xb_add(&bar[XB_TOP], 1u);
            const unsigned tg = og / nx;
            if (og + 1u == (tg + 1u) * nx) xb_add(&bar[XB_TOPGEN], 1u);
            else XB_SPIN(xb_ld(&bar[XB_TOPGEN]) == tg, bar);
            __builtin_amdgcn_fence(__ATOMIC_ACQUIRE, "agent");
            xb_add(&bar[XB_XGEN(b.x)], 1u);
            asm volatile("s_waitcnt vmcnt(0)" ::: "memory");
        } else {
            XB_SPIN(xb_ld(&bar[XB_XGEN(b.x)]) == gen, bar);
            __builtin_amdgcn_fence(__ATOMIC_ACQUIRE, "agent");
            asm volatile("s_waitcnt vmcnt(0)" ::: "memory");
        }
    }
    __syncthreads();
}

struct Params { const float* in[N_IN]; float* out; unsigned char* ws; };


DI void transpose_tile(const float* __restrict__ W, int K, int N, bf16_t* __restrict__ Wt, int tile, float* sm) {
    const int tid = get_tid();
    const int ntn = N / 256, tk = tile / ntn, tn = tile % ntn;
    __syncthreads();
#pragma unroll
    for (int i = 0; i < 4; ++i) {
        const int idx = tid + i * NT, kk = idx >> 6, n4 = (idx & 63) * 4;
        const f32x4 v = *(const f32x4*)(W + (size_t)(tk * 64 + kk) * N + tn * 256 + n4);
        float* d = sm + kk * 257 + n4;
        d[0] = v[0]; d[1] = v[1]; d[2] = v[2]; d[3] = v[3];
    }
    __syncthreads();
#pragma unroll
    for (int i = 0; i < 2; ++i) {
        const int idx = tid + i * NT, nn = idx & 255, kg = idx >> 8;
        const float* c = sm + kg * 8 * 257 + nn;
        *(u32x4*)(Wt + (size_t)(tn * 256 + nn) * K + tk * 64 + kg * 8) = u32x4{pk2(c[0], c[257]), pk2(c[2 * 257], c[3 * 257]), pk2(c[4 * 257], c[5 * 257]), pk2(c[6 * 257], c[7 * 257])};
    }
}

DI void mod_item(const Params& p, int item, float* sm) {
    const int tid = get_tid();
    float* sc = sm;
    float* red = sm + 9 * 1024;
    __syncthreads();
    for (int i = tid; i < 9 * 1024; i += NT) {
        const float v = (i < 8 * 1024) ? p.in[I_C][i] : p.in[I_CCTX][i - 8 * 1024];
        sc[i] = v / (1.f + __expf(-v));
    }
    __syncthreads();
    const int col = tid & 15, kg = tid >> 4, n0 = item * 16;
    float acc[9];
#pragma unroll
    for (int r = 0; r < 9; ++r) acc[r] = 0.f;
    const float* w = p.in[I_ADAW] + (size_t)kg * 16 * 6144 + n0 + col;
    float wv[16];
#pragma unroll
    for (int k = 0; k < 16; ++k) wv[k] = w[(size_t)k * 6144];
#pragma unroll
    for (int k = 0; k < 16; ++k)
#pragma unroll
        for (int r = 0; r < 9; ++r) acc[r] += sc[r * 1024 + kg * 16 + k] * wv[k];
#pragma unroll
    for (int r = 0; r < 9; ++r) red[(kg * 9 + r) * 16 + col] = acc[r];
    __syncthreads();
    if (tid < 9 * 16) {
        const int r = tid >> 4, c2 = tid & 15;
        float s = p.in[I_ADAB][n0 + c2];
        for (int g = 0; g < 64; ++g) s += red[(g * 9 + r) * 16 + c2];
        ((float*)(p.ws + WS_MOD))[r * 6144 + n0 + c2] = s;
    }
    __syncthreads();
}

DI void filter_item(const Params& p, int item, float* sm) {
    const int tid = get_tid();
    float* z  = sm;
    float* ha = sm + 16 * 36;
    float* hb = ha + 16 * 64;
    const int t0 = item * 16;
    float* w1s = hb + 16 * 64;
    float* w2s = w1s + 33 * 64;
    float* w3s = w2s + 64 * 64;
    __syncthreads();
    {
        const f32x4 a2 = *(const f32x4*)(p.in[I_HW2] + tid * 4), a3 = *(const f32x4*)(p.in[I_HW3] + tid * 4);
        f32x4 a1 = f32x4{0.f, 0.f, 0.f, 0.f};
        if (tid < 33 * 16) a1 = *(const f32x4*)(p.in[I_HW1] + tid * 4);
        *(f32x4*)(w2s + tid * 4) = a2; *(f32x4*)(w3s + tid * 4) = a3;
        if (tid < 33 * 16) *(f32x4*)(w1s + tid * 4) = a1;
    }
    if (tid < 16 * 33) {
        const int pp = tid / 33, i = tid % 33;
        const int t = t0 + pp;
        float v;
        if (i == 0) v = (float)t / (float)(SEQ - 1);
        else {
            const int fi = (i - 1) & 15;
            const float f = 1e-4f + (float)fi * ((15.f - 1e-4f) / 15.f);
            const float w = 6.283185307179586f * (float)t / (float)SEQ;
            const float a = f * w;
            v = (i <= 16) ? fcos(a) : -fsin(a);
        }
        z[pp * 36 + i] = v;
    }
    __syncthreads();
    const int pp = tid >> 6, j = tid & 63;
    const float fr = p.in[I_HFREQ][j];
    {
        float a = p.in[I_HB1][j];
#pragma unroll 11
        for (int i = 0; i < 33; ++i) a += z[pp * 36 + i] * w1s[i * 64 + j];
        ha[pp * 64 + j] = fsin(fr * a);
    }
    __syncthreads();
    {
        float a = p.in[I_HB2][j];
#pragma unroll 16
        for (int i = 0; i < 64; ++i) a += ha[pp * 64 + i] * w2s[i * 64 + j];
        hb[pp * 64 + j] = fsin(fr * a);
    }
    __syncthreads();
    {
        float a = p.in[I_HB3][j];
#pragma unroll 16
        for (int i = 0; i < 64; ++i) a += hb[pp * 64 + i] * w3s[i * 64 + j];
        __syncthreads();
        ha[pp * 64 + j] = fsin(fr * a);
    }
    __syncthreads();
    float* fraw = (float*)(p.ws + WS_FRAW);
    float* part = (float*)(p.ws + WS_PART);
    const float* w4 = p.in[I_HW4];
    {
        const int lane = tid & 63, wave = tid >> 6, l15 = lane & 15, lk = lane >> 4;
        float af[16];
#pragma unroll
        for (int ks = 0; ks < 16; ++ks) af[ks] = ha[l15 * 64 + ks * 4 + lk];
        const float mind = -3.0701134573253945f, maxd = -15.350567286626973f;
        const unsigned wvo = (unsigned)((lk * 2048 + wave * 128 + 4 * l15) * 4);
        f32x4 bw[16];
#pragma unroll
        for (int ks = 0; ks < 16; ++ks) { const char* bk = (const char*)w4 + (size_t)ks * 32768; asm volatile("" : "+s"(bk)); bw[ks] = *(const f32x4*)(bk + wvo); }
#pragma unroll 1
        for (int g = 0; g < 2; ++g) {
            f32x4 acc[4];
#pragma unroll
            for (int u = 0; u < 4; ++u) acc[u] = f32x4{0.f, 0.f, 0.f, 0.f};
#pragma unroll
            for (int ks = 0; ks < 16; ++ks) {
#pragma unroll
                for (int u = 0; u < 4; ++u) acc[u] = __builtin_amdgcn_mfma_f32_16x16x4f32(af[ks], bw[ks][u], acc[u], 0, 0, 0);
                if (g == 0) { const char* bk = (const char*)w4 + (size_t)ks * 32768 + 256; asm volatile("" : "+s"(bk)); bw[ks] = *(const f32x4*)(bk + wvo); }
            }
#pragma unroll
            for (int u = 0; u < 4; ++u) {
                const int col = wave * 128 + 64 * g + 4 * l15 + u;
                const int c = col & 511, dir = (col >> 9) & 1;
                const float delta = fabsf(mind + (float)c * ((maxd - mind) / 511.f));
                float sabs = 0.f, v[4];
#pragma unroll
                for (int r = 0; r < 4; ++r) {
                    const int t = t0 + 4 * lk + r;
                    const float t01 = (float)t / (float)(SEQ - 1);
                    v[r] = acc[u][r] * expf(-t01 * delta);
                    if (!(dir == 1 && t == 0)) sabs += fabsf(v[r]);
                }
                *(f32x4*)(fraw + (size_t)col * SEQ + t0 + 4 * lk) = f32x4{v[0], v[1], v[2], v[3]};
                sabs = sum_x32(sum_x16(sabs));
                if (lk == 0) part[item * 2048 + col] = sabs;
            }
        }
    }
    __syncthreads();
}

DI void phase_a(const Params& p, float* sm) {
    constexpr int T_WIN = 16 * 17, T_AO = 8 * 4, T_HO = 8 * 4, T_WO = 16 * 4, T_WQ = 16 * 8;
    constexpr int E0 = T_WIN, E1 = E0 + T_AO, E2 = E1 + T_HO, E3 = E2 + T_WO, E4 = E3 + T_WQ;
    constexpr int E5 = E4 + 64;
    constexpr int E6 = E5 + 384;
    constexpr int E7 = E6 + 1;
    constexpr int E8 = E7 + 256;
    for (int it = blockIdx.x; it < E8; it += gridDim.x) {
        int item = it;
        if (item < 256) { filter_item(p, item, sm); if (PROBE_PHASE == 30 && blockIdx.x == 0 && get_tid() == 0) ((volatile unsigned long long*)(g_lds + LDS_PROBE_OFF))[1] = __builtin_amdgcn_s_memrealtime(); continue; }
        item -= 256;
        if (item < 384) { mod_item(p, item, sm); if (PROBE_PHASE == 31 && blockIdx.x == 0 && get_tid() == 0) ((volatile unsigned long long*)(g_lds + LDS_PROBE_OFF))[1] = __builtin_amdgcn_s_memrealtime(); continue; }
        item -= 384;
        if (item < 1) {
            const int tid = get_tid();
            float* rope = (float*)(p.ws + WS_ROPE);
            const int pos = tid >> 4, f = tid & 15;
            const float inv = powf(10000.f, -(float)(2 * f) / 32.f);
            const float ang = (float)pos * inv;
            rope[tid] = fcos(ang); rope[1024 + tid] = fsin(ang);
            continue;
        }
        item -= 1;
        if (item < 64) {
            const int tid = get_tid();
            const float* src = (item < 32) ? p.in[I_PK1] : p.in[I_PK2];
            const f32x4 v = *(const f32x4*)(src + (size_t)(item & 31) * 4096 + tid * 4);
            const int e = tid * 4, kr = e >> 7, dim = e & 127;
            bf16_t* dst = (bf16_t*)(p.ws + WS_KEYS) + ((size_t)(item * 8 + (dim >> 4)) * 64 + ((dim >> 3) & 1) * 32 + kr) * 8 + (dim & 7);
            *(u32x2*)dst = u32x2{pk2(v[0], v[1]), pk2(v[2], v[3])};
            continue;
        }
        item -= 64;
        if (item < T_WIN) { transpose_tile(p.in[I_WIN], DM, INC, (bf16_t*)(p.ws + WS_WTIN), item, sm); continue; }
        item -= T_WIN;
        if (item < T_AO) { transpose_tile(p.in[I_WAO], QD, DM, (bf16_t*)(p.ws + WS_WTAO), item, sm); continue; }
        item -= T_AO;
        if (item < T_HO) { transpose_tile(p.in[I_WHO], HYD, DM, (bf16_t*)(p.ws + WS_WTHO), item, sm); continue; }
        item -= T_HO;
        if (item < T_WO) { transpose_tile(p.in[I_WO], DM, DM, (bf16_t*)(p.ws + WS_WTO), item, sm); continue; }
        item -= T_WO;
        transpose_tile(p.in[I_PWQ], DM, 2048, (bf16_t*)(p.ws + WS_WTQ), item, sm);
    }
    (void)E1; (void)E2; (void)E3; (void)E4; (void)E5; (void)E6; (void)E7;
}

typedef int i32x8 __attribute__((ext_vector_type(8)));
#define MFMA8(a, b, c) __builtin_amdgcn_mfma_scale_f32_32x32x64_f8f6f4((a), (b), (c), 0, 0, 0, 0x7F7F7F7F, 0, 0x7F7F7F7F)
DI unsigned pk_fp8x4(float a, float b, float c, float d) {
    int w = 0;
    w = __builtin_amdgcn_cvt_pk_fp8_f32(fminf(fmaxf(a, -440.f), 440.f), fminf(fmaxf(b, -440.f), 440.f), w, false);
    w = __builtin_amdgcn_cvt_pk_fp8_f32(fminf(fmaxf(c, -440.f), 440.f), fminf(fmaxf(d, -440.f), 440.f), w, true);
    return (unsigned)w;
}
DI void norm_mod_row(const float* __restrict__ src, const float* __restrict__ g, const float* __restrict__ shift, const float* __restrict__ scale, bf16_t* __restrict__ dst, unsigned char* __restrict__ dst8 = nullptr) {
    const int lane = get_tid() & 63;
    f32x4 v[4];
    float ss = 0.f;
#pragma unroll
    for (int j = 0; j < 4; ++j) { v[j] = *(const f32x4*)(src + j * 256 + lane * 4); ss += v[j][0] * v[j][0] + v[j][1] * v[j][1] + v[j][2] * v[j][2] + v[j][3] * v[j][3]; }
    ss = wave_sum(ss);
    const float rs = rsqrtf(ss * (1.f / DM) + EPS);
#pragma unroll
    for (int j = 0; j < 4; ++j) {
        const int c = j * 256 + lane * 4;
        const f32x4 gg = *(const f32x4*)(g + c), sh = *(const f32x4*)(shift + c), sc = *(const f32x4*)(scale + c);
        float o[4];
#pragma unroll
        for (int e = 0; e < 4; ++e) o[e] = v[j][e] * rs * gg[e] * (1.f + sc[e]) + sh[e];
        *(u32x2*)(dst + c) = u32x2{pk2(o[0], o[1]), pk2(o[2], o[3])};
        if (dst8) *(unsigned*)(dst8 + c) = pk_fp8x4(o[0], o[1], o[2], o[3]);
    }
}

DI void filter_norm_item(const Params& p, int item, float* sm) {
    const int tid = get_tid();
    const int o = item >> 9, c = item & 511;
    const int colf = o * 1024 + c, colb = colf + 512;
    const float* part = (const float*)(p.ws + WS_PART);
    const float* fraw = (const float*)(p.ws + WS_FRAW);
    float v[8], mx = 0.f;
#pragma unroll
    for (int i = 0; i < 8; ++i) {
        const int n = tid * 8 + i;
        v[i] = (n == 0) ? 0.f : (n <= 4096 ? fraw[(size_t)colf * SEQ + 4096 - n] : fraw[(size_t)colb * SEQ + n - 4096]);
        mx = fmaxf(mx, fabsf(v[i]));
    }
    float sacc = 0.f;
    if (tid < 512) sacc = part[(tid & 255) * 2048 + ((tid < 256) ? colf : colb)];
    sacc = wave_sum(sacc); mx = wave_max(mx);
    __syncthreads();
    if ((tid & 63) == 0) { sm[tid >> 6] = sacc; sm[16 + (tid >> 6)] = mx; }
    __syncthreads();
    float tot = EPS, gmx = 0.f;
#pragma unroll
    for (int i = 0; i < 8; ++i) tot += sm[i];
#pragma unroll
    for (int i = 0; i < 16; ++i) gmx = fmaxf(gmx, sm[16 + i]);
    const float inv = 1.f / tot;
    int ex; (void)frexpf(fmaxf(gmx * inv, 1e-30f), &ex);
    const float sc = ldexpf(1.f, 8 - ex), isc = ldexpf(1.f, ex - 8);
    if (tid == 0) ((float*)(p.ws + WS_FSC))[item] = isc;
    const float k = inv * sc;
    int w0 = 0, w1 = 0;
    w0 = __builtin_amdgcn_cvt_pk_fp8_f32(v[0] * k, v[1] * k, w0, false); w0 = __builtin_amdgcn_cvt_pk_fp8_f32(v[2] * k, v[3] * k, w0, true);
    w1 = __builtin_amdgcn_cvt_pk_fp8_f32(v[4] * k, v[5] * k, w1, false); w1 = __builtin_amdgcn_cvt_pk_fp8_f32(v[6] * k, v[7] * k, w1, true);
    *(u32x2*)(p.ws + WS_R + (size_t)item * 8192 + tid * 8) = u32x2{(unsigned)w0, (unsigned)w1};
    __syncthreads();
}

DI void table_conv_item(const Params& p, int ci, unsigned char* lds) {
    const int tid = get_tid();
    const size_t el = (size_t)(ci & 2047) * 8192 + tid * 8;
    const float* src = (ci < 2048 ? p.in[I_PU] : p.in[I_PV]) + el;
    const f32x4 a = *(const f32x4*)src, b = *(const f32x4*)(src + 4);
    const size_t e = el >> 10, col = el & 1023;
    if (ci < 2048) {
        float sq = a[0] * a[0] + a[1] * a[1] + a[2] * a[2] + a[3] * a[3] + b[0] * b[0] + b[1] * b[1] + b[2] * b[2] + b[3] * b[3];
        sq = wave_sum(sq);
        float* wm = (float*)lds;
        __syncthreads();
        if ((tid & 63) == 0) wm[tid >> 6] = sq;
        __syncthreads();
        const int w2 = (tid >> 7) * 2;
        const float rsig = fmaxf(sqrtf((wm[w2] + wm[w2 + 1]) * (1.f / 1024.f)), 1e-30f);
        const float sc = 2.f / rsig;
        if ((tid & 127) == 0) ((float*)(p.ws + WS_USC))[2 * e] = rsig * 0.5f;
        const float xs[8] = {a[0], a[1], a[2], a[3], b[0], b[1], b[2], b[3]};
        unsigned w = 0;
#pragma unroll
        for (int j = 0; j < 8; ++j) {
            const float m = fabsf(xs[j] * sc);
            const unsigned code = (m < 0.25f ? 0u : m < 0.75f ? 1u : m < 1.25f ? 2u : m < 1.75f ? 3u : m < 2.5f ? 4u : m < 3.5f ? 5u : m < 5.f ? 6u : 7u) | (xs[j] < 0.f ? 8u : 0u);
            w |= code << (4 * j);
        }
        *(unsigned*)(p.ws + WS_UT + (el >> 1)) = w;
    } else {
        float sq = a[0] * a[0] + a[1] * a[1] + a[2] * a[2] + a[3] * a[3] + b[0] * b[0] + b[1] * b[1] + b[2] * b[2] + b[3] * b[3];
        sq = wave_sum(sq);
        float* wm = (float*)lds;
        __syncthreads();
        if ((tid & 63) == 0) wm[tid >> 6] = sq;
        __syncthreads();
        const int w2 = (tid >> 7) * 2;
        const float rsig = fmaxf(sqrtf((wm[w2] + wm[w2 + 1]) * (1.f / 1024.f)), 1e-30f);
        const float sc = 2.f / rsig;
        if ((tid & 127) == 0) ((float*)(p.ws + WS_USC))[2 * e + 1] = rsig * 0.5f;
        const float xs[8] = {a[0], a[1], a[2], a[3], b[0], b[1], b[2], b[3]};
        unsigned wc = 0;
#pragma unroll
        for (int j = 0; j < 8; ++j) {
            const float m = fabsf(xs[j] * sc);
            const unsigned code = (m < 0.25f ? 0u : m < 0.75f ? 1u : m < 1.25f ? 2u : m < 1.75f ? 3u : m < 2.5f ? 4u : m < 3.5f ? 5u : m < 5.f ? 6u : 7u) | (xs[j] < 0.f ? 8u : 0u);
            wc |= code << (4 * j);
        }
        const unsigned wo = (unsigned)dppi<0xB1>((int)wc);
        const int cs = (int)(col & 255), ah = cs >> 7, jp = (cs & 127) >> 3;
        const unsigned wev = (jp & 1) ? wo : wc, wod = (jp & 1) ? wc : wo;
        unsigned char* dst = p.ws + WS_VTAB + ((col >> 8) * 16384 + e) * 128 + 8 * ah + (jp >> 1);
#pragma unroll
        for (int q = 0; q < 4; ++q) {
            const int nt = q + 4 * (jp & 1);
            dst[16 * nt] = (unsigned char)(((wev >> (4 * nt)) & 15u) | (((wod >> (4 * nt)) & 15u) << 4));
        }
    }
}

DI void phase_b(const Params& p, float* sm) {
    const int wave = get_tid() >> 6;
    const float* mod = (const float*)(p.ws + WS_MOD);
    constexpr int ROW_ITEMS = (BT + BATCH * CTX) / 16;
    constexpr int CONV = 2 * 16384 * 1024 / 8192;
    constexpr int SHQ = 8 * 2048 / 16;
    constexpr int W8I = 2048 / 16;
    for (int it = blockIdx.x; it < ROW_ITEMS + 1024 + CONV + SHQ + W8I; it += gridDim.x) {
        if (it < 1024) { filter_norm_item(p, it, sm); continue; }
        if (it >= ROW_ITEMS + 1024 + CONV + SHQ) {
            const int tid = get_tid(), lane = tid & 63, n = (it - ROW_ITEMS - 1024 - CONV - SHQ) * 16 + (tid >> 6);
            const bf16_t* wr = (const bf16_t*)(p.ws + WS_WTIN) + (size_t)(2304 + n) * DM + lane * 16;
            const u32x4 w0 = *(const u32x4*)wr, w1 = *(const u32x4*)(wr + 8);
            const float k = W8_SCALE;
            *(u32x4*)(p.ws + WS_W8G + (size_t)n * DM + lane * 16) = u32x4{pk_fp8x4(bflo(w0[0]) * k, bfhi(w0[0]) * k, bflo(w0[1]) * k, bfhi(w0[1]) * k), pk_fp8x4(bflo(w0[2]) * k, bfhi(w0[2]) * k, bflo(w0[3]) * k, bfhi(w0[3]) * k),
                                                                                pk_fp8x4(bflo(w1[0]) * k, bfhi(w1[0]) * k, bflo(w1[1]) * k, bfhi(w1[1]) * k), pk_fp8x4(bflo(w1[2]) * k, bfhi(w1[2]) * k, bflo(w1[3]) * k, bfhi(w1[3]) * k)};
            continue;
        }
        if (it >= ROW_ITEMS + 1024 + CONV) {
            const int tid = get_tid(), lane = tid & 63, o = (it - ROW_ITEMS - 1024 - CONV) * 16 + (tid >> 6), b = o >> 11, n = o & 2047;
            const bf16_t* wr = (const bf16_t*)(p.ws + WS_WTQ) + (size_t)n * DM + lane * 16;
            const float* sh = mod + b * 6144 + 3072 + lane * 16;
            const u32x4 w0 = *(const u32x4*)wr, w1 = *(const u32x4*)(wr + 8);
            float d = 0.f;
#pragma unroll
            for (int i = 0; i < 4; ++i) { d += bflo(w0[i]) * sh[2 * i] + bfhi(w0[i]) * sh[2 * i + 1] + bflo(w1[i]) * sh[8 + 2 * i] + bfhi(w1[i]) * sh[9 + 2 * i]; }
            d = wave_sum(d);
            if (lane == 0) ((float*)(p.ws + WS_SHQ))[o] = d;
            continue;
        }
        if (it >= ROW_ITEMS + 1024) { table_conv_item(p, it - ROW_ITEMS - 1024, (unsigned char*)sm); continue; }
        const int row = (it - 1024) * 16 + wave;
        if (row < BT) {
            const int b = row >> 12;
            norm_mod_row(p.in[I_X] + (size_t)row * DM, p.in[I_NMIX], mod + b * 6144, mod + b * 6144 + 1024, (bf16_t*)(p.ws + WS_H) + (size_t)row * DM, p.ws + WS_H8 + (size_t)row * DM);
        } else {
            const int r = row - BT;
            norm_mod_row(p.in[I_CTX] + (size_t)r * DM, p.in[I_NMIX], mod + 8 * 6144, mod + 8 * 6144 + 1024, (bf16_t*)(p.ws + WS_HC) + (size_t)r * DM);
        }
    }
}

#define MFMA16(a, b, c) __builtin_amdgcn_mfma_f32_16x16x32_bf16((a), (b), (c), 0, 0, 0)
constexpr int GT_P = 256 * 128;
struct RowLoader {
    const bf16_t* base; int ld;
    static constexpr bool kmajor = false;
    template<int ROWS> DI void issue(unsigned char* tile, int kt, int lane, int wave) const {
#pragma unroll
        for (int i = 0; i < ROWS / 128; ++i) {
            const int grp = i * 16 + wave, row = grp * 8 + (lane >> 3), c = (lane & 7) ^ (lane >> 3);
            __builtin_amdgcn_global_load_lds((const unsigned*)((const char*)base + (unsigned)((row * ld + kt * 64 + c * 8) * 2)), (unsigned*)(tile + grp * 1024), 16, 0, 0);
        }
    }
};

struct ColLoader {
    const bf16_t* base; size_t ld;
    static constexpr bool kmajor = true;
    template<int ROWS> DI void issue(unsigned char* tile, int kt, int lane, int wave) const {
        static_assert(ROWS == 128, "k-major loader: 128-row Q tiles only");
        const int row = wave * 4 + (lane >> 4), c = (lane & 15) ^ (2 * (row & 3));
        __builtin_amdgcn_global_load_lds((const unsigned*)(base + (size_t)(kt * 64 + row) * ld + c * 8), (unsigned*)(tile + wave * 1024), 16, 0, 0);
    }
};
template<int NQ>
DI void gemm_prefetch(const RowLoader& lp, const RowLoader& lq, unsigned char* lds) {
    const int tid = get_tid(), lane = tid & 63, wave = __builtin_amdgcn_readfirstlane(tid >> 6);
    lp.template issue<256>(lds, 0, lane, wave); lq.template issue<NQ * 64>(lds + GT_P, 0, lane, wave);
}
template<int NQ, bool KMAJOR>
DI void gemm_kstep(f32x4 (&acc)[4][NQ], const unsigned char* cur, int wp, int wq, int l15, int lk) {
#pragma unroll
    for (int ks = 0; ks < 2; ++ks) {
        bf16x8 fp[4], fq[NQ];
#pragma unroll
        for (int i = 0; i < 4; ++i) { const int row = wp * 64 + i * 16 + l15; fp[i] = *(const bf16x8*)(cur + row * 128 + (((ks * 4 + lk) ^ (row & 7)) << 4)); }
#pragma unroll
        for (int j = 0; j < NQ; ++j) {
            if constexpr (KMAJOR) {
                const int q4 = l15 >> 2, tokq = wq * (16 * NQ) + j * 16 + 4 * (l15 & 3);
                const unsigned char* ap = cur + GT_P + ((ks * 4 + lk) * 8 + q4) * 256 + (((tokq >> 3) ^ (2 * q4)) << 4) + ((tokq >> 2) & 1) * 8;
                const s16x4 lo = __builtin_amdgcn_ds_read_tr16_b64_v4i16((LAS s16x4*)(LAS unsigned char*)ap);
                const s16x4 hi = __builtin_amdgcn_ds_read_tr16_b64_v4i16((LAS s16x4*)(LAS unsigned char*)(ap + 4 * 256));
                fq[j] = __builtin_shufflevector(lo, hi, 0, 1, 2, 3, 4, 5, 6, 7);
            } else { const int row = wq * (16 * NQ) + j * 16 + l15; fq[j] = *(const bf16x8*)(cur + GT_P + row * 128 + (((ks * 4 + lk) ^ (row & 7)) << 4)); }
        }
#pragma unroll
        for (int i = 0; i < 4; ++i)
#pragma unroll
            for (int j = 0; j < NQ; ++j) acc[i][j] = MFMA16(fp[i], fq[j], acc[i][j]);
    }
}
template<int NQ>
DI void gemm_kstep8(f32x4 (&acc)[4][NQ], const unsigned char* cur, int wp, int wq, int l15, int lk) {
    __builtin_amdgcn_sched_barrier(0);
    i32x8 fp[4];
#pragma unroll
    for (int i = 0; i < 4; ++i) {
        const int row = wp * 64 + i * 16 + l15;
        const u32x4 a = *(const u32x4*)(cur + row * 128 + ((lk ^ (row & 7)) << 4)), b = *(const u32x4*)(cur + row * 128 + (((4 + lk) ^ (row & 7)) << 4));
        fp[i] = i32x8{(int)a[0], (int)a[1], (int)a[2], (int)a[3], (int)b[0], (int)b[1], (int)b[2], (int)b[3]};
    }
    u32x4 qa, qb;
    { const int row = wq * (16 * NQ) + l15; qa = *(const u32x4*)(cur + GT_P + row * 128 + ((lk ^ (row & 7)) << 4)); qb = *(const u32x4*)(cur + GT_P + row * 128 + (((4 + lk) ^ (row & 7)) << 4)); }
#pragma unroll
    for (int j = 0; j < NQ; ++j) {
        const i32x8 fq = i32x8{(int)qa[0], (int)qa[1], (int)qa[2], (int)qa[3], (int)qb[0], (int)qb[1], (int)qb[2], (int)qb[3]};
        if (j + 1 < NQ) { const int row = wq * (16 * NQ) + (j + 1) * 16 + l15; qa = *(const u32x4*)(cur + GT_P + row * 128 + ((lk ^ (row & 7)) << 4)); qb = *(const u32x4*)(cur + GT_P + row * 128 + (((4 + lk) ^ (row & 7)) << 4)); }
#pragma unroll
        for (int i = 0; i < 4; ++i) acc[i][j] = __builtin_amdgcn_mfma_scale_f32_16x16x128_f8f6f4(fp[i], fq, acc[i][j], 0, 0, 0, 0x7F7F7F7F, 0, 0x7F7F7F7F);
        __builtin_amdgcn_sched_barrier(0);
    }
}
template<int NQ, class LQ = RowLoader, class NLQ = RowLoader, bool F8 = false>
DI void gemm_mainloop(f32x4 (&acc)[4][NQ], const RowLoader& lp, const LQ& lq, int nk, unsigned char* lds, bool preissued = false, bool pfnext = false,
                      const RowLoader& nlp = RowLoader{nullptr, 0}, const NLQ& nlq = NLQ{nullptr, 0}) {
    const int tid = get_tid(), lane = tid & 63, wave = __builtin_amdgcn_readfirstlane(tid >> 6), wp = wave >> 2, wq = wave & 3;
    constexpr int QROWS = NQ * 64;
    constexpr int STAGE = GT_P + QROWS * 128;
    if (!preissued) {
        __syncthreads();
        lp.template issue<256>(lds, 0, lane, wave); lq.template issue<QROWS>(lds + GT_P, 0, lane, wave);
    }
    asm volatile("s_waitcnt vmcnt(0)" ::: "memory");
    __syncthreads();
    const int l15 = lane & 15, lk = lane >> 4;
    for (int kt = 0; kt < nk; ++kt) {
        unsigned char* cur = lds + (kt & 1) * STAGE;
        unsigned char* nxt = lds + ((kt + 1) & 1) * STAGE;
        const bool last = kt + 1 == nk;
        if (!last) { lp.template issue<256>(nxt, kt + 1, lane, wave); lq.template issue<QROWS>(nxt + GT_P, kt + 1, lane, wave); }
        else if (pfnext) { nlp.template issue<256>(nxt, 0, lane, wave); nlq.template issue<QROWS>(nxt + GT_P, 0, lane, wave); }
        if constexpr (F8) gemm_kstep8<NQ>(acc, cur, wp, wq, l15, lk); else gemm_kstep<NQ, LQ::kmajor>(acc, cur, wp, wq, l15, lk);
        if (last && pfnext) { asm volatile("s_waitcnt lgkmcnt(0)" ::: "memory"); __builtin_amdgcn_s_barrier(); }
        else { asm volatile("s_waitcnt vmcnt(0)" ::: "memory"); __syncthreads(); }
    }
}
template<int NQ>
DI void gemm_shadow(const RowLoader& lp, const RowLoader& lq, int nk, unsigned char* lds) {
    f32x4 acc[4][NQ];
#pragma unroll
    for (int i = 0; i < 4; ++i)
#pragma unroll
        for (int j = 0; j < NQ; ++j) acc[i][j] = f32x4{0.f, 0.f, 0.f, 0.f};
    if (SHADOW == 1) gemm_mainloop<NQ>(acc, lp, lq, nk, lds);
    else {
        const int tid = get_tid(), lane = tid & 63, wave = __builtin_amdgcn_readfirstlane(tid >> 6), wp = wave >> 2, wq = wave & 3;
        constexpr int QROWS = NQ * 64;
        constexpr int STAGE = GT_P + QROWS * 128;
        const int l15 = lane & 15, lk = lane >> 4;
        bf16x8 fp[4], fq[NQ];
        if (SHADOW == 3) {
#pragma unroll
            for (int i = 0; i < 4; ++i) fp[i] = *(const bf16x8*)(lds + (wp * 64 + i * 16 + l15) * 128 + lk * 16);
#pragma unroll
            for (int j = 0; j < NQ; ++j) fq[j] = *(const bf16x8*)(lds + GT_P + (wq * 16 * NQ + j * 16 + l15) * 128 + lk * 16);
        }
        for (int kt = 0; kt < nk; ++kt) {
            unsigned char* cur = lds + (kt & 1) * STAGE;
#pragma unroll
            for (int ks = 0; ks < 2; ++ks) {
                if (SHADOW == 2 || SHADOW == 4) {
#pragma unroll
                    for (int i = 0; i < 4; ++i) { const int row = wp * 64 + i * 16 + l15; fp[i] = *(const bf16x8*)(cur + row * 128 + (((ks * 4 + lk) ^ (row & 7)) << 4)); }
#pragma unroll
                    for (int j = 0; j < NQ; ++j) { const int row = wq * (16 * NQ) + j * 16 + l15; fq[j] = *(const bf16x8*)(cur + GT_P + row * 128 + (((ks * 4 + lk) ^ (row & 7)) << 4)); }
                }
#pragma unroll
                for (int i = 0; i < 4; ++i)
#pragma unroll
                    for (int j = 0; j < NQ; ++j) acc[i][j] = MFMA16(fp[i], fq[j], acc[i][j]);
            }
            if (SHADOW == 2) asm volatile("" ::: "memory");
            if (SHADOW == 4) __syncthreads();
        }
    }
#pragma unroll
    for (int i = 0; i < 4; ++i)
#pragma unroll
        for (int j = 0; j < NQ; ++j) asm volatile("" :: "v"(acc[i][j]));
}

template<int NQ> DI void gemm_shadow1(const RowLoader& lp, const RowLoader& lq, int nk, unsigned char* lds) {
    f32x4 acc[4][NQ];
#pragma unroll
    for (int i = 0; i < 4; ++i)
#pragma unroll
        for (int j = 0; j < NQ; ++j) acc[i][j] = f32x4{0.f, 0.f, 0.f, 0.f};
    gemm_mainloop<NQ>(acc, lp, lq, nk, lds);
#pragma unroll
    for (int i = 0; i < 4; ++i)
#pragma unroll
        for (int j = 0; j < NQ; ++j) asm volatile("" :: "v"(acc[i][j]));
}
DI void head_epilogue(f32x4 (&acc)[4][4], const float* __restrict__ g, float gscale, const float* __restrict__ rope, bool do_rope, int t_base  , unsigned char* __restrict__ dst  , int lane) {
    const int l15 = lane & 15, lk = lane >> 4;
    float gg[4];
#pragma unroll
    for (int j = 0; j < 4; ++j) gg[j] = g[j * 16 + l15] * gscale;
#pragma unroll
    for (int i = 0; i < 4; ++i) {
#pragma unroll
        for (int r = 0; r < 4; ++r) {
            float ss = 0.f;
#pragma unroll
            for (int j = 0; j < 4; ++j) ss += acc[i][j][r] * acc[i][j][r];
            ss = sum16(ss);
            const float rs = rsqrtf(ss * (1.f / 64.f) + EPS);
            float v[4];
#pragma unroll
            for (int j = 0; j < 4; ++j) v[j] = acc[i][j][r] * rs * gg[j];
            const int t = t_base + i * 16 + lk * 4 + r;
            if (do_rope) {
                const int prow = (t >> 6) & 63, pcol = t & 63;
                const float c0 = rope[prow * 16 + l15], s0 = rope[1024 + prow * 16 + l15];
                const float c1 = rope[pcol * 16 + l15], s1 = rope[1024 + pcol * 16 + l15];
                const float a0 = v[0] * c0 - v[1] * s0, a1 = v[1] * c0 + v[0] * s0;
                const float a2 = v[2] * c1 - v[3] * s1, a3 = v[3] * c1 + v[2] * s1;
                v[0] = a0; v[1] = a1; v[2] = a2; v[3] = a3;
            }
            unsigned char* d = dst + (size_t)(i * 16 + lk * 4 + r) * 64 + l15;
            const int w01 = __builtin_amdgcn_cvt_pk_fp8_f32(v[0], v[1], 0, false), w23 = __builtin_amdgcn_cvt_pk_fp8_f32(v[2], v[3], 0, false);
            d[0] = (unsigned char)w01; d[16] = (unsigned char)(w01 >> 8); d[32] = (unsigned char)w23; d[48] = (unsigned char)(w23 >> 8);
        }
    }
}
DI void tstore_epilogue(f32x4 (&acc)[4][4], bf16_t* __restrict__ dst  , size_t ld, int lane) {
    const int l15 = lane & 15, lk = lane >> 4;
#pragma unroll
    for (int i = 0; i < 4; ++i)
#pragma unroll
        for (int j = 0; j < 4; ++j)
            *(u32x2*)(dst + (size_t)(j * 16 + l15) * ld + i * 16 + lk * 4) = u32x2{pk2(acc[i][j][0], acc[i][j][1]), pk2(acc[i][j][2], acc[i][j][3])};
}

DI void phase_c(const Params& p, unsigned char* lds) {
    constexpr int NTM = BT / 256, NTN = INC / 256;
    constexpr int MAIN = NTM * NTN, TOTAL = MAIN + 8;
    const bf16_t* H = (const bf16_t*)(p.ws + WS_H);
    const bf16_t* HCp = (const bf16_t*)(p.ws + WS_HC);
    const bf16_t* WT = (const bf16_t*)(p.ws + WS_WTIN);
    const float* rope = (const float*)(p.ws + WS_ROPE);
    struct CTile { int tm, tn; bool ctx; RowLoader P, Q; };
    auto c_tile = [&](int it) {
        CTile t; t.ctx = false;
        if (it < MAIN) { const int g = it / (16 * NTN), rem = it % (16 * NTN); t.tn = rem >> 4; t.tm = g * 16 + (rem & 15); }
        else { t.ctx = true; t.tm = it - MAIN; t.tn = 2; }
        const bf16_t* A = t.ctx ? HCp + (size_t)t.tm * 256 * DM : H + (size_t)t.tm * 256 * DM;
        const bf16_t* W = WT + (size_t)t.tn * 256 * DM;
        if (t.tn >= 9) {
            t.P = RowLoader{(const bf16_t*)(p.ws + WS_W8G + (size_t)(t.tn * 256 - 2304) * DM), DM / 2}; t.Q = RowLoader{(const bf16_t*)(p.ws + WS_H8 + (size_t)t.tm * 256 * DM), DM / 2}; }
        else { t.P = RowLoader{A, DM}; t.Q = RowLoader{W, DM}; }
        return t;
    };
    bool pre = false;
    CTile cur = c_tile(blockIdx.x);
    for (int it = blockIdx.x; it < TOTAL; it += gridDim.x) {
        const int tid = get_tid(), lane = tid & 63, wave = tid >> 6, wa = wave >> 2, wb = wave & 3;
        const bool has2 = it + (int)gridDim.x < TOTAL;
        const CTile nx = c_tile(has2 ? it + (int)gridDim.x : it);
        const int tm = cur.tm, tn = cur.tn; const bool ctx = cur.ctx;
        f32x4 acc[4][4];
#pragma unroll
        for (int i = 0; i < 4; ++i)
#pragma unroll
            for (int j = 0; j < 4; ++j) acc[i][j] = f32x4{0.f, 0.f, 0.f, 0.f};
        int nk8 = DM / 128; asm volatile("" : "+s"(nk8));
        if (cur.tn >= 9) gemm_mainloop<4, RowLoader, RowLoader, true>(acc, cur.P, cur.Q, nk8, lds, pre, has2, nx.P, nx.Q);
        else gemm_mainloop<4>(acc, cur.P, cur.Q, DM / 64, lds, pre, has2, nx.P, nx.Q);
        pre = has2; cur = nx;
        if (tn >= 9) {
            unsigned char* st = lds + 64 * 1024;
            constexpr int GS = 272;
            const int l15 = lane & 15, lk = lane >> 4;
#pragma unroll
            for (int i = 0; i < 4; ++i)
#pragma unroll
                for (int j = 0; j < 4; ++j) {
                    unsigned q[4];
#pragma unroll
                    for (int r = 0; r < 4; ++r) q[r] = (unsigned)(255.f * __builtin_amdgcn_rcpf(1.f + __expf(acc[i][j][r] * (-1.f / W8_SCALE))) + 0.5f);
                    *(unsigned*)(st + (wb * 64 + j * 16 + l15) * GS + wa * 64 + i * 16 + lk * 4) = q[0] | (q[1] << 8) | (q[2] << 16) | (q[3] << 24);
                }
            __syncthreads();
            unsigned char* G8 = p.ws + WS_G + (size_t)tm * 256 * GC + (tn * 256 - 2304);
            const int t2 = get_tid();
#pragma unroll
            for (int q = 0; q < 4; ++q) {
                const int idx = t2 + q * NT, row = idx >> 4, ch = idx & 15;
                *(u32x4*)(G8 + (size_t)row * GC + ch * 16) = *(const u32x4*)(st + row * GS + ch * 16);
            }
            continue;
        }
        const int b = ctx ? tm : (tm >> 4);
        const int tpos = ctx ? SEQ + wa * 64 : ((tm & 15) * 256 + wa * 64);
        if (tn < 2) {
            const int h = tn * 4 + wb;
            unsigned char* Q = p.ws + WS_Q + ((size_t)(b * NH + h) * SEQ + tpos) * HD;
            head_epilogue(acc, p.in[I_QNG], 1.4426950408889634f, rope, true, tpos, Q, lane);
        } else if (tn == 2) {
            if (wb < 2) {
                unsigned char* K = p.ws + WS_KB + ((size_t)(b * NKV + wb) * TK + tpos) * HD;
                head_epilogue(acc, p.in[I_KNG], 1.f, rope, !ctx, tpos, K, lane);
            } else {
                unsigned char* V8 = p.ws + WS_VT + (size_t)(b * NKV + (wb - 2)) * HD * TK;
                const int l15 = lane & 15, lk = lane >> 4;
#pragma unroll
                for (int i = 0; i < 4; ++i) {
                    const int k = tpos + i * 16 + lk * 4, kin = k & 63, within = kin & 31;
                    const int pos = (k & ~63) + 32 * ((within >> 2) & 1) + 16 * (kin >> 5) + 4 * (within >> 3);
#pragma unroll
                    for (int j = 0; j < 4; ++j)
                        *(unsigned*)(V8 + (size_t)(j * 16 + l15) * TK + pos) = pk_fp8x4(acc[i][j][0] * VT_SCALE, acc[i][j][1] * VT_SCALE, acc[i][j][2] * VT_SCALE, acc[i][j][3] * VT_SCALE);
                }
            }
        } else {
            const int col = tn * 256 - 768 + wb * 64;
            bf16_t* Z = (bf16_t*)(p.ws + WS_ZT) + (size_t)col * BT + (size_t)b * SEQ + tpos;
            tstore_epilogue(acc, Z, BT, lane);
        }
    }
}

#define MFMA32(a, b, c) __builtin_amdgcn_mfma_f32_32x32x16_bf16((a), (b), (c), 0, 0, 0)
DI bf16x8 pack_step(const f32x16& x, int s) {
    u32x4 pk;
    asm volatile("v_cvt_pk_bf16_f32 %0, %4, %5\n\tv_cvt_pk_bf16_f32 %1, %6, %7\n\tv_cvt_pk_bf16_f32 %2, %8, %9\n\tv_cvt_pk_bf16_f32 %3, %10, %11\n\ts_nop 1"
                 : "=&v"(pk[0]), "=&v"(pk[1]), "=&v"(pk[2]), "=&v"(pk[3])
                 : "v"(x[8 * s]), "v"(x[8 * s + 1]), "v"(x[8 * s + 2]), "v"(x[8 * s + 3]), "v"(x[8 * s + 4]), "v"(x[8 * s + 5]), "v"(x[8 * s + 6]), "v"(x[8 * s + 7]));
    return __builtin_bit_cast(bf16x8, pk);
}

constexpr int AT_KSTR = 64, AT_VSTR = 64, AT_VOFF = 64 * AT_KSTR, AT_STAGE = AT_VOFF + 64 * AT_VSTR;
DI void attn_item(const Params& p, int item, unsigned char* lds) {
    const int tid = get_tid(), lane = tid & 63, wave = tid >> 6;
    const int b = item >> 6, kvh = (item >> 5) & 1, qb = item & 31;
    const int h = kvh * 4 + (wave >> 2), q0 = qb * 128 + (wave & 3) * 32;
    const int qi = lane & 31, hf = lane >> 5;
    const unsigned char* Qp = p.ws + WS_Q + ((size_t)(b * NH + h) * SEQ + q0 + qi) * HD + 32 * hf;
    const u32x4 q0v = *(const u32x4*)Qp, q1v = *(const u32x4*)(Qp + 16);
    const i32x8 qf = i32x8{(int)q0v[0], (int)q0v[1], (int)q0v[2], (int)q0v[3], (int)q1v[0], (int)q1v[1], (int)q1v[2], (int)q1v[3]};
    const unsigned char* Kg = p.ws + WS_KB + (size_t)(b * NKV + kvh) * TK * HD;
    const unsigned char* Vg = p.ws + WS_VT + (size_t)(b * NKV + kvh) * HD * TK;
    constexpr int NTILE = TK / 64;
    f32x16 o0, o1, o2;
#pragma unroll
    for (int i = 0; i < 16; ++i) { o0[i] = 0.f; o1[i] = 0.f; o2[i] = 0.f; }
    __syncthreads();
    constexpr int NSUB = 4, NSTG = NTILE / NSUB;
    static_assert(NTILE % NSUB == 0 && 2 * NSUB * AT_STAGE <= LDS_USER, "attention LDS stages");
    const int wv = __builtin_amdgcn_readfirstlane(tid >> 6);
    auto stage_issue = [&](int stg_idx, int buf) {
#pragma unroll
        for (int e = 0; e < 2; ++e) {
            const int q = 2 * wv + e, j = q >> 3, isV = (q >> 2) & 1, part = q & 3;
            const int row = 16 * part + (lane >> 2), c = (lane & 3) ^ ((row >> 2) & 3), tile = stg_idx * NSUB + j;
            const unsigned char* sp = isV ? Vg + (size_t)row * TK + (size_t)tile * 64 + c * 16 : Kg + ((size_t)tile * 64 + row) * HD + c * 16;
            __builtin_amdgcn_global_load_lds((const unsigned*)sp, (unsigned*)(lds + (buf * NSUB + j) * AT_STAGE + isV * AT_VOFF + part * 1024), 16, 0, 0);
        }
    };
    stage_issue(0, 0);
    asm volatile("s_waitcnt vmcnt(0)" ::: "memory");
    __syncthreads();
    const int sw = (qi >> 2) & 3;
    const int kc0 = qi * AT_KSTR + (((2 * hf) ^ sw) << 4), kc1 = qi * AT_KSTR + (((2 * hf + 1) ^ sw) << 4);
    for (int st = 0; st < NSTG; ++st) {
      const bool more = st + 1 < NSTG;
      if (more) stage_issue(st + 1, (st + 1) & 1);
#pragma unroll 1
      for (int j = 0; j < NSUB; ++j) {
        const unsigned char* cur = lds + ((st & 1) * NSUB + j) * AT_STAGE;
        f32x16 sA, sB;
        {
            f32x16 z;
#pragma unroll
            for (int i = 0; i < 16; ++i) z[i] = 0.f;
            const u32x4 ka0 = *(const u32x4*)(cur + kc0), ka1 = *(const u32x4*)(cur + kc1);
            const u32x4 kb0 = *(const u32x4*)(cur + kc0 + 32 * AT_KSTR), kb1 = *(const u32x4*)(cur + kc1 + 32 * AT_KSTR);
            const i32x8 kfa = i32x8{(int)ka0[0], (int)ka0[1], (int)ka0[2], (int)ka0[3], (int)ka1[0], (int)ka1[1], (int)ka1[2], (int)ka1[3]};
            const i32x8 kfb = i32x8{(int)kb0[0], (int)kb0[1], (int)kb0[2], (int)kb0[3], (int)kb1[0], (int)kb1[1], (int)kb1[2], (int)kb1[3]};
            __builtin_amdgcn_s_setprio(1);
            sA = __builtin_amdgcn_mfma_scale_f32_32x32x64_f8f6f4(kfa, qf, z, 0, 0, 0, 0x7F7F7F7F, 0, 0x7C7C7C7C);
            sB = __builtin_amdgcn_mfma_scale_f32_32x32x64_f8f6f4(kfb, qf, z, 0, 0, 0, 0x7F7F7F7F, 0, 0x7C7C7C7C);
            __builtin_amdgcn_s_setprio(0);
        }
#pragma unroll
        for (int i = 0; i < 16; ++i) sA[i] = __builtin_amdgcn_exp2f(sA[i]);
#pragma unroll
        for (int i = 0; i < 16; ++i) sB[i] = __builtin_amdgcn_exp2f(sB[i]);
        int pb[8];
#pragma unroll
        for (int v = 0; v < 8; ++v) {
            const f32x16& sx = (v >> 2) ? sB : sA;
            const int r0 = 4 * (v & 3);
            int w = __builtin_amdgcn_cvt_pk_bf8_f32(sx[r0], sx[r0 + 1], 0, false);
            w = __builtin_amdgcn_cvt_pk_bf8_f32(sx[r0 + 2], sx[r0 + 3], w, true);
            pb[v] = w;
        }
        const i32x8 pf = i32x8{pb[0], pb[1], pb[2], pb[3], pb[4], pb[5], pb[6], pb[7]};
#pragma unroll
        for (int db = 0; db < 2; ++db) {
            const unsigned char* vb = cur + AT_VOFF + db * 32 * AT_VSTR;
            const u32x4 a0 = *(const u32x4*)(vb + kc0), a1 = *(const u32x4*)(vb + kc1);
            const i32x8 vf = i32x8{(int)a0[0], (int)a0[1], (int)a0[2], (int)a0[3], (int)a1[0], (int)a1[1], (int)a1[2], (int)a1[3]};
            if (db == 0) o0 = __builtin_amdgcn_mfma_scale_f32_32x32x64_f8f6f4(vf, pf, o0, 0, 1, 0, 0x7F7F7F7F, 0, 0x7F7F7F7F);
            else         o1 = __builtin_amdgcn_mfma_scale_f32_32x32x64_f8f6f4(vf, pf, o1, 0, 1, 0, 0x7F7F7F7F, 0, 0x7F7F7F7F);
        }
        {
            const int one4 = 0x38383838;
            const i32x8 ones = i32x8{one4, one4, one4, one4, one4, one4, one4, one4};
            o2 = __builtin_amdgcn_mfma_scale_f32_32x32x64_f8f6f4(ones, pf, o2, 0, 1, 0, 0x7F7F7F7F, 0, 0x7F7F7F7F);
        }
      }
      asm volatile("s_waitcnt vmcnt(0)" ::: "memory");
      __syncthreads();
    }
    const float inv = (1.f / VT_SCALE) / o2[0];
    bf16_t* O;
    {
        const int t2 = get_tid(), lane2 = t2 & 63, wave2 = t2 >> 6;
        const int h2 = kvh * 4 + (wave2 >> 2), q2 = qb * 128 + (wave2 & 3) * 32 + (lane2 & 31);
        O = (bf16_t*)(p.ws + WS_ATT) + ((size_t)b * SEQ + q2) * QD + h2 * HD + 4 * (lane2 >> 5);
    }
#pragma unroll
    for (int g4 = 0; g4 < 4; ++g4) {
        *(u32x2*)(O + 8 * g4)      = u32x2{pk2(o0[4 * g4] * inv, o0[4 * g4 + 1] * inv), pk2(o0[4 * g4 + 2] * inv, o0[4 * g4 + 3] * inv)};
        *(u32x2*)(O + 32 + 8 * g4) = u32x2{pk2(o1[4 * g4] * inv, o1[4 * g4 + 1] * inv), pk2(o1[4 * g4 + 2] * inv, o1[4 * g4 + 3] * inv)};
    }
}

constexpr int HY_USTR = 8208, HY_R = 8 * HY_USTR, HY_RSTR = 16384 + 64;
DI void hy_load_filter(const bf16_t* __restrict__ R, unsigned char* lds, int tid) {
    const int i0 = tid * 8;
    const u32x4 w = *(const u32x4*)(R + i0);
    u32x2 nx = u32x2{0u, 0u};
    if (i0 + 8 < 8192) nx = *(const u32x2*)(R + i0 + 8);
    unsigned char* d = lds + HY_R + i0 * 2;
    *(u32x4*)(d) = w;
    *(u32x4*)(d + HY_RSTR) = u32x4{__builtin_amdgcn_alignbit(w[1], w[0], 16), __builtin_amdgcn_alignbit(w[2], w[1], 16), __builtin_amdgcn_alignbit(w[3], w[2], 16), __builtin_amdgcn_alignbit(nx[0], w[3], 16)};
    *(u32x4*)(d + 2 * HY_RSTR) = u32x4{w[1], w[2], w[3], nx[0]};
    *(u32x4*)(d + 3 * HY_RSTR) = u32x4{__builtin_amdgcn_alignbit(w[2], w[1], 16), __builtin_amdgcn_alignbit(w[3], w[2], 16), __builtin_amdgcn_alignbit(nx[0], w[3], 16), __builtin_amdgcn_alignbit(nx[1], nx[0], 16)};
}
DI void short_conv4(const bf16_t* __restrict__ zrow  , int t4, float w0, float w1, float w2, float bias, float (&out)[4]) {
    const u32x2 v = *(const u32x2*)(zrow + t4);
    const float z0 = bflo(v[0]), z1 = bfhi(v[0]), z2 = bflo(v[1]), z3 = bfhi(v[1]);
    const float zm = (t4 > 0) ? bf2f(zrow[t4 - 1]) : 0.f;
    const float zp = (t4 + 4 < SEQ) ? bf2f(zrow[t4 + 4]) : 0.f;
    out[0] = zm * w0 + z0 * w1 + z1 * w2 + bias;
    out[1] = z0 * w0 + z1 * w1 + z2 * w2 + bias;
    out[2] = z1 * w0 + z2 * w1 + z3 * w2 + bias;
    out[3] = z2 * w0 + z3 * w1 + zp * w2 + bias;
}
DI void hyena_item(const Params& p, int c, unsigned char* lds) {
    const int tid = get_tid(), lane = tid & 63, ig = tid >> 6;
    const bf16_t* ZT = (const bf16_t*)(p.ws + WS_ZT);
    const float* cw = p.in[I_HCW];
    const float* cb = p.in[I_HCB];
    __syncthreads();
    {
        const int b = tid >> 7, tb = (tid & 127) * 32;
        const bf16_t* zrow = ZT + (size_t)c * BT + (size_t)b * SEQ;
        const float w0 = cw[c], w1 = cw[HYC + c], w2 = cw[2 * HYC + c], bias = cb[c];
#pragma unroll
        for (int q = 0; q < 8; ++q) {
            float o[4];
            short_conv4(zrow, tb + 4 * q, w0, w1, w2, bias, o);
            *(u32x2*)(lds + b * HY_USTR + (tb + 4 * q) * 2) = u32x2{pk2(o[0], o[1]), pk2(o[2], o[3])};
        }
    }
    const int r = lane & 31, hf = lane >> 5, Il = r >> 3, bb = r & 7;
#pragma unroll 1
    for (int o = 0; o < 2; ++o) {
        hy_load_filter((const bf16_t*)(p.ws + WS_R) + (size_t)(o * 512 + c) * 8192, lds, tid);
        __syncthreads();
        f32x16 acc0, acc1;
#pragma unroll
        for (int i = 0; i < 16; ++i) { acc0[i] = 0.f; acc1[i] = 0.f; }
        const int sh = (-r) & 3;
        const unsigned char* abase = lds + HY_R + sh * HY_RSTR + (4096 + 8 * hf - r - sh) * 2 - 64;
        const unsigned char* ubase = lds + bb * HY_USTR + ((4 * ig + Il) * 64 + 8 * hf) * 2;
#define HY_STEP(MASKED) do { \
            const unsigned char* ap = abase - 128 * d; \
            const unsigned char* ub = ubase - 128 * d; \
            bool valid = true; \
            if (MASKED) { const int J = 4 * ig + Il - d; valid = (unsigned)J < 64u; if (!valid) ub = lds; } \
            _Pragma("unroll") for (int ks = 0; ks < 4; ++ks) { \
                u32x4 braw = *(const u32x4*)(ub + ks * 32); \
                if (MASKED) { if (!valid) braw = u32x4{0u, 0u, 0u, 0u}; } \
                const bf16x8 bf = __builtin_bit_cast(bf16x8, braw); \
                { const s16x4 lo = lds_rd64(ap + 32 * ks + 64), hi = lds_rd64(ap + 32 * ks + 72);     \
                  acc0 = MFMA32(__builtin_shufflevector(lo, hi, 0, 1, 2, 3, 4, 5, 6, 7), bf, acc0); } \
                { const s16x4 lo = lds_rd64(ap + 32 * ks), hi = lds_rd64(ap + 32 * ks + 8); \
                  acc1 = MFMA32(__builtin_shufflevector(lo, hi, 0, 1, 2, 3, 4, 5, 6, 7), bf, acc1); } \
            } } while (0)
        const int dlo = 4 * ig - 63, dhi = 4 * ig + 3;
#pragma unroll 1
        for (int d = dlo; d < dlo + 3; ++d) HY_STEP(true);
#pragma unroll 1
        for (int d = dlo + 3; d <= dhi - 3; ++d) HY_STEP(false);
        if (SHADOW == 6) {
            f32x16 s0 = acc0, s1 = acc1;
            const bf16x8 fa = *(const bf16x8*)(lds + lane * 16), fb = *(const bf16x8*)(lds + 4096 + lane * 16);
#pragma unroll 1
            for (int d = 0; d < 67; ++d) {
#pragma unroll
                for (int ks = 0; ks < 4; ++ks) { s0 = MFMA32(fa, fb, s0); s1 = MFMA32(fa, fb, s1); }
            }
            asm volatile("" :: "v"(s0), "v"(s1));
        }
        if (SHADOW == 7) {
            f32x16 k0 = acc0, k1 = acc1;
#pragma unroll 1
            for (int d = dlo + 3; d <= dhi - 3 + 6; ++d) {
                const unsigned char* ap = abase - 128 * (d > dhi - 3 ? dhi - 3 : d);
                const unsigned char* ub = ubase - 128 * (d > dhi - 3 ? dhi - 3 : d);
#pragma unroll
                for (int ks = 0; ks < 4; ++ks) {
                    const bf16x8 bf = *(const bf16x8*)(ub + ks * 32);
                    { const s16x4 lo = lds_rd64(ap + 32 * ks + 64), hi = lds_rd64(ap + 32 * ks + 72); k0 = MFMA32(__builtin_shufflevector(lo, hi, 0, 1, 2, 3, 4, 5, 6, 7), bf, k0); }
                    { const s16x4 lo = lds_rd64(ap + 32 * ks), hi = lds_rd64(ap + 32 * ks + 8); k1 = MFMA32(__builtin_shufflevector(lo, hi, 0, 1, 2, 3, 4, 5, 6, 7), bf, k1); }
                }
            }
            asm volatile("" :: "v"(k0), "v"(k1));
        }
#pragma unroll 1
        for (int d = dhi - 2; d <= dhi; ++d) HY_STEP(true);
#undef HY_STEP
        __syncthreads();
        const float skip = p.in[I_HSKIP][o * HYD + c];
        const int gcol = (o == 0 ? 512 : 1024) + c;
        const float w0 = cw[gcol], w1 = cw[HYC + gcol], w2 = cw[2 * HYC + gcol], bias = cb[gcol];
        const bf16_t* zrow = ZT + (size_t)gcol * BT + (size_t)bb * SEQ;
        bf16_t* hyt = (bf16_t*)(p.ws + WS_HYT) + (size_t)c * 128 + (size_t)bb * (SEQ / 128) * (512 * 128);
#pragma unroll
        for (int mm = 0; mm < 2; ++mm) {
#pragma unroll
            for (int g4 = 0; g4 < 4; ++g4) {
                const int t4 = (4 * ig + Il) * 64 + 32 * mm + 8 * g4 + 4 * hf;
                float gt[4];
                short_conv4(zrow, t4, w0, w1, w2, bias, gt);
                unsigned char* up = lds + bb * HY_USTR + t4 * 2;
                const u32x2 uv = *(const u32x2*)up;
                const float u0 = bflo(uv[0]), u1 = bfhi(uv[0]), u2 = bflo(uv[1]), u3 = bfhi(uv[1]);
                const f32x16& a = mm ? acc1 : acc0;
                const float y0 = gt[0] * (a[4 * g4] + skip * u0), y1 = gt[1] * (a[4 * g4 + 1] + skip * u1);
                const float y2 = gt[2] * (a[4 * g4 + 2] + skip * u2), y3 = gt[3] * (a[4 * g4 + 3] + skip * u3);
                const u32x2 pk = u32x2{pk2(y0, y1), pk2(y2, y3)};
                if (o == 0) *(u32x2*)up = pk; else *(u32x2*)(hyt + (size_t)(t4 >> 7) * (512 * 128) + (t4 & 127)) = pk;
            }
        }
        __syncthreads();
    }
}

constexpr int HY8_USTR = 4112, HY8_R = 8 * HY8_USTR, HY8_RSTR = 8192 + 32;
constexpr float HY8_US = 16.f;
DI void hy8_load_filter(const unsigned char* __restrict__ R, unsigned char* lds, int tid) {
    const int i0 = tid * 8;
    const unsigned long long lo = *(const unsigned long long*)(R + i0);
    unsigned long long hi = 0ull;
    if (i0 + 8 < 8192) hi = *(const unsigned long long*)(R + i0 + 8);
    unsigned char* d = lds + HY8_R + i0;
    *(unsigned long long*)d = lo;
#pragma unroll
    for (int sft = 1; sft < 8; ++sft) *(unsigned long long*)(d + sft * HY8_RSTR) = (lo >> (8 * sft)) | (hi << (64 - 8 * sft));
}
constexpr int HY8_ZSTR = 8192 + 16;
DI void hy8_stage_z(const Params& p, int col, unsigned char* zs, int lane, int wave) {
    const unsigned char* src = p.ws + WS_ZT + ((size_t)col * BT + (size_t)(wave >> 1) * SEQ) * 2 + (wave & 1) * 4096 + lane * 16;
#pragma unroll
    for (int e = 0; e < 4; ++e) __builtin_amdgcn_global_load_lds((const unsigned*)(src + e * 1024), (unsigned*)(zs + (wave >> 1) * HY8_ZSTR + (wave & 1) * 4096 + e * 1024), 16, 0, 0);
}
DI void short_conv4_lds(const unsigned char* zrow  , int t4, float w0, float w1, float w2, float bias, float (&out)[4]) {
    const u32x2 v = *(const u32x2*)(zrow + 2 * t4);
    const float z0 = bflo(v[0]), z1 = bfhi(v[0]), z2 = bflo(v[1]), z3 = bfhi(v[1]);
    const float zm = (t4 > 0) ? bf2f(*(const bf16_t*)(zrow + 2 * t4 - 2)) : 0.f;
    const float zp = (t4 + 4 < SEQ) ? bf2f(*(const bf16_t*)(zrow + 2 * t4 + 8)) : 0.f;
    out[0] = zm * w0 + z0 * w1 + z1 * w2 + bias;
    out[1] = z0 * w0 + z1 * w1 + z2 * w2 + bias;
    out[2] = z1 * w0 + z2 * w1 + z3 * w2 + bias;
    out[3] = z2 * w0 + z3 * w1 + zp * w2 + bias;
}
DI void hyena_item8(const Params& p, int c, unsigned char* lds) {
    const int tid = get_tid(), lane = tid & 63, ig = tid >> 6;
    const float* cw = p.in[I_HCW];
    const float* cb = p.in[I_HCB];
    unsigned char* zs = lds + HY8_R;
    const int wvu = __builtin_amdgcn_readfirstlane(ig);
    __syncthreads();
    hy8_stage_z(p, c, zs, lane, wvu);
    asm volatile("s_waitcnt vmcnt(0)" ::: "memory");
    __syncthreads();
    {
        const int b = tid >> 7, tb = (tid & 127) * 32;
        const unsigned char* zrow = zs + b * HY8_ZSTR;
        const float w0 = cw[c], w1 = cw[HYC + c], w2 = cw[2 * HYC + c], bias = cb[c];
        unsigned w8[8];
#pragma unroll
        for (int q = 0; q < 8; ++q) {
            float o[4];
            short_conv4_lds(zrow, tb + 4 * q, w0, w1, w2, bias, o);
            w8[q] = pk_fp8x4(o[0] * HY8_US, o[1] * HY8_US, o[2] * HY8_US, o[3] * HY8_US);
        }
        *(u32x4*)(lds + b * HY8_USTR + tb) = u32x4{w8[0], w8[1], w8[2], w8[3]};
        *(u32x4*)(lds + b * HY8_USTR + tb + 16) = u32x4{w8[4], w8[5], w8[6], w8[7]};
    }
    const int r = lane & 31, hf = lane >> 5, Il = r >> 3, bb = r & 7;
    __syncthreads();
#pragma unroll 1
    for (int o = 0; o < 2; ++o) {
        hy8_load_filter(p.ws + WS_R + (size_t)(o * 512 + c) * 8192, lds, tid);
        __syncthreads();
        f32x16 acc0, acc1;
#pragma unroll
        for (int i = 0; i < 16; ++i) { acc0[i] = 0.f; acc1[i] = 0.f; }
        const int sh = (-r) & 7;
        const unsigned char* abase = lds + HY8_R + sh * HY8_RSTR + (4096 + 32 * hf - r - sh) - 32;
        const unsigned char* ubase = lds + bb * HY8_USTR + (4 * ig + Il) * 64 + 32 * hf;
#define HY8_STEP(MASKED) do { \
            const unsigned char* ap = abase - 64 * d; \
            const unsigned char* ub = ubase - 64 * d; \
            bool valid = true; \
            if (MASKED) { const int J = 4 * ig + Il - d; valid = (unsigned)J < 64u; if (!valid) ub = lds; } \
            u32x4 b0 = *(const u32x4*)(ub), b1 = *(const u32x4*)(ub + 16); \
            if (MASKED) { if (!valid) { b0 = u32x4{0u, 0u, 0u, 0u}; b1 = b0; } } \
            const i32x8 bf = i32x8{(int)b0[0], (int)b0[1], (int)b0[2], (int)b0[3], (int)b1[0], (int)b1[1], (int)b1[2], (int)b1[3]}; \
            { const s16x4 q0 = lds_rd64(ap + 32), q1 = lds_rd64(ap + 40), q2 = lds_rd64(ap + 48), q3 = lds_rd64(ap + 56); \
              const u32x2 e0 = __builtin_bit_cast(u32x2, q0), e1 = __builtin_bit_cast(u32x2, q1), e2 = __builtin_bit_cast(u32x2, q2), e3 = __builtin_bit_cast(u32x2, q3); \
              acc0 = MFMA8((i32x8{(int)e0[0], (int)e0[1], (int)e1[0], (int)e1[1], (int)e2[0], (int)e2[1], (int)e3[0], (int)e3[1]}), bf, acc0); } \
            { const s16x4 q0 = lds_rd64(ap), q1 = lds_rd64(ap + 8), q2 = lds_rd64(ap + 16), q3 = lds_rd64(ap + 24); \
              const u32x2 e0 = __builtin_bit_cast(u32x2, q0), e1 = __builtin_bit_cast(u32x2, q1), e2 = __builtin_bit_cast(u32x2, q2), e3 = __builtin_bit_cast(u32x2, q3); \
              acc1 = MFMA8((i32x8{(int)e0[0], (int)e0[1], (int)e1[0], (int)e1[1], (int)e2[0], (int)e2[1], (int)e3[0], (int)e3[1]}), bf, acc1); } \
            } while (0)
        const int dlo = 4 * ig - 63, dhi = 4 * ig + 3;
#pragma unroll 1
        for (int d = dlo; d < dlo + 3; ++d) HY8_STEP(true);
#pragma unroll 1
        for (int d = dlo + 3; d <= dhi - 3; ++d) HY8_STEP(false);
#pragma unroll 1
        for (int d = dhi - 2; d <= dhi; ++d) HY8_STEP(true);
#undef HY8_STEP
        __syncthreads();
        const float skip = p.in[I_HSKIP][o * HYD + c];
        const float asc = ((const float*)(p.ws + WS_FSC))[o * 512 + c] * (1.f / HY8_US);
        const int gcol = (o == 0 ? 512 : 1024) + c;
        const float w0 = cw[gcol], w1 = cw[HYC + gcol], w2 = cw[2 * HYC + gcol], bias = cb[gcol];
        hy8_stage_z(p, gcol, zs, lane, wvu);
        asm volatile("s_waitcnt vmcnt(0)" ::: "memory");
        __syncthreads();
        const unsigned char* zrow = zs + bb * HY8_ZSTR;
        bf16_t* hyt = (bf16_t*)(p.ws + WS_HYT) + (size_t)c * 128 + (size_t)bb * (SEQ / 128) * (512 * 128);
#pragma unroll
        for (int mm = 0; mm < 2; ++mm) {
#pragma unroll
            for (int g4 = 0; g4 < 4; ++g4) {
                const int t4 = (4 * ig + Il) * 64 + 32 * mm + 8 * g4 + 4 * hf;
                float gt[4];
                short_conv4_lds(zrow, t4, w0, w1, w2, bias, gt);
                unsigned* up = (unsigned*)(lds + bb * HY8_USTR + t4);
                const unsigned uv = *up;
                const f32x2 ul = __builtin_amdgcn_cvt_pk_f32_fp8((int)uv, false), uh = __builtin_amdgcn_cvt_pk_f32_fp8((int)uv, true);
                const float us = skip * (1.f / HY8_US);
                const f32x16& a = mm ? acc1 : acc0;
                const float y0 = gt[0] * (a[4 * g4] * asc + us * ul[0]), y1 = gt[1] * (a[4 * g4 + 1] * asc + us * ul[1]);
                const float y2 = gt[2] * (a[4 * g4 + 2] * asc + us * uh[0]), y3 = gt[3] * (a[4 * g4 + 3] * asc + us * uh[1]);
                if (o == 0) *up = pk_fp8x4(y0 * HY8_US, y1 * HY8_US, y2 * HY8_US, y3 * HY8_US);
                else *(u32x2*)(hyt + (size_t)(t4 >> 7) * (512 * 128) + (t4 & 127)) = u32x2{pk2(y0, y1), pk2(y2, y3)};
            }
        }
        __syncthreads();
    }
}

constexpr int CTL_QUEUE_D = 8192;
DI void phase_d(const Params& p, unsigned char* lds) {
    unsigned* ctr = (unsigned*)(p.ws + WS_CTL) + CTL_QUEUE_D;
    volatile LAS unsigned* slot = (volatile LAS unsigned*)(LAS unsigned char*)(lds + LDS_ST_OFF + 8);
    for (;;) {
        __syncthreads();
        if (get_tid() == 0) slot[0] = atomicAdd(ctr, 1u);
        __syncthreads();
        const int it = __builtin_amdgcn_readfirstlane((int)slot[0]);
        if (it >= 1024) break;
        if (it < 512) hyena_item8(p, it, lds); else attn_item(p, it - 512, lds);
    }
}

DI void phase_d2(const Params& p, unsigned char* lds) {
    constexpr int TILES = 8 * (BT / 256);
    const bf16_t* HYT = (const bf16_t*)(p.ws + WS_HYT);
    bf16_t* HY = (bf16_t*)(p.ws + WS_HY);
    for (int it = blockIdx.x; it < TILES; it += gridDim.x) {
        const int tid = get_tid();
        const int c0 = (it & 7) * 64, tok0 = (it >> 3) * 256;
        __syncthreads();
#pragma unroll
        for (int i = 0; i < 2; ++i) {
            const int idx = tid + i * NT, c = idx >> 5, tg = idx & 31;
            *(u32x4*)(lds + c * 528 + tg * 16) = *(const u32x4*)(HYT + (size_t)(c0 + c) * BT + tok0 + tg * 8);
        }
        __syncthreads();
#pragma unroll
        for (int i = 0; i < 2; ++i) {
            const int idx = tid + i * NT, tok = idx >> 3, cg = idx & 7;
            unsigned w[4];
#pragma unroll
            for (int e = 0; e < 4; ++e) {
                const unsigned lo = *(const unsigned short*)(lds + (cg * 8 + 2 * e) * 528 + tok * 2);
                const unsigned hi = *(const unsigned short*)(lds + (cg * 8 + 2 * e + 1) * 528 + tok * 2);
                w[e] = lo | (hi << 16);
            }
            *(u32x4*)(HY + (size_t)(tok0 + tok) * HYD + c0 + cg * 8) = u32x4{w[0], w[1], w[2], w[3]};
        }
    }
}

DI void phase_e(const Params& p, unsigned char* lds) {
    constexpr int TILES = 4 * (BT / 128);
    for (int it = blockIdx.x; it < TILES; it += gridDim.x) {
        const int tid = get_tid(), lane = tid & 63, wave = tid >> 6, wp = wave >> 2, wq = wave & 3;
        const int tn = it & 3, tm = it >> 2;
        const int n0 = tn * 256, tok0 = tm * 128;
        f32x4 acc1[4][2], acc2[4][2];
#pragma unroll
        for (int i = 0; i < 4; ++i)
#pragma unroll
            for (int j = 0; j < 2; ++j) { acc1[i][j] = f32x4{0.f, 0.f, 0.f, 0.f}; acc2[i][j] = f32x4{0.f, 0.f, 0.f, 0.f}; }
        {
            const RowLoader p1{(const bf16_t*)(p.ws + WS_WTAO) + (size_t)n0 * QD, QD}, q1{(const bf16_t*)(p.ws + WS_ATT) + (size_t)tok0 * QD, QD};
            const RowLoader p2{(const bf16_t*)(p.ws + WS_WTHO) + (size_t)n0 * HYD, HYD};
            const ColLoader q2{(const bf16_t*)(p.ws + WS_HYT) + (size_t)tm * (512 * 128), (size_t)128};
            gemm_mainloop<2, RowLoader, ColLoader>(acc1, p1, q1, QD / 64, lds, false, true, p2, q2);
            gemm_mainloop<2, ColLoader, RowLoader>(acc2, p2, q2, HYD / 64, lds, true, false);
        }
        const unsigned char* G8 = p.ws + WS_G;
        bf16_t* M = (bf16_t*)(p.ws + WS_H);
        constexpr int ES = 528, GS = 272, EG2 = 128 * GS;
        __syncthreads();
        {
            u32x4 ga[2], gh[2];
#pragma unroll
            for (int q = 0; q < 2; ++q) {
                const int idx = tid + q * NT, row = idx >> 4, ch = idx & 15;
                const unsigned char* gp = G8 + (size_t)(tok0 + row) * GC + n0 + ch * 16;
                ga[q] = *(const u32x4*)gp; gh[q] = *(const u32x4*)(gp + 1024);
            }
#pragma unroll
            for (int q = 0; q < 2; ++q) {
                const int idx = tid + q * NT, row = idx >> 4, ch = idx & 15;
                *(u32x4*)(lds + row * GS + ch * 16) = ga[q]; *(u32x4*)(lds + EG2 + row * GS + ch * 16) = gh[q];
            }
        }
        __syncthreads();
        const int l15 = lane & 15, lk = lane >> 4;
        u32x2 mo[4][2];
#pragma unroll
        for (int i = 0; i < 4; ++i)
#pragma unroll
            for (int j = 0; j < 2; ++j) {
                const int off = (wq * 32 + j * 16 + l15) * GS + wp * 64 + i * 16 + lk * 4;
                const unsigned ga = *(const unsigned*)(lds + off), gh = *(const unsigned*)(lds + EG2 + off);
                constexpr float K = 1.f / 255.f;
                const float m0 = K * ((float)(ga & 255u) * acc1[i][j][0] + (float)(gh & 255u) * acc2[i][j][0]);
                const float m1 = K * ((float)((ga >> 8) & 255u) * acc1[i][j][1] + (float)((gh >> 8) & 255u) * acc2[i][j][1]);
                const float m2 = K * ((float)((ga >> 16) & 255u) * acc1[i][j][2] + (float)((gh >> 16) & 255u) * acc2[i][j][2]);
                const float m3 = K * ((float)(ga >> 24) * acc1[i][j][3] + (float)(gh >> 24) * acc2[i][j][3]);
                mo[i][j] = u32x2{pk2(m0, m1), pk2(m2, m3)};
            }
        __syncthreads();
#pragma unroll
        for (int i = 0; i < 4; ++i)
#pragma unroll
            for (int j = 0; j < 2; ++j) *(u32x2*)(lds + (wq * 32 + j * 16 + l15) * ES + (wp * 64 + i * 16 + lk * 4) * 2) = mo[i][j];
        __syncthreads();
#pragma unroll
        for (int q = 0; q < 4; ++q) {
            const int idx = tid + q * NT, row = idx >> 5, ch = idx & 31;
            *(u32x4*)(M + (size_t)(tok0 + row) * DM + n0 + ch * 8) = *(const u32x4*)(lds + row * ES + ch * 16);
        }
    }
}

DI void phase_f(const Params& p, unsigned char* lds) {
    constexpr int TILES = 4 * (BT / 256);
    const float* mod = (const float*)(p.ws + WS_MOD);
    for (int it = blockIdx.x; it < TILES; it += gridDim.x) {
        const int tid = get_tid(), lane = tid & 63, wave = tid >> 6, wp = wave >> 2, wq = wave & 3;
        const int tn = it & 3, tm = it >> 2;
        const int n0 = tn * 256, tok0 = tm * 256, b = tok0 >> 12;
        f32x4 acc[4][4];
#pragma unroll
        for (int i = 0; i < 4; ++i)
#pragma unroll
            for (int j = 0; j < 4; ++j) acc[i][j] = f32x4{0.f, 0.f, 0.f, 0.f};
        gemm_mainloop<4>(acc, RowLoader{(const bf16_t*)(p.ws + WS_WTO) + (size_t)n0 * DM, DM}, RowLoader{(const bf16_t*)(p.ws + WS_H) + (size_t)tok0 * DM, DM}, DM / 64, lds);
        const int l15 = lane & 15, lk = lane >> 4;
        constexpr int ES = 528;
        float ss[4] = {0.f, 0.f, 0.f, 0.f};
#pragma unroll
        for (int i = 0; i < 4; ++i) {
            const int n = n0 + wp * 64 + i * 16 + lk * 4;
            const f32x4 g1 = *(const f32x4*)(mod + b * 6144 + 2048 + n);
            const f32x4 s2 = *(const f32x4*)(mod + b * 6144 + 4096 + n), gf = *(const f32x4*)(p.in[I_NFFN] + n);
            const f32x4 gm = f32x4{gf[0] * (1.f + s2[0]), gf[1] * (1.f + s2[1]), gf[2] * (1.f + s2[2]), gf[3] * (1.f + s2[3])};
#pragma unroll
            for (int j = 0; j < 4; ++j) {
                const int tl = wq * 64 + j * 16 + l15;
                const f32x4 xv = *(const f32x4*)(p.in[I_X] + (size_t)(tok0 + tl) * DM + n);
                const f32x4 x1 = f32x4{xv[0] + g1[0] * acc[i][j][0], xv[1] + g1[1] * acc[i][j][1], xv[2] + g1[2] * acc[i][j][2], xv[3] + g1[3] * acc[i][j][3]};
                *(u32x2*)((bf16_t*)(p.out + (size_t)(tok0 + tl) * DM) + n) = u32x2{pk2(x1[0], x1[1]), pk2(x1[2], x1[3])};
                ss[j] += x1[0] * x1[0] + x1[1] * x1[1] + x1[2] * x1[2] + x1[3] * x1[3];
                *(u32x2*)(lds + tl * ES + (wp * 64 + i * 16 + lk * 4) * 2) = u32x2{pk2(x1[0] * gm[0], x1[1] * gm[1]), pk2(x1[2] * gm[2], x1[3] * gm[3])};
            }
        }
#pragma unroll
        for (int j = 0; j < 4; ++j) {
            const float t = sum_x32(sum_x16(ss[j]));
            if (lk == 0) ((float*)(p.ws + WS_SSQ1))[(size_t)(tok0 + wq * 64 + j * 16 + l15) * 16 + tn * 4 + wp] = t;
        }
        __syncthreads();
        bf16_t* Y = (bf16_t*)(p.ws + WS_Y);
#pragma unroll
        for (int q = 0; q < 8; ++q) {
            const int idx = tid + q * NT, row = idx >> 5, ch = idx & 31;
            *(u32x4*)(Y + (size_t)(tok0 + row) * DM + n0 + ch * 8) = *(const u32x4*)(lds + row * ES + ch * 16);
        }
    }
}

DI void ins16(float (&L)[16], float v) {
#pragma unroll
    for (int i = 0; i < 16; ++i) { const float hi = fmaxf(L[i], v); v = fminf(L[i], v); L[i] = hi; }
}
DI void cex_desc(float& a, float& b) { const float hi = fmaxf(a, b), lo = fminf(a, b); a = hi; b = lo; }
DI void bitonic_merge16_desc(float (&v)[16]) {
#pragma unroll
    for (int j = 8; j > 0; j >>= 1)
#pragma unroll
        for (int i = 0; i < 16; ++i) if ((i ^ j) > i) cex_desc(v[i], v[i ^ j]);
}
DI void sort16_desc(float (&v)[16]) {
#pragma unroll
    for (int p = 1; p < 16; p <<= 1)
#pragma unroll
        for (int k = p; k >= 1; k >>= 1)
#pragma unroll
            for (int j = k % p; j <= 15 - k; j += 2 * k)
#pragma unroll
                for (int i = 0; i <= (k - 1 < 15 - j - k ? k - 1 : 15 - j - k); ++i)
                    if ((i + j) / (2 * p) == (i + j + k) / (2 * p)) cex_desc(v[i + j], v[i + j + k]);
}
DI void top16_merge(float (&a)[16], const float (&b)[16]) {
#pragma unroll
    for (int i = 0; i < 16; ++i) a[i] = fmaxf(a[i], b[15 - i]);
    bitonic_merge16_desc(a);
}
DI float pack_idx(float v, unsigned idx, unsigned mask) { return __uint_as_float((__float_as_uint(v) & ~mask) | idx); }
DI void peer_h2_item(const Params& p, int item) {
    const int tok0 = item * 128;
    const int tid = get_tid(), lane = tid & 63, wave = tid >> 6, b = tok0 >> 12;
    const float* sh2 = (const float*)(p.ws + WS_MOD) + b * 6144 + 3072 + lane * 16;
    float sh[16];
#pragma unroll
    for (int i = 0; i < 16; i += 4) { const f32x4 v = *(const f32x4*)(sh2 + i); sh[i] = v[0]; sh[i + 1] = v[1]; sh[i + 2] = v[2]; sh[i + 3] = v[3]; }
    u32x4 ny0, ny1; float nsq;
#define S0_LOAD(tk) do { const bf16_t* yr_ = (const bf16_t*)(p.ws + WS_Y) + (size_t)(tk) * DM + lane * 16; ny0 = *(const u32x4*)yr_; ny1 = *(const u32x4*)(yr_ + 8); \
        nsq = ((const float*)(p.ws + WS_SSQ1))[(size_t)(tk) * 16 + (lane & 15)]; } while (0)
    S0_LOAD(tok0 + wave * 8);
#pragma unroll 1
    for (int t = 0; t < 8; ++t) {
        const int tok = tok0 + wave * 8 + t;
        const u32x4 y0 = ny0, y1 = ny1;
        const float sq1 = nsq;
        if (t + 1 < 8) S0_LOAD(tok + 1);
        const float rs = rsqrtf(sum16(sq1) * (1.f / DM) + EPS);
        float f[16];
#pragma unroll
        for (int q = 0; q < 4; ++q) { f[2 * q] = bflo(y0[q]); f[2 * q + 1] = bfhi(y0[q]); f[8 + 2 * q] = bflo(y1[q]); f[9 + 2 * q] = bfhi(y1[q]); }
        float mx = 0.f;
#pragma unroll
        for (int i = 0; i < 16; ++i) { f[i] = rs * f[i] + sh[i]; mx = fmaxf(mx, fabsf(f[i])); }
        mx = fmaxf(wave_max(mx), 1e-30f);
        const float qs = X8_MAX / mx;
        int w8[4];
#pragma unroll
        for (int q = 0; q < 4; ++q) {
            w8[q] = __builtin_amdgcn_cvt_pk_fp8_f32(f[4 * q] * qs, f[4 * q + 1] * qs, 0, false);
            w8[q] = __builtin_amdgcn_cvt_pk_fp8_f32(f[4 * q + 2] * qs, f[4 * q + 3] * qs, w8[q], true);
        }
        *(u32x4*)(p.ws + WS_X8 + (size_t)tok * DM + lane * 16) = u32x4{(unsigned)w8[0], (unsigned)w8[1], (unsigned)w8[2], (unsigned)w8[3]};
        if (lane == 0) ((float*)(p.ws + WS_SX))[tok] = mx * (1.f / X8_MAX);
    }
#undef S0_LOAD
}
DI void peer_scores_top16(const bf16x8 (&bq)[8], const bf16_t* keysU  , int r, int hf, float (&L)[16]) {
    const unsigned ko = (unsigned)((hf * 32 + r) * 16);
    f32x16 acc[4];
#pragma unroll
    for (int m = 0; m < 4; ++m)
#pragma unroll
        for (int i = 0; i < 16; ++i) acc[m][i] = 0.f;
#pragma unroll
    for (int ks = 0; ks < 8; ++ks) {
#pragma unroll
        for (int m = 0; m < 4; ++m) {
            const bf16x8 ak = *(const bf16x8*)((const char*)keysU + (ko + (unsigned)(m * 8192)) + ks * 1024);
            acc[m] = MFMA32(ak, bq[ks], acc[m]);
        }
    }
    float V[4][16];
#define PK_SORT(m) do { _Pragma("unroll") for (int i = 0; i < 16; ++i) V[m][i] = pack_idx(acc[m][i], (unsigned)((m) * 32 + (i & 3) + 8 * (i >> 2) + 4 * hf), 127u); sort16_desc(V[m]); } while (0)
    PK_SORT(0); PK_SORT(1); top16_merge(V[0], V[1]); __builtin_amdgcn_sched_barrier(0);
    PK_SORT(2); PK_SORT(3); top16_merge(V[2], V[3]); __builtin_amdgcn_sched_barrier(0);
    top16_merge(V[0], V[2]);
#undef PK_SORT
    const int hf3 = (get_tid() >> 5) & 1;
    float P[16];
#pragma unroll
    for (int i = 0; i < 16; ++i) {
        auto sw = __builtin_amdgcn_permlane32_swap(__float_as_uint(V[0][i]), __float_as_uint(V[0][i]), false, false);
        P[i] = hf3 ? __uint_as_float(sw[0]) : __uint_as_float(sw[1]);
    }
    top16_merge(V[0], P);
#pragma unroll
    for (int i = 0; i < 16; ++i) L[i] = V[0][i];
}
DI void peer_pick(const Params& p, const float* l1, const float* l2, int tokg, int h) {
    float v1[16], v2[16];
#pragma unroll
    for (int i = 0; i < 16; i += 4) {
        const f32x4 a = *(const f32x4*)(l1 + i), b = *(const f32x4*)(l2 + i);
        v1[i] = a[0]; v1[i + 1] = a[1]; v1[i + 2] = a[2]; v1[i + 3] = a[3];
        v2[i] = b[0]; v2[i + 1] = b[1]; v2[i + 2] = b[2]; v2[i + 3] = b[3];
    }
    float B[16];
#pragma unroll
    for (int i = 0; i < 16; ++i) B[i] = -3.0e38f;
#pragma unroll
    for (int i = 0; i < 16; ++i)
#pragma unroll
        for (int j = 0; j < 16; ++j)
            if ((i + 1) * (j + 1) <= 16) ins16(B, pack_idx(v1[i] + v2[j], (unsigned)(i * 16 + j), 255u));
    float e[16], sum = 0.f;
#pragma unroll
    for (int k = 0; k < 16; ++k) { e[k] = __expf(B[k] - B[0]); sum += e[k]; }
    const float inv = 1.f / sum;
    int* ex = (int*)(p.ws + WS_EXPI) + (size_t)tokg * 128 + h * 16;
    float* gt = (float*)(p.ws + WS_GATE) + ((size_t)tokg * 128 + h * 16) * 2;
    const f32x2* usv = (const f32x2*)(p.ws + WS_USC);
    int ev[16]; float gv[16], sv[16];
#pragma unroll
    for (int k = 0; k < 16; ++k) {
        const unsigned ij = __float_as_uint(B[k]) & 255u;
        const unsigned i1 = __float_as_uint(l1[ij >> 4]) & 127u, i2 = __float_as_uint(l2[ij & 15u]) & 127u;
        ev[k] = (int)(i1 * 128u + i2);
        const f32x2 sc2 = usv[ev[k]];
        gv[k] = e[k] * inv * sc2[1];
        sv[k] = sc2[0];
    }
#pragma unroll
    for (int k = 0; k < 16; k += 4) *(u32x4*)(ex + k) = u32x4{(unsigned)ev[k], (unsigned)ev[k + 1], (unsigned)ev[k + 2], (unsigned)ev[k + 3]};
#pragma unroll
    for (int k = 0; k < 16; k += 2) *(f32x4*)(gt + 2 * k) = f32x4{gv[k], sv[k], gv[k + 1], sv[k + 1]};
}
DI void phase_h(const Params& p, unsigned char* lds) {
    for (int it = blockIdx.x; it < BT / 128; it += gridDim.x) peer_h2_item(p, it);
    constexpr int TILES = 8 * (BT / 256);
    constexpr int QS = 528;
    float* rsb = (float*)(lds + 136 * 1024);
    bool pre = false;
    for (int it = blockIdx.x; it < TILES; it += gridDim.x) {
        const int tid = get_tid(), lane = tid & 63, wave = tid >> 6, wp = wave >> 2, wq = wave & 3;
        const int tn = it & 7, tm = it >> 3;
        const int n0 = tn * 256, tok0 = tm * 256, b = tok0 >> 12;
        const int it2 = it + (int)gridDim.x; const bool has2 = it2 < TILES;
        const int n2 = (has2 ? it2 & 7 : tn) * 256, tk2 = (has2 ? it2 >> 3 : tm) * 256;
        __syncthreads();
        if (tid < 256) {
            const float* sq = (const float*)(p.ws + WS_SSQ1) + (size_t)(tok0 + tid) * 16;
            const f32x4 a = *(const f32x4*)sq, c = *(const f32x4*)(sq + 4), d = *(const f32x4*)(sq + 8), e = *(const f32x4*)(sq + 12);
            const float ssq = (a[0] + a[1] + a[2] + a[3]) + (c[0] + c[1] + c[2] + c[3]) + (d[0] + d[1] + d[2] + d[3]) + (e[0] + e[1] + e[2] + e[3]);
            rsb[tid] = rsqrtf(ssq * (1.f / DM) + EPS);
        }
        f32x4 acc[4][4];
#pragma unroll
        for (int i = 0; i < 4; ++i)
#pragma unroll
            for (int j = 0; j < 4; ++j) acc[i][j] = f32x4{0.f, 0.f, 0.f, 0.f};
        gemm_mainloop<4>(acc, RowLoader{(const bf16_t*)(p.ws + WS_WTQ) + (size_t)n0 * DM, DM}, RowLoader{(const bf16_t*)(p.ws + WS_Y) + (size_t)tok0 * DM, DM}, DM / 64, lds, pre);
        pre = has2;
        {
            const float* shq = (const float*)(p.ws + WS_SHQ) + b * 2048;
            const int l15 = lane & 15, lk = lane >> 4;
#pragma unroll
            for (int i = 0; i < 4; ++i) {
                const int nl = wp * 64 + i * 16 + lk * 4;
                const f32x4 sh = *(const f32x4*)(shq + n0 + nl);
#pragma unroll
                for (int j = 0; j < 4; ++j) {
                    const int tl = wq * 64 + j * 16 + l15;
                    const float rs = rsb[tl];
                    *(u32x2*)(lds + tl * QS + nl * 2) = u32x2{pk2(rs * acc[i][j][0] + sh[0], rs * acc[i][j][1] + sh[1]), pk2(rs * acc[i][j][2] + sh[2], rs * acc[i][j][3] + sh[3])};
                }
            }
        }
        __syncthreads();
        float L[16];
        {
            const int t1 = get_tid(), ln = t1 & 63, w1 = __builtin_amdgcn_readfirstlane(t1 >> 6), r = ln & 31, hf = ln >> 5, hpl = w1 & 1, tb = w1 >> 1;
            const int hp = 2 * tn + hpl;
            const bf16_t* keys = (const bf16_t*)(p.ws + WS_KEYS) + (size_t)((hp & 1) * 8 + (hp >> 1)) * 128 * 128;
            const unsigned char* qrow = lds + (tb * 32 + r) * QS + (hpl * 128 + 8 * hf) * 2;
            bf16x8 bq[8];
#pragma unroll
            for (int ks = 0; ks < 8; ++ks) bq[ks] = *(const bf16x8*)(qrow + 32 * ks);
            peer_scores_top16(bq, keys, r, hf, L);
        }
        __syncthreads();
        if (has2) gemm_prefetch<4>(RowLoader{(const bf16_t*)(p.ws + WS_WTQ) + (size_t)n2 * DM, DM}, RowLoader{(const bf16_t*)(p.ws + WS_Y) + (size_t)tk2 * DM, DM}, lds);
        float* lists = (float*)(lds + 96 * 1024);
        {
            const int t2 = get_tid(), ln = t2 & 63, w2 = __builtin_amdgcn_readfirstlane(t2 >> 6);
            if ((ln >> 5) == 0) {
                float* dst = lists + (((w2 >> 1) * 32 + (ln & 31)) * 2 + (w2 & 1)) * 16;
#pragma unroll
                for (int i = 0; i < 16; i += 4) *(f32x4*)(dst + i) = f32x4{L[i], L[i + 1], L[i + 2], L[i + 3]};
            }
        }
        __syncthreads();
        {
            const int t3 = get_tid();
            if (t3 < 256) peer_pick(p, lists + (t3 * 2) * 16, lists + (t3 * 2 + 1) * 16, tok0 + t3, tn);
        }
    }
}

DI float dot16_fp8(const u32x4& w, const float (&x)[16]) {
    float d = 0.f;
#pragma unroll
    for (int i = 0; i < 4; ++i) {
        const auto lo = __builtin_amdgcn_cvt_pk_f32_fp8((int)w[i], false);
        const auto hi = __builtin_amdgcn_cvt_pk_f32_fp8((int)w[i], true);
        d += lo[0] * x[4 * i] + lo[1] * x[4 * i + 1] + hi[0] * x[4 * i + 2] + hi[1] * x[4 * i + 3];
    }
    return d;
}
template<int NPART, class F> DI void run_partitioned(const Params& p, unsigned char* lds, int qbase, int nitems, F&& body) {
    unsigned* ctl = (unsigned*)(p.ws + WS_CTL);
    volatile LAS unsigned* slot = (volatile LAS unsigned*)(LAS unsigned char*)(lds + LDS_ST_OFF + 8);
    const int x0 = (int)(xb_xcc_id() & 7u);
#pragma unroll 1
    for (int pp = 0; pp < NPART; ++pp) {
        const int part = (NPART == 8) ? ((x0 + pp) & 7) : ((((x0 + (pp >> 1)) & 7)) + 8 * (pp & 1));
        for (;;) {
            __syncthreads();
            if (get_tid() == 0) slot[0] = atomicAdd(ctl + qbase + 64 * part, 1u);
            __syncthreads();
            const int it = __builtin_amdgcn_readfirstlane((int)slot[0]);
            if (it >= nitems) break;
            body(part, it);
        }
    }
}
constexpr int CTL_QUEUE_I2 = 8320, CTL_QUEUE_I3 = 9408;
constexpr int UW_BYTES = 8384, UW_H2S = 1040, UW_LIST = 4160, UW_LCAP = 2112;
DI int peer_u_list(unsigned* lst, const u32x4& ia, const u32x4& ib, int part, int) {
    const int lane = get_tid() & 63;
    int cnt = 0;
#pragma unroll
    for (int g = 0; g < 8; ++g) {
        const unsigned id = (g < 4) ? ia[g & 3] : ib[g & 3];
        const unsigned idx = (unsigned)((g < 4 ? 0 : 256) + lane * 4 + (g & 3));
        const bool m = (int)(id >> 11) == part;
        const unsigned long long bm = __ballot(m);
        const int pos = cnt + __builtin_amdgcn_mbcnt_hi((unsigned)(bm >> 32), __builtin_amdgcn_mbcnt_lo((unsigned)bm, 0u));
        if (m) lst[pos] = (idx << 16) | id;
        cnt += __popcll(bm);
    }
    const unsigned last = lst[max(cnt - 1, 0)];
    if (lane < 16) lst[cnt + lane] = last;
    return cnt;
}
DI void peer_u_chunk(const Params& p, int part, int chunk, unsigned char* lds) {
    const int tid = get_tid(), lane = tid & 63, wave = __builtin_amdgcn_readfirstlane(tid >> 6);
    unsigned char* wl = lds + wave * UW_BYTES;
    const int n = lane & 15, kg = lane >> 4;
    const int ln4 = lane >> 2;
    const unsigned char* UT4 = p.ws + WS_UT + (lane & 3) * 16;
    const int bpi = 16 * n + 4 * kg;
    const unsigned char* arow = wl + (n & 3) * UW_H2S + kg * 16;
    const int tokw = chunk * 256 + wave * 4;
    u32x4 pia, pib, ph[4]; f32x4 psx;
#define U_LOAD_IDS(tok) do { const u32x4* ex_ = (const u32x4*)((const int*)(p.ws + WS_EXPI) + (size_t)(tok) * 128) + lane; pia = ex_[0]; pib = ex_[64]; } while (0)
#define U_LOAD_H2(tok) do { const unsigned char* hr_ = p.ws + WS_X8 + (size_t)(tok) * DM + lane * 16; \
        ph[0] = *(const u32x4*)hr_; ph[1] = *(const u32x4*)(hr_ + DM); ph[2] = *(const u32x4*)(hr_ + 2 * DM); ph[3] = *(const u32x4*)(hr_ + 3 * DM); \
        psx = *(const f32x4*)((const float*)(p.ws + WS_SX) + (tok)); } while (0)
#define U_BPERM(dst, src) do { dst[0] = (unsigned)__builtin_amdgcn_ds_bpermute(bpi, (int)src[0]); dst[1] = (unsigned)__builtin_amdgcn_ds_bpermute(bpi, (int)src[1]); \
        dst[2] = (unsigned)__builtin_amdgcn_ds_bpermute(bpi, (int)src[2]); dst[3] = (unsigned)__builtin_amdgcn_ds_bpermute(bpi, (int)src[3]); } while (0)
    U_LOAD_IDS(tokw); U_LOAD_H2(tokw);
    int cntc = peer_u_list((unsigned*)(wl + UW_LIST), pia, pib, part, lane);
    U_LOAD_IDS(tokw + 64);
    int have = -1;
    u32x4 brow[8];
#pragma unroll 1
    for (int s = 0; s < 4; ++s) {
        const int tok0 = tokw + s * 64;
#pragma unroll
        for (int r = 0; r < 4; ++r) *(u32x4*)(wl + r * UW_H2S + lane * 16) = ph[r];
        const f32x4 sx = psx;
        const unsigned* lc = (const unsigned*)(wl + UW_LIST + (s & 1) * UW_LCAP);
        unsigned* ln = (unsigned*)(wl + UW_LIST + ((s + 1) & 1) * UW_LCAP);
        int cntn = 0;
        if (s + 1 < 4) {
            cntn = peer_u_list(ln, pia, pib, part, lane);
            U_LOAD_H2(tok0 + 64);
            if (s + 2 < 4) U_LOAD_IDS(tok0 + 128);
        }
        const int ntiles = (cntc + 15) >> 4;
#pragma unroll 1
        for (int t = 0; t < ntiles; ++t) {
            const unsigned ent = lc[t * 16 + n];
            if (have != s * 64 + t) {
                const unsigned char* rp = UT4 + (size_t)(lc[t * 16 + ln4] & 0x3fffu) * 512;
#pragma unroll
                for (int ks = 0; ks < 8; ++ks) brow[ks] = *(const u32x4*)(rp + ks * 64);
            }
            unsigned entn;
            if (t + 1 < ntiles) { entn = lc[(t + 1) * 16 + ln4]; have = s * 64 + t + 1; }
            else if (cntn > 0) { entn = ln[ln4]; have = (s + 1) * 64; }
            else { entn = lc[t * 16 + ln4]; have = -1; }
            const unsigned char* rpn = UT4 + (size_t)(entn & 0x3fffu) * 512;
            const int idx = (int)(ent >> 16), tj = idx >> 7;
            const f32x2 gs = ((const f32x2*)(p.ws + WS_GATE))[(size_t)(tok0 + tj) * 128 + (idx & 127)];
            f32x4 acc0 = f32x4{0.f, 0.f, 0.f, 0.f}, acc1 = acc0;
            u32x4 a0 = *(const u32x4*)arow, a1 = *(const u32x4*)(arow + 64), bc;
            U_BPERM(bc, brow[0]);
#pragma unroll
            for (int ks = 0; ks < 8; ++ks) {
                const i32x8 av = i32x8{(int)a0[0], (int)a0[1], (int)a0[2], (int)a0[3], (int)a1[0], (int)a1[1], (int)a1[2], (int)a1[3]};
                const i32x8 bv = i32x8{(int)bc[0], (int)bc[1], (int)bc[2], (int)bc[3], 0, 0, 0, 0};
                if (ks < 7) { a0 = *(const u32x4*)(arow + (ks + 1) * 128); a1 = *(const u32x4*)(arow + (ks + 1) * 128 + 64); U_BPERM(bc, brow[ks + 1]); }
                if (ks & 1) acc1 = __builtin_amdgcn_mfma_scale_f32_16x16x128_f8f6f4(av, bv, acc1, 0, 4, 0, 0x7F7F7F7F, 0, 0x7F7F7F7F);
                else        acc0 = __builtin_amdgcn_mfma_scale_f32_16x16x128_f8f6f4(av, bv, acc0, 0, 4, 0, 0x7F7F7F7F, 0, 0x7F7F7F7F);
                brow[ks] = *(const u32x4*)(rpn + ks * 64);
                __builtin_amdgcn_sched_barrier(0);
            }
            const float d0 = acc0[0] + acc1[0], d1 = acc0[1] + acc1[1], d2 = acc0[2] + acc1[2], d3 = acc0[3] + acc1[3];
            const float araw = (tj == 0) ? d0 : (tj == 1) ? d1 : (tj == 2) ? d2 : d3;
            const float sxv = (tj == 0) ? sx[0] : (tj == 1) ? sx[1] : (tj == 2) ? sx[2] : sx[3];
            const float a = araw * (gs[1] * sxv);
            const float y = 0.7978845608028654f * (a + 0.044715f * a * a * a);
            const float th = 1.f - 2.f * __builtin_amdgcn_rcpf(__expf(2.f * y) + 1.f);
            const float w = 0.5f * a * (1.f + th) * gs[0];
            if (kg == 0 && t * 16 + n < cntc) ((u32x2*)(p.ws + WS_PAIRS))[(size_t)(tok0 + tj) * 128 + (idx & 127)] = u32x2{ent & 0x3fffu, __float_as_uint(w)};
        }
        cntc = cntn;
    }
#undef U_BPERM
#undef U_LOAD_IDS
#undef U_LOAD_H2
}
DI void phase_i2(const Params& p, unsigned char* lds) {
    run_partitioned<8>(p, lds, CTL_QUEUE_I2, BT / 256, [&](int part, int it) { peer_u_chunk(p, part, it, lds); });
}
typedef int i32x2_t __attribute__((ext_vector_type(2)));
constexpr int VW_BYTES = 9504, VW_PAIRS = 8192, VW_HI = 9216, VW_LO = 9344, VW_ZERO = 9472;
DI void peer_v_chunk(const Params& p, int p8, int chunk, unsigned char* lds) {
    const int tid = get_tid(), lane = tid & 63, wave = __builtin_amdgcn_readfirstlane(tid >> 6);
    unsigned char* wl = lds + wave * VW_BYTES;
    const int slice = p8 & 3;
    const unsigned char* VT4 = p.ws + WS_VTAB + (size_t)slice * 16384 * 128;
    const float* mod = (const float*)(p.ws + WS_MOD);
    const int er = lane >> 3, pc = lane & 7;
    const int n = lane & 31, kg = lane >> 5;
    const int col = slice * 256 + 8 * n;
    const int tokw = (p8 >> 2) * 16384 + chunk * 256 + wave;
    if (lane < 4) ((unsigned*)(wl + VW_ZERO))[lane] = 0u;
    const unsigned char* abase = wl + ((n == 0) ? VW_HI + 16 * kg : (n == 1) ? VW_LO + 16 * kg : VW_ZERO);
    const int astep = (n < 2) ? 1 : 0;
    const int row0 = 32 * kg + (lane & 15), sw0 = (row0 >> 1) & 7;
    const unsigned char* tb0 = wl + row0 * 128 + 8 * ((lane >> 4) & 1);
    u32x4 pp = *((const u32x4*)(p.ws + WS_PAIRS + (size_t)tokw * 1024) + lane);
#pragma unroll 1
    for (int step = 0; step < 16; ++step) {
        const int tok = tokw + step * 16, b = tok >> 12;
        *(u32x4*)(wl + VW_PAIRS + lane * 16) = pp;
        const float w0 = __uint_as_float(pp[1]), w1 = __uint_as_float(pp[3]);
        const float mx = fmaxf(wave_max(fmaxf(fabsf(w0), fabsf(w1))), 1e-30f);
        const float ws = 224.f / mx;
        const int hi = __builtin_amdgcn_cvt_pk_fp8_f32(w0 * ws, w1 * ws, 0, false);
        const f32x2 dq = __builtin_amdgcn_cvt_pk_f32_fp8(hi, false);
        const int lo = __builtin_amdgcn_cvt_pk_fp8_f32((w0 * ws - dq[0]) * 16.f, (w1 * ws - dq[1]) * 16.f, 0, false);
        ((unsigned short*)(wl + VW_HI))[lane] = (unsigned short)hi;
        ((unsigned short*)(wl + VW_LO))[lane] = (unsigned short)lo;
        if (step + 1 < 16) pp = *((const u32x4*)(p.ws + WS_PAIRS + (size_t)(tok + 16) * 1024) + lane);
        bf16_t* xo = (bf16_t*)(p.out + (size_t)tok * DM) + col;
        const u32x4 x1w = *(const u32x4*)xo;
        const f32x4 g2a = *(const f32x4*)(mod + b * 6144 + 5120 + col), g2b = *(const f32x4*)(mod + b * 6144 + 5120 + col + 4);
        float res[8];
#pragma unroll
        for (int i = 0; i < 8; ++i) res[i] = 0.f;
#pragma unroll 1
        for (int hf = 0; hf < 2; ++hf) {
            asm volatile("s_waitcnt lgkmcnt(0)" ::: "memory");
            __builtin_amdgcn_sched_barrier(0);
            const unsigned* pr = (const unsigned*)(wl + VW_PAIRS) + 2 * (64 * hf + er);
#pragma unroll
            for (int q = 0; q < 8; ++q) {
                const unsigned e = pr[16 * q];
                const int sw = (4 * q + (er >> 1)) & 7;
                __builtin_amdgcn_global_load_lds((const unsigned*)(VT4 + (size_t)e * 128 + ((pc ^ sw) << 4)), (unsigned*)(wl + q * 1024), 16, 0, 0);
            }
            const u32x4 a0 = *(const u32x4*)(abase + astep * (64 * hf)), a1 = *(const u32x4*)(abase + astep * (64 * hf + 32));
            const i32x8 av = i32x8{(int)a0[0], (int)a0[1], (int)a0[2], (int)a0[3], (int)a1[0], (int)a1[1], (int)a1[2], (int)a1[3]};
            asm volatile("s_waitcnt vmcnt(0)" ::: "memory");
            __builtin_amdgcn_sched_barrier(0);
#pragma unroll
            for (int nt = 0; nt < 8; ++nt) {
                const int c = (nt ^ sw0) << 4;
                const i32x2_t b0 = __builtin_amdgcn_ds_read_tr4_b64_v2i32((LAS i32x2_t*)(LAS unsigned char*)(tb0 + c));
                const i32x2_t b1 = __builtin_amdgcn_ds_read_tr4_b64_v2i32((LAS i32x2_t*)(LAS unsigned char*)(tb0 + 16 * 128 + c));
                const i32x8 bv = i32x8{b0[0], b0[1], b1[0], b1[1], 0, 0, 0, 0};
                f32x16 z;
#pragma unroll
                for (int i = 0; i < 16; ++i) z[i] = 0.f;
                const f32x16 d = __builtin_amdgcn_mfma_scale_f32_32x32x64_f8f6f4(av, bv, z, 0, 4, 0, 0x7F7F7F7F, 0, 0x7F7F7F7F);
                res[nt] += d[0] + d[1] * (1.f / 16.f);
            }
        }
        const float iw = mx * (1.f / 224.f);
        float xv[8];
#pragma unroll
        for (int i = 0; i < 4; ++i) { xv[2 * i] = bflo(x1w[i]); xv[2 * i + 1] = bfhi(x1w[i]); }
        float ss = 0.f;
#pragma unroll
        for (int i = 0; i < 8; ++i) { xv[i] += (i < 4 ? g2a[i & 3] : g2b[i & 3]) * (res[i] * iw); ss += xv[i] * xv[i]; }
        if (lane < 32) *(u32x4*)xo = u32x4{pk2(xv[0], xv[1]), pk2(xv[2], xv[3]), pk2(xv[4], xv[5]), pk2(xv[6], xv[7])};
        ss = wave_sum(lane < 32 ? ss : 0.f);
        if (lane == 0) ((float*)(p.ws + WS_SSQ))[(size_t)tok * 8 + slice] = ss;
    }
}
DI void phase_i3(const Params& p, unsigned char* lds) {
    run_partitioned<8>(p, lds, CTL_QUEUE_I3, 16384 / 256, [&](int part, int it) { peer_v_chunk(p, part, it, lds); });
}
DI void phase_i4(const Params& p) {
    const bool bad = xb_ld((unsigned*)(p.ws + WS_CTL) + CTL_BADTID) != 0u || xb_ld((unsigned*)(p.ws + WS_CTL) + XB_TMO) != 0u;
    for (int it = blockIdx.x; it < BT / 16; it += gridDim.x) {
        const int tid = get_tid(), lane = tid & 63, row = it * 16 + (tid >> 6);
        const float* sq = (const float*)(p.ws + WS_SSQ) + (size_t)row * 8;
        const f32x4 s0 = *(const f32x4*)sq;
        const float ss = s0[0] + s0[1] + s0[2] + s0[3];
        float rs = rsqrtf(ss * (1.f / DM) + EPS);
        if (bad) rs = __builtin_nanf("");
        float* o = p.out + (size_t)row * DM;
        u32x2 xw[4];
#pragma unroll
        for (int j = 0; j < 4; ++j) xw[j] = *(const u32x2*)((const bf16_t*)o + j * 256 + lane * 4);
        asm volatile("s_waitcnt vmcnt(0)" ::: "memory");
#pragma unroll
        for (int j = 0; j < 4; ++j) {
            const int c = j * 256 + lane * 4;
            const f32x4 g = *(const f32x4*)(p.in[I_FNG] + c);
            *(f32x4*)(o + c) = f32x4{bflo(xw[j][0]) * rs * g[0], bfhi(xw[j][0]) * rs * g[1], bflo(xw[j][1]) * rs * g[2], bfhi(xw[j][1]) * rs * g[3]};
        }
    }
}

DI float probe_mfma_mixed() {
    const int lane = get_tid() & 63, kg = lane >> 4;
    int aw[8];
#pragma unroll
    for (int v = 0; v < 8; ++v) {
        unsigned w = 0;
#pragma unroll
        for (int b = 0; b < 4; ++b) { const unsigned q = 32u * kg + 4u * v + b; w |= (((q & 63u) + 8u) | ((q >> 6) << 7)) << (8 * b); }
        aw[v] = (int)w;
    }
    const i32x8 av = i32x8{aw[0], aw[1], aw[2], aw[3], aw[4], aw[5], aw[6], aw[7]};
    int c1 = 0, c2 = 0, c4 = 0, c5 = 0; unsigned pi1 = 255;
#pragma unroll 1
    for (int pb = 0; pb < 128; ++pb) {
        const int kgB = pb >> 5, i0 = pb & 31;
        const unsigned hot = (kg == kgB) ? (2u << (4 * (i0 & 7))) : 0u;
        const i32x8 bv = i32x8{(i0 >> 3) == 0 ? (int)hot : 0, (i0 >> 3) == 1 ? (int)hot : 0, (i0 >> 3) == 2 ? (int)hot : 0, (i0 >> 3) == 3 ? (int)hot : 0, 0, 0, 0, 0};
        const f32x4 z = f32x4{0.f, 0.f, 0.f, 0.f};
        const f32x4 dd = __builtin_amdgcn_mfma_scale_f32_16x16x128_f8f6f4(av, bv, z, 0, 4, 0, 0x7F7F7F7F, 0, 0x7F7F7F7F);
        const float d = dd[0];
        unsigned qf = 255;
#pragma unroll 1
        for (unsigned q = 0; q < 128; ++q) { const unsigned byte = ((q & 63u) + 8u) | ((q >> 6) << 7); if (__builtin_amdgcn_cvt_f32_fp8((int)byte, 0) == d) qf = q; }
        c1 += (qf != (unsigned)pb); c2 += (qf != (unsigned)(pb ^ 1));
        { const unsigned k = 64u * (i0 >> 4) + 16u * kgB + (i0 & 15); c4 += (qf != k); }
        { const unsigned k = (unsigned)pb, kgA = (k & 63u) >> 4, j = 16u * (k >> 6) + (k & 15u); c5 += (qf != 32u * kgA + j); }
        if (pb == 1) pi1 = qf;
    }
    return c1 == 0 ? 1.1e6f : c2 == 0 ? 2.2e6f : c4 == 0 ? 4.4e6f : c5 == 0 ? 5.5e6f : (pi1 < 90u ? (10.f + (float)pi1) * 100.f : 7.7e6f);
}

__global__ void __launch_bounds__(NT) mega(Params p) {
    unsigned char* lds = g_lds;
    volatile LAS unsigned* st = (volatile LAS unsigned*)(LAS unsigned char*)(lds + LDS_ST_OFF);
    {
        const unsigned hw = __builtin_amdgcn_s_getreg((5 << 11) | 4);
        if ((threadIdx.x & 63) == 0) g_lds[LDS_WTAB_OFF + hw] = (unsigned char)(threadIdx.x >> 6);
        if (threadIdx.x < 2) st[threadIdx.x] = 0u;
        __syncthreads();
        if (get_tid() != (int)threadIdx.x) ((unsigned*)(p.ws + WS_CTL))[CTL_BADTID] = 1u;
    }
    XcdBarrier bar = xcd_barrier_post((unsigned*)(p.ws + WS_CTL), st);
    float* sm = (float*)lds;

#define STAMP(k, which) do { if (PROBE_PHASE == (k) && blockIdx.x == 0 && get_tid() == 0) ((volatile unsigned long long*)(lds + LDS_PROBE_OFF))[which] = __builtin_amdgcn_s_memrealtime(); } while (0)
    STAMP(21, 0); STAMP(30, 0); STAMP(31, 0);
    STAMP(0, 0); phase_a(p, sm);   xcd_barrier(bar); STAMP(0, 1);
    STAMP(1, 0); phase_b(p, sm);   xcd_barrier(bar); STAMP(1, 1);
    if (PROBE_PHASE == 20) { STAMP(20, 0); xcd_barrier(bar); xcd_barrier(bar); xcd_barrier(bar); xcd_barrier(bar); STAMP(20, 1); }
    STAMP(2, 0); phase_c(p, lds);  xcd_barrier(bar); STAMP(2, 1);
    STAMP(3, 0); phase_d(p, lds);  xcd_barrier(bar); STAMP(3, 1);
    STAMP(5, 0); phase_e(p, lds);  xcd_barrier(bar); STAMP(5, 1);
    STAMP(6, 0); phase_f(p, lds);  xcd_barrier(bar); STAMP(6, 1);
    STAMP(8, 0); phase_h(p, lds);  xcd_barrier(bar); STAMP(8, 1);
    STAMP(10, 0); phase_i2(p, lds); xcd_barrier(bar); STAMP(10, 1);
    STAMP(11, 0); phase_i3(p, lds); xcd_barrier(bar); STAMP(11, 1);
    STAMP(12, 0); phase_i4(p);
    float pm = 0.f;
    if (PROBE_PHASE == 40 && blockIdx.x == 0 && get_tid() < 64) pm = probe_mfma_mixed();
    if (PROBE_PHASE >= 0) {
        xcd_barrier(bar); STAMP(12, 1); STAMP(21, 1);
        if (blockIdx.x == 0 && get_tid() == 0) {
            volatile unsigned long long* ts = (volatile unsigned long long*)(lds + LDS_PROBE_OFF);
            if (PROBE_PHASE == 40) p.out[0] += pm; else
            p.out[0] += (float)(ts[1] - ts[0]) * (0.01f / PROBE_SCALE);
        }
    }
}

extern "C" void kernel_launch(void* const* d_in, const int* in_sizes, int n_in, void* d_out, int out_size, void* d_ws, size_t ws_size, hipStream_t stream) {
    static int grid = 0;
    if (grid == 0) {
        int dev = 0, cus = 0;
        if (hipGetDevice(&dev) != hipSuccess || hipDeviceGetAttribute(&cus, hipDeviceAttributeMultiprocessorCount, dev) != hipSuccess) { fprintf(stderr, "kernel_launch: device query failed\n"); grid = -1; return; }
        if (n_in != N_IN || ws_size < WS_END) { fprintf(stderr, "kernel_launch: unexpected n_in %d or ws_size %zu (< %zu)\n", n_in, ws_size, (size_t)WS_END); grid = -1; return; }
        grid = cus;
    }
    if (grid < 0) return;
    (void)hipMemsetAsync((char*)d_ws + WS_CTL, 0, 64 * 1024, stream);
    Params p{};
    for (int i = 0; i < N_IN; ++i) p.in[i] = (const float*)d_in[i];
    p.out = (float*)d_out; p.ws = (unsigned char*)d_ws;
    hipLaunchKernelGGL(mega, dim3(grid), dim3(NT), 0, stream, p);
}
```

```cpp
#include <hip/hip_runtime.h>
#include <stdint.h>
#include <cstdio>

#define DI __device__ __forceinline__
#define LAS __attribute__((address_space(3)))
typedef unsigned short bf16_t;
typedef short bf16x8 __attribute__((ext_vector_type(8)));
typedef short s16x4 __attribute__((ext_vector_type(4)));
typedef float f32x4 __attribute__((ext_vector_type(4)));
typedef float f32x2 __attribute__((ext_vector_type(2)));
typedef float f32x16 __attribute__((ext_vector_type(16)));
typedef unsigned u32x4 __attribute__((ext_vector_type(4)));
typedef unsigned u32x2 __attribute__((ext_vector_type(2)));

#ifndef PROBE_PHASE
#define PROBE_PHASE (-1)
#endif
#ifndef SHADOW
#define SHADOW 0
#endif
#ifndef PROBE_SCALE
#define PROBE_SCALE 100.f
#endif
constexpr int BATCH = 8, SEQ = 4096, DM = 1024, BT = BATCH * SEQ;
constexpr int CTX = 256, TK = SEQ + CTX;
constexpr int NH = 8, NKV = 2, HD = 64;
constexpr int QD = 512, KVD = 128, HYD = 512, HYC = 1536, GC = 2048, INC = 4352;
constexpr int PH = 8, PNK = 128, PDK = 256, PTOP = 16;
constexpr float EPS = 1e-6f;
constexpr int NT = 1024;

enum { I_X = 0, I_C, I_CTX, I_CCTX, I_ADAW, I_ADAB, I_NMIX, I_NFFN, I_WIN, I_QNG, I_KNG, I_HCW, I_HCB,
       I_HW1, I_HB1, I_HW2, I_HB2, I_HW3, I_HB3, I_HW4, I_HFREQ, I_HSKIP, I_WAO, I_WHO, I_WO, I_PWQ, I_PK1, I_PK2, I_PU, I_PV, I_FNG, N_IN };

constexpr size_t MB = 1024 * 1024;
constexpr size_t WS_CTL   = 0;
constexpr size_t WS_MOD   = 64 * 1024;
constexpr size_t WS_ROPE  = WS_MOD + 9 * 6144 * 4;
static_assert(WS_ROPE + 16 * 1024 + 8 * 2048 * 4 + 4096 <= 512 * 1024, "ws");
constexpr size_t WS_PART  = 512 * 1024;
constexpr size_t WS_WTIN  = 3 * MB;
constexpr size_t WS_WTAO  = WS_WTIN + (size_t)INC * DM * 2;
constexpr size_t WS_WTHO  = WS_WTAO + (size_t)DM * QD * 2;
constexpr size_t WS_WTO   = WS_WTHO + (size_t)DM * HYD * 2;
constexpr size_t WS_WTQ   = WS_WTO + (size_t)DM * DM * 2;
constexpr size_t WS_KEYS  = WS_WTQ + (size_t)2048 * DM * 2;
constexpr size_t WS_R     = WS_KEYS + (size_t)2 * 8 * 128 * 128 * 2;
constexpr size_t WS_KB    = WS_R + (size_t)2 * 512 * 8192 * 2;
constexpr size_t WS_VT    = WS_KB + (size_t)BATCH * NKV * TK * HD * 2;
constexpr size_t WS_HC    = WS_VT + (size_t)BATCH * NKV * TK * HD * 2;
constexpr size_t WS_H     = 60 * MB;
constexpr size_t WS_G     = WS_H + 64 * MB;
constexpr size_t WS_ZT    = WS_G + 128 * MB;
constexpr size_t WS_Q     = WS_ZT + 96 * MB;
constexpr size_t WS_ATT   = WS_Q + 32 * MB;
constexpr size_t WS_HYT   = WS_ATT + 32 * MB;
constexpr size_t WS_TAB   = WS_HYT + 32 * MB;
constexpr size_t WS_END   = WS_TAB + 32 * MB;
static_assert(WS_HC + (size_t)2048 * DM * 2 <= WS_H, "ws overlap");
constexpr size_t WS_FRAW  = WS_ATT;
constexpr size_t WS_HY    = WS_Q;
constexpr size_t WS_UT    = WS_TAB;
constexpr size_t WS_VTAB  = WS_TAB + 16 * MB;
constexpr size_t WS_H8    = WS_ATT;
constexpr size_t WS_W8G   = WS_HYT;
constexpr size_t WS_EXPI  = WS_ATT;
constexpr size_t WS_GATE  = WS_Q;
constexpr size_t WS_PAIRS = WS_HYT;
constexpr size_t WS_SSQ   = WS_PART + 1 * MB;
constexpr size_t WS_USC   = WS_PART + 2 * MB + 320 * 1024;
constexpr size_t WS_Y     = WS_ZT;
constexpr size_t WS_X8    = WS_ZT + 64 * MB;
constexpr size_t WS_SSQ1  = WS_ATT + 16 * MB;
constexpr size_t WS_SX    = WS_PART + 2 * MB + 64 * 1024;
constexpr size_t WS_SHQ   = WS_ROPE + 16 * 1024;
constexpr size_t WS_FSC   = WS_SHQ + 64 * 1024;
constexpr float VSCALE = 64.f;
constexpr float W8_SCALE = 64.f;
constexpr float VT_SCALE = 16.f;
constexpr float X8_MAX = 192.f;

constexpr int CTL_BADTID = 8000;
DI unsigned f2bf(float f) { unsigned u = __builtin_bit_cast(unsigned, f); return (u + 0x7fffu + ((u >> 16) & 1u)) >> 16; }
DI unsigned pk2(float lo, float hi) { return f2bf(lo) | (f2bf(hi) << 16); }
DI float bf2f(unsigned short b) { return __builtin_bit_cast(float, (unsigned)b << 16); }
DI float bflo(unsigned u) { return __builtin_bit_cast(float, u << 16); }
DI float bfhi(unsigned u) { return __builtin_bit_cast(float, u & 0xffff0000u); }
DI float red2pi(float x) { const float k = rintf(x * 0.15915494309189535f); float r = fmaf(-k, 6.2831854820251465f, x); return fmaf(-k, -1.7484555e-7f, r); }
DI float fsin(float x) { return __sinf(red2pi(x)); }
DI float fcos(float x) { return __cosf(red2pi(x)); }
constexpr int LDS_BYTES = 160 * 1024;
constexpr int LDS_ST_OFF = LDS_BYTES - 16;
constexpr int LDS_PROBE_OFF = LDS_BYTES - 16 - 32;
constexpr int LDS_WTAB_OFF = LDS_BYTES - 16 - 32 - 64;
constexpr int LDS_USER = LDS_WTAB_OFF;
__shared__ __attribute__((aligned(16))) unsigned char g_lds[LDS_BYTES];
DI s16x4 lds_rd64(const unsigned char* ptr) { return *(const volatile LAS s16x4*)(const LAS unsigned char*)ptr; }
DI int get_tid() {
    const unsigned hw = __builtin_amdgcn_s_getreg((5 << 11) | 4);
    unsigned w = g_lds[LDS_WTAB_OFF + hw];
    w = __builtin_amdgcn_readfirstlane(w);
    int t;
    asm volatile("v_mbcnt_lo_u32_b32 %0, -1, 0\n\tv_mbcnt_hi_u32_b32 %0, -1, %0\n\tv_lshl_or_b32 %0, %1, 6, %0" : "=&v"(t) : "s"(w));
    return t;
}
template<int CTRL> DI float dppf(float v) { return __uint_as_float(__builtin_amdgcn_update_dpp(0u, __float_as_uint(v), CTRL, 0xF, 0xF, true)); }
template<int CTRL> DI int dppi(int v) { return (int)__builtin_amdgcn_update_dpp(0u, (unsigned)v, CTRL, 0xF, 0xF, true); }
DI float sum16(float v) { v += dppf<0xB1>(v); v += dppf<0x4E>(v); v += dppf<0x141>(v); v += dppf<0x140>(v); return v; }
DI float sum_x16(float v) { auto r = __builtin_amdgcn_permlane16_swap(__float_as_uint(v), __float_as_uint(v), false, false); return __uint_as_float(r[0]) + __uint_as_float(r[1]); }
DI float sum_x32(float v) { auto r = __builtin_amdgcn_permlane32_swap(__float_as_uint(v), __float_as_uint(v), false, false); return __uint_as_float(r[0]) + __uint_as_float(r[1]); }
DI float max_x32(float v) { auto r = __builtin_amdgcn_permlane32_swap(__float_as_uint(v), __float_as_uint(v), false, false); return fmaxf(__uint_as_float(r[0]), __uint_as_float(r[1])); }
DI float wave_sum(float v) { return sum_x32(sum_x16(sum16(v))); }
DI float wave_max(float v) {
    v = fmaxf(v, dppf<0xB1>(v)); v = fmaxf(v, dppf<0x4E>(v)); v = fmaxf(v, dppf<0x141>(v)); v = fmaxf(v, dppf<0x140>(v));
    { auto r = __builtin_amdgcn_permlane16_swap(__float_as_uint(v), __float_as_uint(v), false, false); v = fmaxf(__uint_as_float(r[0]), __uint_as_float(r[1])); }
    { auto r = __builtin_amdgcn_permlane32_swap(__float_as_uint(v), __float_as_uint(v), false, false); v = fmaxf(__uint_as_float(r[0]), __uint_as_float(r[1])); }
    return v;
}


#define XB_TMO      128
#define XB_XCNT(j)  (256  + 64 * (j))
#define XB_XSUB(j)  (1280 + 64 * (j))
#define XB_XGEN(j)  (2304 + 64 * (j))
#define XB_TOP      3328
#define XB_TOPGEN   3392
#define XCD_BAR_WORDS 3456
#define XB_SPIN_CAP (1u << 27)
DI unsigned xb_ld(unsigned* p)              { return __hip_atomic_load(p, __ATOMIC_RELAXED, __HIP_MEMORY_SCOPE_AGENT); }
DI unsigned xb_add(unsigned* p, unsigned v) { return __hip_atomic_fetch_add(p, v, __ATOMIC_RELAXED, __HIP_MEMORY_SCOPE_AGENT); }
DI unsigned xb_xcc_id() { return (unsigned)__builtin_amdgcn_s_getreg((3 << 11) | 20) & 0xFu; }
#define XB_SPIN(cond, bar) do { unsigned _sp = 0; while (cond) { __builtin_amdgcn_s_sleep(1); \
    if ((++_sp & 255u) == 0u) { if (xb_ld(&(bar)[XB_TMO])) break; if (_sp > XB_SPIN_CAP) { atomicAdd(&(bar)[XB_TMO], 1u); break; } } } } while (0)
struct XcdBarrier { unsigned* bar; unsigned x; volatile LAS unsigned* st; };
DI XcdBarrier xcd_barrier_post(unsigned* bar, volatile LAS unsigned* st) {
    XcdBarrier b; b.bar = bar; b.x = xb_xcc_id(); b.st = st;
    if (get_tid() == 0) (void)xb_add(&bar[XB_XCNT(b.x)], 1u);
    return b;
}
DI void xcd_barrier_complete(unsigned* bar, unsigned x, unsigned& nloc, unsigned& nx) {
    const unsigned G = gridDim.x * gridDim.y * gridDim.z;
    unsigned sum, cnt, mine, sp = 0u;
    for (;;) {
        sum = 0u; cnt = 0u; mine = 0u;
#pragma unroll
        for (unsigned j = 0; j < 16; ++j) { const unsigned c = xb_ld(&bar[XB_XCNT(j)]); sum += c; cnt += (c > 0u) ? 1u : 0u; mine = (j == x) ? c : mine; }
        if (sum == G) break;
        __builtin_amdgcn_s_sleep(1);
        if ((++sp & 255u) == 0u) { if (xb_ld(&bar[XB_TMO])) break; if (sp > XB_SPIN_CAP) { atomicAdd(&bar[XB_TMO], 1u); break; } }
    }
    nloc = mine > 0u ? mine : 1u; nx = cnt > 0u ? cnt : 1u;
}
DI void xcd_barrier(const XcdBarrier& b) {
    asm volatile("s_waitcnt vmcnt(0)" ::: "memory");
    __syncthreads();
    if (get_tid() == 0) {
        unsigned* bar = b.bar;
        __builtin_amdgcn_s_waitcnt(0);
        unsigned nloc = b.st[0], nx = b.st[1];
        if (nloc == 0u) { xcd_barrier_complete(bar, b.x, nloc, nx); b.st[0] = nloc; b.st[1] = nx; }
        const unsigned old = xb_add(&bar[XB_XSUB(b.x)], 1u);
        const unsigned gen = old / nloc;
        if (old + 1u == (gen + 1u) * nloc) {
            __builtin_amdgcn_fence(__ATOMIC_RELEASE, "agent");
            asm volatile("s_waitcnt vmcnt(0)" ::: "memory");
            const unsigned og = xb_add(&bar[XB_TOP], 1u);
            const unsigned tg = og / nx;
            if (og + 1u == (tg + 1u) * nx) xb_add(&bar[XB_TOPGEN], 1u);
            else XB_SPIN(xb_ld(&bar[XB_TOPGEN]) == tg, bar);
            __builtin_amdgcn_fence(__ATOMIC_ACQUIRE, "agent");
            xb_add(&bar[XB_XGEN(b.x)], 1u);
            asm volatile("s_waitcnt vmcnt(0)" ::: "memory");
        } else {
            XB_SPIN(xb_ld(&bar[XB_XGEN(b.x)]) == gen, bar);
            __builtin_amdgcn_fence(__ATOMIC_ACQUIRE, "agent");
            asm volatile("s_waitcnt vmcnt(0)" ::: "memory");
        }
    }
    __syncthreads();
}

struct Params { const float* in[N_IN]; float* out; unsigned char* ws; };


DI void transpose_tile(const float* __restrict__ W, int K, int N, bf16_t* __restrict__ Wt, int tile, float* sm) {
    const int tid = get_tid();
    const int ntn = N / 256, tk = tile / ntn, tn = tile % ntn;
    __syncthreads();
#pragma unroll
    for (int i = 0; i < 4; ++i) {
        const int idx = tid + i * NT, kk = idx >> 6, n4 = (idx & 63) * 4;
        const f32x4 v = *(const f32x4*)(W + (size_t)(tk * 64 + kk) * N + tn * 256 + n4);
        float* d = sm + kk * 257 + n4;
        d[0] = v[0]; d[1] = v[1]; d[2] = v[2]; d[3] = v[3];
    }
    __syncthreads();
#pragma unroll
    for (int i = 0; i < 2; ++i) {
        const int idx = tid + i * NT, nn = idx & 255, kg = idx >> 8;
        const float* c = sm + kg * 8 * 257 + nn;
        *(u32x4*)(Wt + (size_t)(tn * 256 + nn) * K + tk * 64 + kg * 8) = u32x4{pk2(c[0], c[257]), pk2(c[2 * 257], c[3 * 257]), pk2(c[4 * 257], c[5 * 257]), pk2(c[6 * 257], c[7 * 257])};
    }
}

DI void mod_item(const Params& p, int item, float* sm) {
    const int tid = get_tid();
    float* sc = sm;
    float* red = sm + 9 * 1024;
    __syncthreads();
    for (int i = tid; i < 9 * 1024; i += NT) {
        const float v = (i < 8 * 1024) ? p.in[I_C][i] : p.in[I_CCTX][i - 8 * 1024];
        sc[i] = v / (1.f + __expf(-v));
    }
    __syncthreads();
    const int col = tid & 15, kg = tid >> 4, n0 = item * 16;
    float acc[9];
#pragma unroll
    for (int r = 0; r < 9; ++r) acc[r] = 0.f;
    const float* w = p.in[I_ADAW] + (size_t)kg * 16 * 6144 + n0 + col;
    float wv[16];
#pragma unroll
    for (int k = 0; k < 16; ++k) wv[k] = w[(size_t)k * 6144];
#pragma unroll
    for (int k = 0; k < 16; ++k)
#pragma unroll
        for (int r = 0; r < 9; ++r) acc[r] += sc[r * 1024 + kg * 16 + k] * wv[k];
#pragma unroll
    for (int r = 0; r < 9; ++r) red[(kg * 9 + r) * 16 + col] = acc[r];
    __syncthreads();
    if (tid < 9 * 16) {
        const int r = tid >> 4, c2 = tid & 15;
        float s = p.in[I_ADAB][n0 + c2];
        for (int g = 0; g < 64; ++g) s += red[(g * 9 + r) * 16 + c2];
        ((float*)(p.ws + WS_MOD))[r * 6144 + n0 + c2] = s;
    }
    __syncthreads();
}

DI void filter_item(const Params& p, int item, float* sm) {
    const int tid = get_tid();
    float* z  = sm;
    float* ha = sm + 16 * 36;
    float* hb = ha + 16 * 64;
    const int t0 = item * 16;
    float* w1s = hb + 16 * 64;
    float* w2s = w1s + 33 * 64;
    float* w3s = w2s + 64 * 64;
    __syncthreads();
    {
        const f32x4 a2 = *(const f32x4*)(p.in[I_HW2] + tid * 4), a3 = *(const f32x4*)(p.in[I_HW3] + tid * 4);
        f32x4 a1 = f32x4{0.f, 0.f, 0.f, 0.f};
        if (tid < 33 * 16) a1 = *(const f32x4*)(p.in[I_HW1] + tid * 4);
        *(f32x4*)(w2s + tid * 4) = a2; *(f32x4*)(w3s + tid * 4) = a3;
        if (tid < 33 * 16) *(f32x4*)(w1s + tid * 4) = a1;
    }
    if (tid < 16 * 33) {
        const int pp = tid / 33, i = tid % 33;
        const int t = t0 + pp;
        float v;
        if (i == 0) v = (float)t / (float)(SEQ - 1);
        else {
            const int fi = (i - 1) & 15;
            const float f = 1e-4f + (float)fi * ((15.f - 1e-4f) / 15.f);
            const float w = 6.283185307179586f * (float)t / (float)SEQ;
            const float a = f * w;
            v = (i <= 16) ? fcos(a) : -fsin(a);
        }
        z[pp * 36 + i] = v;
    }
    __syncthreads();
    const int pp = tid >> 6, j = tid & 63;
    const float fr = p.in[I_HFREQ][j];
    {
        float a = p.in[I_HB1][j];
#pragma unroll 11
        for (int i = 0; i < 33; ++i) a += z[pp * 36 + i] * w1s[i * 64 + j];
        ha[pp * 64 + j] = fsin(fr * a);
    }
    __syncthreads();
    {
        float a = p.in[I_HB2][j];
#pragma unroll 16
        for (int i = 0; i < 64; ++i) a += ha[pp * 64 + i] * w2s[i * 64 + j];
        hb[pp * 64 + j] = fsin(fr * a);
    }
    __syncthreads();
    {
        float a = p.in[I_HB3][j];
#pragma unroll 16
        for (int i = 0; i < 64; ++i) a += hb[pp * 64 + i] * w3s[i * 64 + j];
        __syncthreads();
        ha[pp * 64 + j] = fsin(fr * a);
    }
    __syncthreads();
    float* fraw = (float*)(p.ws + WS_FRAW);
    float* part = (float*)(p.ws + WS_PART);
    const float* w4 = p.in[I_HW4];
    {
        const int lane = tid & 63, wave = tid >> 6, l15 = lane & 15, lk = lane >> 4;
        float af[16];
#pragma unroll
        for (int ks = 0; ks < 16; ++ks) af[ks] = ha[l15 * 64 + ks * 4 + lk];
        const float mind = -3.0701134573253945f, maxd = -15.350567286626973f;
        const unsigned wvo = (unsigned)((lk * 2048 + wave * 128 + 4 * l15) * 4);
        f32x4 bw[16];
#pragma unroll
        for (int ks = 0; ks < 16; ++ks) { const char* bk = (const char*)w4 + (size_t)ks * 32768; asm volatile("" : "+s"(bk)); bw[ks] = *(const f32x4*)(bk + wvo); }
#pragma unroll 1
        for (int g = 0; g < 2; ++g) {
            f32x4 acc[4];
#pragma unroll
            for (int u = 0; u < 4; ++u) acc[u] = f32x4{0.f, 0.f, 0.f, 0.f};
#pragma unroll
            for (int ks = 0; ks < 16; ++ks) {
#pragma unroll
                for (int u = 0; u < 4; ++u) acc[u] = __builtin_amdgcn_mfma_f32_16x16x4f32(af[ks], bw[ks][u], acc[u], 0, 0, 0);
                if (g == 0) { const char* bk = (const char*)w4 + (size_t)ks * 32768 + 256; asm volatile("" : "+s"(bk)); bw[ks] = *(const f32x4*)(bk + wvo); }
            }
#pragma unroll
            for (int u = 0; u < 4; ++u) {
                const int col = wave * 128 + 64 * g + 4 * l15 + u;
                const int c = col & 511, dir = (col >> 9) & 1;
                const float delta = fabsf(mind + (float)c * ((maxd - mind) / 511.f));
                float sabs = 0.f, v[4];
#pragma unroll
                for (int r = 0; r < 4; ++r) {
                    const int t = t0 + 4 * lk + r;
                    const float t01 = (float)t / (float)(SEQ - 1);
                    v[r] = acc[u][r] * expf(-t01 * delta);
                    if (!(dir == 1 && t == 0)) sabs += fabsf(v[r]);
                }
                *(f32x4*)(fraw + (size_t)col * SEQ + t0 + 4 * lk) = f32x4{v[0], v[1], v[2], v[3]};
                sabs = sum_x32(sum_x16(sabs));
                if (lk == 0) part[item * 2048 + col] = sabs;
            }
        }
    }
    __syncthreads();
}

DI void phase_a(const Params& p, float* sm) {
    constexpr int T_WIN = 16 * 17, T_AO = 8 * 4, T_HO = 8 * 4, T_WO = 16 * 4, T_WQ = 16 * 8;
    constexpr int E0 = T_WIN, E1 = E0 + T_AO, E2 = E1 + T_HO, E3 = E2 + T_WO, E4 = E3 + T_WQ;
    constexpr int E5 = E4 + 64;
    constexpr int E6 = E5 + 384;
    constexpr int E7 = E6 + 1;
    constexpr int E8 = E7 + 256;
    for (int it = blockIdx.x; it < E8; it += gridDim.x) {
        int item = it;
        if (item < 256) { filter_item(p, item, sm); if (PROBE_PHASE == 30 && blockIdx.x == 0 && get_tid() == 0) ((volatile unsigned long long*)(g_lds + LDS_PROBE_OFF))[1] = __builtin_amdgcn_s_memrealtime(); continue; }
        item -= 256;
        if (item < 384) { mod_item(p, item, sm); if (PROBE_PHASE == 31 && blockIdx.x == 0 && get_tid() == 0) ((volatile unsigned long long*)(g_lds + LDS_PROBE_OFF))[1] = __builtin_amdgcn_s_memrealtime(); continue; }
        item -= 384;
        if (item < 1) {
            const int tid = get_tid();
            float* rope = (float*)(p.ws + WS_ROPE);
            const int pos = tid >> 4, f = tid & 15;
            const float inv = powf(10000.f, -(float)(2 * f) / 32.f);
            const float ang = (float)pos * inv;
            rope[tid] = fcos(ang); rope[1024 + tid] = fsin(ang);
            continue;
        }
        item -= 1;
        if (item < 64) {
            const int tid = get_tid();
            const float* src = (item < 32) ? p.in[I_PK1] : p.in[I_PK2];
            const f32x4 v = *(const f32x4*)(src + (size_t)(item & 31) * 4096 + tid * 4);
            const int e = tid * 4, kr = e >> 7, dim = e & 127;
            bf16_t* dst = (bf16_t*)(p.ws + WS_KEYS) + ((size_t)(item * 8 + (dim >> 4)) * 64 + ((dim >> 3) & 1) * 32 + kr) * 8 + (dim & 7);
            *(u32x2*)dst = u32x2{pk2(v[0], v[1]), pk2(v[2], v[3])};
            continue;
        }
        item -= 64;
        if (item < T_WIN) { transpose_tile(p.in[I_WIN], DM, INC, (bf16_t*)(p.ws + WS_WTIN), item, sm); continue; }
        item -= T_WIN;
        if (item < T_AO) { transpose_tile(p.in[I_WAO], QD, DM, (bf16_t*)(p.ws + WS_WTAO), item, sm); continue; }
        item -= T_AO;
        if (item < T_HO) { transpose_tile(p.in[I_WHO], HYD, DM, (bf16_t*)(p.ws + WS_WTHO), item, sm); continue; }
        item -= T_HO;
        if (item < T_WO) { transpose_tile(p.in[I_WO], DM, DM, (bf16_t*)(p.ws + WS_WTO), item, sm); continue; }
        item -= T_WO;
        transpose_tile(p.in[I_PWQ], DM, 2048, (bf16_t*)(p.ws + WS_WTQ), item, sm);
    }
    (void)E1; (void)E2; (void)E3; (void)E4; (void)E5; (void)E6; (void)E7;
}

typedef int i32x8 __attribute__((ext_vector_type(8)));
#define MFMA8(a, b, c) __builtin_amdgcn_mfma_scale_f32_32x32x64_f8f6f4((a), (b), (c), 0, 0, 0, 0x7F7F7F7F, 0, 0x7F7F7F7F)
DI unsigned pk_fp8x4(float a, float b, float c, float d) {
    int w = 0;
    w = __builtin_amdgcn_cvt_pk_fp8_f32(fminf(fmaxf(a, -440.f), 440.f), fminf(fmaxf(b, -440.f), 440.f), w, false);
    w = __builtin_amdgcn_cvt_pk_fp8_f32(fminf(fmaxf(c, -440.f), 440.f), fminf(fmaxf(d, -440.f), 440.f), w, true);
    return (unsigned)w;
}
DI void norm_mod_row(const float* __restrict__ src, const float* __restrict__ g, const float* __restrict__ shift, const float* __restrict__ scale, bf16_t* __restrict__ dst, unsigned char* __restrict__ dst8 = nullptr) {
    const int lane = get_tid() & 63;
    f32x4 v[4];
    float ss = 0.f;
#pragma unroll
    for (int j = 0; j < 4; ++j) { v[j] = *(const f32x4*)(src + j * 256 + lane * 4); ss += v[j][0] * v[j][0] + v[j][1] * v[j][1] + v[j][2] * v[j][2] + v[j][3] * v[j][3]; }
    ss = wave_sum(ss);
    const float rs = rsqrtf(ss * (1.f / DM) + EPS);
#pragma unroll
    for (int j = 0; j < 4; ++j) {
        const int c = j * 256 + lane * 4;
        const f32x4 gg = *(const f32x4*)(g + c), sh = *(const f32x4*)(shift + c), sc = *(const f32x4*)(scale + c);
        float o[4];
#pragma unroll
        for (int e = 0; e < 4; ++e) o[e] = v[j][e] * rs * gg[e] * (1.f + sc[e]) + sh[e];
        *(u32x2*)(dst + c) = u32x2{pk2(o[0], o[1]), pk2(o[2], o[3])};
        if (dst8) *(unsigned*)(dst8 + c) = pk_fp8x4(o[0], o[1], o[2], o[3]);
    }
}

DI void filter_norm_item(const Params& p, int item, float* sm) {
    const int tid = get_tid();
    const int o = item >> 9, c = item & 511;
    const int colf = o * 1024 + c, colb = colf + 512;
    const float* part = (const float*)(p.ws + WS_PART);
    const float* fraw = (const float*)(p.ws + WS_FRAW);
    float v[8], mx = 0.f;
#pragma unroll
    for (int i = 0; i < 8; ++i) {
        const int n = tid * 8 + i;
        v[i] = (n == 0) ? 0.f : (n <= 4096 ? fraw[(size_t)colf * SEQ + 4096 - n] : fraw[(size_t)colb * SEQ + n - 4096]);
        mx = fmaxf(mx, fabsf(v[i]));
    }
    float sacc = 0.f;
    if (tid < 512) sacc = part[(tid & 255) * 2048 + ((tid < 256) ? colf : colb)];
    sacc = wave_sum(sacc); mx = wave_max(mx);
    __syncthreads();
    if ((tid & 63) == 0) { sm[tid >> 6] = sacc; sm[16 + (tid >> 6)] = mx; }
    __syncthreads();
    float tot = EPS, gmx = 0.f;
#pragma unroll
    for (int i = 0; i < 8; ++i) tot += sm[i];
#pragma unroll
    for (int i = 0; i < 16; ++i) gmx = fmaxf(gmx, sm[16 + i]);
    const float inv = 1.f / tot;
    int ex; (void)frexpf(fmaxf(gmx * inv, 1e-30f), &ex);
    const float sc = ldexpf(1.f, 8 - ex), isc = ldexpf(1.f, ex - 8);
    if (tid == 0) ((float*)(p.ws + WS_FSC))[item] = isc;
    const float k = inv * sc;
    int w0 = 0, w1 = 0;
    w0 = __builtin_amdgcn_cvt_pk_fp8_f32(v[0] * k, v[1] * k, w0, false); w0 = __builtin_amdgcn_cvt_pk_fp8_f32(v[2] * k, v[3] * k, w0, true);
    w1 = __builtin_amdgcn_cvt_pk_fp8_f32(v[4] * k, v[5] * k, w1, false); w1 = __builtin_amdgcn_cvt_pk_fp8_f32(v[6] * k, v[7] * k, w1, true);
    *(u32x2*)(p.ws + WS_R + (size_t)item * 8192 + tid * 8) = u32x2{(unsigned)w0, (unsigned)w1};
    __syncthreads();
}

DI void table_conv_item(const Params& p, int ci, unsigned char* lds) {
    const int tid = get_tid();
    const size_t el = (size_t)(ci & 2047) * 8192 + tid * 8;
    const float* src = (ci < 2048 ? p.in[I_PU] : p.in[I_PV]) + el;
    const f32x4 a = *(const f32x4*)src, b = *(const f32x4*)(src + 4);
    const size_t e = el >> 10, col = el & 1023;
    if (ci < 2048) {
        float sq = a[0] * a[0] + a[1] * a[1] + a[2] * a[2] + a[3] * a[3] + b[0] * b[0] + b[1] * b[1] + b[2] * b[2] + b[3] * b[3];
        sq = wave_sum(sq);
        float* wm = (float*)lds;
        __syncthreads();
        if ((tid & 63) == 0) wm[tid >> 6] = sq;
        __syncthreads();
        const int w2 = (tid >> 7) * 2;
        const float rsig = fmaxf(sqrtf((wm[w2] + wm[w2 + 1]) * (1.f / 1024.f)), 1e-30f);
        const float sc = 2.f / rsig;
        if ((tid & 127) == 0) ((float*)(p.ws + WS_USC))[2 * e] = rsig * 0.5f;
        const float xs[8] = {a[0], a[1], a[2], a[3], b[0], b[1], b[2], b[3]};
        unsigned w = 0;
#pragma unroll
        for (int j = 0; j < 8; ++j) {
            const float m = fabsf(xs[j] * sc);
            const unsigned code = (m < 0.25f ? 0u : m < 0.75f ? 1u : m < 1.25f ? 2u : m < 1.75f ? 3u : m < 2.5f ? 4u : m < 3.5f ? 5u : m < 5.f ? 6u : 7u) | (xs[j] < 0.f ? 8u : 0u);
            w |= code << (4 * j);
        }
        *(unsigned*)(p.ws + WS_UT + (el >> 1)) = w;
    } else {
        float sq = a[0] * a[0] + a[1] * a[1] + a[2] * a[2] + a[3] * a[3] + b[0] * b[0] + b[1] * b[1] + b[2] * b[2] + b[3] * b[3];
        sq = wave_sum(sq);
        float* wm = (float*)lds;
        __syncthreads();
        if ((tid & 63) == 0) wm[tid >> 6] = sq;
        __syncthreads();
        const int w2 = (tid >> 7) * 2;
        const float rsig = fmaxf(sqrtf((wm[w2] + wm[w2 + 1]) * (1.f / 1024.f)), 1e-30f);
        const float sc = 2.f / rsig;
        if ((tid & 127) == 0) ((float*)(p.ws + WS_USC))[2 * e + 1] = rsig * 0.5f;
        const float xs[8] = {a[0], a[1], a[2], a[3], b[0], b[1], b[2], b[3]};
        unsigned wc = 0;
#pragma unroll
        for (int j = 0; j < 8; ++j) {
            const float m = fabsf(xs[j] * sc);
            const unsigned code = (m < 0.25f ? 0u : m < 0.75f ? 1u : m < 1.25f ? 2u : m < 1.75f ? 3u : m < 2.5f ? 4u : m < 3.5f ? 5u : m < 5.f ? 6u : 7u) | (xs[j] < 0.f ? 8u : 0u);
            wc |= code << (4 * j);
        }
        const unsigned wo = (unsigned)dppi<0xB1>((int)wc);
        const int cs = (int)(col & 255), ah = cs >> 7, jp = (cs & 127) >> 3;
        const unsigned wev = (jp & 1) ? wo : wc, wod = (jp & 1) ? wc : wo;
        unsigned char* dst = p.ws + WS_VTAB + ((col >> 8) * 16384 + e) * 128 + 8 * ah + (jp >> 1);
#pragma unroll
        for (int q = 0; q < 4; ++q) {
            const int nt = q + 4 * (jp & 1);
            dst[16 * nt] = (unsigned char)(((wev >> (4 * nt)) & 15u) | (((wod >> (4 * nt)) & 15u) << 4));
        }
    }
}

DI void phase_b(const Params& p, float* sm) {
    const int wave = get_tid() >> 6;
    const float* mod = (const float*)(p.ws + WS_MOD);
    constexpr int ROW_ITEMS = (BT + BATCH * CTX) / 16;
    constexpr int CONV = 2 * 16384 * 1024 / 8192;
    constexpr int SHQ = 8 * 2048 / 16;
    constexpr int W8I = 2048 / 16;
    for (int it = blockIdx.x; it < ROW_ITEMS + 1024 + CONV + SHQ + W8I; it += gridDim.x) {
        if (it < 1024) { filter_norm_item(p, it, sm); continue; }
        if (it >= ROW_ITEMS + 1024 + CONV + SHQ) {
            const int tid = get_tid(), lane = tid & 63, n = (it - ROW_ITEMS - 1024 - CONV - SHQ) * 16 + (tid >> 6);
            const bf16_t* wr = (const bf16_t*)(p.ws + WS_WTIN) + (size_t)(2304 + n) * DM + lane * 16;
            const u32x4 w0 = *(const u32x4*)wr, w1 = *(const u32x4*)(wr + 8);
            const float k = W8_SCALE;
            *(u32x4*)(p.ws + WS_W8G + (size_t)n * DM + lane * 16) = u32x4{pk_fp8x4(bflo(w0[0]) * k, bfhi(w0[0]) * k, bflo(w0[1]) * k, bfhi(w0[1]) * k), pk_fp8x4(bflo(w0[2]) * k, bfhi(w0[2]) * k, bflo(w0[3]) * k, bfhi(w0[3]) * k),
                                                                                pk_fp8x4(bflo(w1[0]) * k, bfhi(w1[0]) * k, bflo(w1[1]) * k, bfhi(w1[1]) * k), pk_fp8x4(bflo(w1[2]) * k, bfhi(w1[2]) * k, bflo(w1[3]) * k, bfhi(w1[3]) * k)};
            continue;
        }
        if (it >= ROW_ITEMS + 1024 + CONV) {
            const int tid = get_tid(), lane = tid & 63, o = (it - ROW_ITEMS - 1024 - CONV) * 16 + (tid >> 6), b = o >> 11, n = o & 2047;
            const bf16_t* wr = (const bf16_t*)(p.ws + WS_WTQ) + (size_t)n * DM + lane * 16;
            const float* sh = mod + b * 6144 + 3072 + lane * 16;
            const u32x4 w0 = *(const u32x4*)wr, w1 = *(const u32x4*)(wr + 8);
            float d = 0.f;
#pragma unroll
            for (int i = 0; i < 4; ++i) { d += bflo(w0[i]) * sh[2 * i] + bfhi(w0[i]) * sh[2 * i + 1] + bflo(w1[i]) * sh[8 + 2 * i] + bfhi(w1[i]) * sh[9 + 2 * i]; }
            d = wave_sum(d);
            if (lane == 0) ((float*)(p.ws + WS_SHQ))[o] = d;
            continue;
        }
        if (it >= ROW_ITEMS + 1024) { table_conv_item(p, it - ROW_ITEMS - 1024, (unsigned char*)sm); continue; }
        const int row = (it - 1024) * 16 + wave;
        if (row < BT) {
            const int b = row >> 12;
            norm_mod_row(p.in[I_X] + (size_t)row * DM, p.in[I_NMIX], mod + b * 6144, mod + b * 6144 + 1024, (bf16_t*)(p.ws + WS_H) + (size_t)row * DM, p.ws + WS_H8 + (size_t)row * DM);
        } else {
            const int r = row - BT;
            norm_mod_row(p.in[I_CTX] + (size_t)r * DM, p.in[I_NMIX], mod + 8 * 6144, mod + 8 * 6144 + 1024, (bf16_t*)(p.ws + WS_HC) + (size_t)r * DM);
        }
    }
}

#define MFMA16(a, b, c) __builtin_amdgcn_mfma_f32_16x16x32_bf16((a), (b), (c), 0, 0, 0)
constexpr int GT_P = 256 * 128;
struct RowLoader {
    const bf16_t* base; int ld;
    static constexpr bool kmajor = false;
    template<int ROWS> DI void issue(unsigned char* tile, int kt, int lane, int wave) const {
#pragma unroll
        for (int i = 0; i < ROWS / 128; ++i) {
            const int grp = i * 16 + wave, row = grp * 8 + (lane >> 3), c = (lane & 7) ^ (lane >> 3);
            __builtin_amdgcn_global_load_lds((const unsigned*)((const char*)base + (unsigned)((row * ld + kt * 64 + c * 8) * 2)), (unsigned*)(tile + grp * 1024), 16, 0, 0);
        }
    }
};

struct ColLoader {
    const bf16_t* base; size_t ld;
    static constexpr bool kmajor = true;
    template<int ROWS> DI void issue(unsigned char* tile, int kt, int lane, int wave) const {
        static_assert(ROWS == 128, "k-major loader: 128-row Q tiles only");
        const int row = wave * 4 + (lane >> 4), c = (lane & 15) ^ (2 * (row & 3));
        __builtin_amdgcn_global_load_lds((const unsigned*)(base + (size_t)(kt * 64 + row) * ld + c * 8), (unsigned*)(tile + wave * 1024), 16, 0, 0);
    }
};
template<int NQ>
DI void gemm_prefetch(const RowLoader& lp, const RowLoader& lq, unsigned char* lds) {
    const int tid = get_tid(), lane = tid & 63, wave = __builtin_amdgcn_readfirstlane(tid >> 6);
    lp.template issue<256>(lds, 0, lane, wave); lq.template issue<NQ * 64>(lds + GT_P, 0, lane, wave);
}
template<int NQ, bool KMAJOR>
DI void gemm_kstep(f32x4 (&acc)[4][NQ], const unsigned char* cur, int wp, int wq, int l15, int lk) {
#pragma unroll
    for (int ks = 0; ks < 2; ++ks) {
        bf16x8 fp[4], fq[NQ];
#pragma unroll
        for (int i = 0; i < 4; ++i) { const int row = wp * 64 + i * 16 + l15; fp[i] = *(const bf16x8*)(cur + row * 128 + (((ks * 4 + lk) ^ (row & 7)) << 4)); }
#pragma unroll
        for (int j = 0; j < NQ; ++j) {
            if constexpr (KMAJOR) {
                const int q4 = l15 >> 2, tokq = wq * (16 * NQ) + j * 16 + 4 * (l15 & 3);
                const unsigned char* ap = cur + GT_P + ((ks * 4 + lk) * 8 + q4) * 256 + (((tokq >> 3) ^ (2 * q4)) << 4) + ((tokq >> 2) & 1) * 8;
                const s16x4 lo = __builtin_amdgcn_ds_read_tr16_b64_v4i16((LAS s16x4*)(LAS unsigned char*)ap);
                const s16x4 hi = __builtin_amdgcn_ds_read_tr16_b64_v4i16((LAS s16x4*)(LAS unsigned char*)(ap + 4 * 256));
                fq[j] = __builtin_shufflevector(lo, hi, 0, 1, 2, 3, 4, 5, 6, 7);
            } else { const int row = wq * (16 * NQ) + j * 16 + l15; fq[j] = *(const bf16x8*)(cur + GT_P + row * 128 + (((ks * 4 + lk) ^ (row & 7)) << 4)); }
        }
#pragma unroll
        for (int i = 0; i < 4; ++i)
#pragma unroll
            for (int j = 0; j < NQ; ++j) acc[i][j] = MFMA16(fp[i], fq[j], acc[i][j]);
    }
}
template<int NQ>
DI void gemm_kstep8(f32x4 (&acc)[4][NQ], const unsigned char* cur, int wp, int wq, int l15, int lk) {
    __builtin_amdgcn_sched_barrier(0);
    i32x8 fp[4];
#pragma unroll
    for (int i = 0; i < 4; ++i) {
        const int row = wp * 64 + i * 16 + l15;
        const u32x4 a = *(const u32x4*)(cur + row * 128 + ((lk ^ (row & 7)) << 4)), b = *(const u32x4*)(cur + row * 128 + (((4 + lk) ^ (row & 7)) << 4));
        fp[i] = i32x8{(int)a[0], (int)a[1], (int)a[2], (int)a[3], (int)b[0], (int)b[1], (int)b[2], (int)b[3]};
    }
    u32x4 qa, qb;
    { const int row = wq * (16 * NQ) + l15; qa = *(const u32x4*)(cur + GT_P + row * 128 + ((lk ^ (row & 7)) << 4)); qb = *(const u32x4*)(cur + GT_P + row * 128 + (((4 + lk) ^ (row & 7)) << 4)); }
#pragma unroll
    for (int j = 0; j < NQ; ++j) {
        const i32x8 fq = i32x8{(int)qa[0], (int)qa[1], (int)qa[2], (int)qa[3], (int)qb[0], (int)qb[1], (int)qb[2], (int)qb[3]};
        if (j + 1 < NQ) { const int row = wq * (16 * NQ) + (j + 1) * 16 + l15; qa = *(const u32x4*)(cur + GT_P + row * 128 + ((lk ^ (row & 7)) << 4)); qb = *(const u32x4*)(cur + GT_P + row * 128 + (((4 + lk) ^ (row & 7)) << 4)); }
#pragma unroll
        for (int i = 0; i < 4; ++i) acc[i][j] = __builtin_amdgcn_mfma_scale_f32_16x16x128_f8f6f4(fp[i], fq, acc[i][j], 0, 0, 0, 0x7F7F7F7F, 0, 0x7F7F7F7F);
        __builtin_amdgcn_sched_barrier(0);
    }
}
template<int NQ, class LQ = RowLoader, class NLQ = RowLoader, bool F8 = false>
DI void gemm_mainloop(f32x4 (&acc)[4][NQ], const RowLoader& lp, const LQ& lq, int nk, unsigned char* lds, bool preissued = false, bool pfnext = false,
                      const RowLoader& nlp = RowLoader{nullptr, 0}, const NLQ& nlq = NLQ{nullptr, 0}) {
    const int tid = get_tid(), lane = tid & 63, wave = __builtin_amdgcn_readfirstlane(tid >> 6), wp = wave >> 2, wq = wave & 3;
    constexpr int QROWS = NQ * 64;
    constexpr int STAGE = GT_P + QROWS * 128;
    if (!preissued) {
        __syncthreads();
        lp.template issue<256>(lds, 0, lane, wave); lq.template issue<QROWS>(lds + GT_P, 0, lane, wave);
    }
    asm volatile("s_waitcnt vmcnt(0)" ::: "memory");
    __syncthreads();
    const int l15 = lane & 15, lk = lane >> 4;
    for (int kt = 0; kt < nk; ++kt) {
        unsigned char* cur = lds + (kt & 1) * STAGE;
        unsigned char* nxt = lds + ((kt + 1) & 1) * STAGE;
        const bool last = kt + 1 == nk;
        if (!last) { lp.template issue<256>(nxt, kt + 1, lane, wave); lq.template issue<QROWS>(nxt + GT_P, kt + 1, lane, wave); }
        else if (pfnext) { nlp.template issue<256>(nxt, 0, lane, wave); nlq.template issue<QROWS>(nxt + GT_P, 0, lane, wave); }
        if constexpr (F8) gemm_kstep8<NQ>(acc, cur, wp, wq, l15, lk); else gemm_kstep<NQ, LQ::kmajor>(acc, cur, wp, wq, l15, lk);
        if (last && pfnext) { asm volatile("s_waitcnt lgkmcnt(0)" ::: "memory"); __builtin_amdgcn_s_barrier(); }
        else { asm volatile("s_waitcnt vmcnt(0)" ::: "memory"); __syncthreads(); }
    }
}
template<int NQ>
DI void gemm_shadow(const RowLoader& lp, const RowLoader& lq, int nk, unsigned char* lds) {
    f32x4 acc[4][NQ];
#pragma unroll
    for (int i = 0; i < 4; ++i)
#pragma unroll
        for (int j = 0; j < NQ; ++j) acc[i][j] = f32x4{0.f, 0.f, 0.f, 0.f};
    if (SHADOW == 1) gemm_mainloop<NQ>(acc, lp, lq, nk, lds);
    else {
        const int tid = get_tid(), lane = tid & 63, wave = __builtin_amdgcn_readfirstlane(tid >> 6), wp = wave >> 2, wq = wave & 3;
        constexpr int QROWS = NQ * 64;
        constexpr int STAGE = GT_P + QROWS * 128;
        const int l15 = lane & 15, lk = lane >> 4;
        bf16x8 fp[4], fq[NQ];
        if (SHADOW == 3) {
#pragma unroll
            for (int i = 0; i < 4; ++i) fp[i] = *(const bf16x8*)(lds + (wp * 64 + i * 16 + l15) * 128 + lk * 16);
#pragma unroll
            for (int j = 0; j < NQ; ++j) fq[j] = *(const bf16x8*)(lds + GT_P + (wq * 16 * NQ + j * 16 + l15) * 128 + lk * 16);
        }
        for (int kt = 0; kt < nk; ++kt) {
            unsigned char* cur = lds + (kt & 1) * STAGE;
#pragma unroll
            for (int ks = 0; ks < 2; ++ks) {
                if (SHADOW == 2 || SHADOW == 4) {
#pragma unroll
                    for (int i = 0; i < 4; ++i) { const int row = wp * 64 + i * 16 + l15; fp[i] = *(const bf16x8*)(cur + row * 128 + (((ks * 4 + lk) ^ (row & 7)) << 4)); }
#pragma unroll
                    for (int j = 0; j < NQ; ++j) { const int row = wq * (16 * NQ) + j * 16 + l15; fq[j] = *(const bf16x8*)(cur + GT_P + row * 128 + (((ks * 4 + lk) ^ (row & 7)) << 4)); }
                }
#pragma unroll
                for (int i = 0; i < 4; ++i)
#pragma unroll
                    for (int j = 0; j < NQ; ++j) acc[i][j] = MFMA16(fp[i], fq[j], acc[i][j]);
            }
            if (SHADOW == 2) asm volatile("" ::: "memory");
            if (SHADOW == 4) __syncthreads();
        }
    }
#pragma unroll
    for (int i = 0; i < 4; ++i)
#pragma unroll
        for (int j = 0; j < NQ; ++j) asm volatile("" :: "v"(acc[i][j]));
}

template<int NQ> DI void gemm_shadow1(const RowLoader& lp, const RowLoader& lq, int nk, unsigned char* lds) {
    f32x4 acc[4][NQ];
#pragma unroll
    for (int i = 0; i < 4; ++i)
#pragma unroll
        for (int j = 0; j < NQ; ++j) acc[i][j] = f32x4{0.f, 0.f, 0.f, 0.f};
    gemm_mainloop<NQ>(acc, lp, lq, nk, lds);
#pragma unroll
    for (int i = 0; i < 4; ++i)
#pragma unroll
        for (int j = 0; j < NQ; ++j) asm volatile("" :: "v"(acc[i][j]));
}
DI void head_epilogue(f32x4 (&acc)[4][4], const float* __restrict__ g, float gscale, const float* __restrict__ rope, bool do_rope, int t_base  , unsigned char* __restrict__ dst  , int lane) {
    const int l15 = lane & 15, lk = lane >> 4;
    float gg[4];
#pragma unroll
    for (int j = 0; j < 4; ++j) gg[j] = g[j * 16 + l15] * gscale;
#pragma unroll
    for (int i = 0; i < 4; ++i) {
#pragma unroll
        for (int r = 0; r < 4; ++r) {
            float ss = 0.f;
#pragma unroll
            for (int j = 0; j < 4; ++j) ss += acc[i][j][r] * acc[i][j][r];
            ss = sum16(ss);
            const float rs = rsqrtf(ss * (1.f / 64.f) + EPS);
            float v[4];
#pragma unroll
            for (int j = 0; j < 4; ++j) v[j] = acc[i][j][r] * rs * gg[j];
            const int t = t_base + i * 16 + lk * 4 + r;
            if (do_rope) {
                const int prow = (t >> 6) & 63, pcol = t & 63;
                const float c0 = rope[prow * 16 + l15], s0 = rope[1024 + prow * 16 + l15];
                const float c1 = rope[pcol * 16 + l15], s1 = rope[1024 + pcol * 16 + l15];
                const float a0 = v[0] * c0 - v[1] * s0, a1 = v[1] * c0 + v[0] * s0;
                const float a2 = v[2] * c1 - v[3] * s1, a3 = v[3] * c1 + v[2] * s1;
                v[0] = a0; v[1] = a1; v[2] = a2; v[3] = a3;
            }
            unsigned char* d = dst + (size_t)(i * 16 + lk * 4 + r) * 64 + l15;
            const int w01 = __builtin_amdgcn_cvt_pk_fp8_f32(v[0], v[1], 0, false), w23 = __builtin_amdgcn_cvt_pk_fp8_f32(v[2], v[3], 0, false);
            d[0] = (unsigned char)w01; d[16] = (unsigned char)(w01 >> 8); d[32] = (unsigned char)w23; d[48] = (unsigned char)(w23 >> 8);
        }
    }
}
DI void tstore_epilogue(f32x4 (&acc)[4][4], bf16_t* __restrict__ dst  , size_t ld, int lane) {
    const int l15 = lane & 15, lk = lane >> 4;
#pragma unroll
    for (int i = 0; i < 4; ++i)
#pragma unroll
        for (int j = 0; j < 4; ++j)
            *(u32x2*)(dst + (size_t)(j * 16 + l15) * ld + i * 16 + lk * 4) = u32x2{pk2(acc[i][j][0], acc[i][j][1]), pk2(acc[i][j][2], acc[i][j][3])};
}

DI void phase_c(const Params& p, unsigned char* lds) {
    constexpr int NTM = BT / 256, NTN = INC / 256;
    constexpr int MAIN = NTM * NTN, TOTAL = MAIN + 8;
    const bf16_t* H = (const bf16_t*)(p.ws + WS_H);
    const bf16_t* HCp = (const bf16_t*)(p.ws + WS_HC);
    const bf16_t* WT = (const bf16_t*)(p.ws + WS_WTIN);
    const float* rope = (const float*)(p.ws + WS_ROPE);
    struct CTile { int tm, tn; bool ctx; RowLoader P, Q; };
    auto c_tile = [&](int it) {
        CTile t; t.ctx = false;
        if (it < MAIN) { const int g = it / (16 * NTN), rem = it % (16 * NTN); t.tn = rem >> 4; t.tm = g * 16 + (rem & 15); }
        else { t.ctx = true; t.tm = it - MAIN; t.tn = 2; }
        const bf16_t* A = t.ctx ? HCp + (size_t)t.tm * 256 * DM : H + (size_t)t.tm * 256 * DM;
        const bf16_t* W = WT + (size_t)t.tn * 256 * DM;
        if (t.tn >= 9) {
            t.P = RowLoader{(const bf16_t*)(p.ws + WS_W8G + (size_t)(t.tn * 256 - 2304) * DM), DM / 2}; t.Q = RowLoader{(const bf16_t*)(p.ws + WS_H8 + (size_t)t.tm * 256 * DM), DM / 2}; }
        else { t.P = RowLoader{A, DM}; t.Q = RowLoader{W, DM}; }
        return t;
    };
    bool pre = false;
    CTile cur = c_tile(blockIdx.x);
    for (int it = blockIdx.x; it < TOTAL; it += gridDim.x) {
        const int tid = get_tid(), lane = tid & 63, wave = tid >> 6, wa = wave >> 2, wb = wave & 3;
        const bool has2 = it + (int)gridDim.x < TOTAL;
        const CTile nx = c_tile(has2 ? it + (int)gridDim.x : it);
        const int tm = cur.tm, tn = cur.tn; const bool ctx = cur.ctx;
        f32x4 acc[4][4];
#pragma unroll
        for (int i = 0; i < 4; ++i)
#pragma unroll
            for (int j = 0; j < 4; ++j) acc[i][j] = f32x4{0.f, 0.f, 0.f, 0.f};
        int nk8 = DM / 128; asm volatile("" : "+s"(nk8));
        if (cur.tn >= 9) gemm_mainloop<4, RowLoader, RowLoader, true>(acc, cur.P, cur.Q, nk8, lds, pre, has2, nx.P, nx.Q);
        else gemm_mainloop<4>(acc, cur.P, cur.Q, DM / 64, lds, pre, has2, nx.P, nx.Q);
        pre = has2; cur = nx;
        if (tn >= 9) {
            unsigned char* st = lds + 64 * 1024;
            constexpr int GS = 272;
            const int l15 = lane & 15, lk = lane >> 4;
#pragma unroll
            for (int i = 0; i < 4; ++i)
#pragma unroll
                for (int j = 0; j < 4; ++j) {
                    unsigned q[4];
#pragma unroll
                    for (int r = 0; r < 4; ++r) q[r] = (unsigned)(255.f * __builtin_amdgcn_rcpf(1.f + __expf(acc[i][j][r] * (-1.f / W8_SCALE))) + 0.5f);
                    *(unsigned*)(st + (wb * 64 + j * 16 + l15) * GS + wa * 64 + i * 16 + lk * 4) = q[0] | (q[1] << 8) | (q[2] << 16) | (q[3] << 24);
                }
            __syncthreads();
            unsigned char* G8 = p.ws + WS_G + (size_t)tm * 256 * GC + (tn * 256 - 2304);
            const int t2 = get_tid();
#pragma unroll
            for (int q = 0; q < 4; ++q) {
                const int idx = t2 + q * NT, row = idx >> 4, ch = idx & 15;
                *(u32x4*)(G8 + (size_t)row * GC + ch * 16) = *(const u32x4*)(st + row * GS + ch * 16);
            }
            continue;
        }
        const int b = ctx ? tm : (tm >> 4);
        const int tpos = ctx ? SEQ + wa * 64 : ((tm & 15) * 256 + wa * 64);
        if (tn < 2) {
            const int h = tn * 4 + wb;
            unsigned char* Q = p.ws + WS_Q + ((size_t)(b * NH + h) * SEQ + tpos) * HD;
            head_epilogue(acc, p.in[I_QNG], 1.4426950408889634f, rope, true, tpos, Q, lane);
        } else if (tn == 2) {
            if (wb < 2) {
                unsigned char* K = p.ws + WS_KB + ((size_t)(b * NKV + wb) * TK + tpos) * HD;
                head_epilogue(acc, p.in[I_KNG], 1.f, rope, !ctx, tpos, K, lane);
            } else {
                unsigned char* V8 = p.ws + WS_VT + (size_t)(b * NKV + (wb - 2)) * HD * TK;
                const int l15 = lane & 15, lk = lane >> 4;
#pragma unroll
                for (int i = 0; i < 4; ++i) {
                    const int k = tpos + i * 16 + lk * 4, kin = k & 63, within = kin & 31;
                    const int pos = (k & ~63) + 32 * ((within >> 2) & 1) + 16 * (kin >> 5) + 4 * (within >> 3);
#pragma unroll
                    for (int j = 0; j < 4; ++j)
                        *(unsigned*)(V8 + (size_t)(j * 16 + l15) * TK + pos) = pk_fp8x4(acc[i][j][0] * VT_SCALE, acc[i][j][1] * VT_SCALE, acc[i][j][2] * VT_SCALE, acc[i][j][3] * VT_SCALE);
                }
            }
        } else {
            const int col = tn * 256 - 768 + wb * 64;
            bf16_t* Z = (bf16_t*)(p.ws + WS_ZT) + (size_t)col * BT + (size_t)b * SEQ + tpos;
            tstore_epilogue(acc, Z, BT, lane);
        }
    }
}

#define MFMA32(a, b, c) __builtin_amdgcn_mfma_f32_32x32x16_bf16((a), (b), (c), 0, 0, 0)
DI bf16x8 pack_step(const f32x16& x, int s) {
    u32x4 pk;
    asm volatile("v_cvt_pk_bf16_f32 %0, %4, %5\n\tv_cvt_pk_bf16_f32 %1, %6, %7\n\tv_cvt_pk_bf16_f32 %2, %8, %9\n\tv_cvt_pk_bf16_f32 %3, %10, %11\n\ts_nop 1"
                 : "=&v"(pk[0]), "=&v"(pk[1]), "=&v"(pk[2]), "=&v"(pk[3])
                 : "v"(x[8 * s]), "v"(x[8 * s + 1]), "v"(x[8 * s + 2]), "v"(x[8 * s + 3]), "v"(x[8 * s + 4]), "v"(x[8 * s + 5]), "v"(x[8 * s + 6]), "v"(x[8 * s + 7]));
    return __builtin_bit_cast(bf16x8, pk);
}

constexpr int AT_KSTR = 64, AT_VSTR = 64, AT_VOFF = 64 * AT_KSTR, AT_STAGE = AT_VOFF + 64 * AT_VSTR;
DI void attn_item(const Params& p, int item, unsigned char* lds) {
    const int tid = get_tid(), lane = tid & 63, wave = tid >> 6;
    const int b = item >> 6, kvh = (item >> 5) & 1, qb = item & 31;
    const int h = kvh * 4 + (wave >> 2), q0 = qb * 128 + (wave & 3) * 32;
    const int qi = lane & 31, hf = lane >> 5;
    const unsigned char* Qp = p.ws + WS_Q + ((size_t)(b * NH + h) * SEQ + q0 + qi) * HD + 32 * hf;
    const u32x4 q0v = *(const u32x4*)Qp, q1v = *(const u32x4*)(Qp + 16);
    const i32x8 qf = i32x8{(int)q0v[0], (int)q0v[1], (int)q0v[2], (int)q0v[3], (int)q1v[0], (int)q1v[1], (int)q1v[2], (int)q1v[3]};
    const unsigned char* Kg = p.ws + WS_KB + (size_t)(b * NKV + kvh) * TK * HD;
    const unsigned char* Vg = p.ws + WS_VT + (size_t)(b * NKV + kvh) * HD * TK;
    constexpr int NTILE = TK / 64;
    f32x16 o0, o1, o2;
#pragma unroll
    for (int i = 0; i < 16; ++i) { o0[i] = 0.f; o1[i] = 0.f; o2[i] = 0.f; }
    __syncthreads();
    constexpr int NSUB = 4, NSTG = NTILE / NSUB;
    static_assert(NTILE % NSUB == 0 && 2 * NSUB * AT_STAGE <= LDS_USER, "attention LDS stages");
    const int wv = __builtin_amdgcn_readfirstlane(tid >> 6);
    auto stage_issue = [&](int stg_idx, int buf) {
#pragma unroll
        for (int e = 0; e < 2; ++e) {
            const int q = 2 * wv + e, j = q >> 3, isV = (q >> 2) & 1, part = q & 3;
            const int row = 16 * part + (lane >> 2), c = (lane & 3) ^ ((row >> 2) & 3), tile = stg_idx * NSUB + j;
            const unsigned char* sp = isV ? Vg + (size_t)row * TK + (size_t)tile * 64 + c * 16 : Kg + ((size_t)tile * 64 + row) * HD + c * 16;
            __builtin_amdgcn_global_load_lds((const unsigned*)sp, (unsigned*)(lds + (buf * NSUB + j) * AT_STAGE + isV * AT_VOFF + part * 1024), 16, 0, 0);
        }
    };
    stage_issue(0, 0);
    asm volatile("s_waitcnt vmcnt(0)" ::: "memory");
    __syncthreads();
    const int sw = (qi >> 2) & 3;
    const int kc0 = qi * AT_KSTR + (((2 * hf) ^ sw) << 4), kc1 = qi * AT_KSTR + (((2 * hf + 1) ^ sw) << 4);
    for (int st = 0; st < NSTG; ++st) {
      const bool more = st + 1 < NSTG;
      if (more) stage_issue(st + 1, (st + 1) & 1);
#pragma unroll 1
      for (int j = 0; j < NSUB; ++j) {
        const unsigned char* cur = lds + ((st & 1) * NSUB + j) * AT_STAGE;
        f32x16 sA, sB;
        {
            f32x16 z;
#pragma unroll
            for (int i = 0; i < 16; ++i) z[i] = 0.f;
            const u32x4 ka0 = *(const u32x4*)(cur + kc0), ka1 = *(const u32x4*)(cur + kc1);
            const u32x4 kb0 = *(const u32x4*)(cur + kc0 + 32 * AT_KSTR), kb1 = *(const u32x4*)(cur + kc1 + 32 * AT_KSTR);
            const i32x8 kfa = i32x8{(int)ka0[0], (int)ka0[1], (int)ka0[2], (int)ka0[3], (int)ka1[0], (int)ka1[1], (int)ka1[2], (int)ka1[3]};
            const i32x8 kfb = i32x8{(int)kb0[0], (int)kb0[1], (int)kb0[2], (int)kb0[3], (int)kb1[0], (int)kb1[1], (int)kb1[2], (int)kb1[3]};
            __builtin_amdgcn_s_setprio(1);
            sA = __builtin_amdgcn_mfma_scale_f32_32x32x64_f8f6f4(kfa, qf, z, 0, 0, 0, 0x7F7F7F7F, 0, 0x7C7C7C7C);
            sB = __builtin_amdgcn_mfma_scale_f32_32x32x64_f8f6f4(kfb, qf, z, 0, 0, 0, 0x7F7F7F7F, 0, 0x7C7C7C7C);
            __builtin_amdgcn_s_setprio(0);
        }
#pragma unroll
        for (int i = 0; i < 16; ++i) sA[i] = __builtin_amdgcn_exp2f(sA[i]);
#pragma unroll
        for (int i = 0; i < 16; ++i) sB[i] = __builtin_amdgcn_exp2f(sB[i]);
        int pb[8];
#pragma unroll
        for (int v = 0; v < 8; ++v) {
            const f32x16& sx = (v >> 2) ? sB : sA;
            const int r0 = 4 * (v & 3);
            int w = __builtin_amdgcn_cvt_pk_bf8_f32(sx[r0], sx[r0 + 1], 0, false);
            w = __builtin_amdgcn_cvt_pk_bf8_f32(sx[r0 + 2], sx[r0 + 3], w, true);
            pb[v] = w;
        }
        const i32x8 pf = i32x8{pb[0], pb[1], pb[2], pb[3], pb[4], pb[5], pb[6], pb[7]};
#pragma unroll
        for (int db = 0; db < 2; ++db) {
            const unsigned char* vb = cur + AT_VOFF + db * 32 * AT_VSTR;
            const u32x4 a0 = *(const u32x4*)(vb + kc0), a1 = *(const u32x4*)(vb + kc1);
            const i32x8 vf = i32x8{(int)a0[0], (int)a0[1], (int)a0[2], (int)a0[3], (int)a1[0], (int)a1[1], (int)a1[2], (int)a1[3]};
            if (db == 0) o0 = __builtin_amdgcn_mfma_scale_f32_32x32x64_f8f6f4(vf, pf, o0, 0, 1, 0, 0x7F7F7F7F, 0, 0x7F7F7F7F);
            else         o1 = __builtin_amdgcn_mfma_scale_f32_32x32x64_f8f6f4(vf, pf, o1, 0, 1, 0, 0x7F7F7F7F, 0, 0x7F7F7F7F);
        }
        {
            const int one4 = 0x38383838;
            const i32x8 ones = i32x8{one4, one4, one4, one4, one4, one4, one4, one4};
            o2 = __builtin_amdgcn_mfma_scale_f32_32x32x64_f8f6f4(ones, pf, o2, 0, 1, 0, 0x7F7F7F7F, 0, 0x7F7F7F7F);
        }
      }
      asm volatile("s_waitcnt vmcnt(0)" ::: "memory");
      __syncthreads();
    }
    const float inv = (1.f / VT_SCALE) / o2[0];
    bf16_t* O;
    {
        const int t2 = get_tid(), lane2 = t2 & 63, wave2 = t2 >> 6;
        const int h2 = kvh * 4 + (wave2 >> 2), q2 = qb * 128 + (wave2 & 3) * 32 + (lane2 & 31);
        O = (bf16_t*)(p.ws + WS_ATT) + ((size_t)b * SEQ + q2) * QD + h2 * HD + 4 * (lane2 >> 5);
    }
#pragma unroll
    for (int g4 = 0; g4 < 4; ++g4) {
        *(u32x2*)(O + 8 * g4)      = u32x2{pk2(o0[4 * g4] * inv, o0[4 * g4 + 1] * inv), pk2(o0[4 * g4 + 2] * inv, o0[4 * g4 + 3] * inv)};
        *(u32x2*)(O + 32 + 8 * g4) = u32x2{pk2(o1[4 * g4] * inv, o1[4 * g4 + 1] * inv), pk2(o1[4 * g4 + 2] * inv, o1[4 * g4 + 3] * inv)};
    }
}

constexpr int HY_USTR = 8208, HY_R = 8 * HY_USTR, HY_RSTR = 16384 + 64;
DI void hy_load_filter(const bf16_t* __restrict__ R, unsigned char* lds, int tid) {
    const int i0 = tid * 8;
    const u32x4 w = *(const u32x4*)(R + i0);
    u32x2 nx = u32x2{0u, 0u};
    if (i0 + 8 < 8192) nx = *(const u32x2*)(R + i0 + 8);
    unsigned char* d = lds + HY_R + i0 * 2;
    *(u32x4*)(d) = w;
    *(u32x4*)(d + HY_RSTR) = u32x4{__builtin_amdgcn_alignbit(w[1], w[0], 16), __builtin_amdgcn_alignbit(w[2], w[1], 16), __builtin_amdgcn_alignbit(w[3], w[2], 16), __builtin_amdgcn_alignbit(nx[0], w[3], 16)};
    *(u32x4*)(d + 2 * HY_RSTR) = u32x4{w[1], w[2], w[3], nx[0]};
    *(u32x4*)(d + 3 * HY_RSTR) = u32x4{__builtin_amdgcn_alignbit(w[2], w[1], 16), __builtin_amdgcn_alignbit(w[3], w[2], 16), __builtin_amdgcn_alignbit(nx[0], w[3], 16), __builtin_amdgcn_alignbit(nx[1], nx[0], 16)};
}
DI void short_conv4(const bf16_t* __restrict__ zrow  , int t4, float w0, float w1, float w2, float bias, float (&out)[4]) {
    const u32x2 v = *(const u32x2*)(zrow + t4);
    const float z0 = bflo(v[0]), z1 = bfhi(v[0]), z2 = bflo(v[1]), z3 = bfhi(v[1]);
    const float zm = (t4 > 0) ? bf2f(zrow[t4 - 1]) : 0.f;
    const float zp = (t4 + 4 < SEQ) ? bf2f(zrow[t4 + 4]) : 0.f;
    out[0] = zm * w0 + z0 * w1 + z1 * w2 + bias;
    out[1] = z0 * w0 + z1 * w1 + z2 * w2 + bias;
    out[2] = z1 * w0 + z2 * w1 + z3 * w2 + bias;
    out[3] = z2 * w0 + z3 * w1 + zp * w2 + bias;
}
DI void hyena_item(const Params& p, int c, unsigned char* lds) {
    const int tid = get_tid(), lane = tid & 63, ig = tid >> 6;
    const bf16_t* ZT = (const bf16_t*)(p.ws + WS_ZT);
    const float* cw = p.in[I_HCW];
    const float* cb = p.in[I_HCB];
    __syncthreads();
    {
        const int b = tid >> 7, tb = (tid & 127) * 32;
        const bf16_t* zrow = ZT + (size_t)c * BT + (size_t)b * SEQ;
        const float w0 = cw[c], w1 = cw[HYC + c], w2 = cw[2 * HYC + c], bias = cb[c];
#pragma unroll
        for (int q = 0; q < 8; ++q) {
            float o[4];
            short_conv4(zrow, tb + 4 * q, w0, w1, w2, bias, o);
            *(u32x2*)(lds + b * HY_USTR + (tb + 4 * q) * 2) = u32x2{pk2(o[0], o[1]), pk2(o[2], o[3])};
        }
    }
    const int r = lane & 31, hf = lane >> 5, Il = r >> 3, bb = r & 7;
#pragma unroll 1
    for (int o = 0; o < 2; ++o) {
        hy_load_filter((const bf16_t*)(p.ws + WS_R) + (size_t)(o * 512 + c) * 8192, lds, tid);
        __syncthreads();
        f32x16 acc0, acc1;
#pragma unroll
        for (int i = 0; i < 16; ++i) { acc0[i] = 0.f; acc1[i] = 0.f; }
        const int sh = (-r) & 3;
        const unsigned char* abase = lds + HY_R + sh * HY_RSTR + (4096 + 8 * hf - r - sh) * 2 - 64;
        const unsigned char* ubase = lds + bb * HY_USTR + ((4 * ig + Il) * 64 + 8 * hf) * 2;
#define HY_STEP(MASKED) do { \
            const unsigned char* ap = abase - 128 * d; \
            const unsigned char* ub = ubase - 128 * d; \
            bool valid = true; \
            if (MASKED) { const int J = 4 * ig + Il - d; valid = (unsigned)J < 64u; if (!valid) ub = lds; } \
            _Pragma("unroll") for (int ks = 0; ks < 4; ++ks) { \
                u32x4 braw = *(const u32x4*)(ub + ks * 32); \
                if (MASKED) { if (!valid) braw = u32x4{0u, 0u, 0u, 0u}; } \
                const bf16x8 bf = __builtin_bit_cast(bf16x8, braw); \
                { const s16x4 lo = lds_rd64(ap + 32 * ks + 64), hi = lds_rd64(ap + 32 * ks + 72);     \
                  acc0 = MFMA32(__builtin_shufflevector(lo, hi, 0, 1, 2, 3, 4, 5, 6, 7), bf, acc0); } \
                { const s16x4 lo = lds_rd64(ap + 32 * ks), hi = lds_rd64(ap + 32 * ks + 8); \
                  acc1 = MFMA32(__builtin_shufflevector(lo, hi, 0, 1, 2, 3, 4, 5, 6, 7), bf, acc1); } \
            } } while (0)
        const int dlo = 4 * ig - 63, dhi = 4 * ig + 3;
#pragma unroll 1
        for (int d = dlo; d < dlo + 3; ++d) HY_STEP(true);
#pragma unroll 1
        for (int d = dlo + 3; d <= dhi - 3; ++d) HY_STEP(false);
        if (SHADOW == 6) {
            f32x16 s0 = acc0, s1 = acc1;
            const bf16x8 fa = *(const bf16x8*)(lds + lane * 16), fb = *(const bf16x8*)(lds + 4096 + lane * 16);
#pragma unroll 1
            for (int d = 0; d < 67; ++d) {
#pragma unroll
                for (int ks = 0; ks < 4; ++ks) { s0 = MFMA32(fa, fb, s0); s1 = MFMA32(fa, fb, s1); }
            }
            asm volatile("" :: "v"(s0), "v"(s1));
        }
        if (SHADOW == 7) {
            f32x16 k0 = acc0, k1 = acc1;
#pragma unroll 1
            for (int d = dlo + 3; d <= dhi - 3 + 6; ++d) {
                const unsigned char* ap = abase - 128 * (d > dhi - 3 ? dhi - 3 : d);
                const unsigned char* ub = ubase - 128 * (d > dhi - 3 ? dhi - 3 : d);
#pragma unroll
                for (int ks = 0; ks < 4; ++ks) {
                    const bf16x8 bf = *(const bf16x8*)(ub + ks * 32);
                    { const s16x4 lo = lds_rd64(ap + 32 * ks + 64), hi = lds_rd64(ap + 32 * ks + 72); k0 = MFMA32(__builtin_shufflevector(lo, hi, 0, 1, 2, 3, 4, 5, 6, 7), bf, k0); }
                    { const s16x4 lo = lds_rd64(ap + 32 * ks), hi = lds_rd64(ap + 32 * ks + 8); k1 = MFMA32(__builtin_shufflevector(lo, hi, 0, 1, 2, 3, 4, 5, 6, 7), bf, k1); }
                }
            }
            asm volatile("" :: "v"(k0), "v"(k1));
        }
#pragma unroll 1
        for (int d = dhi - 2; d <= dhi; ++d) HY_STEP(true);
#undef HY_STEP
        __syncthreads();
        const float skip = p.in[I_HSKIP][o * HYD + c];
        const int gcol = (o == 0 ? 512 : 1024) + c;
        const float w0 = cw[gcol], w1 = cw[HYC + gcol], w2 = cw[2 * HYC + gcol], bias = cb[gcol];
        const bf16_t* zrow = ZT + (size_t)gcol * BT + (size_t)bb * SEQ;
        bf16_t* hyt = (bf16_t*)(p.ws + WS_HYT) + (size_t)c * 128 + (size_t)bb * (SEQ / 128) * (512 * 128);
#pragma unroll
        for (int mm = 0; mm < 2; ++mm) {
#pragma unroll
            for (int g4 = 0; g4 < 4; ++g4) {
                const int t4 = (4 * ig + Il) * 64 + 32 * mm + 8 * g4 + 4 * hf;
                float gt[4];
                short_conv4(zrow, t4, w0, w1, w2, bias, gt);
                unsigned char* up = lds + bb * HY_USTR + t4 * 2;
                const u32x2 uv = *(const u32x2*)up;
                const float u0 = bflo(uv[0]), u1 = bfhi(uv[0]), u2 = bflo(uv[1]), u3 = bfhi(uv[1]);
                const f32x16& a = mm ? acc1 : acc0;
                const float y0 = gt[0] * (a[4 * g4] + skip * u0), y1 = gt[1] * (a[4 * g4 + 1] + skip * u1);
                const float y2 = gt[2] * (a[4 * g4 + 2] + skip * u2), y3 = gt[3] * (a[4 * g4 + 3] + skip * u3);
                const u32x2 pk = u32x2{pk2(y0, y1), pk2(y2, y3)};
                if (o == 0) *(u32x2*)up = pk; else *(u32x2*)(hyt + (size_t)(t4 >> 7) * (512 * 128) + (t4 & 127)) = pk;
            }
        }
        __syncthreads();
    }
}

constexpr int HY8_USTR = 4112, HY8_R = 8 * HY8_USTR, HY8_RSTR = 8192 + 32;
constexpr float HY8_US = 16.f;
DI void hy8_load_filter(const unsigned char* __restrict__ R, unsigned char* lds, int tid) {
    const int i0 = tid * 8;
    const unsigned long long lo = *(const unsigned long long*)(R + i0);
    unsigned long long hi = 0ull;
    if (i0 + 8 < 8192) hi = *(const unsigned long long*)(R + i0 + 8);
    unsigned char* d = lds + HY8_R + i0;
    *(unsigned long long*)d = lo;
#pragma unroll
    for (int sft = 1; sft < 8; ++sft) *(unsigned long long*)(d + sft * HY8_RSTR) = (lo >> (8 * sft)) | (hi << (64 - 8 * sft));
}
constexpr int HY8_ZSTR = 8192 + 16;
DI void hy8_stage_z(const Params& p, int col, unsigned char* zs, int lane, int wave) {
    const unsigned char* src = p.ws + WS_ZT + ((size_t)col * BT + (size_t)(wave >> 1) * SEQ) * 2 + (wave & 1) * 4096 + lane * 16;
#pragma unroll
    for (int e = 0; e < 4; ++e) __builtin_amdgcn_global_load_lds((const unsigned*)(src + e * 1024), (unsigned*)(zs + (wave >> 1) * HY8_ZSTR + (wave & 1) * 4096 + e * 1024), 16, 0, 0);
}
DI void short_conv4_lds(const unsigned char* zrow  , int t4, float w0, float w1, float w2, float bias, float (&out)[4]) {
    const u32x2 v = *(const u32x2*)(zrow + 2 * t4);
    const float z0 = bflo(v[0]), z1 = bfhi(v[0]), z2 = bflo(v[1]), z3 = bfhi(v[1]);
    const float zm = (t4 > 0) ? bf2f(*(const bf16_t*)(zrow + 2 * t4 - 2)) : 0.f;
    const float zp = (t4 + 4 < SEQ) ? bf2f(*(const bf16_t*)(zrow + 2 * t4 + 8)) : 0.f;
    out[0] = zm * w0 + z0 * w1 + z1 * w2 + bias;
    out[1] = z0 * w0 + z1 * w1 + z2 * w2 + bias;
    out[2] = z1 * w0 + z2 * w1 + z3 * w2 + bias;
    out[3] = z2 * w0 + z3 * w1 + zp * w2 + bias;
}
DI void hyena_item8(const Params& p, int c, unsigned char* lds) {
    const int tid = get_tid(), lane = tid & 63, ig = tid >> 6;
    const float* cw = p.in[I_HCW];
    const float* cb = p.in[I_HCB];
    unsigned char* zs = lds + HY8_R;
    const int wvu = __builtin_amdgcn_readfirstlane(ig);
    __syncthreads();
    hy8_stage_z(p, c, zs, lane, wvu);
    asm volatile("s_waitcnt vmcnt(0)" ::: "memory");
    __syncthreads();
    {
        const int b = tid >> 7, tb = (tid & 127) * 32;
        const unsigned char* zrow = zs + b * HY8_ZSTR;
        const float w0 = cw[c], w1 = cw[HYC + c], w2 = cw[2 * HYC + c], bias = cb[c];
        unsigned w8[8];
#pragma unroll
        for (int q = 0; q < 8; ++q) {
            float o[4];
            short_conv4_lds(zrow, tb + 4 * q, w0, w1, w2, bias, o);
            w8[q] = pk_fp8x4(o[0] * HY8_US, o[1] * HY8_US, o[2] * HY8_US, o[3] * HY8_US);
        }
        *(u32x4*)(lds + b * HY8_USTR + tb) = u32x4{w8[0], w8[1], w8[2], w8[3]};
        *(u32x4*)(lds + b * HY8_USTR + tb + 16) = u32x4{w8[4], w8[5], w8[6], w8[7]};
    }
    const int r = lane & 31, hf = lane >> 5, Il = r >> 3, bb = r & 7;
    __syncthreads();
#pragma unroll 1
    for (int o = 0; o < 2; ++o) {
        hy8_load_filter(p.ws + WS_R + (size_t)(o * 512 + c) * 8192, lds, tid);
        __syncthreads();
        f32x16 acc0, acc1;
#pragma unroll
        for (int i = 0; i < 16; ++i) { acc0[i] = 0.f; acc1[i] = 0.f; }
        const int sh = (-r) & 7;
        const unsigned char* abase = lds + HY8_R + sh * HY8_RSTR + (4096 + 32 * hf - r - sh) - 32;
        const unsigned char* ubase = lds + bb * HY8_USTR + (4 * ig + Il) * 64 + 32 * hf;
#define HY8_STEP(MASKED) do { \
            const unsigned char* ap = abase - 64 * d; \
            const unsigned char* ub = ubase - 64 * d; \
            bool valid = true; \
            if (MASKED) { const int J = 4 * ig + Il - d; valid = (unsigned)J < 64u; if (!valid) ub = lds; } \
            u32x4 b0 = *(const u32x4*)(ub), b1 = *(const u32x4*)(ub + 16); \
            if (MASKED) { if (!valid) { b0 = u32x4{0u, 0u, 0u, 0u}; b1 = b0; } } \
            const i32x8 bf = i32x8{(int)b0[0], (int)b0[1], (int)b0[2], (int)b0[3], (int)b1[0], (int)b1[1], (int)b1[2], (int)b1[3]}; \
            { const s16x4 q0 = lds_rd64(ap + 32), q1 = lds_rd64(ap + 40), q2 = lds_rd64(ap + 48), q3 = lds_rd64(ap + 56); \
              const u32x2 e0 = __builtin_bit_cast(u32x2, q0), e1 = __builtin_bit_cast(u32x2, q1), e2 = __builtin_bit_cast(u32x2, q2), e3 = __builtin_bit_cast(u32x2, q3); \
              acc0 = MFMA8((i32x8{(int)e0[0], (int)e0[1], (int)e1[0], (int)e1[1], (int)e2[0], (int)e2[1], (int)e3[0], (int)e3[1]}), bf, acc0); } \
            { const s16x4 q0 = lds_rd64(ap), q1 = lds_rd64(ap + 8), q2 = lds_rd64(ap + 16), q3 = lds_rd64(ap + 24); \
              const u32x2 e0 = __builtin_bit_cast(u32x2, q0), e1 = __builtin_bit_cast(u32x2, q1), e2 = __builtin_bit_cast(u32x2, q2), e3 = __builtin_bit_cast(u32x2, q3); \
              acc1 = MFMA8((i32x8{(int)e0[0], (int)e0[1], (int)e1[0], (int)e1[1], (int)e2[0], (int)e2[1], (int)e3[0], (int)e3[1]}), bf, acc1); } \
            } while (0)
        const int dlo = 4 * ig - 63, dhi = 4 * ig + 3;
#pragma unroll 1
        for (int d = dlo; d < dlo + 3; ++d) HY8_STEP(true);
#pragma unroll 1
        for (int d = dlo + 3; d <= dhi - 3; ++d) HY8_STEP(false);
#pragma unroll 1
        for (int d = dhi - 2; d <= dhi; ++d) HY8_STEP(true);
#undef HY8_STEP
        __syncthreads();
        const float skip = p.in[I_HSKIP][o * HYD + c];
        const float asc = ((const float*)(p.ws + WS_FSC))[o * 512 + c] * (1.f / HY8_US);
        const int gcol = (o == 0 ? 512 : 1024) + c;
        const float w0 = cw[gcol], w1 = cw[HYC + gcol], w2 = cw[2 * HYC + gcol], bias = cb[gcol];
        hy8_stage_z(p, gcol, zs, lane, wvu);
        asm volatile("s_waitcnt vmcnt(0)" ::: "memory");
        __syncthreads();
        const unsigned char* zrow = zs + bb * HY8_ZSTR;
        bf16_t* hyt = (bf16_t*)(p.ws + WS_HYT) + (size_t)c * 128 + (size_t)bb * (SEQ / 128) * (512 * 128);
#pragma unroll
        for (int mm = 0; mm < 2; ++mm) {
#pragma unroll
            for (int g4 = 0; g4 < 4; ++g4) {
                const int t4 = (4 * ig + Il) * 64 + 32 * mm + 8 * g4 + 4 * hf;
                float gt[4];
                short_conv4_lds(zrow, t4, w0, w1, w2, bias, gt);
                unsigned* up = (unsigned*)(lds + bb * HY8_USTR + t4);
                const unsigned uv = *up;
                const f32x2 ul = __builtin_amdgcn_cvt_pk_f32_fp8((int)uv, false), uh = __builtin_amdgcn_cvt_pk_f32_fp8((int)uv, true);
                const float us = skip * (1.f / HY8_US);
                const f32x16& a = mm ? acc1 : acc0;
                const float y0 = gt[0] * (a[4 * g4] * asc + us * ul[0]), y1 = gt[1] * (a[4 * g4 + 1] * asc + us * ul[1]);
                const float y2 = gt[2] * (a[4 * g4 + 2] * asc + us * uh[0]), y3 = gt[3] * (a[4 * g4 + 3] * asc + us * uh[1]);
                if (o == 0) *up = pk_fp8x4(y0 * HY8_US, y1 * HY8_US, y2 * HY8_US, y3 * HY8_US);
                else *(u32x2*)(hyt + (size_t)(t4 >> 7) * (512 * 128) + (t4 & 127)) = u32x2{pk2(y0, y1), pk2(y2, y3)};
            }
        }
        __syncthreads();
    }
}

constexpr int CTL_QUEUE_D = 8192;
DI void phase_d(const Params& p, unsigned char* lds) {
    unsigned* ctr = (unsigned*)(p.ws + WS_CTL) + CTL_QUEUE_D;
    volatile LAS unsigned* slot = (volatile LAS unsigned*)(LAS unsigned char*)(lds + LDS_ST_OFF + 8);
    for (;;) {
        __syncthreads();
        if (get_tid() == 0) slot[0] = atomicAdd(ctr, 1u);
        __syncthreads();
        const int it = __builtin_amdgcn_readfirstlane((int)slot[0]);
        if (it >= 1024) break;
        if (it < 512) hyena_item8(p, it, lds); else attn_item(p, it - 512, lds);
    }
}

DI void phase_d2(const Params& p, unsigned char* lds) {
    constexpr int TILES = 8 * (BT / 256);
    const bf16_t* HYT = (const bf16_t*)(p.ws + WS_HYT);
    bf16_t* HY = (bf16_t*)(p.ws + WS_HY);
    for (int it = blockIdx.x; it < TILES; it += gridDim.x) {
        const int tid = get_tid();
        const int c0 = (it & 7) * 64, tok0 = (it >> 3) * 256;
        __syncthreads();
#pragma unroll
        for (int i = 0; i < 2; ++i) {
            const int idx = tid + i * NT, c = idx >> 5, tg = idx & 31;
            *(u32x4*)(lds + c * 528 + tg * 16) = *(const u32x4*)(HYT + (size_t)(c0 + c) * BT + tok0 + tg * 8);
        }
        __syncthreads();
#pragma unroll
        for (int i = 0; i < 2; ++i) {
            const int idx = tid + i * NT, tok = idx >> 3, cg = idx & 7;
            unsigned w[4];
#pragma unroll
            for (int e = 0; e < 4; ++e) {
                const unsigned lo = *(const unsigned short*)(lds + (cg * 8 + 2 * e) * 528 + tok * 2);
                const unsigned hi = *(const unsigned short*)(lds + (cg * 8 + 2 * e + 1) * 528 + tok * 2);
                w[e] = lo | (hi << 16);
            }
            *(u32x4*)(HY + (size_t)(tok0 + tok) * HYD + c0 + cg * 8) = u32x4{w[0], w[1], w[2], w[3]};
        }
    }
}

template<int NT> DI void xcd_tile(int it, int& tm, int& tn) {
    if (gridDim.x == 256) {
        const int r = it >> 8, b = it & 255, xcd = b & 7, slot = b >> 3;
        tn = slot % NT; tm = r * (256 / NT) + (slot / NT) * 8 + xcd;
    } else { tn = it % NT; tm = it / NT; }
}
DI void phase_e(const Params& p, unsigned char* lds) {
    constexpr int TILES = 4 * (BT / 128);
    for (int it = blockIdx.x; it < TILES; it += gridDim.x) {
        const int tid = get_tid(), lane = tid & 63, wave = tid >> 6, wp = wave >> 2, wq = wave & 3;
        int tn, tm; xcd_tile<4>(it, tm, tn);
        const int n0 = tn * 256, tok0 = tm * 128;
        f32x4 acc1[4][2], acc2[4][2];
#pragma unroll
        for (int i = 0; i < 4; ++i)
#pragma unroll
            for (int j = 0; j < 2; ++j) { acc1[i][j] = f32x4{0.f, 0.f, 0.f, 0.f}; acc2[i][j] = f32x4{0.f, 0.f, 0.f, 0.f}; }
        {
            const RowLoader p1{(const bf16_t*)(p.ws + WS_WTAO) + (size_t)n0 * QD, QD}, q1{(const bf16_t*)(p.ws + WS_ATT) + (size_t)tok0 * QD, QD};
            const RowLoader p2{(const bf16_t*)(p.ws + WS_WTHO) + (size_t)n0 * HYD, HYD};
            const ColLoader q2{(const bf16_t*)(p.ws + WS_HYT) + (size_t)tm * (512 * 128), (size_t)128};
            gemm_mainloop<2, RowLoader, ColLoader>(acc1, p1, q1, QD / 64, lds, false, true, p2, q2);
            gemm_mainloop<2, ColLoader, RowLoader>(acc2, p2, q2, HYD / 64, lds, true, false);
        }
        const unsigned char* G8 = p.ws + WS_G;
        bf16_t* M = (bf16_t*)(p.ws + WS_H);
        constexpr int ES = 528, GS = 272, EG2 = 128 * GS;
        __syncthreads();
        {
            u32x4 ga[2], gh[2];
#pragma unroll
            for (int q = 0; q < 2; ++q) {
                const int idx = tid + q * NT, row = idx >> 4, ch = idx & 15;
                const unsigned char* gp = G8 + (size_t)(tok0 + row) * GC + n0 + ch * 16;
                ga[q] = *(const u32x4*)gp; gh[q] = *(const u32x4*)(gp + 1024);
            }
#pragma unroll
            for (int q = 0; q < 2; ++q) {
                const int idx = tid + q * NT, row = idx >> 4, ch = idx & 15;
                *(u32x4*)(lds + row * GS + ch * 16) = ga[q]; *(u32x4*)(lds + EG2 + row * GS + ch * 16) = gh[q];
            }
        }
        __syncthreads();
        const int l15 = lane & 15, lk = lane >> 4;
        u32x2 mo[4][2];
#pragma unroll
        for (int i = 0; i < 4; ++i)
#pragma unroll
            for (int j = 0; j < 2; ++j) {
                const int off = (wq * 32 + j * 16 + l15) * GS + wp * 64 + i * 16 + lk * 4;
                const unsigned ga = *(const unsigned*)(lds + off), gh = *(const unsigned*)(lds + EG2 + off);
                constexpr float K = 1.f / 255.f;
                const float m0 = K * ((float)(ga & 255u) * acc1[i][j][0] + (float)(gh & 255u) * acc2[i][j][0]);
                const float m1 = K * ((float)((ga >> 8) & 255u) * acc1[i][j][1] + (float)((gh >> 8) & 255u) * acc2[i][j][1]);
                const float m2 = K * ((float)((ga >> 16) & 255u) * acc1[i][j][2] + (float)((gh >> 16) & 255u) * acc2[i][j][2]);
                const float m3 = K * ((float)(ga >> 24) * acc1[i][j][3] + (float)(gh >> 24) * acc2[i][j][3]);
                mo[i][j] = u32x2{pk2(m0, m1), pk2(m2, m3)};
            }
        __syncthreads();
#pragma unroll
        for (int i = 0; i < 4; ++i)
#pragma unroll
            for (int j = 0; j < 2; ++j) *(u32x2*)(lds + (wq * 32 + j * 16 + l15) * ES + (wp * 64 + i * 16 + lk * 4) * 2) = mo[i][j];
        __syncthreads();
#pragma unroll
        for (int q = 0; q < 4; ++q) {
            const int idx = tid + q * NT, row = idx >> 5, ch = idx & 31;
            *(u32x4*)(M + (size_t)(tok0 + row) * DM + n0 + ch * 8) = *(const u32x4*)(lds + row * ES + ch * 16);
        }
    }
}

DI void phase_f(const Params& p, unsigned char* lds) {
    constexpr int TILES = 4 * (BT / 256);
    const float* mod = (const float*)(p.ws + WS_MOD);
    for (int it = blockIdx.x; it < TILES; it += gridDim.x) {
        const int tid = get_tid(), lane = tid & 63, wave = tid >> 6, wp = wave >> 2, wq = wave & 3;
        int tn, tm; xcd_tile<4>(it, tm, tn);
        const int n0 = tn * 256, tok0 = tm * 256, b = tok0 >> 12;
        f32x4 acc[4][4];
#pragma unroll
        for (int i = 0; i < 4; ++i)
#pragma unroll
            for (int j = 0; j < 4; ++j) acc[i][j] = f32x4{0.f, 0.f, 0.f, 0.f};
        gemm_mainloop<4>(acc, RowLoader{(const bf16_t*)(p.ws + WS_WTO) + (size_t)n0 * DM, DM}, RowLoader{(const bf16_t*)(p.ws + WS_H) + (size_t)tok0 * DM, DM}, DM / 64, lds);
        const int l15 = lane & 15, lk = lane >> 4;
        constexpr int ES = 528;
        float ss[4] = {0.f, 0.f, 0.f, 0.f};
#pragma unroll
        for (int i = 0; i < 4; ++i) {
            const int n = n0 + wp * 64 + i * 16 + lk * 4;
            const f32x4 g1 = *(const f32x4*)(mod + b * 6144 + 2048 + n);
            const f32x4 s2 = *(const f32x4*)(mod + b * 6144 + 4096 + n), gf = *(const f32x4*)(p.in[I_NFFN] + n);
            const f32x4 gm = f32x4{gf[0] * (1.f + s2[0]), gf[1] * (1.f + s2[1]), gf[2] * (1.f + s2[2]), gf[3] * (1.f + s2[3])};
#pragma unroll
            for (int j = 0; j < 4; ++j) {
                const int tl = wq * 64 + j * 16 + l15;
                const f32x4 xv = *(const f32x4*)(p.in[I_X] + (size_t)(tok0 + tl) * DM + n);
                const f32x4 x1 = f32x4{xv[0] + g1[0] * acc[i][j][0], xv[1] + g1[1] * acc[i][j][1], xv[2] + g1[2] * acc[i][j][2], xv[3] + g1[3] * acc[i][j][3]};
                *(u32x2*)((bf16_t*)(p.out + (size_t)(tok0 + tl) * DM) + n) = u32x2{pk2(x1[0], x1[1]), pk2(x1[2], x1[3])};
                ss[j] += x1[0] * x1[0] + x1[1] * x1[1] + x1[2] * x1[2] + x1[3] * x1[3];
                *(u32x2*)(lds + tl * ES + (wp * 64 + i * 16 + lk * 4) * 2) = u32x2{pk2(x1[0] * gm[0], x1[1] * gm[1]), pk2(x1[2] * gm[2], x1[3] * gm[3])};
            }
        }
#pragma unroll
        for (int j = 0; j < 4; ++j) {
            const float t = sum_x32(sum_x16(ss[j]));
            if (lk == 0) ((float*)(p.ws + WS_SSQ1))[(size_t)(tok0 + wq * 64 + j * 16 + l15) * 16 + tn * 4 + wp] = t;
        }
        __syncthreads();
        bf16_t* Y = (bf16_t*)(p.ws + WS_Y);
#pragma unroll
        for (int q = 0; q < 8; ++q) {
            const int idx = tid + q * NT, row = idx >> 5, ch = idx & 31;
            *(u32x4*)(Y + (size_t)(tok0 + row) * DM + n0 + ch * 8) = *(const u32x4*)(lds + row * ES + ch * 16);
        }
    }
}

DI void ins16(float (&L)[16], float v) {
#pragma unroll
    for (int i = 0; i < 16; ++i) { const float hi = fmaxf(L[i], v); v = fminf(L[i], v); L[i] = hi; }
}
DI void cex_desc(float& a, float& b) { const float hi = fmaxf(a, b), lo = fminf(a, b); a = hi; b = lo; }
DI void bitonic_merge16_desc(float (&v)[16]) {
#pragma unroll
    for (int j = 8; j > 0; j >>= 1)
#pragma unroll
        for (int i = 0; i < 16; ++i) if ((i ^ j) > i) cex_desc(v[i], v[i ^ j]);
}
DI void sort16_desc(float (&v)[16]) {
#pragma unroll
    for (int p = 1; p < 16; p <<= 1)
#pragma unroll
        for (int k = p; k >= 1; k >>= 1)
#pragma unroll
            for (int j = k % p; j <= 15 - k; j += 2 * k)
#pragma unroll
                for (int i = 0; i <= (k - 1 < 15 - j - k ? k - 1 : 15 - j - k); ++i)
                    if ((i + j) / (2 * p) == (i + j + k) / (2 * p)) cex_desc(v[i + j], v[i + j + k]);
}
DI void top16_merge(float (&a)[16], const float (&b)[16]) {
#pragma unroll
    for (int i = 0; i < 16; ++i) a[i] = fmaxf(a[i], b[15 - i]);
    bitonic_merge16_desc(a);
}
DI float pack_idx(float v, unsigned idx, unsigned mask) { return __uint_as_float((__float_as_uint(v) & ~mask) | idx); }
DI void peer_h2_item(const Params& p, int item) {
    const int tok0 = item * 128;
    const int tid = get_tid(), lane = tid & 63, wave = tid >> 6, b = tok0 >> 12;
    const float* sh2 = (const float*)(p.ws + WS_MOD) + b * 6144 + 3072 + lane * 16;
    float sh[16];
#pragma unroll
    for (int i = 0; i < 16; i += 4) { const f32x4 v = *(const f32x4*)(sh2 + i); sh[i] = v[0]; sh[i + 1] = v[1]; sh[i + 2] = v[2]; sh[i + 3] = v[3]; }
    u32x4 ny0, ny1; float nsq;
#define S0_LOAD(tk) do { const bf16_t* yr_ = (const bf16_t*)(p.ws + WS_Y) + (size_t)(tk) * DM + lane * 16; ny0 = *(const u32x4*)yr_; ny1 = *(const u32x4*)(yr_ + 8); \
        nsq = ((const float*)(p.ws + WS_SSQ1))[(size_t)(tk) * 16 + (lane & 15)]; } while (0)
    S0_LOAD(tok0 + wave * 8);
#pragma unroll 1
    for (int t = 0; t < 8; ++t) {
        const int tok = tok0 + wave * 8 + t;
        const u32x4 y0 = ny0, y1 = ny1;
        const float sq1 = nsq;
        if (t + 1 < 8) S0_LOAD(tok + 1);
        const float rs = rsqrtf(sum16(sq1) * (1.f / DM) + EPS);
        float f[16];
#pragma unroll
        for (int q = 0; q < 4; ++q) { f[2 * q] = bflo(y0[q]); f[2 * q + 1] = bfhi(y0[q]); f[8 + 2 * q] = bflo(y1[q]); f[9 + 2 * q] = bfhi(y1[q]); }
        float mx = 0.f;
#pragma unroll
        for (int i = 0; i < 16; ++i) { f[i] = rs * f[i] + sh[i]; mx = fmaxf(mx, fabsf(f[i])); }
        mx = fmaxf(wave_max(mx), 1e-30f);
        const float qs = X8_MAX / mx;
        int w8[4];
#pragma unroll
        for (int q = 0; q < 4; ++q) {
            w8[q] = __builtin_amdgcn_cvt_pk_fp8_f32(f[4 * q] * qs, f[4 * q + 1] * qs, 0, false);
            w8[q] = __builtin_amdgcn_cvt_pk_fp8_f32(f[4 * q + 2] * qs, f[4 * q + 3] * qs, w8[q], true);
        }
        *(u32x4*)(p.ws + WS_X8 + (size_t)tok * DM + lane * 16) = u32x4{(unsigned)w8[0], (unsigned)w8[1], (unsigned)w8[2], (unsigned)w8[3]};
        if (lane == 0) ((float*)(p.ws + WS_SX))[tok] = mx * (1.f / X8_MAX);
    }
#undef S0_LOAD
}
DI void peer_scores_top16(const bf16x8 (&bq)[8], const bf16_t* keysU  , int r, int hf, float (&L)[16]) {
    const unsigned ko = (unsigned)((hf * 32 + r) * 16);
    f32x16 acc[4];
#pragma unroll
    for (int m = 0; m < 4; ++m)
#pragma unroll
        for (int i = 0; i < 16; ++i) acc[m][i] = 0.f;
#pragma unroll
    for (int ks = 0; ks < 8; ++ks) {
#pragma unroll
        for (int m = 0; m < 4; ++m) {
            const bf16x8 ak = *(const bf16x8*)((const char*)keysU + (ko + (unsigned)(m * 8192)) + ks * 1024);
            acc[m] = MFMA32(ak, bq[ks], acc[m]);
        }
    }
    float V[4][16];
#define PK_SORT(m) do { _Pragma("unroll") for (int i = 0; i < 16; ++i) V[m][i] = pack_idx(acc[m][i], (unsigned)((m) * 32 + (i & 3) + 8 * (i >> 2) + 4 * hf), 127u); sort16_desc(V[m]); } while (0)
    PK_SORT(0); PK_SORT(1); top16_merge(V[0], V[1]); __builtin_amdgcn_sched_barrier(0);
    PK_SORT(2); PK_SORT(3); top16_merge(V[2], V[3]); __builtin_amdgcn_sched_barrier(0);
    top16_merge(V[0], V[2]);
#undef PK_SORT
    const int hf3 = (get_tid() >> 5) & 1;
    float P[16];
#pragma unroll
    for (int i = 0; i < 16; ++i) {
        auto sw = __builtin_amdgcn_permlane32_swap(__float_as_uint(V[0][i]), __float_as_uint(V[0][i]), false, false);
        P[i] = hf3 ? __uint_as_float(sw[0]) : __uint_as_float(sw[1]);
    }
    top16_merge(V[0], P);
#pragma unroll
    for (int i = 0; i < 16; ++i) L[i] = V[0][i];
}
DI void peer_pick(const Params& p, const float* l1, const float* l2, int tokg, int h) {
    float v1[16], v2[16];
#pragma unroll
    for (int i = 0; i < 16; i += 4) {
        const f32x4 a = *(const f32x4*)(l1 + i), b = *(const f32x4*)(l2 + i);
        v1[i] = a[0]; v1[i + 1] = a[1]; v1[i + 2] = a[2]; v1[i + 3] = a[3];
        v2[i] = b[0]; v2[i + 1] = b[1]; v2[i + 2] = b[2]; v2[i + 3] = b[3];
    }
    float B[16];
#pragma unroll
    for (int i = 0; i < 16; ++i) B[i] = -3.0e38f;
#pragma unroll
    for (int i = 0; i < 16; ++i)
#pragma unroll
        for (int j = 0; j < 16; ++j)
            if ((i + 1) * (j + 1) <= 16) ins16(B, pack_idx(v1[i] + v2[j], (unsigned)(i * 16 + j), 255u));
    float e[16], sum = 0.f;
#pragma unroll
    for (int k = 0; k < 16; ++k) { e[k] = __expf(B[k] - B[0]); sum += e[k]; }
    const float inv = 1.f / sum;
    int* ex = (int*)(p.ws + WS_EXPI) + (size_t)tokg * 128 + h * 16;
    float* gt = (float*)(p.ws + WS_GATE) + ((size_t)tokg * 128 + h * 16) * 2;
    const f32x2* usv = (const f32x2*)(p.ws + WS_USC);
    int ev[16]; float gv[16], sv[16];
#pragma unroll
    for (int k = 0; k < 16; ++k) {
        const unsigned ij = __float_as_uint(B[k]) & 255u;
        const unsigned i1 = __float_as_uint(l1[ij >> 4]) & 127u, i2 = __float_as_uint(l2[ij & 15u]) & 127u;
        ev[k] = (int)(i1 * 128u + i2);
        const f32x2 sc2 = usv[ev[k]];
        gv[k] = e[k] * inv * sc2[1];
        sv[k] = sc2[0];
    }
#pragma unroll
    for (int k = 0; k < 16; k += 4) *(u32x4*)(ex + k) = u32x4{(unsigned)ev[k], (unsigned)ev[k + 1], (unsigned)ev[k + 2], (unsigned)ev[k + 3]};
#pragma unroll
    for (int k = 0; k < 16; k += 2) *(f32x4*)(gt + 2 * k) = f32x4{gv[k], sv[k], gv[k + 1], sv[k + 1]};
}
DI void phase_h(const Params& p, unsigned char* lds) {
    for (int it = blockIdx.x; it < BT / 128; it += gridDim.x) peer_h2_item(p, it);
    constexpr int TILES = 8 * (BT / 256);
    constexpr int QS = 528;
    float* rsb = (float*)(lds + 136 * 1024);
    bool pre = false;
    for (int it = blockIdx.x; it < TILES; it += gridDim.x) {
        const int tid = get_tid(), lane = tid & 63, wave = tid >> 6, wp = wave >> 2, wq = wave & 3;
        int tn, tm; xcd_tile<8>(it, tm, tn);
        const int n0 = tn * 256, tok0 = tm * 256, b = tok0 >> 12;
        const int it2 = it + (int)gridDim.x; const bool has2 = it2 < TILES;
        int tn2 = tn, tm2 = tm; if (has2) xcd_tile<8>(it2, tm2, tn2);
        const int n2 = tn2 * 256, tk2 = tm2 * 256;
        __syncthreads();
        if (tid < 256) {
            const float* sq = (const float*)(p.ws + WS_SSQ1) + (size_t)(tok0 + tid) * 16;
            const f32x4 a = *(const f32x4*)sq, c = *(const f32x4*)(sq + 4), d = *(const f32x4*)(sq + 8), e = *(const f32x4*)(sq + 12);
            const float ssq = (a[0] + a[1] + a[2] + a[3]) + (c[0] + c[1] + c[2] + c[3]) + (d[0] + d[1] + d[2] + d[3]) + (e[0] + e[1] + e[2] + e[3]);
            rsb[tid] = rsqrtf(ssq * (1.f / DM) + EPS);
        }
        f32x4 acc[4][4];
#pragma unroll
        for (int i = 0; i < 4; ++i)
#pragma unroll
            for (int j = 0; j < 4; ++j) acc[i][j] = f32x4{0.f, 0.f, 0.f, 0.f};
        gemm_mainloop<4>(acc, RowLoader{(const bf16_t*)(p.ws + WS_WTQ) + (size_t)n0 * DM, DM}, RowLoader{(const bf16_t*)(p.ws + WS_Y) + (size_t)tok0 * DM, DM}, DM / 64, lds, pre);
        pre = has2;
        {
            const float* shq = (const float*)(p.ws + WS_SHQ) + b * 2048;
            const int l15 = lane & 15, lk = lane >> 4;
#pragma unroll
            for (int i = 0; i < 4; ++i) {
                const int nl = wp * 64 + i * 16 + lk * 4;
                const f32x4 sh = *(const f32x4*)(shq + n0 + nl);
#pragma unroll
                for (int j = 0; j < 4; ++j) {
                    const int tl = wq * 64 + j * 16 + l15;
                    const float rs = rsb[tl];
                    *(u32x2*)(lds + tl * QS + nl * 2) = u32x2{pk2(rs * acc[i][j][0] + sh[0], rs * acc[i][j][1] + sh[1]), pk2(rs * acc[i][j][2] + sh[2], rs * acc[i][j][3] + sh[3])};
                }
            }
        }
        __syncthreads();
        float L[16];
        {
            const int t1 = get_tid(), ln = t1 & 63, w1 = __builtin_amdgcn_readfirstlane(t1 >> 6), r = ln & 31, hf = ln >> 5, hpl = w1 & 1, tb = w1 >> 1;
            const int hp = 2 * tn + hpl;
            const bf16_t* keys = (const bf16_t*)(p.ws + WS_KEYS) + (size_t)((hp & 1) * 8 + (hp >> 1)) * 128 * 128;
            const unsigned char* qrow = lds + (tb * 32 + r) * QS + (hpl * 128 + 8 * hf) * 2;
            bf16x8 bq[8];
#pragma unroll
            for (int ks = 0; ks < 8; ++ks) bq[ks] = *(const bf16x8*)(qrow + 32 * ks);
            peer_scores_top16(bq, keys, r, hf, L);
        }
        __syncthreads();
        if (has2) gemm_prefetch<4>(RowLoader{(const bf16_t*)(p.ws + WS_WTQ) + (size_t)n2 * DM, DM}, RowLoader{(const bf16_t*)(p.ws + WS_Y) + (size_t)tk2 * DM, DM}, lds);
        float* lists = (float*)(lds + 96 * 1024);
        {
            const int t2 = get_tid(), ln = t2 & 63, w2 = __builtin_amdgcn_readfirstlane(t2 >> 6);
            if ((ln >> 5) == 0) {
                float* dst = lists + (((w2 >> 1) * 32 + (ln & 31)) * 2 + (w2 & 1)) * 16;
#pragma unroll
                for (int i = 0; i < 16; i += 4) *(f32x4*)(dst + i) = f32x4{L[i], L[i + 1], L[i + 2], L[i + 3]};
            }
        }
        __syncthreads();
        {
            const int t3 = get_tid();
            if (t3 < 256) peer_pick(p, lists + (t3 * 2) * 16, lists + (t3 * 2 + 1) * 16, tok0 + t3, tn);
        }
    }
}

DI float dot16_fp8(const u32x4& w, const float (&x)[16]) {
    float d = 0.f;
#pragma unroll
    for (int i = 0; i < 4; ++i) {
        const auto lo = __builtin_amdgcn_cvt_pk_f32_fp8((int)w[i], false);
        const auto hi = __builtin_amdgcn_cvt_pk_f32_fp8((int)w[i], true);
        d += lo[0] * x[4 * i] + lo[1] * x[4 * i + 1] + hi[0] * x[4 * i + 2] + hi[1] * x[4 * i + 3];
    }
    return d;
}
template<int NPART, class F> DI void run_partitioned(const Params& p, unsigned char* lds, int qbase, int nitems, F&& body) {
    unsigned* ctl = (unsigned*)(p.ws + WS_CTL);
    volatile LAS unsigned* slot = (volatile LAS unsigned*)(LAS unsigned char*)(lds + LDS_ST_OFF + 8);
    const int x0 = (int)(xb_xcc_id() & 7u);
#pragma unroll 1
    for (int pp = 0; pp < NPART; ++pp) {
        const int part = (NPART == 8) ? ((x0 + pp) & 7) : ((((x0 + (pp >> 1)) & 7)) + 8 * (pp & 1));
        for (;;) {
            __syncthreads();
            if (get_tid() == 0) slot[0] = atomicAdd(ctl + qbase + 64 * part, 1u);
            __syncthreads();
            const int it = __builtin_amdgcn_readfirstlane((int)slot[0]);
            if (it >= nitems) break;
            body(part, it);
        }
    }
}
constexpr int CTL_QUEUE_I2 = 8320, CTL_QUEUE_I3 = 9408;
constexpr int UW_BYTES = 8384, UW_H2S = 1040, UW_LIST = 4160, UW_LCAP = 2112;
DI int peer_u_list(unsigned* lst, const u32x4& ia, const u32x4& ib, int part, int) {
    const int lane = get_tid() & 63;
    int cnt = 0;
#pragma unroll
    for (int g = 0; g < 8; ++g) {
        const unsigned id = (g < 4) ? ia[g & 3] : ib[g & 3];
        const unsigned idx = (unsigned)((g < 4 ? 0 : 256) + lane * 4 + (g & 3));
        const bool m = (int)(id >> 11) == part;
        const unsigned long long bm = __ballot(m);
        const int pos = cnt + __builtin_amdgcn_mbcnt_hi((unsigned)(bm >> 32), __builtin_amdgcn_mbcnt_lo((unsigned)bm, 0u));
        if (m) lst[pos] = (idx << 16) | id;
        cnt += __popcll(bm);
    }
    const unsigned last = lst[max(cnt - 1, 0)];
    if (lane < 16) lst[cnt + lane] = last;
    return cnt;
}
DI void peer_u_chunk(const Params& p, int part, int chunk, unsigned char* lds) {
    const int tid = get_tid(), lane = tid & 63, wave = __builtin_amdgcn_readfirstlane(tid >> 6);
    unsigned char* wl = lds + wave * UW_BYTES;
    const int n = lane & 15, kg = lane >> 4;
    const int ln4 = lane >> 2;
    const unsigned char* UT4 = p.ws + WS_UT + (lane & 3) * 16;
    const int bpi = 16 * n + 4 * kg;
    const unsigned char* arow = wl + (n & 3) * UW_H2S + kg * 16;
    const int tokw = chunk * 256 + wave * 4;
    u32x4 pia, pib, ph[4]; f32x4 psx;
#define U_LOAD_IDS(tok) do { const u32x4* ex_ = (const u32x4*)((const int*)(p.ws + WS_EXPI) + (size_t)(tok) * 128) + lane; pia = ex_[0]; pib = ex_[64]; } while (0)
#define U_LOAD_H2(tok) do { const unsigned char* hr_ = p.ws + WS_X8 + (size_t)(tok) * DM + lane * 16; \
        ph[0] = *(const u32x4*)hr_; ph[1] = *(const u32x4*)(hr_ + DM); ph[2] = *(const u32x4*)(hr_ + 2 * DM); ph[3] = *(const u32x4*)(hr_ + 3 * DM); \
        psx = *(const f32x4*)((const float*)(p.ws + WS_SX) + (tok)); } while (0)
#define U_BPERM(dst, src) do { dst[0] = (unsigned)__builtin_amdgcn_ds_bpermute(bpi, (int)src[0]); dst[1] = (unsigned)__builtin_amdgcn_ds_bpermute(bpi, (int)src[1]); \
        dst[2] = (unsigned)__builtin_amdgcn_ds_bpermute(bpi, (int)src[2]); dst[3] = (unsigned)__builtin_amdgcn_ds_bpermute(bpi, (int)src[3]); } while (0)
    U_LOAD_IDS(tokw); U_LOAD_H2(tokw);
    int cntc = peer_u_list((unsigned*)(wl + UW_LIST), pia, pib, part, lane);
    U_LOAD_IDS(tokw + 64);
    int have = -1;
    u32x4 brow[8];
#pragma unroll 1
    for (int s = 0; s < 4; ++s) {
        const int tok0 = tokw + s * 64;
#pragma unroll
        for (int r = 0; r < 4; ++r) *(u32x4*)(wl + r * UW_H2S + lane * 16) = ph[r];
        const f32x4 sx = psx;
        const unsigned* lc = (const unsigned*)(wl + UW_LIST + (s & 1) * UW_LCAP);
        unsigned* ln = (unsigned*)(wl + UW_LIST + ((s + 1) & 1) * UW_LCAP);
        int cntn = 0;
        if (s + 1 < 4) {
            cntn = peer_u_list(ln, pia, pib, part, lane);
            U_LOAD_H2(tok0 + 64);
            if (s + 2 < 4) U_LOAD_IDS(tok0 + 128);
        }
        const int ntiles = (cntc + 15) >> 4;
#pragma unroll 1
        for (int t = 0; t < ntiles; ++t) {
            const unsigned ent = lc[t * 16 + n];
            if (have != s * 64 + t) {
                const unsigned char* rp = UT4 + (size_t)(lc[t * 16 + ln4] & 0x3fffu) * 512;
#pragma unroll
                for (int ks = 0; ks < 8; ++ks) brow[ks] = *(const u32x4*)(rp + ks * 64);
            }
            unsigned entn;
            if (t + 1 < ntiles) { entn = lc[(t + 1) * 16 + ln4]; have = s * 64 + t + 1; }
            else if (cntn > 0) { entn = ln[ln4]; have = (s + 1) * 64; }
            else { entn = lc[t * 16 + ln4]; have = -1; }
            const unsigned char* rpn = UT4 + (size_t)(entn & 0x3fffu) * 512;
            const int idx = (int)(ent >> 16), tj = idx >> 7;
            const f32x2 gs = ((const f32x2*)(p.ws + WS_GATE))[(size_t)(tok0 + tj) * 128 + (idx & 127)];
            f32x4 acc0 = f32x4{0.f, 0.f, 0.f, 0.f}, acc1 = acc0;
            u32x4 a0 = *(const u32x4*)arow, a1 = *(const u32x4*)(arow + 64), bc;
            U_BPERM(bc, brow[0]);
#pragma unroll
            for (int ks = 0; ks < 8; ++ks) {
                const i32x8 av = i32x8{(int)a0[0], (int)a0[1], (int)a0[2], (int)a0[3], (int)a1[0], (int)a1[1], (int)a1[2], (int)a1[3]};
                const i32x8 bv = i32x8{(int)bc[0], (int)bc[1], (int)bc[2], (int)bc[3], 0, 0, 0, 0};
                if (ks < 7) { a0 = *(const u32x4*)(arow + (ks + 1) * 128); a1 = *(const u32x4*)(arow + (ks + 1) * 128 + 64); U_BPERM(bc, brow[ks + 1]); }
                if (ks & 1) acc1 = __builtin_amdgcn_mfma_scale_f32_16x16x128_f8f6f4(av, bv, acc1, 0, 4, 0, 0x7F7F7F7F, 0, 0x7F7F7F7F);
                else        acc0 = __builtin_amdgcn_mfma_scale_f32_16x16x128_f8f6f4(av, bv, acc0, 0, 4, 0, 0x7F7F7F7F, 0, 0x7F7F7F7F);
                brow[ks] = *(const u32x4*)(rpn + ks * 64);
                __builtin_amdgcn_sched_barrier(0);
            }
            const float d0 = acc0[0] + acc1[0], d1 = acc0[1] + acc1[1], d2 = acc0[2] + acc1[2], d3 = acc0[3] + acc1[3];
            const float araw = (tj == 0) ? d0 : (tj == 1) ? d1 : (tj == 2) ? d2 : d3;
            const float sxv = (tj == 0) ? sx[0] : (tj == 1) ? sx[1] : (tj == 2) ? sx[2] : sx[3];
            const float a = araw * (gs[1] * sxv);
            const float y = 0.7978845608028654f * (a + 0.044715f * a * a * a);
            const float th = 1.f - 2.f * __builtin_amdgcn_rcpf(__expf(2.f * y) + 1.f);
            const float w = 0.5f * a * (1.f + th) * gs[0];
            if (kg == 0 && t * 16 + n < cntc) ((u32x2*)(p.ws + WS_PAIRS))[(size_t)(tok0 + tj) * 128 + (idx & 127)] = u32x2{ent & 0x3fffu, __float_as_uint(w)};
        }
        cntc = cntn;
    }
#undef U_BPERM
#undef U_LOAD_IDS
#undef U_LOAD_H2
}
DI void phase_i2(const Params& p, unsigned char* lds) {
    run_partitioned<8>(p, lds, CTL_QUEUE_I2, BT / 256, [&](int part, int it) { peer_u_chunk(p, part, it, lds); });
}
typedef int i32x2_t __attribute__((ext_vector_type(2)));
constexpr int VW_BYTES = 9504, VW_PAIRS = 8192, VW_HI = 9216, VW_LO = 9344, VW_ZERO = 9472;
DI void peer_v_chunk(const Params& p, int p8, int chunk, unsigned char* lds) {
    const int tid = get_tid(), lane = tid & 63, wave = __builtin_amdgcn_readfirstlane(tid >> 6);
    unsigned char* wl = lds + wave * VW_BYTES;
    const int slice = p8 & 3;
    const unsigned char* VT4 = p.ws + WS_VTAB + (size_t)slice * 16384 * 128;
    const float* mod = (const float*)(p.ws + WS_MOD);
    const int er = lane >> 3, pc = lane & 7;
    const int n = lane & 31, kg = lane >> 5;
    const int col = slice * 256 + 8 * n;
    const int tokw = (p8 >> 2) * 16384 + chunk * 256 + wave;
    if (lane < 4) ((unsigned*)(wl + VW_ZERO))[lane] = 0u;
    const unsigned char* abase = wl + ((n == 0) ? VW_HI + 16 * kg : (n == 1) ? VW_LO + 16 * kg : VW_ZERO);
    const int astep = (n < 2) ? 1 : 0;
    const int row0 = 32 * kg + (lane & 15), sw0 = (row0 >> 1) & 7;
    const unsigned char* tb0 = wl + row0 * 128 + 8 * ((lane >> 4) & 1);
    u32x4 pp = *((const u32x4*)(p.ws + WS_PAIRS + (size_t)tokw * 1024) + lane);
#pragma unroll 1
    for (int step = 0; step < 16; ++step) {
        const int tok = tokw + step * 16, b = tok >> 12;
        *(u32x4*)(wl + VW_PAIRS + lane * 16) = pp;
        const float w0 = __uint_as_float(pp[1]), w1 = __uint_as_float(pp[3]);
        const float mx = fmaxf(wave_max(fmaxf(fabsf(w0), fabsf(w1))), 1e-30f);
        const float ws = 224.f / mx;
        const int hi = __builtin_amdgcn_cvt_pk_fp8_f32(w0 * ws, w1 * ws, 0, false);
        const f32x2 dq = __builtin_amdgcn_cvt_pk_f32_fp8(hi, false);
        const int lo = __builtin_amdgcn_cvt_pk_fp8_f32((w0 * ws - dq[0]) * 16.f, (w1 * ws - dq[1]) * 16.f, 0, false);
        ((unsigned short*)(wl + VW_HI))[lane] = (unsigned short)hi;
        ((unsigned short*)(wl + VW_LO))[lane] = (unsigned short)lo;
        if (step + 1 < 16) pp = *((const u32x4*)(p.ws + WS_PAIRS + (size_t)(tok + 16) * 1024) + lane);
        bf16_t* xo = (bf16_t*)(p.out + (size_t)tok * DM) + col;
        const u32x4 x1w = *(const u32x4*)xo;
        const f32x4 g2a = *(const f32x4*)(mod + b * 6144 + 5120 + col), g2b = *(const f32x4*)(mod + b * 6144 + 5120 + col + 4);
        float res[8];
#pragma unroll
        for (int i = 0; i < 8; ++i) res[i] = 0.f;
#pragma unroll 1
        for (int hf = 0; hf < 2; ++hf) {
            asm volatile("s_waitcnt lgkmcnt(0)" ::: "memory");
            __builtin_amdgcn_sched_barrier(0);
            const unsigned* pr = (const unsigned*)(wl + VW_PAIRS) + 2 * (64 * hf + er);
#pragma unroll
            for (int q = 0; q < 8; ++q) {
                const unsigned e = pr[16 * q];
                const int sw = (4 * q + (er >> 1)) & 7;
                __builtin_amdgcn_global_load_lds((const unsigned*)(VT4 + (size_t)e * 128 + ((pc ^ sw) << 4)), (unsigned*)(wl + q * 1024), 16, 0, 0);
            }
            const u32x4 a0 = *(const u32x4*)(abase + astep * (64 * hf)), a1 = *(const u32x4*)(abase + astep * (64 * hf + 32));
            const i32x8 av = i32x8{(int)a0[0], (int)a0[1], (int)a0[2], (int)a0[3], (int)a1[0], (int)a1[1], (int)a1[2], (int)a1[3]};
            asm volatile("s_waitcnt vmcnt(0)" ::: "memory");
            __builtin_amdgcn_sched_barrier(0);
#pragma unroll
            for (int nt = 0; nt < 8; ++nt) {
                const int c = (nt ^ sw0) << 4;
                const i32x2_t b0 = __builtin_amdgcn_ds_read_tr4_b64_v2i32((LAS i32x2_t*)(LAS unsigned char*)(tb0 + c));
                const i32x2_t b1 = __builtin_amdgcn_ds_read_tr4_b64_v2i32((LAS i32x2_t*)(LAS unsigned char*)(tb0 + 16 * 128 + c));
                const i32x8 bv = i32x8{b0[0], b0[1], b1[0], b1[1], 0, 0, 0, 0};
                f32x16 z;
#pragma unroll
                for (int i = 0; i < 16; ++i) z[i] = 0.f;
                const f32x16 d = __builtin_amdgcn_mfma_scale_f32_32x32x64_f8f6f4(av, bv, z, 0, 4, 0, 0x7F7F7F7F, 0, 0x7F7F7F7F);
                res[nt] += d[0] + d[1] * (1.f / 16.f);
            }
        }
        const float iw = mx * (1.f / 224.f);
        float xv[8];
#pragma unroll
        for (int i = 0; i < 4; ++i) { xv[2 * i] = bflo(x1w[i]); xv[2 * i + 1] = bfhi(x1w[i]); }
        float ss = 0.f;
#pragma unroll
        for (int i = 0; i < 8; ++i) { xv[i] += (i < 4 ? g2a[i & 3] : g2b[i & 3]) * (res[i] * iw); ss += xv[i] * xv[i]; }
        if (lane < 32) *(u32x4*)xo = u32x4{pk2(xv[0], xv[1]), pk2(xv[2], xv[3]), pk2(xv[4], xv[5]), pk2(xv[6], xv[7])};
        ss = wave_sum(lane < 32 ? ss : 0.f);
        if (lane == 0) ((float*)(p.ws + WS_SSQ))[(size_t)tok * 8 + slice] = ss;
    }
}
DI void phase_i3(const Params& p, unsigned char* lds) {
    run_partitioned<8>(p, lds, CTL_QUEUE_I3, 16384 / 256, [&](int part, int it) { peer_v_chunk(p, part, it, lds); });
}
DI void phase_i4(const Params& p) {
    const bool bad = xb_ld((unsigned*)(p.ws + WS_CTL) + CTL_BADTID) != 0u || xb_ld((unsigned*)(p.ws + WS_CTL) + XB_TMO) != 0u;
    for (int it = blockIdx.x; it < BT / 16; it += gridDim.x) {
        const int tid = get_tid(), lane = tid & 63, row = it * 16 + (tid >> 6);
        const float* sq = (const float*)(p.ws + WS_SSQ) + (size_t)row * 8;
        const f32x4 s0 = *(const f32x4*)sq;
        const float ss = s0[0] + s0[1] + s0[2] + s0[3];
        float rs = rsqrtf(ss * (1.f / DM) + EPS);
        if (bad) rs = __builtin_nanf("");
        float* o = p.out + (size_t)row * DM;
        u32x2 xw[4];
#pragma unroll
        for (int j = 0; j < 4; ++j) xw[j] = *(const u32x2*)((const bf16_t*)o + j * 256 + lane * 4);
        asm volatile("s_waitcnt vmcnt(0)" ::: "memory");
#pragma unroll
        for (int j = 0; j < 4; ++j) {
            const int c = j * 256 + lane * 4;
            const f32x4 g = *(const f32x4*)(p.in[I_FNG] + c);
            *(f32x4*)(o + c) = f32x4{bflo(xw[j][0]) * rs * g[0], bfhi(xw[j][0]) * rs * g[1], bflo(xw[j][1]) * rs * g[2], bfhi(xw[j][1]) * rs * g[3]};
        }
    }
}

DI float probe_mfma_mixed() {
    const int lane = get_tid() & 63, kg = lane >> 4;
    int aw[8];
#pragma unroll
    for (int v = 0; v < 8; ++v) {
        unsigned w = 0;
#pragma unroll
        for (int b = 0; b < 4; ++b) { const unsigned q = 32u * kg + 4u * v + b; w |= (((q & 63u) + 8u) | ((q >> 6) << 7)) << (8 * b); }
        aw[v] = (int)w;
    }
    const i32x8 av = i32x8{aw[0], aw[1], aw[2], aw[3], aw[4], aw[5], aw[6], aw[7]};
    int c1 = 0, c2 = 0, c4 = 0, c5 = 0; unsigned pi1 = 255;
#pragma unroll 1
    for (int pb = 0; pb < 128; ++pb) {
        const int kgB = pb >> 5, i0 = pb & 31;
        const unsigned hot = (kg == kgB) ? (2u << (4 * (i0 & 7))) : 0u;
        const i32x8 bv = i32x8{(i0 >> 3) == 0 ? (int)hot : 0, (i0 >> 3) == 1 ? (int)hot : 0, (i0 >> 3) == 2 ? (int)hot : 0, (i0 >> 3) == 3 ? (int)hot : 0, 0, 0, 0, 0};
        const f32x4 z = f32x4{0.f, 0.f, 0.f, 0.f};
        const f32x4 dd = __builtin_amdgcn_mfma_scale_f32_16x16x128_f8f6f4(av, bv, z, 0, 4, 0, 0x7F7F7F7F, 0, 0x7F7F7F7F);
        const float d = dd[0];
        unsigned qf = 255;
#pragma unroll 1
        for (unsigned q = 0; q < 128; ++q) { const unsigned byte = ((q & 63u) + 8u) | ((q >> 6) << 7); if (__builtin_amdgcn_cvt_f32_fp8((int)byte, 0) == d) qf = q; }
        c1 += (qf != (unsigned)pb); c2 += (qf != (unsigned)(pb ^ 1));
        { const unsigned k = 64u * (i0 >> 4) + 16u * kgB + (i0 & 15); c4 += (qf != k); }
        { const unsigned k = (unsigned)pb, kgA = (k & 63u) >> 4, j = 16u * (k >> 6) + (k & 15u); c5 += (qf != 32u * kgA + j); }
        if (pb == 1) pi1 = qf;
    }
    return c1 == 0 ? 1.1e6f : c2 == 0 ? 2.2e6f : c4 == 0 ? 4.4e6f : c5 == 0 ? 5.5e6f : (pi1 < 90u ? (10.f + (float)pi1) * 100.f : 7.7e6f);
}

__global__ void __launch_bounds__(NT) mega(Params p) {
    unsigned char* lds = g_lds;
    volatile LAS unsigned* st = (volatile LAS unsigned*)(LAS unsigned char*)(lds + LDS_ST_OFF);
    {
        const unsigned hw = __builtin_amdgcn_s_getreg((5 << 11) | 4);
        if ((threadIdx.x & 63) == 0) g_lds[LDS_WTAB_OFF + hw] = (unsigned char)(threadIdx.x >> 6);
        if (threadIdx.x < 2) st[threadIdx.x] = 0u;
        __syncthreads();
        if (get_tid() != (int)threadIdx.x) ((unsigned*)(p.ws + WS_CTL))[CTL_BADTID] = 1u;
    }
    XcdBarrier bar = xcd_barrier_post((unsigned*)(p.ws + WS_CTL), st);
    float* sm = (float*)lds;

#define STAMP(k, which) do { if (PROBE_PHASE == (k) && blockIdx.x == 0 && get_tid() == 0) ((volatile unsigned long long*)(lds + LDS_PROBE_OFF))[which] = __builtin_amdgcn_s_memrealtime(); } while (0)
    STAMP(21, 0); STAMP(30, 0); STAMP(31, 0);
    STAMP(0, 0); phase_a(p, sm);   xcd_barrier(bar); STAMP(0, 1);
    STAMP(1, 0); phase_b(p, sm);   xcd_barrier(bar); STAMP(1, 1);
    if (PROBE_PHASE == 20) { STAMP(20, 0); xcd_barrier(bar); xcd_barrier(bar); xcd_barrier(bar); xcd_barrier(bar); STAMP(20, 1); }
    STAMP(2, 0); phase_c(p, lds);  xcd_barrier(bar); STAMP(2, 1);
    STAMP(3, 0); phase_d(p, lds);  xcd_barrier(bar); STAMP(3, 1);
    STAMP(5, 0); phase_e(p, lds);  xcd_barrier(bar); STAMP(5, 1);
    STAMP(6, 0); phase_f(p, lds);  xcd_barrier(bar); STAMP(6, 1);
    STAMP(8, 0); phase_h(p, lds);  xcd_barrier(bar); STAMP(8, 1);
    STAMP(10, 0); phase_i2(p, lds); xcd_barrier(bar); STAMP(10, 1);
    STAMP(11, 0); phase_i3(p, lds); xcd_barrier(bar); STAMP(11, 1);
    STAMP(12, 0); phase_i4(p);
    float pm = 0.f;
    if (PROBE_PHASE == 40 && blockIdx.x == 0 && get_tid() < 64) pm = probe_mfma_mixed();
    if (PROBE_PHASE >= 0) {
        xcd_barrier(bar); STAMP(12, 1); STAMP(21, 1);
        if (blockIdx.x == 0 && get_tid() == 0) {
            volatile unsigned long long* ts = (volatile unsigned long long*)(lds + LDS_PROBE_OFF);
            if (PROBE_PHASE == 40) p.out[0] += pm; else
            p.out[0] += (float)(ts[1] - ts[0]) * (0.01f / PROBE_SCALE);
        }
    }
}

extern "C" void kernel_launch(void* const* d_in, const int* in_sizes, int n_in, void* d_out, int out_size, void* d_ws, size_t ws_size, hipStream_t stream) {
    static int grid = 0;
    if (grid == 0) {
        int dev = 0, cus = 0;
        if (hipGetDevice(&dev) != hipSuccess || hipDeviceGetAttribute(&cus, hipDeviceAttributeMultiprocessorCount, dev) != hipSuccess) { fprintf(stderr, "kernel_launch: device query failed\n"); grid = -1; return; }
        if (n_in != N_IN || ws_size < WS_END) { fprintf(stderr, "kernel_launch: unexpected n_in %d or ws_size %zu (< %zu)\n", n_in, ws_size, (size_t)WS_END); grid = -1; return; }
        grid = cus;
    }
    if (grid < 0) return;
    (void)hipMemsetAsync((char*)d_ws + WS_CTL, 0, 64 * 1024, stream);
    Params p{};
    for (int i = 0; i < N_IN; ++i) p.in[i] = (const float*)d_in[i];
    p.out = (float*)d_out; p.ws = (unsigned char*)d_ws;
    hipLaunchKernelGGL(mega, dim3(grid), dim3(NT), 0, stream, p);
}
```

```cpp
#include <hip/hip_runtime.h>
#include <stdint.h>
#include <cstdio>

#define DI __device__ __forceinline__
#define LAS __attribute__((address_space(3)))
typedef unsigned short bf16_t;
typedef short bf16x8 __attribute__((ext_vector_type(8)));
typedef short s16x4 __attribute__((ext_vector_type(4)));
typedef float f32x4 __attribute__((ext_vector_type(4)));
typedef float f32x2 __attribute__((ext_vector_type(2)));
typedef float f32x16 __attribute__((ext_vector_type(16)));
typedef unsigned u32x4 __attribute__((ext_vector_type(4)));
typedef unsigned u32x2 __attribute__((ext_vector_type(2)));

#ifndef PROBE_PHASE
#define PROBE_PHASE (-1)
#endif
#ifndef SHADOW
#define SHADOW 0
#endif
#ifndef PROBE_SCALE
#define PROBE_SCALE 100.f
#endif
constexpr int BATCH = 8, SEQ = 4096, DM = 1024, BT = BATCH * SEQ;
constexpr int CTX = 256, TK = SEQ + CTX;
constexpr int NH = 8, NKV = 2, HD = 64;
constexpr int QD = 512, KVD = 128, HYD = 512, HYC = 1536, GC = 2048, INC = 4352;
constexpr int PH = 8, PNK = 128, PDK = 256, PTOP = 16;
constexpr float EPS = 1e-6f;
constexpr int NT = 1024;

enum { I_X = 0, I_C, I_CTX, I_CCTX, I_ADAW, I_ADAB, I_NMIX, I_NFFN, I_WIN, I_QNG, I_KNG, I_HCW, I_HCB,
       I_HW1, I_HB1, I_HW2, I_HB2, I_HW3, I_HB3, I_HW4, I_HFREQ, I_HSKIP, I_WAO, I_WHO, I_WO, I_PWQ, I_PK1, I_PK2, I_PU, I_PV, I_FNG, N_IN };

constexpr size_t MB = 1024 * 1024;
constexpr size_t WS_CTL   = 0;
constexpr size_t WS_MOD   = 64 * 1024;
constexpr size_t WS_ROPE  = WS_MOD + 9 * 6144 * 4;
static_assert(WS_ROPE + 16 * 1024 + 8 * 2048 * 4 + 4096 <= 512 * 1024, "ws");
constexpr size_t WS_PART  = 512 * 1024;
constexpr size_t WS_WTIN  = 3 * MB;
constexpr size_t WS_WTAO  = WS_WTIN + (size_t)INC * DM * 2;
constexpr size_t WS_WTHO  = WS_WTAO + (size_t)DM * QD * 2;
constexpr size_t WS_WTO   = WS_WTHO + (size_t)DM * HYD * 2;
constexpr size_t WS_WTQ   = WS_WTO + (size_t)DM * DM * 2;
constexpr size_t WS_KEYS  = WS_WTQ + (size_t)2048 * DM * 2;
constexpr size_t WS_R     = WS_KEYS + (size_t)2 * 8 * 128 * 128 * 2;
constexpr size_t WS_KB    = WS_R + (size_t)2 * 512 * 8192 * 2;
constexpr size_t WS_VT    = WS_KB + (size_t)BATCH * NKV * TK * HD * 2;
constexpr size_t WS_HC    = WS_VT + (size_t)BATCH * NKV * TK * HD * 2;
constexpr size_t WS_H     = 60 * MB;
constexpr size_t WS_G     = WS_H + 64 * MB;
constexpr size_t WS_ZT    = WS_G + 128 * MB;
constexpr size_t WS_Q     = WS_ZT + 96 * MB;
constexpr size_t WS_ATT   = WS_Q + 32 * MB;
constexpr size_t WS_HYT   = WS_ATT + 32 * MB;
constexpr size_t WS_TAB   = WS_HYT + 32 * MB;
constexpr size_t WS_END   = WS_TAB + 32 * MB;
static_assert(WS_HC + (size_t)2048 * DM * 2 <= WS_H, "ws overlap");
constexpr size_t WS_FRAW  = WS_ATT;
constexpr size_t WS_HY    = WS_Q;
constexpr size_t WS_UT    = WS_TAB;
constexpr size_t WS_VTAB  = WS_TAB + 16 * MB;
constexpr size_t WS_H8    = WS_ATT;
constexpr size_t WS_W8G   = WS_HYT;
constexpr size_t WS_EXPI  = WS_ATT;
constexpr size_t WS_GATE  = WS_Q;
constexpr size_t WS_PAIRS = WS_HYT;
constexpr size_t WS_SSQ   = WS_PART + 1 * MB;
constexpr size_t WS_USC   = WS_PART + 2 * MB + 320 * 1024;
constexpr size_t WS_Y     = WS_ZT;
constexpr size_t WS_X8    = WS_ZT + 64 * MB;
constexpr size_t WS_SSQ1  = WS_ATT + 16 * MB;
constexpr size_t WS_SX    = WS_PART + 2 * MB + 64 * 1024;
constexpr size_t WS_SHQ   = WS_ROPE + 16 * 1024;
constexpr size_t WS_FSC   = WS_SHQ + 64 * 1024;
constexpr float VSCALE = 64.f;
constexpr float MG_SCALE = 16.f;
constexpr size_t WS_W8O   = WS_R + 8 * MB;
constexpr float W8_SCALE = 64.f;
constexpr float VT_SCALE = 16.f;
constexpr float X8_MAX = 192.f;

constexpr int CTL_BADTID = 8000;
DI unsigned f2bf(float f) { unsigned u = __builtin_bit_cast(unsigned, f); return (u + 0x7fffu + ((u >> 16) & 1u)) >> 16; }
DI unsigned pk2(float lo, float hi) { return f2bf(lo) | (f2bf(hi) << 16); }
DI float bf2f(unsigned short b) { return __builtin_bit_cast(float, (unsigned)b << 16); }
DI float bflo(unsigned u) { return __builtin_bit_cast(float, u << 16); }
DI float bfhi(unsigned u) { return __builtin_bit_cast(float, u & 0xffff0000u); }
DI float red2pi(float x) { const float k = rintf(x * 0.15915494309189535f); float r = fmaf(-k, 6.2831854820251465f, x); return fmaf(-k, -1.7484555e-7f, r); }
DI float fsin(float x) { return __sinf(red2pi(x)); }
DI float fcos(float x) { return __cosf(red2pi(x)); }
constexpr int LDS_BYTES = 160 * 1024;
constexpr int LDS_ST_OFF = LDS_BYTES - 16;
constexpr int LDS_PROBE_OFF = LDS_BYTES - 16 - 32;
constexpr int LDS_WTAB_OFF = LDS_BYTES - 16 - 32 - 64;
constexpr int LDS_USER = LDS_WTAB_OFF;
__shared__ __attribute__((aligned(16))) unsigned char g_lds[LDS_BYTES];
DI s16x4 lds_rd64(const unsigned char* ptr) { return *(const volatile LAS s16x4*)(const LAS unsigned char*)ptr; }
DI int get_tid() {
    const unsigned hw = __builtin_amdgcn_s_getreg((5 << 11) | 4);
    unsigned w = g_lds[LDS_WTAB_OFF + hw];
    w = __builtin_amdgcn_readfirstlane(w);
    int t;
    asm volatile("v_mbcnt_lo_u32_b32 %0, -1, 0\n\tv_mbcnt_hi_u32_b32 %0, -1, %0\n\tv_lshl_or_b32 %0, %1, 6, %0" : "=&v"(t) : "s"(w));
    return t;
}
template<int CTRL> DI float dppf(float v) { return __uint_as_float(__builtin_amdgcn_update_dpp(0u, __float_as_uint(v), CTRL, 0xF, 0xF, true)); }
template<int CTRL> DI int dppi(int v) { return (int)__builtin_amdgcn_update_dpp(0u, (unsigned)v, CTRL, 0xF, 0xF, true); }
DI float sum16(float v) { v += dppf<0xB1>(v); v += dppf<0x4E>(v); v += dppf<0x141>(v); v += dppf<0x140>(v); return v; }
DI float sum_x16(float v) { auto r = __builtin_amdgcn_permlane16_swap(__float_as_uint(v), __float_as_uint(v), false, false); return __uint_as_float(r[0]) + __uint_as_float(r[1]); }
DI float sum_x32(float v) { auto r = __builtin_amdgcn_permlane32_swap(__float_as_uint(v), __float_as_uint(v), false, false); return __uint_as_float(r[0]) + __uint_as_float(r[1]); }
DI float max_x32(float v) { auto r = __builtin_amdgcn_permlane32_swap(__float_as_uint(v), __float_as_uint(v), false, false); return fmaxf(__uint_as_float(r[0]), __uint_as_float(r[1])); }
DI float wave_sum(float v) { return sum_x32(sum_x16(sum16(v))); }
DI float wave_max(float v) {
    v = fmaxf(v, dppf<0xB1>(v)); v = fmaxf(v, dppf<0x4E>(v)); v = fmaxf(v, dppf<0x141>(v)); v = fmaxf(v, dppf<0x140>(v));
    { auto r = __builtin_amdgcn_permlane16_swap(__float_as_uint(v), __float_as_uint(v), false, false); v = fmaxf(__uint_as_float(r[0]), __uint_as_float(r[1])); }
    { auto r = __builtin_amdgcn_permlane32_swap(__float_as_uint(v), __float_as_uint(v), false, false); v = fmaxf(__uint_as_float(r[0]), __uint_as_float(r[1])); }
    return v;
}


#define XB_TMO      128
#define XB_XCNT(j)  (256  + 64 * (j))
#define XB_XSUB(j)  (1280 + 64 * (j))
#define XB_XGEN(j)  (2304 + 64 * (j))
#define XB_TOP      3328
#define XB_TOPGEN   3392
#define XCD_BAR_WORDS 3456
#define XB_SPIN_CAP (1u << 27)
DI unsigned xb_ld(unsigned* p)              { return __hip_atomic_load(p, __ATOMIC_RELAXED, __HIP_MEMORY_SCOPE_AGENT); }
DI unsigned xb_add(unsigned* p, unsigned v) { return __hip_atomic_fetch_add(p, v, __ATOMIC_RELAXED, __HIP_MEMORY_SCOPE_AGENT); }
DI unsigned xb_xcc_id() { return (unsigned)__builtin_amdgcn_s_getreg((3 << 11) | 20) & 0xFu; }
#define XB_SPIN(cond, bar) do { unsigned _sp = 0; while (cond) { __builtin_amdgcn_s_sleep(1); \
    if ((++_sp & 255u) == 0u) { if (xb_ld(&(bar)[XB_TMO])) break; if (_sp > XB_SPIN_CAP) { atomicAdd(&(bar)[XB_TMO], 1u); break; } } } } while (0)
struct XcdBarrier { unsigned* bar; unsigned x; volatile LAS unsigned* st; };
DI XcdBarrier xcd_barrier_post(unsigned* bar, volatile LAS unsigned* st) {
    XcdBarrier b; b.bar = bar; b.x = xb_xcc_id(); b.st = st;
    if (get_tid() == 0) (void)xb_add(&bar[XB_XCNT(b.x)], 1u);
    return b;
}
DI void xcd_barrier_complete(unsigned* bar, unsigned x, unsigned& nloc, unsigned& nx) {
    const unsigned G = gridDim.x * gridDim.y * gridDim.z;
    unsigned sum, cnt, mine, sp = 0u;
    for (;;) {
        sum = 0u; cnt = 0u; mine = 0u;
#pragma unroll
        for (unsigned j = 0; j < 16; ++j) { const unsigned c = xb_ld(&bar[XB_XCNT(j)]); sum += c; cnt += (c > 0u) ? 1u : 0u; mine = (j == x) ? c : mine; }
        if (sum == G) break;
        __builtin_amdgcn_s_sleep(1);
        if ((++sp & 255u) == 0u) { if (xb_ld(&bar[XB_TMO])) break; if (sp > XB_SPIN_CAP) { atomicAdd(&bar[XB_TMO], 1u); break; } }
    }
    nloc = mine > 0u ? mine : 1u; nx = cnt > 0u ? cnt : 1u;
}
DI void xcd_barrier(const XcdBarrier& b) {
    asm volatile("s_waitcnt vmcnt(0)" ::: "memory");
    __syncthreads();
    if (get_tid() == 0) {
        unsigned* bar = b.bar;
        __builtin_amdgcn_s_waitcnt(0);
        unsigned nloc = b.st[0], nx = b.st[1];
        if (nloc == 0u) { xcd_barrier_complete(bar, b.x, nloc, nx); b.st[0] = nloc; b.st[1] = nx; }
        const unsigned old = xb_add(&bar[XB_XSUB(b.x)], 1u);
        const unsigned gen = old / nloc;
        if (old + 1u == (gen + 1u) * nloc) {
            __builtin_amdgcn_fence(__ATOMIC_RELEASE, "agent");
            asm volatile("s_waitcnt vmcnt(0)" ::: "memory");
            const unsigned og = xb_add(&bar[XB_TOP], 1u);
            const unsigned tg = og / nx;
            if (og + 1u == (tg + 1u) * nx) xb_add(&bar[XB_TOPGEN], 1u);
            else XB_SPIN(xb_ld(&bar[XB_TOPGEN]) == tg, bar);
            __builtin_amdgcn_fence(__ATOMIC_ACQUIRE, "agent");
            xb_add(&bar[XB_XGEN(b.x)], 1u);
            asm volatile("s_waitcnt vmcnt(0)" ::: "memory");
        } else {
            XB_SPIN(xb_ld(&bar[XB_XGEN(b.x)]) == gen, bar);
            __builtin_amdgcn_fence(__ATOMIC_ACQUIRE, "agent");
            asm volatile("s_waitcnt vmcnt(0)" ::: "memory");
        }
    }
    __syncthreads();
}

struct Params { const float* in[N_IN]; float* out; unsigned char* ws; };


DI void transpose_tile(const float* __restrict__ W, int K, int N, bf16_t* __restrict__ Wt, int tile, float* sm) {
    const int tid = get_tid();
    const int ntn = N / 256, tk = tile / ntn, tn = tile % ntn;
    __syncthreads();
#pragma unroll
    for (int i = 0; i < 4; ++i) {
        const int idx = tid + i * NT, kk = idx >> 6, n4 = (idx & 63) * 4;
        const f32x4 v = *(const f32x4*)(W + (size_t)(tk * 64 + kk) * N + tn * 256 + n4);
        float* d = sm + kk * 257 + n4;
        d[0] = v[0]; d[1] = v[1]; d[2] = v[2]; d[3] = v[3];
    }
    __syncthreads();
#pragma unroll
    for (int i = 0; i < 2; ++i) {
        const int idx = tid + i * NT, nn = idx & 255, kg = idx >> 8;
        const float* c = sm + kg * 8 * 257 + nn;
        *(u32x4*)(Wt + (size_t)(tn * 256 + nn) * K + tk * 64 + kg * 8) = u32x4{pk2(c[0], c[257]), pk2(c[2 * 257], c[3 * 257]), pk2(c[4 * 257], c[5 * 257]), pk2(c[6 * 257], c[7 * 257])};
    }
}

DI void mod_item(const Params& p, int item, float* sm) {
    const int tid = get_tid();
    float* sc = sm;
    float* red = sm + 9 * 1024;
    __syncthreads();
    for (int i = tid; i < 9 * 1024; i += NT) {
        const float v = (i < 8 * 1024) ? p.in[I_C][i] : p.in[I_CCTX][i - 8 * 1024];
        sc[i] = v / (1.f + __expf(-v));
    }
    __syncthreads();
    const int col = tid & 15, kg = tid >> 4, n0 = item * 16;
    float acc[9];
#pragma unroll
    for (int r = 0; r < 9; ++r) acc[r] = 0.f;
    const float* w = p.in[I_ADAW] + (size_t)kg * 16 * 6144 + n0 + col;
    float wv[16];
#pragma unroll
    for (int k = 0; k < 16; ++k) wv[k] = w[(size_t)k * 6144];
#pragma unroll
    for (int k = 0; k < 16; ++k)
#pragma unroll
        for (int r = 0; r < 9; ++r) acc[r] += sc[r * 1024 + kg * 16 + k] * wv[k];
#pragma unroll
    for (int r = 0; r < 9; ++r) red[(kg * 9 + r) * 16 + col] = acc[r];
    __syncthreads();
    if (tid < 9 * 16) {
        const int r = tid >> 4, c2 = tid & 15;
        float s = p.in[I_ADAB][n0 + c2];
        for (int g = 0; g < 64; ++g) s += red[(g * 9 + r) * 16 + c2];
        ((float*)(p.ws + WS_MOD))[r * 6144 + n0 + c2] = s;
    }
    __syncthreads();
}

DI void filter_item(const Params& p, int item, float* sm) {
    const int tid = get_tid();
    float* z  = sm;
    float* ha = sm + 16 * 36;
    float* hb = ha + 16 * 64;
    const int t0 = item * 16;
    float* w1s = hb + 16 * 64;
    float* w2s = w1s + 33 * 64;
    float* w3s = w2s + 64 * 64;
    __syncthreads();
    {
        const f32x4 a2 = *(const f32x4*)(p.in[I_HW2] + tid * 4), a3 = *(const f32x4*)(p.in[I_HW3] + tid * 4);
        f32x4 a1 = f32x4{0.f, 0.f, 0.f, 0.f};
        if (tid < 33 * 16) a1 = *(const f32x4*)(p.in[I_HW1] + tid * 4);
        *(f32x4*)(w2s + tid * 4) = a2; *(f32x4*)(w3s + tid * 4) = a3;
        if (tid < 33 * 16) *(f32x4*)(w1s + tid * 4) = a1;
    }
    if (tid < 16 * 33) {
        const int pp = tid / 33, i = tid % 33;
        const int t = t0 + pp;
        float v;
        if (i == 0) v = (float)t / (float)(SEQ - 1);
        else {
            const int fi = (i - 1) & 15;
            const float f = 1e-4f + (float)fi * ((15.f - 1e-4f) / 15.f);
            const float w = 6.283185307179586f * (float)t / (float)SEQ;
            const float a = f * w;
            v = (i <= 16) ? fcos(a) : -fsin(a);
        }
        z[pp * 36 + i] = v;
    }
    __syncthreads();
    const int pp = tid >> 6, j = tid & 63;
    const float fr = p.in[I_HFREQ][j];
    {
        float a = p.in[I_HB1][j];
#pragma unroll 11
        for (int i = 0; i < 33; ++i) a += z[pp * 36 + i] * w1s[i * 64 + j];
        ha[pp * 64 + j] = fsin(fr * a);
    }
    __syncthreads();
    {
        float a = p.in[I_HB2][j];
#pragma unroll 16
        for (int i = 0; i < 64; ++i) a += ha[pp * 64 + i] * w2s[i * 64 + j];
        hb[pp * 64 + j] = fsin(fr * a);
    }
    __syncthreads();
    {
        float a = p.in[I_HB3][j];
#pragma unroll 16
        for (int i = 0; i < 64; ++i) a += hb[pp * 64 + i] * w3s[i * 64 + j];
        __syncthreads();
        ha[pp * 64 + j] = fsin(fr * a);
    }
    __syncthreads();
    float* fraw = (float*)(p.ws + WS_FRAW);
    float* part = (float*)(p.ws + WS_PART);
    const float* w4 = p.in[I_HW4];
    {
        const int lane = tid & 63, wave = tid >> 6, l15 = lane & 15, lk = lane >> 4;
        float af[16];
#pragma unroll
        for (int ks = 0; ks < 16; ++ks) af[ks] = ha[l15 * 64 + ks * 4 + lk];
        const float mind = -3.0701134573253945f, maxd = -15.350567286626973f;
        const unsigned wvo = (unsigned)((lk * 2048 + wave * 128 + 4 * l15) * 4);
        f32x4 bw[16];
#pragma unroll
        for (int ks = 0; ks < 16; ++ks) { const char* bk = (const char*)w4 + (size_t)ks * 32768; asm volatile("" : "+s"(bk)); bw[ks] = *(const f32x4*)(bk + wvo); }
#pragma unroll 1
        for (int g = 0; g < 2; ++g) {
            f32x4 acc[4];
#pragma unroll
            for (int u = 0; u < 4; ++u) acc[u] = f32x4{0.f, 0.f, 0.f, 0.f};
#pragma unroll
            for (int ks = 0; ks < 16; ++ks) {
#pragma unroll
                for (int u = 0; u < 4; ++u) acc[u] = __builtin_amdgcn_mfma_f32_16x16x4f32(af[ks], bw[ks][u], acc[u], 0, 0, 0);
                if (g == 0) { const char* bk = (const char*)w4 + (size_t)ks * 32768 + 256; asm volatile("" : "+s"(bk)); bw[ks] = *(const f32x4*)(bk + wvo); }
            }
#pragma unroll
            for (int u = 0; u < 4; ++u) {
                const int col = wave * 128 + 64 * g + 4 * l15 + u;
                const int c = col & 511, dir = (col >> 9) & 1;
                const float delta = fabsf(mind + (float)c * ((maxd - mind) / 511.f));
                float sabs = 0.f, v[4];
#pragma unroll
                for (int r = 0; r < 4; ++r) {
                    const int t = t0 + 4 * lk + r;
                    const float t01 = (float)t / (float)(SEQ - 1);
                    v[r] = acc[u][r] * expf(-t01 * delta);
                    if (!(dir == 1 && t == 0)) sabs += fabsf(v[r]);
                }
                *(f32x4*)(fraw + (size_t)col * SEQ + t0 + 4 * lk) = f32x4{v[0], v[1], v[2], v[3]};
                sabs = sum_x32(sum_x16(sabs));
                if (lk == 0) part[item * 2048 + col] = sabs;
            }
        }
    }
    __syncthreads();
}

DI void phase_a(const Params& p, float* sm) {
    constexpr int T_WIN = 16 * 17, T_AO = 8 * 4, T_HO = 8 * 4, T_WO = 16 * 4, T_WQ = 16 * 8;
    constexpr int E0 = T_WIN, E1 = E0 + T_AO, E2 = E1 + T_HO, E3 = E2 + T_WO, E4 = E3 + T_WQ;
    constexpr int E5 = E4 + 64;
    constexpr int E6 = E5 + 384;
    constexpr int E7 = E6 + 1;
    constexpr int E8 = E7 + 256;
    for (int it = blockIdx.x; it < E8; it += gridDim.x) {
        int item = it;
        if (item < 256) { filter_item(p, item, sm); if (PROBE_PHASE == 30 && blockIdx.x == 0 && get_tid() == 0) ((volatile unsigned long long*)(g_lds + LDS_PROBE_OFF))[1] = __builtin_amdgcn_s_memrealtime(); continue; }
        item -= 256;
        if (item < 384) { mod_item(p, item, sm); if (PROBE_PHASE == 31 && blockIdx.x == 0 && get_tid() == 0) ((volatile unsigned long long*)(g_lds + LDS_PROBE_OFF))[1] = __builtin_amdgcn_s_memrealtime(); continue; }
        item -= 384;
        if (item < 1) {
            const int tid = get_tid();
            float* rope = (float*)(p.ws + WS_ROPE);
            const int pos = tid >> 4, f = tid & 15;
            const float inv = powf(10000.f, -(float)(2 * f) / 32.f);
            const float ang = (float)pos * inv;
            rope[tid] = fcos(ang); rope[1024 + tid] = fsin(ang);
            continue;
        }
        item -= 1;
        if (item < 64) {
            const int tid = get_tid();
            const float* src = (item < 32) ? p.in[I_PK1] : p.in[I_PK2];
            const f32x4 v = *(const f32x4*)(src + (size_t)(item & 31) * 4096 + tid * 4);
            const int e = tid * 4, kr = e >> 7, dim = e & 127;
            bf16_t* dst = (bf16_t*)(p.ws + WS_KEYS) + ((size_t)(item * 8 + (dim >> 4)) * 64 + ((dim >> 3) & 1) * 32 + kr) * 8 + (dim & 7);
            *(u32x2*)dst = u32x2{pk2(v[0], v[1]), pk2(v[2], v[3])};
            continue;
        }
        item -= 64;
        if (item < T_WIN) { transpose_tile(p.in[I_WIN], DM, INC, (bf16_t*)(p.ws + WS_WTIN), item, sm); continue; }
        item -= T_WIN;
        if (item < T_AO) { transpose_tile(p.in[I_WAO], QD, DM, (bf16_t*)(p.ws + WS_WTAO), item, sm); continue; }
        item -= T_AO;
        if (item < T_HO) { transpose_tile(p.in[I_WHO], HYD, DM, (bf16_t*)(p.ws + WS_WTHO), item, sm); continue; }
        item -= T_HO;
        if (item < T_WO) { transpose_tile(p.in[I_WO], DM, DM, (bf16_t*)(p.ws + WS_WTO), item, sm); continue; }
        item -= T_WO;
        transpose_tile(p.in[I_PWQ], DM, 2048, (bf16_t*)(p.ws + WS_WTQ), item, sm);
    }
    (void)E1; (void)E2; (void)E3; (void)E4; (void)E5; (void)E6; (void)E7;
}

typedef int i32x8 __attribute__((ext_vector_type(8)));
#define MFMA8(a, b, c) __builtin_amdgcn_mfma_scale_f32_32x32x64_f8f6f4((a), (b), (c), 0, 0, 0, 0x7F7F7F7F, 0, 0x7F7F7F7F)
DI unsigned pk_fp8x4(float a, float b, float c, float d) {
    int w = 0;
    w = __builtin_amdgcn_cvt_pk_fp8_f32(fminf(fmaxf(a, -440.f), 440.f), fminf(fmaxf(b, -440.f), 440.f), w, false);
    w = __builtin_amdgcn_cvt_pk_fp8_f32(fminf(fmaxf(c, -440.f), 440.f), fminf(fmaxf(d, -440.f), 440.f), w, true);
    return (unsigned)w;
}
DI void norm_mod_row(const f32x4 (&v)[4]  , const float* __restrict__ g, const float* __restrict__ shift, const float* __restrict__ scale, bf16_t* __restrict__ dst, unsigned char* __restrict__ dst8 = nullptr) {
    const int lane = get_tid() & 63;
    float ss = 0.f;
#pragma unroll
    for (int j = 0; j < 4; ++j) ss += v[j][0] * v[j][0] + v[j][1] * v[j][1] + v[j][2] * v[j][2] + v[j][3] * v[j][3];
    ss = wave_sum(ss);
    const float rs = rsqrtf(ss * (1.f / DM) + EPS);
#pragma unroll
    for (int j = 0; j < 4; ++j) {
        const int c = j * 256 + lane * 4;
        const f32x4 gg = *(const f32x4*)(g + c), sh = *(const f32x4*)(shift + c), sc = *(const f32x4*)(scale + c);
        float o[4];
#pragma unroll
        for (int e = 0; e < 4; ++e) o[e] = v[j][e] * rs * gg[e] * (1.f + sc[e]) + sh[e];
        if (dst) *(u32x2*)(dst + c) = u32x2{pk2(o[0], o[1]), pk2(o[2], o[3])};
        if (dst8) *(unsigned*)(dst8 + c) = pk_fp8x4(o[0], o[1], o[2], o[3]);
    }
}

DI void filter_norm_item(const Params& p, int item, float* sm) {
    const int tid = get_tid();
    const int o = item >> 9, c = item & 511;
    const int colf = o * 1024 + c, colb = colf + 512;
    const float* part = (const float*)(p.ws + WS_PART);
    const float* fraw = (const float*)(p.ws + WS_FRAW);
    float v[8], mx = 0.f;
#pragma unroll
    for (int i = 0; i < 8; ++i) {
        const int n = tid * 8 + i;
        v[i] = (n == 0) ? 0.f : (n <= 4096 ? fraw[(size_t)colf * SEQ + 4096 - n] : fraw[(size_t)colb * SEQ + n - 4096]);
        mx = fmaxf(mx, fabsf(v[i]));
    }
    float sacc = 0.f;
    if (tid < 512) sacc = part[(tid & 255) * 2048 + ((tid < 256) ? colf : colb)];
    sacc = wave_sum(sacc); mx = wave_max(mx);
    __syncthreads();
    if ((tid & 63) == 0) { sm[tid >> 6] = sacc; sm[16 + (tid >> 6)] = mx; }
    __syncthreads();
    float tot = EPS, gmx = 0.f;
#pragma unroll
    for (int i = 0; i < 8; ++i) tot += sm[i];
#pragma unroll
    for (int i = 0; i < 16; ++i) gmx = fmaxf(gmx, sm[16 + i]);
    const float inv = 1.f / tot;
    int ex; (void)frexpf(fmaxf(gmx * inv, 1e-30f), &ex);
    const float sc = ldexpf(1.f, 8 - ex), isc = ldexpf(1.f, ex - 8);
    if (tid == 0) ((float*)(p.ws + WS_FSC))[item] = isc;
    const float k = inv * sc;
    int w0 = 0, w1 = 0;
    w0 = __builtin_amdgcn_cvt_pk_fp8_f32(v[0] * k, v[1] * k, w0, false); w0 = __builtin_amdgcn_cvt_pk_fp8_f32(v[2] * k, v[3] * k, w0, true);
    w1 = __builtin_amdgcn_cvt_pk_fp8_f32(v[4] * k, v[5] * k, w1, false); w1 = __builtin_amdgcn_cvt_pk_fp8_f32(v[6] * k, v[7] * k, w1, true);
    *(u32x2*)(p.ws + WS_R + (size_t)item * 8192 + tid * 8) = u32x2{(unsigned)w0, (unsigned)w1};
    __syncthreads();
}

DI const float* table_conv_src(const Params& p, int ci) { return (ci < 2048 ? p.in[I_PU] : p.in[I_PV]) + (size_t)(ci & 2047) * 8192 + (get_tid() * 8); }
DI void table_conv_item(const Params& p, int ci, unsigned char* lds, const f32x4& a, const f32x4& b  ) {
    const int tid = get_tid();
    const size_t el = (size_t)(ci & 2047) * 8192 + tid * 8;
    const size_t e = el >> 10, col = el & 1023;
    if (ci < 2048) {
        float sq = a[0] * a[0] + a[1] * a[1] + a[2] * a[2] + a[3] * a[3] + b[0] * b[0] + b[1] * b[1] + b[2] * b[2] + b[3] * b[3];
        sq = wave_sum(sq);
        float* wm = (float*)lds;
        __syncthreads();
        if ((tid & 63) == 0) wm[tid >> 6] = sq;
        __syncthreads();
        const int w2 = (tid >> 7) * 2;
        const float rsig = fmaxf(sqrtf((wm[w2] + wm[w2 + 1]) * (1.f / 1024.f)), 1e-30f);
        const float sc = 2.f / rsig;
        if ((tid & 127) == 0) ((float*)(p.ws + WS_USC))[2 * e] = rsig * 0.5f;
        const float xs[8] = {a[0], a[1], a[2], a[3], b[0], b[1], b[2], b[3]};
        unsigned w = 0;
#pragma unroll
        for (int j = 0; j < 8; ++j) {
            const float m = fabsf(xs[j] * sc);
            const unsigned code = (m < 0.25f ? 0u : m < 0.75f ? 1u : m < 1.25f ? 2u : m < 1.75f ? 3u : m < 2.5f ? 4u : m < 3.5f ? 5u : m < 5.f ? 6u : 7u) | (xs[j] < 0.f ? 8u : 0u);
            w |= code << (4 * j);
        }
        *(unsigned*)(p.ws + WS_UT + (el >> 1)) = w;
    } else {
        float sq = a[0] * a[0] + a[1] * a[1] + a[2] * a[2] + a[3] * a[3] + b[0] * b[0] + b[1] * b[1] + b[2] * b[2] + b[3] * b[3];
        sq = wave_sum(sq);
        float* wm = (float*)lds;
        __syncthreads();
        if ((tid & 63) == 0) wm[tid >> 6] = sq;
        __syncthreads();
        const int w2 = (tid >> 7) * 2;
        const float rsig = fmaxf(sqrtf((wm[w2] + wm[w2 + 1]) * (1.f / 1024.f)), 1e-30f);
        const float sc = 2.f / rsig;
        if ((tid & 127) == 0) ((float*)(p.ws + WS_USC))[2 * e + 1] = rsig * 0.5f;
        const float xs[8] = {a[0], a[1], a[2], a[3], b[0], b[1], b[2], b[3]};
        unsigned wc = 0;
#pragma unroll
        for (int j = 0; j < 8; ++j) {
            const float m = fabsf(xs[j] * sc);
            const unsigned code = (m < 0.25f ? 0u : m < 0.75f ? 1u : m < 1.25f ? 2u : m < 1.75f ? 3u : m < 2.5f ? 4u : m < 3.5f ? 5u : m < 5.f ? 6u : 7u) | (xs[j] < 0.f ? 8u : 0u);
            wc |= code << (4 * j);
        }
        const unsigned wo = (unsigned)dppi<0xB1>((int)wc);
        const int cs = (int)(col & 255), ah = cs >> 7, jp = (cs & 127) >> 3;
        const unsigned wev = (jp & 1) ? wo : wc, wod = (jp & 1) ? wc : wo;
        unsigned char* dst = p.ws + WS_VTAB + ((col >> 8) * 16384 + e) * 128 + 8 * ah + (jp >> 1);
#pragma unroll
        for (int q = 0; q < 4; ++q) {
            const int nt = q + 4 * (jp & 1);
            dst[16 * nt] = (unsigned char)(((wev >> (4 * nt)) & 15u) | (((wod >> (4 * nt)) & 15u) << 4));
        }
    }
}

DI void phase_b(const Params& p, float* sm) {
    const float* mod = (const float*)(p.ws + WS_MOD);
    constexpr int ROW_ITEMS = (BT + BATCH * CTX) / 16;
    constexpr int CONV = 2 * 16384 * 1024 / 8192;
    constexpr int SHQ = 8 * 2048 / 16;
    constexpr int W8I = INC / 16;
    const int G = (int)gridDim.x;
    for (int it = blockIdx.x; it < 1024; it += G) filter_norm_item(p, it, sm);
    {
        const int tid = get_tid(), lane = tid & 63, wave = tid >> 6;
        auto row_src = [&](int it) { const int row = it * 16 + wave; return (row < BT ? p.in[I_X] + (size_t)row * DM : p.in[I_CTX] + (size_t)(row - BT) * DM) + lane * 4; };
        f32x4 nv[4];
        int it = blockIdx.x;
        if (it < ROW_ITEMS) { const float* s0 = row_src(it);
#pragma unroll
            for (int j = 0; j < 4; ++j) nv[j] = *(const f32x4*)(s0 + j * 256); }
#pragma unroll 1
        for (; it < ROW_ITEMS; it += G) {
            f32x4 v[4];
#pragma unroll
            for (int j = 0; j < 4; ++j) v[j] = nv[j];
            if (it + G < ROW_ITEMS) { const float* s1 = row_src(it + G);
#pragma unroll
                for (int j = 0; j < 4; ++j) nv[j] = *(const f32x4*)(s1 + j * 256); }
            const int row = it * 16 + wave;
            if (row < BT) {
                const int b = row >> 12;
                norm_mod_row(v, p.in[I_NMIX], mod + b * 6144, mod + b * 6144 + 1024, nullptr, p.ws + WS_H8 + (size_t)row * DM);
            } else {
                const int r = row - BT;
                norm_mod_row(v, p.in[I_NMIX], mod + 8 * 6144, mod + 8 * 6144 + 1024, nullptr, p.ws + WS_HC + (size_t)r * DM);
            }
        }
    }
    {
        int ci = blockIdx.x;
        f32x4 na = f32x4{0.f, 0.f, 0.f, 0.f}, nb = na;
        if (ci < CONV) { const float* s0 = table_conv_src(p, ci); na = *(const f32x4*)s0; nb = *(const f32x4*)(s0 + 4); }
#pragma unroll 1
        for (; ci < CONV; ci += G) {
            const f32x4 a = na, b = nb;
            if (ci + G < CONV) { const float* s1 = table_conv_src(p, ci + G); na = *(const f32x4*)s1; nb = *(const f32x4*)(s1 + 4); }
            table_conv_item(p, ci, (unsigned char*)sm, a, b);
        }
    }
    for (int it = blockIdx.x; it < SHQ; it += G) {
        const int tid = get_tid(), lane = tid & 63, o = it * 16 + (tid >> 6), b = o >> 11, n = o & 2047;
        const bf16_t* wr = (const bf16_t*)(p.ws + WS_WTQ) + (size_t)n * DM + lane * 16;
        const float* sh = mod + b * 6144 + 3072 + lane * 16;
        const u32x4 w0 = *(const u32x4*)wr, w1 = *(const u32x4*)(wr + 8);
        float d = 0.f;
#pragma unroll
        for (int i = 0; i < 4; ++i) { d += bflo(w0[i]) * sh[2 * i] + bfhi(w0[i]) * sh[2 * i + 1] + bflo(w1[i]) * sh[8 + 2 * i] + bfhi(w1[i]) * sh[9 + 2 * i]; }
        d = wave_sum(d);
        if (lane == 0) ((float*)(p.ws + WS_SHQ))[o] = d;
    }
    for (int it = blockIdx.x; it < W8I; it += G) {
        const int tid = get_tid(), lane = tid & 63, n = it * 16 + (tid >> 6);
        const bf16_t* wr = (const bf16_t*)(p.ws + WS_WTIN) + (size_t)n * DM + lane * 16;
        const u32x4 w0 = *(const u32x4*)wr, w1 = *(const u32x4*)(wr + 8);
        const float k = W8_SCALE;
        *(u32x4*)(p.ws + WS_W8G + (size_t)n * DM + lane * 16) = u32x4{pk_fp8x4(bflo(w0[0]) * k, bfhi(w0[0]) * k, bflo(w0[1]) * k, bfhi(w0[1]) * k), pk_fp8x4(bflo(w0[2]) * k, bfhi(w0[2]) * k, bflo(w0[3]) * k, bfhi(w0[3]) * k),
                                                                            pk_fp8x4(bflo(w1[0]) * k, bfhi(w1[0]) * k, bflo(w1[1]) * k, bfhi(w1[1]) * k), pk_fp8x4(bflo(w1[2]) * k, bfhi(w1[2]) * k, bflo(w1[3]) * k, bfhi(w1[3]) * k)};
    }
    for (int it = blockIdx.x; it < DM / 16; it += G) {
        const int tid = get_tid(), lane = tid & 63, n = it * 16 + (tid >> 6);
        const bf16_t* wr = (const bf16_t*)(p.ws + WS_WTO) + (size_t)n * DM + lane * 16;
        const u32x4 w0 = *(const u32x4*)wr, w1 = *(const u32x4*)(wr + 8);
        const float k = W8_SCALE;
        *(u32x4*)(p.ws + WS_W8O + (size_t)n * DM + lane * 16) = u32x4{pk_fp8x4(bflo(w0[0]) * k, bfhi(w0[0]) * k, bflo(w0[1]) * k, bfhi(w0[1]) * k), pk_fp8x4(bflo(w0[2]) * k, bfhi(w0[2]) * k, bflo(w0[3]) * k, bfhi(w0[3]) * k),
                                                                            pk_fp8x4(bflo(w1[0]) * k, bfhi(w1[0]) * k, bflo(w1[1]) * k, bfhi(w1[1]) * k), pk_fp8x4(bflo(w1[2]) * k, bfhi(w1[2]) * k, bflo(w1[3]) * k, bfhi(w1[3]) * k)};
    }
}

#define MFMA16(a, b, c) __builtin_amdgcn_mfma_f32_16x16x32_bf16((a), (b), (c), 0, 0, 0)
constexpr int GT_P = 256 * 128;
struct RowLoader {
    const bf16_t* base; int ld;
    static constexpr bool kmajor = false;
    template<int ROWS> DI void issue(unsigned char* tile, int kt, int lane, int wave) const {
#pragma unroll
        for (int i = 0; i < ROWS / 128; ++i) {
            const int grp = i * 16 + wave, row = grp * 8 + (lane >> 3), c = (lane & 7) ^ (lane >> 3);
            __builtin_amdgcn_global_load_lds((const unsigned*)((const char*)base + (unsigned)((row * ld + kt * 64 + c * 8) * 2)), (unsigned*)(tile + grp * 1024), 16, 0, 0);
        }
    }
};

struct ColLoader {
    const bf16_t* base; size_t ld;
    static constexpr bool kmajor = true;
    template<int ROWS> DI void issue(unsigned char* tile, int kt, int lane, int wave) const {
        static_assert(ROWS == 128, "k-major loader: 128-row Q tiles only");
        const int row = wave * 4 + (lane >> 4), c = (lane & 15) ^ (2 * (row & 3));
        __builtin_amdgcn_global_load_lds((const unsigned*)(base + (size_t)(kt * 64 + row) * ld + c * 8), (unsigned*)(tile + wave * 1024), 16, 0, 0);
    }
};
template<int NQ>
DI void gemm_prefetch(const RowLoader& lp, const RowLoader& lq, unsigned char* lds) {
    const int tid = get_tid(), lane = tid & 63, wave = __builtin_amdgcn_readfirstlane(tid >> 6);
    lp.template issue<256>(lds, 0, lane, wave); lq.template issue<NQ * 64>(lds + GT_P, 0, lane, wave);
}
template<int NQ, bool KMAJOR>
DI void gemm_kstep(f32x4 (&acc)[4][NQ], const unsigned char* cur, int wp, int wq, int l15, int lk) {
#pragma unroll
    for (int ks = 0; ks < 2; ++ks) {
        bf16x8 fp[4], fq[NQ];
#pragma unroll
        for (int i = 0; i < 4; ++i) { const int row = wp * 64 + i * 16 + l15; fp[i] = *(const bf16x8*)(cur + row * 128 + (((ks * 4 + lk) ^ (row & 7)) << 4)); }
#pragma unroll
        for (int j = 0; j < NQ; ++j) {
            if constexpr (KMAJOR) {
                const int q4 = l15 >> 2, tokq = wq * (16 * NQ) + j * 16 + 4 * (l15 & 3);
                const unsigned char* ap = cur + GT_P + ((ks * 4 + lk) * 8 + q4) * 256 + (((tokq >> 3) ^ (2 * q4)) << 4) + ((tokq >> 2) & 1) * 8;
                const s16x4 lo = __builtin_amdgcn_ds_read_tr16_b64_v4i16((LAS s16x4*)(LAS unsigned char*)ap);
                const s16x4 hi = __builtin_amdgcn_ds_read_tr16_b64_v4i16((LAS s16x4*)(LAS unsigned char*)(ap + 4 * 256));
                fq[j] = __builtin_shufflevector(lo, hi, 0, 1, 2, 3, 4, 5, 6, 7);
            } else { const int row = wq * (16 * NQ) + j * 16 + l15; fq[j] = *(const bf16x8*)(cur + GT_P + row * 128 + (((ks * 4 + lk) ^ (row & 7)) << 4)); }
        }
#pragma unroll
        for (int i = 0; i < 4; ++i)
#pragma unroll
            for (int j = 0; j < NQ; ++j) acc[i][j] = MFMA16(fp[i], fq[j], acc[i][j]);
    }
}
template<int NQ>
DI void gemm_kstep8(f32x4 (&acc)[4][NQ], const unsigned char* cur, int wp, int wq, int l15, int lk) {
    __builtin_amdgcn_sched_barrier(0);
    if constexpr (NQ == 2) {
        i32x8 fq[2];
#pragma unroll
        for (int j = 0; j < 2; ++j) {
            const int row = wq * 32 + j * 16 + l15;
            const u32x4 a = *(const u32x4*)(cur + GT_P + row * 128 + ((lk ^ (row & 7)) << 4)), b = *(const u32x4*)(cur + GT_P + row * 128 + (((4 + lk) ^ (row & 7)) << 4));
            fq[j] = i32x8{(int)a[0], (int)a[1], (int)a[2], (int)a[3], (int)b[0], (int)b[1], (int)b[2], (int)b[3]};
        }
#pragma unroll
        for (int i = 0; i < 4; ++i) {
            const int row = wp * 64 + i * 16 + l15;
            const u32x4 pa = *(const u32x4*)(cur + row * 128 + ((lk ^ (row & 7)) << 4)), pb = *(const u32x4*)(cur + row * 128 + (((4 + lk) ^ (row & 7)) << 4));
            const i32x8 fp = i32x8{(int)pa[0], (int)pa[1], (int)pa[2], (int)pa[3], (int)pb[0], (int)pb[1], (int)pb[2], (int)pb[3]};
#pragma unroll
            for (int j = 0; j < 2; ++j) acc[i][j] = __builtin_amdgcn_mfma_scale_f32_16x16x128_f8f6f4(fp, fq[j], acc[i][j], 0, 0, 0, 0x7F7F7F7F, 0, 0x7F7F7F7F);
            asm volatile("" : "+v"(acc[i][0]), "+v"(acc[i][1]) :: "memory");
            __builtin_amdgcn_sched_barrier(0);
        }
        return;
    }
    i32x8 fp[4];
#pragma unroll
    for (int i = 0; i < 4; ++i) {
        const int row = wp * 64 + i * 16 + l15;
        const u32x4 a = *(const u32x4*)(cur + row * 128 + ((lk ^ (row & 7)) << 4)), b = *(const u32x4*)(cur + row * 128 + (((4 + lk) ^ (row & 7)) << 4));
        fp[i] = i32x8{(int)a[0], (int)a[1], (int)a[2], (int)a[3], (int)b[0], (int)b[1], (int)b[2], (int)b[3]};
    }
    u32x4 qa, qb;
    { const int row = wq * (16 * NQ) + l15; qa = *(const u32x4*)(cur + GT_P + row * 128 + ((lk ^ (row & 7)) << 4)); qb = *(const u32x4*)(cur + GT_P + row * 128 + (((4 + lk) ^ (row & 7)) << 4)); }
#pragma unroll
    for (int j = 0; j < NQ; ++j) {
        const i32x8 fq = i32x8{(int)qa[0], (int)qa[1], (int)qa[2], (int)qa[3], (int)qb[0], (int)qb[1], (int)qb[2], (int)qb[3]};
        if (j + 1 < NQ) { const int row = wq * (16 * NQ) + (j + 1) * 16 + l15; qa = *(const u32x4*)(cur + GT_P + row * 128 + ((lk ^ (row & 7)) << 4)); qb = *(const u32x4*)(cur + GT_P + row * 128 + (((4 + lk) ^ (row & 7)) << 4)); }
#pragma unroll
        for (int i = 0; i < 4; ++i) acc[i][j] = __builtin_amdgcn_mfma_scale_f32_16x16x128_f8f6f4(fp[i], fq, acc[i][j], 0, 0, 0, 0x7F7F7F7F, 0, 0x7F7F7F7F);
        __builtin_amdgcn_sched_barrier(0);
    }
}
template<int NQ, class LQ = RowLoader, class NLQ = RowLoader, bool F8 = false>
DI void gemm_mainloop(f32x4 (&acc)[4][NQ], const RowLoader& lp, const LQ& lq, int nk, unsigned char* lds, bool preissued = false, bool pfnext = false,
                      const RowLoader& nlp = RowLoader{nullptr, 0}, const NLQ& nlq = NLQ{nullptr, 0}) {
    const int tid = get_tid(), lane = tid & 63, wave = __builtin_amdgcn_readfirstlane(tid >> 6), wp = wave >> 2, wq = wave & 3;
    constexpr int QROWS = NQ * 64;
    constexpr int STAGE = GT_P + QROWS * 128;
    if (!preissued) {
        __syncthreads();
        lp.template issue<256>(lds, 0, lane, wave); lq.template issue<QROWS>(lds + GT_P, 0, lane, wave);
    }
    asm volatile("s_waitcnt vmcnt(0)" ::: "memory");
    __syncthreads();
    const int l15 = lane & 15, lk = lane >> 4;
    for (int kt = 0; kt < nk; ++kt) {
        unsigned char* cur = lds + (kt & 1) * STAGE;
        unsigned char* nxt = lds + ((kt + 1) & 1) * STAGE;
        const bool last = kt + 1 == nk;
        if (!last) { lp.template issue<256>(nxt, kt + 1, lane, wave); lq.template issue<QROWS>(nxt + GT_P, kt + 1, lane, wave); }
        else if (pfnext) { nlp.template issue<256>(nxt, 0, lane, wave); nlq.template issue<QROWS>(nxt + GT_P, 0, lane, wave); }
        if constexpr (F8) gemm_kstep8<NQ>(acc, cur, wp, wq, l15, lk); else gemm_kstep<NQ, LQ::kmajor>(acc, cur, wp, wq, l15, lk);
        if (last && pfnext) { asm volatile("s_waitcnt lgkmcnt(0)" ::: "memory"); __builtin_amdgcn_s_barrier(); }
        else { asm volatile("s_waitcnt vmcnt(0)" ::: "memory"); __syncthreads(); }
    }
}
template<int NQ, int NLW, bool F8 = false>
DI void gemm_mainloop_lw(f32x4 (&acc)[4][NQ], const RowLoader& lp, const RowLoader& lq, int nk, unsigned char* lds) {
    const int tid = get_tid(), lane = tid & 63, wave = __builtin_amdgcn_readfirstlane(tid >> 6), wp = wave >> 2, wq = wave & 3;
    constexpr int QROWS = NQ * 64, STAGE = GT_P + QROWS * 128, NGP = 256 / 8, NGT = NGP + QROWS / 8;
    static_assert(NGT % NLW == 0, "the stage's load groups must divide evenly among the loader waves");
    auto issue_stage = [&](unsigned char* tile, int kt) {
        if (wave < NLW) {
#pragma unroll
            for (int e = 0; e < NGT / NLW; ++e) {
                const int g = wave + e * NLW;
                const bool isq = g >= NGP;
                const int gg = isq ? g - NGP : g;
                const bf16_t* bs = isq ? lq.base : lp.base; const int ldd = isq ? lq.ld : lp.ld;
                const int row = gg * 8 + (lane >> 3), c = (lane & 7) ^ (lane >> 3);
                __builtin_amdgcn_global_load_lds((const unsigned*)((const char*)bs + (unsigned)((row * ldd + kt * 64 + c * 8) * 2)), (unsigned*)(tile + (isq ? GT_P : 0) + gg * 1024), 16, 0, 0);
            }
        }
    };
    __syncthreads();
    issue_stage(lds, 0);
    if (wave < NLW) asm volatile("s_waitcnt vmcnt(0)" ::: "memory");
    __syncthreads();
    const int l15 = lane & 15, lk = lane >> 4;
    for (int kt = 0; kt < nk; ++kt) {
        unsigned char* cur = lds + (kt & 1) * STAGE;
        if (kt + 1 < nk) issue_stage(lds + ((kt + 1) & 1) * STAGE, kt + 1);
        if constexpr (F8) gemm_kstep8<NQ>(acc, cur, wp, wq, l15, lk); else gemm_kstep<NQ, false>(acc, cur, wp, wq, l15, lk);
        if (wave < NLW) asm volatile("s_waitcnt vmcnt(0)" ::: "memory");
        __syncthreads();
    }
}
template<int NQ>
DI void gemm_shadow(const RowLoader& lp, const RowLoader& lq, int nk, unsigned char* lds) {
    f32x4 acc[4][NQ];
#pragma unroll
    for (int i = 0; i < 4; ++i)
#pragma unroll
        for (int j = 0; j < NQ; ++j) acc[i][j] = f32x4{0.f, 0.f, 0.f, 0.f};
    if (SHADOW == 1) gemm_mainloop<NQ>(acc, lp, lq, nk, lds);
    else {
        const int tid = get_tid(), lane = tid & 63, wave = __builtin_amdgcn_readfirstlane(tid >> 6), wp = wave >> 2, wq = wave & 3;
        constexpr int QROWS = NQ * 64;
        constexpr int STAGE = GT_P + QROWS * 128;
        const int l15 = lane & 15, lk = lane >> 4;
        bf16x8 fp[4], fq[NQ];
        if (SHADOW == 3) {
#pragma unroll
            for (int i = 0; i < 4; ++i) fp[i] = *(const bf16x8*)(lds + (wp * 64 + i * 16 + l15) * 128 + lk * 16);
#pragma unroll
            for (int j = 0; j < NQ; ++j) fq[j] = *(const bf16x8*)(lds + GT_P + (wq * 16 * NQ + j * 16 + l15) * 128 + lk * 16);
        }
        for (int kt = 0; kt < nk; ++kt) {
            unsigned char* cur = lds + (kt & 1) * STAGE;
#pragma unroll
            for (int ks = 0; ks < 2; ++ks) {
                if (SHADOW == 2 || SHADOW == 4) {
#pragma unroll
                    for (int i = 0; i < 4; ++i) { const int row = wp * 64 + i * 16 + l15; fp[i] = *(const bf16x8*)(cur + row * 128 + (((ks * 4 + lk) ^ (row & 7)) << 4)); }
#pragma unroll
                    for (int j = 0; j < NQ; ++j) { const int row = wq * (16 * NQ) + j * 16 + l15; fq[j] = *(const bf16x8*)(cur + GT_P + row * 128 + (((ks * 4 + lk) ^ (row & 7)) << 4)); }
                }
#pragma unroll
                for (int i = 0; i < 4; ++i)
#pragma unroll
                    for (int j = 0; j < NQ; ++j) acc[i][j] = MFMA16(fp[i], fq[j], acc[i][j]);
            }
            if (SHADOW == 2) asm volatile("" ::: "memory");
            if (SHADOW == 4) __syncthreads();
        }
    }
#pragma unroll
    for (int i = 0; i < 4; ++i)
#pragma unroll
        for (int j = 0; j < NQ; ++j) asm volatile("" :: "v"(acc[i][j]));
}

template<int NQ> DI void gemm_shadow1(const RowLoader& lp, const RowLoader& lq, int nk, unsigned char* lds) {
    f32x4 acc[4][NQ];
#pragma unroll
    for (int i = 0; i < 4; ++i)
#pragma unroll
        for (int j = 0; j < NQ; ++j) acc[i][j] = f32x4{0.f, 0.f, 0.f, 0.f};
    gemm_mainloop<NQ>(acc, lp, lq, nk, lds);
#pragma unroll
    for (int i = 0; i < 4; ++i)
#pragma unroll
        for (int j = 0; j < NQ; ++j) asm volatile("" :: "v"(acc[i][j]));
}
DI void head_epilogue(f32x4 (&acc)[4][4], const float* __restrict__ g, float gscale, const float* __restrict__ rope, bool do_rope, int t_base  , unsigned char* __restrict__ dst  , int lane, unsigned char* wst  , float eps = EPS) {
    const int l15 = lane & 15, lk = lane >> 4;
    float gg[4];
#pragma unroll
    for (int j = 0; j < 4; ++j) gg[j] = g[j * 16 + l15] * gscale;
#pragma unroll
    for (int i = 0; i < 4; ++i) {
#pragma unroll
        for (int r = 0; r < 4; ++r) {
            float ss = 0.f;
#pragma unroll
            for (int j = 0; j < 4; ++j) ss += acc[i][j][r] * acc[i][j][r];
            ss = sum16(ss);
            const float rs = rsqrtf(ss * (1.f / 64.f) + eps);
            float v[4];
#pragma unroll
            for (int j = 0; j < 4; ++j) v[j] = acc[i][j][r] * rs * gg[j];
            const int t = t_base + i * 16 + lk * 4 + r;
            if (do_rope) {
                const int prow = (t >> 6) & 63, pcol = t & 63;
                const float c0 = rope[prow * 16 + l15], s0 = rope[1024 + prow * 16 + l15];
                const float c1 = rope[pcol * 16 + l15], s1 = rope[1024 + pcol * 16 + l15];
                const float a0 = v[0] * c0 - v[1] * s0, a1 = v[1] * c0 + v[0] * s0;
                const float a2 = v[2] * c1 - v[3] * s1, a3 = v[3] * c1 + v[2] * s1;
                v[0] = a0; v[1] = a1; v[2] = a2; v[3] = a3;
            }
            unsigned char* d = wst + (i * 16 + lk * 4 + r) * 64 + l15;
            const int w01 = __builtin_amdgcn_cvt_pk_fp8_f32(v[0], v[1], 0, false), w23 = __builtin_amdgcn_cvt_pk_fp8_f32(v[2], v[3], 0, false);
            d[0] = (unsigned char)w01; d[16] = (unsigned char)(w01 >> 8); d[32] = (unsigned char)w23; d[48] = (unsigned char)(w23 >> 8);
        }
    }
#pragma unroll
    for (int e = 0; e < 4; ++e) *(u32x4*)(dst + e * 1024 + lane * 16) = *(const u32x4*)(wst + e * 1024 + lane * 16);
}
DI void tstore_epilogue(f32x4 (&acc)[4][4], bf16_t* __restrict__ dst  , size_t ld, int lane) {
    const int l15 = lane & 15, lk = lane >> 4;
#pragma unroll
    for (int i = 0; i < 4; ++i)
#pragma unroll
        for (int j = 0; j < 4; ++j)
            *(u32x2*)(dst + (size_t)(j * 16 + l15) * ld + i * 16 + lk * 4) = u32x2{pk2(acc[i][j][0], acc[i][j][1]), pk2(acc[i][j][2], acc[i][j][3])};
}

DI void phase_c(const Params& p, unsigned char* lds) {
    constexpr int NTM = BT / 256, NTN = INC / 256;
    constexpr int MAIN = NTM * NTN, TOTAL = MAIN + 8;
    const bf16_t* H = (const bf16_t*)(p.ws + WS_H);
    const bf16_t* HCp = (const bf16_t*)(p.ws + WS_HC);
    const bf16_t* WT = (const bf16_t*)(p.ws + WS_WTIN);
    const float* rope = (const float*)(p.ws + WS_ROPE);
    struct CTile { int tm, tn; bool ctx; RowLoader P, Q; };
    auto c_tile = [&](int it) {
        CTile t; t.ctx = false;
        if (it < MAIN) {
            constexpr unsigned long long ORD_LO = 0x719a56056450d20ull, ORD_HI = 0x881de2ull;
            const int g = it / (16 * NTN), rem = it % (16 * NTN), pos = rem >> 4;
            t.tn = (int)((pos < 12 ? ORD_LO >> (5 * pos) : ORD_HI >> (5 * (pos - 12))) & 31ull); t.tm = g * 16 + (rem & 15);
        }
        else { t.ctx = true; t.tm = it - MAIN; t.tn = 2; }
        const bf16_t* A = t.ctx ? HCp + (size_t)t.tm * 256 * DM : H + (size_t)t.tm * 256 * DM;
        const bf16_t* W = WT + (size_t)t.tn * 256 * DM;
        if (t.ctx) {
            t.P = RowLoader{(const bf16_t*)(p.ws + WS_HC + (size_t)t.tm * 256 * DM), DM / 2}; t.Q = RowLoader{(const bf16_t*)(p.ws + WS_W8G + (size_t)(t.tn * 256) * DM), DM / 2}; }
        else if (t.tn >= 9) {
            t.P = RowLoader{(const bf16_t*)(p.ws + WS_W8G + (size_t)(t.tn * 256) * DM), DM / 2}; t.Q = RowLoader{(const bf16_t*)(p.ws + WS_H8 + (size_t)t.tm * 256 * DM), DM / 2}; }
        else {
            t.P = RowLoader{(const bf16_t*)(p.ws + WS_H8 + (size_t)t.tm * 256 * DM), DM / 2}; t.Q = RowLoader{(const bf16_t*)(p.ws + WS_W8G + (size_t)(t.tn * 256) * DM), DM / 2}; }
        return t;
    };
    bool pre = false;
    CTile cur = c_tile(blockIdx.x);
    for (int it = blockIdx.x; it < TOTAL; it += gridDim.x) {
        const int tid = get_tid(), lane = tid & 63, wave = tid >> 6, wa = wave >> 2, wb = wave & 3;
        const bool has2 = it + (int)gridDim.x < TOTAL;
        const CTile nx = c_tile(has2 ? it + (int)gridDim.x : it);
        const int tm = cur.tm, tn = cur.tn; const bool ctx = cur.ctx;
        f32x4 acc[4][4];
#pragma unroll
        for (int i = 0; i < 4; ++i)
#pragma unroll
            for (int j = 0; j < 4; ++j) acc[i][j] = f32x4{0.f, 0.f, 0.f, 0.f};
        int nk8 = DM / 128; asm volatile("" : "+s"(nk8));
        gemm_mainloop<4, RowLoader, RowLoader, true>(acc, cur.P, cur.Q, nk8, lds, pre, has2, nx.P, nx.Q);
        pre = has2; cur = nx;
        if (tn >= 9) {
            unsigned char* st = lds + 64 * 1024;
            constexpr int GS = 272;
            const int l15 = lane & 15, lk = lane >> 4;
#pragma unroll
            for (int i = 0; i < 4; ++i)
#pragma unroll
                for (int j = 0; j < 4; ++j) {
                    unsigned q[4];
#pragma unroll
                    for (int r = 0; r < 4; ++r) q[r] = (unsigned)(255.f * __builtin_amdgcn_rcpf(1.f + __builtin_amdgcn_exp2f(acc[i][j][r] * (-1.4426950408889634f / W8_SCALE))) + 0.5f);
                    *(unsigned*)(st + (wb * 64 + j * 16 + l15) * GS + wa * 64 + i * 16 + lk * 4) = q[0] | (q[1] << 8) | (q[2] << 16) | (q[3] << 24);
                }
            __syncthreads();
            unsigned char* G8 = p.ws + WS_G + (size_t)tm * 256 * GC + (tn * 256 - 2304);
            const int t2 = get_tid();
#pragma unroll
            for (int q = 0; q < 4; ++q) {
                const int idx = t2 + q * NT, row = idx >> 4, ch = idx & 15;
                *(u32x4*)(G8 + (size_t)row * GC + ch * 16) = *(const u32x4*)(st + row * GS + ch * 16);
            }
            continue;
        }
        const float heps = EPS * (W8_SCALE * W8_SCALE), vts = VT_SCALE / W8_SCALE;
        const int b = ctx ? tm : (tm >> 4);
        const int tpos = ctx ? SEQ + wa * 64 : ((tm & 15) * 256 + wa * 64);
        if (tn < 2) {
            const int h = tn * 4 + wb;
            unsigned char* Q = p.ws + WS_Q + ((size_t)(b * NH + h) * SEQ + tpos) * HD;
            head_epilogue(acc, p.in[I_QNG], 1.4426950408889634f, rope, true, tpos, Q, lane, lds + 64 * 1024 + wave * 4096, heps);
        } else if (tn == 2) {
            if (wb < 2) {
                unsigned char* K = p.ws + WS_KB + ((size_t)(b * NKV + wb) * TK + tpos) * HD;
                head_epilogue(acc, p.in[I_KNG], 1.f, rope, !ctx, tpos, K, lane, lds + 64 * 1024 + wave * 4096, heps);
            } else {
                unsigned char* V8 = p.ws + WS_VT + (size_t)(b * NKV + (wb - 2)) * HD * TK;
                const int l15 = lane & 15, lk = lane >> 4;
#pragma unroll
                for (int i = 0; i < 4; ++i) {
                    const int k = tpos + i * 16 + lk * 4, kin = k & 63, within = kin & 31;
                    const int pos = (k & ~63) + 32 * ((within >> 2) & 1) + 16 * (kin >> 5) + 4 * (within >> 3);
#pragma unroll
                    for (int j = 0; j < 4; ++j)
                        *(unsigned*)(V8 + (size_t)(j * 16 + l15) * TK + pos) = pk_fp8x4(acc[i][j][0] * vts, acc[i][j][1] * vts, acc[i][j][2] * vts, acc[i][j][3] * vts);
                }
            }
        } else {
            unsigned char* st = lds + 64 * 1024;
            constexpr int ZS = 528;
            constexpr float ZK = 1.f / W8_SCALE;
            const int l15 = lane & 15, lk = lane >> 4;
            bf16_t* Zt = (bf16_t*)(p.ws + WS_ZT) + (size_t)(tn * 256 - 768) * BT + (size_t)b * SEQ + (tm & 15) * 256;
#pragma unroll 1
            for (int h = 0; h < 2; ++h) {
                if ((wb >> 1) == h) {
#pragma unroll
                    for (int i = 0; i < 4; ++i)
#pragma unroll
                        for (int j = 0; j < 4; ++j)
                            *(u32x2*)(st + ((wb & 1) * 64 + j * 16 + l15) * ZS + (wa * 64 + i * 16 + lk * 4) * 2) = u32x2{pk2(acc[i][j][0] * ZK, acc[i][j][1] * ZK), pk2(acc[i][j][2] * ZK, acc[i][j][3] * ZK)};
                }
                __syncthreads();
                const int t2 = get_tid();
#pragma unroll
                for (int q = 0; q < 4; ++q) {
                    const int idx = t2 + q * NT, row = idx >> 5, ch = idx & 31;
                    *(u32x4*)(Zt + (size_t)(h * 128 + row) * BT + ch * 8) = *(const u32x4*)(st + row * ZS + ch * 16);
                }
                __syncthreads();
            }
        }
    }
}

#define MFMA32(a, b, c) __builtin_amdgcn_mfma_f32_32x32x16_bf16((a), (b), (c), 0, 0, 0)
DI bf16x8 pack_step(const f32x16& x, int s) {
    u32x4 pk;
    asm volatile("v_cvt_pk_bf16_f32 %0, %4, %5\n\tv_cvt_pk_bf16_f32 %1, %6, %7\n\tv_cvt_pk_bf16_f32 %2, %8, %9\n\tv_cvt_pk_bf16_f32 %3, %10, %11\n\ts_nop 1"
                 : "=&v"(pk[0]), "=&v"(pk[1]), "=&v"(pk[2]), "=&v"(pk[3])
                 : "v"(x[8 * s]), "v"(x[8 * s + 1]), "v"(x[8 * s + 2]), "v"(x[8 * s + 3]), "v"(x[8 * s + 4]), "v"(x[8 * s + 5]), "v"(x[8 * s + 6]), "v"(x[8 * s + 7]));
    return __builtin_bit_cast(bf16x8, pk);
}

constexpr int AT_KSTR = 64, AT_VSTR = 64, AT_VOFF = 64 * AT_KSTR, AT_STAGE = AT_VOFF + 64 * AT_VSTR;
DI void attn_item(const Params& p, int item, unsigned char* lds) {
    const int tid = get_tid(), lane = tid & 63, wave = tid >> 6;
    const int b = item >> 6, kvh = (item >> 5) & 1, qb = item & 31;
    const int h = kvh * 4 + (wave >> 2), q0 = qb * 128 + (wave & 3) * 32;
    const int qi = lane & 31, hf = lane >> 5;
    const unsigned char* Qp = p.ws + WS_Q + ((size_t)(b * NH + h) * SEQ + q0 + qi) * HD + 32 * hf;
    const u32x4 q0v = *(const u32x4*)Qp, q1v = *(const u32x4*)(Qp + 16);
    const i32x8 qf = i32x8{(int)q0v[0], (int)q0v[1], (int)q0v[2], (int)q0v[3], (int)q1v[0], (int)q1v[1], (int)q1v[2], (int)q1v[3]};
    const unsigned char* Kg = p.ws + WS_KB + (size_t)(b * NKV + kvh) * TK * HD;
    const unsigned char* Vg = p.ws + WS_VT + (size_t)(b * NKV + kvh) * HD * TK;
    constexpr int NTILE = TK / 64;
    f32x16 o0, o1, o2;
#pragma unroll
    for (int i = 0; i < 16; ++i) { o0[i] = 0.f; o1[i] = 0.f; o2[i] = 0.f; }
    __syncthreads();
    constexpr int NSUB = 4, NSTG = NTILE / NSUB;
    static_assert(NTILE % NSUB == 0 && 2 * NSUB * AT_STAGE <= LDS_USER, "attention LDS stages");
    const int wv = __builtin_amdgcn_readfirstlane(tid >> 6);
    auto stage_issue = [&](int stg_idx, int buf) {
#pragma unroll
        for (int e = 0; e < 2; ++e) {
            const int q = 2 * wv + e, j = q >> 3, isV = (q >> 2) & 1, part = q & 3;
            const int row = 16 * part + (lane >> 2), c = (lane & 3) ^ ((row >> 2) & 3), tile = stg_idx * NSUB + j;
            const unsigned char* sp = isV ? Vg + (size_t)row * TK + (size_t)tile * 64 + c * 16 : Kg + ((size_t)tile * 64 + row) * HD + c * 16;
            __builtin_amdgcn_global_load_lds((const unsigned*)sp, (unsigned*)(lds + (buf * NSUB + j) * AT_STAGE + isV * AT_VOFF + part * 1024), 16, 0, 0);
        }
    };
    stage_issue(0, 0);
    asm volatile("s_waitcnt vmcnt(0)" ::: "memory");
    __syncthreads();
    const int sw = (qi >> 2) & 3;
    const int kc0 = qi * AT_KSTR + (((2 * hf) ^ sw) << 4), kc1 = qi * AT_KSTR + (((2 * hf + 1) ^ sw) << 4);
    for (int st = 0; st < NSTG; ++st) {
      const bool more = st + 1 < NSTG;
      if (more) stage_issue(st + 1, (st + 1) & 1);
#pragma unroll 1
      for (int j = 0; j < NSUB; ++j) {
        const unsigned char* cur = lds + ((st & 1) * NSUB + j) * AT_STAGE;
        f32x16 sA, sB;
        {
            f32x16 z;
#pragma unroll
            for (int i = 0; i < 16; ++i) z[i] = 0.f;
            const u32x4 ka0 = *(const u32x4*)(cur + kc0), ka1 = *(const u32x4*)(cur + kc1);
            const u32x4 kb0 = *(const u32x4*)(cur + kc0 + 32 * AT_KSTR), kb1 = *(const u32x4*)(cur + kc1 + 32 * AT_KSTR);
            const i32x8 kfa = i32x8{(int)ka0[0], (int)ka0[1], (int)ka0[2], (int)ka0[3], (int)ka1[0], (int)ka1[1], (int)ka1[2], (int)ka1[3]};
            const i32x8 kfb = i32x8{(int)kb0[0], (int)kb0[1], (int)kb0[2], (int)kb0[3], (int)kb1[0], (int)kb1[1], (int)kb1[2], (int)kb1[3]};
            __builtin_amdgcn_s_setprio(1);
            sA = __builtin_amdgcn_mfma_scale_f32_32x32x64_f8f6f4(kfa, qf, z, 0, 0, 0, 0x7F7F7F7F, 0, 0x7C7C7C7C);
            sB = __builtin_amdgcn_mfma_scale_f32_32x32x64_f8f6f4(kfb, qf, z, 0, 0, 0, 0x7F7F7F7F, 0, 0x7C7C7C7C);
            __builtin_amdgcn_s_setprio(0);
        }
#pragma unroll
        for (int i = 0; i < 16; ++i) sA[i] = __builtin_amdgcn_exp2f(sA[i]);
#pragma unroll
        for (int i = 0; i < 16; ++i) sB[i] = __builtin_amdgcn_exp2f(sB[i]);
        int pb[8];
#pragma unroll
        for (int v = 0; v < 8; ++v) {
            const f32x16& sx = (v >> 2) ? sB : sA;
            const int r0 = 4 * (v & 3);
            int w = __builtin_amdgcn_cvt_pk_bf8_f32(sx[r0], sx[r0 + 1], __builtin_bit_cast(int, sx[r0]), false);
            w = __builtin_amdgcn_cvt_pk_bf8_f32(sx[r0 + 2], sx[r0 + 3], w, true);
            pb[v] = w;
        }
        const i32x8 pf = i32x8{pb[0], pb[1], pb[2], pb[3], pb[4], pb[5], pb[6], pb[7]};
#pragma unroll
        for (int db = 0; db < 2; ++db) {
            const unsigned char* vb = cur + AT_VOFF + db * 32 * AT_VSTR;
            const u32x4 a0 = *(const u32x4*)(vb + kc0), a1 = *(const u32x4*)(vb + kc1);
            const i32x8 vf = i32x8{(int)a0[0], (int)a0[1], (int)a0[2], (int)a0[3], (int)a1[0], (int)a1[1], (int)a1[2], (int)a1[3]};
            if (db == 0) o0 = __builtin_amdgcn_mfma_scale_f32_32x32x64_f8f6f4(vf, pf, o0, 0, 1, 0, 0x7F7F7F7F, 0, 0x7F7F7F7F);
            else         o1 = __builtin_amdgcn_mfma_scale_f32_32x32x64_f8f6f4(vf, pf, o1, 0, 1, 0, 0x7F7F7F7F, 0, 0x7F7F7F7F);
        }
        {
            const int one4 = 0x38383838;
            const i32x8 ones = i32x8{one4, one4, one4, one4, one4, one4, one4, one4};
            o2 = __builtin_amdgcn_mfma_scale_f32_32x32x64_f8f6f4(ones, pf, o2, 0, 1, 0, 0x7F7F7F7F, 0, 0x7F7F7F7F);
        }
      }
      asm volatile("s_waitcnt vmcnt(0)" ::: "memory");
      __syncthreads();
    }
    const float inv = (1.f / VT_SCALE) / o2[0];
    bf16_t* O;
    {
        const int t2 = get_tid(), lane2 = t2 & 63, wave2 = t2 >> 6;
        const int h2 = kvh * 4 + (wave2 >> 2), q2 = qb * 128 + (wave2 & 3) * 32 + (lane2 & 31);
        O = (bf16_t*)(p.ws + WS_ATT) + ((size_t)b * SEQ + q2) * QD + h2 * HD + 4 * (lane2 >> 5);
    }
#pragma unroll
    for (int g4 = 0; g4 < 4; ++g4) {
        *(u32x2*)(O + 8 * g4)      = u32x2{pk2(o0[4 * g4] * inv, o0[4 * g4 + 1] * inv), pk2(o0[4 * g4 + 2] * inv, o0[4 * g4 + 3] * inv)};
        *(u32x2*)(O + 32 + 8 * g4) = u32x2{pk2(o1[4 * g4] * inv, o1[4 * g4 + 1] * inv), pk2(o1[4 * g4 + 2] * inv, o1[4 * g4 + 3] * inv)};
    }
}

constexpr int HY_USTR = 8208, HY_R = 8 * HY_USTR, HY_RSTR = 16384 + 64;
DI void hy_load_filter(const bf16_t* __restrict__ R, unsigned char* lds, int tid) {
    const int i0 = tid * 8;
    const u32x4 w = *(const u32x4*)(R + i0);
    u32x2 nx = u32x2{0u, 0u};
    if (i0 + 8 < 8192) nx = *(const u32x2*)(R + i0 + 8);
    unsigned char* d = lds + HY_R + i0 * 2;
    *(u32x4*)(d) = w;
    *(u32x4*)(d + HY_RSTR) = u32x4{__builtin_amdgcn_alignbit(w[1], w[0], 16), __builtin_amdgcn_alignbit(w[2], w[1], 16), __builtin_amdgcn_alignbit(w[3], w[2], 16), __builtin_amdgcn_alignbit(nx[0], w[3], 16)};
    *(u32x4*)(d + 2 * HY_RSTR) = u32x4{w[1], w[2], w[3], nx[0]};
    *(u32x4*)(d + 3 * HY_RSTR) = u32x4{__builtin_amdgcn_alignbit(w[2], w[1], 16), __builtin_amdgcn_alignbit(w[3], w[2], 16), __builtin_amdgcn_alignbit(nx[0], w[3], 16), __builtin_amdgcn_alignbit(nx[1], nx[0], 16)};
}
DI void short_conv4(const bf16_t* __restrict__ zrow  , int t4, float w0, float w1, float w2, float bias, float (&out)[4]) {
    const u32x2 v = *(const u32x2*)(zrow + t4);
    const float z0 = bflo(v[0]), z1 = bfhi(v[0]), z2 = bflo(v[1]), z3 = bfhi(v[1]);
    const float zm = (t4 > 0) ? bf2f(zrow[t4 - 1]) : 0.f;
    const float zp = (t4 + 4 < SEQ) ? bf2f(zrow[t4 + 4]) : 0.f;
    out[0] = zm * w0 + z0 * w1 + z1 * w2 + bias;
    out[1] = z0 * w0 + z1 * w1 + z2 * w2 + bias;
    out[2] = z1 * w0 + z2 * w1 + z3 * w2 + bias;
    out[3] = z2 * w0 + z3 * w1 + zp * w2 + bias;
}
DI void hyena_item(const Params& p, int c, unsigned char* lds) {
    const int tid = get_tid(), lane = tid & 63, ig = tid >> 6;
    const bf16_t* ZT = (const bf16_t*)(p.ws + WS_ZT);
    const float* cw = p.in[I_HCW];
    const float* cb = p.in[I_HCB];
    __syncthreads();
    {
        const int b = tid >> 7, tb = (tid & 127) * 32;
        const bf16_t* zrow = ZT + (size_t)c * BT + (size_t)b * SEQ;
        const float w0 = cw[c], w1 = cw[HYC + c], w2 = cw[2 * HYC + c], bias = cb[c];
#pragma unroll
        for (int q = 0; q < 8; ++q) {
            float o[4];
            short_conv4(zrow, tb + 4 * q, w0, w1, w2, bias, o);
            *(u32x2*)(lds + b * HY_USTR + (tb + 4 * q) * 2) = u32x2{pk2(o[0], o[1]), pk2(o[2], o[3])};
        }
    }
    const int r = lane & 31, hf = lane >> 5, Il = r >> 3, bb = r & 7;
#pragma unroll 1
    for (int o = 0; o < 2; ++o) {
        hy_load_filter((const bf16_t*)(p.ws + WS_R) + (size_t)(o * 512 + c) * 8192, lds, tid);
        __syncthreads();
        f32x16 acc0, acc1;
#pragma unroll
        for (int i = 0; i < 16; ++i) { acc0[i] = 0.f; acc1[i] = 0.f; }
        const int sh = (-r) & 3;
        const unsigned char* abase = lds + HY_R + sh * HY_RSTR + (4096 + 8 * hf - r - sh) * 2 - 64;
        const unsigned char* ubase = lds + bb * HY_USTR + ((4 * ig + Il) * 64 + 8 * hf) * 2;
#define HY_STEP(MASKED) do { \
            const unsigned char* ap = abase - 128 * d; \
            const unsigned char* ub = ubase - 128 * d; \
            bool valid = true; \
            if (MASKED) { const int J = 4 * ig + Il - d; valid = (unsigned)J < 64u; if (!valid) ub = lds; } \
            _Pragma("unroll") for (int ks = 0; ks < 4; ++ks) { \
                u32x4 braw = *(const u32x4*)(ub + ks * 32); \
                if (MASKED) { if (!valid) braw = u32x4{0u, 0u, 0u, 0u}; } \
                const bf16x8 bf = __builtin_bit_cast(bf16x8, braw); \
                { const s16x4 lo = lds_rd64(ap + 32 * ks + 64), hi = lds_rd64(ap + 32 * ks + 72);     \
                  acc0 = MFMA32(__builtin_shufflevector(lo, hi, 0, 1, 2, 3, 4, 5, 6, 7), bf, acc0); } \
                { const s16x4 lo = lds_rd64(ap + 32 * ks), hi = lds_rd64(ap + 32 * ks + 8); \
                  acc1 = MFMA32(__builtin_shufflevector(lo, hi, 0, 1, 2, 3, 4, 5, 6, 7), bf, acc1); } \
            } } while (0)
        const int dlo = 4 * ig - 63, dhi = 4 * ig + 3;
#pragma unroll 1
        for (int d = dlo; d < dlo + 3; ++d) HY_STEP(true);
#pragma unroll 1
        for (int d = dlo + 3; d <= dhi - 3; ++d) HY_STEP(false);
        if (SHADOW == 6) {
            f32x16 s0 = acc0, s1 = acc1;
            const bf16x8 fa = *(const bf16x8*)(lds + lane * 16), fb = *(const bf16x8*)(lds + 4096 + lane * 16);
#pragma unroll 1
            for (int d = 0; d < 67; ++d) {
#pragma unroll
                for (int ks = 0; ks < 4; ++ks) { s0 = MFMA32(fa, fb, s0); s1 = MFMA32(fa, fb, s1); }
            }
            asm volatile("" :: "v"(s0), "v"(s1));
        }
        if (SHADOW == 7) {
            f32x16 k0 = acc0, k1 = acc1;
#pragma unroll 1
            for (int d = dlo + 3; d <= dhi - 3 + 6; ++d) {
                const unsigned char* ap = abase - 128 * (d > dhi - 3 ? dhi - 3 : d);
                const unsigned char* ub = ubase - 128 * (d > dhi - 3 ? dhi - 3 : d);
#pragma unroll
                for (int ks = 0; ks < 4; ++ks) {
                    const bf16x8 bf = *(const bf16x8*)(ub + ks * 32);
                    { const s16x4 lo = lds_rd64(ap + 32 * ks + 64), hi = lds_rd64(ap + 32 * ks + 72); k0 = MFMA32(__builtin_shufflevector(lo, hi, 0, 1, 2, 3, 4, 5, 6, 7), bf, k0); }
                    { const s16x4 lo = lds_rd64(ap + 32 * ks), hi = lds_rd64(ap + 32 * ks + 8); k1 = MFMA32(__builtin_shufflevector(lo, hi, 0, 1, 2, 3, 4, 5, 6, 7), bf, k1); }
                }
            }
            asm volatile("" :: "v"(k0), "v"(k1));
        }
#pragma unroll 1
        for (int d = dhi - 2; d <= dhi; ++d) HY_STEP(true);
#undef HY_STEP
        __syncthreads();
        const float skip = p.in[I_HSKIP][o * HYD + c];
        const int gcol = (o == 0 ? 512 : 1024) + c;
        const float w0 = cw[gcol], w1 = cw[HYC + gcol], w2 = cw[2 * HYC + gcol], bias = cb[gcol];
        const bf16_t* zrow = ZT + (size_t)gcol * BT + (size_t)bb * SEQ;
        bf16_t* hyt = (bf16_t*)(p.ws + WS_HYT) + (size_t)c * 128 + (size_t)bb * (SEQ / 128) * (512 * 128);
#pragma unroll
        for (int mm = 0; mm < 2; ++mm) {
#pragma unroll
            for (int g4 = 0; g4 < 4; ++g4) {
                const int t4 = (4 * ig + Il) * 64 + 32 * mm + 8 * g4 + 4 * hf;
                float gt[4];
                short_conv4(zrow, t4, w0, w1, w2, bias, gt);
                unsigned char* up = lds + bb * HY_USTR + t4 * 2;
                const u32x2 uv = *(const u32x2*)up;
                const float u0 = bflo(uv[0]), u1 = bfhi(uv[0]), u2 = bflo(uv[1]), u3 = bfhi(uv[1]);
                const f32x16& a = mm ? acc1 : acc0;
                const float y0 = gt[0] * (a[4 * g4] + skip * u0), y1 = gt[1] * (a[4 * g4 + 1] + skip * u1);
                const float y2 = gt[2] * (a[4 * g4 + 2] + skip * u2), y3 = gt[3] * (a[4 * g4 + 3] + skip * u3);
                const u32x2 pk = u32x2{pk2(y0, y1), pk2(y2, y3)};
                if (o == 0) *(u32x2*)up = pk; else *(u32x2*)(hyt + (size_t)(t4 >> 7) * (512 * 128) + (t4 & 127)) = pk;
            }
        }
        __syncthreads();
    }
}

constexpr int HY8_USTR = 4112, HY8_R = 8 * HY8_USTR, HY8_RSTR = 8192 + 32;
constexpr float HY8_US = 16.f;
DI void hy8_load_filter(const unsigned char* __restrict__ R, unsigned char* lds, int tid) {
    const int i0 = tid * 8;
    const unsigned long long lo = *(const unsigned long long*)(R + i0);
    unsigned long long hi = 0ull;
    if (i0 + 8 < 8192) hi = *(const unsigned long long*)(R + i0 + 8);
    unsigned char* d = lds + HY8_R + i0;
    *(unsigned long long*)d = lo;
#pragma unroll
    for (int sft = 1; sft < 8; ++sft) *(unsigned long long*)(d + sft * HY8_RSTR) = (lo >> (8 * sft)) | (hi << (64 - 8 * sft));
}
constexpr int HY8_ZSTR = 8192 + 16;
DI void hy8_stage_z(const Params& p, int col, unsigned char* zs, int lane, int wave) {
    const unsigned char* src = p.ws + WS_ZT + ((size_t)col * BT + (size_t)(wave >> 1) * SEQ) * 2 + (wave & 1) * 4096 + lane * 16;
#pragma unroll
    for (int e = 0; e < 4; ++e) __builtin_amdgcn_global_load_lds((const unsigned*)(src + e * 1024), (unsigned*)(zs + (wave >> 1) * HY8_ZSTR + (wave & 1) * 4096 + e * 1024), 16, 0, 0);
}
DI void short_conv4_lds(const unsigned char* zrow  , int t4, float w0, float w1, float w2, float bias, float (&out)[4]) {
    const u32x2 v = *(const u32x2*)(zrow + 2 * t4);
    const float z0 = bflo(v[0]), z1 = bfhi(v[0]), z2 = bflo(v[1]), z3 = bfhi(v[1]);
    const float zm = (t4 > 0) ? bf2f(*(const bf16_t*)(zrow + 2 * t4 - 2)) : 0.f;
    const float zp = (t4 + 4 < SEQ) ? bf2f(*(const bf16_t*)(zrow + 2 * t4 + 8)) : 0.f;
    out[0] = zm * w0 + z0 * w1 + z1 * w2 + bias;
    out[1] = z0 * w0 + z1 * w1 + z2 * w2 + bias;
    out[2] = z1 * w0 + z2 * w1 + z3 * w2 + bias;
    out[3] = z2 * w0 + z3 * w1 + zp * w2 + bias;
}
DI void hyena_item8(const Params& p, int c, unsigned char* lds) {
    const int tid = get_tid(), lane = tid & 63, wv0 = tid >> 6;
    const float* cw = p.in[I_HCW];
    const float* cb = p.in[I_HCB];
    unsigned char* zs = lds + HY8_R;
    const int wvu = __builtin_amdgcn_readfirstlane(wv0);
    __syncthreads();
    hy8_stage_z(p, c, zs, lane, wvu);
    asm volatile("s_waitcnt vmcnt(0)" ::: "memory");
    __syncthreads();
    {
        const int b = tid >> 7, tb = (tid & 127) * 32;
        const unsigned char* zrow = zs + b * HY8_ZSTR;
        const float w0 = cw[c], w1 = cw[HYC + c], w2 = cw[2 * HYC + c], bias = cb[c];
        unsigned w8[8];
#pragma unroll
        for (int q = 0; q < 8; ++q) {
            float o[4];
            short_conv4_lds(zrow, tb + 4 * q, w0, w1, w2, bias, o);
            w8[q] = pk_fp8x4(o[0] * HY8_US, o[1] * HY8_US, o[2] * HY8_US, o[3] * HY8_US);
        }
        *(u32x4*)(lds + b * HY8_USTR + tb) = u32x4{w8[0], w8[1], w8[2], w8[3]};
        *(u32x4*)(lds + b * HY8_USTR + tb + 16) = u32x4{w8[4], w8[5], w8[6], w8[7]};
    }
    const int r = lane & 31, hf = lane >> 5, Il = r >> 3, bb = r & 7;
    __syncthreads();
#pragma unroll 1
    for (int o = 0; o < 2; ++o) {
        hy8_load_filter(p.ws + WS_R + (size_t)(o * 512 + c) * 8192, lds, tid);
        __syncthreads();
        const int ig2 = wvu & 7, dh = wvu >> 3;
        f32x16 c00, c01, c10, c11;
#pragma unroll
        for (int i = 0; i < 16; ++i) { c00[i] = 0.f; c01[i] = 0.f; c10[i] = 0.f; c11[i] = 0.f; }
#define HY8_BASES() \
        const int ln_ = get_tid() & 63, r = ln_ & 31, hf = ln_ >> 5, Il = r >> 3, bb = r & 7, sh = (-r) & 7; \
        const unsigned char* abase = lds + HY8_R + sh * HY8_RSTR + (4096 + 32 * hf - r - sh) - 32;       \
        const unsigned char* ubase = lds + bb * HY8_USTR + (8 * ig2 + Il) * 64 + 32 * hf;
#define HY8_LOADB(dst, ubp, a_, MASKED) do { \
            const unsigned char* ub_ = (ubp) + 256 * (a_); \
            bool valid_ = true; \
            if (MASKED) { const int J_ = 8 * ig2 + 4 * (a_) + Il - d; valid_ = (unsigned)J_ < 64u; if (!valid_) ub_ = lds; } \
            u32x4 b0_ = *(const u32x4*)(ub_), b1_ = *(const u32x4*)(ub_ + 16); \
            if (MASKED) { if (!valid_) { b0_ = u32x4{0u, 0u, 0u, 0u}; b1_ = b0_; } } \
            dst = i32x8{(int)b0_[0], (int)b0_[1], (int)b0_[2], (int)b0_[3], (int)b1_[0], (int)b1_[1], (int)b1_[2], (int)b1_[3]}; } while (0)
#define HY8_STEP(MASKED) do { \
            const unsigned char* ap = abase - 64 * d; \
            const unsigned char* ubp = ubase - 64 * d; \
            i32x8 bf0, bf1; \
            HY8_LOADB(bf0, ubp, 0, MASKED); HY8_LOADB(bf1, ubp, 1, MASKED); \
            { const s16x4 q0 = lds_rd64(ap + 32), q1 = lds_rd64(ap + 40), q2 = lds_rd64(ap + 48), q3 = lds_rd64(ap + 56); \
              const u32x2 e0 = __builtin_bit_cast(u32x2, q0), e1 = __builtin_bit_cast(u32x2, q1), e2 = __builtin_bit_cast(u32x2, q2), e3 = __builtin_bit_cast(u32x2, q3); \
              const i32x8 af = i32x8{(int)e0[0], (int)e0[1], (int)e1[0], (int)e1[1], (int)e2[0], (int)e2[1], (int)e3[0], (int)e3[1]}; \
              c00 = MFMA8(af, bf0, c00); c01 = MFMA8(af, bf1, c01); } \
            { const s16x4 q0 = lds_rd64(ap), q1 = lds_rd64(ap + 8), q2 = lds_rd64(ap + 16), q3 = lds_rd64(ap + 24); \
              const u32x2 e0 = __builtin_bit_cast(u32x2, q0), e1 = __builtin_bit_cast(u32x2, q1), e2 = __builtin_bit_cast(u32x2, q2), e3 = __builtin_bit_cast(u32x2, q3); \
              const i32x8 af = i32x8{(int)e0[0], (int)e0[1], (int)e1[0], (int)e1[1], (int)e2[0], (int)e2[1], (int)e3[0], (int)e3[1]}; \
              c10 = MFMA8(af, bf0, c10); c11 = MFMA8(af, bf1, c11); } \
            } while (0)
        const int dlo = 8 * ig2 - 63;
        if (dh == 0) {
            HY8_BASES()
#pragma unroll 1
            for (int d = dlo; d < dlo + 8; ++d) HY8_STEP(true);
#pragma unroll 1
            for (int d = dlo + 8; d < dlo + 36; ++d) HY8_STEP(false);
        } else {
            HY8_BASES()
#pragma unroll 1
            for (int d = dlo + 36; d < dlo + 63; ++d) HY8_STEP(false);
#pragma unroll 1
            for (int d = dlo + 63; d < dlo + 71; ++d) HY8_STEP(true);
        }
#undef HY8_STEP
#undef HY8_LOADB
#undef HY8_BASES
        __syncthreads();
        f32x16 acc0, acc1;
        {
            float* xw = (float*)(lds + HY8_R) + wvu * 1024;
            const float* xr = (const float*)(lds + HY8_R) + (wvu ^ 8) * 1024;
            const int ln = get_tid() & 63;
#define HY8_XCHG(keep0, give0, keep1, give1) do { \
            _Pragma("unroll") for (int i = 0; i < 16; ++i) xw[i * 64 + ln] = give0[i]; \
            __syncthreads(); \
            _Pragma("unroll") for (int i = 0; i < 16; ++i) acc0[i] = keep0[i] + xr[i * 64 + ln]; \
            __syncthreads(); \
            _Pragma("unroll") for (int i = 0; i < 16; ++i) xw[i * 64 + ln] = give1[i]; \
            __syncthreads(); \
            _Pragma("unroll") for (int i = 0; i < 16; ++i) acc1[i] = keep1[i] + xr[i * 64 + ln]; \
            __syncthreads(); } while (0)
            if (dh == 0) HY8_XCHG(c00, c01, c10, c11); else HY8_XCHG(c01, c00, c11, c10);
#undef HY8_XCHG
        }
        const int ig = 2 * ig2 + dh;
        const int lane_e = get_tid() & 63, r_e = lane_e & 31, hf_e = lane_e >> 5, Il_e = r_e >> 3, bb_e = r_e & 7;
        const float skip = p.in[I_HSKIP][o * HYD + c];
        const float asc = ((const float*)(p.ws + WS_FSC))[o * 512 + c] * (1.f / HY8_US);
        const int gcol = (o == 0 ? 512 : 1024) + c;
        const float w0 = cw[gcol], w1 = cw[HYC + gcol], w2 = cw[2 * HYC + gcol], bias = cb[gcol];
        hy8_stage_z(p, gcol, zs, lane_e, wvu);
        asm volatile("s_waitcnt vmcnt(0)" ::: "memory");
        __syncthreads();
        const unsigned char* zrow = zs + bb_e * HY8_ZSTR;
        bf16_t* hyt = (bf16_t*)(p.ws + WS_HYT) + (size_t)c * 128 + (size_t)bb_e * (SEQ / 128) * (512 * 128);
#pragma unroll
        for (int mm = 0; mm < 2; ++mm) {
#pragma unroll
            for (int g4 = 0; g4 < 4; ++g4) {
                const int t4 = (4 * ig + Il_e) * 64 + 32 * mm + 8 * g4 + 4 * hf_e;
                float gt[4];
                short_conv4_lds(zrow, t4, w0, w1, w2, bias, gt);
                unsigned* up = (unsigned*)(lds + bb_e * HY8_USTR + t4);
                const unsigned uv = *up;
                const f32x2 ul = __builtin_amdgcn_cvt_pk_f32_fp8((int)uv, false), uh = __builtin_amdgcn_cvt_pk_f32_fp8((int)uv, true);
                const float us = skip * (1.f / HY8_US);
                const f32x16& a = mm ? acc1 : acc0;
                const float y0 = gt[0] * (a[4 * g4] * asc + us * ul[0]), y1 = gt[1] * (a[4 * g4 + 1] * asc + us * ul[1]);
                const float y2 = gt[2] * (a[4 * g4 + 2] * asc + us * uh[0]), y3 = gt[3] * (a[4 * g4 + 3] * asc + us * uh[1]);
                if (o == 0) *up = pk_fp8x4(y0 * HY8_US, y1 * HY8_US, y2 * HY8_US, y3 * HY8_US);
                else *(u32x2*)(hyt + (size_t)(t4 >> 7) * (512 * 128) + (t4 & 127)) = u32x2{pk2(y0, y1), pk2(y2, y3)};
            }
        }
        __syncthreads();
    }
}

constexpr int CTL_QUEUE_D = 8192;
DI void phase_d(const Params& p, unsigned char* lds) {
    unsigned* ctr = (unsigned*)(p.ws + WS_CTL) + CTL_QUEUE_D;
    volatile LAS unsigned* slot = (volatile LAS unsigned*)(LAS unsigned char*)(lds + LDS_ST_OFF + 8);
    for (;;) {
        __syncthreads();
        if (get_tid() == 0) slot[0] = atomicAdd(ctr, 1u);
        __syncthreads();
        const int it = __builtin_amdgcn_readfirstlane((int)slot[0]);
        if (it >= 1024) break;
        if (it < 512) hyena_item8(p, it, lds); else attn_item(p, it - 512, lds);
    }
}

DI void phase_d2(const Params& p, unsigned char* lds) {
    constexpr int TILES = 8 * (BT / 256);
    const bf16_t* HYT = (const bf16_t*)(p.ws + WS_HYT);
    bf16_t* HY = (bf16_t*)(p.ws + WS_HY);
    for (int it = blockIdx.x; it < TILES; it += gridDim.x) {
        const int tid = get_tid();
        const int c0 = (it & 7) * 64, tok0 = (it >> 3) * 256;
        __syncthreads();
#pragma unroll
        for (int i = 0; i < 2; ++i) {
            const int idx = tid + i * NT, c = idx >> 5, tg = idx & 31;
            *(u32x4*)(lds + c * 528 + tg * 16) = *(const u32x4*)(HYT + (size_t)(c0 + c) * BT + tok0 + tg * 8);
        }
        __syncthreads();
#pragma unroll
        for (int i = 0; i < 2; ++i) {
            const int idx = tid + i * NT, tok = idx >> 3, cg = idx & 7;
            unsigned w[4];
#pragma unroll
            for (int e = 0; e < 4; ++e) {
                const unsigned lo = *(const unsigned short*)(lds + (cg * 8 + 2 * e) * 528 + tok * 2);
                const unsigned hi = *(const unsigned short*)(lds + (cg * 8 + 2 * e + 1) * 528 + tok * 2);
                w[e] = lo | (hi << 16);
            }
            *(u32x4*)(HY + (size_t)(tok0 + tok) * HYD + c0 + cg * 8) = u32x4{w[0], w[1], w[2], w[3]};
        }
    }
}

template<int NT> DI void xcd_tile(int it, int& tm, int& tn) {
    if (gridDim.x == 256) {
        const int r = it >> 8, b = it & 255, xcd = b & 7, slot = b >> 3;
        tn = slot % NT; tm = r * (256 / NT) + (slot / NT) * 8 + xcd;
    } else { tn = it % NT; tm = it / NT; }
}
DI void phase_e(const Params& p, unsigned char* lds) {
    constexpr int TILES = 4 * (BT / 128);
    for (int it = blockIdx.x; it < TILES; it += gridDim.x) {
        const int tid = get_tid(), lane = tid & 63, wave = tid >> 6, wp = wave >> 2, wq = wave & 3;
        int tn, tm; xcd_tile<4>(it, tm, tn);
        const int n0 = tn * 256, tok0 = tm * 128;
        f32x4 acc1[4][2], acc2[4][2];
#pragma unroll
        for (int i = 0; i < 4; ++i)
#pragma unroll
            for (int j = 0; j < 2; ++j) { acc1[i][j] = f32x4{0.f, 0.f, 0.f, 0.f}; acc2[i][j] = f32x4{0.f, 0.f, 0.f, 0.f}; }
        {
            const RowLoader p1{(const bf16_t*)(p.ws + WS_WTAO) + (size_t)n0 * QD, QD}, q1{(const bf16_t*)(p.ws + WS_ATT) + (size_t)tok0 * QD, QD};
            const RowLoader p2{(const bf16_t*)(p.ws + WS_WTHO) + (size_t)n0 * HYD, HYD};
            const ColLoader q2{(const bf16_t*)(p.ws + WS_HYT) + (size_t)tm * (512 * 128), (size_t)128};
            gemm_mainloop<2, RowLoader, ColLoader>(acc1, p1, q1, QD / 64, lds, false, true, p2, q2);
            gemm_mainloop<2, ColLoader, RowLoader>(acc2, p2, q2, HYD / 64, lds, true, false);
        }
        const unsigned char* G8 = p.ws + WS_G;
        unsigned char* M = p.ws + WS_H;
        constexpr int ES = 272, GS = 272, EG2 = 128 * GS;
        __syncthreads();
        {
            u32x4 ga[2], gh[2];
#pragma unroll
            for (int q = 0; q < 2; ++q) {
                const int idx = tid + q * NT, row = idx >> 4, ch = idx & 15;
                const unsigned char* gp = G8 + (size_t)(tok0 + row) * GC + n0 + ch * 16;
                ga[q] = *(const u32x4*)gp; gh[q] = *(const u32x4*)(gp + 1024);
            }
#pragma unroll
            for (int q = 0; q < 2; ++q) {
                const int idx = tid + q * NT, row = idx >> 4, ch = idx & 15;
                *(u32x4*)(lds + row * GS + ch * 16) = ga[q]; *(u32x4*)(lds + EG2 + row * GS + ch * 16) = gh[q];
            }
        }
        __syncthreads();
        const int l15 = lane & 15, lk = lane >> 4;
        unsigned mo[4][2];
#pragma unroll
        for (int i = 0; i < 4; ++i)
#pragma unroll
            for (int j = 0; j < 2; ++j) {
                const int off = (wq * 32 + j * 16 + l15) * GS + wp * 64 + i * 16 + lk * 4;
                const unsigned ga = *(const unsigned*)(lds + off), gh = *(const unsigned*)(lds + EG2 + off);
                constexpr float K = MG_SCALE / 255.f;
                const float m0 = K * ((float)(ga & 255u) * acc1[i][j][0] + (float)(gh & 255u) * acc2[i][j][0]);
                const float m1 = K * ((float)((ga >> 8) & 255u) * acc1[i][j][1] + (float)((gh >> 8) & 255u) * acc2[i][j][1]);
                const float m2 = K * ((float)((ga >> 16) & 255u) * acc1[i][j][2] + (float)((gh >> 16) & 255u) * acc2[i][j][2]);
                const float m3 = K * ((float)(ga >> 24) * acc1[i][j][3] + (float)(gh >> 24) * acc2[i][j][3]);
                mo[i][j] = pk_fp8x4(m0, m1, m2, m3);
            }
        __syncthreads();
#pragma unroll
        for (int i = 0; i < 4; ++i)
#pragma unroll
            for (int j = 0; j < 2; ++j) *(unsigned*)(lds + (wq * 32 + j * 16 + l15) * ES + wp * 64 + i * 16 + lk * 4) = mo[i][j];
        __syncthreads();
#pragma unroll
        for (int q = 0; q < 2; ++q) {
            const int idx = tid + q * NT, row = idx >> 4, ch = idx & 15;
            *(u32x4*)(M + (size_t)(tok0 + row) * DM + n0 + ch * 16) = *(const u32x4*)(lds + row * ES + ch * 16);
        }
    }
}

DI void phase_f(const Params& p, unsigned char* lds) {
    constexpr int TILES = 4 * (BT / 128);
    const float* mod = (const float*)(p.ws + WS_MOD);
    for (int it = blockIdx.x; it < TILES; it += gridDim.x) {
        const int tid = get_tid(), lane = tid & 63, wave = tid >> 6, wp = wave >> 2, wq = wave & 3;
        int tn, tm; xcd_tile<4>(it, tm, tn);
        const int n0 = tn * 256, tok0 = tm * 128, b = tok0 >> 12;
        const int l15 = lane & 15, lk = lane >> 4;
        f32x4 xv[4][2];
#pragma unroll
        for (int i = 0; i < 4; ++i)
#pragma unroll
            for (int j = 0; j < 2; ++j) xv[i][j] = *(const f32x4*)(p.in[I_X] + (size_t)(tok0 + wq * 32 + j * 16 + l15) * DM + n0 + wp * 64 + i * 16 + lk * 4);
        f32x4 acc[4][2];
#pragma unroll
        for (int i = 0; i < 4; ++i)
#pragma unroll
            for (int j = 0; j < 2; ++j) acc[i][j] = f32x4{0.f, 0.f, 0.f, 0.f};
        int nk8 = DM / 128; asm volatile("" : "+s"(nk8));
        gemm_mainloop_lw<2, 8, true>(acc, RowLoader{(const bf16_t*)(p.ws + WS_W8O + (size_t)n0 * DM), DM / 2}, RowLoader{(const bf16_t*)(p.ws + WS_H + (size_t)tok0 * DM), DM / 2}, nk8, lds);
        constexpr int ES = 528, XOFF = 128 * ES;
        float ss[2] = {0.f, 0.f};
#pragma unroll
        for (int i = 0; i < 4; ++i) {
            const int n = n0 + wp * 64 + i * 16 + lk * 4;
            f32x4 g1 = *(const f32x4*)(mod + b * 6144 + 2048 + n);
            g1 *= 1.f / (W8_SCALE * MG_SCALE);
            const f32x4 s2 = *(const f32x4*)(mod + b * 6144 + 4096 + n), gf = *(const f32x4*)(p.in[I_NFFN] + n);
            const f32x4 gm = f32x4{gf[0] * (1.f + s2[0]), gf[1] * (1.f + s2[1]), gf[2] * (1.f + s2[2]), gf[3] * (1.f + s2[3])};
#pragma unroll
            for (int j = 0; j < 2; ++j) {
                const int tl = wq * 32 + j * 16 + l15, co = (wp * 64 + i * 16 + lk * 4) * 2;
                const f32x4 x1 = f32x4{xv[i][j][0] + g1[0] * acc[i][j][0], xv[i][j][1] + g1[1] * acc[i][j][1], xv[i][j][2] + g1[2] * acc[i][j][2], xv[i][j][3] + g1[3] * acc[i][j][3]};
                ss[j] += x1[0] * x1[0] + x1[1] * x1[1] + x1[2] * x1[2] + x1[3] * x1[3];
                *(u32x2*)(lds + XOFF + tl * ES + co) = u32x2{pk2(x1[0], x1[1]), pk2(x1[2], x1[3])};
                *(u32x2*)(lds + tl * ES + co) = u32x2{pk2(x1[0] * gm[0], x1[1] * gm[1]), pk2(x1[2] * gm[2], x1[3] * gm[3])};
            }
        }
#pragma unroll
        for (int j = 0; j < 2; ++j) {
            const float t = sum_x32(sum_x16(ss[j]));
            if (lk == 0) ((float*)(p.ws + WS_SSQ1))[(size_t)(tok0 + wq * 32 + j * 16 + l15) * 16 + tn * 4 + wp] = t;
        }
        __syncthreads();
        bf16_t* Y = (bf16_t*)(p.ws + WS_Y);
        const int t2 = get_tid();
        if (t2 >= 8 * 64) {
#pragma unroll 4
            for (int q = 0; q < 8; ++q) {
                const int idx = (t2 - 8 * 64) + q * 512, row = idx >> 5, ch = idx & 31;
                *(u32x4*)(Y + (size_t)(tok0 + row) * DM + n0 + ch * 8) = *(const u32x4*)(lds + row * ES + ch * 16);
                *(u32x4*)((bf16_t*)(p.out + (size_t)(tok0 + row) * DM) + n0 + ch * 8) = *(const u32x4*)(lds + XOFF + row * ES + ch * 16);
            }
        }
    }
}

DI void ins16(float (&L)[16], float v) {
#pragma unroll
    for (int i = 0; i < 16; ++i) { const float hi = fmaxf(L[i], v); v = fminf(L[i], v); L[i] = hi; }
}
DI void cex_desc(float& a, float& b) { const float hi = fmaxf(a, b), lo = fminf(a, b); a = hi; b = lo; }
DI void bitonic_merge16_desc(float (&v)[16]) {
#pragma unroll
    for (int j = 8; j > 0; j >>= 1)
#pragma unroll
        for (int i = 0; i < 16; ++i) if ((i ^ j) > i) cex_desc(v[i], v[i ^ j]);
}
DI void sort16_desc(float (&v)[16]) {
#pragma unroll
    for (int p = 1; p < 16; p <<= 1)
#pragma unroll
        for (int k = p; k >= 1; k >>= 1)
#pragma unroll
            for (int j = k % p; j <= 15 - k; j += 2 * k)
#pragma unroll
                for (int i = 0; i <= (k - 1 < 15 - j - k ? k - 1 : 15 - j - k); ++i)
                    if ((i + j) / (2 * p) == (i + j + k) / (2 * p)) cex_desc(v[i + j], v[i + j + k]);
}
DI void top16_merge(float (&a)[16], const float (&b)[16]) {
#pragma unroll
    for (int i = 0; i < 16; ++i) a[i] = fmaxf(a[i], b[15 - i]);
    bitonic_merge16_desc(a);
}
DI float pack_idx(float v, unsigned idx, unsigned mask) { return __uint_as_float((__float_as_uint(v) & ~mask) | idx); }
DI void peer_h2_item(const Params& p, int item) {
    const int tok0 = item * 128;
    const int tid = get_tid(), lane = tid & 63, wave = tid >> 6, b = tok0 >> 12;
    const float* sh2 = (const float*)(p.ws + WS_MOD) + b * 6144 + 3072 + lane * 16;
    float sh[16];
#pragma unroll
    for (int i = 0; i < 16; i += 4) { const f32x4 v = *(const f32x4*)(sh2 + i); sh[i] = v[0]; sh[i + 1] = v[1]; sh[i + 2] = v[2]; sh[i + 3] = v[3]; }
    u32x4 ny0, ny1; float nsq;
#define S0_LOAD(tk) do { const bf16_t* yr_ = (const bf16_t*)(p.ws + WS_Y) + (size_t)(tk) * DM + lane * 16; ny0 = *(const u32x4*)yr_; ny1 = *(const u32x4*)(yr_ + 8); \
        nsq = ((const float*)(p.ws + WS_SSQ1))[(size_t)(tk) * 16 + (lane & 15)]; } while (0)
    S0_LOAD(tok0 + wave * 8);
#pragma unroll 1
    for (int t = 0; t < 8; ++t) {
        const int tok = tok0 + wave * 8 + t;
        const u32x4 y0 = ny0, y1 = ny1;
        const float sq1 = nsq;
        if (t + 1 < 8) S0_LOAD(tok + 1);
        const float rs = rsqrtf(sum16(sq1) * (1.f / DM) + EPS);
        float f[16];
#pragma unroll
        for (int q = 0; q < 4; ++q) { f[2 * q] = bflo(y0[q]); f[2 * q + 1] = bfhi(y0[q]); f[8 + 2 * q] = bflo(y1[q]); f[9 + 2 * q] = bfhi(y1[q]); }
        float mx = 0.f;
#pragma unroll
        for (int i = 0; i < 16; ++i) { f[i] = rs * f[i] + sh[i]; mx = fmaxf(mx, fabsf(f[i])); }
        mx = fmaxf(wave_max(mx), 1e-30f);
        const float qs = X8_MAX / mx;
        int w8[4];
#pragma unroll
        for (int q = 0; q < 4; ++q) {
            w8[q] = __builtin_amdgcn_cvt_pk_fp8_f32(f[4 * q] * qs, f[4 * q + 1] * qs, 0, false);
            w8[q] = __builtin_amdgcn_cvt_pk_fp8_f32(f[4 * q + 2] * qs, f[4 * q + 3] * qs, w8[q], true);
        }
        *(u32x4*)(p.ws + WS_X8 + (size_t)tok * DM + lane * 16) = u32x4{(unsigned)w8[0], (unsigned)w8[1], (unsigned)w8[2], (unsigned)w8[3]};
        if (lane == 0) ((float*)(p.ws + WS_SX))[tok] = mx * (1.f / X8_MAX);
    }
#undef S0_LOAD
}
DI void peer_scores_top16(const bf16x8 (&bq)[8], const bf16_t* keysU  , int r, int hf, float (&L)[16]) {
    const unsigned ko = (unsigned)((hf * 32 + r) * 16);
    f32x16 acc[4];
#pragma unroll
    for (int m = 0; m < 4; ++m)
#pragma unroll
        for (int i = 0; i < 16; ++i) acc[m][i] = 0.f;
#pragma unroll
    for (int ks = 0; ks < 8; ++ks) {
#pragma unroll
        for (int m = 0; m < 4; ++m) {
            const bf16x8 ak = *(const bf16x8*)((const char*)keysU + (ko + (unsigned)(m * 8192)) + ks * 1024);
            acc[m] = MFMA32(ak, bq[ks], acc[m]);
        }
    }
    float V[4][16];
#define PK_SORT(m) do { _Pragma("unroll") for (int i = 0; i < 16; ++i) V[m][i] = pack_idx(acc[m][i], (unsigned)((m) * 32 + (i & 3) + 8 * (i >> 2) + 4 * hf), 127u); sort16_desc(V[m]); } while (0)
    PK_SORT(0); PK_SORT(1); top16_merge(V[0], V[1]); __builtin_amdgcn_sched_barrier(0);
    PK_SORT(2); PK_SORT(3); top16_merge(V[2], V[3]); __builtin_amdgcn_sched_barrier(0);
    top16_merge(V[0], V[2]);
#undef PK_SORT
    const int hf3 = (get_tid() >> 5) & 1;
    float P[16];
#pragma unroll
    for (int i = 0; i < 16; ++i) {
        auto sw = __builtin_amdgcn_permlane32_swap(__float_as_uint(V[0][i]), __float_as_uint(V[0][i]), false, false);
        P[i] = hf3 ? __uint_as_float(sw[0]) : __uint_as_float(sw[1]);
    }
    top16_merge(V[0], P);
#pragma unroll
    for (int i = 0; i < 16; ++i) L[i] = V[0][i];
}
DI void peer_pick(const Params& p, const float* l1, const float* l2, int tokg, int h) {
    float v1[16], v2[16];
#pragma unroll
    for (int i = 0; i < 16; i += 4) {
        const f32x4 a = *(const f32x4*)(l1 + i), b = *(const f32x4*)(l2 + i);
        v1[i] = a[0]; v1[i + 1] = a[1]; v1[i + 2] = a[2]; v1[i + 3] = a[3];
        v2[i] = b[0]; v2[i + 1] = b[1]; v2[i + 2] = b[2]; v2[i + 3] = b[3];
    }
    float B[16];
#pragma unroll
    for (int i = 0; i < 16; ++i) B[i] = -3.0e38f;
#pragma unroll
    for (int i = 0; i < 16; ++i)
#pragma unroll
        for (int j = 0; j < 16; ++j)
            if ((i + 1) * (j + 1) <= 16) ins16(B, pack_idx(v1[i] + v2[j], (unsigned)(i * 16 + j), 255u));
    float e[16], sum = 0.f;
#pragma unroll
    for (int k = 0; k < 16; ++k) { e[k] = __expf(B[k] - B[0]); sum += e[k]; }
    const float inv = 1.f / sum;
    int* ex = (int*)(p.ws + WS_EXPI) + (size_t)tokg * 128 + h * 16;
    float* gt = (float*)(p.ws + WS_GATE) + ((size_t)tokg * 128 + h * 16) * 2;
    const f32x2* usv = (const f32x2*)(p.ws + WS_USC);
    int ev[16]; float gv[16], sv[16];
#pragma unroll
    for (int k = 0; k < 16; ++k) {
        const unsigned ij = __float_as_uint(B[k]) & 255u;
        const unsigned i1 = __float_as_uint(l1[ij >> 4]) & 127u, i2 = __float_as_uint(l2[ij & 15u]) & 127u;
        ev[k] = (int)(i1 * 128u + i2);
        const f32x2 sc2 = usv[ev[k]];
        gv[k] = e[k] * inv * sc2[1];
        sv[k] = sc2[0];
    }
#pragma unroll
    for (int k = 0; k < 16; k += 4) *(u32x4*)(ex + k) = u32x4{(unsigned)ev[k], (unsigned)ev[k + 1], (unsigned)ev[k + 2], (unsigned)ev[k + 3]};
#pragma unroll
    for (int k = 0; k < 16; k += 2) *(f32x4*)(gt + 2 * k) = f32x4{gv[k], sv[k], gv[k + 1], sv[k + 1]};
}
DI void phase_h(const Params& p, unsigned char* lds) {
    for (int it = blockIdx.x; it < BT / 128; it += gridDim.x) peer_h2_item(p, it);
    constexpr int TILES = 8 * (BT / 256);
    constexpr int QS = 528;
    float* rsb = (float*)(lds + 136 * 1024);
    bool pre = false;
    for (int it = blockIdx.x; it < TILES; it += gridDim.x) {
        const int tid = get_tid(), lane = tid & 63, wave = tid >> 6, wp = wave >> 2, wq = wave & 3;
        int tn, tm; xcd_tile<8>(it, tm, tn);
        const int n0 = tn * 256, tok0 = tm * 256, b = tok0 >> 12;
        const int it2 = it + (int)gridDim.x; const bool has2 = it2 < TILES;
        int tn2 = tn, tm2 = tm; if (has2) xcd_tile<8>(it2, tm2, tn2);
        const int n2 = tn2 * 256, tk2 = tm2 * 256;
        __syncthreads();
        if (tid < 256) {
            const float* sq = (const float*)(p.ws + WS_SSQ1) + (size_t)(tok0 + tid) * 16;
            const f32x4 a = *(const f32x4*)sq, c = *(const f32x4*)(sq + 4), d = *(const f32x4*)(sq + 8), e = *(const f32x4*)(sq + 12);
            const float ssq = (a[0] + a[1] + a[2] + a[3]) + (c[0] + c[1] + c[2] + c[3]) + (d[0] + d[1] + d[2] + d[3]) + (e[0] + e[1] + e[2] + e[3]);
            rsb[tid] = rsqrtf(ssq * (1.f / DM) + EPS);
        }
        f32x4 acc[4][4];
#pragma unroll
        for (int i = 0; i < 4; ++i)
#pragma unroll
            for (int j = 0; j < 4; ++j) acc[i][j] = f32x4{0.f, 0.f, 0.f, 0.f};
        gemm_mainloop<4>(acc, RowLoader{(const bf16_t*)(p.ws + WS_WTQ) + (size_t)n0 * DM, DM}, RowLoader{(const bf16_t*)(p.ws + WS_Y) + (size_t)tok0 * DM, DM}, DM / 64, lds, pre);
        pre = has2;
        {
            const float* shq = (const float*)(p.ws + WS_SHQ) + b * 2048;
            const int l15 = lane & 15, lk = lane >> 4;
#pragma unroll
            for (int i = 0; i < 4; ++i) {
                const int nl = wp * 64 + i * 16 + lk * 4;
                const f32x4 sh = *(const f32x4*)(shq + n0 + nl);
#pragma unroll
                for (int j = 0; j < 4; ++j) {
                    const int tl = wq * 64 + j * 16 + l15;
                    const float rs = rsb[tl];
                    *(u32x2*)(lds + tl * QS + nl * 2) = u32x2{pk2(rs * acc[i][j][0] + sh[0], rs * acc[i][j][1] + sh[1]), pk2(rs * acc[i][j][2] + sh[2], rs * acc[i][j][3] + sh[3])};
                }
            }
        }
        __syncthreads();
        float L[16];
        {
            const int t1 = get_tid(), ln = t1 & 63, w1 = __builtin_amdgcn_readfirstlane(t1 >> 6), r = ln & 31, hf = ln >> 5, hpl = w1 & 1, tb = w1 >> 1;
            const int hp = 2 * tn + hpl;
            const bf16_t* keys = (const bf16_t*)(p.ws + WS_KEYS) + (size_t)((hp & 1) * 8 + (hp >> 1)) * 128 * 128;
            const unsigned char* qrow = lds + (tb * 32 + r) * QS + (hpl * 128 + 8 * hf) * 2;
            bf16x8 bq[8];
#pragma unroll
            for (int ks = 0; ks < 8; ++ks) bq[ks] = *(const bf16x8*)(qrow + 32 * ks);
            peer_scores_top16(bq, keys, r, hf, L);
        }
        __syncthreads();
        if (has2) gemm_prefetch<4>(RowLoader{(const bf16_t*)(p.ws + WS_WTQ) + (size_t)n2 * DM, DM}, RowLoader{(const bf16_t*)(p.ws + WS_Y) + (size_t)tk2 * DM, DM}, lds);
        float* lists = (float*)(lds + 96 * 1024);
        {
            const int t2 = get_tid(), ln = t2 & 63, w2 = __builtin_amdgcn_readfirstlane(t2 >> 6);
            if ((ln >> 5) == 0) {
                float* dst = lists + (((w2 >> 1) * 32 + (ln & 31)) * 2 + (w2 & 1)) * 16;
#pragma unroll
                for (int i = 0; i < 16; i += 4) *(f32x4*)(dst + i) = f32x4{L[i], L[i + 1], L[i + 2], L[i + 3]};
            }
        }
        __syncthreads();
        {
            const int t3 = get_tid();
            if (t3 < 256) peer_pick(p, lists + (t3 * 2) * 16, lists + (t3 * 2 + 1) * 16, tok0 + t3, tn);
        }
    }
}

DI float dot16_fp8(const u32x4& w, const float (&x)[16]) {
    float d = 0.f;
#pragma unroll
    for (int i = 0; i < 4; ++i) {
        const auto lo = __builtin_amdgcn_cvt_pk_f32_fp8((int)w[i], false);
        const auto hi = __builtin_amdgcn_cvt_pk_f32_fp8((int)w[i], true);
        d += lo[0] * x[4 * i] + lo[1] * x[4 * i + 1] + hi[0] * x[4 * i + 2] + hi[1] * x[4 * i + 3];
    }
    return d;
}
template<int NPART, class F> DI void run_partitioned(const Params& p, unsigned char* lds, int qbase, int nitems, F&& body) {
    unsigned* ctl = (unsigned*)(p.ws + WS_CTL);
    volatile LAS unsigned* slot = (volatile LAS unsigned*)(LAS unsigned char*)(lds + LDS_ST_OFF + 8);
    const int x0 = (int)(xb_xcc_id() & 7u);
#pragma unroll 1
    for (int pp = 0; pp < NPART; ++pp) {
        const int part = (NPART <= 8) ? ((x0 + pp) & (NPART - 1)) : ((((x0 + (pp >> 1)) & 7)) + 8 * (pp & 1));
        for (;;) {
            __syncthreads();
            if (get_tid() == 0) slot[0] = atomicAdd(ctl + qbase + 64 * part, 1u);
            __syncthreads();
            const int it = __builtin_amdgcn_readfirstlane((int)slot[0]);
            if (it >= nitems) break;
            body(part, it);
        }
    }
}
constexpr int CTL_QUEUE_I2 = 8320, CTL_QUEUE_I3 = 9408;
constexpr int UW_BYTES = 8384, UW_H2S = 1040, UW_LIST = 4160, UW_LCAP = 2112;
DI int peer_u_list(unsigned* lst, const u32x4& ia, const u32x4& ib, int, int) {
    const unsigned b0 = (unsigned)((get_tid() & 63) * 4);
    *(u32x4*)(lst + b0)       = u32x4{((b0 + 0u) << 16) | (ia[0] & 0x3fffu), ((b0 + 1u) << 16) | (ia[1] & 0x3fffu), ((b0 + 2u) << 16) | (ia[2] & 0x3fffu), ((b0 + 3u) << 16) | (ia[3] & 0x3fffu)};
    *(u32x4*)(lst + 256 + b0) = u32x4{((b0 + 256u) << 16) | (ib[0] & 0x3fffu), ((b0 + 257u) << 16) | (ib[1] & 0x3fffu), ((b0 + 258u) << 16) | (ib[2] & 0x3fffu), ((b0 + 259u) << 16) | (ib[3] & 0x3fffu)};
    return 512;
}
DI void peer_u_chunk(const Params& p, int part, int chunk, unsigned char* lds) {
    const int tid = get_tid(), lane = tid & 63, wave = __builtin_amdgcn_readfirstlane(tid >> 6);
    unsigned char* wl = lds + wave * UW_BYTES;
    const int n = lane & 15, kg = lane >> 4;
    const int ln4 = lane >> 2;
    const unsigned char* UT4 = p.ws + WS_UT + (lane & 3) * 16;
    const int bpi = 16 * n + 4 * kg;
    const unsigned char* arow = wl + (n & 3) * UW_H2S + kg * 16;
    constexpr int US = 1;
    const int tokw = chunk * (64 * US) + wave * 4;
    u32x4 pia, pib, ph[4]; f32x4 psx;
#define U_LOAD_IDS(tok) do { const u32x4* ex_ = (const u32x4*)((const int*)(p.ws + WS_EXPI) + (size_t)(tok) * 128) + lane; pia = ex_[0]; pib = ex_[64]; } while (0)
#define U_LOAD_H2(tok) do { const unsigned char* hr_ = p.ws + WS_X8 + (size_t)(tok) * DM + lane * 16; \
        ph[0] = *(const u32x4*)hr_; ph[1] = *(const u32x4*)(hr_ + DM); ph[2] = *(const u32x4*)(hr_ + 2 * DM); ph[3] = *(const u32x4*)(hr_ + 3 * DM); \
        psx = *(const f32x4*)((const float*)(p.ws + WS_SX) + (tok)); } while (0)
#define U_BPERM(dst, src) do { dst[0] = (unsigned)__builtin_amdgcn_ds_bpermute(bpi, (int)src[0]); dst[1] = (unsigned)__builtin_amdgcn_ds_bpermute(bpi, (int)src[1]); \
        dst[2] = (unsigned)__builtin_amdgcn_ds_bpermute(bpi, (int)src[2]); dst[3] = (unsigned)__builtin_amdgcn_ds_bpermute(bpi, (int)src[3]); } while (0)
    U_LOAD_IDS(tokw); U_LOAD_H2(tokw);
    int cntc = peer_u_list((unsigned*)(wl + UW_LIST), pia, pib, part, lane);
    if (US > 1) U_LOAD_IDS(tokw + 64);
    int have = -1;
    u32x4 brow[8];
#pragma unroll 1
    for (int s = 0; s < US; ++s) {
        const int tok0 = tokw + s * 64;
#pragma unroll
        for (int r = 0; r < 4; ++r) *(u32x4*)(wl + r * UW_H2S + lane * 16) = ph[r];
        const f32x4 sx = psx;
        const unsigned* lc = (const unsigned*)(wl + UW_LIST + (s & 1) * UW_LCAP);
        unsigned* ln = (unsigned*)(wl + UW_LIST + ((s + 1) & 1) * UW_LCAP);
        int cntn = 0;
        if (s + 1 < US) {
            cntn = peer_u_list(ln, pia, pib, part, lane);
            U_LOAD_H2(tok0 + 64);
            if (s + 2 < US) U_LOAD_IDS(tok0 + 128);
        }
        const int ntiles = (cntc + 15) >> 4;
#pragma unroll 1
        for (int t = 0; t < ntiles; ++t) {
            const unsigned ent = lc[t * 16 + n];
            if (have != s * 64 + t) {
                const unsigned char* rp = UT4 + (size_t)(lc[t * 16 + ln4] & 0x3fffu) * 512;
#pragma unroll
                for (int ks = 0; ks < 8; ++ks) brow[ks] = *(const u32x4*)(rp + ks * 64);
            }
            unsigned entn;
            if (t + 1 < ntiles) { entn = lc[(t + 1) * 16 + ln4]; have = s * 64 + t + 1; }
            else if (cntn > 0) { entn = ln[ln4]; have = (s + 1) * 64; }
            else { entn = lc[t * 16 + ln4]; have = -1; }
            const unsigned char* rpn = UT4 + (size_t)(entn & 0x3fffu) * 512;
            const int idx = (int)(ent >> 16), tj = idx >> 7;
            const f32x2 gs = ((const f32x2*)(p.ws + WS_GATE))[(size_t)(tok0 + tj) * 128 + (idx & 127)];
            f32x4 acc0 = f32x4{0.f, 0.f, 0.f, 0.f}, acc1 = acc0;
            u32x4 a0 = *(const u32x4*)arow, a1 = *(const u32x4*)(arow + 64), bc;
            U_BPERM(bc, brow[0]);
#pragma unroll
            for (int ks = 0; ks < 8; ++ks) {
                const i32x8 av = i32x8{(int)a0[0], (int)a0[1], (int)a0[2], (int)a0[3], (int)a1[0], (int)a1[1], (int)a1[2], (int)a1[3]};
                const i32x8 bv = i32x8{(int)bc[0], (int)bc[1], (int)bc[2], (int)bc[3], 0, 0, 0, 0};
                if (ks < 7) { a0 = *(const u32x4*)(arow + (ks + 1) * 128); a1 = *(const u32x4*)(arow + (ks + 1) * 128 + 64); U_BPERM(bc, brow[ks + 1]); }
                if (ks & 1) acc1 = __builtin_amdgcn_mfma_scale_f32_16x16x128_f8f6f4(av, bv, acc1, 0, 4, 0, 0x7F7F7F7F, 0, 0x7F7F7F7F);
                else        acc0 = __builtin_amdgcn_mfma_scale_f32_16x16x128_f8f6f4(av, bv, acc0, 0, 4, 0, 0x7F7F7F7F, 0, 0x7F7F7F7F);
                brow[ks] = *(const u32x4*)(rpn + ks * 64);
                __builtin_amdgcn_sched_barrier(0);
            }
            const float d0 = acc0[0] + acc1[0], d1 = acc0[1] + acc1[1], d2 = acc0[2] + acc1[2], d3 = acc0[3] + acc1[3];
            const float araw = (tj == 0) ? d0 : (tj == 1) ? d1 : (tj == 2) ? d2 : d3;
            const float sxv = (tj == 0) ? sx[0] : (tj == 1) ? sx[1] : (tj == 2) ? sx[2] : sx[3];
            const float a = araw * (gs[1] * sxv);
            const float y = 0.7978845608028654f * (a + 0.044715f * a * a * a);
            const float th = 1.f - 2.f * __builtin_amdgcn_rcpf(__expf(2.f * y) + 1.f);
            const float w = 0.5f * a * (1.f + th) * gs[0];
            if (kg == 0 && t * 16 + n < cntc) ((u32x2*)(p.ws + WS_PAIRS))[(size_t)(tok0 + tj) * 128 + (idx & 127)] = u32x2{ent & 0x3fffu, __float_as_uint(w)};
        }
        cntc = cntn;
    }
#undef U_BPERM
#undef U_LOAD_IDS
#undef U_LOAD_H2
}
DI void phase_i2(const Params& p, unsigned char* lds) {
    run_partitioned<1>(p, lds, CTL_QUEUE_I2, BT / 64, [&](int part, int it) { peer_u_chunk(p, part, it, lds); });
}
typedef int i32x2_t __attribute__((ext_vector_type(2)));
constexpr int VW_BYTES = 9504, VW_PAIRS = 8192, VW_HI = 9216, VW_LO = 9344, VW_ZERO = 9472;
DI void peer_v_chunk(const Params& p, int p8, int chunk, unsigned char* lds) {
    const int tid = get_tid(), lane = tid & 63, wave = __builtin_amdgcn_readfirstlane(tid >> 6);
    unsigned char* wl = lds + wave * VW_BYTES;
    const int slice = p8 & 3;
    const unsigned char* VT4 = p.ws + WS_VTAB + (size_t)slice * 16384 * 128;
    const float* mod = (const float*)(p.ws + WS_MOD);
    const int er = lane >> 3, pc = lane & 7;
    const int n = lane & 31, kg = lane >> 5;
    const int col = slice * 256 + 8 * n;
    const int tokw = (p8 >> 2) * 16384 + chunk * 256 + wave;
    if (lane < 4) ((unsigned*)(wl + VW_ZERO))[lane] = 0u;
    const unsigned char* abase = wl + ((n == 0) ? VW_HI + 16 * kg : (n == 1) ? VW_LO + 16 * kg : VW_ZERO);
    const int astep = (n < 2) ? 1 : 0;
    const int row0 = 32 * kg + (lane & 15), sw0 = (row0 >> 1) & 7;
    const unsigned char* tb0 = wl + row0 * 128 + 8 * ((lane >> 4) & 1);
    u32x4 pp = *((const u32x4*)(p.ws + WS_PAIRS + (size_t)tokw * 1024) + lane);
#pragma unroll 1
    for (int step = 0; step < 16; ++step) {
        const int tok = tokw + step * 16, b = tok >> 12;
        *(u32x4*)(wl + VW_PAIRS + lane * 16) = pp;
        const float w0 = __uint_as_float(pp[1]), w1 = __uint_as_float(pp[3]);
        const float mx = fmaxf(wave_max(fmaxf(fabsf(w0), fabsf(w1))), 1e-30f);
        const float ws = 224.f / mx;
        const int hi = __builtin_amdgcn_cvt_pk_fp8_f32(w0 * ws, w1 * ws, 0, false);
        const f32x2 dq = __builtin_amdgcn_cvt_pk_f32_fp8(hi, false);
        const int lo = __builtin_amdgcn_cvt_pk_fp8_f32((w0 * ws - dq[0]) * 16.f, (w1 * ws - dq[1]) * 16.f, 0, false);
        ((unsigned short*)(wl + VW_HI))[lane] = (unsigned short)hi;
        ((unsigned short*)(wl + VW_LO))[lane] = (unsigned short)lo;
        if (step + 1 < 16) pp = *((const u32x4*)(p.ws + WS_PAIRS + (size_t)(tok + 16) * 1024) + lane);
        bf16_t* xo = (bf16_t*)(p.out + (size_t)tok * DM) + col;
        const u32x4 x1w = *(const u32x4*)xo;
        const f32x4 g2a = *(const f32x4*)(mod + b * 6144 + 5120 + col), g2b = *(const f32x4*)(mod + b * 6144 + 5120 + col + 4);
        float res[8];
#pragma unroll
        for (int i = 0; i < 8; ++i) res[i] = 0.f;
#pragma unroll 1
        for (int hf = 0; hf < 2; ++hf) {
            asm volatile("s_waitcnt lgkmcnt(0)" ::: "memory");
            __builtin_amdgcn_sched_barrier(0);
            const unsigned* pr = (const unsigned*)(wl + VW_PAIRS) + 2 * (64 * hf + er);
#pragma unroll
            for (int q = 0; q < 8; ++q) {
                const unsigned e = pr[16 * q];
                const int sw = (4 * q + (er >> 1)) & 7;
                __builtin_amdgcn_global_load_lds((const unsigned*)(VT4 + (size_t)e * 128 + ((pc ^ sw) << 4)), (unsigned*)(wl + q * 1024), 16, 0, 0);
            }
            const u32x4 a0 = *(const u32x4*)(abase + astep * (64 * hf)), a1 = *(const u32x4*)(abase + astep * (64 * hf + 32));
            const i32x8 av = i32x8{(int)a0[0], (int)a0[1], (int)a0[2], (int)a0[3], (int)a1[0], (int)a1[1], (int)a1[2], (int)a1[3]};
            asm volatile("s_waitcnt vmcnt(0)" ::: "memory");
            __builtin_amdgcn_sched_barrier(0);
#pragma unroll
            for (int nt = 0; nt < 8; ++nt) {
                const int c = (nt ^ sw0) << 4;
                const i32x2_t b0 = __builtin_amdgcn_ds_read_tr4_b64_v2i32((LAS i32x2_t*)(LAS unsigned char*)(tb0 + c));
                const i32x2_t b1 = __builtin_amdgcn_ds_read_tr4_b64_v2i32((LAS i32x2_t*)(LAS unsigned char*)(tb0 + 16 * 128 + c));
                const i32x8 bv = i32x8{b0[0], b0[1], b1[0], b1[1], 0, 0, 0, 0};
                f32x16 z;
#pragma unroll
                for (int i = 0; i < 16; ++i) z[i] = 0.f;
                const f32x16 d = __builtin_amdgcn_mfma_scale_f32_32x32x64_f8f6f4(av, bv, z, 0, 4, 0, 0x7F7F7F7F, 0, 0x7F7F7F7F);
                res[nt] += d[0] + d[1] * (1.f / 16.f);
            }
        }
        const float iw = mx * (1.f / 224.f);
        float xv[8];
#pragma unroll
        for (int i = 0; i < 4; ++i) { xv[2 * i] = bflo(x1w[i]); xv[2 * i + 1] = bfhi(x1w[i]); }
        float ss = 0.f;
#pragma unroll
        for (int i = 0; i < 8; ++i) { xv[i] += (i < 4 ? g2a[i & 3] : g2b[i & 3]) * (res[i] * iw); ss += xv[i] * xv[i]; }
        if (lane < 32) *(u32x4*)xo = u32x4{pk2(xv[0], xv[1]), pk2(xv[2], xv[3]), pk2(xv[4], xv[5]), pk2(xv[6], xv[7])};
        ss = wave_sum(lane < 32 ? ss : 0.f);
        if (lane == 0) ((float*)(p.ws + WS_SSQ))[(size_t)tok * 8 + slice] = ss;
    }
}
DI void phase_i3(const Params& p, unsigned char* lds) {
    run_partitioned<8>(p, lds, CTL_QUEUE_I3, 16384 / 256, [&](int part, int it) { peer_v_chunk(p, part, it, lds); });
}
DI void phase_i4(const Params& p) {
    const bool bad = xb_ld((unsigned*)(p.ws + WS_CTL) + CTL_BADTID) != 0u || xb_ld((unsigned*)(p.ws + WS_CTL) + XB_TMO) != 0u;
    const int tid = get_tid(), lane = tid & 63, wave = tid >> 6, G = (int)gridDim.x;
    f32x4 gfn[4];
#pragma unroll
    for (int j = 0; j < 4; ++j) gfn[j] = *(const f32x4*)(p.in[I_FNG] + j * 256 + lane * 4);
    u32x2 nx[4]; f32x4 ns = f32x4{0.f, 0.f, 0.f, 0.f};
    int it = blockIdx.x;
#define I4_LOAD(item) do { const int row_ = (item) * 16 + wave; const bf16_t* xr_ = (const bf16_t*)(p.out + (size_t)row_ * DM) + lane * 4; \
        _Pragma("unroll") for (int j = 0; j < 4; ++j) nx[j] = *(const u32x2*)(xr_ + j * 256); \
        ns = *(const f32x4*)((const float*)(p.ws + WS_SSQ) + (size_t)row_ * 8); } while (0)
    if (it < BT / 16) I4_LOAD(it);
#pragma unroll 1
    for (; it < BT / 16; it += G) {
        const int row = it * 16 + wave;
        u32x2 xw[4];
#pragma unroll
        for (int j = 0; j < 4; ++j) xw[j] = nx[j];
        const f32x4 s0 = ns;
        asm volatile("s_waitcnt vmcnt(0)" ::: "memory");
        if (it + G < BT / 16) I4_LOAD(it + G);
        const float ss = s0[0] + s0[1] + s0[2] + s0[3];
        float rs = rsqrtf(ss * (1.f / DM) + EPS);
        if (bad) rs = __builtin_nanf("");
        float* o = p.out + (size_t)row * DM;
#pragma unroll
        for (int j = 0; j < 4; ++j) {
            const f32x4 g = gfn[j];
            const f32x4 r4 = f32x4{bflo(xw[j][0]) * rs * g[0], bfhi(xw[j][0]) * rs * g[1], bflo(xw[j][1]) * rs * g[2], bfhi(xw[j][1]) * rs * g[3]};
            __builtin_nontemporal_store(r4, (f32x4*)(o + j * 256 + lane * 4));
        }
    }
#undef I4_LOAD
}

DI float probe_mfma_mixed() {
    const int lane = get_tid() & 63, kg = lane >> 4;
    int aw[8];
#pragma unroll
    for (int v = 0; v < 8; ++v) {
        unsigned w = 0;
#pragma unroll
        for (int b = 0; b < 4; ++b) { const unsigned q = 32u * kg + 4u * v + b; w |= (((q & 63u) + 8u) | ((q >> 6) << 7)) << (8 * b); }
        aw[v] = (int)w;
    }
    const i32x8 av = i32x8{aw[0], aw[1], aw[2], aw[3], aw[4], aw[5], aw[6], aw[7]};
    int c1 = 0, c2 = 0, c4 = 0, c5 = 0; unsigned pi1 = 255;
#pragma unroll 1
    for (int pb = 0; pb < 128; ++pb) {
        const int kgB = pb >> 5, i0 = pb & 31;
        const unsigned hot = (kg == kgB) ? (2u << (4 * (i0 & 7))) : 0u;
        const i32x8 bv = i32x8{(i0 >> 3) == 0 ? (int)hot : 0, (i0 >> 3) == 1 ? (int)hot : 0, (i0 >> 3) == 2 ? (int)hot : 0, (i0 >> 3) == 3 ? (int)hot : 0, 0, 0, 0, 0};
        const f32x4 z = f32x4{0.f, 0.f, 0.f, 0.f};
        const f32x4 dd = __builtin_amdgcn_mfma_scale_f32_16x16x128_f8f6f4(av, bv, z, 0, 4, 0, 0x7F7F7F7F, 0, 0x7F7F7F7F);
        const float d = dd[0];
        unsigned qf = 255;
#pragma unroll 1
        for (unsigned q = 0; q < 128; ++q) { const unsigned byte = ((q & 63u) + 8u) | ((q >> 6) << 7); if (__builtin_amdgcn_cvt_f32_fp8((int)byte, 0) == d) qf = q; }
        c1 += (qf != (unsigned)pb); c2 += (qf != (unsigned)(pb ^ 1));
        { const unsigned k = 64u * (i0 >> 4) + 16u * kgB + (i0 & 15); c4 += (qf != k); }
        { const unsigned k = (unsigned)pb, kgA = (k & 63u) >> 4, j = 16u * (k >> 6) + (k & 15u); c5 += (qf != 32u * kgA + j); }
        if (pb == 1) pi1 = qf;
    }
    return c1 == 0 ? 1.1e6f : c2 == 0 ? 2.2e6f : c4 == 0 ? 4.4e6f : c5 == 0 ? 5.5e6f : (pi1 < 90u ? (10.f + (float)pi1) * 100.f : 7.7e6f);
}

__global__ void __launch_bounds__(NT) mega(Params p) {
    unsigned char* lds = g_lds;
    volatile LAS unsigned* st = (volatile LAS unsigned*)(LAS unsigned char*)(lds + LDS_ST_OFF);
    {
        const unsigned hw = __builtin_amdgcn_s_getreg((5 << 11) | 4);
        if ((threadIdx.x & 63) == 0) g_lds[LDS_WTAB_OFF + hw] = (unsigned char)(threadIdx.x >> 6);
        if (threadIdx.x < 2) st[threadIdx.x] = 0u;
        __syncthreads();
        if (get_tid() != (int)threadIdx.x) ((unsigned*)(p.ws + WS_CTL))[CTL_BADTID] = 1u;
    }
    XcdBarrier bar = xcd_barrier_post((unsigned*)(p.ws + WS_CTL), st);
    float* sm = (float*)lds;

#define STAMP(k, which) do { if (PROBE_PHASE == (k) && blockIdx.x == 0 && get_tid() == 0) ((volatile unsigned long long*)(lds + LDS_PROBE_OFF))[which] = __builtin_amdgcn_s_memrealtime(); } while (0)
    STAMP(21, 0); STAMP(30, 0); STAMP(31, 0);
    STAMP(0, 0); phase_a(p, sm);   xcd_barrier(bar); STAMP(0, 1);
    STAMP(1, 0); phase_b(p, sm);   xcd_barrier(bar); STAMP(1, 1);
    if (PROBE_PHASE == 20) { STAMP(20, 0); xcd_barrier(bar); xcd_barrier(bar); xcd_barrier(bar); xcd_barrier(bar); STAMP(20, 1); }
    STAMP(2, 0); phase_c(p, lds);  xcd_barrier(bar); STAMP(2, 1);
    STAMP(3, 0); phase_d(p, lds);  xcd_barrier(bar); STAMP(3, 1);
    STAMP(5, 0); phase_e(p, lds);  xcd_barrier(bar); STAMP(5, 1);
    STAMP(6, 0); phase_f(p, lds);  xcd_barrier(bar); STAMP(6, 1);
    STAMP(8, 0); phase_h(p, lds);  xcd_barrier(bar); STAMP(8, 1);
    STAMP(10, 0); phase_i2(p, lds); xcd_barrier(bar); STAMP(10, 1);
    STAMP(11, 0); phase_i3(p, lds); xcd_barrier(bar); STAMP(11, 1);
    STAMP(12, 0); phase_i4(p);
    float pm = 0.f;
    if (PROBE_PHASE == 40 && blockIdx.x == 0 && get_tid() < 64) pm = probe_mfma_mixed();
    if (PROBE_PHASE >= 0) {
        xcd_barrier(bar); STAMP(12, 1); STAMP(21, 1);
        if (blockIdx.x == 0 && get_tid() == 0) {
            volatile unsigned long long* ts = (volatile unsigned long long*)(lds + LDS_PROBE_OFF);
            if (PROBE_PHASE == 40) p.out[0] += pm; else
            p.out[0] += (float)(ts[1] - ts[0]) * (0.01f / PROBE_SCALE);
        }
    }
}

extern "C" void kernel_launch(void* const* d_in, const int* in_sizes, int n_in, void* d_out, int out_size, void* d_ws, size_t ws_size, hipStream_t stream) {
    static int grid = 0;
    if (grid == 0) {
        int dev = 0, cus = 0;
        if (hipGetDevice(&dev) != hipSuccess || hipDeviceGetAttribute(&cus, hipDeviceAttributeMultiprocessorCount, dev) != hipSuccess) { fprintf(stderr, "kernel_launch: device query failed\n"); grid = -1; return; }
        if (n_in != N_IN || ws_size < WS_END) { fprintf(stderr, "kernel_launch: unexpected n_in %d or ws_size %zu (< %zu)\n", n_in, ws_size, (size_t)WS_END); grid = -1; return; }
        grid = cus;
    }
    if (grid < 0) return;
    (void)hipMemsetAsync((char*)d_ws + WS_CTL, 0, 64 * 1024, stream);
    Params p{};
    for (int i = 0; i < N_IN; ++i) p.in[i] = (const float*)d_in[i];
    p.out = (float*)d_out; p.ws = (unsigned char*)d_ws;
    hipLaunchKernelGGL(mega, dim3(grid), dim3(NT), 0, stream, p);
}
```
